# Optimizing an MI355X kernel written in HIP

```python
import math
import jax, jax.numpy as jnp
from jax import lax
import numpy as np

D_MODEL = 1024
BATCH = 8
SEQ = 4096
DEPTH = 1

GRID_W = 64
CTX_LEN = 256
EPS = 1e-6

SSM_WIDTH = 512
SSM_GROUP = 16
SSM_GROUPS = SSM_WIDTH // SSM_GROUP
SSM_STATE = 64

NA_HEADS = 8
NA_HEAD_DIM = 64
NA_WIDTH = NA_HEADS * NA_HEAD_DIM
NA_ROWS_MAX = 8
NA_COLS = 16

COL_K = SSM_WIDTH
COL_V = COL_K + NA_WIDTH
COL_Q = COL_V + NA_WIDTH
COL_GA = COL_Q + NA_WIDTH
COL_GB = COL_GA + D_MODEL
IN_COLS = COL_GB + D_MODEL
CTX_COLS = COL_Q

PEER_HEADS = 8
PEER_KEYS = 128
PEER_EXPERTS = PEER_KEYS * PEER_KEYS
PEER_QDIM = 256
PEER_HALF = PEER_QDIM // 2
PEER_TOPK = 16
PEER_BLOCK = 128

kernel_name = 'hybrid_s5_natten_peer_dit_layer'


def rms_norm(t, g):
    tf = t.astype(jnp.float32)
    y = tf * lax.rsqrt(jnp.mean(tf * tf, axis=-1, keepdims=True) + EPS)
    return (y * g.astype(jnp.float32)).astype(t.dtype)


def modulate(t, g, shift, scale):
    return rms_norm(t, g) * (1 + scale) + shift


def adaln(cond, w_mod, b_mod, n_chunks):
    m = jax.nn.silu(cond) @ w_mod[:, :n_chunks * D_MODEL] + b_mod[:n_chunks * D_MODEL]
    return jnp.split(m, n_chunks, axis=-1)


def s5_discretise(p, direction):
    f32 = jnp.float32
    lam = lax.complex(p['ssm_a_re'][direction].astype(f32), p['ssm_a_im'][direction].astype(f32))
    dt = jnp.exp(p['ssm_log_dt'][direction].astype(f32))[:, None]
    lam_bar = jnp.exp(lam * dt)
    b = lax.complex(p['ssm_b_re'][direction].astype(f32), p['ssm_b_im'][direction].astype(f32))
    b_bar = ((lam_bar - 1) / lam)[..., None] * b
    cmat = lax.complex(p['ssm_c_re'][direction].astype(f32), p['ssm_c_im'][direction].astype(f32))
    return lam_bar, b_bar, cmat


def _linear_recurrence(e1, e2):
    a1, b1 = e1
    a2, b2 = e2
    return a2 * a1, a2 * b1 + b2


def s5_scan(lam_bar, bu, s0, reverse):
    if s0 is not None:
        bu = bu.at[-1 if reverse else 0].add(lam_bar * s0)
    a = jnp.broadcast_to(lam_bar, (bu.shape[0], 1) + lam_bar.shape)
    _, s = lax.associative_scan(_linear_recurrence, (a, bu), reverse=reverse, axis=0)
    return s


def s5_mixer(u_lat, u_ctx, p, with_ctx_out):
    def groups(u):
        n, b = u.shape[1], u.shape[0]
        return jnp.swapaxes(u.astype(jnp.float32), 0, 1).reshape(n, b, SSM_GROUPS, SSM_GROUP).astype(jnp.complex64)

    def readout(cmat, s):
        y = jnp.einsum('ghp,nbgp->nbgh', cmat, s).real
        return jnp.swapaxes(y.reshape(y.shape[0], y.shape[1], SSM_WIDTH), 0, 1)

    ul, uc = groups(u_lat), groups(u_ctx)
    d_skip = p['ssm_d'].astype(jnp.float32)
    y_lat = d_skip * u_lat.astype(jnp.float32)
    y_ctx = d_skip * u_ctx.astype(jnp.float32) if with_ctx_out else None
    for direction, reverse in ((0, False), (1, True)):
        lam_bar, b_bar, cmat = s5_discretise(p, direction)
        s_ctx = s5_scan(lam_bar, jnp.einsum('gph,nbgh->nbgp', b_bar, uc), None, reverse)
        s0 = s_ctx[0] if reverse else s_ctx[-1]
        s_lat = s5_scan(lam_bar, jnp.einsum('gph,nbgh->nbgp', b_bar, ul), s0, reverse)
        y_lat = y_lat + readout(cmat, s_lat)
        if with_ctx_out:
            y_ctx = y_ctx + readout(cmat, s_ctx)
    return y_lat, y_ctx


def s5_glu(y, p):
    z = jax.nn.gelu(y)
    return z * jax.nn.sigmoid(z @ p['w_glu'] + p['b_glu'])


def ctx_heads(t):
    b, n, _ = t.shape
    return t.reshape(b, n, NA_HEADS, NA_HEAD_DIM).transpose(0, 2, 1, 3)


def na_mixer(q, k, v, k_ctx, v_ctx, rpb):
    b, l, _ = q.shape
    rows = l // GRID_W
    kh = min(NA_ROWS_MAX, rows)
    n_band = kh * GRID_W

    def grid_heads(t):
        return t.reshape(b, rows, GRID_W, NA_HEADS, NA_HEAD_DIM).transpose(0, 3, 1, 2, 4)

    qg, kg, vg = grid_heads(q), grid_heads(k), grid_heads(v)
    cols = jnp.arange(GRID_W)
    c0 = jnp.clip(cols - NA_COLS // 2, 0, GRID_W - NA_COLS)
    col_in = (cols[None, :] >= c0[:, None]) & (cols[None, :] < c0[:, None] + NA_COLS)
    dc = jnp.clip(cols[None, :] - cols[:, None] + NA_COLS - 1, 0, 2 * NA_COLS - 2)
    rpb = rpb.astype(jnp.float32)
    scale = NA_HEAD_DIM ** -0.5

    def row_block(args):
        r, q_row = args
        r0 = jnp.clip(r - kh // 2, 0, rows - kh)
        k_band = lax.dynamic_slice_in_dim(kg, r0, kh, axis=2).reshape(b, NA_HEADS, n_band, NA_HEAD_DIM)
        v_band = lax.dynamic_slice_in_dim(vg, r0, kh, axis=2).reshape(b, NA_HEADS, n_band, NA_HEAD_DIM)
        dr = r0 + jnp.arange(kh) - r + NA_ROWS_MAX - 1
        bias = rpb[:, dr[:, None, None], dc[None, :, :]]
        bias = jnp.where(col_in[None, None], bias, -jnp.inf)
        bias = bias.transpose(0, 2, 1, 3).reshape(NA_HEADS, GRID_W, n_band)
        s_lat = jnp.einsum('bhqd,bhkd->bhqk', q_row, k_band).astype(jnp.float32) * scale + bias
        s_ctx = jnp.einsum('bhqd,bhkd->bhqk', q_row, k_ctx).astype(jnp.float32) * scale
        prob = jax.nn.softmax(jnp.concatenate([s_lat, s_ctx], axis=-1), axis=-1).astype(v.dtype)
        return (jnp.einsum('bhqk,bhkd->bhqd', prob[..., :n_band], v_band)
                + jnp.einsum('bhqk,bhkd->bhqd', prob[..., n_band:], v_ctx))

    o = lax.map(row_block, (jnp.arange(rows), jnp.moveaxis(qg, 2, 0)))
    return o.transpose(1, 0, 3, 2, 4).reshape(b, l, NA_WIDTH)


def ctx_attention(q_c, k_c, v_c):
    s = jnp.einsum('bhqd,bhkd->bhqk', q_c, k_c).astype(jnp.float32) * NA_HEAD_DIM ** -0.5
    prob = jax.nn.softmax(s, axis=-1).astype(v_c.dtype)
    o = jnp.einsum('bhqk,bhkd->bhqd', prob, v_c)
    b, _, n, _ = o.shape
    return o.transpose(0, 2, 1, 3).reshape(b, n, NA_WIDTH)


def peer_ffn(h, w_q, subkeys, u_tab, v_tab):
    b, l, d = h.shape
    q = (h @ w_q).reshape(b, l, PEER_HEADS, 2, PEER_HALF)
    s = jnp.einsum('blhnd,nkd->blhnk', q, subkeys).astype(jnp.float32)
    s_top, i_top = lax.top_k(s, PEER_TOPK)
    n_cand = PEER_TOPK * PEER_TOPK
    cand = (s_top[..., 0, :, None] + s_top[..., 1, None, :]).reshape(b, l, PEER_HEADS, n_cand)
    cand_idx = (i_top[..., 0, :, None] * PEER_KEYS + i_top[..., 1, None, :]).reshape(b, l, PEER_HEADS, n_cand)
    best, pos = lax.top_k(cand, PEER_TOPK)
    expert = jnp.take_along_axis(cand_idx, pos, axis=-1)
    gate = jax.nn.softmax(best, axis=-1)
    n_blk = (b * l) // PEER_BLOCK

    def block(args):
        h_blk, e_blk, g_blk = args
        a = jnp.einsum('td,thkd->thk', h_blk, u_tab[e_blk])
        w = (g_blk * jax.nn.gelu(a.astype(jnp.float32))).astype(v_tab.dtype)
        return jnp.einsum('thk,thkd->td', w, v_tab[e_blk])

    out = lax.map(block, (h.reshape(n_blk, PEER_BLOCK, d),
                          expert.reshape(n_blk, PEER_BLOCK, PEER_HEADS, PEER_TOPK),
                          gate.reshape(n_blk, PEER_BLOCK, PEER_HEADS, PEER_TOPK)))
    return out.reshape(b, l, d)


def hybrid_layer(x, ctx, c, c_ctx, p, with_ctx_out):
    shift1, scale1, gate1, shift2, scale2, gate2 = adaln(c[:, None, :], p['w_mod'], p['b_mod'], 6)
    mod_c = adaln(c_ctx[None, None, :], p['w_mod'], p['b_mod'], 6 if with_ctx_out else 2)

    hx = modulate(x, p['norm1_g'], shift1, scale1)
    hc = modulate(ctx, p['norm1_g'], mod_c[0], mod_c[1])
    px = hx @ p['w_in']
    u_x, k_x, v_x, q_x, ga_x, gb_x = jnp.split(px, [COL_K, COL_V, COL_Q, COL_GA, COL_GB], axis=-1)
    pc = hc @ p['w_in'][:, :(IN_COLS if with_ctx_out else CTX_COLS)]
    u_c, k_c, v_c = pc[..., :COL_K], pc[..., COL_K:COL_V], pc[..., COL_V:COL_Q]
    kc, vc = ctx_heads(k_c), ctx_heads(v_c)

    y_ssm_x, y_ssm_c = s5_mixer(u_x, u_c, p, with_ctx_out)
    branch_a = (s5_glu(y_ssm_x, p) @ p['w_branch_a']).astype(x.dtype)
    branch_b = na_mixer(q_x, k_x, v_x, kc, vc, p['na_rpb']) @ p['w_branch_b']
    merged = jax.nn.sigmoid(ga_x) * branch_a + jax.nn.sigmoid(gb_x) * branch_b
    x = x + gate1 * (merged @ p['w_out'])
    x = x + gate2 * peer_ffn(modulate(x, p['norm2_g'], shift2, scale2),
                             p['peer_w_q'], p['peer_subkeys'], p['peer_u'], p['peer_v'])

    if with_ctx_out:
        _, _, c_gate1, c_shift2, c_scale2, c_gate2 = mod_c
        q_c, ga_c, gb_c = pc[..., COL_Q:COL_GA], pc[..., COL_GA:COL_GB], pc[..., COL_GB:]
        branch_a_c = (s5_glu(y_ssm_c, p) @ p['w_branch_a']).astype(ctx.dtype)
        branch_b_c = ctx_attention(ctx_heads(q_c), kc, vc) @ p['w_branch_b']
        merged_c = jax.nn.sigmoid(ga_c) * branch_a_c + jax.nn.sigmoid(gb_c) * branch_b_c
        ctx = ctx + c_gate1 * (merged_c @ p['w_out'])
        ctx = ctx + c_gate2 * peer_ffn(modulate(ctx, p['norm2_g'], c_shift2, c_scale2),
                                       p['peer_w_q'], p['peer_subkeys'], p['peer_u'], p['peer_v'])
    return x, ctx


def setup_inputs(seed: int = 0) -> dict:
    key = jax.random.key(seed)
    ks = jax.random.split(key, 28)
    f32 = jnp.float32

    def nrm(k, shape, scale):
        return jax.random.normal(k, shape, f32) * scale

    L = DEPTH
    G, P, H = SSM_GROUPS, SSM_STATE, SSM_GROUP
    n_idx = jnp.arange(SSM_STATE, dtype=f32)
    return {
        'x': nrm(ks[0], (BATCH, SEQ, D_MODEL), 1.0),
        'c': nrm(ks[1], (BATCH, D_MODEL), 1.0),
        'ctx': nrm(ks[2], (BATCH, CTX_LEN, D_MODEL), 1.0),
        'c_ctx': nrm(ks[3], (D_MODEL,), 1.0),
        'w_mod': nrm(ks[4], (L, D_MODEL, 6 * D_MODEL), 0.5 * D_MODEL ** -0.5),
        'b_mod': nrm(ks[5], (L, 6 * D_MODEL), 0.01),
        'norm1_g': 1.0 + nrm(ks[6], (L, D_MODEL), 0.01),
        'norm2_g': 1.0 + nrm(ks[7], (L, D_MODEL), 0.01),
        'w_in': nrm(ks[8], (L, D_MODEL, IN_COLS), D_MODEL ** -0.5),
        'ssm_a_re': -0.5 + nrm(ks[9], (L, 2, G, P), 0.01),
        'ssm_a_im': math.pi * n_idx + nrm(ks[10], (L, 2, G, P), 0.01),
        'ssm_log_dt': jax.random.uniform(ks[11], (L, 2, G), f32, math.log(1e-3), math.log(1e-1)),
        'ssm_b_re': nrm(ks[12], (L, 2, G, P, H), (2 * H) ** -0.5),
        'ssm_b_im': nrm(ks[13], (L, 2, G, P, H), (2 * H) ** -0.5),
        'ssm_c_re': nrm(ks[14], (L, 2, G, H, P), P ** -0.5),
        'ssm_c_im': nrm(ks[15], (L, 2, G, H, P), P ** -0.5),
        'ssm_d': nrm(ks[16], (L, SSM_WIDTH), 1.0),
        'w_glu': nrm(ks[17], (L, SSM_WIDTH, SSM_WIDTH), SSM_WIDTH ** -0.5),
        'b_glu': nrm(ks[18], (L, SSM_WIDTH), 0.01),
        'w_branch_a': nrm(ks[19], (L, SSM_WIDTH, D_MODEL), SSM_WIDTH ** -0.5),
        'w_branch_b': nrm(ks[20], (L, NA_WIDTH, D_MODEL), NA_WIDTH ** -0.5),
        'na_rpb': nrm(ks[21], (L, NA_HEADS, 2 * NA_ROWS_MAX - 1, 2 * NA_COLS - 1), 0.02),
        'w_out': nrm(ks[22], (L, D_MODEL, D_MODEL), D_MODEL ** -0.5),
        'peer_w_q': nrm(ks[23], (L, D_MODEL, PEER_HEADS * PEER_QDIM), D_MODEL ** -0.5),
        'peer_subkeys': nrm(ks[24], (L, 2, PEER_KEYS, PEER_HALF), PEER_HALF ** -0.5),
        'peer_u': nrm(ks[25], (L, PEER_EXPERTS, D_MODEL), D_MODEL ** -0.5),
        'peer_v': nrm(ks[26], (L, PEER_EXPERTS, D_MODEL), PEER_HEADS ** -0.5),
        'final_g': 1.0 + nrm(ks[27], (D_MODEL,), 0.01),
    }


def reference(x, c, ctx, c_ctx, w_mod, b_mod, norm1_g, norm2_g, w_in,
              ssm_a_re, ssm_a_im, ssm_log_dt, ssm_b_re, ssm_b_im, ssm_c_re, ssm_c_im, ssm_d,
              w_glu, b_glu, w_branch_a, w_branch_b, na_rpb, w_out,
              peer_w_q, peer_subkeys, peer_u, peer_v, final_g):
    for i in range(DEPTH):
        p = {
            'w_mod': w_mod[i], 'b_mod': b_mod[i], 'norm1_g': norm1_g[i], 'norm2_g': norm2_g[i],
            'w_in': w_in[i],
            'ssm_a_re': ssm_a_re[i], 'ssm_a_im': ssm_a_im[i], 'ssm_log_dt': ssm_log_dt[i],
            'ssm_b_re': ssm_b_re[i], 'ssm_b_im': ssm_b_im[i], 'ssm_c_re': ssm_c_re[i], 'ssm_c_im': ssm_c_im[i],
            'ssm_d': ssm_d[i], 'w_glu': w_glu[i], 'b_glu': b_glu[i],
            'w_branch_a': w_branch_a[i], 'w_branch_b': w_branch_b[i], 'na_rpb': na_rpb[i], 'w_out': w_out[i],
            'peer_w_q': peer_w_q[i], 'peer_subkeys': peer_subkeys[i], 'peer_u': peer_u[i], 'peer_v': peer_v[i],
        }
        x, ctx = hybrid_layer(x, ctx, c, c_ctx, p, with_ctx_out=(i < DEPTH - 1))
    return rms_norm(x, final_g)
```

```cpp
#include <hip/hip_runtime.h>
#include <hip/hip_cooperative_groups.h>
#include <cstdio>
#include <cstdint>
namespace cg = cooperative_groups;

#ifndef MODE_COOP
#define MODE_COOP 1
#endif

constexpr int DM = 1024, NB = 8, SEQL = 4096, CTXL = 256, GW = 64;
constexpr int INC = 4096, CTXC = 1536;
constexpr int NT = 512;
constexpr float EPSN = 1e-6f;

struct P {
    const float *x, *c, *ctx, *c_ctx, *w_mod, *b_mod, *norm1_g, *norm2_g, *w_in;
    const float *a_re, *a_im, *log_dt, *b_re, *b_im, *c_re, *c_im, *ssm_d;
    const float *w_glu, *b_glu, *w_a, *w_b, *rpb, *w_out, *w_q, *subkeys, *peer_u, *peer_v, *final_g;
    float* out;
    float *mod, *hx, *hc, *px, *pc, *yf, *yr, *zb, *gl, *na, *merged, *h2, *qb;
};

__device__ __forceinline__ float wave_sum(float v) {
#pragma unroll
    for (int o = 1; o < 64; o <<= 1) v += __shfl_xor(v, o);
    return v;
}
__device__ __forceinline__ float wave_max(float v) {
#pragma unroll
    for (int o = 1; o < 64; o <<= 1) v = fmaxf(v, __shfl_xor(v, o));
    return v;
}
__device__ __forceinline__ float sigmoidf_(float x) { return 1.f / (1.f + __expf(-x)); }
__device__ __forceinline__ float siluf_(float x) { return x / (1.f + __expf(-x)); }
__device__ __forceinline__ float gelu_tanh(float x) {
    const float k0 = 0.7978845608028654f, k1 = 0.044715f;
    float u = k0 * (x + k1 * x * x * x);
    float t = 1.f - 2.f / (1.f + __expf(2.f * u));
    return 0.5f * x * (1.f + t);
}

__device__ void ph_adaln(const P& p) {
    const int gtid = blockIdx.x * blockDim.x + threadIdx.x, gsz = gridDim.x * blockDim.x;
    for (int j = gtid; j < 6 * DM; j += gsz) {
        float acc[9];
#pragma unroll
        for (int r = 0; r < 9; ++r) acc[r] = 0.f;
        for (int k = 0; k < DM; ++k) {
            const float w = p.w_mod[(size_t)k * (6 * DM) + j];
#pragma unroll
            for (int r = 0; r < 8; ++r) acc[r] += siluf_(p.c[r * DM + k]) * w;
            acc[8] += siluf_(p.c_ctx[k]) * w;
        }
        const float bj = p.b_mod[j];
#pragma unroll
        for (int r = 0; r < 9; ++r) p.mod[r * (6 * DM) + j] = acc[r] + bj;
    }
}

__device__ void normmod_rows(const float* src, float* dst, int nrows, const float* g, const float* shift, const float* scale) {
    const int wave = threadIdx.x >> 6, lane = threadIdx.x & 63, nw = blockDim.x >> 6;
    for (int r = blockIdx.x * nw + wave; r < nrows; r += gridDim.x * nw) {
        const float4* s = (const float4*)(src + (size_t)r * DM);
        float4 v[4]; float ss = 0.f;
#pragma unroll
        for (int j = 0; j < 4; ++j) { v[j] = s[lane + 64 * j]; ss += v[j].x * v[j].x + v[j].y * v[j].y + v[j].z * v[j].z + v[j].w * v[j].w; }
        ss = wave_sum(ss);
        const float rstd = rsqrtf(ss * (1.f / DM) + EPSN);
        float4* d = (float4*)(dst + (size_t)r * DM);
#pragma unroll
        for (int j = 0; j < 4; ++j) {
            const int i4 = lane + 64 * j;
            const float4 gg = ((const float4*)g)[i4], sh = ((const float4*)shift)[i4], sc = ((const float4*)scale)[i4];
            float4 o;
            o.x = v[j].x * rstd * gg.x * (1.f + sc.x) + sh.x; o.y = v[j].y * rstd * gg.y * (1.f + sc.y) + sh.y;
            o.z = v[j].z * rstd * gg.z * (1.f + sc.z) + sh.z; o.w = v[j].w * rstd * gg.w * (1.f + sc.w) + sh.w;
            d[i4] = o;
        }
    }
}

template <class Epi>
__device__ void gemm_naive(const float* A, int lda, const float* Bm, int ldb, int M, int N, int K, float* smem, Epi epi) {
    float* As = smem;
    float* Bs = smem + 16 * 132;
    const int tid = threadIdx.x, ty = tid >> 4, tx = tid & 15;
    const int tilesN = N / 64, ntiles = (M / 128) * tilesN;
    for (int t = blockIdx.x; t < ntiles; t += gridDim.x) {
        const int tm = t / tilesN, tn = t % tilesN, row0 = tm * 128, col0 = tn * 64;
        float acc[4][4];
#pragma unroll
        for (int i = 0; i < 4; ++i)
#pragma unroll
            for (int j = 0; j < 4; ++j) acc[i][j] = 0.f;
        for (int k0 = 0; k0 < K; k0 += 16) {
            {
                const int r = tid >> 2, kk = (tid & 3) * 4;
                const float4 a = *(const float4*)(A + (size_t)(row0 + r) * lda + k0 + kk);
                As[(kk + 0) * 132 + r] = a.x; As[(kk + 1) * 132 + r] = a.y; As[(kk + 2) * 132 + r] = a.z; As[(kk + 3) * 132 + r] = a.w;
            }
            if (tid < 256) {
                const int kk = tid >> 4, cc = (tid & 15) * 4;
                *(float4*)&Bs[kk * 64 + cc] = *(const float4*)(Bm + (size_t)(k0 + kk) * ldb + col0 + cc);
            }
            __syncthreads();
#pragma unroll
            for (int kk = 0; kk < 16; ++kk) {
                const float4 a = *(const float4*)&As[kk * 132 + ty * 4];
                const float4 b = *(const float4*)&Bs[kk * 64 + tx * 4];
                acc[0][0] += a.x * b.x; acc[0][1] += a.x * b.y; acc[0][2] += a.x * b.z; acc[0][3] += a.x * b.w;
                acc[1][0] += a.y * b.x; acc[1][1] += a.y * b.y; acc[1][2] += a.y * b.z; acc[1][3] += a.y * b.w;
                acc[2][0] += a.z * b.x; acc[2][1] += a.z * b.y; acc[2][2] += a.z * b.z; acc[2][3] += a.z * b.w;
                acc[3][0] += a.w * b.x; acc[3][1] += a.w * b.y; acc[3][2] += a.w * b.z; acc[3][3] += a.w * b.w;
            }
            __syncthreads();
        }
#pragma unroll
        for (int i = 0; i < 4; ++i)
#pragma unroll
            for (int j = 0; j < 4; ++j) epi(row0 + ty * 4 + i, col0 + tx * 4 + j, acc[i][j]);
    }
}

struct EpiStore { float* C; int ldc; __device__ void operator()(int r, int c, float v) const { C[(size_t)r * ldc + c] = v; } };
struct EpiGlu { float* gl; const float* zb; const float* bias; __device__ void operator()(int r, int c, float v) const { gl[(size_t)r * 512 + c] = zb[(size_t)r * 512 + c] * sigmoidf_(v + bias[c]); } };
struct EpiBrA { float* merged; const float* px; __device__ void operator()(int r, int c, float v) const { merged[(size_t)r * DM + c] = sigmoidf_(px[(size_t)r * INC + 2048 + c]) * v; } };
struct EpiBrB { float* merged; const float* px; __device__ void operator()(int r, int c, float v) const { merged[(size_t)r * DM + c] += sigmoidf_(px[(size_t)r * INC + 3072 + c]) * v; } };
struct EpiOut { float* x1; const float* x; const float* gate1; __device__ void operator()(int r, int c, float v) const { x1[(size_t)r * DM + c] = x[(size_t)r * DM + c] + gate1[c] * v; } };

__device__ void ph_ssm(const P& p) {
    const int wave = threadIdx.x >> 6, lane = threadIdx.x & 63, nw = blockDim.x >> 6;
    for (int vw = blockIdx.x * nw + wave; vw < 64; vw += gridDim.x * nw) {
        const int g = vw >> 1, dir = vw & 1, pp = lane;
        const int gi = dir * 32 + g;
        const float are = p.a_re[gi * 64 + pp], aim = p.a_im[gi * 64 + pp];
        const float dt = expf(p.log_dt[gi]);
        const float er = expf(are * dt);
        const float lr = er * cosf(aim * dt), li = er * sinf(aim * dt);
        const float nr = lr - 1.f, ni = li, den = are * are + aim * aim;
        const float qr = (nr * are + ni * aim) / den, qi = (ni * are - nr * aim) / den;
        float bbr[16], bbi[16], cr[16], ci[16];
#pragma unroll
        for (int h = 0; h < 16; ++h) {
            const float br = p.b_re[((size_t)gi * 64 + pp) * 16 + h], bi = p.b_im[((size_t)gi * 64 + pp) * 16 + h];
            bbr[h] = qr * br - qi * bi; bbi[h] = qr * bi + qi * br;
            cr[h] = p.c_re[((size_t)gi * 16 + h) * 64 + pp]; ci[h] = p.c_im[((size_t)gi * 16 + h) * 64 + pp];
        }
        float sr = 0.f, si = 0.f;
        for (int j = 0; j < CTXL; ++j) {
            const int jc = dir == 0 ? j : (CTXL - 1 - j);
            const float* u = p.pc + (size_t)jc * CTXC + g * 16;
            float bur = 0.f, bui = 0.f;
#pragma unroll
            for (int h = 0; h < 16; ++h) { const float uh = u[h]; bur += bbr[h] * uh; bui += bbi[h] * uh; }
            const float nsr = lr * sr - li * si + bur, nsi = lr * si + li * sr + bui;
            sr = nsr; si = nsi;
        }
        float* ydst = dir == 0 ? p.yf : p.yr;
        for (int i = 0; i < SEQL; ++i) {
            const int t = dir == 0 ? i : (SEQL - 1 - i);
            const float* u = p.px + (size_t)t * INC + g * 16;
            float bur = 0.f, bui = 0.f;
#pragma unroll
            for (int h = 0; h < 16; ++h) { const float uh = u[h]; bur += bbr[h] * uh; bui += bbi[h] * uh; }
            const float nsr = lr * sr - li * si + bur, nsi = lr * si + li * sr + bui;
            sr = nsr; si = nsi;
            float yo = 0.f;
#pragma unroll
            for (int h = 0; h < 16; ++h) { const float y = wave_sum(cr[h] * sr - ci[h] * si); if (lane == h) yo = y; }
            if (lane < 16) ydst[(size_t)t * 512 + g * 16 + lane] = yo;
        }
    }
}

__device__ void ph_na(const P& p) {
    const int tid = threadIdx.x, hh = tid >> 7, col = (tid >> 1) & 63, half = tid & 1;
    for (int it = blockIdx.x; it < GW * 2; it += gridDim.x) {
        const int r = it >> 1, head = (it & 1) * 4 + hh;
        int r0 = r - 4; r0 = r0 < 0 ? 0 : (r0 > 56 ? 56 : r0);
        int c0 = col - 8; c0 = c0 < 0 ? 0 : (c0 > 48 ? 48 : c0);
        const int tq = r * GW + col;
        const int doff = head * 64 + half * 32;
        float q[32], o[32];
        {
            const float4* qp = (const float4*)(p.px + (size_t)tq * INC + 1536 + doff);
#pragma unroll
            for (int d = 0; d < 8; ++d) { const float4 v = qp[d]; q[4 * d] = v.x; q[4 * d + 1] = v.y; q[4 * d + 2] = v.z; q[4 * d + 3] = v.w; }
        }
#pragma unroll
        for (int d = 0; d < 32; ++d) o[d] = 0.f;
        float m = -INFINITY, l = 0.f;
        for (int kk = 0; kk < 128 + CTXL; ++kk) {
            const float* kp; const float* vp; float bias = 0.f;
            if (kk < 128) {
                const int i = kk >> 4, cc = kk & 15, krow = r0 + i, kcol = c0 + cc;
                const size_t tk = (size_t)(krow * GW + kcol);
                kp = p.px + tk * INC + 512 + doff; vp = p.px + tk * INC + 1024 + doff;
                const int dr = krow - r + 7, dc = kcol - col + 15;
                bias = p.rpb[(head * 15 + dr) * 31 + dc];
            } else {
                const int j = kk - 128;
                kp = p.pc + (size_t)j * CTXC + 512 + doff; vp = p.pc + (size_t)j * CTXC + 1024 + doff;
            }
            float s = 0.f;
#pragma unroll
            for (int d = 0; d < 8; ++d) { const float4 kv = ((const float4*)kp)[d]; s += q[4 * d] * kv.x + q[4 * d + 1] * kv.y + q[4 * d + 2] * kv.z + q[4 * d + 3] * kv.w; }
            s += __shfl_xor(s, 1);
            s = s * 0.125f + bias;
            const float mn = fmaxf(m, s);
            const float corr = __expf(m - mn), pe = __expf(s - mn);
            l = l * corr + pe;
#pragma unroll
            for (int d = 0; d < 8; ++d) {
                const float4 vv = ((const float4*)vp)[d];
                o[4 * d] = o[4 * d] * corr + pe * vv.x; o[4 * d + 1] = o[4 * d + 1] * corr + pe * vv.y;
                o[4 * d + 2] = o[4 * d + 2] * corr + pe * vv.z; o[4 * d + 3] = o[4 * d + 3] * corr + pe * vv.w;
            }
            m = mn;
        }
        const float inv = 1.f / l;
        float4* op = (float4*)(p.na + (size_t)tq * 512 + doff);
#pragma unroll
        for (int d = 0; d < 8; ++d) { float4 v; v.x = o[4 * d] * inv; v.y = o[4 * d + 1] * inv; v.z = o[4 * d + 2] * inv; v.w = o[4 * d + 3] * inv; op[d] = v; }
    }
}

__device__ void ph_z(const P& p) {
    const int gtid = blockIdx.x * blockDim.x + threadIdx.x, gsz = gridDim.x * blockDim.x;
    for (int i = gtid; i < SEQL * 512; i += gsz) {
        const int t = i >> 9, cidx = i & 511;
        const float y = p.ssm_d[cidx] * p.px[(size_t)t * INC + cidx] + p.yf[i] + p.yr[i];
        p.zb[i] = gelu_tanh(y);
    }
}

__device__ void ph_peer(const P& p, int b) {
    const int wave = threadIdx.x >> 6, lane = threadIdx.x & 63, nw = blockDim.x >> 6;
    const float NEG = -INFINITY;
    for (int tt = blockIdx.x * nw + wave; tt < SEQL; tt += gridDim.x * nw) {
        const float* qrow = p.qb + (size_t)tt * 2048;
        const float4* hrow = (const float4*)(p.h2 + (size_t)tt * DM);
        float4 hv[4], acc[4];
#pragma unroll
        for (int j = 0; j < 4; ++j) { hv[j] = hrow[lane + 64 * j]; acc[j] = make_float4(0.f, 0.f, 0.f, 0.f); }
        for (int h = 0; h < 8; ++h) {
            float stop0 = NEG, stop1 = NEG; int itop0 = 0, itop1 = 0;
            for (int n = 0; n < 2; ++n) {
                const float4* qh = (const float4*)(qrow + h * 256 + n * 128);
                const float4* k0 = (const float4*)(p.subkeys + ((size_t)(n * 128 + lane)) * 128);
                const float4* k1 = (const float4*)(p.subkeys + ((size_t)(n * 128 + lane + 64)) * 128);
                float s0 = 0.f, s1 = 0.f;
                for (int d = 0; d < 32; ++d) {
                    const float4 qv = qh[d], a = k0[d], c = k1[d];
                    s0 += qv.x * a.x + qv.y * a.y + qv.z * a.z + qv.w * a.w;
                    s1 += qv.x * c.x + qv.y * c.y + qv.z * c.z + qv.w * c.w;
                }
                float mytop = NEG; int myidx = 0;
                for (int r = 0; r < 16; ++r) {
                    const float lv = fmaxf(s0, s1);
                    const float mx = wave_max(lv);
                    const unsigned long long bal = __ballot(lv == mx);
                    const int owner = __ffsll((long long)bal) - 1;
                    const int li = (s0 >= s1) ? lane : lane + 64;
                    const int idx = __shfl(li, owner);
                    if (lane == r) { mytop = mx; myidx = idx; }
                    if (lane == owner) { if (s0 >= s1) s0 = NEG; else s1 = NEG; }
                }
                if (n == 0) { stop0 = mytop; itop0 = myidx; } else { stop1 = mytop; itop1 = myidx; }
            }
            float cv0, cv1, cv2, cv3; int ce0, ce1, ce2, ce3;
            {
                const int jj = lane & 15, ib = lane >> 4;
                const float sj = __shfl(stop1, jj); const int ij = __shfl(itop1, jj);
                cv0 = __shfl(stop0, ib) + sj;      ce0 = __shfl(itop0, ib) * 128 + ij;
                cv1 = __shfl(stop0, ib + 4) + sj;  ce1 = __shfl(itop0, ib + 4) * 128 + ij;
                cv2 = __shfl(stop0, ib + 8) + sj;  ce2 = __shfl(itop0, ib + 8) * 128 + ij;
                cv3 = __shfl(stop0, ib + 12) + sj; ce3 = __shfl(itop0, ib + 12) * 128 + ij;
            }
            float best = NEG; int expert = 0;
            for (int r = 0; r < 16; ++r) {
                const float lv = fmaxf(fmaxf(cv0, cv1), fmaxf(cv2, cv3));
                const float mx = wave_max(lv);
                const unsigned long long bal = __ballot(lv == mx);
                const int owner = __ffsll((long long)bal) - 1;
                const int wm = (cv0 == lv) ? 0 : ((cv1 == lv) ? 1 : ((cv2 == lv) ? 2 : 3));
                const int le = wm == 0 ? ce0 : (wm == 1 ? ce1 : (wm == 2 ? ce2 : ce3));
                const int eid = __shfl(le, owner);
                if (lane == r) { best = mx; expert = eid; }
                if (lane == owner) { if (wm == 0) cv0 = NEG; else if (wm == 1) cv1 = NEG; else if (wm == 2) cv2 = NEG; else cv3 = NEG; }
            }
            const float m16 = wave_max(lane < 16 ? best : NEG);
            const float ex = lane < 16 ? __expf(best - m16) : 0.f;
            const float gsum = wave_sum(ex);
            const float gate = ex / gsum;
            for (int k = 0; k < 16; ++k) {
                const int e = __shfl(expert, k);
                const float gk = __shfl(gate, k);
                const float4* ur = (const float4*)(p.peer_u + (size_t)e * DM);
                const float4* vr = (const float4*)(p.peer_v + (size_t)e * DM);
                float part = 0.f;
#pragma unroll
                for (int j = 0; j < 4; ++j) { const float4 uu = ur[lane + 64 * j]; part += hv[j].x * uu.x + hv[j].y * uu.y + hv[j].z * uu.z + hv[j].w * uu.w; }
                const float a = wave_sum(part);
                const float w = gk * gelu_tanh(a);
#pragma unroll
                for (int j = 0; j < 4; ++j) { const float4 vv = vr[lane + 64 * j]; acc[j].x += w * vv.x; acc[j].y += w * vv.y; acc[j].z += w * vv.z; acc[j].w += w * vv.w; }
            }
        }
        float4* orow = (float4*)(p.out + ((size_t)b * SEQL + tt) * DM);
        const float4* g2 = (const float4*)(p.mod + (size_t)b * (6 * DM) + 5 * DM);
        float4 x2[4]; float ss = 0.f;
#pragma unroll
        for (int j = 0; j < 4; ++j) {
            const float4 x1 = orow[lane + 64 * j], gg = g2[lane + 64 * j];
            x2[j].x = x1.x + gg.x * acc[j].x; x2[j].y = x1.y + gg.y * acc[j].y; x2[j].z = x1.z + gg.z * acc[j].z; x2[j].w = x1.w + gg.w * acc[j].w;
            ss += x2[j].x * x2[j].x + x2[j].y * x2[j].y + x2[j].z * x2[j].z + x2[j].w * x2[j].w;
        }
        ss = wave_sum(ss);
        const float rstd = rsqrtf(ss * (1.f / DM) + EPSN);
#pragma unroll
        for (int j = 0; j < 4; ++j) {
            const float4 fg = ((const float4*)p.final_g)[lane + 64 * j];
            float4 o; o.x = x2[j].x * rstd * fg.x; o.y = x2[j].y * rstd * fg.y; o.z = x2[j].z * rstd * fg.z; o.w = x2[j].w * rstd * fg.w;
            orow[lane + 64 * j] = o;
        }
    }
}

constexpr int NPH = 13;
template <int ph>
__device__ __forceinline__ void run_phase(const P& p, int b, float* smem) {
    const float* modb = p.mod + (size_t)b * (6 * DM);
    float* x1 = p.out + (size_t)b * SEQL * DM;
    if constexpr (ph == 0) { if (b == 0) ph_adaln(p); }
    if constexpr (ph == 1) {
        normmod_rows(p.x + (size_t)b * SEQL * DM, p.hx, SEQL, p.norm1_g, modb, modb + DM);
        normmod_rows(p.ctx + (size_t)b * CTXL * DM, p.hc, CTXL, p.norm1_g, p.mod + 8 * (6 * DM), p.mod + 8 * (6 * DM) + DM);
    }
    if constexpr (ph == 2) {
        gemm_naive(p.hx, DM, p.w_in, INC, SEQL, INC, DM, smem, EpiStore{p.px, INC});
        gemm_naive(p.hc, DM, p.w_in, INC, CTXL, CTXC, DM, smem, EpiStore{p.pc, CTXC});
    }
    if constexpr (ph == 3) ph_ssm(p);
    if constexpr (ph == 4) ph_na(p);
    if constexpr (ph == 5) ph_z(p);
    if constexpr (ph == 6) gemm_naive(p.zb, 512, p.w_glu, 512, SEQL, 512, 512, smem, EpiGlu{p.gl, p.zb, p.b_glu});
    if constexpr (ph == 7) gemm_naive(p.gl, 512, p.w_a, DM, SEQL, DM, 512, smem, EpiBrA{p.merged, p.px});
    if constexpr (ph == 8) gemm_naive(p.na, 512, p.w_b, DM, SEQL, DM, 512, smem, EpiBrB{p.merged, p.px});
    if constexpr (ph == 9) gemm_naive(p.merged, DM, p.w_out, DM, SEQL, DM, DM, smem, EpiOut{x1, p.x + (size_t)b * SEQL * DM, modb + 2 * DM});
    if constexpr (ph == 10) normmod_rows(x1, p.h2, SEQL, p.norm2_g, modb + 3 * DM, modb + 4 * DM);
    if constexpr (ph == 11) gemm_naive(p.h2, DM, p.w_q, 2048, SEQL, 2048, DM, smem, EpiStore{p.qb, 2048});
    if constexpr (ph == 12) ph_peer(p, b);
}

template <int PH, int HI>
__device__ __forceinline__ void run_range(const P& p, int b, float* smem, int coop) {
    if constexpr (PH < HI) {
        run_phase<PH>(p, b, smem);
#if MODE_COOP
        if (coop) cg::this_grid().sync();
#endif
        run_range<PH + 1, HI>(p, b, smem, coop);
    }
}

template <int LO, int HI>
__global__ void __launch_bounds__(NT) mega(P p, int b_lo, int b_hi, int coop) {
    __shared__ __attribute__((aligned(16))) float smem[16 * 132 + 16 * 64];
    for (int b = b_lo; b < b_hi; ++b) {
        asm volatile("" : "+s"(b));
        run_range<LO, HI>(p, b, smem, coop);
    }
}

template <int PH>
static void launch_one(const P& p, int b, int grid, hipStream_t stream) {
    hipLaunchKernelGGL((mega<PH, PH + 1>), dim3(grid), dim3(NT), 0, stream, p, b, b + 1, 0);
}
template <int PH>
static void launch_all(const P& p, int b, int grid, hipStream_t stream) {
    if constexpr (PH < NPH) { if (PH > 0 || b == 0) launch_one<PH>(p, b, grid, stream); launch_all<PH + 1>(p, b, grid, stream); }
}

extern "C" void kernel_launch(void* const* d_in, const int* in_sizes, int n_in, void* d_out, int out_size, void* d_ws, size_t ws_size, hipStream_t stream) {
    static int grid = 0;
    if (grid == 0) {
        int dev = 0, cus = 0, per_cu = 0;
        hipGetDevice(&dev);
        hipDeviceGetAttribute(&cus, hipDeviceAttributeMultiprocessorCount, dev);
#if MODE_COOP
        hipOccupancyMaxActiveBlocksPerMultiprocessor(&per_cu, (const void*)mega<0, NPH>, NT, 0);
#else
        per_cu = 2;
#endif
        if (per_cu < 1) per_cu = 1;
        if (per_cu > 2) per_cu = 2;
        grid = cus * per_cu;
    }
    P p{};
    const float* const* in = (const float* const*)d_in;
    p.x = in[0]; p.c = in[1]; p.ctx = in[2]; p.c_ctx = in[3]; p.w_mod = in[4]; p.b_mod = in[5]; p.norm1_g = in[6]; p.norm2_g = in[7]; p.w_in = in[8];
    p.a_re = in[9]; p.a_im = in[10]; p.log_dt = in[11]; p.b_re = in[12]; p.b_im = in[13]; p.c_re = in[14]; p.c_im = in[15]; p.ssm_d = in[16];
    p.w_glu = in[17]; p.b_glu = in[18]; p.w_a = in[19]; p.w_b = in[20]; p.rpb = in[21]; p.w_out = in[22]; p.w_q = in[23]; p.subkeys = in[24];
    p.peer_u = in[25]; p.peer_v = in[26]; p.final_g = in[27];
    p.out = (float*)d_out;
    float* w = (float*)d_ws; size_t off = 0;
    auto take = [&](size_t n) { float* r = w + off; off += (n + 63) & ~(size_t)63; return r; };
    p.mod = take(9 * 6 * DM); p.hx = take((size_t)SEQL * DM); p.hc = take((size_t)CTXL * DM); p.px = take((size_t)SEQL * INC); p.pc = take((size_t)CTXL * CTXC);
    p.yf = take((size_t)SEQL * 512); p.yr = take((size_t)SEQL * 512); p.zb = take((size_t)SEQL * 512); p.gl = take((size_t)SEQL * 512); p.na = take((size_t)SEQL * 512);
    p.merged = take((size_t)SEQL * DM); p.h2 = take((size_t)SEQL * DM); p.qb = take((size_t)SEQL * 2048);
#if MODE_COOP
    int b_lo = 0, b_hi = NB, coop = 1;
    void* args[] = {&p, &b_lo, &b_hi, &coop};
    hipError_t e = hipLaunchCooperativeKernel((const void*)mega<0, NPH>, dim3(grid), dim3(NT), args, 0, stream);
    if (e != hipSuccess) fprintf(stderr, "cooperative launch failed: %s (grid %d)\n", hipGetErrorString(e), grid);
#else
    for (int b = 0; b < NB; ++b) launch_all<0>(p, b, grid, stream);
#endif
}
```

```cpp
#include <hip/hip_runtime.h>
#include <hip/hip_cooperative_groups.h>
#include <cstdio>
#include <cstdint>
namespace cg = cooperative_groups;

#define LAS __attribute__((address_space(3)))
typedef unsigned short bf16_t;
typedef short bf16x8 __attribute__((ext_vector_type(8)));
typedef float f32x4 __attribute__((ext_vector_type(4)));
typedef float f32x2 __attribute__((ext_vector_type(2)));
typedef unsigned u32x4 __attribute__((ext_vector_type(4)));
typedef unsigned u32x2 __attribute__((ext_vector_type(2)));

constexpr int DM = 1024, NB = 8, SEQL = 4096, CTXL = 256, GW = 64, NTOK = NB * SEQL, NCTX = NB * CTXL;
constexpr int INC = 4096, CTXC = 1536;
constexpr int NT = 512, NWAVES = 8;
constexpr float EPSN = 1e-6f;
constexpr int SSM_ROWS = 1280;
constexpr int SSM_LD = 768;

__device__ __forceinline__ unsigned f2bf(float f) { unsigned u = __builtin_bit_cast(unsigned, f); return (u + 0x7fffu + ((u >> 16) & 1u)) >> 16; }
__device__ __forceinline__ unsigned pk2(float lo, float hi) { return f2bf(lo) | (f2bf(hi) << 16); }
__device__ __forceinline__ float bflo(unsigned w) { return __builtin_bit_cast(float, w << 16); }
__device__ __forceinline__ float bfhi(unsigned w) { return __builtin_bit_cast(float, w & 0xffff0000u); }
__device__ __forceinline__ float bf2f(bf16_t h) { return __builtin_bit_cast(float, (unsigned)h << 16); }

__device__ __forceinline__ float wave_sum(float v) {
#pragma unroll
    for (int o = 1; o < 64; o <<= 1) v += __shfl_xor(v, o);
    return v;
}
__device__ __forceinline__ float wave_max(float v) {
#pragma unroll
    for (int o = 1; o < 64; o <<= 1) v = fmaxf(v, __shfl_xor(v, o));
    return v;
}
__device__ __forceinline__ float sigmoidf_(float x) { return 1.f / (1.f + __expf(-x)); }
__device__ __forceinline__ float siluf_(float x) { return x / (1.f + __expf(-x)); }
__device__ __forceinline__ float gelu_tanh(float x) {
    const float k0 = 0.7978845608028654f, k1 = 0.044715f;
    const float u = k0 * (x + k1 * x * x * x);
    const float t = 1.f - 2.f / (1.f + __expf(2.f * u));
    return 0.5f * x * (1.f + t);
}

namespace pg8 {
#define PG8_LAS __attribute__((address_space(3)))
constexpr int BM = 256, BK = 64, HALF = 128, HTB = HALF * BK * 2  , STAGE_BYTES = 8 * HTB, NXCD = 8, WGM = 8;
__host__ __device__ __forceinline__ int lds_byte(int r, int c) { const int st = (r >> 4) * 2 + (c >> 5), rr = r & 15, cc = c & 31, ob = rr * 64 + cc * 2; return st * 1024 + (ob ^ (((ob >> 9) & 1) << 5)); }
__host__ __device__ __forceinline__ void stage_rc(int b, int& R, int& C) { const int st = b / 1024, sb = b % 1024, swz = sb ^ (((sb >> 9) & 1) << 5); R = (st >> 1) * 16 + swz / 64; C = (st & 1) * 32 + (swz % 64) / 2; }
__host__ __device__ __forceinline__ int perm32(int rho) { const int n = rho >> 4, i = rho & 15; return 8 * (i >> 2) + 4 * n + (i & 3); }

struct Unit { int pm, pn, g; };
struct Gemm {
    const bf16_t* A; const bf16_t* Bt; int K, lda, ldb; size_t gsa, gsb;
    __device__ __forceinline__ const char* abase(const Unit& u) const { return (const char*)(A + (size_t)u.g * gsa + (size_t)u.pm * BM * lda); }
    __device__ __forceinline__ const char* bbase(const Unit& u) const { return (const char*)(Bt + (size_t)u.g * gsb + (size_t)u.pn * BM * ldb); }
};
struct StaticOrder {
    int nM, nN, nwg, G, c, ngrp;
    __device__ void init(int M, int N, int G_, int c_, int ngrp_ = 1) { nM = M / BM; nN = N / BM; nwg = nM * nN; G = G_; c = c_; ngrp = ngrp_; }
    __device__ bool next(int i, Unit& u) const {
        const long L = (long)i * G + c; if (L >= (long)nwg * ngrp) return false;
        u.g = (int)(L / nwg);
        int wgid = (int)(L % nwg); { const int q = nwg / NXCD, r = nwg % NXCD, xcd = wgid % NXCD, off = wgid / NXCD; wgid = (xcd < r ? xcd * (q + 1) : r * (q + 1) + (xcd - r) * q) + off; }
        const int nig = WGM * nN, gid = wgid / nig, fm = gid * WGM, gsz = (nM - fm) < WGM ? (nM - fm) : WGM;
        u.pm = fm + ((wgid % nig) % gsz); u.pn = (wgid % nig) / gsz; return true;
    }
    __device__ __forceinline__ void a_ready(const Unit&) const {}
    __device__ __forceinline__ void done(const Unit&) const {}
};
__device__ __forceinline__ unsigned cvt_pk_bf16(float lo, float hi) { unsigned r; asm volatile("v_cvt_pk_bf16_f32 %0, %1, %2" : "=v"(r) : "v"(lo), "v"(hi)); return r; }
template <class Epi, class Sched, bool ALIGN_EPI = false, bool SP2 = false>
__device__ __forceinline__ void gemm_phase(PG8_LAS unsigned char* lds, const Gemm g, const Sched& S, const Epi& E) {
    const int tid = threadIdx.x, wid = __builtin_amdgcn_readfirstlane(tid >> 6), lane = tid & 63, wr = wid >> 2, wc = wid & 3, fr = lane & 15, fq = lane >> 4;
    const int K = g.K, nt = K / BK;
    unsigned voffA[2], voffB[2];
#pragma unroll
    for (int i = 0; i < 2; ++i) { int R, C; stage_rc(tid * 16 + i * 8192, R, C); const int Rb = Epi::PERM ? ((R & ~31) + perm32(R & 31)) : R;
        voffA[i] = (unsigned)(R * g.lda + C) * 2u; voffB[i] = (unsigned)(Rb * g.ldb + C) * 2u; }
    const size_t kstep = (size_t)(BK * 2);
    const size_t hstepA = (size_t)HALF * g.lda * 2, hstepB = (size_t)HALF * g.ldb * 2;
    const unsigned ldsw = (unsigned)wid * 1024u;
    const int aoff = lds_byte(wr * 64 + fr, fq * 8), boff = lds_byte(wc * 32 + fr, fq * 8);
#define PG8_SA(b, h) (((b) * 2 + (h)) * HTB)
#define PG8_SB(b, h) ((4 + (b) * 2 + (h)) * HTB)
#define PG8_STAGE(bufoff, gbase, voff) do { _Pragma("unroll") for (int _i = 0; _i < 2; ++_i) \
        __builtin_amdgcn_global_load_lds((const unsigned*)((const char*)(gbase) + (voff)[_i]), (PG8_LAS unsigned*)(lds + (bufoff) + ldsw + _i * 8192), 16, 0, 0); } while (0)
#define PG8_LDA(dst, b, h) do { _Pragma("unroll") for (int m = 0; m < 4; ++m) _Pragma("unroll") for (int k = 0; k < 2; ++k) dst[m][k] = *(const PG8_LAS bf16x8*)(lds + PG8_SA(b, h) + aoff + m * 2048 + k * 1024); } while (0)
#define PG8_LDB(dst, b, h) do { _Pragma("unroll") for (int n = 0; n < 2; ++n) _Pragma("unroll") for (int k = 0; k < 2; ++k) dst[n][k] = *(const PG8_LAS bf16x8*)(lds + PG8_SB(b, h) + boff + n * 2048 + k * 1024); } while (0)
#define PG8_MMA(ai, bj, At, Bt) do { __builtin_amdgcn_s_setprio(1); _Pragma("unroll") for (int m = 0; m < 4; ++m) _Pragma("unroll") for (int n = 0; n < 2; ++n) _Pragma("unroll") for (int k = 0; k < 2; ++k) \
        acc[ai][bj][m][n] = __builtin_amdgcn_mfma_f32_16x16x32_bf16(Bt[n][k], At[m][k], acc[ai][bj][m][n], 0, 0, 0); __builtin_amdgcn_s_setprio(0); } while (0)
#define PG8_WAIT_V(n) asm volatile("s_waitcnt vmcnt(" #n ")" ::: "memory")
#define PG8_WAIT_L(n) asm volatile("s_waitcnt lgkmcnt(" #n ")" ::: "memory")
#define PG8_BAR __builtin_amdgcn_s_barrier()
#define PG8_SCHED __builtin_amdgcn_sched_barrier(0)
    Unit cur, nxt; int ui = 0;
    if (!S.next(0, cur)) return;
    f32x4 acc[2][2][4][2];
#pragma unroll
    for (int a = 0; a < 2; ++a)
#pragma unroll
        for (int b = 0; b < 2; ++b)
#pragma unroll
            for (int m = 0; m < 4; ++m)
#pragma unroll
                for (int n = 0; n < 2; ++n) acc[a][b][m][n] = (f32x4){0.f, 0.f, 0.f, 0.f};
    bf16x8 At[4][2], B0[2][2], B1[2][2];
    const char* cA = g.abase(cur); const char* cB = g.bbase(cur);
    S.a_ready(cur);
    if constexpr (SP2) {
        PG8_STAGE(PG8_SB(0, 0), cB, voffB); PG8_STAGE(PG8_SB(0, 1), cB + hstepB, voffB); PG8_STAGE(PG8_SA(0, 0), cA, voffA); PG8_STAGE(PG8_SA(0, 1), cA + hstepA, voffA);
        if (wr == 1) PG8_BAR;
        PG8_WAIT_V(2); PG8_BAR;
        PG8_STAGE(PG8_SB(1, 0), cB + kstep, voffB); PG8_STAGE(PG8_SA(1, 0), cA + kstep, voffA); PG8_STAGE(PG8_SB(1, 1), cB + hstepB + kstep, voffB);
        PG8_WAIT_V(6); PG8_BAR;
    } else {
        PG8_STAGE(PG8_SB(0, 0), cB, voffB); PG8_STAGE(PG8_SA(0, 0), cA, voffA); PG8_STAGE(PG8_SB(0, 1), cB + hstepB, voffB); PG8_STAGE(PG8_SA(0, 1), cA + hstepA, voffA);
        if (wr == 1) PG8_BAR;
        PG8_WAIT_V(4); PG8_BAR;
        PG8_STAGE(PG8_SB(1, 0), cB + kstep, voffB); PG8_STAGE(PG8_SA(1, 0), cA + kstep, voffA); PG8_STAGE(PG8_SB(1, 1), cB + hstepB + kstep, voffB);
        PG8_WAIT_V(6); PG8_BAR;
    }
    for (;;) {
        const bool has_next = S.next(ui + 1, nxt);
        const char* nA = has_next ? g.abase(nxt) : cA; const char* nB = has_next ? g.bbase(nxt) : cB;
        for (int t = 0; t < nt; t += 2) {
            const bool last = (t == nt - 2);
            const char* a1 = cA + (size_t)(t + 1) * kstep;
            const char* a2 = last ? nA : cA + (size_t)(t + 2) * kstep; const char* b2 = last ? nB : cB + (size_t)(t + 2) * kstep;
            const char* a3 = a2 + kstep; const char* b3 = b2 + kstep;
            if (last && has_next) S.a_ready(nxt);
            if constexpr (SP2) {
            PG8_LDB(B0, 0, 0); PG8_LDB(B1, 0, 1); PG8_SCHED; PG8_LDA(At, 0, 0); PG8_STAGE(PG8_SA(1, 1), a1 + hstepA, voffA);
            PG8_WAIT_V(8); PG8_WAIT_L(0); PG8_BAR; PG8_MMA(0, 0, At, B0); PG8_MMA(0, 1, At, B1); PG8_BAR; PG8_SCHED;
            PG8_LDA(At, 0, 1); PG8_STAGE(PG8_SB(0, 0), b2, voffB); PG8_STAGE(PG8_SB(0, 1), b2 + hstepB, voffB); PG8_STAGE(PG8_SA(0, 0), a2, voffA);
            PG8_WAIT_V(8); PG8_WAIT_L(0); PG8_BAR; PG8_MMA(1, 0, At, B0); PG8_MMA(1, 1, At, B1); PG8_BAR; PG8_SCHED;
            PG8_LDB(B0, 1, 0); PG8_LDB(B1, 1, 1); PG8_SCHED; PG8_LDA(At, 1, 0); PG8_STAGE(PG8_SA(0, 1), a2 + hstepA, voffA);
            PG8_WAIT_V(8); PG8_WAIT_L(0); PG8_BAR; PG8_MMA(0, 0, At, B0); PG8_MMA(0, 1, At, B1); PG8_BAR; PG8_SCHED;
            PG8_LDA(At, 1, 1); PG8_STAGE(PG8_SB(1, 0), b3, voffB); PG8_STAGE(PG8_SB(1, 1), b3 + hstepB, voffB); PG8_STAGE(PG8_SA(1, 0), a3, voffA);
            PG8_WAIT_V(8); PG8_WAIT_L(0); PG8_BAR; PG8_MMA(1, 0, At, B0); PG8_MMA(1, 1, At, B1); PG8_BAR; PG8_SCHED;
            } else {
            PG8_LDB(B0, 0, 0); PG8_SCHED; PG8_LDA(At, 0, 0); PG8_STAGE(PG8_SA(1, 1), a1 + hstepA, voffA);
            PG8_WAIT_L(8); PG8_BAR; PG8_WAIT_L(0); PG8_MMA(0, 0, At, B0); PG8_BAR; PG8_SCHED;
            PG8_LDB(B1, 0, 1); PG8_STAGE(PG8_SB(0, 0), b2, voffB);
            PG8_BAR; PG8_WAIT_L(0); PG8_MMA(0, 1, At, B1); PG8_BAR;
            PG8_LDA(At, 0, 1); PG8_STAGE(PG8_SA(0, 0), a2, voffA);
            PG8_BAR; PG8_WAIT_L(0); PG8_MMA(1, 0, At, B0); PG8_BAR; PG8_SCHED;
            PG8_STAGE(PG8_SB(0, 1), b2 + hstepB, voffB);
            PG8_WAIT_V(6); PG8_BAR; PG8_MMA(1, 1, At, B1); PG8_BAR;
            PG8_LDB(B0, 1, 0); PG8_SCHED; PG8_LDA(At, 1, 0); PG8_STAGE(PG8_SA(0, 1), a2 + hstepA, voffA);
            PG8_WAIT_L(8); PG8_BAR; PG8_WAIT_L(0); PG8_MMA(0, 0, At, B0); PG8_BAR; PG8_SCHED;
            PG8_LDB(B1, 1, 1); PG8_STAGE(PG8_SB(1, 0), b3, voffB);
            PG8_BAR; PG8_WAIT_L(0); PG8_MMA(0, 1, At, B1); PG8_BAR;
            PG8_LDA(At, 1, 1); PG8_STAGE(PG8_SA(1, 0), a3, voffA);
            PG8_BAR; PG8_WAIT_L(0); PG8_MMA(1, 0, At, B0); PG8_BAR; PG8_SCHED;
            PG8_STAGE(PG8_SB(1, 1), b3 + hstepB, voffB);
            PG8_WAIT_V(6); PG8_BAR; PG8_MMA(1, 1, At, B1); PG8_BAR;
            }
        }
        if constexpr (ALIGN_EPI) { if (wr == 0) PG8_BAR; }
        if constexpr (!Epi::AFTER_DRAIN) { E(acc, cur, wr, wc, fr, fq); S.done(cur); }
        if (!has_next) break;
#pragma unroll
        for (int a = 0; a < 2; ++a)
#pragma unroll
            for (int b = 0; b < 2; ++b)
#pragma unroll
                for (int m = 0; m < 4; ++m)
#pragma unroll
                    for (int n = 0; n < 2; ++n) acc[a][b][m][n] = (f32x4){0.f, 0.f, 0.f, 0.f};
        cur = nxt; cA = nA; cB = nB; ++ui;
        if constexpr (ALIGN_EPI) { if (wr == 1) PG8_BAR; }
    }
    PG8_WAIT_V(0);
    if constexpr (!ALIGN_EPI) { if (wr == 0) PG8_BAR; }
    PG8_BAR;
    if constexpr (Epi::AFTER_DRAIN) { E.fused(acc, cur, wr, wc, fr, fq, lds, wid, lane); S.done(cur); }
#undef PG8_SA
#undef PG8_SB
#undef PG8_STAGE
#undef PG8_LDA
#undef PG8_LDB
#undef PG8_MMA
#undef PG8_WAIT_V
#undef PG8_WAIT_L
#undef PG8_BAR
#undef PG8_SCHED
}
}

struct P {
    const float *x, *c, *ctx, *c_ctx, *w_mod, *b_mod, *norm1_g, *norm2_g, *w_in;
    const float *a_re, *a_im, *log_dt, *b_re, *b_im, *c_re, *c_im, *ssm_d;
    const float *w_glu, *b_glu, *w_a, *w_b, *rpb, *w_out, *w_q, *subkeys, *peer_u, *peer_v, *final_g;
    float* out;
    float *mod, *c2, *rowss;
    bf16_t *w_in_t, *w_glu_t, *w_a_t, *w_b_t, *w_out_t, *w_q_t;
    bf16_t *pu, *pv;
    bf16_t *hx, *hc;
    bf16_t *U, *kb, *vb, *qb, *kc, *vc, *ga, *gb;
    float *yf, *yr;
    bf16_t *z, *gl, *na, *merged, *x1g, *qp;
    float *tbuf;
};

namespace pg8 {
struct EpiInProj {
    static constexpr bool PERM = true, AFTER_DRAIN = false;
    bf16_t* U; bf16_t* d_kvq; size_t kvq_stride; bf16_t* d_gate; int is_ctx;
    __device__ __forceinline__ void operator()(const f32x4 (&acc)[2][2][4][2], const Unit& u, int wr, int wc, int fr, int fq) const {
        if (u.pn < 2) {
#pragma unroll
            for (int ai = 0; ai < 2; ++ai)
#pragma unroll
                for (int m = 0; m < 4; ++m) {
                    const int row = u.pm * BM + ai * HALF + wr * 64 + m * 16 + fr;
                    const int n = is_ctx ? (1024 + (row >> 8) * 8 + ((row & 255) >> 5)) : ((row >> 12) * 128 + ((row & 4095) >> 5));
                    const int jj = row & 31;
#pragma unroll
                    for (int bj = 0; bj < 2; ++bj) {
                        const int col = u.pn * BM + bj * HALF + wc * 32 + 8 * fq;
                        const f32x4 v0 = acc[ai][bj][m][0], v1 = acc[ai][bj][m][1];
                        u32x4 w; w.x = cvt_pk_bf16(v0[0], v0[1]); w.y = cvt_pk_bf16(v0[2], v0[3]); w.z = cvt_pk_bf16(v1[0], v1[1]); w.w = cvt_pk_bf16(v1[2], v1[3]);
                        *(u32x4*)(U + ((size_t)((col >> 4) * SSM_ROWS + n) * SSM_LD + jj * 16 + (col & 15))) = w;
                    }
                    asm volatile("" ::: "memory");
                }
        } else {
            bf16_t* base; int ld, c0;
            if (u.pn < 8) { const int which = (u.pn - 2) >> 1; base = d_kvq + (size_t)which * kvq_stride; ld = 512; c0 = 512 + which * 512; }
            else { const int which = (u.pn - 8) >> 2; base = d_gate + (size_t)which * ((size_t)NTOK * DM); ld = DM; c0 = 2048 + which * 1024; }
#pragma unroll
            for (int ai = 0; ai < 2; ++ai)
#pragma unroll
                for (int m = 0; m < 4; ++m) {
                    const int row = u.pm * BM + ai * HALF + wr * 64 + m * 16 + fr;
#pragma unroll
                    for (int bj = 0; bj < 2; ++bj) {
                        const int col = u.pn * BM + bj * HALF + wc * 32 + 8 * fq - c0;
                        const f32x4 v0 = acc[ai][bj][m][0], v1 = acc[ai][bj][m][1];
                        u32x4 w; w.x = cvt_pk_bf16(v0[0], v0[1]); w.y = cvt_pk_bf16(v0[2], v0[3]); w.z = cvt_pk_bf16(v1[0], v1[1]); w.w = cvt_pk_bf16(v1[2], v1[3]);
                        *(u32x4*)(base + (size_t)row * ld + col) = w;
                    }
                    asm volatile("" ::: "memory");
                }
        }
    }
};
struct EpiGlu {
    static constexpr bool PERM = true, AFTER_DRAIN = false;
    bf16_t* gl; const bf16_t* z; const float* bias;
    __device__ __forceinline__ void operator()(const f32x4 (&acc)[2][2][4][2], const Unit& u, int wr, int wc, int fr, int fq) const {
#pragma unroll
        for (int ai = 0; ai < 2; ++ai)
#pragma unroll
            for (int m = 0; m < 4; ++m) {
                const int row = u.pm * BM + ai * HALF + wr * 64 + m * 16 + fr;
#pragma unroll
                for (int bj = 0; bj < 2; ++bj) {
                    const int col = u.pn * BM + bj * HALF + wc * 32 + 8 * fq;
                    const f32x4 v0 = acc[ai][bj][m][0], v1 = acc[ai][bj][m][1];
                    const f32x4 b0 = *(const f32x4*)(bias + col), b1 = *(const f32x4*)(bias + col + 4);
                    const u32x4 zz = *(const u32x4*)(z + (size_t)row * 512 + col);
                    float o[8];
                    o[0] = bflo(zz.x) * sigmoidf_(v0[0] + b0[0]); o[1] = bfhi(zz.x) * sigmoidf_(v0[1] + b0[1]);
                    o[2] = bflo(zz.y) * sigmoidf_(v0[2] + b0[2]); o[3] = bfhi(zz.y) * sigmoidf_(v0[3] + b0[3]);
                    o[4] = bflo(zz.z) * sigmoidf_(v1[0] + b1[0]); o[5] = bfhi(zz.z) * sigmoidf_(v1[1] + b1[1]);
                    o[6] = bflo(zz.w) * sigmoidf_(v1[2] + b1[2]); o[7] = bfhi(zz.w) * sigmoidf_(v1[3] + b1[3]);
                    u32x4 w; w.x = cvt_pk_bf16(o[0], o[1]); w.y = cvt_pk_bf16(o[2], o[3]); w.z = cvt_pk_bf16(o[4], o[5]); w.w = cvt_pk_bf16(o[6], o[7]);
                    *(u32x4*)(gl + (size_t)row * 512 + col) = w;
                }
            }
    }
};
struct EpiBrA {
    static constexpr bool PERM = true, AFTER_DRAIN = false;
    float* t; const bf16_t* ga;
    __device__ __forceinline__ void operator()(const f32x4 (&acc)[2][2][4][2], const Unit& u, int wr, int wc, int fr, int fq) const {
#pragma unroll
        for (int ai = 0; ai < 2; ++ai)
#pragma unroll
            for (int m = 0; m < 4; ++m) {
                const int row = u.pm * BM + ai * HALF + wr * 64 + m * 16 + fr;
#pragma unroll
                for (int bj = 0; bj < 2; ++bj) {
                    const int col = u.pn * BM + bj * HALF + wc * 32 + 8 * fq;
                    const f32x4 v0 = acc[ai][bj][m][0], v1 = acc[ai][bj][m][1];
                    const u32x4 gg = *(const u32x4*)(ga + (size_t)row * DM + col);
                    f32x4 o0, o1;
                    o0[0] = sigmoidf_(bflo(gg.x)) * v0[0]; o0[1] = sigmoidf_(bfhi(gg.x)) * v0[1]; o0[2] = sigmoidf_(bflo(gg.y)) * v0[2]; o0[3] = sigmoidf_(bfhi(gg.y)) * v0[3];
                    o1[0] = sigmoidf_(bflo(gg.z)) * v1[0]; o1[1] = sigmoidf_(bfhi(gg.z)) * v1[1]; o1[2] = sigmoidf_(bflo(gg.w)) * v1[2]; o1[3] = sigmoidf_(bfhi(gg.w)) * v1[3];
                    *(f32x4*)(t + (size_t)row * DM + col) = o0; *(f32x4*)(t + (size_t)row * DM + col + 4) = o1;
                }
            }
    }
};
struct EpiBrB {
    static constexpr bool PERM = true, AFTER_DRAIN = false;
    bf16_t* merged; const float* t; const bf16_t* gb;
    __device__ __forceinline__ void operator()(const f32x4 (&acc)[2][2][4][2], const Unit& u, int wr, int wc, int fr, int fq) const {
#pragma unroll
        for (int ai = 0; ai < 2; ++ai)
#pragma unroll
            for (int m = 0; m < 4; ++m) {
                const int row = u.pm * BM + ai * HALF + wr * 64 + m * 16 + fr;
#pragma unroll
                for (int bj = 0; bj < 2; ++bj) {
                    const int col = u.pn * BM + bj * HALF + wc * 32 + 8 * fq;
                    const f32x4 v0 = acc[ai][bj][m][0], v1 = acc[ai][bj][m][1];
                    const u32x4 gg = *(const u32x4*)(gb + (size_t)row * DM + col);
                    const f32x4 t0 = *(const f32x4*)(t + (size_t)row * DM + col), t1 = *(const f32x4*)(t + (size_t)row * DM + col + 4);
                    float o[8];
                    o[0] = t0[0] + sigmoidf_(bflo(gg.x)) * v0[0]; o[1] = t0[1] + sigmoidf_(bfhi(gg.x)) * v0[1]; o[2] = t0[2] + sigmoidf_(bflo(gg.y)) * v0[2]; o[3] = t0[3] + sigmoidf_(bfhi(gg.y)) * v0[3];
                    o[4] = t1[0] + sigmoidf_(bflo(gg.z)) * v1[0]; o[5] = t1[1] + sigmoidf_(bfhi(gg.z)) * v1[1]; o[6] = t1[2] + sigmoidf_(bflo(gg.w)) * v1[2]; o[7] = t1[3] + sigmoidf_(bfhi(gg.w)) * v1[3];
                    u32x4 w; w.x = cvt_pk_bf16(o[0], o[1]); w.y = cvt_pk_bf16(o[2], o[3]); w.z = cvt_pk_bf16(o[4], o[5]); w.w = cvt_pk_bf16(o[6], o[7]);
                    *(u32x4*)(merged + (size_t)row * DM + col) = w;
                }
            }
    }
};
struct EpiOut {
    static constexpr bool PERM = true, AFTER_DRAIN = false;
    const float* x; float* x1; bf16_t* x1g; const float* mod; const float* g2; float* rowss;
    __device__ __forceinline__ void operator()(const f32x4 (&acc)[2][2][4][2], const Unit& u, int wr, int wc, int fr, int fq) const {
#pragma unroll
        for (int ai = 0; ai < 2; ++ai)
#pragma unroll
            for (int m = 0; m < 4; ++m) {
                const int row = u.pm * BM + ai * HALF + wr * 64 + m * 16 + fr;
                const float* modb = mod + (size_t)(row >> 12) * (6 * DM);
                float ss = 0.f;
#pragma unroll
                for (int bj = 0; bj < 2; ++bj) {
                    const int col = u.pn * BM + bj * HALF + wc * 32 + 8 * fq;
#pragma unroll
                    for (int n = 0; n < 2; ++n) {
                        const int cc = col + 4 * n;
                        const f32x4 v = acc[ai][bj][m][n];
                        const f32x4 xx = *(const f32x4*)(x + (size_t)row * DM + cc);
                        const f32x4 g1 = *(const f32x4*)(modb + 2 * DM + cc), sc = *(const f32x4*)(modb + 4 * DM + cc), gg = *(const f32x4*)(g2 + cc);
                        const f32x4 o = xx + g1 * v;
                        *(f32x4*)(x1 + (size_t)row * DM + cc) = o;
                        ss += o[0] * o[0] + o[1] * o[1] + o[2] * o[2] + o[3] * o[3];
                        const f32x4 og = o * gg * (sc + 1.f);
                        u32x2 w; w.x = cvt_pk_bf16(og[0], og[1]); w.y = cvt_pk_bf16(og[2], og[3]);
                        *(u32x2*)(x1g + (size_t)row * DM + cc) = w;
                    }
                }
                ss += __shfl_xor(ss, 16); ss += __shfl_xor(ss, 32);
                if (fq == 0) atomicAdd(rowss + row, ss);
            }
    }
};
struct EpiQ {
    static constexpr bool PERM = true, AFTER_DRAIN = false;
    bf16_t* qp; const float* rowss; const float* c2;
    __device__ __forceinline__ void operator()(const f32x4 (&acc)[2][2][4][2], const Unit& u, int wr, int wc, int fr, int fq) const {
#pragma unroll
        for (int ai = 0; ai < 2; ++ai)
#pragma unroll
            for (int m = 0; m < 4; ++m) {
                const int row = u.pm * BM + ai * HALF + wr * 64 + m * 16 + fr;
                const float rstd = rsqrtf(rowss[row] * (1.f / DM) + EPSN);
                const float* cb = c2 + (size_t)(row >> 12) * 2048;
#pragma unroll
                for (int bj = 0; bj < 2; ++bj) {
                    const int col = u.pn * BM + bj * HALF + wc * 32 + 8 * fq;
                    const f32x4 v0 = acc[ai][bj][m][0] * rstd + *(const f32x4*)(cb + col), v1 = acc[ai][bj][m][1] * rstd + *(const f32x4*)(cb + col + 4);
                    u32x4 w; w.x = cvt_pk_bf16(v0[0], v0[1]); w.y = cvt_pk_bf16(v0[2], v0[3]); w.z = cvt_pk_bf16(v1[0], v1[1]); w.w = cvt_pk_bf16(v1[2], v1[3]);
                    *(u32x4*)(qp + (size_t)row * 2048 + col) = w;
                }
            }
    }
};
}

__device__ __forceinline__ void p0_transpose_item(const float* W, int K, int N, bf16_t* WT, LAS float* scr, int item, int lane) {
    const int nblk = N / 32, kb = item / nblk, nb = item % nblk, k0 = 64 * kb, n0 = 32 * nb;
#pragma unroll 8
    for (int i = 0; i < 32; ++i) { const int kk = 2 * i + (lane >> 5); scr[kk * 33 + (lane & 31)] = W[(size_t)(k0 + kk) * N + n0 + (lane & 31)]; }
    asm volatile("s_waitcnt lgkmcnt(0)" ::: "memory");
    const int c = lane & 7;
#pragma unroll
    for (int j = 0; j < 4; ++j) { const int n = (lane >> 3) + 8 * j; const LAS float* s = scr + (8 * c) * 33 + n;
        u32x4 o; o.x = pk2(s[0 * 33], s[1 * 33]); o.y = pk2(s[2 * 33], s[3 * 33]); o.z = pk2(s[4 * 33], s[5 * 33]); o.w = pk2(s[6 * 33], s[7 * 33]);
        *(u32x4*)(WT + (size_t)(n0 + n) * K + k0 + 8 * c) = o; }
    asm volatile("s_waitcnt lgkmcnt(0)" ::: "memory");
}

template <int NR, bool SILU>
__device__ __forceinline__ void gemv_block64(const float* const (&rows)[NR], const float* W, int ldw, int col0, const float* bias, float* y, int ldy, LAS float* scr) {
    const int wave = threadIdx.x >> 6, lane = threadIdx.x & 63;
    float acc[NR];
#pragma unroll
    for (int r = 0; r < NR; ++r) acc[r] = 0.f;
    const int kb = wave * 128;
#pragma unroll 4
    for (int k = kb; k < kb + 128; ++k) {
        const float w = W[(size_t)k * ldw + col0 + lane];
#pragma unroll
        for (int r = 0; r < NR; ++r) { const float s = rows[r][k]; acc[r] += (SILU ? siluf_(s) : s) * w; }
    }
#pragma unroll
    for (int r = 0; r < NR; ++r) scr[(wave * NR + r) * 64 + lane] = acc[r];
    __syncthreads();
    for (int e = threadIdx.x; e < NR * 64; e += NT) {
        const int r = e >> 6, l = e & 63; float s = 0.f;
#pragma unroll
        for (int w = 0; w < 8; ++w) s += scr[(w * NR + r) * 64 + l];
        y[(size_t)r * ldy + col0 + l] = s + (bias ? bias[col0 + l] : 0.f);
    }
    __syncthreads();
}

__device__ __forceinline__ void ph_prep(const P& p, LAS unsigned char* lds) {
    const int wave = threadIdx.x >> 6, lane = threadIdx.x & 63, G = gridDim.x;
    for (int cb = blockIdx.x; cb < 96; cb += G) {
        const float* const rows[9] = {p.c, p.c + DM, p.c + 2 * DM, p.c + 3 * DM, p.c + 4 * DM, p.c + 5 * DM, p.c + 6 * DM, p.c + 7 * DM, p.c_ctx};
        gemv_block64<9, true>(rows, p.w_mod, 6 * DM, cb * 64, p.b_mod, p.mod, 6 * DM, (LAS float*)lds);
    }
    {
        LAS float* scr = (LAS float*)(lds + wave * 16384);
        const int gw = blockIdx.x * NWAVES + wave, NGW = G * NWAVES;
        constexpr int I_IN = (DM / 64) * (INC / 32), I_GLU = (512 / 64) * (512 / 32), I_A = (512 / 64) * (DM / 32), I_OUT = (DM / 64) * (DM / 32), I_Q = (DM / 64) * (2048 / 32);
        constexpr int NITEMS = I_IN + I_GLU + 2 * I_A + I_OUT + I_Q;
        for (int it = gw; it < NITEMS; it += NGW) {
            int r = it;
            if (r < I_IN) { p0_transpose_item(p.w_in, DM, INC, p.w_in_t, scr, r, lane); continue; } r -= I_IN;
            if (r < I_GLU) { p0_transpose_item(p.w_glu, 512, 512, p.w_glu_t, scr, r, lane); continue; } r -= I_GLU;
            if (r < I_A) { p0_transpose_item(p.w_a, 512, DM, p.w_a_t, scr, r, lane); continue; } r -= I_A;
            if (r < I_A) { p0_transpose_item(p.w_b, 512, DM, p.w_b_t, scr, r, lane); continue; } r -= I_A;
            if (r < I_OUT) { p0_transpose_item(p.w_out, DM, DM, p.w_out_t, scr, r, lane); continue; } r -= I_OUT;
            p0_transpose_item(p.w_q, DM, 2048, p.w_q_t, scr, r, lane);
        }
    }
    {
        const size_t nchunk = (size_t)16384 * DM / 8, gsz = (size_t)G * NT;
        for (size_t i = (size_t)blockIdx.x * NT + threadIdx.x; i < 2 * nchunk; i += gsz) {
            const bool second = i >= nchunk; const size_t j = second ? i - nchunk : i;
            const float* src = (second ? p.peer_v : p.peer_u) + j * 8;
            const f32x4 a = *(const f32x4*)src, b = *(const f32x4*)(src + 4);
            u32x4 o; o.x = pk2(a[0], a[1]); o.y = pk2(a[2], a[3]); o.z = pk2(b[0], b[1]); o.w = pk2(b[2], b[3]);
            *(u32x4*)((second ? p.pv : p.pu) + j * 8) = o;
        }
    }
}

__device__ __forceinline__ void normmod_row_bf16(const float* src, bf16_t* dst, const float* g, const float* shift, const float* scale, int lane) {
    const f32x4* s = (const f32x4*)src;
    f32x4 v[4]; float ss = 0.f;
#pragma unroll
    for (int j = 0; j < 4; ++j) { v[j] = s[lane + 64 * j]; ss += v[j][0] * v[j][0] + v[j][1] * v[j][1] + v[j][2] * v[j][2] + v[j][3] * v[j][3]; }
    ss = wave_sum(ss);
    const float rstd = rsqrtf(ss * (1.f / DM) + EPSN);
#pragma unroll
    for (int j = 0; j < 4; ++j) {
        const int i4 = lane + 64 * j;
        const f32x4 gg = ((const f32x4*)g)[i4], sh = ((const f32x4*)shift)[i4], sc = ((const f32x4*)scale)[i4];
        const f32x4 o = v[j] * rstd * gg * (sc + 1.f) + sh;
        u32x2 w; w.x = pk2(o[0], o[1]); w.y = pk2(o[2], o[3]);
        *(u32x2*)(dst + (size_t)i4 * 4) = w;
    }
}
__device__ __forceinline__ void ph_norm1(const P& p, LAS unsigned char* lds) {
    const int wave = threadIdx.x >> 6, lane = threadIdx.x & 63, G = gridDim.x;
    for (int cb = blockIdx.x; cb < 32; cb += G) {
        const float* m3 = p.mod + 3 * DM;
        const float* const rows[8] = {m3, m3 + 6 * DM, m3 + 12 * DM, m3 + 18 * DM, m3 + 24 * DM, m3 + 30 * DM, m3 + 36 * DM, m3 + 42 * DM};
        gemv_block64<8, false>(rows, p.w_q, 2048, cb * 64, nullptr, p.c2, 2048, (LAS float*)lds);
    }
    for (int r = blockIdx.x * NWAVES + wave; r < NTOK + NCTX; r += G * NWAVES) {
        if (r < NTOK) { const float* modb = p.mod + (size_t)(r >> 12) * (6 * DM); normmod_row_bf16(p.x + (size_t)r * DM, p.hx + (size_t)r * DM, p.norm1_g, modb, modb + DM, lane); }
        else { const int rc = r - NTOK; const float* modc = p.mod + 8 * (6 * DM); normmod_row_bf16(p.ctx + (size_t)rc * DM, p.hc + (size_t)rc * DM, p.norm1_g, modc, modc + DM, lane); }
    }
}

__device__ __forceinline__ void ph_ssm_naive(const P& p) {
    const int wave = threadIdx.x >> 6, lane = threadIdx.x & 63;
    if (wave >= 2) return;
    const int vw = blockIdx.x + gridDim.x * wave;
    if (vw >= NB * 64) return;
    const int b = vw >> 6, g = (vw >> 1) & 31, dir = vw & 1, pp = lane;
    const int gi = dir * 32 + g;
    const float are = p.a_re[gi * 64 + pp], aim = p.a_im[gi * 64 + pp];
    const float dt = expf(p.log_dt[gi]);
    const float er = expf(are * dt);
    const float lr = er * cosf(aim * dt), li = er * sinf(aim * dt);
    const float nr = lr - 1.f, ni = li, den = are * are + aim * aim;
    const float qr = (nr * are + ni * aim) / den, qi = (ni * are - nr * aim) / den;
    float bbr[16], bbi[16], cr[16], ci[16];
#pragma unroll
    for (int h = 0; h < 16; ++h) {
        const float br = p.b_re[((size_t)gi * 64 + pp) * 16 + h], bi = p.b_im[((size_t)gi * 64 + pp) * 16 + h];
        bbr[h] = qr * br - qi * bi; bbi[h] = qr * bi + qi * br;
        cr[h] = p.c_re[((size_t)gi * 16 + h) * 64 + pp]; ci[h] = p.c_im[((size_t)gi * 16 + h) * 64 + pp];
    }
    float sr = 0.f, si = 0.f;
    const bf16_t* Ug = p.U + (size_t)g * SSM_ROWS * SSM_LD;
    for (int j = 0; j < CTXL + SEQL; ++j) {
        const bool is_ctx = j < CTXL;
        int t; const bf16_t* up;
        if (is_ctx) { t = dir == 0 ? j : (CTXL - 1 - j); up = Ug + (size_t)(1024 + b * 8 + (t >> 5)) * SSM_LD + (t & 31) * 16; }
        else { const int i = j - CTXL; t = dir == 0 ? i : (SEQL - 1 - i); up = Ug + (size_t)(b * 128 + (t >> 5)) * SSM_LD + (t & 31) * 16; }
        const u32x4 ua = *(const u32x4*)up, ub = *(const u32x4*)(up + 8);
        float uu[16];
        uu[0] = bflo(ua.x); uu[1] = bfhi(ua.x); uu[2] = bflo(ua.y); uu[3] = bfhi(ua.y); uu[4] = bflo(ua.z); uu[5] = bfhi(ua.z); uu[6] = bflo(ua.w); uu[7] = bfhi(ua.w);
        uu[8] = bflo(ub.x); uu[9] = bfhi(ub.x); uu[10] = bflo(ub.y); uu[11] = bfhi(ub.y); uu[12] = bflo(ub.z); uu[13] = bfhi(ub.z); uu[14] = bflo(ub.w); uu[15] = bfhi(ub.w);
        float bur = 0.f, bui = 0.f;
#pragma unroll
        for (int h = 0; h < 16; ++h) { bur += bbr[h] * uu[h]; bui += bbi[h] * uu[h]; }
        const float nsr = lr * sr - li * si + bur, nsi = lr * si + li * sr + bui;
        sr = nsr; si = nsi;
        if (!is_ctx) {
            float yo = 0.f;
#pragma unroll
            for (int h = 0; h < 16; ++h) { const float y = wave_sum(cr[h] * sr - ci[h] * si); if (lane == h) yo = y; }
            float* ydst = dir == 0 ? p.yf : p.yr;
            if (lane < 16) ydst[((size_t)b * SEQL + t) * 512 + g * 16 + lane] = yo;
        }
    }
}
__device__ __forceinline__ void ph_z_naive(const P& p) {
    const size_t gsz = (size_t)gridDim.x * NT;
    for (size_t i = (size_t)blockIdx.x * NT + threadIdx.x; i < (size_t)NTOK * 512; i += gsz) {
        const int tok = (int)(i >> 9), cidx = (int)(i & 511), g = cidx >> 4, h = cidx & 15;
        const int b = tok >> 12, t = tok & 4095;
        const float u = bf2f(p.U[(size_t)(g * SSM_ROWS + b * 128 + (t >> 5)) * SSM_LD + (t & 31) * 16 + h]);
        const float y = p.ssm_d[cidx] * u + p.yf[i] + p.yr[i];
        p.z[i] = (bf16_t)f2bf(gelu_tanh(y));
    }
}

__device__ __forceinline__ void ph_na_naive(const P& p) {
    const int tid = threadIdx.x, hh = tid >> 7, col = (tid >> 1) & 63, half = tid & 1;
    for (int it = blockIdx.x; it < NB * GW * 2; it += gridDim.x) {
        const int b = it >> 7, r = (it >> 1) & 63, head = (it & 1) * 4 + hh;
        int r0 = r - 4; r0 = r0 < 0 ? 0 : (r0 > 56 ? 56 : r0);
        int c0 = col - 8; c0 = c0 < 0 ? 0 : (c0 > 48 ? 48 : c0);
        const size_t tq = (size_t)b * SEQL + r * GW + col;
        const int doff = head * 64 + half * 32;
        float q[32], o[32];
        {
            const u32x4* qp = (const u32x4*)(p.qb + tq * 512 + doff);
#pragma unroll
            for (int d = 0; d < 4; ++d) { const u32x4 v = qp[d]; q[8 * d] = bflo(v.x); q[8 * d + 1] = bfhi(v.x); q[8 * d + 2] = bflo(v.y); q[8 * d + 3] = bfhi(v.y); q[8 * d + 4] = bflo(v.z); q[8 * d + 5] = bfhi(v.z); q[8 * d + 6] = bflo(v.w); q[8 * d + 7] = bfhi(v.w); }
        }
#pragma unroll
        for (int d = 0; d < 32; ++d) o[d] = 0.f;
        float m = -INFINITY, l = 0.f;
        for (int kk = 0; kk < 128 + CTXL; ++kk) {
            const bf16_t* kp; const bf16_t* vp; float bias = 0.f;
            if (kk < 128) {
                const int i = kk >> 4, cc = kk & 15, krow = r0 + i, kcol = c0 + cc;
                const size_t tk = (size_t)b * SEQL + krow * GW + kcol;
                kp = p.kb + tk * 512 + doff; vp = p.vb + tk * 512 + doff;
                bias = p.rpb[(head * 15 + (krow - r + 7)) * 31 + (kcol - col + 15)];
            } else {
                const size_t j = (size_t)b * CTXL + (kk - 128);
                kp = p.kc + j * 512 + doff; vp = p.vc + j * 512 + doff;
            }
            float s = 0.f;
#pragma unroll
            for (int d = 0; d < 4; ++d) { const u32x4 v = ((const u32x4*)kp)[d];
                s += q[8 * d] * bflo(v.x) + q[8 * d + 1] * bfhi(v.x) + q[8 * d + 2] * bflo(v.y) + q[8 * d + 3] * bfhi(v.y) + q[8 * d + 4] * bflo(v.z) + q[8 * d + 5] * bfhi(v.z) + q[8 * d + 6] * bflo(v.w) + q[8 * d + 7] * bfhi(v.w); }
            s += __shfl_xor(s, 1);
            s = s * 0.125f + bias;
            const float mn = fmaxf(m, s);
            const float corr = __expf(m - mn), pe = __expf(s - mn);
            l = l * corr + pe;
#pragma unroll
            for (int d = 0; d < 4; ++d) { const u32x4 v = ((const u32x4*)vp)[d];
                o[8 * d] = o[8 * d] * corr + pe * bflo(v.x); o[8 * d + 1] = o[8 * d + 1] * corr + pe * bfhi(v.x); o[8 * d + 2] = o[8 * d + 2] * corr + pe * bflo(v.y); o[8 * d + 3] = o[8 * d + 3] * corr + pe * bfhi(v.y);
                o[8 * d + 4] = o[8 * d + 4] * corr + pe * bflo(v.z); o[8 * d + 5] = o[8 * d + 5] * corr + pe * bfhi(v.z); o[8 * d + 6] = o[8 * d + 6] * corr + pe * bflo(v.w); o[8 * d + 7] = o[8 * d + 7] * corr + pe * bfhi(v.w); }
            m = mn;
        }
        const float inv = 1.f / l;
        u32x4* op = (u32x4*)(p.na + tq * 512 + doff);
#pragma unroll
        for (int d = 0; d < 4; ++d) { u32x4 w; w.x = pk2(o[8 * d] * inv, o[8 * d + 1] * inv); w.y = pk2(o[8 * d + 2] * inv, o[8 * d + 3] * inv); w.z = pk2(o[8 * d + 4] * inv, o[8 * d + 5] * inv); w.w = pk2(o[8 * d + 6] * inv, o[8 * d + 7] * inv); op[d] = w; }
    }
}

__device__ __forceinline__ void ph_peer_naive(const P& p) {
    const int wave = threadIdx.x >> 6, lane = threadIdx.x & 63;
    const float NEG = -INFINITY;
    for (int tok = blockIdx.x * NWAVES + wave; tok < NTOK; tok += gridDim.x * NWAVES) {
        const int b = tok >> 12;
        const float* modb = p.mod + (size_t)b * (6 * DM);
        const bf16_t* qrow = p.qp + (size_t)tok * 2048;
        float hv[16], acc[16], x1v[16];
        const float rstd2 = rsqrtf(p.rowss[tok] * (1.f / DM) + EPSN);
#pragma unroll
        for (int j = 0; j < 2; ++j)
#pragma unroll
            for (int q4 = 0; q4 < 2; ++q4) {
                const int e0 = j * 512 + lane * 8 + q4 * 4;
                const f32x4 xv = *(const f32x4*)(p.out + (size_t)tok * DM + e0), gg = *(const f32x4*)(p.norm2_g + e0), sh = *(const f32x4*)(modb + 3 * DM + e0), sc = *(const f32x4*)(modb + 4 * DM + e0);
#pragma unroll
                for (int i = 0; i < 4; ++i) { x1v[j * 8 + q4 * 4 + i] = xv[i]; hv[j * 8 + q4 * 4 + i] = xv[i] * rstd2 * gg[i] * (1.f + sc[i]) + sh[i]; acc[j * 8 + q4 * 4 + i] = 0.f; }
            }
        for (int h = 0; h < 8; ++h) {
            float stop0 = NEG, stop1 = NEG; int itop0 = 0, itop1 = 0;
            for (int n = 0; n < 2; ++n) {
                const bf16_t* qh = qrow + h * 256 + n * 128;
                const f32x4* k0 = (const f32x4*)(p.subkeys + ((size_t)(n * 128 + lane)) * 128);
                const f32x4* k1 = (const f32x4*)(p.subkeys + ((size_t)(n * 128 + lane + 64)) * 128);
                float s0 = 0.f, s1 = 0.f;
                for (int d = 0; d < 16; ++d) {
                    const u32x4 qv = *(const u32x4*)(qh + d * 8);
                    const f32x4 a0 = k0[2 * d], a1 = k0[2 * d + 1], c0 = k1[2 * d], c1 = k1[2 * d + 1];
                    const float q0 = bflo(qv.x), q1 = bfhi(qv.x), q2 = bflo(qv.y), q3 = bfhi(qv.y), q4 = bflo(qv.z), q5 = bfhi(qv.z), q6 = bflo(qv.w), q7 = bfhi(qv.w);
                    s0 += q0 * a0[0] + q1 * a0[1] + q2 * a0[2] + q3 * a0[3] + q4 * a1[0] + q5 * a1[1] + q6 * a1[2] + q7 * a1[3];
                    s1 += q0 * c0[0] + q1 * c0[1] + q2 * c0[2] + q3 * c0[3] + q4 * c1[0] + q5 * c1[1] + q6 * c1[2] + q7 * c1[3];
                }
                float mytop = NEG; int myidx = 0;
                for (int r = 0; r < 16; ++r) {
                    const float lv = fmaxf(s0, s1);
                    const float mx = wave_max(lv);
                    const unsigned long long bal = __ballot(lv == mx);
                    const int owner = __ffsll((long long)bal) - 1;
                    const int li = (s0 >= s1) ? lane : lane + 64;
                    const int idx = __shfl(li, owner);
                    if (lane == r) { mytop = mx; myidx = idx; }
                    if (lane == owner) { if (s0 >= s1) s0 = NEG; else s1 = NEG; }
                }
                if (n == 0) { stop0 = mytop; itop0 = myidx; } else { stop1 = mytop; itop1 = myidx; }
            }
            float cv0, cv1, cv2, cv3; int ce0, ce1, ce2, ce3;
            {
                const int jj = lane & 15, ib = lane >> 4;
                const float sj = __shfl(stop1, jj); const int ij = __shfl(itop1, jj);
                cv0 = __shfl(stop0, ib) + sj;      ce0 = __shfl(itop0, ib) * 128 + ij;
                cv1 = __shfl(stop0, ib + 4) + sj;  ce1 = __shfl(itop0, ib + 4) * 128 + ij;
                cv2 = __shfl(stop0, ib + 8) + sj;  ce2 = __shfl(itop0, ib + 8) * 128 + ij;
                cv3 = __shfl(stop0, ib + 12) + sj; ce3 = __shfl(itop0, ib + 12) * 128 + ij;
            }
            float best = NEG; int expert = 0;
            for (int r = 0; r < 16; ++r) {
                const float lv = fmaxf(fmaxf(cv0, cv1), fmaxf(cv2, cv3));
                const float mx = wave_max(lv);
                const unsigned long long bal = __ballot(lv == mx);
                const int owner = __ffsll((long long)bal) - 1;
                const int wm = (cv0 == lv) ? 0 : ((cv1 == lv) ? 1 : ((cv2 == lv) ? 2 : 3));
                const int le = wm == 0 ? ce0 : (wm == 1 ? ce1 : (wm == 2 ? ce2 : ce3));
                const int eid = __shfl(le, owner);
                if (lane == r) { best = mx; expert = eid; }
                if (lane == owner) { if (wm == 0) cv0 = NEG; else if (wm == 1) cv1 = NEG; else if (wm == 2) cv2 = NEG; else cv3 = NEG; }
            }
            const float m16 = wave_max(lane < 16 ? best : NEG);
            const float ex = lane < 16 ? __expf(best - m16) : 0.f;
            const float gsum = wave_sum(ex);
            const float gate = ex / gsum;
            for (int k = 0; k < 16; ++k) {
                const int e = __shfl(expert, k);
                const float gk = __shfl(gate, k);
                const bf16_t* ur = p.pu + (size_t)e * DM; const bf16_t* vr = p.pv + (size_t)e * DM;
                float part = 0.f;
#pragma unroll
                for (int j = 0; j < 2; ++j) { const u32x4 uu = *(const u32x4*)(ur + j * 512 + lane * 8);
                    part += hv[j * 8] * bflo(uu.x) + hv[j * 8 + 1] * bfhi(uu.x) + hv[j * 8 + 2] * bflo(uu.y) + hv[j * 8 + 3] * bfhi(uu.y) + hv[j * 8 + 4] * bflo(uu.z) + hv[j * 8 + 5] * bfhi(uu.z) + hv[j * 8 + 6] * bflo(uu.w) + hv[j * 8 + 7] * bfhi(uu.w); }
                const float a = wave_sum(part);
                const float w = gk * gelu_tanh(a);
#pragma unroll
                for (int j = 0; j < 2; ++j) { const u32x4 vv = *(const u32x4*)(vr + j * 512 + lane * 8);
                    acc[j * 8] += w * bflo(vv.x); acc[j * 8 + 1] += w * bfhi(vv.x); acc[j * 8 + 2] += w * bflo(vv.y); acc[j * 8 + 3] += w * bfhi(vv.y); acc[j * 8 + 4] += w * bflo(vv.z); acc[j * 8 + 5] += w * bfhi(vv.z); acc[j * 8 + 6] += w * bflo(vv.w); acc[j * 8 + 7] += w * bfhi(vv.w); }
            }
        }
        float ss = 0.f;
#pragma unroll
        for (int j = 0; j < 2; ++j)
#pragma unroll
            for (int q4 = 0; q4 < 2; ++q4) {
                const int e0 = j * 512 + lane * 8 + q4 * 4;
                const f32x4 g2 = *(const f32x4*)(modb + 5 * DM + e0);
#pragma unroll
                for (int i = 0; i < 4; ++i) { const int ix = j * 8 + q4 * 4 + i; x1v[ix] = x1v[ix] + g2[i] * acc[ix]; ss += x1v[ix] * x1v[ix]; }
            }
        ss = wave_sum(ss);
        const float rstd = rsqrtf(ss * (1.f / DM) + EPSN);
#pragma unroll
        for (int j = 0; j < 2; ++j)
#pragma unroll
            for (int q4 = 0; q4 < 2; ++q4) {
                const int e0 = j * 512 + lane * 8 + q4 * 4;
                const f32x4 fg = *(const f32x4*)(p.final_g + e0);
                f32x4 o;
#pragma unroll
                for (int i = 0; i < 4; ++i) o[i] = x1v[j * 8 + q4 * 4 + i] * rstd * fg[i];
                *(f32x4*)(p.out + (size_t)tok * DM + e0) = o;
            }
    }
}

constexpr int LDS_BYTES = 147456;
#define GSYNC() cg::this_grid().sync()

__global__ void __launch_bounds__(NT, 2) mega(P p) {
    extern __shared__ __attribute__((aligned(16))) unsigned char lds_raw[];
    LAS unsigned char* lds = (LAS unsigned char*)lds_raw;
    const int G = gridDim.x, bx = blockIdx.x;
    using namespace pg8;

    ph_prep(p, lds);
    GSYNC();
    ph_norm1(p, lds);
    GSYNC();
    {
        Gemm g{p.hx, p.w_in_t, DM, DM, DM, 0, 0}; StaticOrder S; S.init(NTOK, INC, G, bx);
        EpiInProj E{p.U, p.kb, (size_t)NTOK * 512, p.ga, 0};
        gemm_phase<EpiInProj, StaticOrder, true, true>(lds, g, S, E);
        Gemm g2{p.hc, p.w_in_t, DM, DM, DM, 0, 0}; StaticOrder S2; S2.init(NCTX, CTXC, G, bx);
        EpiInProj E2{p.U, p.kc, (size_t)NCTX * 512, p.ga, 1};
        gemm_phase<EpiInProj, StaticOrder, true, true>(lds, g2, S2, E2);
    }
    GSYNC();
    ph_ssm_naive(p);
    ph_na_naive(p);
    GSYNC();
    ph_z_naive(p);
    GSYNC();
    {
        Gemm g{p.z, p.w_glu_t, 512, 512, 512, 0, 0}; StaticOrder S; S.init(NTOK, 512, G, bx);
        EpiGlu E{p.gl, p.z, p.b_glu};
        gemm_phase<EpiGlu, StaticOrder, true, true>(lds, g, S, E);
    }
    GSYNC();
    {
        Gemm g{p.gl, p.w_a_t, 512, 512, 512, 0, 0}; StaticOrder S; S.init(NTOK, DM, G, bx);
        EpiBrA E{p.tbuf, p.ga};
        gemm_phase<EpiBrA, StaticOrder, true, true>(lds, g, S, E);
        Gemm g2{p.na, p.w_b_t, 512, 512, 512, 0, 0};
        EpiBrB E2{p.merged, p.tbuf, p.gb};
        gemm_phase<EpiBrB, StaticOrder, true, true>(lds, g2, S, E2);
    }
    GSYNC();
    {
        Gemm g{p.merged, p.w_out_t, DM, DM, DM, 0, 0}; StaticOrder S; S.init(NTOK, DM, G, bx);
        EpiOut E{p.x, p.out, p.x1g, p.mod, p.norm2_g, p.rowss};
        gemm_phase<EpiOut, StaticOrder, true, true>(lds, g, S, E);
    }
    GSYNC();
    {
        Gemm g{p.x1g, p.w_q_t, DM, DM, DM, 0, 0}; StaticOrder S; S.init(NTOK, 2048, G, bx);
        EpiQ E{p.qp, p.rowss, p.c2};
        gemm_phase<EpiQ, StaticOrder, true, true>(lds, g, S, E);
    }
    GSYNC();
    ph_peer_naive(p);
}

extern "C" void kernel_launch(void* const* d_in, const int* in_sizes, int n_in, void* d_out, int out_size, void* d_ws, size_t ws_size, hipStream_t stream) {
    static int grid = 0;
    if (grid == 0) {
        int dev = 0, cus = 0, per_cu = 0;
        (void)hipGetDevice(&dev);
        (void)hipDeviceGetAttribute(&cus, hipDeviceAttributeMultiprocessorCount, dev);
        (void)hipFuncSetAttribute((const void*)mega, hipFuncAttributeMaxDynamicSharedMemorySize, LDS_BYTES);
        (void)hipOccupancyMaxActiveBlocksPerMultiprocessor(&per_cu, (const void*)mega, NT, LDS_BYTES);
        if (per_cu < 1) { fprintf(stderr, "occupancy query says %d blocks per CU\n", per_cu); per_cu = 1; }
        grid = cus;
    }
    P p{};
    const float* const* in = (const float* const*)d_in;
    p.x = in[0]; p.c = in[1]; p.ctx = in[2]; p.c_ctx = in[3]; p.w_mod = in[4]; p.b_mod = in[5]; p.norm1_g = in[6]; p.norm2_g = in[7]; p.w_in = in[8];
    p.a_re = in[9]; p.a_im = in[10]; p.log_dt = in[11]; p.b_re = in[12]; p.b_im = in[13]; p.c_re = in[14]; p.c_im = in[15]; p.ssm_d = in[16];
    p.w_glu = in[17]; p.b_glu = in[18]; p.w_a = in[19]; p.w_b = in[20]; p.rpb = in[21]; p.w_out = in[22]; p.w_q = in[23]; p.subkeys = in[24];
    p.peer_u = in[25]; p.peer_v = in[26]; p.final_g = in[27];
    p.out = (float*)d_out;
    unsigned char* ws = (unsigned char*)d_ws; unsigned char* ob = (unsigned char*)d_out;
    constexpr size_t MiB = 1u << 20;
    p.rowss = (float*)(ws + 512 * 1024);
    p.mod = (float*)(ws + 1 * MiB); p.c2 = (float*)(ws + 1 * MiB + 256 * 1024);
    p.w_in_t = (bf16_t*)(ws + 3 * MiB); p.w_glu_t = (bf16_t*)(ws + 11 * MiB); p.w_a_t = (bf16_t*)(ws + 12 * MiB); p.w_b_t = (bf16_t*)(ws + 13 * MiB);
    p.w_out_t = (bf16_t*)(ws + 14 * MiB); p.w_q_t = (bf16_t*)(ws + 16 * MiB);
    p.pu = (bf16_t*)(ws + 54 * MiB); p.pv = (bf16_t*)(ws + 86 * MiB);
    p.ga = (bf16_t*)(ws + 118 * MiB); p.gb = (bf16_t*)(ws + 182 * MiB);
    p.kb = (bf16_t*)(ws + 246 * MiB); p.vb = (bf16_t*)(ws + 278 * MiB); p.qb = (bf16_t*)(ws + 310 * MiB); p.kc = (bf16_t*)(ws + 342 * MiB); p.vc = (bf16_t*)(ws + 344 * MiB);
    p.U = (bf16_t*)(ws + 346 * MiB);
    p.na = (bf16_t*)(ws + 21 * MiB);
    p.z = (bf16_t*)(ws + 446 * MiB); p.gl = (bf16_t*)(ws + 478 * MiB);
    p.hx = (bf16_t*)ob; p.hc = (bf16_t*)(ob + 64 * MiB);
    p.yf = (float*)ob; p.yr = (float*)(ob + 64 * MiB);
    p.merged = (bf16_t*)(ws + 246 * MiB); p.tbuf = (float*)(ws + 310 * MiB);
    p.x1g = (bf16_t*)(ws + 118 * MiB);
    p.qp = (bf16_t*)(ws + 246 * MiB);
    (void)hipMemsetAsync(ws, 0, 1 * MiB, stream);
    void* args[] = {&p};
    hipError_t e = hipLaunchCooperativeKernel((const void*)mega, dim3(grid), dim3(NT), args, LDS_BYTES, stream);
    if (e != hipSuccess) fprintf(stderr, "cooperative launch failed: %s (grid %d)\n", hipGetErrorString(e), grid);
}
```

```cpp
#include <hip/hip_runtime.h>
#include <hip/hip_cooperative_groups.h>
#include <cstdio>
#include <cstdint>
namespace cg = cooperative_groups;

#define LAS __attribute__((address_space(3)))
typedef unsigned short bf16_t;
typedef short bf16x8 __attribute__((ext_vector_type(8)));
typedef float f32x4 __attribute__((ext_vector_type(4)));
typedef float f32x2 __attribute__((ext_vector_type(2)));
typedef unsigned u32x4 __attribute__((ext_vector_type(4)));
typedef unsigned u32x2 __attribute__((ext_vector_type(2)));

constexpr int DM = 1024, NB = 8, SEQL = 4096, CTXL = 256, GW = 64, NTOK = NB * SEQL, NCTX = NB * CTXL;
constexpr int INC = 4096, CTXC = 1536;
constexpr int NT = 512, NWAVES = 8;
constexpr float EPSN = 1e-6f;
constexpr int SSM_ROWS = 1280;
constexpr int SSM_LD = 768;

__device__ __forceinline__ unsigned f2bf(float f) { unsigned u = __builtin_bit_cast(unsigned, f); return (u + 0x7fffu + ((u >> 16) & 1u)) >> 16; }
__device__ __forceinline__ unsigned pk2(float lo, float hi) { return f2bf(lo) | (f2bf(hi) << 16); }
__device__ __forceinline__ float bflo(unsigned w) { return __builtin_bit_cast(float, w << 16); }
__device__ __forceinline__ float bfhi(unsigned w) { return __builtin_bit_cast(float, w & 0xffff0000u); }
__device__ __forceinline__ float bf2f(bf16_t h) { return __builtin_bit_cast(float, (unsigned)h << 16); }

__device__ __forceinline__ float wave_sum(float v) {
#pragma unroll
    for (int o = 1; o < 64; o <<= 1) v += __shfl_xor(v, o);
    return v;
}
__device__ __forceinline__ float wave_max(float v) {
#pragma unroll
    for (int o = 1; o < 64; o <<= 1) v = fmaxf(v, __shfl_xor(v, o));
    return v;
}
__device__ __forceinline__ float sigmoidf_(float x) { return 1.f / (1.f + __expf(-x)); }
__device__ __forceinline__ float siluf_(float x) { return x / (1.f + __expf(-x)); }
__device__ __forceinline__ float gelu_tanh(float x) {
    const float k0 = 0.7978845608028654f, k1 = 0.044715f;
    const float u = k0 * (x + k1 * x * x * x);
    const float t = 1.f - 2.f / (1.f + __expf(2.f * u));
    return 0.5f * x * (1.f + t);
}

namespace pg8 {
#define PG8_LAS __attribute__((address_space(3)))
constexpr int BM = 256, BK = 64, HALF = 128, HTB = HALF * BK * 2  , STAGE_BYTES = 8 * HTB, NXCD = 8, WGM = 8;
__host__ __device__ __forceinline__ int lds_byte(int r, int c) { const int st = (r >> 4) * 2 + (c >> 5), rr = r & 15, cc = c & 31, ob = rr * 64 + cc * 2; return st * 1024 + (ob ^ (((ob >> 9) & 1) << 5)); }
__host__ __device__ __forceinline__ void stage_rc(int b, int& R, int& C) { const int st = b / 1024, sb = b % 1024, swz = sb ^ (((sb >> 9) & 1) << 5); R = (st >> 1) * 16 + swz / 64; C = (st & 1) * 32 + (swz % 64) / 2; }
__host__ __device__ __forceinline__ int perm32(int rho) { const int n = rho >> 4, i = rho & 15; return 8 * (i >> 2) + 4 * n + (i & 3); }

struct Unit { int pm, pn, g; };
template <int K_, int LDA, int LDB, long GSA = 0, long GSB = 0>
struct Gemm {
    const bf16_t* A; const bf16_t* Bt;
    static constexpr int K = K_, lda = LDA, ldb = LDB;
    __device__ __forceinline__ const char* abase(const Unit& u) const { return (const char*)(A + (size_t)u.g * GSA + (size_t)u.pm * BM * LDA); }
    __device__ __forceinline__ const char* bbase(const Unit& u) const { return (const char*)(Bt + (size_t)u.g * GSB + (size_t)u.pn * BM * LDB); }
};
template <int M, int N, int NGRP = 1>
struct StaticOrder {
    static constexpr int nM = M / BM, nN = N / BM, nwg = nM * nN;
    int G, c;
    __device__ void init(int G_, int c_) { G = G_; c = c_; }
    __device__ bool next(int i, Unit& u) const {
        const int L = i * G + c; if (L >= nwg * NGRP) return false;
        u.g = L / nwg;
        int wgid = L % nwg; { constexpr int q = nwg / NXCD, r = nwg % NXCD; const int xcd = wgid % NXCD, off = wgid / NXCD; wgid = (xcd < r ? xcd * (q + 1) : r * (q + 1) + (xcd - r) * q) + off; }
        constexpr int nig = WGM * nN; const int gid = wgid / nig, fm = gid * WGM, gsz = (nM - fm) < WGM ? (nM - fm) : WGM;
        u.pm = fm + ((wgid % nig) % gsz); u.pn = (wgid % nig) / gsz; return true;
    }
    __device__ __forceinline__ void a_ready(const Unit&) const {}
    __device__ __forceinline__ void done(const Unit&) const {}
};
__device__ __forceinline__ unsigned cvt_pk_bf16(float lo, float hi) { unsigned r; asm volatile("v_cvt_pk_bf16_f32 %0, %1, %2" : "=v"(r) : "v"(lo), "v"(hi)); return r; }
template <class Epi, class Sched, bool ALIGN_EPI = false, bool SP2 = false, class GemmT>
__device__ __forceinline__ void gemm_phase(PG8_LAS unsigned char* lds, const GemmT g, const Sched& S, const Epi& E) {
    const int tid = threadIdx.x, wid = __builtin_amdgcn_readfirstlane(tid >> 6), lane = tid & 63, wr = wid >> 2, wc = wid & 3, fr = lane & 15, fq = lane >> 4;
    const int K = g.K, nt = K / BK;
    unsigned voffA[2], voffB[2];
#pragma unroll
    for (int i = 0; i < 2; ++i) { int R, C; stage_rc(tid * 16 + i * 8192, R, C); const int Rb = Epi::PERM ? ((R & ~31) + perm32(R & 31)) : R;
        voffA[i] = (unsigned)(R * g.lda + C) * 2u; voffB[i] = (unsigned)(Rb * g.ldb + C) * 2u; }
    const size_t kstep = (size_t)(BK * 2);
    const size_t hstepA = (size_t)HALF * g.lda * 2, hstepB = (size_t)HALF * g.ldb * 2;
    const unsigned ldsw = (unsigned)wid * 1024u;
    const int aoff = lds_byte(wr * 64 + fr, fq * 8), boff = lds_byte(wc * 32 + fr, fq * 8);
#define PG8_SA(b, h) (((b) * 2 + (h)) * HTB)
#define PG8_SB(b, h) ((4 + (b) * 2 + (h)) * HTB)
#define PG8_STAGE(bufoff, gbase, voff) do { _Pragma("unroll") for (int _i = 0; _i < 2; ++_i) \
        __builtin_amdgcn_global_load_lds((const unsigned*)((const char*)(gbase) + (voff)[_i]), (PG8_LAS unsigned*)(lds + (bufoff) + ldsw + _i * 8192), 16, 0, 0); } while (0)
#define PG8_LDA(dst, b, h) do { _Pragma("unroll") for (int m = 0; m < 4; ++m) _Pragma("unroll") for (int k = 0; k < 2; ++k) dst[m][k] = *(const PG8_LAS bf16x8*)(lds + PG8_SA(b, h) + aoff + m * 2048 + k * 1024); } while (0)
#define PG8_LDB(dst, b, h) do { _Pragma("unroll") for (int n = 0; n < 2; ++n) _Pragma("unroll") for (int k = 0; k < 2; ++k) dst[n][k] = *(const PG8_LAS bf16x8*)(lds + PG8_SB(b, h) + boff + n * 2048 + k * 1024); } while (0)
#define PG8_MMA(ai, bj, At, Bt) do { __builtin_amdgcn_s_setprio(1); _Pragma("unroll") for (int m = 0; m < 4; ++m) _Pragma("unroll") for (int n = 0; n < 2; ++n) _Pragma("unroll") for (int k = 0; k < 2; ++k) \
        acc[ai][bj][m][n] = __builtin_amdgcn_mfma_f32_16x16x32_bf16(Bt[n][k], At[m][k], acc[ai][bj][m][n], 0, 0, 0); __builtin_amdgcn_s_setprio(0); } while (0)
#define PG8_WAIT_V(n) asm volatile("s_waitcnt vmcnt(" #n ")" ::: "memory")
#define PG8_WAIT_L(n) asm volatile("s_waitcnt lgkmcnt(" #n ")" ::: "memory")
#define PG8_BAR __builtin_amdgcn_s_barrier()
#define PG8_SCHED __builtin_amdgcn_sched_barrier(0)
    Unit cur, nxt; int ui = 0;
    if (!S.next(0, cur)) return;
    f32x4 acc[2][2][4][2];
#pragma unroll
    for (int a = 0; a < 2; ++a)
#pragma unroll
        for (int b = 0; b < 2; ++b)
#pragma unroll
            for (int m = 0; m < 4; ++m)
#pragma unroll
                for (int n = 0; n < 2; ++n) acc[a][b][m][n] = (f32x4){0.f, 0.f, 0.f, 0.f};
    bf16x8 At[4][2], B0[2][2], B1[2][2];
    const char* cA = g.abase(cur); const char* cB = g.bbase(cur);
    S.a_ready(cur);
    if constexpr (SP2) {
        PG8_STAGE(PG8_SB(0, 0), cB, voffB); PG8_STAGE(PG8_SB(0, 1), cB + hstepB, voffB); PG8_STAGE(PG8_SA(0, 0), cA, voffA); PG8_STAGE(PG8_SA(0, 1), cA + hstepA, voffA);
        if (wr == 1) PG8_BAR;
        PG8_WAIT_V(2); PG8_BAR;
        PG8_STAGE(PG8_SB(1, 0), cB + kstep, voffB); PG8_STAGE(PG8_SA(1, 0), cA + kstep, voffA); PG8_STAGE(PG8_SB(1, 1), cB + hstepB + kstep, voffB);
        PG8_WAIT_V(6); PG8_BAR;
    } else {
        PG8_STAGE(PG8_SB(0, 0), cB, voffB); PG8_STAGE(PG8_SA(0, 0), cA, voffA); PG8_STAGE(PG8_SB(0, 1), cB + hstepB, voffB); PG8_STAGE(PG8_SA(0, 1), cA + hstepA, voffA);
        if (wr == 1) PG8_BAR;
        PG8_WAIT_V(4); PG8_BAR;
        PG8_STAGE(PG8_SB(1, 0), cB + kstep, voffB); PG8_STAGE(PG8_SA(1, 0), cA + kstep, voffA); PG8_STAGE(PG8_SB(1, 1), cB + hstepB + kstep, voffB);
        PG8_WAIT_V(6); PG8_BAR;
    }
    for (;;) {
        const bool has_next = S.next(ui + 1, nxt);
        const char* nA = has_next ? g.abase(nxt) : cA; const char* nB = has_next ? g.bbase(nxt) : cB;
        for (int t = 0; t < nt; t += 2) {
            const bool last = (t == nt - 2);
            const char* a1 = cA + (size_t)(t + 1) * kstep;
            const char* a2 = last ? nA : cA + (size_t)(t + 2) * kstep; const char* b2 = last ? nB : cB + (size_t)(t + 2) * kstep;
            const char* a3 = a2 + kstep; const char* b3 = b2 + kstep;
            if (last && has_next) S.a_ready(nxt);
            if constexpr (SP2) {
            PG8_LDB(B0, 0, 0); PG8_LDB(B1, 0, 1); PG8_SCHED; PG8_LDA(At, 0, 0); PG8_STAGE(PG8_SA(1, 1), a1 + hstepA, voffA);
            PG8_WAIT_V(8); PG8_WAIT_L(0); PG8_BAR; PG8_MMA(0, 0, At, B0); PG8_MMA(0, 1, At, B1); PG8_BAR; PG8_SCHED;
            PG8_LDA(At, 0, 1); PG8_STAGE(PG8_SB(0, 0), b2, voffB); PG8_STAGE(PG8_SB(0, 1), b2 + hstepB, voffB); PG8_STAGE(PG8_SA(0, 0), a2, voffA);
            PG8_WAIT_V(8); PG8_WAIT_L(0); PG8_BAR; PG8_MMA(1, 0, At, B0); PG8_MMA(1, 1, At, B1); PG8_BAR; PG8_SCHED;
            PG8_LDB(B0, 1, 0); PG8_LDB(B1, 1, 1); PG8_SCHED; PG8_LDA(At, 1, 0); PG8_STAGE(PG8_SA(0, 1), a2 + hstepA, voffA);
            PG8_WAIT_V(8); PG8_WAIT_L(0); PG8_BAR; PG8_MMA(0, 0, At, B0); PG8_MMA(0, 1, At, B1); PG8_BAR; PG8_SCHED;
            PG8_LDA(At, 1, 1); PG8_STAGE(PG8_SB(1, 0), b3, voffB); PG8_STAGE(PG8_SB(1, 1), b3 + hstepB, voffB); PG8_STAGE(PG8_SA(1, 0), a3, voffA);
            PG8_WAIT_V(8); PG8_WAIT_L(0); PG8_BAR; PG8_MMA(1, 0, At, B0); PG8_MMA(1, 1, At, B1); PG8_BAR; PG8_SCHED;
            } else {
            PG8_LDB(B0, 0, 0); PG8_SCHED; PG8_LDA(At, 0, 0); PG8_STAGE(PG8_SA(1, 1), a1 + hstepA, voffA);
            PG8_WAIT_L(8); PG8_BAR; PG8_WAIT_L(0); PG8_MMA(0, 0, At, B0); PG8_BAR; PG8_SCHED;
            PG8_LDB(B1, 0, 1); PG8_STAGE(PG8_SB(0, 0), b2, voffB);
            PG8_BAR; PG8_WAIT_L(0); PG8_MMA(0, 1, At, B1); PG8_BAR;
            PG8_LDA(At, 0, 1); PG8_STAGE(PG8_SA(0, 0), a2, voffA);
            PG8_BAR; PG8_WAIT_L(0); PG8_MMA(1, 0, At, B0); PG8_BAR; PG8_SCHED;
            PG8_STAGE(PG8_SB(0, 1), b2 + hstepB, voffB);
            PG8_WAIT_V(6); PG8_BAR; PG8_MMA(1, 1, At, B1); PG8_BAR;
            PG8_LDB(B0, 1, 0); PG8_SCHED; PG8_LDA(At, 1, 0); PG8_STAGE(PG8_SA(0, 1), a2 + hstepA, voffA);
            PG8_WAIT_L(8); PG8_BAR; PG8_WAIT_L(0); PG8_MMA(0, 0, At, B0); PG8_BAR; PG8_SCHED;
            PG8_LDB(B1, 1, 1); PG8_STAGE(PG8_SB(1, 0), b3, voffB);
            PG8_BAR; PG8_WAIT_L(0); PG8_MMA(0, 1, At, B1); PG8_BAR;
            PG8_LDA(At, 1, 1); PG8_STAGE(PG8_SA(1, 0), a3, voffA);
            PG8_BAR; PG8_WAIT_L(0); PG8_MMA(1, 0, At, B0); PG8_BAR; PG8_SCHED;
            PG8_STAGE(PG8_SB(1, 1), b3 + hstepB, voffB);
            PG8_WAIT_V(6); PG8_BAR; PG8_MMA(1, 1, At, B1); PG8_BAR;
            }
        }
        if constexpr (ALIGN_EPI) { if (wr == 0) PG8_BAR; }
        if constexpr (!Epi::AFTER_DRAIN) { E(acc, cur, wr, wc, fr, fq); S.done(cur); }
        if (!has_next) break;
#pragma unroll
        for (int a = 0; a < 2; ++a)
#pragma unroll
            for (int b = 0; b < 2; ++b)
#pragma unroll
                for (int m = 0; m < 4; ++m)
#pragma unroll
                    for (int n = 0; n < 2; ++n) acc[a][b][m][n] = (f32x4){0.f, 0.f, 0.f, 0.f};
        cur = nxt; cA = nA; cB = nB; ++ui;
        if constexpr (ALIGN_EPI) { if (wr == 1) PG8_BAR; }
    }
    PG8_WAIT_V(0);
    if constexpr (!ALIGN_EPI) { if (wr == 0) PG8_BAR; }
    PG8_BAR;
    if constexpr (Epi::AFTER_DRAIN) { E.fused(acc, cur, wr, wc, fr, fq, lds, wid, lane); S.done(cur); }
#undef PG8_SA
#undef PG8_SB
#undef PG8_STAGE
#undef PG8_LDA
#undef PG8_LDB
#undef PG8_MMA
#undef PG8_WAIT_V
#undef PG8_WAIT_L
#undef PG8_BAR
#undef PG8_SCHED
}
}

struct P {
    const float *x, *c, *ctx, *c_ctx, *w_mod, *b_mod, *norm1_g, *norm2_g, *w_in;
    const float *a_re, *a_im, *log_dt, *b_re, *b_im, *c_re, *c_im, *ssm_d;
    const float *w_glu, *b_glu, *w_a, *w_b, *rpb, *w_out, *w_q, *subkeys, *peer_u, *peer_v, *final_g;
    float* out;
    float *mod, *c2, *rowss;
    bf16_t *w_in_t, *w_glu_t, *w_a_t, *w_b_t, *w_out_t, *w_q_t;
    bf16_t *pu, *pv;
    bf16_t *hx, *hc;
    bf16_t *U, *kb, *vb, *qb, *kc, *vc, *ga, *gb;
    bf16_t *Kmat, *Win; float *lamT, *E;
    bf16_t *z, *gl, *na, *merged, *x1g, *qp;
    float *tbuf;
};

namespace pg8 {
struct EpiInProj {
    static constexpr bool PERM = true, AFTER_DRAIN = false;
    bf16_t* U; bf16_t* d_kvq; size_t kvq_stride; bf16_t* d_gate; int is_ctx;
    __device__ __forceinline__ void operator()(const f32x4 (&acc)[2][2][4][2], const Unit& u, int wr, int wc, int fr, int fq) const {
        if (u.pn < 2) {
#pragma unroll
            for (int ai = 0; ai < 2; ++ai)
#pragma unroll
                for (int m = 0; m < 4; ++m) {
                    const int row = u.pm * BM + ai * HALF + wr * 64 + m * 16 + fr;
                    const int n = is_ctx ? (1024 + (row >> 8) * 8 + ((row & 255) >> 5)) : ((row >> 12) * 128 + ((row & 4095) >> 5));
                    const int jj = row & 31;
#pragma unroll
                    for (int bj = 0; bj < 2; ++bj) {
                        const int col = u.pn * BM + bj * HALF + wc * 32 + 8 * fq;
                        const f32x4 v0 = acc[ai][bj][m][0], v1 = acc[ai][bj][m][1];
                        u32x4 w; w.x = cvt_pk_bf16(v0[0], v0[1]); w.y = cvt_pk_bf16(v0[2], v0[3]); w.z = cvt_pk_bf16(v1[0], v1[1]); w.w = cvt_pk_bf16(v1[2], v1[3]);
                        *(u32x4*)(U + ((size_t)((col >> 4) * SSM_ROWS + n) * SSM_LD + jj * 16 + (col & 15))) = w;
                    }
                    asm volatile("" ::: "memory");
                }
        } else {
            bf16_t* base; int ld, c0;
            if (u.pn < 8) { const int which = (u.pn - 2) >> 1; base = d_kvq + (size_t)which * kvq_stride; ld = 512; c0 = 512 + which * 512; }
            else { const int which = (u.pn - 8) >> 2; base = d_gate + (size_t)which * ((size_t)NTOK * DM); ld = DM; c0 = 2048 + which * 1024; }
#pragma unroll
            for (int ai = 0; ai < 2; ++ai)
#pragma unroll
                for (int m = 0; m < 4; ++m) {
                    const int row = u.pm * BM + ai * HALF + wr * 64 + m * 16 + fr;
#pragma unroll
                    for (int bj = 0; bj < 2; ++bj) {
                        const int col = u.pn * BM + bj * HALF + wc * 32 + 8 * fq - c0;
                        const f32x4 v0 = acc[ai][bj][m][0], v1 = acc[ai][bj][m][1];
                        u32x4 w; w.x = cvt_pk_bf16(v0[0], v0[1]); w.y = cvt_pk_bf16(v0[2], v0[3]); w.z = cvt_pk_bf16(v1[0], v1[1]); w.w = cvt_pk_bf16(v1[2], v1[3]);
                        *(u32x4*)(base + (size_t)row * ld + col) = w;
                    }
                    asm volatile("" ::: "memory");
                }
        }
    }
};
struct EpiGlu {
    static constexpr bool PERM = true, AFTER_DRAIN = false;
    bf16_t* gl; const bf16_t* z; const float* bias;
    __device__ __forceinline__ void operator()(const f32x4 (&acc)[2][2][4][2], const Unit& u, int wr, int wc, int fr, int fq) const {
#pragma unroll
        for (int ai = 0; ai < 2; ++ai)
#pragma unroll
            for (int m = 0; m < 4; ++m) {
                const int row = u.pm * BM + ai * HALF + wr * 64 + m * 16 + fr;
#pragma unroll
                for (int bj = 0; bj < 2; ++bj) {
                    const int col = u.pn * BM + bj * HALF + wc * 32 + 8 * fq;
                    const f32x4 v0 = acc[ai][bj][m][0], v1 = acc[ai][bj][m][1];
                    const f32x4 b0 = *(const f32x4*)(bias + col), b1 = *(const f32x4*)(bias + col + 4);
                    const u32x4 zz = *(const u32x4*)(z + (size_t)row * 512 + col);
                    float o[8];
                    o[0] = bflo(zz.x) * sigmoidf_(v0[0] + b0[0]); o[1] = bfhi(zz.x) * sigmoidf_(v0[1] + b0[1]);
                    o[2] = bflo(zz.y) * sigmoidf_(v0[2] + b0[2]); o[3] = bfhi(zz.y) * sigmoidf_(v0[3] + b0[3]);
                    o[4] = bflo(zz.z) * sigmoidf_(v1[0] + b1[0]); o[5] = bfhi(zz.z) * sigmoidf_(v1[1] + b1[1]);
                    o[6] = bflo(zz.w) * sigmoidf_(v1[2] + b1[2]); o[7] = bfhi(zz.w) * sigmoidf_(v1[3] + b1[3]);
                    u32x4 w; w.x = cvt_pk_bf16(o[0], o[1]); w.y = cvt_pk_bf16(o[2], o[3]); w.z = cvt_pk_bf16(o[4], o[5]); w.w = cvt_pk_bf16(o[6], o[7]);
                    *(u32x4*)(gl + (size_t)row * 512 + col) = w;
                }
            }
    }
};
struct EpiBrA {
    static constexpr bool PERM = true, AFTER_DRAIN = false;
    float* t; const bf16_t* ga;
    __device__ __forceinline__ void operator()(const f32x4 (&acc)[2][2][4][2], const Unit& u, int wr, int wc, int fr, int fq) const {
#pragma unroll
        for (int ai = 0; ai < 2; ++ai)
#pragma unroll
            for (int m = 0; m < 4; ++m) {
                const int row = u.pm * BM + ai * HALF + wr * 64 + m * 16 + fr;
#pragma unroll
                for (int bj = 0; bj < 2; ++bj) {
                    const int col = u.pn * BM + bj * HALF + wc * 32 + 8 * fq;
                    const f32x4 v0 = acc[ai][bj][m][0], v1 = acc[ai][bj][m][1];
                    const u32x4 gg = *(const u32x4*)(ga + (size_t)row * DM + col);
                    f32x4 o0, o1;
                    o0[0] = sigmoidf_(bflo(gg.x)) * v0[0]; o0[1] = sigmoidf_(bfhi(gg.x)) * v0[1]; o0[2] = sigmoidf_(bflo(gg.y)) * v0[2]; o0[3] = sigmoidf_(bfhi(gg.y)) * v0[3];
                    o1[0] = sigmoidf_(bflo(gg.z)) * v1[0]; o1[1] = sigmoidf_(bfhi(gg.z)) * v1[1]; o1[2] = sigmoidf_(bflo(gg.w)) * v1[2]; o1[3] = sigmoidf_(bfhi(gg.w)) * v1[3];
                    *(f32x4*)(t + (size_t)row * DM + col) = o0; *(f32x4*)(t + (size_t)row * DM + col + 4) = o1;
                }
            }
    }
};
struct EpiBrB {
    static constexpr bool PERM = true, AFTER_DRAIN = false;
    bf16_t* merged; const float* t; const bf16_t* gb;
    __device__ __forceinline__ void operator()(const f32x4 (&acc)[2][2][4][2], const Unit& u, int wr, int wc, int fr, int fq) const {
#pragma unroll
        for (int ai = 0; ai < 2; ++ai)
#pragma unroll
            for (int m = 0; m < 4; ++m) {
                const int row = u.pm * BM + ai * HALF + wr * 64 + m * 16 + fr;
#pragma unroll
                for (int bj = 0; bj < 2; ++bj) {
                    const int col = u.pn * BM + bj * HALF + wc * 32 + 8 * fq;
                    const f32x4 v0 = acc[ai][bj][m][0], v1 = acc[ai][bj][m][1];
                    const u32x4 gg = *(const u32x4*)(gb + (size_t)row * DM + col);
                    const f32x4 t0 = *(const f32x4*)(t + (size_t)row * DM + col), t1 = *(const f32x4*)(t + (size_t)row * DM + col + 4);
                    float o[8];
                    o[0] = t0[0] + sigmoidf_(bflo(gg.x)) * v0[0]; o[1] = t0[1] + sigmoidf_(bfhi(gg.x)) * v0[1]; o[2] = t0[2] + sigmoidf_(bflo(gg.y)) * v0[2]; o[3] = t0[3] + sigmoidf_(bfhi(gg.y)) * v0[3];
                    o[4] = t1[0] + sigmoidf_(bflo(gg.z)) * v1[0]; o[5] = t1[1] + sigmoidf_(bfhi(gg.z)) * v1[1]; o[6] = t1[2] + sigmoidf_(bflo(gg.w)) * v1[2]; o[7] = t1[3] + sigmoidf_(bfhi(gg.w)) * v1[3];
                    u32x4 w; w.x = cvt_pk_bf16(o[0], o[1]); w.y = cvt_pk_bf16(o[2], o[3]); w.z = cvt_pk_bf16(o[4], o[5]); w.w = cvt_pk_bf16(o[6], o[7]);
                    *(u32x4*)(merged + (size_t)row * DM + col) = w;
                }
            }
    }
};
struct EpiOut {
    static constexpr bool PERM = true, AFTER_DRAIN = false;
    const float* x; float* x1; bf16_t* x1g; const float* mod; const float* g2; float* rowss;
    __device__ __forceinline__ void operator()(const f32x4 (&acc)[2][2][4][2], const Unit& u, int wr, int wc, int fr, int fq) const {
#pragma unroll
        for (int ai = 0; ai < 2; ++ai)
#pragma unroll
            for (int m = 0; m < 4; ++m) {
                const int row = u.pm * BM + ai * HALF + wr * 64 + m * 16 + fr;
                const float* modb = mod + (size_t)(row >> 12) * (6 * DM);
                float ss = 0.f;
#pragma unroll
                for (int bj = 0; bj < 2; ++bj) {
                    const int col = u.pn * BM + bj * HALF + wc * 32 + 8 * fq;
#pragma unroll
                    for (int n = 0; n < 2; ++n) {
                        const int cc = col + 4 * n;
                        const f32x4 v = acc[ai][bj][m][n];
                        const f32x4 xx = *(const f32x4*)(x + (size_t)row * DM + cc);
                        const f32x4 g1 = *(const f32x4*)(modb + 2 * DM + cc), sc = *(const f32x4*)(modb + 4 * DM + cc), gg = *(const f32x4*)(g2 + cc);
                        const f32x4 o = xx + g1 * v;
                        *(f32x4*)(x1 + (size_t)row * DM + cc) = o;
                        ss += o[0] * o[0] + o[1] * o[1] + o[2] * o[2] + o[3] * o[3];
                        const f32x4 og = o * gg * (sc + 1.f);
                        u32x2 w; w.x = cvt_pk_bf16(og[0], og[1]); w.y = cvt_pk_bf16(og[2], og[3]);
                        *(u32x2*)(x1g + (size_t)row * DM + cc) = w;
                    }
                }
                ss += __shfl_xor(ss, 16); ss += __shfl_xor(ss, 32);
                if (fq == 0) atomicAdd(rowss + row, ss);
            }
    }
};
struct EpiQ {
    static constexpr bool PERM = true, AFTER_DRAIN = false;
    bf16_t* qp; const float* rowss; const float* c2;
    __device__ __forceinline__ void operator()(const f32x4 (&acc)[2][2][4][2], const Unit& u, int wr, int wc, int fr, int fq) const {
#pragma unroll
        for (int ai = 0; ai < 2; ++ai)
#pragma unroll
            for (int m = 0; m < 4; ++m) {
                const int row = u.pm * BM + ai * HALF + wr * 64 + m * 16 + fr;
                const float rstd = rsqrtf(rowss[row] * (1.f / DM) + EPSN);
                const float* cb = c2 + (size_t)(row >> 12) * 2048;
#pragma unroll
                for (int bj = 0; bj < 2; ++bj) {
                    const int col = u.pn * BM + bj * HALF + wc * 32 + 8 * fq;
                    const f32x4 v0 = acc[ai][bj][m][0] * rstd + *(const f32x4*)(cb + col), v1 = acc[ai][bj][m][1] * rstd + *(const f32x4*)(cb + col + 4);
                    u32x4 w; w.x = cvt_pk_bf16(v0[0], v0[1]); w.y = cvt_pk_bf16(v0[2], v0[3]); w.z = cvt_pk_bf16(v1[0], v1[1]); w.w = cvt_pk_bf16(v1[2], v1[3]);
                    *(u32x4*)(qp + (size_t)row * 2048 + col) = w;
                }
            }
    }
};
struct EpiE {
    static constexpr bool PERM = true, AFTER_DRAIN = false;
    float* E;
    __device__ __forceinline__ void operator()(const f32x4 (&acc)[2][2][4][2], const Unit& u, int wr, int wc, int fr, int fq) const {
#pragma unroll
        for (int ai = 0; ai < 2; ++ai)
#pragma unroll
            for (int m = 0; m < 4; ++m) {
                const int row = u.pm * BM + ai * HALF + wr * 64 + m * 16 + fr;
#pragma unroll
                for (int bj = 0; bj < 2; ++bj) {
                    const int col = u.pn * BM + bj * HALF + wc * 32 + 8 * fq;
                    float* d = E + ((size_t)(u.g * SSM_ROWS + row) * 256 + col);
                    *(f32x4*)d = acc[ai][bj][m][0]; *(f32x4*)(d + 4) = acc[ai][bj][m][1];
                }
            }
    }
};
struct EpiZ {
    static constexpr bool PERM = true, AFTER_DRAIN = false;
    bf16_t* z;
    __device__ __forceinline__ void operator()(const f32x4 (&acc)[2][2][4][2], const Unit& u, int wr, int wc, int fr, int fq) const {
#pragma unroll
        for (int ai = 0; ai < 2; ++ai)
#pragma unroll
            for (int m = 0; m < 4; ++m) {
                const int n = u.pm * BM + ai * HALF + wr * 64 + m * 16 + fr;
                const size_t tok0 = (size_t)(n >> 7) * SEQL + (size_t)(n & 127) * 32;
#pragma unroll
                for (int bj = 0; bj < 2; ++bj) {
                    const int col = u.pn * BM + bj * HALF + wc * 32 + 8 * fq;
                    const f32x4 v0 = acc[ai][bj][m][0], v1 = acc[ai][bj][m][1];
                    u32x4 w; w.x = cvt_pk_bf16(gelu_tanh(v0[0]), gelu_tanh(v0[1])); w.y = cvt_pk_bf16(gelu_tanh(v0[2]), gelu_tanh(v0[3]));
                    w.z = cvt_pk_bf16(gelu_tanh(v1[0]), gelu_tanh(v1[1])); w.w = cvt_pk_bf16(gelu_tanh(v1[2]), gelu_tanh(v1[3]));
                    *(u32x4*)(z + (tok0 + (col >> 4)) * 512 + u.g * 16 + (col & 15)) = w;
                }
            }
    }
};
}

__device__ __forceinline__ void sincos_d(double th, double& s, double& c) {
    const double twopi = 6.283185307179586476925, hpi = 1.570796326794896619231;
    th -= twopi * rint(th / twopi);
    const double q = rint(th / hpi); const double y = th - q * hpi, y2 = y * y;
    const double sy = y * (1.0 - y2 / 6.0 * (1.0 - y2 / 20.0 * (1.0 - y2 / 42.0 * (1.0 - y2 / 72.0 * (1.0 - y2 / 110.0 * (1.0 - y2 / 156.0 * (1.0 - y2 / 210.0)))))));
    const double cy = 1.0 - y2 / 2.0 * (1.0 - y2 / 12.0 * (1.0 - y2 / 30.0 * (1.0 - y2 / 56.0 * (1.0 - y2 / 90.0 * (1.0 - y2 / 132.0 * (1.0 - y2 / 182.0))))));
    const int qi = ((int)q) & 3;
    s = qi == 0 ? sy : (qi == 1 ? cy : (qi == 2 ? -sy : -cy));
    c = qi == 0 ? cy : (qi == 1 ? -sy : (qi == 2 ? -cy : sy));
}
__device__ __forceinline__ void ssm_prep_item(const P& p, LAS unsigned char* lds, int item) {
    const int g = item >> 2, qtr = item & 3, tid = threadIdx.x;
    LAS f32x2* lamk = (LAS f32x2*)lds;
    LAS f32x2* Bb = lamk + 2 * 64 * 33;
    LAS f32x2* Cc = Bb + 2 * 64 * 16;
    LAS float* Kc = (LAS float*)(Cc + 2 * 16 * 64);
    if (tid < 128) {
        const int d = tid >> 6, pp = tid & 63, gi = d * 32 + g;
        const double are = (double)p.a_re[gi * 64 + pp], aim = (double)p.a_im[gi * 64 + pp];
        const double dt = (double)expf(p.log_dt[gi]);
        const double er = exp(are * dt); double sn, cs; sincos_d(aim * dt, sn, cs);
        const double lr = er * cs, li = er * sn;
        double pr = 1.0, pi_ = 0.0;
        for (int k = 0; k <= 32; ++k) {
            lamk[(d * 64 + pp) * 33 + k] = (f32x2){(float)pr, (float)pi_};
            const double nr_ = pr * lr - pi_ * li, ni_ = pr * li + pi_ * lr; pr = nr_; pi_ = ni_;
        }
        if (qtr == 0) { const f32x2 l32 = lamk[(d * 64 + pp) * 33 + 32]; *(f32x2*)(p.lamT + (size_t)(gi * 64 + pp) * 2) = l32; }
        const double nr = lr - 1.0, ni = li, den = are * are + aim * aim;
        const double qr = (nr * are + ni * aim) / den, qi = (ni * are - nr * aim) / den;
        for (int h = 0; h < 16; ++h) {
            const double br = (double)p.b_re[((size_t)gi * 64 + pp) * 16 + h], bi = (double)p.b_im[((size_t)gi * 64 + pp) * 16 + h];
            Bb[(d * 64 + pp) * 16 + h] = (f32x2){(float)(qr * br - qi * bi), (float)(qr * bi + qi * br)};
        }
    }
    for (int e = tid; e < 2 * 16 * 64; e += NT) {
        const int d = e >> 10, h = (e >> 6) & 15, pp = e & 63; const size_t src = ((size_t)(d * 32 + g) * 16 + h) * 64 + pp;
        Cc[e] = (f32x2){p.c_re[src], p.c_im[src]};
    }
    __syncthreads();
    for (int e = tid; e < 2 * 32 * 256; e += NT) {
        const int d = e >> 13, k = (e >> 8) & 31, h = (e >> 4) & 15, h2 = e & 15;
        float sacc = 0.f;
        for (int pp = 0; pp < 64; ++pp) {
            const f32x2 c = Cc[(d * 16 + h) * 64 + pp], l = lamk[(d * 64 + pp) * 33 + k], b = Bb[(d * 64 + pp) * 16 + h2];
            const float clr = c[0] * l[0] - c[1] * l[1], cli = c[0] * l[1] + c[1] * l[0];
            sacc += clr * b[0] - cli * b[1];
        }
        Kc[e] = sacc;
    }
    __syncthreads();
    for (int ch = tid; ch < 128 * 96; ch += NT) {
        const int mrow = 128 * qtr + ch / 96, k0 = (ch % 96) * 8, ii = mrow >> 4, h = mrow & 15;
        float v[8];
        if (k0 < 512) {
            const int jj = k0 >> 4, h20 = k0 & 15;
#pragma unroll
            for (int i = 0; i < 8; ++i) {
                const int h2 = h20 + i; float val = 0.f;
                if (ii >= jj) val += Kc[((0 * 32 + (ii - jj)) * 16 + h) * 16 + h2];
                if (jj >= ii) val += Kc[((1 * 32 + (jj - ii)) * 16 + h) * 16 + h2];
                if (ii == jj && h == h2) val += p.ssm_d[g * 16 + h];
                v[i] = val;
            }
        } else {
            const int sc = k0 - 512, d = sc >> 7, ri = (sc >> 6) & 1, p0 = sc & 63, e = d == 0 ? ii + 1 : 32 - ii;
#pragma unroll
            for (int i = 0; i < 8; ++i) {
                const int pp = p0 + i; const f32x2 c = Cc[(d * 16 + h) * 64 + pp], l = lamk[(d * 64 + pp) * 33 + e];
                const float clr = c[0] * l[0] - c[1] * l[1], cli = c[0] * l[1] + c[1] * l[0];
                v[i] = ri == 0 ? clr : -cli;
            }
        }
        u32x4 o; o.x = pk2(v[0], v[1]); o.y = pk2(v[2], v[3]); o.z = pk2(v[4], v[5]); o.w = pk2(v[6], v[7]);
        *(u32x4*)(p.Kmat + ((size_t)(g * 512 + mrow) * SSM_LD + k0)) = o;
    }
    for (int ch = tid; ch < 64 * 64; ch += NT) {
        const int nrow = 64 * qtr + ch / 64, k0 = (ch % 64) * 8, d = nrow >> 7, ri = (nrow >> 6) & 1, pp = nrow & 63;
        const int jj = k0 >> 4, h20 = k0 & 15, e = d == 0 ? 31 - jj : jj;
        const f32x2 l = lamk[(d * 64 + pp) * 33 + e];
        float v[8];
#pragma unroll
        for (int i = 0; i < 8; ++i) { const f32x2 b = Bb[(d * 64 + pp) * 16 + h20 + i]; v[i] = ri == 0 ? (l[0] * b[0] - l[1] * b[1]) : (l[0] * b[1] + l[1] * b[0]); }
        u32x4 o; o.x = pk2(v[0], v[1]); o.y = pk2(v[2], v[3]); o.z = pk2(v[4], v[5]); o.w = pk2(v[6], v[7]);
        *(u32x4*)(p.Win + ((size_t)(g * 256 + nrow) * 512 + k0)) = o;
    }
    __syncthreads();
}
__device__ __forceinline__ void ph_carry(const P& p) {
    const int tid = threadIdx.x;
    if (tid >= 128) return;
    for (int gidx = blockIdx.x * 128 + tid; gidx < 32 * 8 * 2 * 64; gidx += gridDim.x * 128) {
        const int pp = gidx & 63, d = (gidx >> 6) & 1, b = (gidx >> 7) & 7, g = gidx >> 10;
        const f32x2 lt = *(const f32x2*)(p.lamT + (size_t)((d * 32 + g) * 64 + pp) * 2);
        const float* Eg = p.E + (size_t)g * SSM_ROWS * 256 + d * 128 + pp;
        bf16_t* Ug = p.U + (size_t)g * SSM_ROWS * SSM_LD + 512 + d * 128 + pp;
        float fr = 0.f, fi = 0.f;
#pragma unroll
        for (int cc = 0; cc < 8; ++cc) {
            const int n = 1024 + b * 8 + (d == 0 ? cc : 7 - cc);
            const float er = Eg[(size_t)n * 256], ei = Eg[(size_t)n * 256 + 64];
            const float nr = lt[0] * fr - lt[1] * fi + er, ni = lt[0] * fi + lt[1] * fr + ei; fr = nr; fi = ni;
        }
#pragma unroll 8
        for (int c = 0; c < 128; ++c) {
            const int n = b * 128 + (d == 0 ? c : 127 - c);
            const float er = Eg[(size_t)n * 256], ei = Eg[(size_t)n * 256 + 64];
            Ug[(size_t)n * SSM_LD] = (bf16_t)f2bf(fr); Ug[(size_t)n * SSM_LD + 64] = (bf16_t)f2bf(fi);
            const float nr = lt[0] * fr - lt[1] * fi + er, ni = lt[0] * fi + lt[1] * fr + ei; fr = nr; fi = ni;
        }
    }
}


__device__ __forceinline__ void p0_transpose_item(const float* W, int K, int N, bf16_t* WT, LAS float* scr, int item, int lane) {
    const int nblk = N / 32, kb = item / nblk, nb = item % nblk, k0 = 64 * kb, n0 = 32 * nb;
#pragma unroll 8
    for (int i = 0; i < 32; ++i) { const int kk = 2 * i + (lane >> 5); scr[kk * 33 + (lane & 31)] = W[(size_t)(k0 + kk) * N + n0 + (lane & 31)]; }
    asm volatile("s_waitcnt lgkmcnt(0)" ::: "memory");
    const int c = lane & 7;
#pragma unroll
    for (int j = 0; j < 4; ++j) { const int n = (lane >> 3) + 8 * j; const LAS float* s = scr + (8 * c) * 33 + n;
        u32x4 o; o.x = pk2(s[0 * 33], s[1 * 33]); o.y = pk2(s[2 * 33], s[3 * 33]); o.z = pk2(s[4 * 33], s[5 * 33]); o.w = pk2(s[6 * 33], s[7 * 33]);
        *(u32x4*)(WT + (size_t)(n0 + n) * K + k0 + 8 * c) = o; }
    asm volatile("s_waitcnt lgkmcnt(0)" ::: "memory");
}

template <int NR, bool SILU>
__device__ __forceinline__ void gemv_block64(const float* const (&rows)[NR], const float* W, int ldw, int col0, const float* bias, float* y, int ldy, LAS float* scr) {
    const int wave = threadIdx.x >> 6, lane = threadIdx.x & 63;
    float acc[NR];
#pragma unroll
    for (int r = 0; r < NR; ++r) acc[r] = 0.f;
    const int kb = wave * 128;
#pragma unroll 4
    for (int k = kb; k < kb + 128; ++k) {
        const float w = W[(size_t)k * ldw + col0 + lane];
#pragma unroll
        for (int r = 0; r < NR; ++r) { const float s = rows[r][k]; acc[r] += (SILU ? siluf_(s) : s) * w; }
    }
#pragma unroll
    for (int r = 0; r < NR; ++r) scr[(wave * NR + r) * 64 + lane] = acc[r];
    __syncthreads();
    for (int e = threadIdx.x; e < NR * 64; e += NT) {
        const int r = e >> 6, l = e & 63; float s = 0.f;
#pragma unroll
        for (int w = 0; w < 8; ++w) s += scr[(w * NR + r) * 64 + l];
        y[(size_t)r * ldy + col0 + l] = s + (bias ? bias[col0 + l] : 0.f);
    }
    __syncthreads();
}

__device__ __forceinline__ void ph_prep(const P& p, LAS unsigned char* lds) {
    const int wave = threadIdx.x >> 6, lane = threadIdx.x & 63, G = gridDim.x;
    for (int cb = blockIdx.x; cb < 96; cb += G) {
        const float* const rows[9] = {p.c, p.c + DM, p.c + 2 * DM, p.c + 3 * DM, p.c + 4 * DM, p.c + 5 * DM, p.c + 6 * DM, p.c + 7 * DM, p.c_ctx};
        gemv_block64<9, true>(rows, p.w_mod, 6 * DM, cb * 64, p.b_mod, p.mod, 6 * DM, (LAS float*)lds);
    }
    for (int it = G - 1 - (int)blockIdx.x; it < 128; it += G) ssm_prep_item(p, lds, it);
    {
        LAS float* scr = (LAS float*)(lds + wave * 16384);
        const int gw = blockIdx.x * NWAVES + wave, NGW = G * NWAVES;
        constexpr int I_IN = (DM / 64) * (INC / 32), I_GLU = (512 / 64) * (512 / 32), I_A = (512 / 64) * (DM / 32), I_OUT = (DM / 64) * (DM / 32), I_Q = (DM / 64) * (2048 / 32);
        constexpr int NITEMS = I_IN + I_GLU + 2 * I_A + I_OUT + I_Q;
        for (int it = gw; it < NITEMS; it += NGW) {
            int r = it;
            if (r < I_IN) { p0_transpose_item(p.w_in, DM, INC, p.w_in_t, scr, r, lane); continue; } r -= I_IN;
            if (r < I_GLU) { p0_transpose_item(p.w_glu, 512, 512, p.w_glu_t, scr, r, lane); continue; } r -= I_GLU;
            if (r < I_A) { p0_transpose_item(p.w_a, 512, DM, p.w_a_t, scr, r, lane); continue; } r -= I_A;
            if (r < I_A) { p0_transpose_item(p.w_b, 512, DM, p.w_b_t, scr, r, lane); continue; } r -= I_A;
            if (r < I_OUT) { p0_transpose_item(p.w_out, DM, DM, p.w_out_t, scr, r, lane); continue; } r -= I_OUT;
            p0_transpose_item(p.w_q, DM, 2048, p.w_q_t, scr, r, lane);
        }
    }
    {
        const size_t nchunk = (size_t)16384 * DM / 8, gsz = (size_t)G * NT;
        for (size_t i = (size_t)blockIdx.x * NT + threadIdx.x; i < 2 * nchunk; i += gsz) {
            const bool second = i >= nchunk; const size_t j = second ? i - nchunk : i;
            const float* src = (second ? p.peer_v : p.peer_u) + j * 8;
            const f32x4 a = *(const f32x4*)src, b = *(const f32x4*)(src + 4);
            u32x4 o; o.x = pk2(a[0], a[1]); o.y = pk2(a[2], a[3]); o.z = pk2(b[0], b[1]); o.w = pk2(b[2], b[3]);
            *(u32x4*)((second ? p.pv : p.pu) + j * 8) = o;
        }
    }
}


__device__ __forceinline__ void normmod_row_bf16(const float* src, bf16_t* dst, const float* g, const float* shift, const float* scale, int lane) {
    const f32x4* s = (const f32x4*)src;
    f32x4 v[4]; float ss = 0.f;
#pragma unroll
    for (int j = 0; j < 4; ++j) { v[j] = s[lane + 64 * j]; ss += v[j][0] * v[j][0] + v[j][1] * v[j][1] + v[j][2] * v[j][2] + v[j][3] * v[j][3]; }
    ss = wave_sum(ss);
    const float rstd = rsqrtf(ss * (1.f / DM) + EPSN);
#pragma unroll
    for (int j = 0; j < 4; ++j) {
        const int i4 = lane + 64 * j;
        const f32x4 gg = ((const f32x4*)g)[i4], sh = ((const f32x4*)shift)[i4], sc = ((const f32x4*)scale)[i4];
        const f32x4 o = v[j] * rstd * gg * (sc + 1.f) + sh;
        u32x2 w; w.x = pk2(o[0], o[1]); w.y = pk2(o[2], o[3]);
        *(u32x2*)(dst + (size_t)i4 * 4) = w;
    }
}
__device__ __forceinline__ void ph_norm1(const P& p, LAS unsigned char* lds) {
    const int wave = threadIdx.x >> 6, lane = threadIdx.x & 63, G = gridDim.x;
    for (int cb = blockIdx.x; cb < 32; cb += G) {
        const float* m3 = p.mod + 3 * DM;
        const float* const rows[8] = {m3, m3 + 6 * DM, m3 + 12 * DM, m3 + 18 * DM, m3 + 24 * DM, m3 + 30 * DM, m3 + 36 * DM, m3 + 42 * DM};
        gemv_block64<8, false>(rows, p.w_q, 2048, cb * 64, nullptr, p.c2, 2048, (LAS float*)lds);
    }
    for (int r = blockIdx.x * NWAVES + wave; r < NTOK + NCTX; r += G * NWAVES) {
        if (r < NTOK) { const float* modb = p.mod + (size_t)(r >> 12) * (6 * DM); normmod_row_bf16(p.x + (size_t)r * DM, p.hx + (size_t)r * DM, p.norm1_g, modb, modb + DM, lane); }
        else { const int rc = r - NTOK; const float* modc = p.mod + 8 * (6 * DM); normmod_row_bf16(p.ctx + (size_t)rc * DM, p.hc + (size_t)rc * DM, p.norm1_g, modc, modc + DM, lane); }
    }
}

__device__ __forceinline__ void ph_na_naive(const P& p) {
    const int tid = threadIdx.x, hh = tid >> 7, col = (tid >> 1) & 63, half = tid & 1;
    for (int it = blockIdx.x; it < NB * GW * 2; it += gridDim.x) {
        const int b = it >> 7, r = (it >> 1) & 63, head = (it & 1) * 4 + hh;
        int r0 = r - 4; r0 = r0 < 0 ? 0 : (r0 > 56 ? 56 : r0);
        int c0 = col - 8; c0 = c0 < 0 ? 0 : (c0 > 48 ? 48 : c0);
        const size_t tq = (size_t)b * SEQL + r * GW + col;
        const int doff = head * 64 + half * 32;
        float q[32], o[32];
        {
            const u32x4* qp = (const u32x4*)(p.qb + tq * 512 + doff);
#pragma unroll
            for (int d = 0; d < 4; ++d) { const u32x4 v = qp[d]; q[8 * d] = bflo(v.x); q[8 * d + 1] = bfhi(v.x); q[8 * d + 2] = bflo(v.y); q[8 * d + 3] = bfhi(v.y); q[8 * d + 4] = bflo(v.z); q[8 * d + 5] = bfhi(v.z); q[8 * d + 6] = bflo(v.w); q[8 * d + 7] = bfhi(v.w); }
        }
#pragma unroll
        for (int d = 0; d < 32; ++d) o[d] = 0.f;
        float m = -INFINITY, l = 0.f;
        for (int kk = 0; kk < 128 + CTXL; ++kk) {
            const bf16_t* kp; const bf16_t* vp; float bias = 0.f;
            if (kk < 128) {
                const int i = kk >> 4, cc = kk & 15, krow = r0 + i, kcol = c0 + cc;
                const size_t tk = (size_t)b * SEQL + krow * GW + kcol;
                kp = p.kb + tk * 512 + doff; vp = p.vb + tk * 512 + doff;
                bias = p.rpb[(head * 15 + (krow - r + 7)) * 31 + (kcol - col + 15)];
            } else {
                const size_t j = (size_t)b * CTXL + (kk - 128);
                kp = p.kc + j * 512 + doff; vp = p.vc + j * 512 + doff;
            }
            float s = 0.f;
#pragma unroll
            for (int d = 0; d < 4; ++d) { const u32x4 v = ((const u32x4*)kp)[d];
                s += q[8 * d] * bflo(v.x) + q[8 * d + 1] * bfhi(v.x) + q[8 * d + 2] * bflo(v.y) + q[8 * d + 3] * bfhi(v.y) + q[8 * d + 4] * bflo(v.z) + q[8 * d + 5] * bfhi(v.z) + q[8 * d + 6] * bflo(v.w) + q[8 * d + 7] * bfhi(v.w); }
            s += __shfl_xor(s, 1);
            s = s * 0.125f + bias;
            const float mn = fmaxf(m, s);
            const float corr = __expf(m - mn), pe = __expf(s - mn);
            l = l * corr + pe;
#pragma unroll
            for (int d = 0; d < 4; ++d) { const u32x4 v = ((const u32x4*)vp)[d];
                o[8 * d] = o[8 * d] * corr + pe * bflo(v.x); o[8 * d + 1] = o[8 * d + 1] * corr + pe * bfhi(v.x); o[8 * d + 2] = o[8 * d + 2] * corr + pe * bflo(v.y); o[8 * d + 3] = o[8 * d + 3] * corr + pe * bfhi(v.y);
                o[8 * d + 4] = o[8 * d + 4] * corr + pe * bflo(v.z); o[8 * d + 5] = o[8 * d + 5] * corr + pe * bfhi(v.z); o[8 * d + 6] = o[8 * d + 6] * corr + pe * bflo(v.w); o[8 * d + 7] = o[8 * d + 7] * corr + pe * bfhi(v.w); }
            m = mn;
        }
        const float inv = 1.f / l;
        u32x4* op = (u32x4*)(p.na + tq * 512 + doff);
#pragma unroll
        for (int d = 0; d < 4; ++d) { u32x4 w; w.x = pk2(o[8 * d] * inv, o[8 * d + 1] * inv); w.y = pk2(o[8 * d + 2] * inv, o[8 * d + 3] * inv); w.z = pk2(o[8 * d + 4] * inv, o[8 * d + 5] * inv); w.w = pk2(o[8 * d + 6] * inv, o[8 * d + 7] * inv); op[d] = w; }
    }
}

__device__ __forceinline__ void ph_peer_naive(const P& p) {
    const int wave = threadIdx.x >> 6, lane = threadIdx.x & 63;
    const float NEG = -INFINITY;
    for (int tok = blockIdx.x * NWAVES + wave; tok < NTOK; tok += gridDim.x * NWAVES) {
        const int b = tok >> 12;
        const float* modb = p.mod + (size_t)b * (6 * DM);
        const bf16_t* qrow = p.qp + (size_t)tok * 2048;
        float hv[16], acc[16], x1v[16];
        const float rstd2 = rsqrtf(p.rowss[tok] * (1.f / DM) + EPSN);
#pragma unroll
        for (int j = 0; j < 2; ++j)
#pragma unroll
            for (int q4 = 0; q4 < 2; ++q4) {
                const int e0 = j * 512 + lane * 8 + q4 * 4;
                const f32x4 xv = *(const f32x4*)(p.out + (size_t)tok * DM + e0), gg = *(const f32x4*)(p.norm2_g + e0), sh = *(const f32x4*)(modb + 3 * DM + e0), sc = *(const f32x4*)(modb + 4 * DM + e0);
#pragma unroll
                for (int i = 0; i < 4; ++i) { x1v[j * 8 + q4 * 4 + i] = xv[i]; hv[j * 8 + q4 * 4 + i] = xv[i] * rstd2 * gg[i] * (1.f + sc[i]) + sh[i]; acc[j * 8 + q4 * 4 + i] = 0.f; }
            }
        for (int h = 0; h < 8; ++h) {
            float stop0 = NEG, stop1 = NEG; int itop0 = 0, itop1 = 0;
            for (int n = 0; n < 2; ++n) {
                const bf16_t* qh = qrow + h * 256 + n * 128;
                const f32x4* k0 = (const f32x4*)(p.subkeys + ((size_t)(n * 128 + lane)) * 128);
                const f32x4* k1 = (const f32x4*)(p.subkeys + ((size_t)(n * 128 + lane + 64)) * 128);
                float s0 = 0.f, s1 = 0.f;
                for (int d = 0; d < 16; ++d) {
                    const u32x4 qv = *(const u32x4*)(qh + d * 8);
                    const f32x4 a0 = k0[2 * d], a1 = k0[2 * d + 1], c0 = k1[2 * d], c1 = k1[2 * d + 1];
                    const float q0 = bflo(qv.x), q1 = bfhi(qv.x), q2 = bflo(qv.y), q3 = bfhi(qv.y), q4 = bflo(qv.z), q5 = bfhi(qv.z), q6 = bflo(qv.w), q7 = bfhi(qv.w);
                    s0 += q0 * a0[0] + q1 * a0[1] + q2 * a0[2] + q3 * a0[3] + q4 * a1[0] + q5 * a1[1] + q6 * a1[2] + q7 * a1[3];
                    s1 += q0 * c0[0] + q1 * c0[1] + q2 * c0[2] + q3 * c0[3] + q4 * c1[0] + q5 * c1[1] + q6 * c1[2] + q7 * c1[3];
                }
                float mytop = NEG; int myidx = 0;
                for (int r = 0; r < 16; ++r) {
                    const float lv = fmaxf(s0, s1);
                    const float mx = wave_max(lv);
                    const unsigned long long bal = __ballot(lv == mx);
                    const int owner = __ffsll((long long)bal) - 1;
                    const int li = (s0 >= s1) ? lane : lane + 64;
                    const int idx = __shfl(li, owner);
                    if (lane == r) { mytop = mx; myidx = idx; }
                    if (lane == owner) { if (s0 >= s1) s0 = NEG; else s1 = NEG; }
                }
                if (n == 0) { stop0 = mytop; itop0 = myidx; } else { stop1 = mytop; itop1 = myidx; }
            }
            float cv0, cv1, cv2, cv3; int ce0, ce1, ce2, ce3;
            {
                const int jj = lane & 15, ib = lane >> 4;
                const float sj = __shfl(stop1, jj); const int ij = __shfl(itop1, jj);
                cv0 = __shfl(stop0, ib) + sj;      ce0 = __shfl(itop0, ib) * 128 + ij;
                cv1 = __shfl(stop0, ib + 4) + sj;  ce1 = __shfl(itop0, ib + 4) * 128 + ij;
                cv2 = __shfl(stop0, ib + 8) + sj;  ce2 = __shfl(itop0, ib + 8) * 128 + ij;
                cv3 = __shfl(stop0, ib + 12) + sj; ce3 = __shfl(itop0, ib + 12) * 128 + ij;
            }
            float best = NEG; int expert = 0;
            for (int r = 0; r < 16; ++r) {
                const float lv = fmaxf(fmaxf(cv0, cv1), fmaxf(cv2, cv3));
                const float mx = wave_max(lv);
                const unsigned long long bal = __ballot(lv == mx);
                const int owner = __ffsll((long long)bal) - 1;
                const int wm = (cv0 == lv) ? 0 : ((cv1 == lv) ? 1 : ((cv2 == lv) ? 2 : 3));
                const int le = wm == 0 ? ce0 : (wm == 1 ? ce1 : (wm == 2 ? ce2 : ce3));
                const int eid = __shfl(le, owner);
                if (lane == r) { best = mx; expert = eid; }
                if (lane == owner) { if (wm == 0) cv0 = NEG; else if (wm == 1) cv1 = NEG; else if (wm == 2) cv2 = NEG; else cv3 = NEG; }
            }
            const float m16 = wave_max(lane < 16 ? best : NEG);
            const float ex = lane < 16 ? __expf(best - m16) : 0.f;
            const float gsum = wave_sum(ex);
            const float gate = ex / gsum;
            for (int k = 0; k < 16; ++k) {
                const int e = __shfl(expert, k);
                const float gk = __shfl(gate, k);
                const bf16_t* ur = p.pu + (size_t)e * DM; const bf16_t* vr = p.pv + (size_t)e * DM;
                float part = 0.f;
#pragma unroll
                for (int j = 0; j < 2; ++j) { const u32x4 uu = *(const u32x4*)(ur + j * 512 + lane * 8);
                    part += hv[j * 8] * bflo(uu.x) + hv[j * 8 + 1] * bfhi(uu.x) + hv[j * 8 + 2] * bflo(uu.y) + hv[j * 8 + 3] * bfhi(uu.y) + hv[j * 8 + 4] * bflo(uu.z) + hv[j * 8 + 5] * bfhi(uu.z) + hv[j * 8 + 6] * bflo(uu.w) + hv[j * 8 + 7] * bfhi(uu.w); }
                const float a = wave_sum(part);
                const float w = gk * gelu_tanh(a);
#pragma unroll
                for (int j = 0; j < 2; ++j) { const u32x4 vv = *(const u32x4*)(vr + j * 512 + lane * 8);
                    acc[j * 8] += w * bflo(vv.x); acc[j * 8 + 1] += w * bfhi(vv.x); acc[j * 8 + 2] += w * bflo(vv.y); acc[j * 8 + 3] += w * bfhi(vv.y); acc[j * 8 + 4] += w * bflo(vv.z); acc[j * 8 + 5] += w * bfhi(vv.z); acc[j * 8 + 6] += w * bflo(vv.w); acc[j * 8 + 7] += w * bfhi(vv.w); }
            }
        }
        float ss = 0.f;
#pragma unroll
        for (int j = 0; j < 2; ++j)
#pragma unroll
            for (int q4 = 0; q4 < 2; ++q4) {
                const int e0 = j * 512 + lane * 8 + q4 * 4;
                const f32x4 g2 = *(const f32x4*)(modb + 5 * DM + e0);
#pragma unroll
                for (int i = 0; i < 4; ++i) { const int ix = j * 8 + q4 * 4 + i; x1v[ix] = x1v[ix] + g2[i] * acc[ix]; ss += x1v[ix] * x1v[ix]; }
            }
        ss = wave_sum(ss);
        const float rstd = rsqrtf(ss * (1.f / DM) + EPSN);
#pragma unroll
        for (int j = 0; j < 2; ++j)
#pragma unroll
            for (int q4 = 0; q4 < 2; ++q4) {
                const int e0 = j * 512 + lane * 8 + q4 * 4;
                const f32x4 fg = *(const f32x4*)(p.final_g + e0);
                f32x4 o;
#pragma unroll
                for (int i = 0; i < 4; ++i) o[i] = x1v[j * 8 + q4 * 4 + i] * rstd * fg[i];
                *(f32x4*)(p.out + (size_t)tok * DM + e0) = o;
            }
    }
}

constexpr int LDS_BYTES = 147456;
#define GSYNC() cg::this_grid().sync()

__global__ void __launch_bounds__(NT, 2) mega(P p) {
    extern __shared__ __attribute__((aligned(16))) unsigned char lds_raw[];
    LAS unsigned char* lds = (LAS unsigned char*)lds_raw;
    const int G = gridDim.x, bx = blockIdx.x;
    using namespace pg8;

    ph_prep(p, lds);
    GSYNC();
    ph_norm1(p, lds);
    GSYNC();
    {
        Gemm<DM, DM, DM> g{p.hx, p.w_in_t}; StaticOrder<NTOK, INC> S; S.init(G, bx);
        EpiInProj E{p.U, p.kb, (size_t)NTOK * 512, p.ga, 0};
        gemm_phase<EpiInProj, StaticOrder<NTOK, INC>, true, true>(lds, g, S, E);
        Gemm<DM, DM, DM> g2{p.hc, p.w_in_t}; StaticOrder<NCTX, CTXC> S2; S2.init(G, bx);
        EpiInProj E2{p.U, p.kc, (size_t)NCTX * 512, p.ga, 1};
        gemm_phase<EpiInProj, StaticOrder<NCTX, CTXC>, true, true>(lds, g2, S2, E2);
    }
    GSYNC();
    {
        Gemm<512, SSM_LD, 512, (long)SSM_ROWS * SSM_LD, 256L * 512> g{p.U, p.Win}; StaticOrder<SSM_ROWS, 256, 32> S; S.init(G, bx);
        EpiE E{p.E};
        gemm_phase<EpiE, StaticOrder<SSM_ROWS, 256, 32>, true, true>(lds, g, S, E);
    }
    GSYNC();
    ph_carry(p);
    ph_na_naive(p);
    GSYNC();
    {
        Gemm<SSM_LD, SSM_LD, SSM_LD, (long)SSM_ROWS * SSM_LD, 512L * SSM_LD> g{p.U, p.Kmat}; StaticOrder<1024, 512, 32> S; S.init(G, bx);
        EpiZ E{p.z};
        gemm_phase<EpiZ, StaticOrder<1024, 512, 32>, true, true>(lds, g, S, E);
    }
    GSYNC();
    {
        Gemm<512, 512, 512> g{p.z, p.w_glu_t}; StaticOrder<NTOK, 512> S; S.init(G, bx);
        EpiGlu E{p.gl, p.z, p.b_glu};
        gemm_phase<EpiGlu, StaticOrder<NTOK, 512>, true, true>(lds, g, S, E);
    }
    GSYNC();
    {
        Gemm<512, 512, 512> g{p.gl, p.w_a_t}; StaticOrder<NTOK, DM> S; S.init(G, bx);
        EpiBrA E{p.tbuf, p.ga};
        gemm_phase<EpiBrA, StaticOrder<NTOK, DM>, true, true>(lds, g, S, E);
        Gemm<512, 512, 512> g2{p.na, p.w_b_t};
        EpiBrB E2{p.merged, p.tbuf, p.gb};
        gemm_phase<EpiBrB, StaticOrder<NTOK, DM>, true, true>(lds, g2, S, E2);
    }
    GSYNC();
    {
        Gemm<DM, DM, DM> g{p.merged, p.w_out_t}; StaticOrder<NTOK, DM> S; S.init(G, bx);
        EpiOut E{p.x, p.out, p.x1g, p.mod, p.norm2_g, p.rowss};
        gemm_phase<EpiOut, StaticOrder<NTOK, DM>, true, true>(lds, g, S, E);
    }
    GSYNC();
    {
        Gemm<DM, DM, DM> g{p.x1g, p.w_q_t}; StaticOrder<NTOK, 2048> S; S.init(G, bx);
        EpiQ E{p.qp, p.rowss, p.c2};
        gemm_phase<EpiQ, StaticOrder<NTOK, 2048>, true, true>(lds, g, S, E);
    }
    GSYNC();
    ph_peer_naive(p);
}

extern "C" void kernel_launch(void* const* d_in, const int* in_sizes, int n_in, void* d_out, int out_size, void* d_ws, size_t ws_size, hipStream_t stream) {
    static int grid = 0;
    if (grid == 0) {
        int dev = 0, cus = 0, per_cu = 0;
        (void)hipGetDevice(&dev);
        (void)hipDeviceGetAttribute(&cus, hipDeviceAttributeMultiprocessorCount, dev);
        (void)hipFuncSetAttribute((const void*)mega, hipFuncAttributeMaxDynamicSharedMemorySize, LDS_BYTES);
        (void)hipOccupancyMaxActiveBlocksPerMultiprocessor(&per_cu, (const void*)mega, NT, LDS_BYTES);
        if (per_cu < 1) { fprintf(stderr, "occupancy query says %d blocks per CU\n", per_cu); per_cu = 1; }
        grid = cus;
    }
    P p{};
    const float* const* in = (const float* const*)d_in;
    p.x = in[0]; p.c = in[1]; p.ctx = in[2]; p.c_ctx = in[3]; p.w_mod = in[4]; p.b_mod = in[5]; p.norm1_g = in[6]; p.norm2_g = in[7]; p.w_in = in[8];
    p.a_re = in[9]; p.a_im = in[10]; p.log_dt = in[11]; p.b_re = in[12]; p.b_im = in[13]; p.c_re = in[14]; p.c_im = in[15]; p.ssm_d = in[16];
    p.w_glu = in[17]; p.b_glu = in[18]; p.w_a = in[19]; p.w_b = in[20]; p.rpb = in[21]; p.w_out = in[22]; p.w_q = in[23]; p.subkeys = in[24];
    p.peer_u = in[25]; p.peer_v = in[26]; p.final_g = in[27];
    p.out = (float*)d_out;
    unsigned char* ws = (unsigned char*)d_ws; unsigned char* ob = (unsigned char*)d_out;
    constexpr size_t MiB = 1u << 20;
    p.rowss = (float*)(ws + 512 * 1024);
    p.mod = (float*)(ws + 1 * MiB); p.c2 = (float*)(ws + 1 * MiB + 256 * 1024);
    p.w_in_t = (bf16_t*)(ws + 3 * MiB); p.w_glu_t = (bf16_t*)(ws + 11 * MiB); p.w_a_t = (bf16_t*)(ws + 12 * MiB); p.w_b_t = (bf16_t*)(ws + 13 * MiB);
    p.w_out_t = (bf16_t*)(ws + 14 * MiB); p.w_q_t = (bf16_t*)(ws + 16 * MiB);
    p.pu = (bf16_t*)(ws + 54 * MiB); p.pv = (bf16_t*)(ws + 86 * MiB);
    p.ga = (bf16_t*)(ws + 118 * MiB); p.gb = (bf16_t*)(ws + 182 * MiB);
    p.kb = (bf16_t*)(ws + 246 * MiB); p.vb = (bf16_t*)(ws + 278 * MiB); p.qb = (bf16_t*)(ws + 310 * MiB); p.kc = (bf16_t*)(ws + 342 * MiB); p.vc = (bf16_t*)(ws + 344 * MiB);
    p.U = (bf16_t*)(ws + 346 * MiB);
    p.Kmat = (bf16_t*)(ws + 21 * MiB); p.Win = (bf16_t*)(ws + 45 * MiB); p.lamT = (float*)(ws + 53 * MiB); p.E = (float*)(ws + 406 * MiB);
    p.na = (bf16_t*)ob; p.z = (bf16_t*)(ob + 32 * MiB); p.gl = (bf16_t*)(ob + 64 * MiB);
    p.hx = (bf16_t*)ob; p.hc = (bf16_t*)(ob + 64 * MiB);
    p.merged = (bf16_t*)(ws + 246 * MiB); p.tbuf = (float*)(ws + 310 * MiB);
    p.x1g = (bf16_t*)(ws + 118 * MiB);
    p.qp = (bf16_t*)(ws + 246 * MiB);
    (void)hipMemsetAsync(ws, 0, 1 * MiB, stream);
    void* args[] = {&p};
    hipError_t e = hipLaunchCooperativeKernel((const void*)mega, dim3(grid), dim3(NT), args, LDS_BYTES, stream);
    if (e != hipSuccess) fprintf(stderr, "cooperative launch failed: %s (grid %d)\n", hipGetErrorString(e), grid);
}
```

```cpp
#include <hip/hip_runtime.h>
#include <hip/hip_cooperative_groups.h>
#include <cstdio>
#include <cstdint>
namespace cg = cooperative_groups;

#define LAS __attribute__((address_space(3)))
typedef unsigned short bf16_t;
typedef short bf16x8 __attribute__((ext_vector_type(8)));
typedef float f32x4 __attribute__((ext_vector_type(4)));
typedef float f32x2 __attribute__((ext_vector_type(2)));
typedef unsigned u32x4 __attribute__((ext_vector_type(4)));
typedef unsigned u32x2 __attribute__((ext_vector_type(2)));

constexpr int DM = 1024, NB = 8, SEQL = 4096, CTXL = 256, GW = 64, NTOK = NB * SEQL, NCTX = NB * CTXL;
constexpr int INC = 4096, CTXC = 1536;
constexpr int NT = 512, NWAVES = 8;
constexpr float EPSN = 1e-6f;
constexpr int SSM_ROWS = 1280;
constexpr int SSM_LD = 768;

__device__ __forceinline__ unsigned f2bf(float f) { unsigned u = __builtin_bit_cast(unsigned, f); return (u + 0x7fffu + ((u >> 16) & 1u)) >> 16; }
__device__ __forceinline__ unsigned pk2(float lo, float hi) { return f2bf(lo) | (f2bf(hi) << 16); }
__device__ __forceinline__ float bflo(unsigned w) { return __builtin_bit_cast(float, w << 16); }
__device__ __forceinline__ float bfhi(unsigned w) { return __builtin_bit_cast(float, w & 0xffff0000u); }
__device__ __forceinline__ float bf2f(bf16_t h) { return __builtin_bit_cast(float, (unsigned)h << 16); }

__device__ __forceinline__ float wave_sum(float v) {
#pragma unroll
    for (int o = 1; o < 64; o <<= 1) v += __shfl_xor(v, o);
    return v;
}
__device__ __forceinline__ float wave_max(float v) {
#pragma unroll
    for (int o = 1; o < 64; o <<= 1) v = fmaxf(v, __shfl_xor(v, o));
    return v;
}
__device__ __forceinline__ float sigmoidf_(float x) { return 1.f / (1.f + __expf(-x)); }
__device__ __forceinline__ float siluf_(float x) { return x / (1.f + __expf(-x)); }
__device__ __forceinline__ float gelu_tanh(float x) {
    const float k0 = 0.7978845608028654f, k1 = 0.044715f;
    const float u = k0 * (x + k1 * x * x * x);
    const float t = 1.f - 2.f / (1.f + __expf(2.f * u));
    return 0.5f * x * (1.f + t);
}

namespace pg8 {
#define PG8_LAS __attribute__((address_space(3)))
constexpr int BM = 256, BK = 64, HALF = 128, HTB = HALF * BK * 2  , STAGE_BYTES = 8 * HTB, NXCD = 8, WGM = 8;
__host__ __device__ __forceinline__ int lds_byte(int r, int c) { const int st = (r >> 4) * 2 + (c >> 5), rr = r & 15, cc = c & 31, ob = rr * 64 + cc * 2; return st * 1024 + (ob ^ (((ob >> 9) & 1) << 5)); }
__host__ __device__ __forceinline__ void stage_rc(int b, int& R, int& C) { const int st = b / 1024, sb = b % 1024, swz = sb ^ (((sb >> 9) & 1) << 5); R = (st >> 1) * 16 + swz / 64; C = (st & 1) * 32 + (swz % 64) / 2; }
__host__ __device__ __forceinline__ int perm32(int rho) { const int n = rho >> 4, i = rho & 15; return 8 * (i >> 2) + 4 * n + (i & 3); }

struct Unit { int pm, pn, g; };
template <int K_, int LDA, int LDB, long GSA = 0, long GSB = 0>
struct Gemm {
    const bf16_t* A; const bf16_t* Bt;
    static constexpr int K = K_, lda = LDA, ldb = LDB;
    __device__ __forceinline__ const char* abase(const Unit& u) const { return (const char*)(A + (size_t)u.g * GSA + (size_t)u.pm * BM * LDA); }
    __device__ __forceinline__ const char* bbase(const Unit& u) const { return (const char*)(Bt + (size_t)u.g * GSB + (size_t)u.pn * BM * LDB); }
};
template <int M, int N, int NGRP = 1>
struct StaticOrder {
    static constexpr int nM = M / BM, nN = N / BM, nwg = nM * nN;
    int G, c;
    __device__ void init(int G_, int c_) { G = G_; c = c_; }
    __device__ bool next(int i, Unit& u) const {
        const int L = i * G + c; if (L >= nwg * NGRP) return false;
        u.g = L / nwg;
        int wgid = L % nwg; { constexpr int q = nwg / NXCD, r = nwg % NXCD; const int xcd = wgid % NXCD, off = wgid / NXCD; wgid = (xcd < r ? xcd * (q + 1) : r * (q + 1) + (xcd - r) * q) + off; }
        constexpr int nig = WGM * nN; const int gid = wgid / nig, fm = gid * WGM, gsz = (nM - fm) < WGM ? (nM - fm) : WGM;
        u.pm = fm + ((wgid % nig) % gsz); u.pn = (wgid % nig) / gsz; return true;
    }
    __device__ __forceinline__ void a_ready(const Unit&) const {}
    __device__ __forceinline__ void done(const Unit&) const {}
};
__device__ __forceinline__ unsigned cvt_pk_bf16(float lo, float hi) { unsigned r; asm volatile("v_cvt_pk_bf16_f32 %0, %1, %2" : "=v"(r) : "v"(lo), "v"(hi)); return r; }
template <class Epi, class Sched, bool ALIGN_EPI = false, bool SP2 = false, class GemmT>
__device__ __forceinline__ void gemm_phase(PG8_LAS unsigned char* lds, const GemmT g, const Sched& S, const Epi& E) {
    const int tid = threadIdx.x, wid = __builtin_amdgcn_readfirstlane(tid >> 6), lane = tid & 63, wr = wid >> 2, wc = wid & 3, fr = lane & 15, fq = lane >> 4;
    const int K = g.K, nt = K / BK;
    unsigned voffA[2], voffB[2];
#pragma unroll
    for (int i = 0; i < 2; ++i) { int R, C; stage_rc(tid * 16 + i * 8192, R, C); const int Rb = Epi::PERM ? ((R & ~31) + perm32(R & 31)) : R;
        voffA[i] = (unsigned)(R * g.lda + C) * 2u; voffB[i] = (unsigned)(Rb * g.ldb + C) * 2u; }
    const size_t kstep = (size_t)(BK * 2);
    const size_t hstepA = (size_t)HALF * g.lda * 2, hstepB = (size_t)HALF * g.ldb * 2;
    const unsigned ldsw = (unsigned)wid * 1024u;
    const int aoff = lds_byte(wr * 64 + fr, fq * 8), boff = lds_byte(wc * 32 + fr, fq * 8);
#define PG8_SA(b, h) (((b) * 2 + (h)) * HTB)
#define PG8_SB(b, h) ((4 + (b) * 2 + (h)) * HTB)
#define PG8_STAGE(bufoff, gbase, voff) do { _Pragma("unroll") for (int _i = 0; _i < 2; ++_i) \
        __builtin_amdgcn_global_load_lds((const unsigned*)((const char*)(gbase) + (voff)[_i]), (PG8_LAS unsigned*)(lds + (bufoff) + ldsw + _i * 8192), 16, 0, 0); } while (0)
#define PG8_LDA(dst, b, h) do { _Pragma("unroll") for (int m = 0; m < 4; ++m) _Pragma("unroll") for (int k = 0; k < 2; ++k) dst[m][k] = *(const PG8_LAS bf16x8*)(lds + PG8_SA(b, h) + aoff + m * 2048 + k * 1024); } while (0)
#define PG8_LDB(dst, b, h) do { _Pragma("unroll") for (int n = 0; n < 2; ++n) _Pragma("unroll") for (int k = 0; k < 2; ++k) dst[n][k] = *(const PG8_LAS bf16x8*)(lds + PG8_SB(b, h) + boff + n * 2048 + k * 1024); } while (0)
#define PG8_MMA(ai, bj, At, Bt) do { __builtin_amdgcn_s_setprio(1); _Pragma("unroll") for (int m = 0; m < 4; ++m) _Pragma("unroll") for (int n = 0; n < 2; ++n) _Pragma("unroll") for (int k = 0; k < 2; ++k) \
        acc[ai][bj][m][n] = __builtin_amdgcn_mfma_f32_16x16x32_bf16(Bt[n][k], At[m][k], acc[ai][bj][m][n], 0, 0, 0); __builtin_amdgcn_s_setprio(0); } while (0)
#define PG8_WAIT_V(n) asm volatile("s_waitcnt vmcnt(" #n ")" ::: "memory")
#define PG8_WAIT_L(n) asm volatile("s_waitcnt lgkmcnt(" #n ")" ::: "memory")
#define PG8_BAR __builtin_amdgcn_s_barrier()
#define PG8_SCHED __builtin_amdgcn_sched_barrier(0)
    Unit cur, nxt; int ui = 0;
    if (!S.next(0, cur)) return;
    f32x4 acc[2][2][4][2];
#pragma unroll
    for (int a = 0; a < 2; ++a)
#pragma unroll
        for (int b = 0; b < 2; ++b)
#pragma unroll
            for (int m = 0; m < 4; ++m)
#pragma unroll
                for (int n = 0; n < 2; ++n) acc[a][b][m][n] = (f32x4){0.f, 0.f, 0.f, 0.f};
    bf16x8 At[4][2], B0[2][2], B1[2][2];
    const char* cA = g.abase(cur); const char* cB = g.bbase(cur);
    S.a_ready(cur);
    if constexpr (SP2) {
        PG8_STAGE(PG8_SB(0, 0), cB, voffB); PG8_STAGE(PG8_SB(0, 1), cB + hstepB, voffB); PG8_STAGE(PG8_SA(0, 0), cA, voffA); PG8_STAGE(PG8_SA(0, 1), cA + hstepA, voffA);
        if (wr == 1) PG8_BAR;
        PG8_WAIT_V(2); PG8_BAR;
        PG8_STAGE(PG8_SB(1, 0), cB + kstep, voffB); PG8_STAGE(PG8_SA(1, 0), cA + kstep, voffA); PG8_STAGE(PG8_SB(1, 1), cB + hstepB + kstep, voffB);
        PG8_WAIT_V(6); PG8_BAR;
    } else {
        PG8_STAGE(PG8_SB(0, 0), cB, voffB); PG8_STAGE(PG8_SA(0, 0), cA, voffA); PG8_STAGE(PG8_SB(0, 1), cB + hstepB, voffB); PG8_STAGE(PG8_SA(0, 1), cA + hstepA, voffA);
        if (wr == 1) PG8_BAR;
        PG8_WAIT_V(4); PG8_BAR;
        PG8_STAGE(PG8_SB(1, 0), cB + kstep, voffB); PG8_STAGE(PG8_SA(1, 0), cA + kstep, voffA); PG8_STAGE(PG8_SB(1, 1), cB + hstepB + kstep, voffB);
        PG8_WAIT_V(6); PG8_BAR;
    }
    for (;;) {
        const bool has_next = S.next(ui + 1, nxt);
        const char* nA = has_next ? g.abase(nxt) : cA; const char* nB = has_next ? g.bbase(nxt) : cB;
        for (int t = 0; t < nt; t += 2) {
            const bool last = (t == nt - 2);
            const char* a1 = cA + (size_t)(t + 1) * kstep;
            const char* a2 = last ? nA : cA + (size_t)(t + 2) * kstep; const char* b2 = last ? nB : cB + (size_t)(t + 2) * kstep;
            const char* a3 = a2 + kstep; const char* b3 = b2 + kstep;
            if (last && has_next) S.a_ready(nxt);
            if constexpr (SP2) {
            PG8_LDB(B0, 0, 0); PG8_LDB(B1, 0, 1); PG8_SCHED; PG8_LDA(At, 0, 0); PG8_STAGE(PG8_SA(1, 1), a1 + hstepA, voffA);
            PG8_WAIT_V(8); PG8_WAIT_L(0); PG8_BAR; PG8_MMA(0, 0, At, B0); PG8_MMA(0, 1, At, B1); PG8_BAR; PG8_SCHED;
            PG8_LDA(At, 0, 1); PG8_STAGE(PG8_SB(0, 0), b2, voffB); PG8_STAGE(PG8_SB(0, 1), b2 + hstepB, voffB); PG8_STAGE(PG8_SA(0, 0), a2, voffA);
            PG8_WAIT_V(8); PG8_WAIT_L(0); PG8_BAR; PG8_MMA(1, 0, At, B0); PG8_MMA(1, 1, At, B1); PG8_BAR; PG8_SCHED;
            PG8_LDB(B0, 1, 0); PG8_LDB(B1, 1, 1); PG8_SCHED; PG8_LDA(At, 1, 0); PG8_STAGE(PG8_SA(0, 1), a2 + hstepA, voffA);
            PG8_WAIT_V(8); PG8_WAIT_L(0); PG8_BAR; PG8_MMA(0, 0, At, B0); PG8_MMA(0, 1, At, B1); PG8_BAR; PG8_SCHED;
            PG8_LDA(At, 1, 1); PG8_STAGE(PG8_SB(1, 0), b3, voffB); PG8_STAGE(PG8_SB(1, 1), b3 + hstepB, voffB); PG8_STAGE(PG8_SA(1, 0), a3, voffA);
            PG8_WAIT_V(8); PG8_WAIT_L(0); PG8_BAR; PG8_MMA(1, 0, At, B0); PG8_MMA(1, 1, At, B1); PG8_BAR; PG8_SCHED;
            } else {
            PG8_LDB(B0, 0, 0); PG8_SCHED; PG8_LDA(At, 0, 0); PG8_STAGE(PG8_SA(1, 1), a1 + hstepA, voffA);
            PG8_WAIT_L(8); PG8_BAR; PG8_WAIT_L(0); PG8_MMA(0, 0, At, B0); PG8_BAR; PG8_SCHED;
            PG8_LDB(B1, 0, 1); PG8_STAGE(PG8_SB(0, 0), b2, voffB);
            PG8_BAR; PG8_WAIT_L(0); PG8_MMA(0, 1, At, B1); PG8_BAR;
            PG8_LDA(At, 0, 1); PG8_STAGE(PG8_SA(0, 0), a2, voffA);
            PG8_BAR; PG8_WAIT_L(0); PG8_MMA(1, 0, At, B0); PG8_BAR; PG8_SCHED;
            PG8_STAGE(PG8_SB(0, 1), b2 + hstepB, voffB);
            PG8_WAIT_V(6); PG8_BAR; PG8_MMA(1, 1, At, B1); PG8_BAR;
            PG8_LDB(B0, 1, 0); PG8_SCHED; PG8_LDA(At, 1, 0); PG8_STAGE(PG8_SA(0, 1), a2 + hstepA, voffA);
            PG8_WAIT_L(8); PG8_BAR; PG8_WAIT_L(0); PG8_MMA(0, 0, At, B0); PG8_BAR; PG8_SCHED;
            PG8_LDB(B1, 1, 1); PG8_STAGE(PG8_SB(1, 0), b3, voffB);
            PG8_BAR; PG8_WAIT_L(0); PG8_MMA(0, 1, At, B1); PG8_BAR;
            PG8_LDA(At, 1, 1); PG8_STAGE(PG8_SA(1, 0), a3, voffA);
            PG8_BAR; PG8_WAIT_L(0); PG8_MMA(1, 0, At, B0); PG8_BAR; PG8_SCHED;
            PG8_STAGE(PG8_SB(1, 1), b3 + hstepB, voffB);
            PG8_WAIT_V(6); PG8_BAR; PG8_MMA(1, 1, At, B1); PG8_BAR;
            }
        }
        if constexpr (ALIGN_EPI) { if (wr == 0) PG8_BAR; }
        if constexpr (!Epi::AFTER_DRAIN) { E(acc, cur, wr, wc, fr, fq); S.done(cur); }
        if (!has_next) break;
#pragma unroll
        for (int a = 0; a < 2; ++a)
#pragma unroll
            for (int b = 0; b < 2; ++b)
#pragma unroll
                for (int m = 0; m < 4; ++m)
#pragma unroll
                    for (int n = 0; n < 2; ++n) acc[a][b][m][n] = (f32x4){0.f, 0.f, 0.f, 0.f};
        cur = nxt; cA = nA; cB = nB; ++ui;
        if constexpr (ALIGN_EPI) { if (wr == 1) PG8_BAR; }
    }
    PG8_WAIT_V(0);
    if constexpr (!ALIGN_EPI) { if (wr == 0) PG8_BAR; }
    PG8_BAR;
    if constexpr (Epi::AFTER_DRAIN) { E.fused(acc, cur, wr, wc, fr, fq, lds, wid, lane); S.done(cur); }
#undef PG8_SA
#undef PG8_SB
#undef PG8_STAGE
#undef PG8_LDA
#undef PG8_LDB
#undef PG8_MMA
#undef PG8_WAIT_V
#undef PG8_WAIT_L
#undef PG8_BAR
#undef PG8_SCHED
}
}

struct P {
    const float *x, *c, *ctx, *c_ctx, *w_mod, *b_mod, *norm1_g, *norm2_g, *w_in;
    const float *a_re, *a_im, *log_dt, *b_re, *b_im, *c_re, *c_im, *ssm_d;
    const float *w_glu, *b_glu, *w_a, *w_b, *rpb, *w_out, *w_q, *subkeys, *peer_u, *peer_v, *final_g;
    float* out;
    float *mod, *c2, *rowss;
    bf16_t *w_in_t, *w_glu_t, *w_a_t, *w_b_t, *w_out_t, *w_q_t;
    bf16_t *pu, *pv;
    bf16_t *hx, *hc;
    bf16_t *U, *kb, *vb, *qb, *kc, *vc, *ga, *gb;
    bf16_t *Kmat, *Win; float *lamT, *E;
    bf16_t *z, *gl, *na, *merged, *x1g, *qp;
    float *tbuf;
    unsigned* topk;
};

namespace pg8 {
struct EpiInProj {
    static constexpr bool PERM = true, AFTER_DRAIN = false;
    bf16_t* U; bf16_t* d_kvq; size_t kvq_stride; bf16_t* d_gate; int is_ctx;
    __device__ __forceinline__ void operator()(const f32x4 (&acc)[2][2][4][2], const Unit& u, int wr, int wc, int fr, int fq) const {
        if (u.pn < 2) {
#pragma unroll
            for (int ai = 0; ai < 2; ++ai)
#pragma unroll
                for (int m = 0; m < 4; ++m) {
                    const int row = u.pm * BM + ai * HALF + wr * 64 + m * 16 + fr;
                    const int n = is_ctx ? (1024 + (row >> 8) * 8 + ((row & 255) >> 5)) : ((row >> 12) * 128 + ((row & 4095) >> 5));
                    const int jj = row & 31;
#pragma unroll
                    for (int bj = 0; bj < 2; ++bj) {
                        const int col = u.pn * BM + bj * HALF + wc * 32 + 8 * fq;
                        const f32x4 v0 = acc[ai][bj][m][0], v1 = acc[ai][bj][m][1];
                        u32x4 w; w.x = cvt_pk_bf16(v0[0], v0[1]); w.y = cvt_pk_bf16(v0[2], v0[3]); w.z = cvt_pk_bf16(v1[0], v1[1]); w.w = cvt_pk_bf16(v1[2], v1[3]);
                        *(u32x4*)(U + ((size_t)((col >> 4) * SSM_ROWS + n) * SSM_LD + jj * 16 + (col & 15))) = w;
                    }
                    asm volatile("" ::: "memory");
                }
        } else {
            bf16_t* base; int ld, c0;
            if (u.pn < 8) { const int which = (u.pn - 2) >> 1; base = d_kvq + (size_t)which * kvq_stride; ld = 512; c0 = 512 + which * 512; }
            else { const int which = (u.pn - 8) >> 2; base = d_gate + (size_t)which * ((size_t)NTOK * DM); ld = DM; c0 = 2048 + which * 1024; }
#pragma unroll
            for (int ai = 0; ai < 2; ++ai)
#pragma unroll
                for (int m = 0; m < 4; ++m) {
                    const int row = u.pm * BM + ai * HALF + wr * 64 + m * 16 + fr;
#pragma unroll
                    for (int bj = 0; bj < 2; ++bj) {
                        const int col = u.pn * BM + bj * HALF + wc * 32 + 8 * fq - c0;
                        const f32x4 v0 = acc[ai][bj][m][0], v1 = acc[ai][bj][m][1];
                        u32x4 w; w.x = cvt_pk_bf16(v0[0], v0[1]); w.y = cvt_pk_bf16(v0[2], v0[3]); w.z = cvt_pk_bf16(v1[0], v1[1]); w.w = cvt_pk_bf16(v1[2], v1[3]);
                        *(u32x4*)(base + (size_t)row * ld + col) = w;
                    }
                    asm volatile("" ::: "memory");
                }
        }
    }
};
struct EpiGlu {
    static constexpr bool PERM = true, AFTER_DRAIN = false;
    bf16_t* gl; const bf16_t* z; const float* bias;
    __device__ __forceinline__ void operator()(const f32x4 (&acc)[2][2][4][2], const Unit& u, int wr, int wc, int fr, int fq) const {
#pragma unroll
        for (int ai = 0; ai < 2; ++ai)
#pragma unroll
            for (int m = 0; m < 4; ++m) {
                const int row = u.pm * BM + ai * HALF + wr * 64 + m * 16 + fr;
#pragma unroll
                for (int bj = 0; bj < 2; ++bj) {
                    const int col = u.pn * BM + bj * HALF + wc * 32 + 8 * fq;
                    const f32x4 v0 = acc[ai][bj][m][0], v1 = acc[ai][bj][m][1];
                    const f32x4 b0 = *(const f32x4*)(bias + col), b1 = *(const f32x4*)(bias + col + 4);
                    const u32x4 zz = *(const u32x4*)(z + (size_t)row * 512 + col);
                    float o[8];
                    o[0] = bflo(zz.x) * sigmoidf_(v0[0] + b0[0]); o[1] = bfhi(zz.x) * sigmoidf_(v0[1] + b0[1]);
                    o[2] = bflo(zz.y) * sigmoidf_(v0[2] + b0[2]); o[3] = bfhi(zz.y) * sigmoidf_(v0[3] + b0[3]);
                    o[4] = bflo(zz.z) * sigmoidf_(v1[0] + b1[0]); o[5] = bfhi(zz.z) * sigmoidf_(v1[1] + b1[1]);
                    o[6] = bflo(zz.w) * sigmoidf_(v1[2] + b1[2]); o[7] = bfhi(zz.w) * sigmoidf_(v1[3] + b1[3]);
                    u32x4 w; w.x = cvt_pk_bf16(o[0], o[1]); w.y = cvt_pk_bf16(o[2], o[3]); w.z = cvt_pk_bf16(o[4], o[5]); w.w = cvt_pk_bf16(o[6], o[7]);
                    *(u32x4*)(gl + (size_t)row * 512 + col) = w;
                }
            }
    }
};
struct EpiBrA {
    static constexpr bool PERM = true, AFTER_DRAIN = false;
    float* t; const bf16_t* ga;
    __device__ __forceinline__ void operator()(const f32x4 (&acc)[2][2][4][2], const Unit& u, int wr, int wc, int fr, int fq) const {
#pragma unroll
        for (int ai = 0; ai < 2; ++ai)
#pragma unroll
            for (int m = 0; m < 4; ++m) {
                const int row = u.pm * BM + ai * HALF + wr * 64 + m * 16 + fr;
#pragma unroll
                for (int bj = 0; bj < 2; ++bj) {
                    const int col = u.pn * BM + bj * HALF + wc * 32 + 8 * fq;
                    const f32x4 v0 = acc[ai][bj][m][0], v1 = acc[ai][bj][m][1];
                    const u32x4 gg = *(const u32x4*)(ga + (size_t)row * DM + col);
                    f32x4 o0, o1;
                    o0[0] = sigmoidf_(bflo(gg.x)) * v0[0]; o0[1] = sigmoidf_(bfhi(gg.x)) * v0[1]; o0[2] = sigmoidf_(bflo(gg.y)) * v0[2]; o0[3] = sigmoidf_(bfhi(gg.y)) * v0[3];
                    o1[0] = sigmoidf_(bflo(gg.z)) * v1[0]; o1[1] = sigmoidf_(bfhi(gg.z)) * v1[1]; o1[2] = sigmoidf_(bflo(gg.w)) * v1[2]; o1[3] = sigmoidf_(bfhi(gg.w)) * v1[3];
                    *(f32x4*)(t + (size_t)row * DM + col) = o0; *(f32x4*)(t + (size_t)row * DM + col + 4) = o1;
                }
            }
    }
};
struct EpiBrB {
    static constexpr bool PERM = true, AFTER_DRAIN = false;
    bf16_t* merged; const float* t; const bf16_t* gb;
    __device__ __forceinline__ void operator()(const f32x4 (&acc)[2][2][4][2], const Unit& u, int wr, int wc, int fr, int fq) const {
#pragma unroll
        for (int ai = 0; ai < 2; ++ai)
#pragma unroll
            for (int m = 0; m < 4; ++m) {
                const int row = u.pm * BM + ai * HALF + wr * 64 + m * 16 + fr;
#pragma unroll
                for (int bj = 0; bj < 2; ++bj) {
                    const int col = u.pn * BM + bj * HALF + wc * 32 + 8 * fq;
                    const f32x4 v0 = acc[ai][bj][m][0], v1 = acc[ai][bj][m][1];
                    const u32x4 gg = *(const u32x4*)(gb + (size_t)row * DM + col);
                    const f32x4 t0 = *(const f32x4*)(t + (size_t)row * DM + col), t1 = *(const f32x4*)(t + (size_t)row * DM + col + 4);
                    float o[8];
                    o[0] = t0[0] + sigmoidf_(bflo(gg.x)) * v0[0]; o[1] = t0[1] + sigmoidf_(bfhi(gg.x)) * v0[1]; o[2] = t0[2] + sigmoidf_(bflo(gg.y)) * v0[2]; o[3] = t0[3] + sigmoidf_(bfhi(gg.y)) * v0[3];
                    o[4] = t1[0] + sigmoidf_(bflo(gg.z)) * v1[0]; o[5] = t1[1] + sigmoidf_(bfhi(gg.z)) * v1[1]; o[6] = t1[2] + sigmoidf_(bflo(gg.w)) * v1[2]; o[7] = t1[3] + sigmoidf_(bfhi(gg.w)) * v1[3];
                    u32x4 w; w.x = cvt_pk_bf16(o[0], o[1]); w.y = cvt_pk_bf16(o[2], o[3]); w.z = cvt_pk_bf16(o[4], o[5]); w.w = cvt_pk_bf16(o[6], o[7]);
                    *(u32x4*)(merged + (size_t)row * DM + col) = w;
                }
            }
    }
};
struct EpiOut {
    static constexpr bool PERM = true, AFTER_DRAIN = false;
    const float* x; float* x1; bf16_t* x1g; const float* mod; const float* g2; float* rowss;
    __device__ __forceinline__ void operator()(const f32x4 (&acc)[2][2][4][2], const Unit& u, int wr, int wc, int fr, int fq) const {
#pragma unroll
        for (int ai = 0; ai < 2; ++ai)
#pragma unroll
            for (int m = 0; m < 4; ++m) {
                const int row = u.pm * BM + ai * HALF + wr * 64 + m * 16 + fr;
                const float* modb = mod + (size_t)(row >> 12) * (6 * DM);
                float ss = 0.f;
#pragma unroll
                for (int bj = 0; bj < 2; ++bj) {
                    const int col = u.pn * BM + bj * HALF + wc * 32 + 8 * fq;
#pragma unroll
                    for (int n = 0; n < 2; ++n) {
                        const int cc = col + 4 * n;
                        const f32x4 v = acc[ai][bj][m][n];
                        const f32x4 xx = *(const f32x4*)(x + (size_t)row * DM + cc);
                        const f32x4 g1 = *(const f32x4*)(modb + 2 * DM + cc), sc = *(const f32x4*)(modb + 4 * DM + cc), gg = *(const f32x4*)(g2 + cc);
                        const f32x4 o = xx + g1 * v;
                        *(f32x4*)(x1 + (size_t)row * DM + cc) = o;
                        ss += o[0] * o[0] + o[1] * o[1] + o[2] * o[2] + o[3] * o[3];
                        const f32x4 og = o * gg * (sc + 1.f);
                        u32x2 w; w.x = cvt_pk_bf16(og[0], og[1]); w.y = cvt_pk_bf16(og[2], og[3]);
                        *(u32x2*)(x1g + (size_t)row * DM + cc) = w;
                    }
                }
                ss += __shfl_xor(ss, 16); ss += __shfl_xor(ss, 32);
                if (fq == 0) atomicAdd(rowss + row, ss);
            }
    }
};
struct EpiQ {
    static constexpr bool PERM = true, AFTER_DRAIN = false;
    bf16_t* qp; const float* rowss; const float* c2;
    __device__ __forceinline__ void operator()(const f32x4 (&acc)[2][2][4][2], const Unit& u, int wr, int wc, int fr, int fq) const {
#pragma unroll
        for (int ai = 0; ai < 2; ++ai)
#pragma unroll
            for (int m = 0; m < 4; ++m) {
                const int row = u.pm * BM + ai * HALF + wr * 64 + m * 16 + fr;
                const float rstd = rsqrtf(rowss[row] * (1.f / DM) + EPSN);
                const float* cb = c2 + (size_t)(row >> 12) * 2048;
#pragma unroll
                for (int bj = 0; bj < 2; ++bj) {
                    const int col = u.pn * BM + bj * HALF + wc * 32 + 8 * fq;
                    const f32x4 v0 = acc[ai][bj][m][0] * rstd + *(const f32x4*)(cb + col), v1 = acc[ai][bj][m][1] * rstd + *(const f32x4*)(cb + col + 4);
                    u32x4 w; w.x = cvt_pk_bf16(v0[0], v0[1]); w.y = cvt_pk_bf16(v0[2], v0[3]); w.z = cvt_pk_bf16(v1[0], v1[1]); w.w = cvt_pk_bf16(v1[2], v1[3]);
                    *(u32x4*)(qp + (size_t)row * 2048 + col) = w;
                }
            }
    }
};
struct EpiE {
    static constexpr bool PERM = true, AFTER_DRAIN = false;
    float* E;
    __device__ __forceinline__ void operator()(const f32x4 (&acc)[2][2][4][2], const Unit& u, int wr, int wc, int fr, int fq) const {
#pragma unroll
        for (int ai = 0; ai < 2; ++ai)
#pragma unroll
            for (int m = 0; m < 4; ++m) {
                const int row = u.pm * BM + ai * HALF + wr * 64 + m * 16 + fr;
#pragma unroll
                for (int bj = 0; bj < 2; ++bj) {
                    const int col = u.pn * BM + bj * HALF + wc * 32 + 8 * fq;
                    float* d = E + ((size_t)(u.g * SSM_ROWS + row) * 256 + col);
                    *(f32x4*)d = acc[ai][bj][m][0]; *(f32x4*)(d + 4) = acc[ai][bj][m][1];
                }
            }
    }
};
struct EpiZ {
    static constexpr bool PERM = true, AFTER_DRAIN = false;
    bf16_t* z;
    __device__ __forceinline__ void operator()(const f32x4 (&acc)[2][2][4][2], const Unit& u, int wr, int wc, int fr, int fq) const {
#pragma unroll
        for (int ai = 0; ai < 2; ++ai)
#pragma unroll
            for (int m = 0; m < 4; ++m) {
                const int n = u.pm * BM + ai * HALF + wr * 64 + m * 16 + fr;
                const size_t tok0 = (size_t)(n >> 7) * SEQL + (size_t)(n & 127) * 32;
#pragma unroll
                for (int bj = 0; bj < 2; ++bj) {
                    const int col = u.pn * BM + bj * HALF + wc * 32 + 8 * fq;
                    const f32x4 v0 = acc[ai][bj][m][0], v1 = acc[ai][bj][m][1];
                    u32x4 w; w.x = cvt_pk_bf16(gelu_tanh(v0[0]), gelu_tanh(v0[1])); w.y = cvt_pk_bf16(gelu_tanh(v0[2]), gelu_tanh(v0[3]));
                    w.z = cvt_pk_bf16(gelu_tanh(v1[0]), gelu_tanh(v1[1])); w.w = cvt_pk_bf16(gelu_tanh(v1[2]), gelu_tanh(v1[3]));
                    *(u32x4*)(z + (tok0 + (col >> 4)) * 512 + u.g * 16 + (col & 15)) = w;
                }
            }
    }
};
}

__device__ __forceinline__ void sincos_d(double th, double& s, double& c) {
    const double twopi = 6.283185307179586476925, hpi = 1.570796326794896619231;
    th -= twopi * rint(th / twopi);
    const double q = rint(th / hpi); const double y = th - q * hpi, y2 = y * y;
    const double sy = y * (1.0 - y2 / 6.0 * (1.0 - y2 / 20.0 * (1.0 - y2 / 42.0 * (1.0 - y2 / 72.0 * (1.0 - y2 / 110.0 * (1.0 - y2 / 156.0 * (1.0 - y2 / 210.0)))))));
    const double cy = 1.0 - y2 / 2.0 * (1.0 - y2 / 12.0 * (1.0 - y2 / 30.0 * (1.0 - y2 / 56.0 * (1.0 - y2 / 90.0 * (1.0 - y2 / 132.0 * (1.0 - y2 / 182.0))))));
    const int qi = ((int)q) & 3;
    s = qi == 0 ? sy : (qi == 1 ? cy : (qi == 2 ? -sy : -cy));
    c = qi == 0 ? cy : (qi == 1 ? -sy : (qi == 2 ? -cy : sy));
}
__device__ __forceinline__ void ssm_prep_item(const P& p, LAS unsigned char* lds, int item) {
    const int g = item >> 2, qtr = item & 3, tid = threadIdx.x;
    LAS f32x2* lamk = (LAS f32x2*)lds;
    LAS f32x2* Bb = lamk + 2 * 64 * 33;
    LAS f32x2* Cc = Bb + 2 * 64 * 16;
    LAS float* Kc = (LAS float*)(Cc + 2 * 16 * 64);
    if (tid < 128) {
        const int d = tid >> 6, pp = tid & 63, gi = d * 32 + g;
        const double are = (double)p.a_re[gi * 64 + pp], aim = (double)p.a_im[gi * 64 + pp];
        const double dt = (double)expf(p.log_dt[gi]);
        const double er = exp(are * dt); double sn, cs; sincos_d(aim * dt, sn, cs);
        const double lr = er * cs, li = er * sn;
        double pr = 1.0, pi_ = 0.0;
        for (int k = 0; k <= 32; ++k) {
            lamk[(d * 64 + pp) * 33 + k] = (f32x2){(float)pr, (float)pi_};
            const double nr_ = pr * lr - pi_ * li, ni_ = pr * li + pi_ * lr; pr = nr_; pi_ = ni_;
        }
        if (qtr == 0) { const f32x2 l32 = lamk[(d * 64 + pp) * 33 + 32]; *(f32x2*)(p.lamT + (size_t)(gi * 64 + pp) * 2) = l32; }
        const double nr = lr - 1.0, ni = li, den = are * are + aim * aim;
        const double qr = (nr * are + ni * aim) / den, qi = (ni * are - nr * aim) / den;
        for (int h = 0; h < 16; ++h) {
            const double br = (double)p.b_re[((size_t)gi * 64 + pp) * 16 + h], bi = (double)p.b_im[((size_t)gi * 64 + pp) * 16 + h];
            Bb[(d * 64 + pp) * 16 + h] = (f32x2){(float)(qr * br - qi * bi), (float)(qr * bi + qi * br)};
        }
    }
    for (int e = tid; e < 2 * 16 * 64; e += NT) {
        const int d = e >> 10, h = (e >> 6) & 15, pp = e & 63; const size_t src = ((size_t)(d * 32 + g) * 16 + h) * 64 + pp;
        Cc[e] = (f32x2){p.c_re[src], p.c_im[src]};
    }
    __syncthreads();
    for (int e = tid; e < 2 * 32 * 256; e += NT) {
        const int d = e >> 13, k = (e >> 8) & 31, h = (e >> 4) & 15, h2 = e & 15;
        float sacc = 0.f;
        for (int pp = 0; pp < 64; ++pp) {
            const f32x2 c = Cc[(d * 16 + h) * 64 + pp], l = lamk[(d * 64 + pp) * 33 + k], b = Bb[(d * 64 + pp) * 16 + h2];
            const float clr = c[0] * l[0] - c[1] * l[1], cli = c[0] * l[1] + c[1] * l[0];
            sacc += clr * b[0] - cli * b[1];
        }
        Kc[e] = sacc;
    }
    __syncthreads();
    for (int ch = tid; ch < 128 * 96; ch += NT) {
        const int mrow = 128 * qtr + ch / 96, k0 = (ch % 96) * 8, ii = mrow >> 4, h = mrow & 15;
        float v[8];
        if (k0 < 512) {
            const int jj = k0 >> 4, h20 = k0 & 15;
#pragma unroll
            for (int i = 0; i < 8; ++i) {
                const int h2 = h20 + i; float val = 0.f;
                if (ii >= jj) val += Kc[((0 * 32 + (ii - jj)) * 16 + h) * 16 + h2];
                if (jj >= ii) val += Kc[((1 * 32 + (jj - ii)) * 16 + h) * 16 + h2];
                if (ii == jj && h == h2) val += p.ssm_d[g * 16 + h];
                v[i] = val;
            }
        } else {
            const int sc = k0 - 512, d = sc >> 7, ri = (sc >> 6) & 1, p0 = sc & 63, e = d == 0 ? ii + 1 : 32 - ii;
#pragma unroll
            for (int i = 0; i < 8; ++i) {
                const int pp = p0 + i; const f32x2 c = Cc[(d * 16 + h) * 64 + pp], l = lamk[(d * 64 + pp) * 33 + e];
                const float clr = c[0] * l[0] - c[1] * l[1], cli = c[0] * l[1] + c[1] * l[0];
                v[i] = ri == 0 ? clr : -cli;
            }
        }
        u32x4 o; o.x = pk2(v[0], v[1]); o.y = pk2(v[2], v[3]); o.z = pk2(v[4], v[5]); o.w = pk2(v[6], v[7]);
        *(u32x4*)(p.Kmat + ((size_t)(g * 512 + mrow) * SSM_LD + k0)) = o;
    }
    for (int ch = tid; ch < 64 * 64; ch += NT) {
        const int nrow = 64 * qtr + ch / 64, k0 = (ch % 64) * 8, d = nrow >> 7, ri = (nrow >> 6) & 1, pp = nrow & 63;
        const int jj = k0 >> 4, h20 = k0 & 15, e = d == 0 ? 31 - jj : jj;
        const f32x2 l = lamk[(d * 64 + pp) * 33 + e];
        float v[8];
#pragma unroll
        for (int i = 0; i < 8; ++i) { const f32x2 b = Bb[(d * 64 + pp) * 16 + h20 + i]; v[i] = ri == 0 ? (l[0] * b[0] - l[1] * b[1]) : (l[0] * b[1] + l[1] * b[0]); }
        u32x4 o; o.x = pk2(v[0], v[1]); o.y = pk2(v[2], v[3]); o.z = pk2(v[4], v[5]); o.w = pk2(v[6], v[7]);
        *(u32x4*)(p.Win + ((size_t)(g * 256 + nrow) * 512 + k0)) = o;
    }
    __syncthreads();
}
__device__ __forceinline__ void ph_carry(const P& p) {
    const int tid = threadIdx.x;
    if (tid >= 128) return;
    for (int gidx = blockIdx.x * 128 + tid; gidx < 32 * 8 * 2 * 64; gidx += gridDim.x * 128) {
        const int pp = gidx & 63, d = (gidx >> 6) & 1, b = (gidx >> 7) & 7, g = gidx >> 10;
        const f32x2 lt = *(const f32x2*)(p.lamT + (size_t)((d * 32 + g) * 64 + pp) * 2);
        const float* Eg = p.E + (size_t)g * SSM_ROWS * 256 + d * 128 + pp;
        bf16_t* Ug = p.U + (size_t)g * SSM_ROWS * SSM_LD + 512 + d * 128 + pp;
        float fr = 0.f, fi = 0.f;
#pragma unroll
        for (int cc = 0; cc < 8; ++cc) {
            const int n = 1024 + b * 8 + (d == 0 ? cc : 7 - cc);
            const float er = Eg[(size_t)n * 256], ei = Eg[(size_t)n * 256 + 64];
            const float nr = lt[0] * fr - lt[1] * fi + er, ni = lt[0] * fi + lt[1] * fr + ei; fr = nr; fi = ni;
        }
#pragma unroll 8
        for (int c = 0; c < 128; ++c) {
            const int n = b * 128 + (d == 0 ? c : 127 - c);
            const float er = Eg[(size_t)n * 256], ei = Eg[(size_t)n * 256 + 64];
            Ug[(size_t)n * SSM_LD] = (bf16_t)f2bf(fr); Ug[(size_t)n * SSM_LD + 64] = (bf16_t)f2bf(fi);
            const float nr = lt[0] * fr - lt[1] * fi + er, ni = lt[0] * fi + lt[1] * fr + ei; fr = nr; fi = ni;
        }
    }
}


__device__ __forceinline__ void p0_transpose_item(const float* W, int K, int N, bf16_t* WT, LAS float* scr, int item, int lane) {
    const int nblk = N / 32, kb = item / nblk, nb = item % nblk, k0 = 64 * kb, n0 = 32 * nb;
#pragma unroll 8
    for (int i = 0; i < 32; ++i) { const int kk = 2 * i + (lane >> 5); scr[kk * 33 + (lane & 31)] = W[(size_t)(k0 + kk) * N + n0 + (lane & 31)]; }
    asm volatile("s_waitcnt lgkmcnt(0)" ::: "memory");
    const int c = lane & 7;
#pragma unroll
    for (int j = 0; j < 4; ++j) { const int n = (lane >> 3) + 8 * j; const LAS float* s = scr + (8 * c) * 33 + n;
        u32x4 o; o.x = pk2(s[0 * 33], s[1 * 33]); o.y = pk2(s[2 * 33], s[3 * 33]); o.z = pk2(s[4 * 33], s[5 * 33]); o.w = pk2(s[6 * 33], s[7 * 33]);
        *(u32x4*)(WT + (size_t)(n0 + n) * K + k0 + 8 * c) = o; }
    asm volatile("s_waitcnt lgkmcnt(0)" ::: "memory");
}

template <int NR, bool SILU>
__device__ __forceinline__ void gemv_block64(const float* const (&rows)[NR], const float* W, int ldw, int col0, const float* bias, float* y, int ldy, LAS float* scr) {
    const int wave = threadIdx.x >> 6, lane = threadIdx.x & 63;
    float acc[NR];
#pragma unroll
    for (int r = 0; r < NR; ++r) acc[r] = 0.f;
    const int kb = wave * 128;
#pragma unroll 4
    for (int k = kb; k < kb + 128; ++k) {
        const float w = W[(size_t)k * ldw + col0 + lane];
#pragma unroll
        for (int r = 0; r < NR; ++r) { const float s = rows[r][k]; acc[r] += (SILU ? siluf_(s) : s) * w; }
    }
#pragma unroll
    for (int r = 0; r < NR; ++r) scr[(wave * NR + r) * 64 + lane] = acc[r];
    __syncthreads();
    for (int e = threadIdx.x; e < NR * 64; e += NT) {
        const int r = e >> 6, l = e & 63; float s = 0.f;
#pragma unroll
        for (int w = 0; w < 8; ++w) s += scr[(w * NR + r) * 64 + l];
        y[(size_t)r * ldy + col0 + l] = s + (bias ? bias[col0 + l] : 0.f);
    }
    __syncthreads();
}

__device__ __forceinline__ void ph_prep(const P& p, LAS unsigned char* lds) {
    const int wave = threadIdx.x >> 6, lane = threadIdx.x & 63, G = gridDim.x;
    for (int cb = blockIdx.x; cb < 96; cb += G) {
        const float* const rows[9] = {p.c, p.c + DM, p.c + 2 * DM, p.c + 3 * DM, p.c + 4 * DM, p.c + 5 * DM, p.c + 6 * DM, p.c + 7 * DM, p.c_ctx};
        gemv_block64<9, true>(rows, p.w_mod, 6 * DM, cb * 64, p.b_mod, p.mod, 6 * DM, (LAS float*)lds);
    }
    for (int it = G - 1 - (int)blockIdx.x; it < 128; it += G) ssm_prep_item(p, lds, it);
    {
        LAS float* scr = (LAS float*)(lds + wave * 16384);
        const int gw = blockIdx.x * NWAVES + wave, NGW = G * NWAVES;
        constexpr int I_IN = (DM / 64) * (INC / 32), I_GLU = (512 / 64) * (512 / 32), I_A = (512 / 64) * (DM / 32), I_OUT = (DM / 64) * (DM / 32), I_Q = (DM / 64) * (2048 / 32);
        constexpr int NITEMS = I_IN + I_GLU + 2 * I_A + I_OUT + I_Q;
        for (int it = gw; it < NITEMS; it += NGW) {
            int r = it;
            if (r < I_IN) { p0_transpose_item(p.w_in, DM, INC, p.w_in_t, scr, r, lane); continue; } r -= I_IN;
            if (r < I_GLU) { p0_transpose_item(p.w_glu, 512, 512, p.w_glu_t, scr, r, lane); continue; } r -= I_GLU;
            if (r < I_A) { p0_transpose_item(p.w_a, 512, DM, p.w_a_t, scr, r, lane); continue; } r -= I_A;
            if (r < I_A) { p0_transpose_item(p.w_b, 512, DM, p.w_b_t, scr, r, lane); continue; } r -= I_A;
            if (r < I_OUT) { p0_transpose_item(p.w_out, DM, DM, p.w_out_t, scr, r, lane); continue; } r -= I_OUT;
            p0_transpose_item(p.w_q, DM, 2048, p.w_q_t, scr, r, lane);
        }
    }
    {
        const size_t nchunk = (size_t)16384 * DM / 8, gsz = (size_t)G * NT;
        for (size_t i = (size_t)blockIdx.x * NT + threadIdx.x; i < 2 * nchunk; i += gsz) {
            const bool second = i >= nchunk; const size_t j = second ? i - nchunk : i;
            const float* src = (second ? p.peer_v : p.peer_u) + j * 8;
            const f32x4 a = *(const f32x4*)src, b = *(const f32x4*)(src + 4);
            u32x4 o; o.x = pk2(a[0], a[1]); o.y = pk2(a[2], a[3]); o.z = pk2(b[0], b[1]); o.w = pk2(b[2], b[3]);
            *(u32x4*)((second ? p.pv : p.pu) + j * 8) = o;
        }
    }
}


__device__ __forceinline__ void normmod_row_bf16(const float* src, bf16_t* dst, const float* g, const float* shift, const float* scale, int lane) {
    const f32x4* s = (const f32x4*)src;
    f32x4 v[4]; float ss = 0.f;
#pragma unroll
    for (int j = 0; j < 4; ++j) { v[j] = s[lane + 64 * j]; ss += v[j][0] * v[j][0] + v[j][1] * v[j][1] + v[j][2] * v[j][2] + v[j][3] * v[j][3]; }
    ss = wave_sum(ss);
    const float rstd = rsqrtf(ss * (1.f / DM) + EPSN);
#pragma unroll
    for (int j = 0; j < 4; ++j) {
        const int i4 = lane + 64 * j;
        const f32x4 gg = ((const f32x4*)g)[i4], sh = ((const f32x4*)shift)[i4], sc = ((const f32x4*)scale)[i4];
        const f32x4 o = v[j] * rstd * gg * (sc + 1.f) + sh;
        u32x2 w; w.x = pk2(o[0], o[1]); w.y = pk2(o[2], o[3]);
        *(u32x2*)(dst + (size_t)i4 * 4) = w;
    }
}
__device__ __forceinline__ void ph_norm1(const P& p, LAS unsigned char* lds) {
    const int wave = threadIdx.x >> 6, lane = threadIdx.x & 63, G = gridDim.x;
    for (int cb = blockIdx.x; cb < 32; cb += G) {
        const float* m3 = p.mod + 3 * DM;
        const float* const rows[8] = {m3, m3 + 6 * DM, m3 + 12 * DM, m3 + 18 * DM, m3 + 24 * DM, m3 + 30 * DM, m3 + 36 * DM, m3 + 42 * DM};
        gemv_block64<8, false>(rows, p.w_q, 2048, cb * 64, nullptr, p.c2, 2048, (LAS float*)lds);
    }
    for (int r = blockIdx.x * NWAVES + wave; r < NTOK + NCTX; r += G * NWAVES) {
        if (r < NTOK) { const float* modb = p.mod + (size_t)(r >> 12) * (6 * DM); normmod_row_bf16(p.x + (size_t)r * DM, p.hx + (size_t)r * DM, p.norm1_g, modb, modb + DM, lane); }
        else { const int rc = r - NTOK; const float* modc = p.mod + 8 * (6 * DM); normmod_row_bf16(p.ctx + (size_t)rc * DM, p.hc + (size_t)rc * DM, p.norm1_g, modc, modc + DM, lane); }
    }
}

__device__ __forceinline__ void ph_na_naive(const P& p) {
    const int tid = threadIdx.x, hh = tid >> 7, col = (tid >> 1) & 63, half = tid & 1;
    for (int it = blockIdx.x; it < NB * GW * 2; it += gridDim.x) {
        const int b = it >> 7, r = (it >> 1) & 63, head = (it & 1) * 4 + hh;
        int r0 = r - 4; r0 = r0 < 0 ? 0 : (r0 > 56 ? 56 : r0);
        int c0 = col - 8; c0 = c0 < 0 ? 0 : (c0 > 48 ? 48 : c0);
        const size_t tq = (size_t)b * SEQL + r * GW + col;
        const int doff = head * 64 + half * 32;
        float q[32], o[32];
        {
            const u32x4* qp = (const u32x4*)(p.qb + tq * 512 + doff);
#pragma unroll
            for (int d = 0; d < 4; ++d) { const u32x4 v = qp[d]; q[8 * d] = bflo(v.x); q[8 * d + 1] = bfhi(v.x); q[8 * d + 2] = bflo(v.y); q[8 * d + 3] = bfhi(v.y); q[8 * d + 4] = bflo(v.z); q[8 * d + 5] = bfhi(v.z); q[8 * d + 6] = bflo(v.w); q[8 * d + 7] = bfhi(v.w); }
        }
#pragma unroll
        for (int d = 0; d < 32; ++d) o[d] = 0.f;
        float m = -INFINITY, l = 0.f;
        for (int kk = 0; kk < 128 + CTXL; ++kk) {
            const bf16_t* kp; const bf16_t* vp; float bias = 0.f;
            if (kk < 128) {
                const int i = kk >> 4, cc = kk & 15, krow = r0 + i, kcol = c0 + cc;
                const size_t tk = (size_t)b * SEQL + krow * GW + kcol;
                kp = p.kb + tk * 512 + doff; vp = p.vb + tk * 512 + doff;
                bias = p.rpb[(head * 15 + (krow - r + 7)) * 31 + (kcol - col + 15)];
            } else {
                const size_t j = (size_t)b * CTXL + (kk - 128);
                kp = p.kc + j * 512 + doff; vp = p.vc + j * 512 + doff;
            }
            float s = 0.f;
#pragma unroll
            for (int d = 0; d < 4; ++d) { const u32x4 v = ((const u32x4*)kp)[d];
                s += q[8 * d] * bflo(v.x) + q[8 * d + 1] * bfhi(v.x) + q[8 * d + 2] * bflo(v.y) + q[8 * d + 3] * bfhi(v.y) + q[8 * d + 4] * bflo(v.z) + q[8 * d + 5] * bfhi(v.z) + q[8 * d + 6] * bflo(v.w) + q[8 * d + 7] * bfhi(v.w); }
            s += __shfl_xor(s, 1);
            s = s * 0.125f + bias;
            const float mn = fmaxf(m, s);
            const float corr = __expf(m - mn), pe = __expf(s - mn);
            l = l * corr + pe;
#pragma unroll
            for (int d = 0; d < 4; ++d) { const u32x4 v = ((const u32x4*)vp)[d];
                o[8 * d] = o[8 * d] * corr + pe * bflo(v.x); o[8 * d + 1] = o[8 * d + 1] * corr + pe * bfhi(v.x); o[8 * d + 2] = o[8 * d + 2] * corr + pe * bflo(v.y); o[8 * d + 3] = o[8 * d + 3] * corr + pe * bfhi(v.y);
                o[8 * d + 4] = o[8 * d + 4] * corr + pe * bflo(v.z); o[8 * d + 5] = o[8 * d + 5] * corr + pe * bfhi(v.z); o[8 * d + 6] = o[8 * d + 6] * corr + pe * bflo(v.w); o[8 * d + 7] = o[8 * d + 7] * corr + pe * bfhi(v.w); }
            m = mn;
        }
        const float inv = 1.f / l;
        u32x4* op = (u32x4*)(p.na + tq * 512 + doff);
#pragma unroll
        for (int d = 0; d < 4; ++d) { u32x4 w; w.x = pk2(o[8 * d] * inv, o[8 * d + 1] * inv); w.y = pk2(o[8 * d + 2] * inv, o[8 * d + 3] * inv); w.z = pk2(o[8 * d + 4] * inv, o[8 * d + 5] * inv); w.w = pk2(o[8 * d + 6] * inv, o[8 * d + 7] * inv); op[d] = w; }
    }
}

typedef __bf16 bf16x2_t __attribute__((ext_vector_type(2)));
__device__ __forceinline__ float dot2bf(unsigned a, unsigned b, float c) { return __builtin_amdgcn_fdot2_f32_bf16(__builtin_bit_cast(bf16x2_t, a), __builtin_bit_cast(bf16x2_t, b), c, false); }
__device__ __forceinline__ unsigned ordkey(float f) { unsigned u = __builtin_bit_cast(unsigned, f); return u ^ ((unsigned)((int)u >> 31) | 0x80000000u); }
__device__ __forceinline__ float unordkey(unsigned k) { return __builtin_bit_cast(float, k ^ ((k & 0x80000000u) ? 0x80000000u : 0xFFFFFFFFu)); }
template <bool DESC> __device__ __forceinline__ void cex(unsigned& a, unsigned& b) { const unsigned mx = a > b ? a : b, mn = a > b ? b : a; if (DESC) { a = mx; b = mn; } else { a = mn; b = mx; } }
__device__ __forceinline__ void sort16_desc(unsigned (&a)[16]) {
#pragma unroll
    for (int k = 2; k <= 16; k <<= 1)
#pragma unroll
        for (int j = k >> 1; j > 0; j >>= 1)
#pragma unroll
            for (int i = 0; i < 16; ++i) { const int l = i ^ j; if (l > i) { if ((i & k) == 0) cex<true>(a[i], a[l]); else cex<false>(a[i], a[l]); } }
}
__device__ __forceinline__ void merge16_desc(unsigned (&a)[16]) {
#pragma unroll
    for (int j = 8; j > 0; j >>= 1)
#pragma unroll
        for (int i = 0; i < 16; ++i) { const int l = i ^ j; if (l > i) cex<true>(a[i], a[l]); }
}
__device__ __forceinline__ void top16_merge(unsigned (&a)[16], const unsigned (&b)[16]) {
#pragma unroll
    for (int i = 0; i < 16; ++i) a[i] = a[i] > b[15 - i] ? a[i] : b[15 - i];
    merge16_desc(a);
}
struct PairTab { int i[52], j[52], n; };
constexpr PairTab make_pairs() { PairTab t{}; int n = 0; for (int i = 0; i < 16; ++i) for (int j = 0; j < 16; ++j) if ((i + 1) * (j + 1) <= 16) { t.i[n] = i; t.j[n] = j; ++n; } t.n = n; for (int k = n; k < 52; ++k) { t.i[k] = 0; t.j[k] = 0; } return t; }
constexpr PairTab PAIRS = make_pairs();
static_assert(PAIRS.n == 50, "50 candidate pairs");

constexpr int SK_LD = 136;
__device__ __forceinline__ void ph_peer_topk(const P& p, LAS unsigned char* lds) {
    const int tid = threadIdx.x, wave = tid >> 6, lane = tid & 63;
    LAS bf16_t* sk = (LAS bf16_t*)lds;
    for (int e = tid; e < 2 * 128 * 16; e += NT) {
        const int row = e >> 4, c8 = (e & 15) * 8;
        const f32x4 a = *(const f32x4*)(p.subkeys + (size_t)row * 128 + c8), b = *(const f32x4*)(p.subkeys + (size_t)row * 128 + c8 + 4);
        u32x4 o; o.x = pk2(a[0], a[1]); o.y = pk2(a[2], a[3]); o.z = pk2(b[0], b[1]); o.w = pk2(b[2], b[3]);
        *(LAS u32x4*)(sk + row * SK_LD + c8) = o;
    }
    __syncthreads();
    const int lt = lane & 15, lq = lane >> 4;
    for (int tile = blockIdx.x * NWAVES + wave; tile < NTOK / 16; tile += gridDim.x * NWAVES) {
        const int tok = tile * 16 + lt;
        const bf16_t* qrow = p.qp + (size_t)tok * 2048;
        for (int h = 0; h < 8; ++h) {
            unsigned s0[16], s1[16];
#pragma unroll
            for (int n = 0; n < 2; ++n) {
                bf16x8 bq[4];
#pragma unroll
                for (int ks = 0; ks < 4; ++ks) bq[ks] = *(const bf16x8*)(qrow + h * 256 + n * 128 + ks * 32 + lq * 8);
                unsigned a[16], b[16];
#pragma unroll
                for (int kb = 0; kb < 8; ++kb) {
                    f32x4 c = {0.f, 0.f, 0.f, 0.f};
#pragma unroll
                    for (int ks = 0; ks < 4; ++ks) {
                        const bf16x8 ak = *(const LAS bf16x8*)(sk + (n * 128 + kb * 16 + lt) * SK_LD + ks * 32 + lq * 8);
                        c = __builtin_amdgcn_mfma_f32_16x16x32_bf16(ak, bq[ks], c, 0, 0, 0);
                    }
#pragma unroll
                    for (int r = 0; r < 4; ++r) {
                        const unsigned key = (ordkey(c[r]) & ~127u) | (unsigned)(kb * 16 + lq * 4 + r);
                        if (kb < 4) a[kb * 4 + r] = key; else b[(kb - 4) * 4 + r] = key;
                    }
                    asm volatile("" ::: "memory");
                }
                sort16_desc(a); sort16_desc(b);
                top16_merge(a, b);
#pragma unroll
                for (int i = 0; i < 16; ++i) b[i] = __shfl_xor(a[i], 16);
                top16_merge(a, b);
#pragma unroll
                for (int i = 0; i < 16; ++i) b[i] = __shfl_xor(a[i], 32);
                top16_merge(a, b);
                if (n == 0) {
#pragma unroll
                    for (int i = 0; i < 16; ++i) s0[i] = a[i];
                } else {
#pragma unroll
                    for (int i = 0; i < 16; ++i) s1[i] = a[i];
                }
            }
            unsigned ck[16], ce_[13]; float cs[13];
#pragma unroll
            for (int s = 0; s < 13; ++s) {
                const unsigned k0 = lq == 0 ? s0[PAIRS.i[s * 4]] : (lq == 1 ? s0[PAIRS.i[s * 4 + 1]] : (lq == 2 ? s0[PAIRS.i[s * 4 + 2]] : s0[PAIRS.i[s * 4 + 3]]));
                const unsigned k1 = lq == 0 ? s1[PAIRS.j[s * 4]] : (lq == 1 ? s1[PAIRS.j[s * 4 + 1]] : (lq == 2 ? s1[PAIRS.j[s * 4 + 2]] : s1[PAIRS.j[s * 4 + 3]]));
                const float sum = unordkey(k0 & ~127u) + unordkey(k1 & ~127u);
                const bool valid = (s * 4 + lq) < PAIRS.n;
                cs[s] = sum; ce_[s] = (k0 & 127u) * 128u + (k1 & 127u);
                ck[s] = valid ? ((ordkey(sum) & ~63u) | (unsigned)(s * 4 + lq)) : 0u;
            }
            ck[13] = 0u; ck[14] = 0u; ck[15] = 0u;
            unsigned srt[16], ob[16];
#pragma unroll
            for (int i = 0; i < 16; ++i) srt[i] = ck[i];
            sort16_desc(srt);
#pragma unroll
            for (int i = 0; i < 16; ++i) ob[i] = __shfl_xor(srt[i], 16);
            top16_merge(srt, ob);
#pragma unroll
            for (int i = 0; i < 16; ++i) ob[i] = __shfl_xor(srt[i], 32);
            unsigned thr = 0xFFFFFFFFu;
#pragma unroll
            for (int i = 0; i < 16; ++i) { const unsigned v = srt[i] > ob[15 - i] ? srt[i] : ob[15 - i]; thr = v < thr ? v : thr; }
            const float mtop = unordkey(s0[0] & ~127u) + unordkey(s1[0] & ~127u);
            float zp = 0.f; int cnt = 0;
#pragma unroll
            for (int s = 0; s < 13; ++s) { const bool sel = ck[s] >= thr && ck[s] != 0u; const float e = sel ? __expf(cs[s] - mtop) : 0.f; cs[s] = e; zp += e; cnt += sel ? 1 : 0; }
            float z = zp; z += __shfl_xor(z, 16); z += __shfl_xor(z, 32);
            const float rz = 1.f / z;
            const int c0 = __shfl(cnt, lt), c1 = __shfl(cnt, lt + 16), c2 = __shfl(cnt, lt + 32);
            int pos = lq == 0 ? 0 : (lq == 1 ? c0 : (lq == 2 ? c0 + c1 : c0 + c1 + c2));
            u32x2* dst = (u32x2*)p.topk + ((size_t)tok * 8 + h) * 16;
#pragma unroll
            for (int s = 0; s < 13; ++s) {
                const bool sel = ck[s] >= thr && ck[s] != 0u;
                if (sel) { u32x2 o; o.x = ce_[s]; o.y = __builtin_bit_cast(unsigned, cs[s] * rz); dst[pos] = o; ++pos; }
            }
        }
    }
}

__device__ __forceinline__ void ph_peer_gather(const P& p) {
    const int wave = threadIdx.x >> 6, lane = threadIdx.x & 63;
    for (int tok = blockIdx.x * NWAVES + wave; tok < NTOK; tok += gridDim.x * NWAVES) {
        const int b = tok >> 12;
        const float* modb = p.mod + (size_t)b * (6 * DM);
        float acc[16]; unsigned hp[8];
        const float rstd2 = rsqrtf(p.rowss[tok] * (1.f / DM) + EPSN);
#pragma unroll
        for (int j = 0; j < 2; ++j)
#pragma unroll
            for (int q4 = 0; q4 < 2; ++q4) {
                const int e0 = j * 512 + lane * 8 + q4 * 4;
                const f32x4 xv = *(const f32x4*)(p.out + (size_t)tok * DM + e0), gg = *(const f32x4*)(p.norm2_g + e0), sh = *(const f32x4*)(modb + 3 * DM + e0), sc = *(const f32x4*)(modb + 4 * DM + e0);
                const f32x4 hv = xv * rstd2 * gg * (sc + 1.f) + sh;
#pragma unroll
                for (int i = 0; i < 4; ++i) acc[j * 8 + q4 * 4 + i] = 0.f;
                hp[j * 4 + q4 * 2] = pk2(hv[0], hv[1]); hp[j * 4 + q4 * 2 + 1] = pk2(hv[2], hv[3]);
            }
        const u32x2* tk = (const u32x2*)p.topk + (size_t)tok * 128;
        const u32x2 ent0 = tk[lane], ent1 = tk[lane + 64];
#pragma unroll 1
        for (int k0 = 0; k0 < 128; k0 += 8) {
            u32x4 uu[8][2], vv[8][2]; float gk[8];
#pragma unroll
            for (int i = 0; i < 8; ++i) {
                const int k = k0 + i;
                const unsigned ex = k0 < 64 ? ent0.x : ent1.x, gx = k0 < 64 ? ent0.y : ent1.y;
                const unsigned e = __builtin_amdgcn_readlane(ex, k & 63);
                gk[i] = __builtin_bit_cast(float, __builtin_amdgcn_readlane(gx, k & 63));
                const bf16_t* ur = p.pu + (size_t)e * DM + lane * 8; const bf16_t* vr = p.pv + (size_t)e * DM + lane * 8;
                uu[i][0] = *(const u32x4*)ur; uu[i][1] = *(const u32x4*)(ur + 512);
                vv[i][0] = *(const u32x4*)vr; vv[i][1] = *(const u32x4*)(vr + 512);
            }
            float pd[8];
#pragma unroll
            for (int i = 0; i < 8; ++i) {
                float d = 0.f;
#pragma unroll
                for (int j = 0; j < 2; ++j) {
                    const unsigned u0 = uu[i][j][0], u1 = uu[i][j][1], u2 = uu[i][j][2], u3 = uu[i][j][3];
                    d = dot2bf(u0, hp[j * 4 + 0], d); d = dot2bf(u1, hp[j * 4 + 1], d); d = dot2bf(u2, hp[j * 4 + 2], d); d = dot2bf(u3, hp[j * 4 + 3], d);
                }
                pd[i] = d;
            }
            float r4[4], r2[2], r1;
            { const bool hi = lane & 32;
#pragma unroll
              for (int i = 0; i < 4; ++i) { const float keep = hi ? pd[i + 4] : pd[i], send = hi ? pd[i] : pd[i + 4]; r4[i] = keep + __shfl_xor(send, 32); } }
            { const bool hi = lane & 16;
#pragma unroll
              for (int i = 0; i < 2; ++i) { const float keep = hi ? r4[i + 2] : r4[i], send = hi ? r4[i] : r4[i + 2]; r2[i] = keep + __shfl_xor(send, 16); } }
            { const bool hi = lane & 8; const float keep = hi ? r2[1] : r2[0], send = hi ? r2[0] : r2[1]; r1 = keep + __shfl_xor(send, 8); }
            r1 += __shfl_xor(r1, 4); r1 += __shfl_xor(r1, 2); r1 += __shfl_xor(r1, 1);
#pragma unroll
            for (int i = 0; i < 8; ++i) {
                const float a = __builtin_bit_cast(float, __builtin_amdgcn_readlane(__builtin_bit_cast(unsigned, r1), ((i >> 2) & 1) * 32 + ((i >> 1) & 1) * 16 + (i & 1) * 8));
                const float w = gk[i] * gelu_tanh(a);
#pragma unroll
                for (int j = 0; j < 2; ++j) {
                    acc[j * 8 + 0] += w * bflo(vv[i][j].x); acc[j * 8 + 1] += w * bfhi(vv[i][j].x); acc[j * 8 + 2] += w * bflo(vv[i][j].y); acc[j * 8 + 3] += w * bfhi(vv[i][j].y);
                    acc[j * 8 + 4] += w * bflo(vv[i][j].z); acc[j * 8 + 5] += w * bfhi(vv[i][j].z); acc[j * 8 + 6] += w * bflo(vv[i][j].w); acc[j * 8 + 7] += w * bfhi(vv[i][j].w);
                }
            }
        }
        float ss = 0.f; float x1v[16];
#pragma unroll
        for (int j = 0; j < 2; ++j)
#pragma unroll
            for (int q4 = 0; q4 < 2; ++q4) {
                const int e0 = j * 512 + lane * 8 + q4 * 4;
                const f32x4 g2 = *(const f32x4*)(modb + 5 * DM + e0), xv = *(const f32x4*)(p.out + (size_t)tok * DM + e0);
#pragma unroll
                for (int i = 0; i < 4; ++i) { const int ix = j * 8 + q4 * 4 + i; x1v[ix] = xv[i] + g2[i] * acc[ix]; ss += x1v[ix] * x1v[ix]; }
            }
        ss = wave_sum(ss);
        const float rstd = rsqrtf(ss * (1.f / DM) + EPSN);
#pragma unroll
        for (int j = 0; j < 2; ++j)
#pragma unroll
            for (int q4 = 0; q4 < 2; ++q4) {
                const int e0 = j * 512 + lane * 8 + q4 * 4;
                const f32x4 fg = *(const f32x4*)(p.final_g + e0);
                f32x4 o;
#pragma unroll
                for (int i = 0; i < 4; ++i) o[i] = x1v[j * 8 + q4 * 4 + i] * rstd * fg[i];
                *(f32x4*)(p.out + (size_t)tok * DM + e0) = o;
            }
    }
}

constexpr int LDS_BYTES = 147456;
#define GSYNC() cg::this_grid().sync()

__global__ void __launch_bounds__(NT, 2) mega(P p) {
    extern __shared__ __attribute__((aligned(16))) unsigned char lds_raw[];
    LAS unsigned char* lds = (LAS unsigned char*)lds_raw;
    const int G = gridDim.x, bx = blockIdx.x;
    using namespace pg8;

    ph_prep(p, lds);
    GSYNC();
    ph_norm1(p, lds);
    GSYNC();
    {
        Gemm<DM, DM, DM> g{p.hx, p.w_in_t}; StaticOrder<NTOK, INC> S; S.init(G, bx);
        EpiInProj E{p.U, p.kb, (size_t)NTOK * 512, p.ga, 0};
        gemm_phase<EpiInProj, StaticOrder<NTOK, INC>, true, true>(lds, g, S, E);
        Gemm<DM, DM, DM> g2{p.hc, p.w_in_t}; StaticOrder<NCTX, CTXC> S2; S2.init(G, bx);
        EpiInProj E2{p.U, p.kc, (size_t)NCTX * 512, p.ga, 1};
        gemm_phase<EpiInProj, StaticOrder<NCTX, CTXC>, true, true>(lds, g2, S2, E2);
    }
    GSYNC();
    {
        Gemm<512, SSM_LD, 512, (long)SSM_ROWS * SSM_LD, 256L * 512> g{p.U, p.Win}; StaticOrder<SSM_ROWS, 256, 32> S; S.init(G, bx);
        EpiE E{p.E};
        gemm_phase<EpiE, StaticOrder<SSM_ROWS, 256, 32>, true, true>(lds, g, S, E);
    }
    GSYNC();
    ph_carry(p);
    ph_na_naive(p);
    GSYNC();
    {
        Gemm<SSM_LD, SSM_LD, SSM_LD, (long)SSM_ROWS * SSM_LD, 512L * SSM_LD> g{p.U, p.Kmat}; StaticOrder<1024, 512, 32> S; S.init(G, bx);
        EpiZ E{p.z};
        gemm_phase<EpiZ, StaticOrder<1024, 512, 32>, true, true>(lds, g, S, E);
    }
    GSYNC();
    {
        Gemm<512, 512, 512> g{p.z, p.w_glu_t}; StaticOrder<NTOK, 512> S; S.init(G, bx);
        EpiGlu E{p.gl, p.z, p.b_glu};
        gemm_phase<EpiGlu, StaticOrder<NTOK, 512>, true, true>(lds, g, S, E);
    }
    GSYNC();
    {
        Gemm<512, 512, 512> g{p.gl, p.w_a_t}; StaticOrder<NTOK, DM> S; S.init(G, bx);
        EpiBrA E{p.tbuf, p.ga};
        gemm_phase<EpiBrA, StaticOrder<NTOK, DM>, true, true>(lds, g, S, E);
        Gemm<512, 512, 512> g2{p.na, p.w_b_t};
        EpiBrB E2{p.merged, p.tbuf, p.gb};
        gemm_phase<EpiBrB, StaticOrder<NTOK, DM>, true, true>(lds, g2, S, E2);
    }
    GSYNC();
    {
        Gemm<DM, DM, DM> g{p.merged, p.w_out_t}; StaticOrder<NTOK, DM> S; S.init(G, bx);
        EpiOut E{p.x, p.out, p.x1g, p.mod, p.norm2_g, p.rowss};
        gemm_phase<EpiOut, StaticOrder<NTOK, DM>, true, true>(lds, g, S, E);
    }
    GSYNC();
    {
        Gemm<DM, DM, DM> g{p.x1g, p.w_q_t}; StaticOrder<NTOK, 2048> S; S.init(G, bx);
        EpiQ E{p.qp, p.rowss, p.c2};
        gemm_phase<EpiQ, StaticOrder<NTOK, 2048>, true, true>(lds, g, S, E);
    }
    GSYNC();
    ph_peer_topk(p, lds);
    GSYNC();
    ph_peer_gather(p);
}

extern "C" void kernel_launch(void* const* d_in, const int* in_sizes, int n_in, void* d_out, int out_size, void* d_ws, size_t ws_size, hipStream_t stream) {
    static int grid = 0;
    if (grid == 0) {
        int dev = 0, cus = 0, per_cu = 0;
        (void)hipGetDevice(&dev);
        (void)hipDeviceGetAttribute(&cus, hipDeviceAttributeMultiprocessorCount, dev);
        (void)hipFuncSetAttribute((const void*)mega, hipFuncAttributeMaxDynamicSharedMemorySize, LDS_BYTES);
        (void)hipOccupancyMaxActiveBlocksPerMultiprocessor(&per_cu, (const void*)mega, NT, LDS_BYTES);
        if (per_cu < 1) { fprintf(stderr, "occupancy query says %d blocks per CU\n", per_cu); per_cu = 1; }
        grid = cus;
    }
    P p{};
    const float* const* in = (const float* const*)d_in;
    p.x = in[0]; p.c = in[1]; p.ctx = in[2]; p.c_ctx = in[3]; p.w_mod = in[4]; p.b_mod = in[5]; p.norm1_g = in[6]; p.norm2_g = in[7]; p.w_in = in[8];
    p.a_re = in[9]; p.a_im = in[10]; p.log_dt = in[11]; p.b_re = in[12]; p.b_im = in[13]; p.c_re = in[14]; p.c_im = in[15]; p.ssm_d = in[16];
    p.w_glu = in[17]; p.b_glu = in[18]; p.w_a = in[19]; p.w_b = in[20]; p.rpb = in[21]; p.w_out = in[22]; p.w_q = in[23]; p.subkeys = in[24];
    p.peer_u = in[25]; p.peer_v = in[26]; p.final_g = in[27];
    p.out = (float*)d_out;
    unsigned char* ws = (unsigned char*)d_ws; unsigned char* ob = (unsigned char*)d_out;
    constexpr size_t MiB = 1u << 20;
    p.rowss = (float*)(ws + 512 * 1024);
    p.mod = (float*)(ws + 1 * MiB); p.c2 = (float*)(ws + 1 * MiB + 256 * 1024);
    p.w_in_t = (bf16_t*)(ws + 3 * MiB); p.w_glu_t = (bf16_t*)(ws + 11 * MiB); p.w_a_t = (bf16_t*)(ws + 12 * MiB); p.w_b_t = (bf16_t*)(ws + 13 * MiB);
    p.w_out_t = (bf16_t*)(ws + 14 * MiB); p.w_q_t = (bf16_t*)(ws + 16 * MiB);
    p.pu = (bf16_t*)(ws + 54 * MiB); p.pv = (bf16_t*)(ws + 86 * MiB);
    p.ga = (bf16_t*)(ws + 118 * MiB); p.gb = (bf16_t*)(ws + 182 * MiB);
    p.kb = (bf16_t*)(ws + 246 * MiB); p.vb = (bf16_t*)(ws + 278 * MiB); p.qb = (bf16_t*)(ws + 310 * MiB); p.kc = (bf16_t*)(ws + 342 * MiB); p.vc = (bf16_t*)(ws + 344 * MiB);
    p.U = (bf16_t*)(ws + 346 * MiB);
    p.Kmat = (bf16_t*)(ws + 21 * MiB); p.Win = (bf16_t*)(ws + 45 * MiB); p.lamT = (float*)(ws + 53 * MiB); p.E = (float*)(ws + 406 * MiB);
    p.na = (bf16_t*)ob; p.z = (bf16_t*)(ob + 32 * MiB); p.gl = (bf16_t*)(ob + 64 * MiB);
    p.hx = (bf16_t*)ob; p.hc = (bf16_t*)(ob + 64 * MiB);
    p.merged = (bf16_t*)(ws + 246 * MiB); p.tbuf = (float*)(ws + 310 * MiB);
    p.x1g = (bf16_t*)(ws + 118 * MiB);
    p.qp = (bf16_t*)(ws + 246 * MiB);
    p.topk = (unsigned*)(ws + 182 * MiB);
    (void)hipMemsetAsync(ws, 0, 1 * MiB, stream);
    void* args[] = {&p};
    hipError_t e = hipLaunchCooperativeKernel((const void*)mega, dim3(grid), dim3(NT), args, LDS_BYTES, stream);
    if (e != hipSuccess) fprintf(stderr, "cooperative launch failed: %s (grid %d)\n", hipGetErrorString(e), grid);
}
```

```cpp
#include <hip/hip_runtime.h>
#include <hip/hip_cooperative_groups.h>
#include <cstdio>
#include <cstdint>
namespace cg = cooperative_groups;

#define LAS __attribute__((address_space(3)))
typedef unsigned short bf16_t;
typedef short bf16x8 __attribute__((ext_vector_type(8)));
typedef float f32x4 __attribute__((ext_vector_type(4)));
typedef float f32x2 __attribute__((ext_vector_type(2)));
typedef unsigned u32x4 __attribute__((ext_vector_type(4)));
typedef unsigned u32x2 __attribute__((ext_vector_type(2)));

constexpr int DM = 1024, NB = 8, SEQL = 4096, CTXL = 256, GW = 64, NTOK = NB * SEQL, NCTX = NB * CTXL;
constexpr int INC = 4096, CTXC = 1536;
constexpr int NT = 512, NWAVES = 8;
constexpr float EPSN = 1e-6f;
constexpr int SSM_ROWS = 1280;
constexpr int SSM_LD = 768;

__device__ __forceinline__ unsigned f2bf(float f) { unsigned u = __builtin_bit_cast(unsigned, f); return (u + 0x7fffu + ((u >> 16) & 1u)) >> 16; }
__device__ __forceinline__ unsigned pk2(float lo, float hi) { return f2bf(lo) | (f2bf(hi) << 16); }
__device__ __forceinline__ float bflo(unsigned w) { return __builtin_bit_cast(float, w << 16); }
__device__ __forceinline__ float bfhi(unsigned w) { return __builtin_bit_cast(float, w & 0xffff0000u); }
__device__ __forceinline__ float bf2f(bf16_t h) { return __builtin_bit_cast(float, (unsigned)h << 16); }

__device__ __forceinline__ float wave_sum(float v) {
#pragma unroll
    for (int o = 1; o < 64; o <<= 1) v += __shfl_xor(v, o);
    return v;
}
__device__ __forceinline__ float wave_max(float v) {
#pragma unroll
    for (int o = 1; o < 64; o <<= 1) v = fmaxf(v, __shfl_xor(v, o));
    return v;
}
__device__ __forceinline__ float sigmoidf_(float x) { return 1.f / (1.f + __expf(-x)); }
__device__ __forceinline__ float siluf_(float x) { return x / (1.f + __expf(-x)); }
__device__ __forceinline__ float gelu_tanh(float x) {
    const float k0 = 0.7978845608028654f, k1 = 0.044715f;
    const float u = k0 * (x + k1 * x * x * x);
    const float t = 1.f - 2.f / (1.f + __expf(2.f * u));
    return 0.5f * x * (1.f + t);
}

namespace pg8 {
#define PG8_LAS __attribute__((address_space(3)))
constexpr int BM = 256, BK = 64, HALF = 128, HTB = HALF * BK * 2  , STAGE_BYTES = 8 * HTB, NXCD = 8, WGM = 8;
__host__ __device__ __forceinline__ int lds_byte(int r, int c) { const int st = (r >> 4) * 2 + (c >> 5), rr = r & 15, cc = c & 31, ob = rr * 64 + cc * 2; return st * 1024 + (ob ^ (((ob >> 9) & 1) << 5)); }
__host__ __device__ __forceinline__ void stage_rc(int b, int& R, int& C) { const int st = b / 1024, sb = b % 1024, swz = sb ^ (((sb >> 9) & 1) << 5); R = (st >> 1) * 16 + swz / 64; C = (st & 1) * 32 + (swz % 64) / 2; }
__host__ __device__ __forceinline__ int perm32(int rho) { const int n = rho >> 4, i = rho & 15; return 8 * (i >> 2) + 4 * n + (i & 3); }

struct Unit { int pm, pn, g; };
template <int K_, int LDA, int LDB, long GSA = 0, long GSB = 0>
struct Gemm {
    const bf16_t* A; const bf16_t* Bt;
    static constexpr int K = K_, lda = LDA, ldb = LDB;
    __device__ __forceinline__ const char* abase(const Unit& u) const { return (const char*)(A + (size_t)u.g * GSA + (size_t)u.pm * BM * LDA); }
    __device__ __forceinline__ const char* bbase(const Unit& u) const { return (const char*)(Bt + (size_t)u.g * GSB + (size_t)u.pn * BM * LDB); }
};
template <int M, int N, int NGRP = 1>
struct StaticOrder {
    static constexpr int nM = M / BM, nN = N / BM, nwg = nM * nN;
    int G, c;
    __device__ void init(int G_, int c_) { G = G_; c = c_; }
    __device__ bool next(int i, Unit& u) const {
        const int L = i * G + c; if (L >= nwg * NGRP) return false;
        u.g = L / nwg;
        int wgid = L % nwg; { constexpr int q = nwg / NXCD, r = nwg % NXCD; const int xcd = wgid % NXCD, off = wgid / NXCD; wgid = (xcd < r ? xcd * (q + 1) : r * (q + 1) + (xcd - r) * q) + off; }
        constexpr int nig = WGM * nN; const int gid = wgid / nig, fm = gid * WGM, gsz = (nM - fm) < WGM ? (nM - fm) : WGM;
        u.pm = fm + ((wgid % nig) % gsz); u.pn = (wgid % nig) / gsz; return true;
    }
    __device__ __forceinline__ void a_ready(const Unit&) const {}
    __device__ __forceinline__ void done(const Unit&) const {}
};
__device__ __forceinline__ unsigned cvt_pk_bf16(float lo, float hi) { unsigned r; asm volatile("v_cvt_pk_bf16_f32 %0, %1, %2" : "=v"(r) : "v"(lo), "v"(hi)); return r; }
template <class Epi, class Sched, bool ALIGN_EPI = false, bool SP2 = false, class GemmT>
__device__ __forceinline__ void gemm_phase(PG8_LAS unsigned char* lds, const GemmT g, const Sched& S, const Epi& E) {
    const int tid = threadIdx.x, wid = __builtin_amdgcn_readfirstlane(tid >> 6), lane = tid & 63, wr = wid >> 2, wc = wid & 3, fr = lane & 15, fq = lane >> 4;
    const int K = g.K, nt = K / BK;
    unsigned voffA[2], voffB[2];
#pragma unroll
    for (int i = 0; i < 2; ++i) { int R, C; stage_rc(tid * 16 + i * 8192, R, C); const int Rb = Epi::PERM ? ((R & ~31) + perm32(R & 31)) : R;
        voffA[i] = (unsigned)(R * g.lda + C) * 2u; voffB[i] = (unsigned)(Rb * g.ldb + C) * 2u; }
    const size_t kstep = (size_t)(BK * 2);
    const size_t hstepA = (size_t)HALF * g.lda * 2, hstepB = (size_t)HALF * g.ldb * 2;
    const unsigned ldsw = (unsigned)wid * 1024u;
    const int aoff = lds_byte(wr * 64 + fr, fq * 8), boff = lds_byte(wc * 32 + fr, fq * 8);
#define PG8_SA(b, h) (((b) * 2 + (h)) * HTB)
#define PG8_SB(b, h) ((4 + (b) * 2 + (h)) * HTB)
#define PG8_STAGE(bufoff, gbase, voff) do { _Pragma("unroll") for (int _i = 0; _i < 2; ++_i) \
        __builtin_amdgcn_global_load_lds((const unsigned*)((const char*)(gbase) + (voff)[_i]), (PG8_LAS unsigned*)(lds + (bufoff) + ldsw + _i * 8192), 16, 0, 0); } while (0)
#define PG8_LDA(dst, b, h) do { _Pragma("unroll") for (int m = 0; m < 4; ++m) _Pragma("unroll") for (int k = 0; k < 2; ++k) dst[m][k] = *(const PG8_LAS bf16x8*)(lds + PG8_SA(b, h) + aoff + m * 2048 + k * 1024); } while (0)
#define PG8_LDB(dst, b, h) do { _Pragma("unroll") for (int n = 0; n < 2; ++n) _Pragma("unroll") for (int k = 0; k < 2; ++k) dst[n][k] = *(const PG8_LAS bf16x8*)(lds + PG8_SB(b, h) + boff + n * 2048 + k * 1024); } while (0)
#define PG8_MMA(ai, bj, At, Bt) do { __builtin_amdgcn_s_setprio(1); _Pragma("unroll") for (int m = 0; m < 4; ++m) _Pragma("unroll") for (int n = 0; n < 2; ++n) _Pragma("unroll") for (int k = 0; k < 2; ++k) \
        acc[ai][bj][m][n] = __builtin_amdgcn_mfma_f32_16x16x32_bf16(Bt[n][k], At[m][k], acc[ai][bj][m][n], 0, 0, 0); __builtin_amdgcn_s_setprio(0); } while (0)
#define PG8_WAIT_V(n) asm volatile("s_waitcnt vmcnt(" #n ")" ::: "memory")
#define PG8_WAIT_L(n) asm volatile("s_waitcnt lgkmcnt(" #n ")" ::: "memory")
#define PG8_BAR __builtin_amdgcn_s_barrier()
#define PG8_SCHED __builtin_amdgcn_sched_barrier(0)
    Unit cur, nxt; int ui = 0;
    if (!S.next(0, cur)) return;
    f32x4 acc[2][2][4][2];
#pragma unroll
    for (int a = 0; a < 2; ++a)
#pragma unroll
        for (int b = 0; b < 2; ++b)
#pragma unroll
            for (int m = 0; m < 4; ++m)
#pragma unroll
                for (int n = 0; n < 2; ++n) acc[a][b][m][n] = (f32x4){0.f, 0.f, 0.f, 0.f};
    bf16x8 At[4][2], B0[2][2], B1[2][2];
    const char* cA = g.abase(cur); const char* cB = g.bbase(cur);
    S.a_ready(cur);
    if constexpr (SP2) {
        PG8_STAGE(PG8_SB(0, 0), cB, voffB); PG8_STAGE(PG8_SB(0, 1), cB + hstepB, voffB); PG8_STAGE(PG8_SA(0, 0), cA, voffA); PG8_STAGE(PG8_SA(0, 1), cA + hstepA, voffA);
        if (wr == 1) PG8_BAR;
        PG8_WAIT_V(2); PG8_BAR;
        PG8_STAGE(PG8_SB(1, 0), cB + kstep, voffB); PG8_STAGE(PG8_SA(1, 0), cA + kstep, voffA); PG8_STAGE(PG8_SB(1, 1), cB + hstepB + kstep, voffB);
        PG8_WAIT_V(6); PG8_BAR;
    } else {
        PG8_STAGE(PG8_SB(0, 0), cB, voffB); PG8_STAGE(PG8_SA(0, 0), cA, voffA); PG8_STAGE(PG8_SB(0, 1), cB + hstepB, voffB); PG8_STAGE(PG8_SA(0, 1), cA + hstepA, voffA);
        if (wr == 1) PG8_BAR;
        PG8_WAIT_V(4); PG8_BAR;
        PG8_STAGE(PG8_SB(1, 0), cB + kstep, voffB); PG8_STAGE(PG8_SA(1, 0), cA + kstep, voffA); PG8_STAGE(PG8_SB(1, 1), cB + hstepB + kstep, voffB);
        PG8_WAIT_V(6); PG8_BAR;
    }
    for (;;) {
        const bool has_next = S.next(ui + 1, nxt);
        const char* nA = has_next ? g.abase(nxt) : cA; const char* nB = has_next ? g.bbase(nxt) : cB;
        for (int t = 0; t < nt; t += 2) {
            const bool last = (t == nt - 2);
            const char* a1 = cA + (size_t)(t + 1) * kstep;
            const char* a2 = last ? nA : cA + (size_t)(t + 2) * kstep; const char* b2 = last ? nB : cB + (size_t)(t + 2) * kstep;
            const char* a3 = a2 + kstep; const char* b3 = b2 + kstep;
            if (last && has_next) S.a_ready(nxt);
            if constexpr (SP2) {
            PG8_LDB(B0, 0, 0); PG8_LDB(B1, 0, 1); PG8_SCHED; PG8_LDA(At, 0, 0); PG8_STAGE(PG8_SA(1, 1), a1 + hstepA, voffA);
            PG8_WAIT_V(8); PG8_WAIT_L(0); PG8_BAR; PG8_MMA(0, 0, At, B0); PG8_MMA(0, 1, At, B1); PG8_BAR; PG8_SCHED;
            PG8_LDA(At, 0, 1); PG8_STAGE(PG8_SB(0, 0), b2, voffB); PG8_STAGE(PG8_SB(0, 1), b2 + hstepB, voffB); PG8_STAGE(PG8_SA(0, 0), a2, voffA);
            PG8_WAIT_V(8); PG8_WAIT_L(0); PG8_BAR; PG8_MMA(1, 0, At, B0); PG8_MMA(1, 1, At, B1); PG8_BAR; PG8_SCHED;
            PG8_LDB(B0, 1, 0); PG8_LDB(B1, 1, 1); PG8_SCHED; PG8_LDA(At, 1, 0); PG8_STAGE(PG8_SA(0, 1), a2 + hstepA, voffA);
            PG8_WAIT_V(8); PG8_WAIT_L(0); PG8_BAR; PG8_MMA(0, 0, At, B0); PG8_MMA(0, 1, At, B1); PG8_BAR; PG8_SCHED;
            PG8_LDA(At, 1, 1); PG8_STAGE(PG8_SB(1, 0), b3, voffB); PG8_STAGE(PG8_SB(1, 1), b3 + hstepB, voffB); PG8_STAGE(PG8_SA(1, 0), a3, voffA);
            PG8_WAIT_V(8); PG8_WAIT_L(0); PG8_BAR; PG8_MMA(1, 0, At, B0); PG8_MMA(1, 1, At, B1); PG8_BAR; PG8_SCHED;
            } else {
            PG8_LDB(B0, 0, 0); PG8_SCHED; PG8_LDA(At, 0, 0); PG8_STAGE(PG8_SA(1, 1), a1 + hstepA, voffA);
            PG8_WAIT_L(8); PG8_BAR; PG8_WAIT_L(0); PG8_MMA(0, 0, At, B0); PG8_BAR; PG8_SCHED;
            PG8_LDB(B1, 0, 1); PG8_STAGE(PG8_SB(0, 0), b2, voffB);
            PG8_BAR; PG8_WAIT_L(0); PG8_MMA(0, 1, At, B1); PG8_BAR;
            PG8_LDA(At, 0, 1); PG8_STAGE(PG8_SA(0, 0), a2, voffA);
            PG8_BAR; PG8_WAIT_L(0); PG8_MMA(1, 0, At, B0); PG8_BAR; PG8_SCHED;
            PG8_STAGE(PG8_SB(0, 1), b2 + hstepB, voffB);
            PG8_WAIT_V(6); PG8_BAR; PG8_MMA(1, 1, At, B1); PG8_BAR;
            PG8_LDB(B0, 1, 0); PG8_SCHED; PG8_LDA(At, 1, 0); PG8_STAGE(PG8_SA(0, 1), a2 + hstepA, voffA);
            PG8_WAIT_L(8); PG8_BAR; PG8_WAIT_L(0); PG8_MMA(0, 0, At, B0); PG8_BAR; PG8_SCHED;
            PG8_LDB(B1, 1, 1); PG8_STAGE(PG8_SB(1, 0), b3, voffB);
            PG8_BAR; PG8_WAIT_L(0); PG8_MMA(0, 1, At, B1); PG8_BAR;
            PG8_LDA(At, 1, 1); PG8_STAGE(PG8_SA(1, 0), a3, voffA);
            PG8_BAR; PG8_WAIT_L(0); PG8_MMA(1, 0, At, B0); PG8_BAR; PG8_SCHED;
            PG8_STAGE(PG8_SB(1, 1), b3 + hstepB, voffB);
            PG8_WAIT_V(6); PG8_BAR; PG8_MMA(1, 1, At, B1); PG8_BAR;
            }
        }
        if constexpr (ALIGN_EPI) { if (wr == 0) PG8_BAR; }
        if constexpr (!Epi::AFTER_DRAIN) { E(acc, cur, wr, wc, fr, fq); S.done(cur); }
        if (!has_next) break;
#pragma unroll
        for (int a = 0; a < 2; ++a)
#pragma unroll
            for (int b = 0; b < 2; ++b)
#pragma unroll
                for (int m = 0; m < 4; ++m)
#pragma unroll
                    for (int n = 0; n < 2; ++n) acc[a][b][m][n] = (f32x4){0.f, 0.f, 0.f, 0.f};
        cur = nxt; cA = nA; cB = nB; ++ui;
        if constexpr (ALIGN_EPI) { if (wr == 1) PG8_BAR; }
    }
    PG8_WAIT_V(0);
    if constexpr (!ALIGN_EPI) { if (wr == 0) PG8_BAR; }
    PG8_BAR;
    if constexpr (Epi::AFTER_DRAIN) { E.fused(acc, cur, wr, wc, fr, fq, lds, wid, lane); S.done(cur); }
#undef PG8_SA
#undef PG8_SB
#undef PG8_STAGE
#undef PG8_LDA
#undef PG8_LDB
#undef PG8_MMA
#undef PG8_WAIT_V
#undef PG8_WAIT_L
#undef PG8_BAR
#undef PG8_SCHED
}
}

constexpr size_t MiB = 1u << 20;
struct P {
    const float *x, *c, *ctx, *c_ctx, *w_mod, *b_mod, *norm1_g, *norm2_g, *w_in;
    const float *a_re, *a_im, *log_dt, *b_re, *b_im, *c_re, *c_im, *ssm_d;
    const float *w_glu, *b_glu, *w_a, *w_b, *rpb, *w_out, *w_q, *subkeys, *peer_u, *peer_v, *final_g;
    float* out;
    unsigned char* ws;
    __device__ __forceinline__ float* rowss() const { return (float*)(ws + 512 * 1024); }
    __device__ __forceinline__ float* mod() const { return (float*)(ws + 1 * MiB); }
    __device__ __forceinline__ float* c2() const { return (float*)(ws + 1 * MiB + 256 * 1024); }
    __device__ __forceinline__ bf16_t* w_in_t() const { return (bf16_t*)(ws + 3 * MiB); }
    __device__ __forceinline__ bf16_t* w_glu_t() const { return (bf16_t*)(ws + 11 * MiB); }
    __device__ __forceinline__ bf16_t* w_a_t() const { return (bf16_t*)(ws + 12 * MiB); }
    __device__ __forceinline__ bf16_t* w_b_t() const { return (bf16_t*)(ws + 13 * MiB); }
    __device__ __forceinline__ bf16_t* w_out_t() const { return (bf16_t*)(ws + 14 * MiB); }
    __device__ __forceinline__ bf16_t* w_q_t() const { return (bf16_t*)(ws + 16 * MiB); }
    __device__ __forceinline__ bf16_t* Kmat() const { return (bf16_t*)(ws + 21 * MiB); }
    __device__ __forceinline__ bf16_t* Win() const { return (bf16_t*)(ws + 45 * MiB); }
    __device__ __forceinline__ float* lamT() const { return (float*)(ws + 53 * MiB); }
    __device__ __forceinline__ bf16_t* pu() const { return (bf16_t*)(ws + 54 * MiB); }
    __device__ __forceinline__ bf16_t* pv() const { return (bf16_t*)(ws + 86 * MiB); }
    __device__ __forceinline__ bf16_t* ga() const { return (bf16_t*)(ws + 118 * MiB); }
    __device__ __forceinline__ bf16_t* gb() const { return (bf16_t*)(ws + 182 * MiB); }
    __device__ __forceinline__ bf16_t* x1g() const { return (bf16_t*)(ws + 118 * MiB); }
    __device__ __forceinline__ unsigned* topk() const { return (unsigned*)(ws + 182 * MiB); }
    __device__ __forceinline__ bf16_t* kb() const { return (bf16_t*)(ws + 246 * MiB); }
    __device__ __forceinline__ bf16_t* vT() const { return (bf16_t*)(ws + 278 * MiB); }
    __device__ __forceinline__ bf16_t* qb() const { return (bf16_t*)(ws + 310 * MiB); }
    __device__ __forceinline__ bf16_t* kc() const { return (bf16_t*)(ws + 342 * MiB); }
    __device__ __forceinline__ bf16_t* vcT() const { return (bf16_t*)(ws + 344 * MiB); }
    __device__ __forceinline__ bf16_t* U() const { return (bf16_t*)(ws + 346 * MiB); }
    __device__ __forceinline__ float* E() const { return (float*)(ws + 406 * MiB); }
    __device__ __forceinline__ bf16_t* merged() const { return (bf16_t*)(ws + 246 * MiB); }
    __device__ __forceinline__ float* tbuf() const { return (float*)(ws + 310 * MiB); }
    __device__ __forceinline__ bf16_t* qp() const { return (bf16_t*)(ws + 246 * MiB); }
    __device__ __forceinline__ bf16_t* hx() const { return (bf16_t*)out; }
    __device__ __forceinline__ bf16_t* hc() const { return (bf16_t*)((unsigned char*)out + 64 * MiB); }
    __device__ __forceinline__ bf16_t* na() const { return (bf16_t*)out; }
    __device__ __forceinline__ bf16_t* z() const { return (bf16_t*)((unsigned char*)out + 32 * MiB); }
    __device__ __forceinline__ bf16_t* gl() const { return (bf16_t*)((unsigned char*)out + 64 * MiB); }
};

namespace pg8 {
struct EpiInProj {
    static constexpr bool PERM = true, AFTER_DRAIN = false;
    bf16_t* U; bf16_t* d_kq; size_t kq_stride; bf16_t* d_vT; bf16_t* d_gate; int is_ctx;
    __device__ __forceinline__ void operator()(const f32x4 (&acc)[2][2][4][2], const Unit& u, int wr, int wc, int fr, int fq) const {
        if (u.pn < 2) {
#pragma unroll
            for (int ai = 0; ai < 2; ++ai)
#pragma unroll
                for (int m = 0; m < 4; ++m) {
                    const int row = u.pm * BM + ai * HALF + wr * 64 + m * 16 + fr;
                    const int n = is_ctx ? (1024 + (row >> 8) * 8 + ((row & 255) >> 5)) : ((row >> 12) * 128 + ((row & 4095) >> 5));
                    const int jj = row & 31;
#pragma unroll
                    for (int bj = 0; bj < 2; ++bj) {
                        const int col = u.pn * BM + bj * HALF + wc * 32 + 8 * fq;
                        const f32x4 v0 = acc[ai][bj][m][0], v1 = acc[ai][bj][m][1];
                        u32x4 w; w.x = cvt_pk_bf16(v0[0], v0[1]); w.y = cvt_pk_bf16(v0[2], v0[3]); w.z = cvt_pk_bf16(v1[0], v1[1]); w.w = cvt_pk_bf16(v1[2], v1[3]);
                        *(u32x4*)(U + ((size_t)((col >> 4) * SSM_ROWS + n) * SSM_LD + jj * 16 + (col & 15))) = w;
                    }
                    asm volatile("" ::: "memory");
                }
        } else if (u.pn == 4 || u.pn == 5) {
            const int T = is_ctx ? CTXL : SEQL;
#pragma unroll
            for (int ai = 0; ai < 2; ++ai)
#pragma unroll
                for (int m = 0; m < 4; ++m) {
                    const int row = u.pm * BM + ai * HALF + wr * 64 + m * 16 + fr;
                    const int b = is_ctx ? (row >> 8) : (row >> 12), t = is_ctx ? (row & 255) : (row & 4095);
#pragma unroll
                    for (int bj = 0; bj < 2; ++bj) {
                        const int col = u.pn * BM + bj * HALF + wc * 32 + 8 * fq - 1024;
                        bf16_t* dst = d_vT + ((size_t)(b * 512 + col) * T + t);
#pragma unroll
                        for (int n = 0; n < 2; ++n)
#pragma unroll
                            for (int i = 0; i < 4; ++i) dst[(size_t)(n * 4 + i) * T] = (bf16_t)f2bf(acc[ai][bj][m][n][i]);
                    }
                    asm volatile("" ::: "memory");
                }
        } else {
            bf16_t* base; int ld, c0;
            if (u.pn < 8) { const int which = (u.pn - 2) >> 2; base = d_kq + (size_t)which * kq_stride; ld = 512; c0 = 512 + which * 1024; }
            else { const int which = (u.pn - 8) >> 2; base = d_gate + (size_t)which * ((size_t)NTOK * DM); ld = DM; c0 = 2048 + which * 1024; }
#pragma unroll
            for (int ai = 0; ai < 2; ++ai)
#pragma unroll
                for (int m = 0; m < 4; ++m) {
                    const int row = u.pm * BM + ai * HALF + wr * 64 + m * 16 + fr;
#pragma unroll
                    for (int bj = 0; bj < 2; ++bj) {
                        const int col = u.pn * BM + bj * HALF + wc * 32 + 8 * fq - c0;
                        const f32x4 v0 = acc[ai][bj][m][0], v1 = acc[ai][bj][m][1];
                        u32x4 w; w.x = cvt_pk_bf16(v0[0], v0[1]); w.y = cvt_pk_bf16(v0[2], v0[3]); w.z = cvt_pk_bf16(v1[0], v1[1]); w.w = cvt_pk_bf16(v1[2], v1[3]);
                        *(u32x4*)(base + (size_t)row * ld + col) = w;
                    }
                    asm volatile("" ::: "memory");
                }
        }
    }
};
struct EpiGlu {
    static constexpr bool PERM = true, AFTER_DRAIN = false;
    bf16_t* gl; const bf16_t* z; const float* bias;
    __device__ __forceinline__ void operator()(const f32x4 (&acc)[2][2][4][2], const Unit& u, int wr, int wc, int fr, int fq) const {
#pragma unroll
        for (int ai = 0; ai < 2; ++ai)
#pragma unroll
            for (int m = 0; m < 4; ++m) {
                const int row = u.pm * BM + ai * HALF + wr * 64 + m * 16 + fr;
#pragma unroll
                for (int bj = 0; bj < 2; ++bj) {
                    const int col = u.pn * BM + bj * HALF + wc * 32 + 8 * fq;
                    const f32x4 v0 = acc[ai][bj][m][0], v1 = acc[ai][bj][m][1];
                    const f32x4 b0 = *(const f32x4*)(bias + col), b1 = *(const f32x4*)(bias + col + 4);
                    const u32x4 zz = *(const u32x4*)(z + (size_t)row * 512 + col);
                    float o[8];
                    o[0] = bflo(zz.x) * sigmoidf_(v0[0] + b0[0]); o[1] = bfhi(zz.x) * sigmoidf_(v0[1] + b0[1]);
                    o[2] = bflo(zz.y) * sigmoidf_(v0[2] + b0[2]); o[3] = bfhi(zz.y) * sigmoidf_(v0[3] + b0[3]);
                    o[4] = bflo(zz.z) * sigmoidf_(v1[0] + b1[0]); o[5] = bfhi(zz.z) * sigmoidf_(v1[1] + b1[1]);
                    o[6] = bflo(zz.w) * sigmoidf_(v1[2] + b1[2]); o[7] = bfhi(zz.w) * sigmoidf_(v1[3] + b1[3]);
                    u32x4 w; w.x = cvt_pk_bf16(o[0], o[1]); w.y = cvt_pk_bf16(o[2], o[3]); w.z = cvt_pk_bf16(o[4], o[5]); w.w = cvt_pk_bf16(o[6], o[7]);
                    *(u32x4*)(gl + (size_t)row * 512 + col) = w;
                }
            }
    }
};
struct EpiBrA {
    static constexpr bool PERM = true, AFTER_DRAIN = false;
    float* t; const bf16_t* ga;
    __device__ __forceinline__ void operator()(const f32x4 (&acc)[2][2][4][2], const Unit& u, int wr, int wc, int fr, int fq) const {
#pragma unroll
        for (int ai = 0; ai < 2; ++ai)
#pragma unroll
            for (int m = 0; m < 4; ++m) {
                const int row = u.pm * BM + ai * HALF + wr * 64 + m * 16 + fr;
#pragma unroll
                for (int bj = 0; bj < 2; ++bj) {
                    const int col = u.pn * BM + bj * HALF + wc * 32 + 8 * fq;
                    const f32x4 v0 = acc[ai][bj][m][0], v1 = acc[ai][bj][m][1];
                    const u32x4 gg = *(const u32x4*)(ga + (size_t)row * DM + col);
                    f32x4 o0, o1;
                    o0[0] = sigmoidf_(bflo(gg.x)) * v0[0]; o0[1] = sigmoidf_(bfhi(gg.x)) * v0[1]; o0[2] = sigmoidf_(bflo(gg.y)) * v0[2]; o0[3] = sigmoidf_(bfhi(gg.y)) * v0[3];
                    o1[0] = sigmoidf_(bflo(gg.z)) * v1[0]; o1[1] = sigmoidf_(bfhi(gg.z)) * v1[1]; o1[2] = sigmoidf_(bflo(gg.w)) * v1[2]; o1[3] = sigmoidf_(bfhi(gg.w)) * v1[3];
                    *(f32x4*)(t + (size_t)row * DM + col) = o0; *(f32x4*)(t + (size_t)row * DM + col + 4) = o1;
                }
            }
    }
};
struct EpiBrB {
    static constexpr bool PERM = true, AFTER_DRAIN = false;
    bf16_t* merged; const float* t; const bf16_t* gb;
    __device__ __forceinline__ void operator()(const f32x4 (&acc)[2][2][4][2], const Unit& u, int wr, int wc, int fr, int fq) const {
#pragma unroll
        for (int ai = 0; ai < 2; ++ai)
#pragma unroll
            for (int m = 0; m < 4; ++m) {
                const int row = u.pm * BM + ai * HALF + wr * 64 + m * 16 + fr;
#pragma unroll
                for (int bj = 0; bj < 2; ++bj) {
                    const int col = u.pn * BM + bj * HALF + wc * 32 + 8 * fq;
                    const f32x4 v0 = acc[ai][bj][m][0], v1 = acc[ai][bj][m][1];
                    const u32x4 gg = *(const u32x4*)(gb + (size_t)row * DM + col);
                    const f32x4 t0 = *(const f32x4*)(t + (size_t)row * DM + col), t1 = *(const f32x4*)(t + (size_t)row * DM + col + 4);
                    float o[8];
                    o[0] = t0[0] + sigmoidf_(bflo(gg.x)) * v0[0]; o[1] = t0[1] + sigmoidf_(bfhi(gg.x)) * v0[1]; o[2] = t0[2] + sigmoidf_(bflo(gg.y)) * v0[2]; o[3] = t0[3] + sigmoidf_(bfhi(gg.y)) * v0[3];
                    o[4] = t1[0] + sigmoidf_(bflo(gg.z)) * v1[0]; o[5] = t1[1] + sigmoidf_(bfhi(gg.z)) * v1[1]; o[6] = t1[2] + sigmoidf_(bflo(gg.w)) * v1[2]; o[7] = t1[3] + sigmoidf_(bfhi(gg.w)) * v1[3];
                    u32x4 w; w.x = cvt_pk_bf16(o[0], o[1]); w.y = cvt_pk_bf16(o[2], o[3]); w.z = cvt_pk_bf16(o[4], o[5]); w.w = cvt_pk_bf16(o[6], o[7]);
                    *(u32x4*)(merged + (size_t)row * DM + col) = w;
                }
            }
    }
};
struct EpiOut {
    static constexpr bool PERM = true, AFTER_DRAIN = false;
    const float* x; float* x1; bf16_t* x1g; const float* mod; const float* g2; float* rowss;
    __device__ __forceinline__ void operator()(const f32x4 (&acc)[2][2][4][2], const Unit& u, int wr, int wc, int fr, int fq) const {
#pragma unroll
        for (int ai = 0; ai < 2; ++ai)
#pragma unroll
            for (int m = 0; m < 4; ++m) {
                const int row = u.pm * BM + ai * HALF + wr * 64 + m * 16 + fr;
                const float* modb = mod + (size_t)(row >> 12) * (6 * DM);
                float ss = 0.f;
#pragma unroll
                for (int bj = 0; bj < 2; ++bj) {
                    const int col = u.pn * BM + bj * HALF + wc * 32 + 8 * fq;
#pragma unroll
                    for (int n = 0; n < 2; ++n) {
                        const int cc = col + 4 * n;
                        const f32x4 v = acc[ai][bj][m][n];
                        const f32x4 xx = *(const f32x4*)(x + (size_t)row * DM + cc);
                        const f32x4 g1 = *(const f32x4*)(modb + 2 * DM + cc), sc = *(const f32x4*)(modb + 4 * DM + cc), gg = *(const f32x4*)(g2 + cc);
                        const f32x4 o = xx + g1 * v;
                        *(f32x4*)(x1 + (size_t)row * DM + cc) = o;
                        ss += o[0] * o[0] + o[1] * o[1] + o[2] * o[2] + o[3] * o[3];
                        const f32x4 og = o * gg * (sc + 1.f);
                        u32x2 w; w.x = cvt_pk_bf16(og[0], og[1]); w.y = cvt_pk_bf16(og[2], og[3]);
                        *(u32x2*)(x1g + (size_t)row * DM + cc) = w;
                    }
                }
                ss += __shfl_xor(ss, 16); ss += __shfl_xor(ss, 32);
                if (fq == 0) atomicAdd(rowss + row, ss);
            }
    }
};
struct EpiQ {
    static constexpr bool PERM = true, AFTER_DRAIN = false;
    bf16_t* qp; const float* rowss; const float* c2;
    __device__ __forceinline__ void operator()(const f32x4 (&acc)[2][2][4][2], const Unit& u, int wr, int wc, int fr, int fq) const {
#pragma unroll
        for (int ai = 0; ai < 2; ++ai)
#pragma unroll
            for (int m = 0; m < 4; ++m) {
                const int row = u.pm * BM + ai * HALF + wr * 64 + m * 16 + fr;
                const float rstd = rsqrtf(rowss[row] * (1.f / DM) + EPSN);
                const float* cb = c2 + (size_t)(row >> 12) * 2048;
#pragma unroll
                for (int bj = 0; bj < 2; ++bj) {
                    const int col = u.pn * BM + bj * HALF + wc * 32 + 8 * fq;
                    const f32x4 v0 = acc[ai][bj][m][0] * rstd + *(const f32x4*)(cb + col), v1 = acc[ai][bj][m][1] * rstd + *(const f32x4*)(cb + col + 4);
                    u32x4 w; w.x = cvt_pk_bf16(v0[0], v0[1]); w.y = cvt_pk_bf16(v0[2], v0[3]); w.z = cvt_pk_bf16(v1[0], v1[1]); w.w = cvt_pk_bf16(v1[2], v1[3]);
                    *(u32x4*)(qp + (size_t)row * 2048 + col) = w;
                }
            }
    }
};
struct EpiE {
    static constexpr bool PERM = true, AFTER_DRAIN = false;
    float* E;
    __device__ __forceinline__ void operator()(const f32x4 (&acc)[2][2][4][2], const Unit& u, int wr, int wc, int fr, int fq) const {
#pragma unroll
        for (int ai = 0; ai < 2; ++ai)
#pragma unroll
            for (int m = 0; m < 4; ++m) {
                const int row = u.pm * BM + ai * HALF + wr * 64 + m * 16 + fr;
#pragma unroll
                for (int bj = 0; bj < 2; ++bj) {
                    const int col = u.pn * BM + bj * HALF + wc * 32 + 8 * fq;
                    float* d = E + ((size_t)(u.g * SSM_ROWS + row) * 256 + col);
                    *(f32x4*)d = acc[ai][bj][m][0]; *(f32x4*)(d + 4) = acc[ai][bj][m][1];
                }
            }
    }
};
struct EpiZ {
    static constexpr bool PERM = true, AFTER_DRAIN = false;
    bf16_t* z;
    __device__ __forceinline__ void operator()(const f32x4 (&acc)[2][2][4][2], const Unit& u, int wr, int wc, int fr, int fq) const {
#pragma unroll
        for (int ai = 0; ai < 2; ++ai)
#pragma unroll
            for (int m = 0; m < 4; ++m) {
                const int n = u.pm * BM + ai * HALF + wr * 64 + m * 16 + fr;
                const size_t tok0 = (size_t)(n >> 7) * SEQL + (size_t)(n & 127) * 32;
#pragma unroll
                for (int bj = 0; bj < 2; ++bj) {
                    const int col = u.pn * BM + bj * HALF + wc * 32 + 8 * fq;
                    const f32x4 v0 = acc[ai][bj][m][0], v1 = acc[ai][bj][m][1];
                    u32x4 w; w.x = cvt_pk_bf16(gelu_tanh(v0[0]), gelu_tanh(v0[1])); w.y = cvt_pk_bf16(gelu_tanh(v0[2]), gelu_tanh(v0[3]));
                    w.z = cvt_pk_bf16(gelu_tanh(v1[0]), gelu_tanh(v1[1])); w.w = cvt_pk_bf16(gelu_tanh(v1[2]), gelu_tanh(v1[3]));
                    *(u32x4*)(z + (tok0 + (col >> 4)) * 512 + u.g * 16 + (col & 15)) = w;
                }
            }
    }
};
}

__device__ __forceinline__ void sincos_d(double th, double& s, double& c) {
    const double twopi = 6.283185307179586476925, hpi = 1.570796326794896619231;
    th -= twopi * rint(th / twopi);
    const double q = rint(th / hpi); const double y = th - q * hpi, y2 = y * y;
    const double sy = y * (1.0 - y2 / 6.0 * (1.0 - y2 / 20.0 * (1.0 - y2 / 42.0 * (1.0 - y2 / 72.0 * (1.0 - y2 / 110.0 * (1.0 - y2 / 156.0 * (1.0 - y2 / 210.0)))))));
    const double cy = 1.0 - y2 / 2.0 * (1.0 - y2 / 12.0 * (1.0 - y2 / 30.0 * (1.0 - y2 / 56.0 * (1.0 - y2 / 90.0 * (1.0 - y2 / 132.0 * (1.0 - y2 / 182.0))))));
    const int qi = ((int)q) & 3;
    s = qi == 0 ? sy : (qi == 1 ? cy : (qi == 2 ? -sy : -cy));
    c = qi == 0 ? cy : (qi == 1 ? -sy : (qi == 2 ? -cy : sy));
}
__device__ __forceinline__ void ssm_prep_item(const P& p, LAS unsigned char* lds, int item) {
    const int g = item >> 2, qtr = item & 3, tid = threadIdx.x;
    LAS f32x2* lamk = (LAS f32x2*)lds;
    LAS f32x2* Bb = lamk + 2 * 64 * 33;
    LAS f32x2* Cc = Bb + 2 * 64 * 16;
    LAS float* Kc = (LAS float*)(Cc + 2 * 16 * 64);
    if (tid < 128) {
        const int d = tid >> 6, pp = tid & 63, gi = d * 32 + g;
        const double are = (double)p.a_re[gi * 64 + pp], aim = (double)p.a_im[gi * 64 + pp];
        const double dt = (double)expf(p.log_dt[gi]);
        const double er = exp(are * dt); double sn, cs; sincos_d(aim * dt, sn, cs);
        const double lr = er * cs, li = er * sn;
        double pr = 1.0, pi_ = 0.0;
        for (int k = 0; k <= 32; ++k) {
            lamk[(d * 64 + pp) * 33 + k] = (f32x2){(float)pr, (float)pi_};
            const double nr_ = pr * lr - pi_ * li, ni_ = pr * li + pi_ * lr; pr = nr_; pi_ = ni_;
        }
        if (qtr == 0) { const f32x2 l32 = lamk[(d * 64 + pp) * 33 + 32]; *(f32x2*)(p.lamT() + (size_t)(gi * 64 + pp) * 2) = l32; }
        const double nr = lr - 1.0, ni = li, den = are * are + aim * aim;
        const double qr = (nr * are + ni * aim) / den, qi = (ni * are - nr * aim) / den;
        for (int h = 0; h < 16; ++h) {
            const double br = (double)p.b_re[((size_t)gi * 64 + pp) * 16 + h], bi = (double)p.b_im[((size_t)gi * 64 + pp) * 16 + h];
            Bb[(d * 64 + pp) * 16 + h] = (f32x2){(float)(qr * br - qi * bi), (float)(qr * bi + qi * br)};
        }
    }
    for (int e = tid; e < 2 * 16 * 64; e += NT) {
        const int d = e >> 10, h = (e >> 6) & 15, pp = e & 63; const size_t src = ((size_t)(d * 32 + g) * 16 + h) * 64 + pp;
        Cc[e] = (f32x2){p.c_re[src], p.c_im[src]};
    }
    __syncthreads();
    for (int e = tid; e < 2 * 32 * 256; e += NT) {
        const int d = e >> 13, k = (e >> 8) & 31, h = (e >> 4) & 15, h2 = e & 15;
        float sacc = 0.f;
        for (int pp = 0; pp < 64; ++pp) {
            const f32x2 c = Cc[(d * 16 + h) * 64 + pp], l = lamk[(d * 64 + pp) * 33 + k], b = Bb[(d * 64 + pp) * 16 + h2];
            const float clr = c[0] * l[0] - c[1] * l[1], cli = c[0] * l[1] + c[1] * l[0];
            sacc += clr * b[0] - cli * b[1];
        }
        Kc[e] = sacc;
    }
    __syncthreads();
    for (int ch = tid; ch < 128 * 96; ch += NT) {
        const int mrow = 128 * qtr + ch / 96, k0 = (ch % 96) * 8, ii = mrow >> 4, h = mrow & 15;
        float v[8];
        if (k0 < 512) {
            const int jj = k0 >> 4, h20 = k0 & 15;
#pragma unroll
            for (int i = 0; i < 8; ++i) {
                const int h2 = h20 + i; float val = 0.f;
                if (ii >= jj) val += Kc[((0 * 32 + (ii - jj)) * 16 + h) * 16 + h2];
                if (jj >= ii) val += Kc[((1 * 32 + (jj - ii)) * 16 + h) * 16 + h2];
                if (ii == jj && h == h2) val += p.ssm_d[g * 16 + h];
                v[i] = val;
            }
        } else {
            const int sc = k0 - 512, d = sc >> 7, ri = (sc >> 6) & 1, p0 = sc & 63, e = d == 0 ? ii + 1 : 32 - ii;
#pragma unroll
            for (int i = 0; i < 8; ++i) {
                const int pp = p0 + i; const f32x2 c = Cc[(d * 16 + h) * 64 + pp], l = lamk[(d * 64 + pp) * 33 + e];
                const float clr = c[0] * l[0] - c[1] * l[1], cli = c[0] * l[1] + c[1] * l[0];
                v[i] = ri == 0 ? clr : -cli;
            }
        }
        u32x4 o; o.x = pk2(v[0], v[1]); o.y = pk2(v[2], v[3]); o.z = pk2(v[4], v[5]); o.w = pk2(v[6], v[7]);
        *(u32x4*)(p.Kmat() + ((size_t)(g * 512 + mrow) * SSM_LD + k0)) = o;
    }
    for (int ch = tid; ch < 64 * 64; ch += NT) {
        const int nrow = 64 * qtr + ch / 64, k0 = (ch % 64) * 8, d = nrow >> 7, ri = (nrow >> 6) & 1, pp = nrow & 63;
        const int jj = k0 >> 4, h20 = k0 & 15, e = d == 0 ? 31 - jj : jj;
        const f32x2 l = lamk[(d * 64 + pp) * 33 + e];
        float v[8];
#pragma unroll
        for (int i = 0; i < 8; ++i) { const f32x2 b = Bb[(d * 64 + pp) * 16 + h20 + i]; v[i] = ri == 0 ? (l[0] * b[0] - l[1] * b[1]) : (l[0] * b[1] + l[1] * b[0]); }
        u32x4 o; o.x = pk2(v[0], v[1]); o.y = pk2(v[2], v[3]); o.z = pk2(v[4], v[5]); o.w = pk2(v[6], v[7]);
        *(u32x4*)(p.Win() + ((size_t)(g * 256 + nrow) * 512 + k0)) = o;
    }
    __syncthreads();
}
__device__ __forceinline__ void ph_carry(const P& p) {
    const int tid = threadIdx.x;
    if (tid >= 128) return;
    for (int gidx = blockIdx.x * 128 + tid; gidx < 32 * 8 * 2 * 64; gidx += gridDim.x * 128) {
        const int pp = gidx & 63, d = (gidx >> 6) & 1, b = (gidx >> 7) & 7, g = gidx >> 10;
        const f32x2 lt = *(const f32x2*)(p.lamT() + (size_t)((d * 32 + g) * 64 + pp) * 2);
        const float* Eg = p.E() + (size_t)g * SSM_ROWS * 256 + d * 128 + pp;
        bf16_t* Ug = p.U() + (size_t)g * SSM_ROWS * SSM_LD + 512 + d * 128 + pp;
        float fr = 0.f, fi = 0.f;
#pragma unroll
        for (int cc = 0; cc < 8; ++cc) {
            const int n = 1024 + b * 8 + (d == 0 ? cc : 7 - cc);
            const float er = Eg[(size_t)n * 256], ei = Eg[(size_t)n * 256 + 64];
            const float nr = lt[0] * fr - lt[1] * fi + er, ni = lt[0] * fi + lt[1] * fr + ei; fr = nr; fi = ni;
        }
#pragma unroll 8
        for (int c = 0; c < 128; ++c) {
            const int n = b * 128 + (d == 0 ? c : 127 - c);
            const float er = Eg[(size_t)n * 256], ei = Eg[(size_t)n * 256 + 64];
            Ug[(size_t)n * SSM_LD] = (bf16_t)f2bf(fr); Ug[(size_t)n * SSM_LD + 64] = (bf16_t)f2bf(fi);
            const float nr = lt[0] * fr - lt[1] * fi + er, ni = lt[0] * fi + lt[1] * fr + ei; fr = nr; fi = ni;
        }
    }
}


__device__ __forceinline__ void p0_transpose_item(const float* W, int K, int N, bf16_t* WT, LAS float* scr, int item, int lane) {
    const int nblk = N / 32, kb = item / nblk, nb = item % nblk, k0 = 64 * kb, n0 = 32 * nb;
#pragma unroll 8
    for (int i = 0; i < 32; ++i) { const int kk = 2 * i + (lane >> 5); scr[kk * 33 + (lane & 31)] = W[(size_t)(k0 + kk) * N + n0 + (lane & 31)]; }
    asm volatile("s_waitcnt lgkmcnt(0)" ::: "memory");
    const int c = lane & 7;
#pragma unroll
    for (int j = 0; j < 4; ++j) { const int n = (lane >> 3) + 8 * j; const LAS float* s = scr + (8 * c) * 33 + n;
        u32x4 o; o.x = pk2(s[0 * 33], s[1 * 33]); o.y = pk2(s[2 * 33], s[3 * 33]); o.z = pk2(s[4 * 33], s[5 * 33]); o.w = pk2(s[6 * 33], s[7 * 33]);
        *(u32x4*)(WT + (size_t)(n0 + n) * K + k0 + 8 * c) = o; }
    asm volatile("s_waitcnt lgkmcnt(0)" ::: "memory");
}

template <int NR, bool SILU>
__device__ __forceinline__ void gemv_block64(const float* const (&rows)[NR], const float* W, int ldw, int col0, const float* bias, float* y, int ldy, LAS float* scr) {
    const int wave = threadIdx.x >> 6, lane = threadIdx.x & 63;
    float acc[NR];
#pragma unroll
    for (int r = 0; r < NR; ++r) acc[r] = 0.f;
    const int kb = wave * 128;
#pragma unroll 4
    for (int k = kb; k < kb + 128; ++k) {
        const float w = W[(size_t)k * ldw + col0 + lane];
#pragma unroll
        for (int r = 0; r < NR; ++r) { const float s = rows[r][k]; acc[r] += (SILU ? siluf_(s) : s) * w; }
    }
#pragma unroll
    for (int r = 0; r < NR; ++r) scr[(wave * NR + r) * 64 + lane] = acc[r];
    __syncthreads();
    for (int e = threadIdx.x; e < NR * 64; e += NT) {
        const int r = e >> 6, l = e & 63; float s = 0.f;
#pragma unroll
        for (int w = 0; w < 8; ++w) s += scr[(w * NR + r) * 64 + l];
        y[(size_t)r * ldy + col0 + l] = s + (bias ? bias[col0 + l] : 0.f);
    }
    __syncthreads();
}

__device__ __forceinline__ void ph_prep(const P& p, LAS unsigned char* lds) {
    const int wave = threadIdx.x >> 6, lane = threadIdx.x & 63, G = gridDim.x;
    for (int cb = blockIdx.x; cb < 96; cb += G) {
        const float* const rows[9] = {p.c, p.c + DM, p.c + 2 * DM, p.c + 3 * DM, p.c + 4 * DM, p.c + 5 * DM, p.c + 6 * DM, p.c + 7 * DM, p.c_ctx};
        gemv_block64<9, true>(rows, p.w_mod, 6 * DM, cb * 64, p.b_mod, p.mod(), 6 * DM, (LAS float*)lds);
    }
    for (int it = G - 1 - (int)blockIdx.x; it < 128; it += G) ssm_prep_item(p, lds, it);
    {
        LAS float* scr = (LAS float*)(lds + wave * 16384);
        const int gw = blockIdx.x * NWAVES + wave, NGW = G * NWAVES;
        constexpr int I_IN = (DM / 64) * (INC / 32), I_GLU = (512 / 64) * (512 / 32), I_A = (512 / 64) * (DM / 32), I_OUT = (DM / 64) * (DM / 32), I_Q = (DM / 64) * (2048 / 32);
        constexpr int NITEMS = I_IN + I_GLU + 2 * I_A + I_OUT + I_Q;
        for (int it = gw; it < NITEMS; it += NGW) {
            int r = it;
            if (r < I_IN) { p0_transpose_item(p.w_in, DM, INC, p.w_in_t(), scr, r, lane); continue; } r -= I_IN;
            if (r < I_GLU) { p0_transpose_item(p.w_glu, 512, 512, p.w_glu_t(), scr, r, lane); continue; } r -= I_GLU;
            if (r < I_A) { p0_transpose_item(p.w_a, 512, DM, p.w_a_t(), scr, r, lane); continue; } r -= I_A;
            if (r < I_A) { p0_transpose_item(p.w_b, 512, DM, p.w_b_t(), scr, r, lane); continue; } r -= I_A;
            if (r < I_OUT) { p0_transpose_item(p.w_out, DM, DM, p.w_out_t(), scr, r, lane); continue; } r -= I_OUT;
            p0_transpose_item(p.w_q, DM, 2048, p.w_q_t(), scr, r, lane);
        }
    }
    {
        const size_t nchunk = (size_t)16384 * DM / 8, gsz = (size_t)G * NT;
        for (size_t i = (size_t)blockIdx.x * NT + threadIdx.x; i < 2 * nchunk; i += gsz) {
            const bool second = i >= nchunk; const size_t j = second ? i - nchunk : i;
            const float* src = (second ? p.peer_v : p.peer_u) + j * 8;
            const f32x4 a = *(const f32x4*)src, b = *(const f32x4*)(src + 4);
            u32x4 o; o.x = pk2(a[0], a[1]); o.y = pk2(a[2], a[3]); o.z = pk2(b[0], b[1]); o.w = pk2(b[2], b[3]);
            *(u32x4*)((second ? p.pv() : p.pu()) + j * 8) = o;
        }
    }
}


__device__ __forceinline__ void normmod_row_bf16(const float* src, bf16_t* dst, const float* g, const float* shift, const float* scale, int lane) {
    const f32x4* s = (const f32x4*)src;
    f32x4 v[4]; float ss = 0.f;
#pragma unroll
    for (int j = 0; j < 4; ++j) { v[j] = s[lane + 64 * j]; ss += v[j][0] * v[j][0] + v[j][1] * v[j][1] + v[j][2] * v[j][2] + v[j][3] * v[j][3]; }
    ss = wave_sum(ss);
    const float rstd = rsqrtf(ss * (1.f / DM) + EPSN);
#pragma unroll
    for (int j = 0; j < 4; ++j) {
        const int i4 = lane + 64 * j;
        const f32x4 gg = ((const f32x4*)g)[i4], sh = ((const f32x4*)shift)[i4], sc = ((const f32x4*)scale)[i4];
        const f32x4 o = v[j] * rstd * gg * (sc + 1.f) + sh;
        u32x2 w; w.x = pk2(o[0], o[1]); w.y = pk2(o[2], o[3]);
        *(u32x2*)(dst + (size_t)i4 * 4) = w;
    }
}
__device__ __forceinline__ void ph_norm1(const P& p, LAS unsigned char* lds) {
    const int wave = threadIdx.x >> 6, lane = threadIdx.x & 63, G = gridDim.x;
    for (int cb = blockIdx.x; cb < 32; cb += G) {
        const float* m3 = p.mod() + 3 * DM;
        const float* const rows[8] = {m3, m3 + 6 * DM, m3 + 12 * DM, m3 + 18 * DM, m3 + 24 * DM, m3 + 30 * DM, m3 + 36 * DM, m3 + 42 * DM};
        gemv_block64<8, false>(rows, p.w_q, 2048, cb * 64, nullptr, p.c2(), 2048, (LAS float*)lds);
    }
    for (int r = blockIdx.x * NWAVES + wave; r < NTOK + NCTX; r += G * NWAVES) {
        if (r < NTOK) { const float* modb = p.mod() + (size_t)(r >> 12) * (6 * DM); normmod_row_bf16(p.x + (size_t)r * DM, p.hx() + (size_t)r * DM, p.norm1_g, modb, modb + DM, lane); }
        else { const int rc = r - NTOK; const float* modc = p.mod() + 8 * (6 * DM); normmod_row_bf16(p.ctx + (size_t)rc * DM, p.hc() + (size_t)rc * DM, p.norm1_g, modc, modc + DM, lane); }
    }
}

typedef short s16x4 __attribute__((ext_vector_type(4)));
__device__ __forceinline__ void ph_na(const P& p, LAS unsigned char* lds) {
    const int tid = threadIdx.x, h = tid >> 6, lane = tid & 63, lt = lane & 15, lq = lane >> 4;
    LAS float* rp = (LAS float*)lds;
    for (int e = tid; e < 8 * 15 * 31; e += NT) rp[e] = p.rpb[e];
    __syncthreads();
    for (int item = blockIdx.x; item < NB * GW; item += gridDim.x) {
        const int b = item >> 6, r = item & 63;
        int r0 = r - 4; r0 = r0 < 0 ? 0 : (r0 > 56 ? 56 : r0);
        const bf16_t* Kb = p.kb() + (size_t)b * SEQL * 512 + h * 64 + lq * 8;
        const bf16_t* Kc = p.kc() + (size_t)b * CTXL * 512 + h * 64 + lq * 8;
        const bf16_t* Vt = p.vT() + (size_t)((b * 8 + h) * 64 + lt) * SEQL + lq * 4;
        const bf16_t* Vc = p.vcT() + (size_t)((b * 8 + h) * 64 + lt) * CTXL + lq * 4;
#pragma unroll 1
        for (int cqi = 0; cqi < 4; ++cqi) {
            const int cq = cqi * 16;
            int cw = cq - 8; cw = cw < 0 ? 0 : (cw > 32 ? 32 : cw);
            const int qc = cq + lt;
            int c0 = qc - 8; c0 = c0 < 0 ? 0 : (c0 > 48 ? 48 : c0);
            const size_t tq = (size_t)b * SEQL + r * GW + qc;
            bf16x8 qf[2];
            qf[0] = *(const bf16x8*)(p.qb() + tq * 512 + h * 64 + lq * 8); qf[1] = *(const bf16x8*)(p.qb() + tq * 512 + h * 64 + 32 + lq * 8);
            f32x4 o[4];
#pragma unroll
            for (int d = 0; d < 4; ++d) o[d] = (f32x4){0.f, 0.f, 0.f, 0.f};
            float m = -1e30f, l = 0.f;
#pragma unroll 1
            for (int chunk = 0; chunk < 4; ++chunk) {
                f32x4 s[8];
#pragma unroll
                for (int blk = 0; blk < 8; ++blk) {
                    const bf16_t* kp;
                    if (chunk < 2) kp = Kb + (size_t)((r0 + chunk * 4 + (blk >> 1)) * GW + cw + (blk & 1) * 16 + lt) * 512;
                    else kp = Kc + (size_t)((chunk - 2) * 128 + blk * 16 + lt) * 512;
                    const bf16x8 k0 = *(const bf16x8*)kp, k1 = *(const bf16x8*)(kp + 32);
                    f32x4 c = {0.f, 0.f, 0.f, 0.f};
                    c = __builtin_amdgcn_mfma_f32_16x16x32_bf16(k0, qf[0], c, 0, 0, 0);
                    c = __builtin_amdgcn_mfma_f32_16x16x32_bf16(k1, qf[1], c, 0, 0, 0);
                    s[blk] = c;
                }
                float mx = -1e30f;
#pragma unroll
                for (int blk = 0; blk < 8; ++blk)
#pragma unroll
                    for (int rr = 0; rr < 4; ++rr) {
                        float t = s[blk][rr] * 0.125f;
                        if (chunk < 2) {
                            const int i = chunk * 4 + (blk >> 1), kc = cw + (blk & 1) * 16 + lq * 4 + rr;
                            const bool valid = kc >= c0 && kc < c0 + 16;
                            const int idx = valid ? ((h * 15 + (r0 + i - r + 7)) * 31 + (kc - qc + 15)) : 0;
                            t = valid ? t + rp[idx] : -1e30f;
                        }
                        s[blk][rr] = t; mx = fmaxf(mx, t);
                    }
                mx = fmaxf(mx, __shfl_xor(mx, 16)); mx = fmaxf(mx, __shfl_xor(mx, 32));
                const float mn = fmaxf(m, mx), corr = __expf(m - mn);
                m = mn; l *= corr;
#pragma unroll
                for (int d = 0; d < 4; ++d) o[d] = o[d] * corr;
#pragma unroll
                for (int st = 0; st < 4; ++st) {
                    float pe[8];
#pragma unroll
                    for (int rr = 0; rr < 4; ++rr) { pe[rr] = __expf(s[2 * st][rr] - mn); pe[4 + rr] = __expf(s[2 * st + 1][rr] - mn); }
#pragma unroll
                    for (int i = 0; i < 8; ++i) l += pe[i];
                    u32x4 pw; pw.x = pk2(pe[0], pe[1]); pw.y = pk2(pe[2], pe[3]); pw.z = pk2(pe[4], pe[5]); pw.w = pk2(pe[6], pe[7]);
                    const bf16x8 pf = __builtin_bit_cast(bf16x8, pw);
                    const bf16_t* vp;
                    if (chunk < 2) vp = Vt + (size_t)((r0 + chunk * 4 + st) * GW + cw);
                    else vp = Vc + (size_t)((chunk - 2) * 128 + st * 32);
                    const size_t dstr = chunk < 2 ? (size_t)16 * SEQL : (size_t)16 * CTXL;
#pragma unroll
                    for (int d = 0; d < 4; ++d) {
                        const u32x2 va = *(const u32x2*)(vp + d * dstr), vb = *(const u32x2*)(vp + d * dstr + 16);
                        u32x4 vw; vw.x = va.x; vw.y = va.y; vw.z = vb.x; vw.w = vb.y;
                        o[d] = __builtin_amdgcn_mfma_f32_16x16x32_bf16(__builtin_bit_cast(bf16x8, vw), pf, o[d], 0, 0, 0);
                    }
                }
            }
            l += __shfl_xor(l, 16); l += __shfl_xor(l, 32);
            const float inv = 1.f / l;
            bf16_t* op = p.na() + tq * 512 + h * 64 + lq * 4;
#pragma unroll
            for (int d = 0; d < 4; ++d) { u32x2 w; w.x = pk2(o[d][0] * inv, o[d][1] * inv); w.y = pk2(o[d][2] * inv, o[d][3] * inv); *(u32x2*)(op + d * 16) = w; }
        }
    }
}

typedef __bf16 bf16x2_t __attribute__((ext_vector_type(2)));
__device__ __forceinline__ float dot2bf(unsigned a, unsigned b, float c) { return __builtin_amdgcn_fdot2_f32_bf16(__builtin_bit_cast(bf16x2_t, a), __builtin_bit_cast(bf16x2_t, b), c, false); }
__device__ __forceinline__ unsigned ordkey(float f) { unsigned u = __builtin_bit_cast(unsigned, f); return u ^ ((unsigned)((int)u >> 31) | 0x80000000u); }
__device__ __forceinline__ float unordkey(unsigned k) { return __builtin_bit_cast(float, k ^ ((k & 0x80000000u) ? 0x80000000u : 0xFFFFFFFFu)); }
template <bool DESC> __device__ __forceinline__ void cex(unsigned& a, unsigned& b) { const unsigned mx = a > b ? a : b, mn = a > b ? b : a; if (DESC) { a = mx; b = mn; } else { a = mn; b = mx; } }
__device__ __forceinline__ void sort16_desc(unsigned (&a)[16]) {
#pragma unroll
    for (int k = 2; k <= 16; k <<= 1)
#pragma unroll
        for (int j = k >> 1; j > 0; j >>= 1)
#pragma unroll
            for (int i = 0; i < 16; ++i) { const int l = i ^ j; if (l > i) { if ((i & k) == 0) cex<true>(a[i], a[l]); else cex<false>(a[i], a[l]); } }
}
__device__ __forceinline__ void merge16_desc(unsigned (&a)[16]) {
#pragma unroll
    for (int j = 8; j > 0; j >>= 1)
#pragma unroll
        for (int i = 0; i < 16; ++i) { const int l = i ^ j; if (l > i) cex<true>(a[i], a[l]); }
}
__device__ __forceinline__ void top16_merge(unsigned (&a)[16], const unsigned (&b)[16]) {
#pragma unroll
    for (int i = 0; i < 16; ++i) a[i] = a[i] > b[15 - i] ? a[i] : b[15 - i];
    merge16_desc(a);
}
struct PairTab { int i[52], j[52], n; };
constexpr PairTab make_pairs() { PairTab t{}; int n = 0; for (int i = 0; i < 16; ++i) for (int j = 0; j < 16; ++j) if ((i + 1) * (j + 1) <= 16) { t.i[n] = i; t.j[n] = j; ++n; } t.n = n; for (int k = n; k < 52; ++k) { t.i[k] = 0; t.j[k] = 0; } return t; }
constexpr PairTab PAIRS = make_pairs();
static_assert(PAIRS.n == 50, "50 candidate pairs");

constexpr int SK_LD = 136;
__device__ __forceinline__ void ph_peer_topk(const P& p, LAS unsigned char* lds) {
    const int tid = threadIdx.x, wave = tid >> 6, lane = tid & 63;
    LAS bf16_t* sk = (LAS bf16_t*)lds;
    for (int e = tid; e < 2 * 128 * 16; e += NT) {
        const int row = e >> 4, c8 = (e & 15) * 8;
        const f32x4 a = *(const f32x4*)(p.subkeys + (size_t)row * 128 + c8), b = *(const f32x4*)(p.subkeys + (size_t)row * 128 + c8 + 4);
        u32x4 o; o.x = pk2(a[0], a[1]); o.y = pk2(a[2], a[3]); o.z = pk2(b[0], b[1]); o.w = pk2(b[2], b[3]);
        *(LAS u32x4*)(sk + row * SK_LD + c8) = o;
    }
    __syncthreads();
    const int lt = lane & 15, lq = lane >> 4;
    for (int tile = blockIdx.x * NWAVES + wave; tile < NTOK / 16; tile += gridDim.x * NWAVES) {
        const int tok = tile * 16 + lt;
        const bf16_t* qrow = p.qp() + (size_t)tok * 2048;
        for (int h = 0; h < 8; ++h) {
            unsigned s0[16], s1[16];
#pragma unroll
            for (int n = 0; n < 2; ++n) {
                bf16x8 bq[4];
#pragma unroll
                for (int ks = 0; ks < 4; ++ks) bq[ks] = *(const bf16x8*)(qrow + h * 256 + n * 128 + ks * 32 + lq * 8);
                unsigned a[16], b[16];
#pragma unroll
                for (int kb = 0; kb < 8; ++kb) {
                    f32x4 c = {0.f, 0.f, 0.f, 0.f};
#pragma unroll
                    for (int ks = 0; ks < 4; ++ks) {
                        const bf16x8 ak = *(const LAS bf16x8*)(sk + (n * 128 + kb * 16 + lt) * SK_LD + ks * 32 + lq * 8);
                        c = __builtin_amdgcn_mfma_f32_16x16x32_bf16(ak, bq[ks], c, 0, 0, 0);
                    }
#pragma unroll
                    for (int r = 0; r < 4; ++r) {
                        const unsigned key = (ordkey(c[r]) & ~127u) | (unsigned)(kb * 16 + lq * 4 + r);
                        if (kb < 4) a[kb * 4 + r] = key; else b[(kb - 4) * 4 + r] = key;
                    }
                    asm volatile("" ::: "memory");
                }
                sort16_desc(a); sort16_desc(b);
                top16_merge(a, b);
#pragma unroll
                for (int i = 0; i < 16; ++i) b[i] = __shfl_xor(a[i], 16);
                top16_merge(a, b);
#pragma unroll
                for (int i = 0; i < 16; ++i) b[i] = __shfl_xor(a[i], 32);
                top16_merge(a, b);
                if (n == 0) {
#pragma unroll
                    for (int i = 0; i < 16; ++i) s0[i] = a[i];
                } else {
#pragma unroll
                    for (int i = 0; i < 16; ++i) s1[i] = a[i];
                }
            }
            unsigned ck[16], ce_[13]; float cs[13];
#pragma unroll
            for (int s = 0; s < 13; ++s) {
                const unsigned k0 = lq == 0 ? s0[PAIRS.i[s * 4]] : (lq == 1 ? s0[PAIRS.i[s * 4 + 1]] : (lq == 2 ? s0[PAIRS.i[s * 4 + 2]] : s0[PAIRS.i[s * 4 + 3]]));
                const unsigned k1 = lq == 0 ? s1[PAIRS.j[s * 4]] : (lq == 1 ? s1[PAIRS.j[s * 4 + 1]] : (lq == 2 ? s1[PAIRS.j[s * 4 + 2]] : s1[PAIRS.j[s * 4 + 3]]));
                const float sum = unordkey(k0 & ~127u) + unordkey(k1 & ~127u);
                const bool valid = (s * 4 + lq) < PAIRS.n;
                cs[s] = sum; ce_[s] = (k0 & 127u) * 128u + (k1 & 127u);
                ck[s] = valid ? ((ordkey(sum) & ~63u) | (unsigned)(s * 4 + lq)) : 0u;
            }
            ck[13] = 0u; ck[14] = 0u; ck[15] = 0u;
            unsigned srt[16], ob[16];
#pragma unroll
            for (int i = 0; i < 16; ++i) srt[i] = ck[i];
            sort16_desc(srt);
#pragma unroll
            for (int i = 0; i < 16; ++i) ob[i] = __shfl_xor(srt[i], 16);
            top16_merge(srt, ob);
#pragma unroll
            for (int i = 0; i < 16; ++i) ob[i] = __shfl_xor(srt[i], 32);
            unsigned thr = 0xFFFFFFFFu;
#pragma unroll
            for (int i = 0; i < 16; ++i) { const unsigned v = srt[i] > ob[15 - i] ? srt[i] : ob[15 - i]; thr = v < thr ? v : thr; }
            const float mtop = unordkey(s0[0] & ~127u) + unordkey(s1[0] & ~127u);
            float zp = 0.f; int cnt = 0;
#pragma unroll
            for (int s = 0; s < 13; ++s) { const bool sel = ck[s] >= thr && ck[s] != 0u; const float e = sel ? __expf(cs[s] - mtop) : 0.f; cs[s] = e; zp += e; cnt += sel ? 1 : 0; }
            float z = zp; z += __shfl_xor(z, 16); z += __shfl_xor(z, 32);
            const float rz = 1.f / z;
            const int c0 = __shfl(cnt, lt), c1 = __shfl(cnt, lt + 16), c2 = __shfl(cnt, lt + 32);
            int pos = lq == 0 ? 0 : (lq == 1 ? c0 : (lq == 2 ? c0 + c1 : c0 + c1 + c2));
            u32x2* dst = (u32x2*)p.topk() + ((size_t)tok * 8 + h) * 16;
#pragma unroll
            for (int s = 0; s < 13; ++s) {
                const bool sel = ck[s] >= thr && ck[s] != 0u;
                if (sel) { u32x2 o; o.x = ce_[s]; o.y = __builtin_bit_cast(unsigned, cs[s] * rz); dst[pos] = o; ++pos; }
            }
        }
    }
}

__device__ __forceinline__ void ph_peer_gather(const P& p) {
    const int wave = threadIdx.x >> 6, lane = threadIdx.x & 63;
    for (int tok = blockIdx.x * NWAVES + wave; tok < NTOK; tok += gridDim.x * NWAVES) {
        const int b = tok >> 12;
        const float* modb = p.mod() + (size_t)b * (6 * DM);
        float acc[16]; unsigned hp[8];
        const float rstd2 = rsqrtf(p.rowss()[tok] * (1.f / DM) + EPSN);
#pragma unroll
        for (int j = 0; j < 2; ++j)
#pragma unroll
            for (int q4 = 0; q4 < 2; ++q4) {
                const int e0 = j * 512 + lane * 8 + q4 * 4;
                const f32x4 xv = *(const f32x4*)(p.out + (size_t)tok * DM + e0), gg = *(const f32x4*)(p.norm2_g + e0), sh = *(const f32x4*)(modb + 3 * DM + e0), sc = *(const f32x4*)(modb + 4 * DM + e0);
                const f32x4 hv = xv * rstd2 * gg * (sc + 1.f) + sh;
#pragma unroll
                for (int i = 0; i < 4; ++i) acc[j * 8 + q4 * 4 + i] = 0.f;
                hp[j * 4 + q4 * 2] = pk2(hv[0], hv[1]); hp[j * 4 + q4 * 2 + 1] = pk2(hv[2], hv[3]);
            }
        const u32x2* tk = (const u32x2*)p.topk() + (size_t)tok * 128;
        const u32x2 ent0 = tk[lane], ent1 = tk[lane + 64];
#pragma unroll 1
        for (int k0 = 0; k0 < 128; k0 += 8) {
            u32x4 uu[8][2], vv[8][2]; float gk[8];
#pragma unroll
            for (int i = 0; i < 8; ++i) {
                const int k = k0 + i;
                const unsigned ex = k0 < 64 ? ent0.x : ent1.x, gx = k0 < 64 ? ent0.y : ent1.y;
                const unsigned e = __builtin_amdgcn_readlane(ex, k & 63);
                gk[i] = __builtin_bit_cast(float, __builtin_amdgcn_readlane(gx, k & 63));
                const bf16_t* ur = p.pu() + (size_t)e * DM + lane * 8; const bf16_t* vr = p.pv() + (size_t)e * DM + lane * 8;
                uu[i][0] = *(const u32x4*)ur; uu[i][1] = *(const u32x4*)(ur + 512);
                vv[i][0] = *(const u32x4*)vr; vv[i][1] = *(const u32x4*)(vr + 512);
            }
            float pd[8];
#pragma unroll
            for (int i = 0; i < 8; ++i) {
                float d = 0.f;
#pragma unroll
                for (int j = 0; j < 2; ++j) {
                    const unsigned u0 = uu[i][j][0], u1 = uu[i][j][1], u2 = uu[i][j][2], u3 = uu[i][j][3];
                    d = dot2bf(u0, hp[j * 4 + 0], d); d = dot2bf(u1, hp[j * 4 + 1], d); d = dot2bf(u2, hp[j * 4 + 2], d); d = dot2bf(u3, hp[j * 4 + 3], d);
                }
                pd[i] = d;
            }
            float r4[4], r2[2], r1;
            { const bool hi = lane & 32;
#pragma unroll
              for (int i = 0; i < 4; ++i) { const float keep = hi ? pd[i + 4] : pd[i], send = hi ? pd[i] : pd[i + 4]; r4[i] = keep + __shfl_xor(send, 32); } }
            { const bool hi = lane & 16;
#pragma unroll
              for (int i = 0; i < 2; ++i) { const float keep = hi ? r4[i + 2] : r4[i], send = hi ? r4[i] : r4[i + 2]; r2[i] = keep + __shfl_xor(send, 16); } }
            { const bool hi = lane & 8; const float keep = hi ? r2[1] : r2[0], send = hi ? r2[0] : r2[1]; r1 = keep + __shfl_xor(send, 8); }
            r1 += __shfl_xor(r1, 4); r1 += __shfl_xor(r1, 2); r1 += __shfl_xor(r1, 1);
#pragma unroll
            for (int i = 0; i < 8; ++i) {
                const float a = __builtin_bit_cast(float, __builtin_amdgcn_readlane(__builtin_bit_cast(unsigned, r1), ((i >> 2) & 1) * 32 + ((i >> 1) & 1) * 16 + (i & 1) * 8));
                const float w = gk[i] * gelu_tanh(a);
#pragma unroll
                for (int j = 0; j < 2; ++j) {
                    acc[j * 8 + 0] += w * bflo(vv[i][j].x); acc[j * 8 + 1] += w * bfhi(vv[i][j].x); acc[j * 8 + 2] += w * bflo(vv[i][j].y); acc[j * 8 + 3] += w * bfhi(vv[i][j].y);
                    acc[j * 8 + 4] += w * bflo(vv[i][j].z); acc[j * 8 + 5] += w * bfhi(vv[i][j].z); acc[j * 8 + 6] += w * bflo(vv[i][j].w); acc[j * 8 + 7] += w * bfhi(vv[i][j].w);
                }
            }
        }
        float ss = 0.f; float x1v[16];
#pragma unroll
        for (int j = 0; j < 2; ++j)
#pragma unroll
            for (int q4 = 0; q4 < 2; ++q4) {
                const int e0 = j * 512 + lane * 8 + q4 * 4;
                const f32x4 g2 = *(const f32x4*)(modb + 5 * DM + e0), xv = *(const f32x4*)(p.out + (size_t)tok * DM + e0);
#pragma unroll
                for (int i = 0; i < 4; ++i) { const int ix = j * 8 + q4 * 4 + i; x1v[ix] = xv[i] + g2[i] * acc[ix]; ss += x1v[ix] * x1v[ix]; }
            }
        ss = wave_sum(ss);
        const float rstd = rsqrtf(ss * (1.f / DM) + EPSN);
#pragma unroll
        for (int j = 0; j < 2; ++j)
#pragma unroll
            for (int q4 = 0; q4 < 2; ++q4) {
                const int e0 = j * 512 + lane * 8 + q4 * 4;
                const f32x4 fg = *(const f32x4*)(p.final_g + e0);
                f32x4 o;
#pragma unroll
                for (int i = 0; i < 4; ++i) o[i] = x1v[j * 8 + q4 * 4 + i] * rstd * fg[i];
                *(f32x4*)(p.out + (size_t)tok * DM + e0) = o;
            }
    }
}

constexpr int LDS_BYTES = 147456;
#define GSYNC() cg::this_grid().sync()

__global__ void __launch_bounds__(NT, 2) mega(P p) {
    extern __shared__ __attribute__((aligned(16))) unsigned char lds_raw[];
    LAS unsigned char* lds = (LAS unsigned char*)lds_raw;
    const int G = gridDim.x, bx = blockIdx.x;
    using namespace pg8;

    ph_prep(p, lds);
    GSYNC();
    ph_norm1(p, lds);
    GSYNC();
    {
        Gemm<DM, DM, DM> g{p.hx(), p.w_in_t()}; StaticOrder<NTOK, INC> S; S.init(G, bx);
        EpiInProj E{p.U(), p.kb(), (size_t)(p.qb() - p.kb()), p.vT(), p.ga(), 0};
        gemm_phase<EpiInProj, StaticOrder<NTOK, INC>, true, true>(lds, g, S, E);
        Gemm<DM, DM, DM> g2{p.hc(), p.w_in_t()}; StaticOrder<NCTX, CTXC> S2; S2.init(G, bx);
        EpiInProj E2{p.U(), p.kc(), 0, p.vcT(), p.ga(), 1};
        gemm_phase<EpiInProj, StaticOrder<NCTX, CTXC>, true, true>(lds, g2, S2, E2);
    }
    GSYNC();
    {
        Gemm<512, SSM_LD, 512, (long)SSM_ROWS * SSM_LD, 256L * 512> g{p.U(), p.Win()}; StaticOrder<SSM_ROWS, 256, 32> S; S.init(G, bx);
        EpiE E{p.E()};
        gemm_phase<EpiE, StaticOrder<SSM_ROWS, 256, 32>, true, true>(lds, g, S, E);
    }
    GSYNC();
    ph_carry(p);
    ph_na(p, lds);
    GSYNC();
    {
        Gemm<SSM_LD, SSM_LD, SSM_LD, (long)SSM_ROWS * SSM_LD, 512L * SSM_LD> g{p.U(), p.Kmat()}; StaticOrder<1024, 512, 32> S; S.init(G, bx);
        EpiZ E{p.z()};
        gemm_phase<EpiZ, StaticOrder<1024, 512, 32>, true, true>(lds, g, S, E);
    }
    GSYNC();
    {
        Gemm<512, 512, 512> g{p.z(), p.w_glu_t()}; StaticOrder<NTOK, 512> S; S.init(G, bx);
        EpiGlu E{p.gl(), p.z(), p.b_glu};
        gemm_phase<EpiGlu, StaticOrder<NTOK, 512>, true, true>(lds, g, S, E);
    }
    GSYNC();
    {
        Gemm<512, 512, 512> g{p.gl(), p.w_a_t()}; StaticOrder<NTOK, DM> S; S.init(G, bx);
        EpiBrA E{p.tbuf(), p.ga()};
        gemm_phase<EpiBrA, StaticOrder<NTOK, DM>, true, true>(lds, g, S, E);
        Gemm<512, 512, 512> g2{p.na(), p.w_b_t()};
        EpiBrB E2{p.merged(), p.tbuf(), p.gb()};
        gemm_phase<EpiBrB, StaticOrder<NTOK, DM>, true, true>(lds, g2, S, E2);
    }
    GSYNC();
    {
        Gemm<DM, DM, DM> g{p.merged(), p.w_out_t()}; StaticOrder<NTOK, DM> S; S.init(G, bx);
        EpiOut E{p.x, p.out, p.x1g(), p.mod(), p.norm2_g, p.rowss()};
        gemm_phase<EpiOut, StaticOrder<NTOK, DM>, true, true>(lds, g, S, E);
    }
    GSYNC();
    {
        Gemm<DM, DM, DM> g{p.x1g(), p.w_q_t()}; StaticOrder<NTOK, 2048> S; S.init(G, bx);
        EpiQ E{p.qp(), p.rowss(), p.c2()};
        gemm_phase<EpiQ, StaticOrder<NTOK, 2048>, true, true>(lds, g, S, E);
    }
    GSYNC();
    ph_peer_topk(p, lds);
    GSYNC();
    ph_peer_gather(p);
}

extern "C" void kernel_launch(void* const* d_in, const int* in_sizes, int n_in, void* d_out, int out_size, void* d_ws, size_t ws_size, hipStream_t stream) {
    static int grid = 0;
    if (grid == 0) {
        int dev = 0, cus = 0, per_cu = 0;
        (void)hipGetDevice(&dev);
        (void)hipDeviceGetAttribute(&cus, hipDeviceAttributeMultiprocessorCount, dev);
        (void)hipFuncSetAttribute((const void*)mega, hipFuncAttributeMaxDynamicSharedMemorySize, LDS_BYTES);
        (void)hipOccupancyMaxActiveBlocksPerMultiprocessor(&per_cu, (const void*)mega, NT, LDS_BYTES);
        if (per_cu < 1) { fprintf(stderr, "occupancy query says %d blocks per CU\n", per_cu); per_cu = 1; }
        grid = cus;
    }
    P p{};
    const float* const* in = (const float* const*)d_in;
    p.x = in[0]; p.c = in[1]; p.ctx = in[2]; p.c_ctx = in[3]; p.w_mod = in[4]; p.b_mod = in[5]; p.norm1_g = in[6]; p.norm2_g = in[7]; p.w_in = in[8];
    p.a_re = in[9]; p.a_im = in[10]; p.log_dt = in[11]; p.b_re = in[12]; p.b_im = in[13]; p.c_re = in[14]; p.c_im = in[15]; p.ssm_d = in[16];
    p.w_glu = in[17]; p.b_glu = in[18]; p.w_a = in[19]; p.w_b = in[20]; p.rpb = in[21]; p.w_out = in[22]; p.w_q = in[23]; p.subkeys = in[24];
    p.peer_u = in[25]; p.peer_v = in[26]; p.final_g = in[27];
    p.out = (float*)d_out;
    p.ws = (unsigned char*)d_ws;
    (void)hipMemsetAsync(d_ws, 0, 1 * MiB, stream);
    void* args[] = {&p};
    hipError_t e = hipLaunchCooperativeKernel((const void*)mega, dim3(grid), dim3(NT), args, LDS_BYTES, stream);
    if (e != hipSuccess) fprintf(stderr, "cooperative launch failed: %s (grid %d)\n", hipGetErrorString(e), grid);
}
```

```cpp
#include <hip/hip_runtime.h>
#include <hip/hip_cooperative_groups.h>
#include <cstdio>
#include <cstdint>
namespace cg = cooperative_groups;

#define LAS __attribute__((address_space(3)))
typedef unsigned short bf16_t;
typedef short bf16x8 __attribute__((ext_vector_type(8)));
typedef float f32x4 __attribute__((ext_vector_type(4)));
typedef float f32x2 __attribute__((ext_vector_type(2)));
typedef unsigned u32x4 __attribute__((ext_vector_type(4)));
typedef unsigned u32x2 __attribute__((ext_vector_type(2)));

constexpr int DM = 1024, NB = 8, SEQL = 4096, CTXL = 256, GW = 64, NTOK = NB * SEQL, NCTX = NB * CTXL;
constexpr int INC = 4096, CTXC = 1536;
constexpr int NT = 512, NWAVES = 8;
constexpr float EPSN = 1e-6f;
constexpr int SSM_ROWS = 1280;
constexpr int SSM_LD = 768;

__device__ __forceinline__ unsigned f2bf(float f) { unsigned u = __builtin_bit_cast(unsigned, f); return (u + 0x7fffu + ((u >> 16) & 1u)) >> 16; }
__device__ __forceinline__ unsigned pk2(float lo, float hi) { return f2bf(lo) | (f2bf(hi) << 16); }
__device__ __forceinline__ float bflo(unsigned w) { return __builtin_bit_cast(float, w << 16); }
__device__ __forceinline__ float bfhi(unsigned w) { return __builtin_bit_cast(float, w & 0xffff0000u); }
__device__ __forceinline__ float bf2f(bf16_t h) { return __builtin_bit_cast(float, (unsigned)h << 16); }

__device__ __forceinline__ float wave_sum(float v) {
#pragma unroll
    for (int o = 1; o < 64; o <<= 1) v += __shfl_xor(v, o);
    return v;
}
__device__ __forceinline__ float wave_max(float v) {
#pragma unroll
    for (int o = 1; o < 64; o <<= 1) v = fmaxf(v, __shfl_xor(v, o));
    return v;
}
__device__ __forceinline__ float sigmoidf_(float x) { return 1.f / (1.f + __expf(-x)); }
__device__ __forceinline__ float siluf_(float x) { return x / (1.f + __expf(-x)); }
__device__ __forceinline__ float gelu_tanh(float x) {
    const float k0 = 0.7978845608028654f, k1 = 0.044715f;
    const float u = k0 * (x + k1 * x * x * x);
    const float t = 1.f - 2.f / (1.f + __expf(2.f * u));
    return 0.5f * x * (1.f + t);
}

namespace pg8 {
#define PG8_LAS __attribute__((address_space(3)))
constexpr int BM = 256, BK = 64, HALF = 128, HTB = HALF * BK * 2  , STAGE_BYTES = 8 * HTB, NXCD = 8, WGM = 8;
__host__ __device__ __forceinline__ int lds_byte(int r, int c) { const int st = (r >> 4) * 2 + (c >> 5), rr = r & 15, cc = c & 31, ob = rr * 64 + cc * 2; return st * 1024 + (ob ^ (((ob >> 9) & 1) << 5)); }
__host__ __device__ __forceinline__ void stage_rc(int b, int& R, int& C) { const int st = b / 1024, sb = b % 1024, swz = sb ^ (((sb >> 9) & 1) << 5); R = (st >> 1) * 16 + swz / 64; C = (st & 1) * 32 + (swz % 64) / 2; }
__host__ __device__ __forceinline__ int perm32(int rho) { const int n = rho >> 4, i = rho & 15; return 8 * (i >> 2) + 4 * n + (i & 3); }

struct Unit { int pm, pn, g; };
template <int K_, int LDA, int LDB, long GSA = 0, long GSB = 0>
struct Gemm {
    const bf16_t* A; const bf16_t* Bt;
    static constexpr int K = K_, lda = LDA, ldb = LDB;
    __device__ __forceinline__ const char* abase(const Unit& u) const { return (const char*)(A + (size_t)u.g * GSA + (size_t)u.pm * BM * LDA); }
    __device__ __forceinline__ const char* bbase(const Unit& u) const { return (const char*)(Bt + (size_t)u.g * GSB + (size_t)u.pn * BM * LDB); }
};
template <int M, int N, int NGRP = 1>
struct StaticOrder {
    static constexpr int nM = M / BM, nN = N / BM, nwg = nM * nN;
    int G, c;
    __device__ void init(int G_, int c_) { G = G_; c = c_; }
    __device__ bool next(int i, Unit& u) const {
        const int L = i * G + c; if (L >= nwg * NGRP) return false;
        u.g = L / nwg;
        int wgid = L % nwg; { constexpr int q = nwg / NXCD, r = nwg % NXCD; const int xcd = wgid % NXCD, off = wgid / NXCD; wgid = (xcd < r ? xcd * (q + 1) : r * (q + 1) + (xcd - r) * q) + off; }
        constexpr int nig = WGM * nN; const int gid = wgid / nig, fm = gid * WGM, gsz = (nM - fm) < WGM ? (nM - fm) : WGM;
        u.pm = fm + ((wgid % nig) % gsz); u.pn = (wgid % nig) / gsz; return true;
    }
    __device__ __forceinline__ void a_ready(const Unit&) const {}
    __device__ __forceinline__ void done(const Unit&) const {}
};
__device__ __forceinline__ unsigned cvt_pk_bf16(float lo, float hi) { unsigned r; asm volatile("v_cvt_pk_bf16_f32 %0, %1, %2" : "=v"(r) : "v"(lo), "v"(hi)); return r; }
template <class Epi, class Sched, bool ALIGN_EPI = false, bool SP2 = false, class GemmT>
__device__ __forceinline__ void gemm_phase(PG8_LAS unsigned char* lds, const GemmT g, const Sched& S, const Epi& E) {
    const int tid = threadIdx.x, wid = __builtin_amdgcn_readfirstlane(tid >> 6), lane = tid & 63, wr = wid >> 2, wc = wid & 3, fr = lane & 15, fq = lane >> 4;
    const int K = g.K, nt = K / BK;
    unsigned voffA[2], voffB[2];
#pragma unroll
    for (int i = 0; i < 2; ++i) { int R, C; stage_rc(tid * 16 + i * 8192, R, C); const int Rb = Epi::PERM ? ((R & ~31) + perm32(R & 31)) : R;
        voffA[i] = (unsigned)(R * g.lda + C) * 2u; voffB[i] = (unsigned)(Rb * g.ldb + C) * 2u; }
    const size_t kstep = (size_t)(BK * 2);
    const size_t hstepA = (size_t)HALF * g.lda * 2, hstepB = (size_t)HALF * g.ldb * 2;
    const unsigned ldsw = (unsigned)wid * 1024u;
    const int aoff = lds_byte(wr * 64 + fr, fq * 8), boff = lds_byte(wc * 32 + fr, fq * 8);
#define PG8_SA(b, h) (((b) * 2 + (h)) * HTB)
#define PG8_SB(b, h) ((4 + (b) * 2 + (h)) * HTB)
#define PG8_STAGE(bufoff, gbase, voff) do { _Pragma("unroll") for (int _i = 0; _i < 2; ++_i) \
        __builtin_amdgcn_global_load_lds((const unsigned*)((const char*)(gbase) + (voff)[_i]), (PG8_LAS unsigned*)(lds + (bufoff) + ldsw + _i * 8192), 16, 0, 0); } while (0)
#define PG8_LDA(dst, b, h) do { _Pragma("unroll") for (int m = 0; m < 4; ++m) _Pragma("unroll") for (int k = 0; k < 2; ++k) dst[m][k] = *(const PG8_LAS bf16x8*)(lds + PG8_SA(b, h) + aoff + m * 2048 + k * 1024); } while (0)
#define PG8_LDB(dst, b, h) do { _Pragma("unroll") for (int n = 0; n < 2; ++n) _Pragma("unroll") for (int k = 0; k < 2; ++k) dst[n][k] = *(const PG8_LAS bf16x8*)(lds + PG8_SB(b, h) + boff + n * 2048 + k * 1024); } while (0)
#define PG8_MMA(ai, bj, At, Bt) do { __builtin_amdgcn_s_setprio(1); _Pragma("unroll") for (int m = 0; m < 4; ++m) _Pragma("unroll") for (int n = 0; n < 2; ++n) _Pragma("unroll") for (int k = 0; k < 2; ++k) \
        acc[ai][bj][m][n] = __builtin_amdgcn_mfma_f32_16x16x32_bf16(Bt[n][k], At[m][k], acc[ai][bj][m][n], 0, 0, 0); __builtin_amdgcn_s_setprio(0); } while (0)
#define PG8_WAIT_V(n) asm volatile("s_waitcnt vmcnt(" #n ")" ::: "memory")
#define PG8_WAIT_L(n) asm volatile("s_waitcnt lgkmcnt(" #n ")" ::: "memory")
#define PG8_BAR __builtin_amdgcn_s_barrier()
#define PG8_SCHED __builtin_amdgcn_sched_barrier(0)
    Unit cur, nxt; int ui = 0;
    if (!S.next(0, cur)) return;
    f32x4 acc[2][2][4][2];
#pragma unroll
    for (int a = 0; a < 2; ++a)
#pragma unroll
        for (int b = 0; b < 2; ++b)
#pragma unroll
            for (int m = 0; m < 4; ++m)
#pragma unroll
                for (int n = 0; n < 2; ++n) acc[a][b][m][n] = (f32x4){0.f, 0.f, 0.f, 0.f};
    bf16x8 At[4][2], B0[2][2], B1[2][2];
    const char* cA = g.abase(cur); const char* cB = g.bbase(cur);
    S.a_ready(cur);
    if constexpr (SP2) {
        PG8_STAGE(PG8_SB(0, 0), cB, voffB); PG8_STAGE(PG8_SB(0, 1), cB + hstepB, voffB); PG8_STAGE(PG8_SA(0, 0), cA, voffA); PG8_STAGE(PG8_SA(0, 1), cA + hstepA, voffA);
        if (wr == 1) PG8_BAR;
        PG8_WAIT_V(2); PG8_BAR;
        PG8_STAGE(PG8_SB(1, 0), cB + kstep, voffB); PG8_STAGE(PG8_SA(1, 0), cA + kstep, voffA); PG8_STAGE(PG8_SB(1, 1), cB + hstepB + kstep, voffB);
        PG8_WAIT_V(6); PG8_BAR;
    } else {
        PG8_STAGE(PG8_SB(0, 0), cB, voffB); PG8_STAGE(PG8_SA(0, 0), cA, voffA); PG8_STAGE(PG8_SB(0, 1), cB + hstepB, voffB); PG8_STAGE(PG8_SA(0, 1), cA + hstepA, voffA);
        if (wr == 1) PG8_BAR;
        PG8_WAIT_V(4); PG8_BAR;
        PG8_STAGE(PG8_SB(1, 0), cB + kstep, voffB); PG8_STAGE(PG8_SA(1, 0), cA + kstep, voffA); PG8_STAGE(PG8_SB(1, 1), cB + hstepB + kstep, voffB);
        PG8_WAIT_V(6); PG8_BAR;
    }
    for (;;) {
        const bool has_next = S.next(ui + 1, nxt);
        const char* nA = has_next ? g.abase(nxt) : cA; const char* nB = has_next ? g.bbase(nxt) : cB;
        for (int t = 0; t < nt; t += 2) {
            const bool last = (t == nt - 2);
            const char* a1 = cA + (size_t)(t + 1) * kstep;
            const char* a2 = last ? nA : cA + (size_t)(t + 2) * kstep; const char* b2 = last ? nB : cB + (size_t)(t + 2) * kstep;
            const char* a3 = a2 + kstep; const char* b3 = b2 + kstep;
            if (last && has_next) S.a_ready(nxt);
            if constexpr (SP2) {
            PG8_LDB(B0, 0, 0); PG8_LDB(B1, 0, 1); PG8_SCHED; PG8_LDA(At, 0, 0); PG8_STAGE(PG8_SA(1, 1), a1 + hstepA, voffA);
            PG8_WAIT_V(8); PG8_WAIT_L(0); PG8_BAR; PG8_MMA(0, 0, At, B0); PG8_MMA(0, 1, At, B1); PG8_BAR; PG8_SCHED;
            PG8_LDA(At, 0, 1); PG8_STAGE(PG8_SB(0, 0), b2, voffB); PG8_STAGE(PG8_SB(0, 1), b2 + hstepB, voffB); PG8_STAGE(PG8_SA(0, 0), a2, voffA);
            PG8_WAIT_V(8); PG8_WAIT_L(0); PG8_BAR; PG8_MMA(1, 0, At, B0); PG8_MMA(1, 1, At, B1); PG8_BAR; PG8_SCHED;
            PG8_LDB(B0, 1, 0); PG8_LDB(B1, 1, 1); PG8_SCHED; PG8_LDA(At, 1, 0); PG8_STAGE(PG8_SA(0, 1), a2 + hstepA, voffA);
            PG8_WAIT_V(8); PG8_WAIT_L(0); PG8_BAR; PG8_MMA(0, 0, At, B0); PG8_MMA(0, 1, At, B1); PG8_BAR; PG8_SCHED;
            PG8_LDA(At, 1, 1); PG8_STAGE(PG8_SB(1, 0), b3, voffB); PG8_STAGE(PG8_SB(1, 1), b3 + hstepB, voffB); PG8_STAGE(PG8_SA(1, 0), a3, voffA);
            PG8_WAIT_V(8); PG8_WAIT_L(0); PG8_BAR; PG8_MMA(1, 0, At, B0); PG8_MMA(1, 1, At, B1); PG8_BAR; PG8_SCHED;
            } else {
            PG8_LDB(B0, 0, 0); PG8_SCHED; PG8_LDA(At, 0, 0); PG8_STAGE(PG8_SA(1, 1), a1 + hstepA, voffA);
            PG8_WAIT_L(8); PG8_BAR; PG8_WAIT_L(0); PG8_MMA(0, 0, At, B0); PG8_BAR; PG8_SCHED;
            PG8_LDB(B1, 0, 1); PG8_STAGE(PG8_SB(0, 0), b2, voffB);
            PG8_BAR; PG8_WAIT_L(0); PG8_MMA(0, 1, At, B1); PG8_BAR;
            PG8_LDA(At, 0, 1); PG8_STAGE(PG8_SA(0, 0), a2, voffA);
            PG8_BAR; PG8_WAIT_L(0); PG8_MMA(1, 0, At, B0); PG8_BAR; PG8_SCHED;
            PG8_STAGE(PG8_SB(0, 1), b2 + hstepB, voffB);
            PG8_WAIT_V(6); PG8_BAR; PG8_MMA(1, 1, At, B1); PG8_BAR;
            PG8_LDB(B0, 1, 0); PG8_SCHED; PG8_LDA(At, 1, 0); PG8_STAGE(PG8_SA(0, 1), a2 + hstepA, voffA);
            PG8_WAIT_L(8); PG8_BAR; PG8_WAIT_L(0); PG8_MMA(0, 0, At, B0); PG8_BAR; PG8_SCHED;
            PG8_LDB(B1, 1, 1); PG8_STAGE(PG8_SB(1, 0), b3, voffB);
            PG8_BAR; PG8_WAIT_L(0); PG8_MMA(0, 1, At, B1); PG8_BAR;
            PG8_LDA(At, 1, 1); PG8_STAGE(PG8_SA(1, 0), a3, voffA);
            PG8_BAR; PG8_WAIT_L(0); PG8_MMA(1, 0, At, B0); PG8_BAR; PG8_SCHED;
            PG8_STAGE(PG8_SB(1, 1), b3 + hstepB, voffB);
            PG8_WAIT_V(6); PG8_BAR; PG8_MMA(1, 1, At, B1); PG8_BAR;
            }
        }
        if constexpr (ALIGN_EPI) { if (wr == 0) PG8_BAR; }
        if constexpr (!Epi::AFTER_DRAIN) { E(acc, cur, wr, wc, fr, fq); S.done(cur); }
        if (!has_next) break;
#pragma unroll
        for (int a = 0; a < 2; ++a)
#pragma unroll
            for (int b = 0; b < 2; ++b)
#pragma unroll
                for (int m = 0; m < 4; ++m)
#pragma unroll
                    for (int n = 0; n < 2; ++n) acc[a][b][m][n] = (f32x4){0.f, 0.f, 0.f, 0.f};
        cur = nxt; cA = nA; cB = nB; ++ui;
        if constexpr (ALIGN_EPI) { if (wr == 1) PG8_BAR; }
    }
    PG8_WAIT_V(0);
    if constexpr (!ALIGN_EPI) { if (wr == 0) PG8_BAR; }
    PG8_BAR;
    if constexpr (Epi::AFTER_DRAIN) { E.fused(acc, cur, wr, wc, fr, fq, lds, wid, lane); S.done(cur); }
#undef PG8_SA
#undef PG8_SB
#undef PG8_STAGE
#undef PG8_LDA
#undef PG8_LDB
#undef PG8_MMA
#undef PG8_WAIT_V
#undef PG8_WAIT_L
#undef PG8_BAR
#undef PG8_SCHED
}
}

constexpr size_t MiB = 1u << 20;
struct P {
    const float *x, *c, *ctx, *c_ctx, *w_mod, *b_mod, *norm1_g, *norm2_g, *w_in;
    const float *a_re, *a_im, *log_dt, *b_re, *b_im, *c_re, *c_im, *ssm_d;
    const float *w_glu, *b_glu, *w_a, *w_b, *rpb, *w_out, *w_q, *subkeys, *peer_u, *peer_v, *final_g;
    float* out;
    unsigned char* ws;
    __device__ __forceinline__ float* rowss() const { return (float*)(ws + 512 * 1024); }
    __device__ __forceinline__ float* mod() const { return (float*)(ws + 1 * MiB); }
    __device__ __forceinline__ float* c2() const { return (float*)(ws + 1 * MiB + 256 * 1024); }
    __device__ __forceinline__ bf16_t* w_in_t() const { return (bf16_t*)(ws + 3 * MiB); }
    __device__ __forceinline__ bf16_t* w_glu_t() const { return (bf16_t*)(ws + 11 * MiB); }
    __device__ __forceinline__ bf16_t* w_a_t() const { return (bf16_t*)(ws + 12 * MiB); }
    __device__ __forceinline__ bf16_t* w_b_t() const { return (bf16_t*)(ws + 13 * MiB); }
    __device__ __forceinline__ bf16_t* w_out_t() const { return (bf16_t*)(ws + 14 * MiB); }
    __device__ __forceinline__ bf16_t* w_q_t() const { return (bf16_t*)(ws + 16 * MiB); }
    __device__ __forceinline__ bf16_t* Kmat() const { return (bf16_t*)(ws + 21 * MiB); }
    __device__ __forceinline__ bf16_t* Win() const { return (bf16_t*)(ws + 45 * MiB); }
    __device__ __forceinline__ float* lamT() const { return (float*)(ws + 53 * MiB); }
    __device__ __forceinline__ bf16_t* pu() const { return (bf16_t*)(ws + 54 * MiB); }
    __device__ __forceinline__ bf16_t* pv() const { return (bf16_t*)(ws + 86 * MiB); }
    __device__ __forceinline__ bf16_t* ga() const { return (bf16_t*)(ws + 118 * MiB); }
    __device__ __forceinline__ bf16_t* gb() const { return (bf16_t*)(ws + 182 * MiB); }
    __device__ __forceinline__ bf16_t* x1g() const { return (bf16_t*)(ws + 118 * MiB); }
    __device__ __forceinline__ unsigned* topk() const { return (unsigned*)(ws + 182 * MiB); }
    __device__ __forceinline__ bf16_t* kb() const { return (bf16_t*)(ws + 246 * MiB); }
    __device__ __forceinline__ bf16_t* vT() const { return (bf16_t*)(ws + 278 * MiB); }
    __device__ __forceinline__ bf16_t* qb() const { return (bf16_t*)(ws + 310 * MiB); }
    __device__ __forceinline__ bf16_t* kc() const { return (bf16_t*)(ws + 342 * MiB); }
    __device__ __forceinline__ bf16_t* vcT() const { return (bf16_t*)(ws + 344 * MiB); }
    __device__ __forceinline__ bf16_t* U() const { return (bf16_t*)(ws + 346 * MiB); }
    __device__ __forceinline__ float* E() const { return (float*)(ws + 406 * MiB); }
    __device__ __forceinline__ bf16_t* merged() const { return (bf16_t*)(ws + 246 * MiB); }
    __device__ __forceinline__ float* tbuf() const { return (float*)(ws + 310 * MiB); }
    __device__ __forceinline__ bf16_t* qp() const { return (bf16_t*)(ws + 246 * MiB); }
    __device__ __forceinline__ bf16_t* hx() const { return (bf16_t*)out; }
    __device__ __forceinline__ bf16_t* hc() const { return (bf16_t*)((unsigned char*)out + 64 * MiB); }
    __device__ __forceinline__ bf16_t* na() const { return (bf16_t*)out; }
    __device__ __forceinline__ bf16_t* z() const { return (bf16_t*)((unsigned char*)out + 32 * MiB); }
    __device__ __forceinline__ bf16_t* gl() const { return (bf16_t*)((unsigned char*)out + 64 * MiB); }
};

namespace pg8 {
struct EpiInProj {
    static constexpr bool PERM = true, AFTER_DRAIN = false;
    bf16_t* U; bf16_t* d_kq; size_t kq_stride; bf16_t* d_vT; bf16_t* d_gate; int is_ctx;
    __device__ __forceinline__ void operator()(const f32x4 (&acc)[2][2][4][2], const Unit& u, int wr, int wc, int fr, int fq) const {
        if (u.pn < 2) {
#pragma unroll
            for (int ai = 0; ai < 2; ++ai)
#pragma unroll
                for (int m = 0; m < 4; ++m) {
                    const int row = u.pm * BM + ai * HALF + wr * 64 + m * 16 + fr;
                    const int n = is_ctx ? (1024 + (row >> 8) * 8 + ((row & 255) >> 5)) : ((row >> 12) * 128 + ((row & 4095) >> 5));
                    const int jj = row & 31;
#pragma unroll
                    for (int bj = 0; bj < 2; ++bj) {
                        const int col = u.pn * BM + bj * HALF + wc * 32 + 8 * fq;
                        const f32x4 v0 = acc[ai][bj][m][0], v1 = acc[ai][bj][m][1];
                        u32x4 w; w.x = cvt_pk_bf16(v0[0], v0[1]); w.y = cvt_pk_bf16(v0[2], v0[3]); w.z = cvt_pk_bf16(v1[0], v1[1]); w.w = cvt_pk_bf16(v1[2], v1[3]);
                        *(u32x4*)(U + ((size_t)((col >> 4) * SSM_ROWS + n) * SSM_LD + jj * 16 + (col & 15))) = w;
                    }
                    asm volatile("" ::: "memory");
                }
        } else if (u.pn == 4 || u.pn == 5) {
            const int T = is_ctx ? CTXL : SEQL;
#pragma unroll
            for (int ai = 0; ai < 2; ++ai)
#pragma unroll
                for (int m = 0; m < 4; ++m) {
                    const int row = u.pm * BM + ai * HALF + wr * 64 + m * 16 + fr;
                    const int b = is_ctx ? (row >> 8) : (row >> 12), t = is_ctx ? (row & 255) : (row & 4095);
#pragma unroll
                    for (int bj = 0; bj < 2; ++bj) {
                        const int col = u.pn * BM + bj * HALF + wc * 32 + 8 * fq - 1024;
                        bf16_t* dst = d_vT + ((size_t)(b * 512 + col) * T + t);
#pragma unroll
                        for (int n = 0; n < 2; ++n)
#pragma unroll
                            for (int i = 0; i < 4; ++i) dst[(size_t)(n * 4 + i) * T] = (bf16_t)f2bf(acc[ai][bj][m][n][i]);
                    }
                    asm volatile("" ::: "memory");
                }
        } else {
            bf16_t* base; int ld, c0;
            if (u.pn < 8) { const int which = (u.pn - 2) >> 2; base = d_kq + (size_t)which * kq_stride; ld = 512; c0 = 512 + which * 1024; }
            else { const int which = (u.pn - 8) >> 2; base = d_gate + (size_t)which * ((size_t)NTOK * DM); ld = DM; c0 = 2048 + which * 1024; }
#pragma unroll
            for (int ai = 0; ai < 2; ++ai)
#pragma unroll
                for (int m = 0; m < 4; ++m) {
                    const int row = u.pm * BM + ai * HALF + wr * 64 + m * 16 + fr;
#pragma unroll
                    for (int bj = 0; bj < 2; ++bj) {
                        const int col = u.pn * BM + bj * HALF + wc * 32 + 8 * fq - c0;
                        const f32x4 v0 = acc[ai][bj][m][0], v1 = acc[ai][bj][m][1];
                        u32x4 w; w.x = cvt_pk_bf16(v0[0], v0[1]); w.y = cvt_pk_bf16(v0[2], v0[3]); w.z = cvt_pk_bf16(v1[0], v1[1]); w.w = cvt_pk_bf16(v1[2], v1[3]);
                        *(u32x4*)(base + (size_t)row * ld + col) = w;
                    }
                    asm volatile("" ::: "memory");
                }
        }
    }
};
struct EpiGlu {
    static constexpr bool PERM = true, AFTER_DRAIN = false;
    bf16_t* gl; const bf16_t* z; const float* bias;
    __device__ __forceinline__ void operator()(const f32x4 (&acc)[2][2][4][2], const Unit& u, int wr, int wc, int fr, int fq) const {
#pragma unroll
        for (int ai = 0; ai < 2; ++ai)
#pragma unroll
            for (int m = 0; m < 4; ++m) {
                const int row = u.pm * BM + ai * HALF + wr * 64 + m * 16 + fr;
#pragma unroll
                for (int bj = 0; bj < 2; ++bj) {
                    const int col = u.pn * BM + bj * HALF + wc * 32 + 8 * fq;
                    const f32x4 v0 = acc[ai][bj][m][0], v1 = acc[ai][bj][m][1];
                    const f32x4 b0 = *(const f32x4*)(bias + col), b1 = *(const f32x4*)(bias + col + 4);
                    const u32x4 zz = *(const u32x4*)(z + (size_t)row * 512 + col);
                    float o[8];
                    o[0] = bflo(zz.x) * sigmoidf_(v0[0] + b0[0]); o[1] = bfhi(zz.x) * sigmoidf_(v0[1] + b0[1]);
                    o[2] = bflo(zz.y) * sigmoidf_(v0[2] + b0[2]); o[3] = bfhi(zz.y) * sigmoidf_(v0[3] + b0[3]);
                    o[4] = bflo(zz.z) * sigmoidf_(v1[0] + b1[0]); o[5] = bfhi(zz.z) * sigmoidf_(v1[1] + b1[1]);
                    o[6] = bflo(zz.w) * sigmoidf_(v1[2] + b1[2]); o[7] = bfhi(zz.w) * sigmoidf_(v1[3] + b1[3]);
                    u32x4 w; w.x = cvt_pk_bf16(o[0], o[1]); w.y = cvt_pk_bf16(o[2], o[3]); w.z = cvt_pk_bf16(o[4], o[5]); w.w = cvt_pk_bf16(o[6], o[7]);
                    *(u32x4*)(gl + (size_t)row * 512 + col) = w;
                }
            }
    }
};
struct EpiBrA {
    static constexpr bool PERM = true, AFTER_DRAIN = false;
    float* t; const bf16_t* ga;
    __device__ __forceinline__ void operator()(const f32x4 (&acc)[2][2][4][2], const Unit& u, int wr, int wc, int fr, int fq) const {
#pragma unroll
        for (int ai = 0; ai < 2; ++ai)
#pragma unroll
            for (int m = 0; m < 4; ++m) {
                const int row = u.pm * BM + ai * HALF + wr * 64 + m * 16 + fr;
#pragma unroll
                for (int bj = 0; bj < 2; ++bj) {
                    const int col = u.pn * BM + bj * HALF + wc * 32 + 8 * fq;
                    const f32x4 v0 = acc[ai][bj][m][0], v1 = acc[ai][bj][m][1];
                    const u32x4 gg = *(const u32x4*)(ga + (size_t)row * DM + col);
                    f32x4 o0, o1;
                    o0[0] = sigmoidf_(bflo(gg.x)) * v0[0]; o0[1] = sigmoidf_(bfhi(gg.x)) * v0[1]; o0[2] = sigmoidf_(bflo(gg.y)) * v0[2]; o0[3] = sigmoidf_(bfhi(gg.y)) * v0[3];
                    o1[0] = sigmoidf_(bflo(gg.z)) * v1[0]; o1[1] = sigmoidf_(bfhi(gg.z)) * v1[1]; o1[2] = sigmoidf_(bflo(gg.w)) * v1[2]; o1[3] = sigmoidf_(bfhi(gg.w)) * v1[3];
                    *(f32x4*)(t + (size_t)row * DM + col) = o0; *(f32x4*)(t + (size_t)row * DM + col + 4) = o1;
                }
            }
    }
};
struct EpiBrB {
    static constexpr bool PERM = true, AFTER_DRAIN = false;
    bf16_t* merged; const float* t; const bf16_t* gb;
    __device__ __forceinline__ void operator()(const f32x4 (&acc)[2][2][4][2], const Unit& u, int wr, int wc, int fr, int fq) const {
#pragma unroll
        for (int ai = 0; ai < 2; ++ai)
#pragma unroll
            for (int m = 0; m < 4; ++m) {
                const int row = u.pm * BM + ai * HALF + wr * 64 + m * 16 + fr;
#pragma unroll
                for (int bj = 0; bj < 2; ++bj) {
                    const int col = u.pn * BM + bj * HALF + wc * 32 + 8 * fq;
                    const f32x4 v0 = acc[ai][bj][m][0], v1 = acc[ai][bj][m][1];
                    const u32x4 gg = *(const u32x4*)(gb + (size_t)row * DM + col);
                    const f32x4 t0 = *(const f32x4*)(t + (size_t)row * DM + col), t1 = *(const f32x4*)(t + (size_t)row * DM + col + 4);
                    float o[8];
                    o[0] = t0[0] + sigmoidf_(bflo(gg.x)) * v0[0]; o[1] = t0[1] + sigmoidf_(bfhi(gg.x)) * v0[1]; o[2] = t0[2] + sigmoidf_(bflo(gg.y)) * v0[2]; o[3] = t0[3] + sigmoidf_(bfhi(gg.y)) * v0[3];
                    o[4] = t1[0] + sigmoidf_(bflo(gg.z)) * v1[0]; o[5] = t1[1] + sigmoidf_(bfhi(gg.z)) * v1[1]; o[6] = t1[2] + sigmoidf_(bflo(gg.w)) * v1[2]; o[7] = t1[3] + sigmoidf_(bfhi(gg.w)) * v1[3];
                    u32x4 w; w.x = cvt_pk_bf16(o[0], o[1]); w.y = cvt_pk_bf16(o[2], o[3]); w.z = cvt_pk_bf16(o[4], o[5]); w.w = cvt_pk_bf16(o[6], o[7]);
                    *(u32x4*)(merged + (size_t)row * DM + col) = w;
                }
            }
    }
};
struct EpiOut {
    static constexpr bool PERM = true, AFTER_DRAIN = false;
    const float* x; float* x1; bf16_t* x1g; const float* mod; const float* g2; float* rowss;
    __device__ __forceinline__ void operator()(const f32x4 (&acc)[2][2][4][2], const Unit& u, int wr, int wc, int fr, int fq) const {
#pragma unroll
        for (int ai = 0; ai < 2; ++ai)
#pragma unroll
            for (int m = 0; m < 4; ++m) {
                const int row = u.pm * BM + ai * HALF + wr * 64 + m * 16 + fr;
                const float* modb = mod + (size_t)(row >> 12) * (6 * DM);
                float ss = 0.f;
#pragma unroll
                for (int bj = 0; bj < 2; ++bj) {
                    const int col = u.pn * BM + bj * HALF + wc * 32 + 8 * fq;
#pragma unroll
                    for (int n = 0; n < 2; ++n) {
                        const int cc = col + 4 * n;
                        const f32x4 v = acc[ai][bj][m][n];
                        const f32x4 xx = *(const f32x4*)(x + (size_t)row * DM + cc);
                        const f32x4 g1 = *(const f32x4*)(modb + 2 * DM + cc), sc = *(const f32x4*)(modb + 4 * DM + cc), gg = *(const f32x4*)(g2 + cc);
                        const f32x4 o = xx + g1 * v;
                        *(f32x4*)(x1 + (size_t)row * DM + cc) = o;
                        ss += o[0] * o[0] + o[1] * o[1] + o[2] * o[2] + o[3] * o[3];
                        const f32x4 og = o * gg * (sc + 1.f);
                        u32x2 w; w.x = cvt_pk_bf16(og[0], og[1]); w.y = cvt_pk_bf16(og[2], og[3]);
                        *(u32x2*)(x1g + (size_t)row * DM + cc) = w;
                    }
                }
                ss += __shfl_xor(ss, 16); ss += __shfl_xor(ss, 32);
                if (fq == 0) atomicAdd(rowss + row, ss);
            }
    }
};
struct EpiQ {
    static constexpr bool PERM = true, AFTER_DRAIN = false;
    bf16_t* qp; const float* rowss; const float* c2;
    __device__ __forceinline__ void operator()(const f32x4 (&acc)[2][2][4][2], const Unit& u, int wr, int wc, int fr, int fq) const {
#pragma unroll
        for (int ai = 0; ai < 2; ++ai)
#pragma unroll
            for (int m = 0; m < 4; ++m) {
                const int row = u.pm * BM + ai * HALF + wr * 64 + m * 16 + fr;
                const float rstd = rsqrtf(rowss[row] * (1.f / DM) + EPSN);
                const float* cb = c2 + (size_t)(row >> 12) * 2048;
#pragma unroll
                for (int bj = 0; bj < 2; ++bj) {
                    const int col = u.pn * BM + bj * HALF + wc * 32 + 8 * fq;
                    const f32x4 v0 = acc[ai][bj][m][0] * rstd + *(const f32x4*)(cb + col), v1 = acc[ai][bj][m][1] * rstd + *(const f32x4*)(cb + col + 4);
                    u32x4 w; w.x = cvt_pk_bf16(v0[0], v0[1]); w.y = cvt_pk_bf16(v0[2], v0[3]); w.z = cvt_pk_bf16(v1[0], v1[1]); w.w = cvt_pk_bf16(v1[2], v1[3]);
                    *(u32x4*)(qp + (size_t)row * 2048 + col) = w;
                }
            }
    }
};
struct EpiE {
    static constexpr bool PERM = true, AFTER_DRAIN = false;
    float* E;
    __device__ __forceinline__ void operator()(const f32x4 (&acc)[2][2][4][2], const Unit& u, int wr, int wc, int fr, int fq) const {
#pragma unroll
        for (int ai = 0; ai < 2; ++ai)
#pragma unroll
            for (int m = 0; m < 4; ++m) {
                const int row = u.pm * BM + ai * HALF + wr * 64 + m * 16 + fr;
#pragma unroll
                for (int bj = 0; bj < 2; ++bj) {
                    const int col = u.pn * BM + bj * HALF + wc * 32 + 8 * fq;
                    float* d = E + ((size_t)(u.g * SSM_ROWS + row) * 256 + col);
                    *(f32x4*)d = acc[ai][bj][m][0]; *(f32x4*)(d + 4) = acc[ai][bj][m][1];
                }
            }
    }
};
struct EpiZ {
    static constexpr bool PERM = true, AFTER_DRAIN = false;
    bf16_t* z;
    __device__ __forceinline__ void operator()(const f32x4 (&acc)[2][2][4][2], const Unit& u, int wr, int wc, int fr, int fq) const {
#pragma unroll
        for (int ai = 0; ai < 2; ++ai)
#pragma unroll
            for (int m = 0; m < 4; ++m) {
                const int n = u.pm * BM + ai * HALF + wr * 64 + m * 16 + fr;
                const size_t tok0 = (size_t)(n >> 7) * SEQL + (size_t)(n & 127) * 32;
#pragma unroll
                for (int bj = 0; bj < 2; ++bj) {
                    const int col = u.pn * BM + bj * HALF + wc * 32 + 8 * fq;
                    const f32x4 v0 = acc[ai][bj][m][0], v1 = acc[ai][bj][m][1];
                    u32x4 w; w.x = cvt_pk_bf16(gelu_tanh(v0[0]), gelu_tanh(v0[1])); w.y = cvt_pk_bf16(gelu_tanh(v0[2]), gelu_tanh(v0[3]));
                    w.z = cvt_pk_bf16(gelu_tanh(v1[0]), gelu_tanh(v1[1])); w.w = cvt_pk_bf16(gelu_tanh(v1[2]), gelu_tanh(v1[3]));
                    *(u32x4*)(z + (tok0 + (col >> 4)) * 512 + u.g * 16 + (col & 15)) = w;
                }
            }
    }
};
}

__device__ __forceinline__ void sincos_d(double th, double& s, double& c) {
    const double twopi = 6.283185307179586476925, hpi = 1.570796326794896619231;
    th -= twopi * rint(th / twopi);
    const double q = rint(th / hpi); const double y = th - q * hpi, y2 = y * y;
    const double sy = y * (1.0 - y2 / 6.0 * (1.0 - y2 / 20.0 * (1.0 - y2 / 42.0 * (1.0 - y2 / 72.0 * (1.0 - y2 / 110.0 * (1.0 - y2 / 156.0 * (1.0 - y2 / 210.0)))))));
    const double cy = 1.0 - y2 / 2.0 * (1.0 - y2 / 12.0 * (1.0 - y2 / 30.0 * (1.0 - y2 / 56.0 * (1.0 - y2 / 90.0 * (1.0 - y2 / 132.0 * (1.0 - y2 / 182.0))))));
    const int qi = ((int)q) & 3;
    s = qi == 0 ? sy : (qi == 1 ? cy : (qi == 2 ? -sy : -cy));
    c = qi == 0 ? cy : (qi == 1 ? -sy : (qi == 2 ? -cy : sy));
}
__device__ __forceinline__ void ssm_prep_item(const P& p, LAS unsigned char* lds, int item) {
    const int g = item >> 2, qtr = item & 3, tid = threadIdx.x;
    LAS f32x2* lamk = (LAS f32x2*)lds;
    LAS f32x2* Bb = lamk + 2 * 64 * 33;
    LAS f32x2* Cc = Bb + 2 * 64 * 16;
    LAS float* Kc = (LAS float*)(Cc + 2 * 16 * 64);
    if (tid < 128) {
        const int d = tid >> 6, pp = tid & 63, gi = d * 32 + g;
        const double are = (double)p.a_re[gi * 64 + pp], aim = (double)p.a_im[gi * 64 + pp];
        const double dt = (double)expf(p.log_dt[gi]);
        const double er = exp(are * dt); double sn, cs; sincos_d(aim * dt, sn, cs);
        const double lr = er * cs, li = er * sn;
        double pr = 1.0, pi_ = 0.0;
        for (int k = 0; k <= 32; ++k) {
            lamk[(d * 64 + pp) * 33 + k] = (f32x2){(float)pr, (float)pi_};
            const double nr_ = pr * lr - pi_ * li, ni_ = pr * li + pi_ * lr; pr = nr_; pi_ = ni_;
        }
        if (qtr == 0) { const f32x2 l32 = lamk[(d * 64 + pp) * 33 + 32]; *(f32x2*)(p.lamT() + (size_t)(gi * 64 + pp) * 2) = l32; }
        const double nr = lr - 1.0, ni = li, den = are * are + aim * aim;
        const double qr = (nr * are + ni * aim) / den, qi = (ni * are - nr * aim) / den;
        for (int h = 0; h < 16; ++h) {
            const double br = (double)p.b_re[((size_t)gi * 64 + pp) * 16 + h], bi = (double)p.b_im[((size_t)gi * 64 + pp) * 16 + h];
            Bb[(d * 64 + pp) * 16 + h] = (f32x2){(float)(qr * br - qi * bi), (float)(qr * bi + qi * br)};
        }
    }
    for (int e = tid; e < 2 * 16 * 64; e += NT) {
        const int d = e >> 10, h = (e >> 6) & 15, pp = e & 63; const size_t src = ((size_t)(d * 32 + g) * 16 + h) * 64 + pp;
        Cc[e] = (f32x2){p.c_re[src], p.c_im[src]};
    }
    __syncthreads();
    for (int e = tid; e < 2 * 32 * 256; e += NT) {
        const int d = e >> 13, k = (e >> 8) & 31, h = (e >> 4) & 15, h2 = e & 15;
        float sacc = 0.f;
        for (int pp = 0; pp < 64; ++pp) {
            const f32x2 c = Cc[(d * 16 + h) * 64 + pp], l = lamk[(d * 64 + pp) * 33 + k], b = Bb[(d * 64 + pp) * 16 + h2];
            const float clr = c[0] * l[0] - c[1] * l[1], cli = c[0] * l[1] + c[1] * l[0];
            sacc += clr * b[0] - cli * b[1];
        }
        Kc[e] = sacc;
    }
    __syncthreads();
    for (int ch = tid; ch < 128 * 96; ch += NT) {
        const int mrow = 128 * qtr + ch / 96, k0 = (ch % 96) * 8, ii = mrow >> 4, h = mrow & 15;
        float v[8];
        if (k0 < 512) {
            const int jj = k0 >> 4, h20 = k0 & 15;
#pragma unroll
            for (int i = 0; i < 8; ++i) {
                const int h2 = h20 + i; float val = 0.f;
                if (ii >= jj) val += Kc[((0 * 32 + (ii - jj)) * 16 + h) * 16 + h2];
                if (jj >= ii) val += Kc[((1 * 32 + (jj - ii)) * 16 + h) * 16 + h2];
                if (ii == jj && h == h2) val += p.ssm_d[g * 16 + h];
                v[i] = val;
            }
        } else {
            const int sc = k0 - 512, d = sc >> 7, ri = (sc >> 6) & 1, p0 = sc & 63, e = d == 0 ? ii + 1 : 32 - ii;
#pragma unroll
            for (int i = 0; i < 8; ++i) {
                const int pp = p0 + i; const f32x2 c = Cc[(d * 16 + h) * 64 + pp], l = lamk[(d * 64 + pp) * 33 + e];
                const float clr = c[0] * l[0] - c[1] * l[1], cli = c[0] * l[1] + c[1] * l[0];
                v[i] = ri == 0 ? clr : -cli;
            }
        }
        u32x4 o; o.x = pk2(v[0], v[1]); o.y = pk2(v[2], v[3]); o.z = pk2(v[4], v[5]); o.w = pk2(v[6], v[7]);
        *(u32x4*)(p.Kmat() + ((size_t)(g * 512 + mrow) * SSM_LD + k0)) = o;
    }
    for (int ch = tid; ch < 64 * 64; ch += NT) {
        const int nrow = 64 * qtr + ch / 64, k0 = (ch % 64) * 8, d = nrow >> 7, ri = (nrow >> 6) & 1, pp = nrow & 63;
        const int jj = k0 >> 4, h20 = k0 & 15, e = d == 0 ? 31 - jj : jj;
        const f32x2 l = lamk[(d * 64 + pp) * 33 + e];
        float v[8];
#pragma unroll
        for (int i = 0; i < 8; ++i) { const f32x2 b = Bb[(d * 64 + pp) * 16 + h20 + i]; v[i] = ri == 0 ? (l[0] * b[0] - l[1] * b[1]) : (l[0] * b[1] + l[1] * b[0]); }
        u32x4 o; o.x = pk2(v[0], v[1]); o.y = pk2(v[2], v[3]); o.z = pk2(v[4], v[5]); o.w = pk2(v[6], v[7]);
        *(u32x4*)(p.Win() + ((size_t)(g * 256 + nrow) * 512 + k0)) = o;
    }
    __syncthreads();
}
__device__ __forceinline__ void ph_carry(const P& p) {
    const int tid = threadIdx.x;
    if (tid >= 128) return;
    for (int gidx = blockIdx.x * 128 + tid; gidx < 32 * 8 * 2 * 64; gidx += gridDim.x * 128) {
        const int pp = gidx & 63, d = (gidx >> 6) & 1, b = (gidx >> 7) & 7, g = gidx >> 10;
        const f32x2 lt = *(const f32x2*)(p.lamT() + (size_t)((d * 32 + g) * 64 + pp) * 2);
        const float* Eg = p.E() + (size_t)g * SSM_ROWS * 256 + d * 128 + pp;
        bf16_t* Ug = p.U() + (size_t)g * SSM_ROWS * SSM_LD + 512 + d * 128 + pp;
        float fr = 0.f, fi = 0.f;
#pragma unroll
        for (int cc = 0; cc < 8; ++cc) {
            const int n = 1024 + b * 8 + (d == 0 ? cc : 7 - cc);
            const float er = Eg[(size_t)n * 256], ei = Eg[(size_t)n * 256 + 64];
            const float nr = lt[0] * fr - lt[1] * fi + er, ni = lt[0] * fi + lt[1] * fr + ei; fr = nr; fi = ni;
        }
#pragma unroll 8
        for (int c = 0; c < 128; ++c) {
            const int n = b * 128 + (d == 0 ? c : 127 - c);
            const float er = Eg[(size_t)n * 256], ei = Eg[(size_t)n * 256 + 64];
            Ug[(size_t)n * SSM_LD] = (bf16_t)f2bf(fr); Ug[(size_t)n * SSM_LD + 64] = (bf16_t)f2bf(fi);
            const float nr = lt[0] * fr - lt[1] * fi + er, ni = lt[0] * fi + lt[1] * fr + ei; fr = nr; fi = ni;
        }
    }
}


__device__ __forceinline__ void p0_transpose_item(const float* W, int K, int N, bf16_t* WT, LAS float* scr, int item, int lane) {
    const int nblk = N / 32, kb = item / nblk, nb = item % nblk, k0 = 64 * kb, n0 = 32 * nb;
#pragma unroll 8
    for (int i = 0; i < 32; ++i) { const int kk = 2 * i + (lane >> 5); scr[kk * 33 + (lane & 31)] = W[(size_t)(k0 + kk) * N + n0 + (lane & 31)]; }
    asm volatile("s_waitcnt lgkmcnt(0)" ::: "memory");
    const int c = lane & 7;
#pragma unroll
    for (int j = 0; j < 4; ++j) { const int n = (lane >> 3) + 8 * j; const LAS float* s = scr + (8 * c) * 33 + n;
        u32x4 o; o.x = pk2(s[0 * 33], s[1 * 33]); o.y = pk2(s[2 * 33], s[3 * 33]); o.z = pk2(s[4 * 33], s[5 * 33]); o.w = pk2(s[6 * 33], s[7 * 33]);
        *(u32x4*)(WT + (size_t)(n0 + n) * K + k0 + 8 * c) = o; }
    asm volatile("s_waitcnt lgkmcnt(0)" ::: "memory");
}

template <int NR, bool SILU>
__device__ __forceinline__ void gemv_block64(const float* const (&rows)[NR], const float* W, int ldw, int col0, const float* bias, float* y, int ldy, LAS float* scr) {
    const int wave = threadIdx.x >> 6, lane = threadIdx.x & 63;
    float acc[NR];
#pragma unroll
    for (int r = 0; r < NR; ++r) acc[r] = 0.f;
    const int kb = wave * 128;
#pragma unroll 4
    for (int k = kb; k < kb + 128; ++k) {
        const float w = W[(size_t)k * ldw + col0 + lane];
#pragma unroll
        for (int r = 0; r < NR; ++r) { const float s = rows[r][k]; acc[r] += (SILU ? siluf_(s) : s) * w; }
    }
#pragma unroll
    for (int r = 0; r < NR; ++r) scr[(wave * NR + r) * 64 + lane] = acc[r];
    __syncthreads();
    for (int e = threadIdx.x; e < NR * 64; e += NT) {
        const int r = e >> 6, l = e & 63; float s = 0.f;
#pragma unroll
        for (int w = 0; w < 8; ++w) s += scr[(w * NR + r) * 64 + l];
        y[(size_t)r * ldy + col0 + l] = s + (bias ? bias[col0 + l] : 0.f);
    }
    __syncthreads();
}

__device__ __forceinline__ void ph_prep(const P& p, LAS unsigned char* lds) {
    const int wave = threadIdx.x >> 6, lane = threadIdx.x & 63, G = gridDim.x;
    for (int cb = blockIdx.x; cb < 96; cb += G) {
        const float* const rows[9] = {p.c, p.c + DM, p.c + 2 * DM, p.c + 3 * DM, p.c + 4 * DM, p.c + 5 * DM, p.c + 6 * DM, p.c + 7 * DM, p.c_ctx};
        gemv_block64<9, true>(rows, p.w_mod, 6 * DM, cb * 64, p.b_mod, p.mod(), 6 * DM, (LAS float*)lds);
    }
    for (int it = G - 1 - (int)blockIdx.x; it < 128; it += G) ssm_prep_item(p, lds, it);
    {
        LAS float* scr = (LAS float*)(lds + wave * 16384);
        const int gw = blockIdx.x * NWAVES + wave, NGW = G * NWAVES;
        constexpr int I_IN = (DM / 64) * (INC / 32), I_GLU = (512 / 64) * (512 / 32), I_A = (512 / 64) * (DM / 32), I_OUT = (DM / 64) * (DM / 32), I_Q = (DM / 64) * (2048 / 32);
        constexpr int NITEMS = I_IN + I_GLU + 2 * I_A + I_OUT + I_Q;
        for (int it = gw; it < NITEMS; it += NGW) {
            int r = it;
            if (r < I_IN) { p0_transpose_item(p.w_in, DM, INC, p.w_in_t(), scr, r, lane); continue; } r -= I_IN;
            if (r < I_GLU) { p0_transpose_item(p.w_glu, 512, 512, p.w_glu_t(), scr, r, lane); continue; } r -= I_GLU;
            if (r < I_A) { p0_transpose_item(p.w_a, 512, DM, p.w_a_t(), scr, r, lane); continue; } r -= I_A;
            if (r < I_A) { p0_transpose_item(p.w_b, 512, DM, p.w_b_t(), scr, r, lane); continue; } r -= I_A;
            if (r < I_OUT) { p0_transpose_item(p.w_out, DM, DM, p.w_out_t(), scr, r, lane); continue; } r -= I_OUT;
            p0_transpose_item(p.w_q, DM, 2048, p.w_q_t(), scr, r, lane);
        }
    }
    {
        const size_t nchunk = (size_t)16384 * DM / 8, gsz = (size_t)G * NT;
        for (size_t i = (size_t)blockIdx.x * NT + threadIdx.x; i < 2 * nchunk; i += gsz) {
            const bool second = i >= nchunk; const size_t j = second ? i - nchunk : i;
            const float* src = (second ? p.peer_v : p.peer_u) + j * 8;
            const f32x4 a = *(const f32x4*)src, b = *(const f32x4*)(src + 4);
            u32x4 o; o.x = pk2(a[0], a[1]); o.y = pk2(a[2], a[3]); o.z = pk2(b[0], b[1]); o.w = pk2(b[2], b[3]);
            *(u32x4*)((second ? p.pv() : p.pu()) + j * 8) = o;
        }
    }
}


__device__ __forceinline__ void normmod_row_bf16(const float* src, bf16_t* dst, const float* g, const float* shift, const float* scale, int lane) {
    const f32x4* s = (const f32x4*)src;
    f32x4 v[4]; float ss = 0.f;
#pragma unroll
    for (int j = 0; j < 4; ++j) { v[j] = s[lane + 64 * j]; ss += v[j][0] * v[j][0] + v[j][1] * v[j][1] + v[j][2] * v[j][2] + v[j][3] * v[j][3]; }
    ss = wave_sum(ss);
    const float rstd = rsqrtf(ss * (1.f / DM) + EPSN);
#pragma unroll
    for (int j = 0; j < 4; ++j) {
        const int i4 = lane + 64 * j;
        const f32x4 gg = ((const f32x4*)g)[i4], sh = ((const f32x4*)shift)[i4], sc = ((const f32x4*)scale)[i4];
        const f32x4 o = v[j] * rstd * gg * (sc + 1.f) + sh;
        u32x2 w; w.x = pk2(o[0], o[1]); w.y = pk2(o[2], o[3]);
        *(u32x2*)(dst + (size_t)i4 * 4) = w;
    }
}
__device__ __forceinline__ void ph_norm1(const P& p, LAS unsigned char* lds) {
    const int wave = threadIdx.x >> 6, lane = threadIdx.x & 63, G = gridDim.x;
    for (int cb = blockIdx.x; cb < 32; cb += G) {
        const float* m3 = p.mod() + 3 * DM;
        const float* const rows[8] = {m3, m3 + 6 * DM, m3 + 12 * DM, m3 + 18 * DM, m3 + 24 * DM, m3 + 30 * DM, m3 + 36 * DM, m3 + 42 * DM};
        gemv_block64<8, false>(rows, p.w_q, 2048, cb * 64, nullptr, p.c2(), 2048, (LAS float*)lds);
    }
    for (int r = blockIdx.x * NWAVES + wave; r < NTOK + NCTX; r += G * NWAVES) {
        if (r < NTOK) { const float* modb = p.mod() + (size_t)(r >> 12) * (6 * DM); normmod_row_bf16(p.x + (size_t)r * DM, p.hx() + (size_t)r * DM, p.norm1_g, modb, modb + DM, lane); }
        else { const int rc = r - NTOK; const float* modc = p.mod() + 8 * (6 * DM); normmod_row_bf16(p.ctx + (size_t)rc * DM, p.hc() + (size_t)rc * DM, p.norm1_g, modc, modc + DM, lane); }
    }
}

typedef short s16x4 __attribute__((ext_vector_type(4)));
__device__ __forceinline__ void ph_na(const P& p, LAS unsigned char* lds) {
    const int tid = threadIdx.x, h = tid >> 6, lane = tid & 63, lt = lane & 15, lq = lane >> 4;
    LAS float* rp = (LAS float*)lds;
    for (int e = tid; e < 8 * 15 * 31; e += NT) rp[e] = p.rpb[e];
    __syncthreads();
    for (int item = blockIdx.x; item < NB * GW; item += gridDim.x) {
        const int b = item >> 6, r = item & 63;
        int r0 = r - 4; r0 = r0 < 0 ? 0 : (r0 > 56 ? 56 : r0);
        const bf16_t* Kb = p.kb() + (size_t)b * SEQL * 512 + h * 64 + lq * 8;
        const bf16_t* Kc = p.kc() + (size_t)b * CTXL * 512 + h * 64 + lq * 8;
        const bf16_t* Vt = p.vT() + (size_t)((b * 8 + h) * 64 + lt) * SEQL + lq * 4;
        const bf16_t* Vc = p.vcT() + (size_t)((b * 8 + h) * 64 + lt) * CTXL + lq * 4;
#pragma unroll 1
        for (int cqi = 0; cqi < 4; ++cqi) {
            const int cq = cqi * 16;
            int cw = cq - 8; cw = cw < 0 ? 0 : (cw > 32 ? 32 : cw);
            const int qc = cq + lt;
            int c0 = qc - 8; c0 = c0 < 0 ? 0 : (c0 > 48 ? 48 : c0);
            const size_t tq = (size_t)b * SEQL + r * GW + qc;
            bf16x8 qf[2];
            qf[0] = *(const bf16x8*)(p.qb() + tq * 512 + h * 64 + lq * 8); qf[1] = *(const bf16x8*)(p.qb() + tq * 512 + h * 64 + 32 + lq * 8);
            f32x4 o[4];
#pragma unroll
            for (int d = 0; d < 4; ++d) o[d] = (f32x4){0.f, 0.f, 0.f, 0.f};
            float m = -1e30f, l = 0.f;
#pragma unroll 1
            for (int chunk = 0; chunk < 4; ++chunk) {
                f32x4 s[8];
#pragma unroll
                for (int blk = 0; blk < 8; ++blk) {
                    const bf16_t* kp;
                    if (chunk < 2) kp = Kb + (size_t)((r0 + chunk * 4 + (blk >> 1)) * GW + cw + (blk & 1) * 16 + lt) * 512;
                    else kp = Kc + (size_t)((chunk - 2) * 128 + blk * 16 + lt) * 512;
                    const bf16x8 k0 = *(const bf16x8*)kp, k1 = *(const bf16x8*)(kp + 32);
                    f32x4 c = {0.f, 0.f, 0.f, 0.f};
                    c = __builtin_amdgcn_mfma_f32_16x16x32_bf16(k0, qf[0], c, 0, 0, 0);
                    c = __builtin_amdgcn_mfma_f32_16x16x32_bf16(k1, qf[1], c, 0, 0, 0);
                    s[blk] = c;
                }
                float mx = -1e30f;
#pragma unroll
                for (int blk = 0; blk < 8; ++blk)
#pragma unroll
                    for (int rr = 0; rr < 4; ++rr) {
                        float t = s[blk][rr] * 0.125f;
                        if (chunk < 2) {
                            const int i = chunk * 4 + (blk >> 1), kc = cw + (blk & 1) * 16 + lq * 4 + rr;
                            const bool valid = kc >= c0 && kc < c0 + 16;
                            const int idx = valid ? ((h * 15 + (r0 + i - r + 7)) * 31 + (kc - qc + 15)) : 0;
                            t = valid ? t + rp[idx] : -1e30f;
                        }
                        s[blk][rr] = t; mx = fmaxf(mx, t);
                    }
                mx = fmaxf(mx, __shfl_xor(mx, 16)); mx = fmaxf(mx, __shfl_xor(mx, 32));
                const float mn = fmaxf(m, mx), corr = __expf(m - mn);
                m = mn; l *= corr;
#pragma unroll
                for (int d = 0; d < 4; ++d) o[d] = o[d] * corr;
#pragma unroll
                for (int st = 0; st < 4; ++st) {
                    float pe[8];
#pragma unroll
                    for (int rr = 0; rr < 4; ++rr) { pe[rr] = __expf(s[2 * st][rr] - mn); pe[4 + rr] = __expf(s[2 * st + 1][rr] - mn); }
#pragma unroll
                    for (int i = 0; i < 8; ++i) l += pe[i];
                    u32x4 pw; pw.x = pk2(pe[0], pe[1]); pw.y = pk2(pe[2], pe[3]); pw.z = pk2(pe[4], pe[5]); pw.w = pk2(pe[6], pe[7]);
                    const bf16x8 pf = __builtin_bit_cast(bf16x8, pw);
                    const bf16_t* vp;
                    if (chunk < 2) vp = Vt + (size_t)((r0 + chunk * 4 + st) * GW + cw);
                    else vp = Vc + (size_t)((chunk - 2) * 128 + st * 32);
                    const size_t dstr = chunk < 2 ? (size_t)16 * SEQL : (size_t)16 * CTXL;
#pragma unroll
                    for (int d = 0; d < 4; ++d) {
                        const u32x2 va = *(const u32x2*)(vp + d * dstr), vb = *(const u32x2*)(vp + d * dstr + 16);
                        u32x4 vw; vw.x = va.x; vw.y = va.y; vw.z = vb.x; vw.w = vb.y;
                        o[d] = __builtin_amdgcn_mfma_f32_16x16x32_bf16(__builtin_bit_cast(bf16x8, vw), pf, o[d], 0, 0, 0);
                    }
                }
            }
            l += __shfl_xor(l, 16); l += __shfl_xor(l, 32);
            const float inv = 1.f / l;
            bf16_t* op = p.na() + tq * 512 + h * 64 + lq * 4;
#pragma unroll
            for (int d = 0; d < 4; ++d) { u32x2 w; w.x = pk2(o[d][0] * inv, o[d][1] * inv); w.y = pk2(o[d][2] * inv, o[d][3] * inv); *(u32x2*)(op + d * 16) = w; }
        }
    }
}

typedef __bf16 bf16x2_t __attribute__((ext_vector_type(2)));
__device__ __forceinline__ float dot2bf(unsigned a, unsigned b, float c) { return __builtin_amdgcn_fdot2_f32_bf16(__builtin_bit_cast(bf16x2_t, a), __builtin_bit_cast(bf16x2_t, b), c, false); }
__device__ __forceinline__ unsigned ordkey(float f) { unsigned u = __builtin_bit_cast(unsigned, f); return u ^ ((unsigned)((int)u >> 31) | 0x80000000u); }
__device__ __forceinline__ float unordkey(unsigned k) { return __builtin_bit_cast(float, k ^ ((k & 0x80000000u) ? 0x80000000u : 0xFFFFFFFFu)); }
template <bool DESC> __device__ __forceinline__ void cex(unsigned& a, unsigned& b) { const unsigned mx = a > b ? a : b, mn = a > b ? b : a; if (DESC) { a = mx; b = mn; } else { a = mn; b = mx; } }
__device__ __forceinline__ void sort16_desc(unsigned (&a)[16]) {
#pragma unroll
    for (int k = 2; k <= 16; k <<= 1)
#pragma unroll
        for (int j = k >> 1; j > 0; j >>= 1)
#pragma unroll
            for (int i = 0; i < 16; ++i) { const int l = i ^ j; if (l > i) { if ((i & k) == 0) cex<true>(a[i], a[l]); else cex<false>(a[i], a[l]); } }
}
__device__ __forceinline__ void merge16_desc(unsigned (&a)[16]) {
#pragma unroll
    for (int j = 8; j > 0; j >>= 1)
#pragma unroll
        for (int i = 0; i < 16; ++i) { const int l = i ^ j; if (l > i) cex<true>(a[i], a[l]); }
}
__device__ __forceinline__ void top16_merge(unsigned (&a)[16], const unsigned (&b)[16]) {
#pragma unroll
    for (int i = 0; i < 16; ++i) a[i] = a[i] > b[15 - i] ? a[i] : b[15 - i];
    merge16_desc(a);
}
struct PairTab { int i[52], j[52], n; };
constexpr PairTab make_pairs() { PairTab t{}; int n = 0; for (int i = 0; i < 16; ++i) for (int j = 0; j < 16; ++j) if ((i + 1) * (j + 1) <= 16) { t.i[n] = i; t.j[n] = j; ++n; } t.n = n; for (int k = n; k < 52; ++k) { t.i[k] = 0; t.j[k] = 0; } return t; }
constexpr PairTab PAIRS = make_pairs();
static_assert(PAIRS.n == 50, "50 candidate pairs");

constexpr int SK_LD = 136;
__device__ __forceinline__ void ph_peer_topk(const P& p, LAS unsigned char* lds) {
    const int tid = threadIdx.x, wave = tid >> 6, lane = tid & 63;
    LAS bf16_t* sk = (LAS bf16_t*)lds;
    for (int e = tid; e < 2 * 128 * 16; e += NT) {
        const int row = e >> 4, c8 = (e & 15) * 8;
        const f32x4 a = *(const f32x4*)(p.subkeys + (size_t)row * 128 + c8), b = *(const f32x4*)(p.subkeys + (size_t)row * 128 + c8 + 4);
        u32x4 o; o.x = pk2(a[0], a[1]); o.y = pk2(a[2], a[3]); o.z = pk2(b[0], b[1]); o.w = pk2(b[2], b[3]);
        *(LAS u32x4*)(sk + row * SK_LD + c8) = o;
    }
    __syncthreads();
    const int lt = lane & 15, lq = lane >> 4;
    for (int tile = blockIdx.x * NWAVES + wave; tile < NTOK / 16; tile += gridDim.x * NWAVES) {
        const int tok = tile * 16 + lt;
        const bf16_t* qrow = p.qp() + (size_t)tok * 2048;
        for (int h = 0; h < 8; ++h) {
            unsigned s0[16], s1[16];
#pragma unroll
            for (int n = 0; n < 2; ++n) {
                bf16x8 bq[4];
#pragma unroll
                for (int ks = 0; ks < 4; ++ks) bq[ks] = *(const bf16x8*)(qrow + h * 256 + n * 128 + ks * 32 + lq * 8);
                unsigned a[16], b[16];
#pragma unroll
                for (int kb = 0; kb < 8; ++kb) {
                    f32x4 c = {0.f, 0.f, 0.f, 0.f};
#pragma unroll
                    for (int ks = 0; ks < 4; ++ks) {
                        const bf16x8 ak = *(const LAS bf16x8*)(sk + (n * 128 + kb * 16 + lt) * SK_LD + ks * 32 + lq * 8);
                        c = __builtin_amdgcn_mfma_f32_16x16x32_bf16(ak, bq[ks], c, 0, 0, 0);
                    }
#pragma unroll
                    for (int r = 0; r < 4; ++r) {
                        const unsigned key = (ordkey(c[r]) & ~127u) | (unsigned)(kb * 16 + lq * 4 + r);
                        if (kb < 4) a[kb * 4 + r] = key; else b[(kb - 4) * 4 + r] = key;
                    }
                    asm volatile("" ::: "memory");
                }
                sort16_desc(a); sort16_desc(b);
                top16_merge(a, b);
#pragma unroll
                for (int i = 0; i < 16; ++i) b[i] = __shfl_xor(a[i], 16);
                top16_merge(a, b);
#pragma unroll
                for (int i = 0; i < 16; ++i) b[i] = __shfl_xor(a[i], 32);
                top16_merge(a, b);
                if (n == 0) {
#pragma unroll
                    for (int i = 0; i < 16; ++i) s0[i] = a[i];
                } else {
#pragma unroll
                    for (int i = 0; i < 16; ++i) s1[i] = a[i];
                }
            }
            unsigned ck[16], ce_[13]; float cs[13];
#pragma unroll
            for (int s = 0; s < 13; ++s) {
                const unsigned k0 = lq == 0 ? s0[PAIRS.i[s * 4]] : (lq == 1 ? s0[PAIRS.i[s * 4 + 1]] : (lq == 2 ? s0[PAIRS.i[s * 4 + 2]] : s0[PAIRS.i[s * 4 + 3]]));
                const unsigned k1 = lq == 0 ? s1[PAIRS.j[s * 4]] : (lq == 1 ? s1[PAIRS.j[s * 4 + 1]] : (lq == 2 ? s1[PAIRS.j[s * 4 + 2]] : s1[PAIRS.j[s * 4 + 3]]));
                const float sum = unordkey(k0 & ~127u) + unordkey(k1 & ~127u);
                const bool valid = (s * 4 + lq) < PAIRS.n;
                cs[s] = sum; ce_[s] = (k0 & 127u) * 128u + (k1 & 127u);
                ck[s] = valid ? ((ordkey(sum) & ~63u) | (unsigned)(s * 4 + lq)) : 0u;
            }
            ck[13] = 0u; ck[14] = 0u; ck[15] = 0u;
            unsigned srt[16], ob[16];
#pragma unroll
            for (int i = 0; i < 16; ++i) srt[i] = ck[i];
            sort16_desc(srt);
#pragma unroll
            for (int i = 0; i < 16; ++i) ob[i] = __shfl_xor(srt[i], 16);
            top16_merge(srt, ob);
#pragma unroll
            for (int i = 0; i < 16; ++i) ob[i] = __shfl_xor(srt[i], 32);
            unsigned thr = 0xFFFFFFFFu;
#pragma unroll
            for (int i = 0; i < 16; ++i) { const unsigned v = srt[i] > ob[15 - i] ? srt[i] : ob[15 - i]; thr = v < thr ? v : thr; }
            const float mtop = unordkey(s0[0] & ~127u) + unordkey(s1[0] & ~127u);
            float zp = 0.f; int cnt = 0;
#pragma unroll
            for (int s = 0; s < 13; ++s) { const bool sel = ck[s] >= thr && ck[s] != 0u; const float e = sel ? __expf(cs[s] - mtop) : 0.f; cs[s] = e; zp += e; cnt += sel ? 1 : 0; }
            float z = zp; z += __shfl_xor(z, 16); z += __shfl_xor(z, 32);
            const float rz = 1.f / z;
            const int c0 = __shfl(cnt, lt), c1 = __shfl(cnt, lt + 16), c2 = __shfl(cnt, lt + 32);
            int pos = lq == 0 ? 0 : (lq == 1 ? c0 : (lq == 2 ? c0 + c1 : c0 + c1 + c2));
            u32x2* dst = (u32x2*)p.topk() + ((size_t)tok * 8 + h) * 16;
#pragma unroll
            for (int s = 0; s < 13; ++s) {
                const bool sel = ck[s] >= thr && ck[s] != 0u;
                if (sel) { u32x2 o; o.x = ce_[s]; o.y = __builtin_bit_cast(unsigned, cs[s] * rz); dst[pos] = o; ++pos; }
            }
        }
    }
}

__device__ __forceinline__ void ph_peer_gather(const P& p) {
    const int wave = threadIdx.x >> 6, lane = threadIdx.x & 63;
    for (int tok = blockIdx.x * NWAVES + wave; tok < NTOK; tok += gridDim.x * NWAVES) {
        const int b = tok >> 12;
        const float* modb = p.mod() + (size_t)b * (6 * DM);
        float acc[16]; unsigned hp[8];
        const float rstd2 = rsqrtf(p.rowss()[tok] * (1.f / DM) + EPSN);
#pragma unroll
        for (int j = 0; j < 2; ++j)
#pragma unroll
            for (int q4 = 0; q4 < 2; ++q4) {
                const int e0 = j * 512 + lane * 8 + q4 * 4;
                const f32x4 xv = *(const f32x4*)(p.out + (size_t)tok * DM + e0), gg = *(const f32x4*)(p.norm2_g + e0), sh = *(const f32x4*)(modb + 3 * DM + e0), sc = *(const f32x4*)(modb + 4 * DM + e0);
                const f32x4 hv = xv * rstd2 * gg * (sc + 1.f) + sh;
#pragma unroll
                for (int i = 0; i < 4; ++i) acc[j * 8 + q4 * 4 + i] = 0.f;
                hp[j * 4 + q4 * 2] = pk2(hv[0], hv[1]); hp[j * 4 + q4 * 2 + 1] = pk2(hv[2], hv[3]);
            }
        const u32x2* tk = (const u32x2*)p.topk() + (size_t)tok * 128;
        const u32x2 ent0 = tk[lane], ent1 = tk[lane + 64];
#pragma unroll 1
        for (int k0 = 0; k0 < 128; k0 += 8) {
            u32x4 uu[8][2], vv[8][2]; float gk[8];
#pragma unroll
            for (int i = 0; i < 8; ++i) {
                const int k = k0 + i;
                const unsigned ex = k0 < 64 ? ent0.x : ent1.x, gx = k0 < 64 ? ent0.y : ent1.y;
                const unsigned e = __builtin_amdgcn_readlane(ex, k & 63);
                gk[i] = __builtin_bit_cast(float, __builtin_amdgcn_readlane(gx, k & 63));
                const bf16_t* ur = p.pu() + (size_t)e * DM + lane * 8; const bf16_t* vr = p.pv() + (size_t)e * DM + lane * 8;
                uu[i][0] = *(const u32x4*)ur; uu[i][1] = *(const u32x4*)(ur + 512);
                vv[i][0] = *(const u32x4*)vr; vv[i][1] = *(const u32x4*)(vr + 512);
            }
            float pd[8];
#pragma unroll
            for (int i = 0; i < 8; ++i) {
                float d = 0.f;
#pragma unroll
                for (int j = 0; j < 2; ++j) {
                    const unsigned u0 = uu[i][j][0], u1 = uu[i][j][1], u2 = uu[i][j][2], u3 = uu[i][j][3];
                    d = dot2bf(u0, hp[j * 4 + 0], d); d = dot2bf(u1, hp[j * 4 + 1], d); d = dot2bf(u2, hp[j * 4 + 2], d); d = dot2bf(u3, hp[j * 4 + 3], d);
                }
                pd[i] = d;
            }
            float r4[4], r2[2], r1;
            { const bool hi = lane & 32;
#pragma unroll
              for (int i = 0; i < 4; ++i) { const float keep = hi ? pd[i + 4] : pd[i], send = hi ? pd[i] : pd[i + 4]; r4[i] = keep + __shfl_xor(send, 32); } }
            { const bool hi = lane & 16;
#pragma unroll
              for (int i = 0; i < 2; ++i) { const float keep = hi ? r4[i + 2] : r4[i], send = hi ? r4[i] : r4[i + 2]; r2[i] = keep + __shfl_xor(send, 16); } }
            { const bool hi = lane & 8; const float keep = hi ? r2[1] : r2[0], send = hi ? r2[0] : r2[1]; r1 = keep + __shfl_xor(send, 8); }
            r1 += __shfl_xor(r1, 4); r1 += __shfl_xor(r1, 2); r1 += __shfl_xor(r1, 1);
#pragma unroll
            for (int i = 0; i < 8; ++i) {
                const float a = __builtin_bit_cast(float, __builtin_amdgcn_readlane(__builtin_bit_cast(unsigned, r1), ((i >> 2) & 1) * 32 + ((i >> 1) & 1) * 16 + (i & 1) * 8));
                const float w = gk[i] * gelu_tanh(a);
#pragma unroll
                for (int j = 0; j < 2; ++j) {
                    acc[j * 8 + 0] += w * bflo(vv[i][j].x); acc[j * 8 + 1] += w * bfhi(vv[i][j].x); acc[j * 8 + 2] += w * bflo(vv[i][j].y); acc[j * 8 + 3] += w * bfhi(vv[i][j].y);
                    acc[j * 8 + 4] += w * bflo(vv[i][j].z); acc[j * 8 + 5] += w * bfhi(vv[i][j].z); acc[j * 8 + 6] += w * bflo(vv[i][j].w); acc[j * 8 + 7] += w * bfhi(vv[i][j].w);
                }
            }
        }
        float ss = 0.f; float x1v[16];
#pragma unroll
        for (int j = 0; j < 2; ++j)
#pragma unroll
            for (int q4 = 0; q4 < 2; ++q4) {
                const int e0 = j * 512 + lane * 8 + q4 * 4;
                const f32x4 g2 = *(const f32x4*)(modb + 5 * DM + e0), xv = *(const f32x4*)(p.out + (size_t)tok * DM + e0);
#pragma unroll
                for (int i = 0; i < 4; ++i) { const int ix = j * 8 + q4 * 4 + i; x1v[ix] = xv[i] + g2[i] * acc[ix]; ss += x1v[ix] * x1v[ix]; }
            }
        ss = wave_sum(ss);
        const float rstd = rsqrtf(ss * (1.f / DM) + EPSN);
#pragma unroll
        for (int j = 0; j < 2; ++j)
#pragma unroll
            for (int q4 = 0; q4 < 2; ++q4) {
                const int e0 = j * 512 + lane * 8 + q4 * 4;
                const f32x4 fg = *(const f32x4*)(p.final_g + e0);
                f32x4 o;
#pragma unroll
                for (int i = 0; i < 4; ++i) o[i] = x1v[j * 8 + q4 * 4 + i] * rstd * fg[i];
                *(f32x4*)(p.out + (size_t)tok * DM + e0) = o;
            }
    }
}


#define XB_TMO      128
#define XB_XCNT(j)  (256  + 64 * (j))
#define XB_XSUB(j)  (1280 + 64 * (j))
#define XB_XGEN(j)  (2304 + 64 * (j))
#define XB_TOP      3328
#define XB_TOPGEN   3392
#define XCD_BAR_WORDS 3456
#define XB_SPIN_CAP (1u << 18)
__device__ __forceinline__ unsigned xb_ld(unsigned* p)              { return __hip_atomic_load(p, __ATOMIC_RELAXED, __HIP_MEMORY_SCOPE_AGENT); }
__device__ __forceinline__ unsigned xb_add(unsigned* p, unsigned v) { return __hip_atomic_fetch_add(p, v, __ATOMIC_RELAXED, __HIP_MEMORY_SCOPE_AGENT); }
__device__ __forceinline__ unsigned xb_xcc_id() { return (unsigned)__builtin_amdgcn_s_getreg((3 << 11) | 20) & 0xFu; }
#define XB_SPIN(cond, bar) do { unsigned _sp = 0; while (cond) { __builtin_amdgcn_s_sleep(1); \
    if ((++_sp & 255u) == 0u) { if (xb_ld(&(bar)[XB_TMO])) break; if (_sp > XB_SPIN_CAP) { atomicAdd(&(bar)[XB_TMO], 1u); break; } } } } while (0)
struct XcdBarrier { unsigned* bar; unsigned x; volatile LAS unsigned* st; };
__device__ __forceinline__ XcdBarrier xcd_barrier_post(unsigned* bar, volatile LAS unsigned* st) {
    XcdBarrier b; b.bar = bar; b.x = xb_xcc_id(); b.st = st;
    if (threadIdx.x == 0) (void)xb_add(&bar[XB_XCNT(b.x)], 1u);
    return b;
}
__device__ __forceinline__ void xcd_barrier_complete(unsigned* bar, unsigned x, unsigned& nloc, unsigned& nx) {
    const unsigned G = gridDim.x * gridDim.y * gridDim.z;
    unsigned sum, cnt, mine, sp = 0u;
    for (;;) {
        sum = 0u; cnt = 0u; mine = 0u;
#pragma unroll
        for (unsigned j = 0; j < 16; ++j) { const unsigned c = xb_ld(&bar[XB_XCNT(j)]); sum += c; cnt += (c > 0u) ? 1u : 0u; mine = (j == x) ? c : mine; }
        if (sum == G) break;
        __builtin_amdgcn_s_sleep(1);
        if ((++sp & 255u) == 0u) { if (xb_ld(&bar[XB_TMO])) break; if (sp > XB_SPIN_CAP) { atomicAdd(&bar[XB_TMO], 1u); break; } }
    }
    nloc = mine > 0u ? mine : 1u; nx = cnt > 0u ? cnt : 1u;
}
__device__ __forceinline__ void xcd_barrier(const XcdBarrier& b) {
    asm volatile("s_waitcnt vmcnt(0)" ::: "memory");
    __syncthreads();
    if (threadIdx.x == 0) {
        unsigned* bar = b.bar;
        __builtin_amdgcn_s_waitcnt(0);
        unsigned nloc = b.st[0], nx = b.st[1];
        if (nloc == 0u) { xcd_barrier_complete(bar, b.x, nloc, nx); b.st[0] = nloc; b.st[1] = nx; }
        const unsigned old = xb_add(&bar[XB_XSUB(b.x)], 1u);
        const unsigned gen = old / nloc;
        if (old + 1u == (gen + 1u) * nloc) {
            __builtin_amdgcn_fence(__ATOMIC_RELEASE, "agent");
            asm volatile("s_waitcnt vmcnt(0)" ::: "memory");
            const unsigned og = xb_add(&bar[XB_TOP], 1u);
            const unsigned tg = og / nx;
            if (og + 1u == (tg + 1u) * nx) xb_add(&bar[XB_TOPGEN], 1u);
            else XB_SPIN(xb_ld(&bar[XB_TOPGEN]) == tg, bar);
            __builtin_amdgcn_fence(__ATOMIC_ACQUIRE, "agent");
            xb_add(&bar[XB_XGEN(b.x)], 1u);
            asm volatile("s_waitcnt vmcnt(0)" ::: "memory");
        } else {
            XB_SPIN(xb_ld(&bar[XB_XGEN(b.x)]) == gen, bar);
            __builtin_amdgcn_fence(__ATOMIC_ACQUIRE, "agent");
            asm volatile("s_waitcnt vmcnt(0)" ::: "memory");
        }
    }
    __syncthreads();
}

constexpr int LDS_BYTES = 147456;
#define GSYNC() xcd_barrier(xbar)
constexpr int MISC_OFF = LDS_BYTES - 64;

__global__ void __launch_bounds__(NT, 2) mega(P p) {
    extern __shared__ __attribute__((aligned(16))) unsigned char lds_raw[];
    LAS unsigned char* lds = (LAS unsigned char*)lds_raw;
    const int G = gridDim.x, bx = blockIdx.x;
    using namespace pg8;
    if (threadIdx.x < 16) ((LAS unsigned*)(lds + MISC_OFF))[threadIdx.x] = 0u;
    __syncthreads();
    const XcdBarrier xbar = xcd_barrier_post((unsigned*)p.ws, (volatile LAS unsigned*)(lds + MISC_OFF));

    ph_prep(p, lds);
    cg::this_grid().sync();
    ph_norm1(p, lds);
    GSYNC();
    {
        Gemm<DM, DM, DM> g{p.hx(), p.w_in_t()}; StaticOrder<NTOK, INC> S; S.init(G, bx);
        EpiInProj E{p.U(), p.kb(), (size_t)(p.qb() - p.kb()), p.vT(), p.ga(), 0};
        gemm_phase<EpiInProj, StaticOrder<NTOK, INC>, true, true>(lds, g, S, E);
        Gemm<DM, DM, DM> g2{p.hc(), p.w_in_t()}; StaticOrder<NCTX, CTXC> S2; S2.init(G, bx);
        EpiInProj E2{p.U(), p.kc(), 0, p.vcT(), p.ga(), 1};
        gemm_phase<EpiInProj, StaticOrder<NCTX, CTXC>, true, true>(lds, g2, S2, E2);
    }
    GSYNC();
    {
        Gemm<512, SSM_LD, 512, (long)SSM_ROWS * SSM_LD, 256L * 512> g{p.U(), p.Win()}; StaticOrder<SSM_ROWS, 256, 32> S; S.init(G, bx);
        EpiE E{p.E()};
        gemm_phase<EpiE, StaticOrder<SSM_ROWS, 256, 32>, true, true>(lds, g, S, E);
    }
    GSYNC();
    ph_carry(p);
    ph_na(p, lds);
    GSYNC();
    {
        Gemm<SSM_LD, SSM_LD, SSM_LD, (long)SSM_ROWS * SSM_LD, 512L * SSM_LD> g{p.U(), p.Kmat()}; StaticOrder<1024, 512, 32> S; S.init(G, bx);
        EpiZ E{p.z()};
        gemm_phase<EpiZ, StaticOrder<1024, 512, 32>, true, true>(lds, g, S, E);
    }
    GSYNC();
    {
        Gemm<512, 512, 512> g{p.z(), p.w_glu_t()}; StaticOrder<NTOK, 512> S; S.init(G, bx);
        EpiGlu E{p.gl(), p.z(), p.b_glu};
        gemm_phase<EpiGlu, StaticOrder<NTOK, 512>, true, true>(lds, g, S, E);
    }
    GSYNC();
    {
        Gemm<512, 512, 512> g{p.gl(), p.w_a_t()}; StaticOrder<NTOK, DM> S; S.init(G, bx);
        EpiBrA E{p.tbuf(), p.ga()};
        gemm_phase<EpiBrA, StaticOrder<NTOK, DM>, true, true>(lds, g, S, E);
        Gemm<512, 512, 512> g2{p.na(), p.w_b_t()};
        EpiBrB E2{p.merged(), p.tbuf(), p.gb()};
        gemm_phase<EpiBrB, StaticOrder<NTOK, DM>, true, true>(lds, g2, S, E2);
    }
    GSYNC();
    {
        Gemm<DM, DM, DM> g{p.merged(), p.w_out_t()}; StaticOrder<NTOK, DM> S; S.init(G, bx);
        EpiOut E{p.x, p.out, p.x1g(), p.mod(), p.norm2_g, p.rowss()};
        gemm_phase<EpiOut, StaticOrder<NTOK, DM>, true, true>(lds, g, S, E);
    }
    GSYNC();
    {
        Gemm<DM, DM, DM> g{p.x1g(), p.w_q_t()}; StaticOrder<NTOK, 2048> S; S.init(G, bx);
        EpiQ E{p.qp(), p.rowss(), p.c2()};
        gemm_phase<EpiQ, StaticOrder<NTOK, 2048>, true, true>(lds, g, S, E);
    }
    GSYNC();
    ph_peer_topk(p, lds);
    GSYNC();
    ph_peer_gather(p);
}

extern "C" void kernel_launch(void* const* d_in, const int* in_sizes, int n_in, void* d_out, int out_size, void* d_ws, size_t ws_size, hipStream_t stream) {
    static int grid = 0;
    if (grid == 0) {
        int dev = 0, cus = 0, per_cu = 0;
        (void)hipGetDevice(&dev);
        (void)hipDeviceGetAttribute(&cus, hipDeviceAttributeMultiprocessorCount, dev);
        (void)hipFuncSetAttribute((const void*)mega, hipFuncAttributeMaxDynamicSharedMemorySize, LDS_BYTES);
        (void)hipOccupancyMaxActiveBlocksPerMultiprocessor(&per_cu, (const void*)mega, NT, LDS_BYTES);
        if (per_cu < 1) { fprintf(stderr, "occupancy query says %d blocks per CU\n", per_cu); per_cu = 1; }
        grid = cus;
    }
    P p{};
    const float* const* in = (const float* const*)d_in;
    p.x = in[0]; p.c = in[1]; p.ctx = in[2]; p.c_ctx = in[3]; p.w_mod = in[4]; p.b_mod = in[5]; p.norm1_g = in[6]; p.norm2_g = in[7]; p.w_in = in[8];
    p.a_re = in[9]; p.a_im = in[10]; p.log_dt = in[11]; p.b_re = in[12]; p.b_im = in[13]; p.c_re = in[14]; p.c_im = in[15]; p.ssm_d = in[16];
    p.w_glu = in[17]; p.b_glu = in[18]; p.w_a = in[19]; p.w_b = in[20]; p.rpb = in[21]; p.w_out = in[22]; p.w_q = in[23]; p.subkeys = in[24];
    p.peer_u = in[25]; p.peer_v = in[26]; p.final_g = in[27];
    p.out = (float*)d_out;
    p.ws = (unsigned char*)d_ws;
    (void)hipMemsetAsync(d_ws, 0, 1 * MiB, stream);
    void* args[] = {&p};
    hipError_t e = hipLaunchCooperativeKernel((const void*)mega, dim3(grid), dim3(NT), args, LDS_BYTES, stream);
    if (e != hipSuccess) fprintf(stderr, "cooperative launch failed: %s (grid %d)\n", hipGetErrorString(e), grid);
}
```

```cpp
#include <hip/hip_runtime.h>
#include <hip/hip_cooperative_groups.h>
#include <cstdio>
#include <cstdint>
namespace cg = cooperative_groups;

#define LAS __attribute__((address_space(3)))
typedef unsigned short bf16_t;
typedef short bf16x8 __attribute__((ext_vector_type(8)));
typedef float f32x4 __attribute__((ext_vector_type(4)));
typedef float f32x2 __attribute__((ext_vector_type(2)));
typedef unsigned u32x4 __attribute__((ext_vector_type(4)));
typedef unsigned u32x2 __attribute__((ext_vector_type(2)));

constexpr int DM = 1024, NB = 8, SEQL = 4096, CTXL = 256, GW = 64, NTOK = NB * SEQL, NCTX = NB * CTXL;
constexpr int INC = 4096, CTXC = 1536;
constexpr int NT = 512, NWAVES = 8;
constexpr float EPSN = 1e-6f;
constexpr int SSM_ROWS = 1280;
constexpr int SSM_LD = 768;

__device__ __forceinline__ unsigned f2bf(float f) { unsigned u = __builtin_bit_cast(unsigned, f); return (u + 0x7fffu + ((u >> 16) & 1u)) >> 16; }
__device__ __forceinline__ unsigned pk2(float lo, float hi) { return f2bf(lo) | (f2bf(hi) << 16); }
__device__ __forceinline__ float bflo(unsigned w) { return __builtin_bit_cast(float, w << 16); }
__device__ __forceinline__ float bfhi(unsigned w) { return __builtin_bit_cast(float, w & 0xffff0000u); }
__device__ __forceinline__ float bf2f(bf16_t h) { return __builtin_bit_cast(float, (unsigned)h << 16); }

__device__ __forceinline__ float wave_sum(float v) {
#pragma unroll
    for (int o = 1; o < 64; o <<= 1) v += __shfl_xor(v, o);
    return v;
}
__device__ __forceinline__ float wave_max(float v) {
#pragma unroll
    for (int o = 1; o < 64; o <<= 1) v = fmaxf(v, __shfl_xor(v, o));
    return v;
}
__device__ __forceinline__ float sigmoidf_(float x) { return 1.f / (1.f + __expf(-x)); }
__device__ __forceinline__ float siluf_(float x) { return x / (1.f + __expf(-x)); }
__device__ __forceinline__ float gelu_tanh(float x) {
    const float k0 = 0.7978845608028654f, k1 = 0.044715f;
    const float u = k0 * (x + k1 * x * x * x);
    const float t = 1.f - 2.f / (1.f + __expf(2.f * u));
    return 0.5f * x * (1.f + t);
}

namespace pg8 {
#define PG8_LAS __attribute__((address_space(3)))
constexpr int BM = 256, BK = 64, HALF = 128, HTB = HALF * BK * 2  , STAGE_BYTES = 8 * HTB, NXCD = 8, WGM = 8;
__host__ __device__ __forceinline__ int lds_byte(int r, int c) { const int st = (r >> 4) * 2 + (c >> 5), rr = r & 15, cc = c & 31, ob = rr * 64 + cc * 2; return st * 1024 + (ob ^ (((ob >> 9) & 1) << 5)); }
__host__ __device__ __forceinline__ void stage_rc(int b, int& R, int& C) { const int st = b / 1024, sb = b % 1024, swz = sb ^ (((sb >> 9) & 1) << 5); R = (st >> 1) * 16 + swz / 64; C = (st & 1) * 32 + (swz % 64) / 2; }
__host__ __device__ __forceinline__ int perm32(int rho) { const int n = rho >> 4, i = rho & 15; return 8 * (i >> 2) + 4 * n + (i & 3); }

struct Unit { int pm, pn, g; };
template <int K_, int LDA, int LDB, long GSA = 0, long GSB = 0>
struct Gemm {
    const bf16_t* A; const bf16_t* Bt;
    static constexpr int K = K_, lda = LDA, ldb = LDB;
    __device__ __forceinline__ const char* abase(const Unit& u) const { return (const char*)(A + (size_t)u.g * GSA + (size_t)u.pm * BM * LDA); }
    __device__ __forceinline__ const char* bbase(const Unit& u) const { return (const char*)(Bt + (size_t)u.g * GSB + (size_t)u.pn * BM * LDB); }
};
template <int M, int N, int NGRP = 1>
struct StaticOrder {
    static constexpr int nM = M / BM, nN = N / BM, nwg = nM * nN;
    int G, c;
    __device__ void init(int G_, int c_) { G = G_; c = c_; }
    __device__ bool next(int i, Unit& u) const {
        const int L = i * G + c; if (L >= nwg * NGRP) return false;
        u.g = L / nwg;
        int wgid = L % nwg; { constexpr int q = nwg / NXCD, r = nwg % NXCD; const int xcd = wgid % NXCD, off = wgid / NXCD; wgid = (xcd < r ? xcd * (q + 1) : r * (q + 1) + (xcd - r) * q) + off; }
        constexpr int nig = WGM * nN; const int gid = wgid / nig, fm = gid * WGM, gsz = (nM - fm) < WGM ? (nM - fm) : WGM;
        u.pm = fm + ((wgid % nig) % gsz); u.pn = (wgid % nig) / gsz; return true;
    }
    __device__ __forceinline__ void a_ready(const Unit&) const {}
    __device__ __forceinline__ void done(const Unit&) const {}
};
__device__ __forceinline__ unsigned cvt_pk_bf16(float lo, float hi) { unsigned r; asm volatile("v_cvt_pk_bf16_f32 %0, %1, %2" : "=v"(r) : "v"(lo), "v"(hi)); return r; }
template <class Epi, class Sched, bool ALIGN_EPI = false, bool SP2 = false, class GemmT>
__device__ __forceinline__ void gemm_phase(PG8_LAS unsigned char* lds, const GemmT g, const Sched& S, const Epi& E) {
    const int tid = threadIdx.x, wid = __builtin_amdgcn_readfirstlane(tid >> 6), lane = tid & 63, wr = wid >> 2, wc = wid & 3, fr = lane & 15, fq = lane >> 4;
    const int K = g.K, nt = K / BK;
    unsigned voffA[2], voffB[2];
#pragma unroll
    for (int i = 0; i < 2; ++i) { int R, C; stage_rc(tid * 16 + i * 8192, R, C); const int Rb = Epi::PERM ? ((R & ~31) + perm32(R & 31)) : R;
        voffA[i] = (unsigned)(R * g.lda + C) * 2u; voffB[i] = (unsigned)(Rb * g.ldb + C) * 2u; }
    const size_t kstep = (size_t)(BK * 2);
    const size_t hstepA = (size_t)HALF * g.lda * 2, hstepB = (size_t)HALF * g.ldb * 2;
    const unsigned ldsw = (unsigned)wid * 1024u;
    const int aoff = lds_byte(wr * 64 + fr, fq * 8), boff = lds_byte(wc * 32 + fr, fq * 8);
#define PG8_SA(b, h) (((b) * 2 + (h)) * HTB)
#define PG8_SB(b, h) ((4 + (b) * 2 + (h)) * HTB)
#define PG8_STAGE(bufoff, gbase, voff) do { _Pragma("unroll") for (int _i = 0; _i < 2; ++_i) \
        __builtin_amdgcn_global_load_lds((const unsigned*)((const char*)(gbase) + (voff)[_i]), (PG8_LAS unsigned*)(lds + (bufoff) + ldsw + _i * 8192), 16, 0, 0); } while (0)
#define PG8_LDA(dst, b, h) do { _Pragma("unroll") for (int m = 0; m < 4; ++m) _Pragma("unroll") for (int k = 0; k < 2; ++k) dst[m][k] = *(const PG8_LAS bf16x8*)(lds + PG8_SA(b, h) + aoff + m * 2048 + k * 1024); } while (0)
#define PG8_LDB(dst, b, h) do { _Pragma("unroll") for (int n = 0; n < 2; ++n) _Pragma("unroll") for (int k = 0; k < 2; ++k) dst[n][k] = *(const PG8_LAS bf16x8*)(lds + PG8_SB(b, h) + boff + n * 2048 + k * 1024); } while (0)
#define PG8_MMA(ai, bj, At, Bt) do { __builtin_amdgcn_s_setprio(1); _Pragma("unroll") for (int m = 0; m < 4; ++m) _Pragma("unroll") for (int n = 0; n < 2; ++n) _Pragma("unroll") for (int k = 0; k < 2; ++k) \
        acc[ai][bj][m][n] = __builtin_amdgcn_mfma_f32_16x16x32_bf16(Bt[n][k], At[m][k], acc[ai][bj][m][n], 0, 0, 0); __builtin_amdgcn_s_setprio(0); } while (0)
#define PG8_WAIT_V(n) asm volatile("s_waitcnt vmcnt(" #n ")" ::: "memory")
#define PG8_WAIT_L(n) asm volatile("s_waitcnt lgkmcnt(" #n ")" ::: "memory")
#define PG8_BAR __builtin_amdgcn_s_barrier()
#define PG8_SCHED __builtin_amdgcn_sched_barrier(0)
    Unit cur, nxt; int ui = 0;
    if (!S.next(0, cur)) return;
    f32x4 acc[2][2][4][2];
#pragma unroll
    for (int a = 0; a < 2; ++a)
#pragma unroll
        for (int b = 0; b < 2; ++b)
#pragma unroll
            for (int m = 0; m < 4; ++m)
#pragma unroll
                for (int n = 0; n < 2; ++n) acc[a][b][m][n] = (f32x4){0.f, 0.f, 0.f, 0.f};
    bf16x8 At[4][2], B0[2][2], B1[2][2];
    const char* cA = g.abase(cur); const char* cB = g.bbase(cur);
    S.a_ready(cur);
    if constexpr (SP2) {
        PG8_STAGE(PG8_SB(0, 0), cB, voffB); PG8_STAGE(PG8_SB(0, 1), cB + hstepB, voffB); PG8_STAGE(PG8_SA(0, 0), cA, voffA); PG8_STAGE(PG8_SA(0, 1), cA + hstepA, voffA);
        if (wr == 1) PG8_BAR;
        PG8_WAIT_V(2); PG8_BAR;
        PG8_STAGE(PG8_SB(1, 0), cB + kstep, voffB); PG8_STAGE(PG8_SA(1, 0), cA + kstep, voffA); PG8_STAGE(PG8_SB(1, 1), cB + hstepB + kstep, voffB);
        PG8_WAIT_V(6); PG8_BAR;
    } else {
        PG8_STAGE(PG8_SB(0, 0), cB, voffB); PG8_STAGE(PG8_SA(0, 0), cA, voffA); PG8_STAGE(PG8_SB(0, 1), cB + hstepB, voffB); PG8_STAGE(PG8_SA(0, 1), cA + hstepA, voffA);
        if (wr == 1) PG8_BAR;
        PG8_WAIT_V(4); PG8_BAR;
        PG8_STAGE(PG8_SB(1, 0), cB + kstep, voffB); PG8_STAGE(PG8_SA(1, 0), cA + kstep, voffA); PG8_STAGE(PG8_SB(1, 1), cB + hstepB + kstep, voffB);
        PG8_WAIT_V(6); PG8_BAR;
    }
    for (;;) {
        const bool has_next = S.next(ui + 1, nxt);
        const char* nA = has_next ? g.abase(nxt) : cA; const char* nB = has_next ? g.bbase(nxt) : cB;
        for (int t = 0; t < nt; t += 2) {
            const bool last = (t == nt - 2);
            const char* a1 = cA + (size_t)(t + 1) * kstep;
            const char* a2 = last ? nA : cA + (size_t)(t + 2) * kstep; const char* b2 = last ? nB : cB + (size_t)(t + 2) * kstep;
            const char* a3 = a2 + kstep; const char* b3 = b2 + kstep;
            if (last && has_next) S.a_ready(nxt);
            if constexpr (SP2) {
            PG8_LDB(B0, 0, 0); PG8_LDB(B1, 0, 1); PG8_SCHED; PG8_LDA(At, 0, 0); PG8_STAGE(PG8_SA(1, 1), a1 + hstepA, voffA);
            PG8_WAIT_V(8); PG8_WAIT_L(0); PG8_BAR; PG8_MMA(0, 0, At, B0); PG8_MMA(0, 1, At, B1); PG8_BAR; PG8_SCHED;
            PG8_LDA(At, 0, 1); PG8_STAGE(PG8_SB(0, 0), b2, voffB); PG8_STAGE(PG8_SB(0, 1), b2 + hstepB, voffB); PG8_STAGE(PG8_SA(0, 0), a2, voffA);
            PG8_WAIT_V(8); PG8_WAIT_L(0); PG8_BAR; PG8_MMA(1, 0, At, B0); PG8_MMA(1, 1, At, B1); PG8_BAR; PG8_SCHED;
            PG8_LDB(B0, 1, 0); PG8_LDB(B1, 1, 1); PG8_SCHED; PG8_LDA(At, 1, 0); PG8_STAGE(PG8_SA(0, 1), a2 + hstepA, voffA);
            PG8_WAIT_V(8); PG8_WAIT_L(0); PG8_BAR; PG8_MMA(0, 0, At, B0); PG8_MMA(0, 1, At, B1); PG8_BAR; PG8_SCHED;
            PG8_LDA(At, 1, 1); PG8_STAGE(PG8_SB(1, 0), b3, voffB); PG8_STAGE(PG8_SB(1, 1), b3 + hstepB, voffB); PG8_STAGE(PG8_SA(1, 0), a3, voffA);
            PG8_WAIT_V(8); PG8_WAIT_L(0); PG8_BAR; PG8_MMA(1, 0, At, B0); PG8_MMA(1, 1, At, B1); PG8_BAR; PG8_SCHED;
            } else {
            PG8_LDB(B0, 0, 0); PG8_SCHED; PG8_LDA(At, 0, 0); PG8_STAGE(PG8_SA(1, 1), a1 + hstepA, voffA);
            PG8_WAIT_L(8); PG8_BAR; PG8_WAIT_L(0); PG8_MMA(0, 0, At, B0); PG8_BAR; PG8_SCHED;
            PG8_LDB(B1, 0, 1); PG8_STAGE(PG8_SB(0, 0), b2, voffB);
            PG8_BAR; PG8_WAIT_L(0); PG8_MMA(0, 1, At, B1); PG8_BAR;
            PG8_LDA(At, 0, 1); PG8_STAGE(PG8_SA(0, 0), a2, voffA);
            PG8_BAR; PG8_WAIT_L(0); PG8_MMA(1, 0, At, B0); PG8_BAR; PG8_SCHED;
            PG8_STAGE(PG8_SB(0, 1), b2 + hstepB, voffB);
            PG8_WAIT_V(6); PG8_BAR; PG8_MMA(1, 1, At, B1); PG8_BAR;
            PG8_LDB(B0, 1, 0); PG8_SCHED; PG8_LDA(At, 1, 0); PG8_STAGE(PG8_SA(0, 1), a2 + hstepA, voffA);
            PG8_WAIT_L(8); PG8_BAR; PG8_WAIT_L(0); PG8_MMA(0, 0, At, B0); PG8_BAR; PG8_SCHED;
            PG8_LDB(B1, 1, 1); PG8_STAGE(PG8_SB(1, 0), b3, voffB);
            PG8_BAR; PG8_WAIT_L(0); PG8_MMA(0, 1, At, B1); PG8_BAR;
            PG8_LDA(At, 1, 1); PG8_STAGE(PG8_SA(1, 0), a3, voffA);
            PG8_BAR; PG8_WAIT_L(0); PG8_MMA(1, 0, At, B0); PG8_BAR; PG8_SCHED;
            PG8_STAGE(PG8_SB(1, 1), b3 + hstepB, voffB);
            PG8_WAIT_V(6); PG8_BAR; PG8_MMA(1, 1, At, B1); PG8_BAR;
            }
        }
        if constexpr (ALIGN_EPI) { if (wr == 0) PG8_BAR; }
        if constexpr (!Epi::AFTER_DRAIN) { E(acc, cur, wr, wc, fr, fq); S.done(cur); }
        if (!has_next) break;
#pragma unroll
        for (int a = 0; a < 2; ++a)
#pragma unroll
            for (int b = 0; b < 2; ++b)
#pragma unroll
                for (int m = 0; m < 4; ++m)
#pragma unroll
                    for (int n = 0; n < 2; ++n) acc[a][b][m][n] = (f32x4){0.f, 0.f, 0.f, 0.f};
        cur = nxt; cA = nA; cB = nB; ++ui;
        if constexpr (ALIGN_EPI) { if (wr == 1) PG8_BAR; }
    }
    PG8_WAIT_V(0);
    if constexpr (!ALIGN_EPI) { if (wr == 0) PG8_BAR; }
    PG8_BAR;
    if constexpr (Epi::AFTER_DRAIN) { E.fused(acc, cur, wr, wc, fr, fq, lds, wid, lane); S.done(cur); }
#undef PG8_SA
#undef PG8_SB
#undef PG8_STAGE
#undef PG8_LDA
#undef PG8_LDB
#undef PG8_MMA
#undef PG8_WAIT_V
#undef PG8_WAIT_L
#undef PG8_BAR
#undef PG8_SCHED
}
}

constexpr size_t MiB = 1u << 20;
struct P {
    const float *x, *c, *ctx, *c_ctx, *w_mod, *b_mod, *norm1_g, *norm2_g, *w_in;
    const float *a_re, *a_im, *log_dt, *b_re, *b_im, *c_re, *c_im, *ssm_d;
    const float *w_glu, *b_glu, *w_a, *w_b, *rpb, *w_out, *w_q, *subkeys, *peer_u, *peer_v, *final_g;
    float* out;
    unsigned char* ws;
    __device__ __forceinline__ float* rowss() const { return (float*)(ws + 512 * 1024); }
    __device__ __forceinline__ float* mod() const { return (float*)(ws + 1 * MiB); }
    __device__ __forceinline__ float* c2() const { return (float*)(ws + 1 * MiB + 256 * 1024); }
    __device__ __forceinline__ bf16_t* w_in_t() const { return (bf16_t*)(ws + 3 * MiB); }
    __device__ __forceinline__ bf16_t* w_glu_t() const { return (bf16_t*)(ws + 11 * MiB); }
    __device__ __forceinline__ bf16_t* w_a_t() const { return (bf16_t*)(ws + 12 * MiB); }
    __device__ __forceinline__ bf16_t* w_b_t() const { return (bf16_t*)(ws + 13 * MiB); }
    __device__ __forceinline__ bf16_t* w_out_t() const { return (bf16_t*)(ws + 14 * MiB); }
    __device__ __forceinline__ bf16_t* w_q_t() const { return (bf16_t*)(ws + 16 * MiB); }
    __device__ __forceinline__ bf16_t* Kmat() const { return (bf16_t*)(ws + 21 * MiB); }
    __device__ __forceinline__ bf16_t* Win() const { return (bf16_t*)(ws + 45 * MiB); }
    __device__ __forceinline__ float* lamT() const { return (float*)(ws + 53 * MiB); }
    __device__ __forceinline__ unsigned char* pu8() const { return ws + 54 * MiB; }
    __device__ __forceinline__ unsigned char* pv8() const { return ws + 70 * MiB; }
    __device__ __forceinline__ float* pisc() const { return (float*)(ws + 53 * MiB + 128 * 1024); }
    __device__ __forceinline__ bf16_t* ga() const { return (bf16_t*)(ws + 118 * MiB); }
    __device__ __forceinline__ bf16_t* gb() const { return (bf16_t*)(ws + 182 * MiB); }
    __device__ __forceinline__ bf16_t* x1g() const { return (bf16_t*)(ws + 118 * MiB); }
    __device__ __forceinline__ unsigned* topk() const { return (unsigned*)(ws + 182 * MiB); }
    __device__ __forceinline__ bf16_t* kb() const { return (bf16_t*)(ws + 246 * MiB); }
    __device__ __forceinline__ bf16_t* vT() const { return (bf16_t*)(ws + 278 * MiB); }
    __device__ __forceinline__ bf16_t* qb() const { return (bf16_t*)(ws + 310 * MiB); }
    __device__ __forceinline__ bf16_t* kc() const { return (bf16_t*)(ws + 342 * MiB); }
    __device__ __forceinline__ bf16_t* vcT() const { return (bf16_t*)(ws + 344 * MiB); }
    __device__ __forceinline__ bf16_t* U() const { return (bf16_t*)(ws + 346 * MiB); }
    __device__ __forceinline__ float* E() const { return (float*)(ws + 406 * MiB); }
    __device__ __forceinline__ bf16_t* merged() const { return (bf16_t*)(ws + 246 * MiB); }
    __device__ __forceinline__ float* tbuf() const { return (float*)(ws + 310 * MiB); }
    __device__ __forceinline__ bf16_t* qp() const { return (bf16_t*)(ws + 246 * MiB); }
    __device__ __forceinline__ bf16_t* hx() const { return (bf16_t*)out; }
    __device__ __forceinline__ bf16_t* hc() const { return (bf16_t*)((unsigned char*)out + 64 * MiB); }
    __device__ __forceinline__ bf16_t* na() const { return (bf16_t*)out; }
    __device__ __forceinline__ bf16_t* z() const { return (bf16_t*)((unsigned char*)out + 32 * MiB); }
    __device__ __forceinline__ bf16_t* gl() const { return (bf16_t*)((unsigned char*)out + 64 * MiB); }
};

namespace pg8 {
struct EpiInProj {
    static constexpr bool PERM = true, AFTER_DRAIN = false;
    bf16_t* U; bf16_t* d_kq; size_t kq_stride; bf16_t* d_vT; bf16_t* d_gate; int is_ctx;
    __device__ __forceinline__ void operator()(const f32x4 (&acc)[2][2][4][2], const Unit& u, int wr, int wc, int fr, int fq) const {
        if (u.pn < 2) {
#pragma unroll
            for (int ai = 0; ai < 2; ++ai)
#pragma unroll
                for (int m = 0; m < 4; ++m) {
                    const int row = u.pm * BM + ai * HALF + wr * 64 + m * 16 + fr;
                    const int n = is_ctx ? (1024 + (row >> 8) * 8 + ((row & 255) >> 5)) : ((row >> 12) * 128 + ((row & 4095) >> 5));
                    const int jj = row & 31;
#pragma unroll
                    for (int bj = 0; bj < 2; ++bj) {
                        const int col = u.pn * BM + bj * HALF + wc * 32 + 8 * fq;
                        const f32x4 v0 = acc[ai][bj][m][0], v1 = acc[ai][bj][m][1];
                        u32x4 w; w.x = cvt_pk_bf16(v0[0], v0[1]); w.y = cvt_pk_bf16(v0[2], v0[3]); w.z = cvt_pk_bf16(v1[0], v1[1]); w.w = cvt_pk_bf16(v1[2], v1[3]);
                        *(u32x4*)(U + ((size_t)((col >> 4) * SSM_ROWS + n) * SSM_LD + jj * 16 + (col & 15))) = w;
                    }
                    asm volatile("" ::: "memory");
                }
        } else if (u.pn == 4 || u.pn == 5) {
            const int T = is_ctx ? CTXL : SEQL;
#pragma unroll
            for (int ai = 0; ai < 2; ++ai)
#pragma unroll
                for (int m = 0; m < 4; ++m) {
                    const int row = u.pm * BM + ai * HALF + wr * 64 + m * 16 + fr;
                    const int b = is_ctx ? (row >> 8) : (row >> 12), t = is_ctx ? (row & 255) : (row & 4095);
#pragma unroll
                    for (int bj = 0; bj < 2; ++bj) {
                        const int col = u.pn * BM + bj * HALF + wc * 32 + 8 * fq - 1024;
                        bf16_t* dst = d_vT + ((size_t)(b * 512 + col) * T + t);
#pragma unroll
                        for (int n = 0; n < 2; ++n)
#pragma unroll
                            for (int i = 0; i < 4; ++i) dst[(size_t)(n * 4 + i) * T] = (bf16_t)f2bf(acc[ai][bj][m][n][i]);
                    }
                    asm volatile("" ::: "memory");
                }
        } else {
            bf16_t* base; int ld, c0;
            if (u.pn < 8) { const int which = (u.pn - 2) >> 2; base = d_kq + (size_t)which * kq_stride; ld = 512; c0 = 512 + which * 1024; }
            else { const int which = (u.pn - 8) >> 2; base = d_gate + (size_t)which * ((size_t)NTOK * DM); ld = DM; c0 = 2048 + which * 1024; }
#pragma unroll
            for (int ai = 0; ai < 2; ++ai)
#pragma unroll
                for (int m = 0; m < 4; ++m) {
                    const int row = u.pm * BM + ai * HALF + wr * 64 + m * 16 + fr;
#pragma unroll
                    for (int bj = 0; bj < 2; ++bj) {
                        const int col = u.pn * BM + bj * HALF + wc * 32 + 8 * fq - c0;
                        const f32x4 v0 = acc[ai][bj][m][0], v1 = acc[ai][bj][m][1];
                        u32x4 w; w.x = cvt_pk_bf16(v0[0], v0[1]); w.y = cvt_pk_bf16(v0[2], v0[3]); w.z = cvt_pk_bf16(v1[0], v1[1]); w.w = cvt_pk_bf16(v1[2], v1[3]);
                        *(u32x4*)(base + (size_t)row * ld + col) = w;
                    }
                    asm volatile("" ::: "memory");
                }
        }
    }
};
struct EpiGlu {
    static constexpr bool PERM = true, AFTER_DRAIN = false;
    bf16_t* gl; const bf16_t* z; const float* bias;
    __device__ __forceinline__ void operator()(const f32x4 (&acc)[2][2][4][2], const Unit& u, int wr, int wc, int fr, int fq) const {
#pragma unroll
        for (int ai = 0; ai < 2; ++ai)
#pragma unroll
            for (int m = 0; m < 4; ++m) {
                const int row = u.pm * BM + ai * HALF + wr * 64 + m * 16 + fr;
#pragma unroll
                for (int bj = 0; bj < 2; ++bj) {
                    const int col = u.pn * BM + bj * HALF + wc * 32 + 8 * fq;
                    const f32x4 v0 = acc[ai][bj][m][0], v1 = acc[ai][bj][m][1];
                    const f32x4 b0 = *(const f32x4*)(bias + col), b1 = *(const f32x4*)(bias + col + 4);
                    const u32x4 zz = *(const u32x4*)(z + (size_t)row * 512 + col);
                    float o[8];
                    o[0] = bflo(zz.x) * sigmoidf_(v0[0] + b0[0]); o[1] = bfhi(zz.x) * sigmoidf_(v0[1] + b0[1]);
                    o[2] = bflo(zz.y) * sigmoidf_(v0[2] + b0[2]); o[3] = bfhi(zz.y) * sigmoidf_(v0[3] + b0[3]);
                    o[4] = bflo(zz.z) * sigmoidf_(v1[0] + b1[0]); o[5] = bfhi(zz.z) * sigmoidf_(v1[1] + b1[1]);
                    o[6] = bflo(zz.w) * sigmoidf_(v1[2] + b1[2]); o[7] = bfhi(zz.w) * sigmoidf_(v1[3] + b1[3]);
                    u32x4 w; w.x = cvt_pk_bf16(o[0], o[1]); w.y = cvt_pk_bf16(o[2], o[3]); w.z = cvt_pk_bf16(o[4], o[5]); w.w = cvt_pk_bf16(o[6], o[7]);
                    *(u32x4*)(gl + (size_t)row * 512 + col) = w;
                }
            }
    }
};
struct EpiBrA {
    static constexpr bool PERM = true, AFTER_DRAIN = false;
    float* t; const bf16_t* ga;
    __device__ __forceinline__ void operator()(const f32x4 (&acc)[2][2][4][2], const Unit& u, int wr, int wc, int fr, int fq) const {
#pragma unroll
        for (int ai = 0; ai < 2; ++ai)
#pragma unroll
            for (int m = 0; m < 4; ++m) {
                const int row = u.pm * BM + ai * HALF + wr * 64 + m * 16 + fr;
#pragma unroll
                for (int bj = 0; bj < 2; ++bj) {
                    const int col = u.pn * BM + bj * HALF + wc * 32 + 8 * fq;
                    const f32x4 v0 = acc[ai][bj][m][0], v1 = acc[ai][bj][m][1];
                    const u32x4 gg = *(const u32x4*)(ga + (size_t)row * DM + col);
                    f32x4 o0, o1;
                    o0[0] = sigmoidf_(bflo(gg.x)) * v0[0]; o0[1] = sigmoidf_(bfhi(gg.x)) * v0[1]; o0[2] = sigmoidf_(bflo(gg.y)) * v0[2]; o0[3] = sigmoidf_(bfhi(gg.y)) * v0[3];
                    o1[0] = sigmoidf_(bflo(gg.z)) * v1[0]; o1[1] = sigmoidf_(bfhi(gg.z)) * v1[1]; o1[2] = sigmoidf_(bflo(gg.w)) * v1[2]; o1[3] = sigmoidf_(bfhi(gg.w)) * v1[3];
                    *(f32x4*)(t + (size_t)row * DM + col) = o0; *(f32x4*)(t + (size_t)row * DM + col + 4) = o1;
                }
            }
    }
};
struct EpiBrB {
    static constexpr bool PERM = true, AFTER_DRAIN = false;
    bf16_t* merged; const float* t; const bf16_t* gb;
    __device__ __forceinline__ void operator()(const f32x4 (&acc)[2][2][4][2], const Unit& u, int wr, int wc, int fr, int fq) const {
#pragma unroll
        for (int ai = 0; ai < 2; ++ai)
#pragma unroll
            for (int m = 0; m < 4; ++m) {
                const int row = u.pm * BM + ai * HALF + wr * 64 + m * 16 + fr;
#pragma unroll
                for (int bj = 0; bj < 2; ++bj) {
                    const int col = u.pn * BM + bj * HALF + wc * 32 + 8 * fq;
                    const f32x4 v0 = acc[ai][bj][m][0], v1 = acc[ai][bj][m][1];
                    const u32x4 gg = *(const u32x4*)(gb + (size_t)row * DM + col);
                    const f32x4 t0 = *(const f32x4*)(t + (size_t)row * DM + col), t1 = *(const f32x4*)(t + (size_t)row * DM + col + 4);
                    float o[8];
                    o[0] = t0[0] + sigmoidf_(bflo(gg.x)) * v0[0]; o[1] = t0[1] + sigmoidf_(bfhi(gg.x)) * v0[1]; o[2] = t0[2] + sigmoidf_(bflo(gg.y)) * v0[2]; o[3] = t0[3] + sigmoidf_(bfhi(gg.y)) * v0[3];
                    o[4] = t1[0] + sigmoidf_(bflo(gg.z)) * v1[0]; o[5] = t1[1] + sigmoidf_(bfhi(gg.z)) * v1[1]; o[6] = t1[2] + sigmoidf_(bflo(gg.w)) * v1[2]; o[7] = t1[3] + sigmoidf_(bfhi(gg.w)) * v1[3];
                    u32x4 w; w.x = cvt_pk_bf16(o[0], o[1]); w.y = cvt_pk_bf16(o[2], o[3]); w.z = cvt_pk_bf16(o[4], o[5]); w.w = cvt_pk_bf16(o[6], o[7]);
                    *(u32x4*)(merged + (size_t)row * DM + col) = w;
                }
            }
    }
};
struct EpiOut {
    static constexpr bool PERM = true, AFTER_DRAIN = false;
    const float* x; float* x1; bf16_t* x1g; const float* mod; const float* g2; float* rowss;
    __device__ __forceinline__ void operator()(const f32x4 (&acc)[2][2][4][2], const Unit& u, int wr, int wc, int fr, int fq) const {
#pragma unroll
        for (int ai = 0; ai < 2; ++ai)
#pragma unroll
            for (int m = 0; m < 4; ++m) {
                const int row = u.pm * BM + ai * HALF + wr * 64 + m * 16 + fr;
                const float* modb = mod + (size_t)(row >> 12) * (6 * DM);
                float ss = 0.f;
#pragma unroll
                for (int bj = 0; bj < 2; ++bj) {
                    const int col = u.pn * BM + bj * HALF + wc * 32 + 8 * fq;
#pragma unroll
                    for (int n = 0; n < 2; ++n) {
                        const int cc = col + 4 * n;
                        const f32x4 v = acc[ai][bj][m][n];
                        const f32x4 xx = *(const f32x4*)(x + (size_t)row * DM + cc);
                        const f32x4 g1 = *(const f32x4*)(modb + 2 * DM + cc), sc = *(const f32x4*)(modb + 4 * DM + cc), gg = *(const f32x4*)(g2 + cc);
                        const f32x4 o = xx + g1 * v;
                        *(f32x4*)(x1 + (size_t)row * DM + cc) = o;
                        ss += o[0] * o[0] + o[1] * o[1] + o[2] * o[2] + o[3] * o[3];
                        const f32x4 og = o * gg * (sc + 1.f);
                        u32x2 w; w.x = cvt_pk_bf16(og[0], og[1]); w.y = cvt_pk_bf16(og[2], og[3]);
                        *(u32x2*)(x1g + (size_t)row * DM + cc) = w;
                    }
                }
                ss += __shfl_xor(ss, 16); ss += __shfl_xor(ss, 32);
                if (fq == 0) atomicAdd(rowss + row, ss);
            }
    }
};
struct EpiQ {
    static constexpr bool PERM = true, AFTER_DRAIN = false;
    bf16_t* qp; const float* rowss; const float* c2;
    __device__ __forceinline__ void operator()(const f32x4 (&acc)[2][2][4][2], const Unit& u, int wr, int wc, int fr, int fq) const {
#pragma unroll
        for (int ai = 0; ai < 2; ++ai)
#pragma unroll
            for (int m = 0; m < 4; ++m) {
                const int row = u.pm * BM + ai * HALF + wr * 64 + m * 16 + fr;
                const float rstd = rsqrtf(rowss[row] * (1.f / DM) + EPSN);
                const float* cb = c2 + (size_t)(row >> 12) * 2048;
#pragma unroll
                for (int bj = 0; bj < 2; ++bj) {
                    const int col = u.pn * BM + bj * HALF + wc * 32 + 8 * fq;
                    const f32x4 v0 = acc[ai][bj][m][0] * rstd + *(const f32x4*)(cb + col), v1 = acc[ai][bj][m][1] * rstd + *(const f32x4*)(cb + col + 4);
                    u32x4 w; w.x = cvt_pk_bf16(v0[0], v0[1]); w.y = cvt_pk_bf16(v0[2], v0[3]); w.z = cvt_pk_bf16(v1[0], v1[1]); w.w = cvt_pk_bf16(v1[2], v1[3]);
                    *(u32x4*)(qp + (size_t)row * 2048 + col) = w;
                }
            }
    }
};
struct EpiE {
    static constexpr bool PERM = true, AFTER_DRAIN = false;
    float* E;
    __device__ __forceinline__ void operator()(const f32x4 (&acc)[2][2][4][2], const Unit& u, int wr, int wc, int fr, int fq) const {
#pragma unroll
        for (int ai = 0; ai < 2; ++ai)
#pragma unroll
            for (int m = 0; m < 4; ++m) {
                const int row = u.pm * BM + ai * HALF + wr * 64 + m * 16 + fr;
#pragma unroll
                for (int bj = 0; bj < 2; ++bj) {
                    const int col = u.pn * BM + bj * HALF + wc * 32 + 8 * fq;
                    float* d = E + ((size_t)(u.g * SSM_ROWS + row) * 256 + col);
                    *(f32x4*)d = acc[ai][bj][m][0]; *(f32x4*)(d + 4) = acc[ai][bj][m][1];
                }
            }
    }
};
struct EpiZ {
    static constexpr bool PERM = true, AFTER_DRAIN = false;
    bf16_t* z;
    __device__ __forceinline__ void operator()(const f32x4 (&acc)[2][2][4][2], const Unit& u, int wr, int wc, int fr, int fq) const {
#pragma unroll
        for (int ai = 0; ai < 2; ++ai)
#pragma unroll
            for (int m = 0; m < 4; ++m) {
                const int n = u.pm * BM + ai * HALF + wr * 64 + m * 16 + fr;
                const size_t tok0 = (size_t)(n >> 7) * SEQL + (size_t)(n & 127) * 32;
#pragma unroll
                for (int bj = 0; bj < 2; ++bj) {
                    const int col = u.pn * BM + bj * HALF + wc * 32 + 8 * fq;
                    const f32x4 v0 = acc[ai][bj][m][0], v1 = acc[ai][bj][m][1];
                    u32x4 w; w.x = cvt_pk_bf16(gelu_tanh(v0[0]), gelu_tanh(v0[1])); w.y = cvt_pk_bf16(gelu_tanh(v0[2]), gelu_tanh(v0[3]));
                    w.z = cvt_pk_bf16(gelu_tanh(v1[0]), gelu_tanh(v1[1])); w.w = cvt_pk_bf16(gelu_tanh(v1[2]), gelu_tanh(v1[3]));
                    *(u32x4*)(z + (tok0 + (col >> 4)) * 512 + u.g * 16 + (col & 15)) = w;
                }
            }
    }
};
}

__device__ __forceinline__ void sincos_d(double th, double& s, double& c) {
    const double twopi = 6.283185307179586476925, hpi = 1.570796326794896619231;
    th -= twopi * rint(th / twopi);
    const double q = rint(th / hpi); const double y = th - q * hpi, y2 = y * y;
    const double sy = y * (1.0 - y2 / 6.0 * (1.0 - y2 / 20.0 * (1.0 - y2 / 42.0 * (1.0 - y2 / 72.0 * (1.0 - y2 / 110.0 * (1.0 - y2 / 156.0 * (1.0 - y2 / 210.0)))))));
    const double cy = 1.0 - y2 / 2.0 * (1.0 - y2 / 12.0 * (1.0 - y2 / 30.0 * (1.0 - y2 / 56.0 * (1.0 - y2 / 90.0 * (1.0 - y2 / 132.0 * (1.0 - y2 / 182.0))))));
    const int qi = ((int)q) & 3;
    s = qi == 0 ? sy : (qi == 1 ? cy : (qi == 2 ? -sy : -cy));
    c = qi == 0 ? cy : (qi == 1 ? -sy : (qi == 2 ? -cy : sy));
}
__device__ __forceinline__ void ssm_prep_item(const P& p, LAS unsigned char* lds, int item) {
    const int g = item >> 2, qtr = item & 3, tid = threadIdx.x;
    LAS f32x2* lamk = (LAS f32x2*)lds;
    LAS f32x2* Bb = lamk + 2 * 64 * 33;
    LAS f32x2* Cc = Bb + 2 * 64 * 16;
    LAS float* Kc = (LAS float*)(Cc + 2 * 16 * 64);
    if (tid < 128) {
        const int d = tid >> 6, pp = tid & 63, gi = d * 32 + g;
        const double are = (double)p.a_re[gi * 64 + pp], aim = (double)p.a_im[gi * 64 + pp];
        const double dt = (double)expf(p.log_dt[gi]);
        const double er = exp(are * dt); double sn, cs; sincos_d(aim * dt, sn, cs);
        const double lr = er * cs, li = er * sn;
        double pr = 1.0, pi_ = 0.0;
        for (int k = 0; k <= 32; ++k) {
            lamk[(d * 64 + pp) * 33 + k] = (f32x2){(float)pr, (float)pi_};
            const double nr_ = pr * lr - pi_ * li, ni_ = pr * li + pi_ * lr; pr = nr_; pi_ = ni_;
        }
        if (qtr == 0) { const f32x2 l32 = lamk[(d * 64 + pp) * 33 + 32]; *(f32x2*)(p.lamT() + (size_t)(gi * 64 + pp) * 2) = l32; }
        const double nr = lr - 1.0, ni = li, den = are * are + aim * aim;
        const double qr = (nr * are + ni * aim) / den, qi = (ni * are - nr * aim) / den;
        for (int h = 0; h < 16; ++h) {
            const double br = (double)p.b_re[((size_t)gi * 64 + pp) * 16 + h], bi = (double)p.b_im[((size_t)gi * 64 + pp) * 16 + h];
            Bb[(d * 64 + pp) * 16 + h] = (f32x2){(float)(qr * br - qi * bi), (float)(qr * bi + qi * br)};
        }
    }
    for (int e = tid; e < 2 * 16 * 64; e += NT) {
        const int d = e >> 10, h = (e >> 6) & 15, pp = e & 63; const size_t src = ((size_t)(d * 32 + g) * 16 + h) * 64 + pp;
        Cc[e] = (f32x2){p.c_re[src], p.c_im[src]};
    }
    __syncthreads();
    for (int e = tid; e < 2 * 32 * 256; e += NT) {
        const int d = e >> 13, k = (e >> 8) & 31, h = (e >> 4) & 15, h2 = e & 15;
        float sacc = 0.f;
        for (int pp = 0; pp < 64; ++pp) {
            const f32x2 c = Cc[(d * 16 + h) * 64 + pp], l = lamk[(d * 64 + pp) * 33 + k], b = Bb[(d * 64 + pp) * 16 + h2];
            const float clr = c[0] * l[0] - c[1] * l[1], cli = c[0] * l[1] + c[1] * l[0];
            sacc += clr * b[0] - cli * b[1];
        }
        Kc[e] = sacc;
    }
    __syncthreads();
    for (int ch = tid; ch < 128 * 96; ch += NT) {
        const int mrow = 128 * qtr + ch / 96, k0 = (ch % 96) * 8, ii = mrow >> 4, h = mrow & 15;
        float v[8];
        if (k0 < 512) {
            const int jj = k0 >> 4, h20 = k0 & 15;
#pragma unroll
            for (int i = 0; i < 8; ++i) {
                const int h2 = h20 + i; float val = 0.f;
                if (ii >= jj) val += Kc[((0 * 32 + (ii - jj)) * 16 + h) * 16 + h2];
                if (jj >= ii) val += Kc[((1 * 32 + (jj - ii)) * 16 + h) * 16 + h2];
                if (ii == jj && h == h2) val += p.ssm_d[g * 16 + h];
                v[i] = val;
            }
        } else {
            const int sc = k0 - 512, d = sc >> 7, ri = (sc >> 6) & 1, p0 = sc & 63, e = d == 0 ? ii + 1 : 32 - ii;
#pragma unroll
            for (int i = 0; i < 8; ++i) {
                const int pp = p0 + i; const f32x2 c = Cc[(d * 16 + h) * 64 + pp], l = lamk[(d * 64 + pp) * 33 + e];
                const float clr = c[0] * l[0] - c[1] * l[1], cli = c[0] * l[1] + c[1] * l[0];
                v[i] = ri == 0 ? clr : -cli;
            }
        }
        u32x4 o; o.x = pk2(v[0], v[1]); o.y = pk2(v[2], v[3]); o.z = pk2(v[4], v[5]); o.w = pk2(v[6], v[7]);
        *(u32x4*)(p.Kmat() + ((size_t)(g * 512 + mrow) * SSM_LD + k0)) = o;
    }
    for (int ch = tid; ch < 64 * 64; ch += NT) {
        const int nrow = 64 * qtr + ch / 64, k0 = (ch % 64) * 8, d = nrow >> 7, ri = (nrow >> 6) & 1, pp = nrow & 63;
        const int jj = k0 >> 4, h20 = k0 & 15, e = d == 0 ? 31 - jj : jj;
        const f32x2 l = lamk[(d * 64 + pp) * 33 + e];
        float v[8];
#pragma unroll
        for (int i = 0; i < 8; ++i) { const f32x2 b = Bb[(d * 64 + pp) * 16 + h20 + i]; v[i] = ri == 0 ? (l[0] * b[0] - l[1] * b[1]) : (l[0] * b[1] + l[1] * b[0]); }
        u32x4 o; o.x = pk2(v[0], v[1]); o.y = pk2(v[2], v[3]); o.z = pk2(v[4], v[5]); o.w = pk2(v[6], v[7]);
        *(u32x4*)(p.Win() + ((size_t)(g * 256 + nrow) * 512 + k0)) = o;
    }
    __syncthreads();
}
__device__ __forceinline__ void ph_carry(const P& p) {
    const int tid = threadIdx.x;
    if (tid >= 128) return;
    for (int gidx = blockIdx.x * 128 + tid; gidx < 32 * 8 * 2 * 64; gidx += gridDim.x * 128) {
        const int pp = gidx & 63, d = (gidx >> 6) & 1, b = (gidx >> 7) & 7, g = gidx >> 10;
        const f32x2 lt = *(const f32x2*)(p.lamT() + (size_t)((d * 32 + g) * 64 + pp) * 2);
        const float* Eg = p.E() + (size_t)g * SSM_ROWS * 256 + d * 128 + pp;
        bf16_t* Ug = p.U() + (size_t)g * SSM_ROWS * SSM_LD + 512 + d * 128 + pp;
        float fr = 0.f, fi = 0.f;
#pragma unroll
        for (int cc = 0; cc < 8; ++cc) {
            const int n = 1024 + b * 8 + (d == 0 ? cc : 7 - cc);
            const float er = Eg[(size_t)n * 256], ei = Eg[(size_t)n * 256 + 64];
            const float nr = lt[0] * fr - lt[1] * fi + er, ni = lt[0] * fi + lt[1] * fr + ei; fr = nr; fi = ni;
        }
#pragma unroll 8
        for (int c = 0; c < 128; ++c) {
            const int n = b * 128 + (d == 0 ? c : 127 - c);
            const float er = Eg[(size_t)n * 256], ei = Eg[(size_t)n * 256 + 64];
            Ug[(size_t)n * SSM_LD] = (bf16_t)f2bf(fr); Ug[(size_t)n * SSM_LD + 64] = (bf16_t)f2bf(fi);
            const float nr = lt[0] * fr - lt[1] * fi + er, ni = lt[0] * fi + lt[1] * fr + ei; fr = nr; fi = ni;
        }
    }
}


__device__ __forceinline__ void p0_transpose_item(const float* W, int K, int N, bf16_t* WT, LAS float* scr, int item, int lane) {
    const int nblk = N / 32, kb = item / nblk, nb = item % nblk, k0 = 64 * kb, n0 = 32 * nb;
#pragma unroll 8
    for (int i = 0; i < 32; ++i) { const int kk = 2 * i + (lane >> 5); scr[kk * 33 + (lane & 31)] = W[(size_t)(k0 + kk) * N + n0 + (lane & 31)]; }
    asm volatile("s_waitcnt lgkmcnt(0)" ::: "memory");
    const int c = lane & 7;
#pragma unroll
    for (int j = 0; j < 4; ++j) { const int n = (lane >> 3) + 8 * j; const LAS float* s = scr + (8 * c) * 33 + n;
        u32x4 o; o.x = pk2(s[0 * 33], s[1 * 33]); o.y = pk2(s[2 * 33], s[3 * 33]); o.z = pk2(s[4 * 33], s[5 * 33]); o.w = pk2(s[6 * 33], s[7 * 33]);
        *(u32x4*)(WT + (size_t)(n0 + n) * K + k0 + 8 * c) = o; }
    asm volatile("s_waitcnt lgkmcnt(0)" ::: "memory");
}

template <int NR, bool SILU>
__device__ __forceinline__ void gemv_block64(const float* const (&rows)[NR], const float* W, int ldw, int col0, const float* bias, float* y, int ldy, LAS float* scr) {
    const int wave = threadIdx.x >> 6, lane = threadIdx.x & 63;
    float acc[NR];
#pragma unroll
    for (int r = 0; r < NR; ++r) acc[r] = 0.f;
    const int kb = wave * 128;
#pragma unroll 4
    for (int k = kb; k < kb + 128; ++k) {
        const float w = W[(size_t)k * ldw + col0 + lane];
#pragma unroll
        for (int r = 0; r < NR; ++r) { const float s = rows[r][k]; acc[r] += (SILU ? siluf_(s) : s) * w; }
    }
#pragma unroll
    for (int r = 0; r < NR; ++r) scr[(wave * NR + r) * 64 + lane] = acc[r];
    __syncthreads();
    for (int e = threadIdx.x; e < NR * 64; e += NT) {
        const int r = e >> 6, l = e & 63; float s = 0.f;
#pragma unroll
        for (int w = 0; w < 8; ++w) s += scr[(w * NR + r) * 64 + l];
        y[(size_t)r * ldy + col0 + l] = s + (bias ? bias[col0 + l] : 0.f);
    }
    __syncthreads();
}

__device__ __forceinline__ void ph_prep(const P& p, LAS unsigned char* lds) {
    const int wave = threadIdx.x >> 6, lane = threadIdx.x & 63, G = gridDim.x;
    for (int cb = blockIdx.x; cb < 96; cb += G) {
        const float* const rows[9] = {p.c, p.c + DM, p.c + 2 * DM, p.c + 3 * DM, p.c + 4 * DM, p.c + 5 * DM, p.c + 6 * DM, p.c + 7 * DM, p.c_ctx};
        gemv_block64<9, true>(rows, p.w_mod, 6 * DM, cb * 64, p.b_mod, p.mod(), 6 * DM, (LAS float*)lds);
    }
    for (int it = G - 1 - (int)blockIdx.x; it < 128; it += G) ssm_prep_item(p, lds, it);
    {
        LAS float* scr = (LAS float*)(lds + wave * 16384);
        const int gw = blockIdx.x * NWAVES + wave, NGW = G * NWAVES;
        constexpr int I_IN = (DM / 64) * (INC / 32), I_GLU = (512 / 64) * (512 / 32), I_A = (512 / 64) * (DM / 32), I_OUT = (DM / 64) * (DM / 32), I_Q = (DM / 64) * (2048 / 32);
        constexpr int NITEMS = I_IN + I_GLU + 2 * I_A + I_OUT + I_Q;
        for (int it = gw; it < NITEMS; it += NGW) {
            int r = it;
            if (r < I_IN) { p0_transpose_item(p.w_in, DM, INC, p.w_in_t(), scr, r, lane); continue; } r -= I_IN;
            if (r < I_GLU) { p0_transpose_item(p.w_glu, 512, 512, p.w_glu_t(), scr, r, lane); continue; } r -= I_GLU;
            if (r < I_A) { p0_transpose_item(p.w_a, 512, DM, p.w_a_t(), scr, r, lane); continue; } r -= I_A;
            if (r < I_A) { p0_transpose_item(p.w_b, 512, DM, p.w_b_t(), scr, r, lane); continue; } r -= I_A;
            if (r < I_OUT) { p0_transpose_item(p.w_out, DM, DM, p.w_out_t(), scr, r, lane); continue; } r -= I_OUT;
            p0_transpose_item(p.w_q, DM, 2048, p.w_q_t(), scr, r, lane);
        }
    }
    {
        const int gw = blockIdx.x * NWAVES + wave, NGW = G * NWAVES;
        for (int r = gw; r < 2 * 16384; r += NGW) {
            const bool second = r >= 16384; const int rr = second ? r - 16384 : r;
            const float* src = (second ? p.peer_v : p.peer_u) + (size_t)rr * DM + lane * 16;
            f32x4 v[4]; float am = 0.f;
#pragma unroll
            for (int j = 0; j < 4; ++j) { v[j] = *(const f32x4*)(src + 4 * j); am = fmaxf(am, fmaxf(fmaxf(fabsf(v[j][0]), fabsf(v[j][1])), fmaxf(fabsf(v[j][2]), fabsf(v[j][3])))); }
            am = wave_max(am);
            const float sc = am > 0.f ? 448.f / am : 1.f;
            u32x4 o;
#pragma unroll
            for (int j = 0; j < 4; ++j) { int w = 0; w = __builtin_amdgcn_cvt_pk_fp8_f32(v[j][0] * sc, v[j][1] * sc, w, false); w = __builtin_amdgcn_cvt_pk_fp8_f32(v[j][2] * sc, v[j][3] * sc, w, true); o[j] = (unsigned)w; }
            *(u32x4*)((second ? p.pv8() : p.pu8()) + (size_t)rr * DM + lane * 16) = o;
            if (lane == 0) p.pisc()[r] = am > 0.f ? am * (1.f / 448.f) : 1.f;
        }
    }
}

__device__ __forceinline__ void normmod_row_bf16(const float* src, bf16_t* dst, const float* g, const float* shift, const float* scale, int lane) {
    const f32x4* s = (const f32x4*)src;
    f32x4 v[4]; float ss = 0.f;
#pragma unroll
    for (int j = 0; j < 4; ++j) { v[j] = s[lane + 64 * j]; ss += v[j][0] * v[j][0] + v[j][1] * v[j][1] + v[j][2] * v[j][2] + v[j][3] * v[j][3]; }
    ss = wave_sum(ss);
    const float rstd = rsqrtf(ss * (1.f / DM) + EPSN);
#pragma unroll
    for (int j = 0; j < 4; ++j) {
        const int i4 = lane + 64 * j;
        const f32x4 gg = ((const f32x4*)g)[i4], sh = ((const f32x4*)shift)[i4], sc = ((const f32x4*)scale)[i4];
        const f32x4 o = v[j] * rstd * gg * (sc + 1.f) + sh;
        u32x2 w; w.x = pk2(o[0], o[1]); w.y = pk2(o[2], o[3]);
        *(u32x2*)(dst + (size_t)i4 * 4) = w;
    }
}
__device__ __forceinline__ void ph_norm1(const P& p, LAS unsigned char* lds) {
    const int wave = threadIdx.x >> 6, lane = threadIdx.x & 63, G = gridDim.x;
    for (int cb = blockIdx.x; cb < 32; cb += G) {
        const float* m3 = p.mod() + 3 * DM;
        const float* const rows[8] = {m3, m3 + 6 * DM, m3 + 12 * DM, m3 + 18 * DM, m3 + 24 * DM, m3 + 30 * DM, m3 + 36 * DM, m3 + 42 * DM};
        gemv_block64<8, false>(rows, p.w_q, 2048, cb * 64, nullptr, p.c2(), 2048, (LAS float*)lds);
    }
    for (int r = blockIdx.x * NWAVES + wave; r < NTOK + NCTX; r += G * NWAVES) {
        if (r < NTOK) { const float* modb = p.mod() + (size_t)(r >> 12) * (6 * DM); normmod_row_bf16(p.x + (size_t)r * DM, p.hx() + (size_t)r * DM, p.norm1_g, modb, modb + DM, lane); }
        else { const int rc = r - NTOK; const float* modc = p.mod() + 8 * (6 * DM); normmod_row_bf16(p.ctx + (size_t)rc * DM, p.hc() + (size_t)rc * DM, p.norm1_g, modc, modc + DM, lane); }
    }
}

typedef short s16x4 __attribute__((ext_vector_type(4)));
__device__ __forceinline__ void ph_na(const P& p, LAS unsigned char* lds) {
    const int tid = threadIdx.x, h = tid >> 6, lane = tid & 63, lt = lane & 15, lq = lane >> 4;
    LAS float* rp = (LAS float*)lds;
    for (int e = tid; e < 8 * 15 * 31; e += NT) rp[e] = p.rpb[e];
    __syncthreads();
    for (int item = blockIdx.x; item < NB * GW; item += gridDim.x) {
        const int b = item >> 6, r = item & 63;
        int r0 = r - 4; r0 = r0 < 0 ? 0 : (r0 > 56 ? 56 : r0);
        const bf16_t* Kb = p.kb() + (size_t)b * SEQL * 512 + h * 64 + lq * 8;
        const bf16_t* Kc = p.kc() + (size_t)b * CTXL * 512 + h * 64 + lq * 8;
        const bf16_t* Vt = p.vT() + (size_t)((b * 8 + h) * 64 + lt) * SEQL + lq * 4;
        const bf16_t* Vc = p.vcT() + (size_t)((b * 8 + h) * 64 + lt) * CTXL + lq * 4;
#pragma unroll 1
        for (int cqi = 0; cqi < 4; ++cqi) {
            const int cq = cqi * 16;
            int cw = cq - 8; cw = cw < 0 ? 0 : (cw > 32 ? 32 : cw);
            const int qc = cq + lt;
            int c0 = qc - 8; c0 = c0 < 0 ? 0 : (c0 > 48 ? 48 : c0);
            const size_t tq = (size_t)b * SEQL + r * GW + qc;
            bf16x8 qf[2];
            qf[0] = *(const bf16x8*)(p.qb() + tq * 512 + h * 64 + lq * 8); qf[1] = *(const bf16x8*)(p.qb() + tq * 512 + h * 64 + 32 + lq * 8);
            f32x4 o[4];
#pragma unroll
            for (int d = 0; d < 4; ++d) o[d] = (f32x4){0.f, 0.f, 0.f, 0.f};
            float m = -1e30f, l = 0.f;
#pragma unroll 1
            for (int chunk = 0; chunk < 4; ++chunk) {
                f32x4 s[8];
#pragma unroll
                for (int blk = 0; blk < 8; ++blk) {
                    const bf16_t* kp;
                    if (chunk < 2) kp = Kb + (size_t)((r0 + chunk * 4 + (blk >> 1)) * GW + cw + (blk & 1) * 16 + lt) * 512;
                    else kp = Kc + (size_t)((chunk - 2) * 128 + blk * 16 + lt) * 512;
                    const bf16x8 k0 = *(const bf16x8*)kp, k1 = *(const bf16x8*)(kp + 32);
                    f32x4 c = {0.f, 0.f, 0.f, 0.f};
                    c = __builtin_amdgcn_mfma_f32_16x16x32_bf16(k0, qf[0], c, 0, 0, 0);
                    c = __builtin_amdgcn_mfma_f32_16x16x32_bf16(k1, qf[1], c, 0, 0, 0);
                    s[blk] = c;
                }
                float mx = -1e30f;
#pragma unroll
                for (int blk = 0; blk < 8; ++blk)
#pragma unroll
                    for (int rr = 0; rr < 4; ++rr) {
                        float t = s[blk][rr] * 0.125f;
                        if (chunk < 2) {
                            const int i = chunk * 4 + (blk >> 1), kc = cw + (blk & 1) * 16 + lq * 4 + rr;
                            const bool valid = kc >= c0 && kc < c0 + 16;
                            const int idx = valid ? ((h * 15 + (r0 + i - r + 7)) * 31 + (kc - qc + 15)) : 0;
                            t = valid ? t + rp[idx] : -1e30f;
                        }
                        s[blk][rr] = t; mx = fmaxf(mx, t);
                    }
                mx = fmaxf(mx, __shfl_xor(mx, 16)); mx = fmaxf(mx, __shfl_xor(mx, 32));
                const float mn = fmaxf(m, mx), corr = __expf(m - mn);
                m = mn; l *= corr;
#pragma unroll
                for (int d = 0; d < 4; ++d) o[d] = o[d] * corr;
#pragma unroll
                for (int st = 0; st < 4; ++st) {
                    float pe[8];
#pragma unroll
                    for (int rr = 0; rr < 4; ++rr) { pe[rr] = __expf(s[2 * st][rr] - mn); pe[4 + rr] = __expf(s[2 * st + 1][rr] - mn); }
#pragma unroll
                    for (int i = 0; i < 8; ++i) l += pe[i];
                    u32x4 pw; pw.x = pk2(pe[0], pe[1]); pw.y = pk2(pe[2], pe[3]); pw.z = pk2(pe[4], pe[5]); pw.w = pk2(pe[6], pe[7]);
                    const bf16x8 pf = __builtin_bit_cast(bf16x8, pw);
                    const bf16_t* vp;
                    if (chunk < 2) vp = Vt + (size_t)((r0 + chunk * 4 + st) * GW + cw);
                    else vp = Vc + (size_t)((chunk - 2) * 128 + st * 32);
                    const size_t dstr = chunk < 2 ? (size_t)16 * SEQL : (size_t)16 * CTXL;
#pragma unroll
                    for (int d = 0; d < 4; ++d) {
                        const u32x2 va = *(const u32x2*)(vp + d * dstr), vb = *(const u32x2*)(vp + d * dstr + 16);
                        u32x4 vw; vw.x = va.x; vw.y = va.y; vw.z = vb.x; vw.w = vb.y;
                        o[d] = __builtin_amdgcn_mfma_f32_16x16x32_bf16(__builtin_bit_cast(bf16x8, vw), pf, o[d], 0, 0, 0);
                    }
                }
            }
            l += __shfl_xor(l, 16); l += __shfl_xor(l, 32);
            const float inv = 1.f / l;
            bf16_t* op = p.na() + tq * 512 + h * 64 + lq * 4;
#pragma unroll
            for (int d = 0; d < 4; ++d) { u32x2 w; w.x = pk2(o[d][0] * inv, o[d][1] * inv); w.y = pk2(o[d][2] * inv, o[d][3] * inv); *(u32x2*)(op + d * 16) = w; }
        }
    }
}

typedef __bf16 bf16x2_t __attribute__((ext_vector_type(2)));
__device__ __forceinline__ float dot2bf(unsigned a, unsigned b, float c) { return __builtin_amdgcn_fdot2_f32_bf16(__builtin_bit_cast(bf16x2_t, a), __builtin_bit_cast(bf16x2_t, b), c, false); }
__device__ __forceinline__ unsigned ordkey(float f) { unsigned u = __builtin_bit_cast(unsigned, f); return u ^ ((unsigned)((int)u >> 31) | 0x80000000u); }
__device__ __forceinline__ float unordkey(unsigned k) { return __builtin_bit_cast(float, k ^ ((k & 0x80000000u) ? 0x80000000u : 0xFFFFFFFFu)); }
template <bool DESC> __device__ __forceinline__ void cex(unsigned& a, unsigned& b) { const unsigned mx = a > b ? a : b, mn = a > b ? b : a; if (DESC) { a = mx; b = mn; } else { a = mn; b = mx; } }
__device__ __forceinline__ void sort16_desc(unsigned (&a)[16]) {
#pragma unroll
    for (int k = 2; k <= 16; k <<= 1)
#pragma unroll
        for (int j = k >> 1; j > 0; j >>= 1)
#pragma unroll
            for (int i = 0; i < 16; ++i) { const int l = i ^ j; if (l > i) { if ((i & k) == 0) cex<true>(a[i], a[l]); else cex<false>(a[i], a[l]); } }
}
__device__ __forceinline__ void merge16_desc(unsigned (&a)[16]) {
#pragma unroll
    for (int j = 8; j > 0; j >>= 1)
#pragma unroll
        for (int i = 0; i < 16; ++i) { const int l = i ^ j; if (l > i) cex<true>(a[i], a[l]); }
}
__device__ __forceinline__ void top16_merge(unsigned (&a)[16], const unsigned (&b)[16]) {
#pragma unroll
    for (int i = 0; i < 16; ++i) a[i] = a[i] > b[15 - i] ? a[i] : b[15 - i];
    merge16_desc(a);
}
struct PairTab { int i[52], j[52], n; };
constexpr PairTab make_pairs() { PairTab t{}; int n = 0; for (int i = 0; i < 16; ++i) for (int j = 0; j < 16; ++j) if ((i + 1) * (j + 1) <= 16) { t.i[n] = i; t.j[n] = j; ++n; } t.n = n; for (int k = n; k < 52; ++k) { t.i[k] = 0; t.j[k] = 0; } return t; }
constexpr PairTab PAIRS = make_pairs();
static_assert(PAIRS.n == 50, "50 candidate pairs");

constexpr int SK_LD = 136;
__device__ __forceinline__ void ph_peer_topk(const P& p, LAS unsigned char* lds) {
    const int tid = threadIdx.x, wave = tid >> 6, lane = tid & 63;
    LAS bf16_t* sk = (LAS bf16_t*)lds;
    for (int e = tid; e < 2 * 128 * 16; e += NT) {
        const int row = e >> 4, c8 = (e & 15) * 8;
        const f32x4 a = *(const f32x4*)(p.subkeys + (size_t)row * 128 + c8), b = *(const f32x4*)(p.subkeys + (size_t)row * 128 + c8 + 4);
        u32x4 o; o.x = pk2(a[0], a[1]); o.y = pk2(a[2], a[3]); o.z = pk2(b[0], b[1]); o.w = pk2(b[2], b[3]);
        *(LAS u32x4*)(sk + row * SK_LD + c8) = o;
    }
    __syncthreads();
    const int lt = lane & 15, lq = lane >> 4;
    for (int tile = blockIdx.x * NWAVES + wave; tile < NTOK / 16; tile += gridDim.x * NWAVES) {
        const int tok = tile * 16 + lt;
        const bf16_t* qrow = p.qp() + (size_t)tok * 2048;
        for (int h = 0; h < 8; ++h) {
            unsigned s0[16], s1[16];
#pragma unroll
            for (int n = 0; n < 2; ++n) {
                bf16x8 bq[4];
#pragma unroll
                for (int ks = 0; ks < 4; ++ks) bq[ks] = *(const bf16x8*)(qrow + h * 256 + n * 128 + ks * 32 + lq * 8);
                unsigned a[16], b[16];
#pragma unroll
                for (int kb = 0; kb < 8; ++kb) {
                    f32x4 c = {0.f, 0.f, 0.f, 0.f};
#pragma unroll
                    for (int ks = 0; ks < 4; ++ks) {
                        const bf16x8 ak = *(const LAS bf16x8*)(sk + (n * 128 + kb * 16 + lt) * SK_LD + ks * 32 + lq * 8);
                        c = __builtin_amdgcn_mfma_f32_16x16x32_bf16(ak, bq[ks], c, 0, 0, 0);
                    }
#pragma unroll
                    for (int r = 0; r < 4; ++r) {
                        const unsigned key = (ordkey(c[r]) & ~127u) | (unsigned)(kb * 16 + lq * 4 + r);
                        if (kb < 4) a[kb * 4 + r] = key; else b[(kb - 4) * 4 + r] = key;
                    }
                    asm volatile("" ::: "memory");
                }
                sort16_desc(a); sort16_desc(b);
                top16_merge(a, b);
#pragma unroll
                for (int i = 0; i < 16; ++i) b[i] = __shfl_xor(a[i], 16);
                top16_merge(a, b);
#pragma unroll
                for (int i = 0; i < 16; ++i) b[i] = __shfl_xor(a[i], 32);
                top16_merge(a, b);
                if (n == 0) {
#pragma unroll
                    for (int i = 0; i < 16; ++i) s0[i] = a[i];
                } else {
#pragma unroll
                    for (int i = 0; i < 16; ++i) s1[i] = a[i];
                }
            }
            unsigned ck[16], ce_[13]; float cs[13];
#pragma unroll
            for (int s = 0; s < 13; ++s) {
                const unsigned k0 = lq == 0 ? s0[PAIRS.i[s * 4]] : (lq == 1 ? s0[PAIRS.i[s * 4 + 1]] : (lq == 2 ? s0[PAIRS.i[s * 4 + 2]] : s0[PAIRS.i[s * 4 + 3]]));
                const unsigned k1 = lq == 0 ? s1[PAIRS.j[s * 4]] : (lq == 1 ? s1[PAIRS.j[s * 4 + 1]] : (lq == 2 ? s1[PAIRS.j[s * 4 + 2]] : s1[PAIRS.j[s * 4 + 3]]));
                const float sum = unordkey(k0 & ~127u) + unordkey(k1 & ~127u);
                const bool valid = (s * 4 + lq) < PAIRS.n;
                cs[s] = sum; ce_[s] = (k0 & 127u) * 128u + (k1 & 127u);
                ck[s] = valid ? ((ordkey(sum) & ~63u) | (unsigned)(s * 4 + lq)) : 0u;
            }
            ck[13] = 0u; ck[14] = 0u; ck[15] = 0u;
            unsigned srt[16], ob[16];
#pragma unroll
            for (int i = 0; i < 16; ++i) srt[i] = ck[i];
            sort16_desc(srt);
#pragma unroll
            for (int i = 0; i < 16; ++i) ob[i] = __shfl_xor(srt[i], 16);
            top16_merge(srt, ob);
#pragma unroll
            for (int i = 0; i < 16; ++i) ob[i] = __shfl_xor(srt[i], 32);
            unsigned thr = 0xFFFFFFFFu;
#pragma unroll
            for (int i = 0; i < 16; ++i) { const unsigned v = srt[i] > ob[15 - i] ? srt[i] : ob[15 - i]; thr = v < thr ? v : thr; }
            const float mtop = unordkey(s0[0] & ~127u) + unordkey(s1[0] & ~127u);
            float zp = 0.f; int cnt = 0;
#pragma unroll
            for (int s = 0; s < 13; ++s) { const bool sel = ck[s] >= thr && ck[s] != 0u; const float e = sel ? __expf(cs[s] - mtop) : 0.f; cs[s] = e; zp += e; cnt += sel ? 1 : 0; }
            float z = zp; z += __shfl_xor(z, 16); z += __shfl_xor(z, 32);
            const float rz = 1.f / z;
            const int c0 = __shfl(cnt, lt), c1 = __shfl(cnt, lt + 16), c2 = __shfl(cnt, lt + 32);
            int pos = lq == 0 ? 0 : (lq == 1 ? c0 : (lq == 2 ? c0 + c1 : c0 + c1 + c2));
            u32x2* dst = (u32x2*)p.topk() + ((size_t)tok * 8 + h) * 16;
#pragma unroll
            for (int s = 0; s < 13; ++s) {
                const bool sel = ck[s] >= thr && ck[s] != 0u;
                if (sel) { u32x2 o; o.x = ce_[s]; o.y = __builtin_bit_cast(unsigned, cs[s] * rz); dst[pos] = o; ++pos; }
            }
        }
    }
}

__device__ __forceinline__ void ph_peer_gather(const P& p) {
    const int wave = __builtin_amdgcn_readfirstlane(threadIdx.x >> 6), lane = threadIdx.x & 63;
    const float* isc = p.pisc();
    for (int tok = blockIdx.x * NWAVES + wave; tok < NTOK; tok += gridDim.x * NWAVES) {
        const int b = tok >> 12;
        const float* modb = p.mod() + (size_t)b * (6 * DM);
        float acc[16], hv[16];
        const float rstd2 = rsqrtf(p.rowss()[tok] * (1.f / DM) + EPSN);
#pragma unroll
        for (int j = 0; j < 4; ++j) {
            const int e0 = lane * 16 + j * 4;
            const f32x4 xv = *(const f32x4*)(p.out + (size_t)tok * DM + e0), gg = *(const f32x4*)(p.norm2_g + e0), sh = *(const f32x4*)(modb + 3 * DM + e0), sc = *(const f32x4*)(modb + 4 * DM + e0);
            const f32x4 h4 = xv * rstd2 * gg * (sc + 1.f) + sh;
#pragma unroll
            for (int i = 0; i < 4; ++i) { hv[j * 4 + i] = h4[i]; acc[j * 4 + i] = 0.f; }
        }
        const u32x2* tk = (const u32x2*)p.topk() + (size_t)tok * 128;
        const u32x2 ent0 = tk[lane], ent1 = tk[lane + 64];
        const unsigned e0x = ent0[0], e0y = ent0[1], e1x = ent1[0], e1y = ent1[1];
        const float isu0 = isc[e0x], isu1 = isc[e1x];
        const float gsv0 = __builtin_bit_cast(float, e0y) * isc[16384 + e0x], gsv1 = __builtin_bit_cast(float, e1y) * isc[16384 + e1x];
#pragma unroll 1
        for (int k0 = 0; k0 < 128; k0 += 8) {
            u32x4 uu[8], vv[8];
            const unsigned ex = k0 < 64 ? e0x : e1x, gxs = __builtin_bit_cast(unsigned, k0 < 64 ? gsv0 : gsv1), sxs = __builtin_bit_cast(unsigned, k0 < 64 ? isu0 : isu1);
#pragma unroll
            for (int i = 0; i < 8; ++i) {
                const unsigned e = __builtin_amdgcn_readlane(ex, (k0 + i) & 63);
                uu[i] = *(const u32x4*)(p.pu8() + (size_t)e * DM + lane * 16);
                vv[i] = *(const u32x4*)(p.pv8() + (size_t)e * DM + lane * 16);
            }
            float pd[8];
#pragma unroll
            for (int i = 0; i < 8; ++i) {
                float d = 0.f;
#pragma unroll
                for (int j = 0; j < 4; ++j) {
                    const int w = (int)uu[i][j];
                    const f32x2 lo = __builtin_amdgcn_cvt_pk_f32_fp8(w, false), hi = __builtin_amdgcn_cvt_pk_f32_fp8(w, true);
                    d += lo[0] * hv[j * 4] + lo[1] * hv[j * 4 + 1] + hi[0] * hv[j * 4 + 2] + hi[1] * hv[j * 4 + 3];
                }
                pd[i] = d;
            }
            float r4[4], r2[2], r1;
            { const bool hi = lane & 32;
#pragma unroll
              for (int i = 0; i < 4; ++i) { const float keep = hi ? pd[i + 4] : pd[i], send = hi ? pd[i] : pd[i + 4]; r4[i] = keep + __shfl_xor(send, 32); } }
            { const bool hi = lane & 16;
#pragma unroll
              for (int i = 0; i < 2; ++i) { const float keep = hi ? r4[i + 2] : r4[i], send = hi ? r4[i] : r4[i + 2]; r2[i] = keep + __shfl_xor(send, 16); } }
            { const bool hi = lane & 8; const float keep = hi ? r2[1] : r2[0], send = hi ? r2[0] : r2[1]; r1 = keep + __shfl_xor(send, 8); }
            r1 += __shfl_xor(r1, 4); r1 += __shfl_xor(r1, 2); r1 += __shfl_xor(r1, 1);
#pragma unroll
            for (int i = 0; i < 8; ++i) {
                const float sui = __builtin_bit_cast(float, __builtin_amdgcn_readlane(sxs, (k0 + i) & 63)), gki = __builtin_bit_cast(float, __builtin_amdgcn_readlane(gxs, (k0 + i) & 63));
                const float a = sui * __builtin_bit_cast(float, __builtin_amdgcn_readlane(__builtin_bit_cast(unsigned, r1), ((i >> 2) & 1) * 32 + ((i >> 1) & 1) * 16 + (i & 1) * 8));
                const float w = gki * gelu_tanh(a);
#pragma unroll
                for (int j = 0; j < 4; ++j) {
                    const int wv = (int)vv[i][j];
                    const f32x2 lo = __builtin_amdgcn_cvt_pk_f32_fp8(wv, false), hi = __builtin_amdgcn_cvt_pk_f32_fp8(wv, true);
                    acc[j * 4] += w * lo[0]; acc[j * 4 + 1] += w * lo[1]; acc[j * 4 + 2] += w * hi[0]; acc[j * 4 + 3] += w * hi[1];
                }
            }
        }
        float ss = 0.f; float x2[16];
#pragma unroll
        for (int j = 0; j < 4; ++j) {
            const int e0 = lane * 16 + j * 4;
            const f32x4 g2 = *(const f32x4*)(modb + 5 * DM + e0), xv = *(const f32x4*)(p.out + (size_t)tok * DM + e0);
#pragma unroll
            for (int i = 0; i < 4; ++i) { const int ix = j * 4 + i; x2[ix] = xv[i] + g2[i] * acc[ix]; ss += x2[ix] * x2[ix]; }
        }
        ss = wave_sum(ss);
        const float rstd = rsqrtf(ss * (1.f / DM) + EPSN);
#pragma unroll
        for (int j = 0; j < 4; ++j) {
            const int e0 = lane * 16 + j * 4;
            const f32x4 fg = *(const f32x4*)(p.final_g + e0);
            f32x4 o;
#pragma unroll
            for (int i = 0; i < 4; ++i) o[i] = x2[j * 4 + i] * rstd * fg[i];
            *(f32x4*)(p.out + (size_t)tok * DM + e0) = o;
        }
    }
}

#define XB_TMO      128
#define XB_XCNT(j)  (256  + 64 * (j))
#define XB_XSUB(j)  (1280 + 64 * (j))
#define XB_XGEN(j)  (2304 + 64 * (j))
#define XB_TOP      3328
#define XB_TOPGEN   3392
#define XCD_BAR_WORDS 3456
#define XB_SPIN_CAP (1u << 18)
__device__ __forceinline__ unsigned xb_ld(unsigned* p)              { return __hip_atomic_load(p, __ATOMIC_RELAXED, __HIP_MEMORY_SCOPE_AGENT); }
__device__ __forceinline__ unsigned xb_add(unsigned* p, unsigned v) { return __hip_atomic_fetch_add(p, v, __ATOMIC_RELAXED, __HIP_MEMORY_SCOPE_AGENT); }
__device__ __forceinline__ unsigned xb_xcc_id() { return (unsigned)__builtin_amdgcn_s_getreg((3 << 11) | 20) & 0xFu; }
#define XB_SPIN(cond, bar) do { unsigned _sp = 0; while (cond) { __builtin_amdgcn_s_sleep(1); \
    if ((++_sp & 255u) == 0u) { if (xb_ld(&(bar)[XB_TMO])) break; if (_sp > XB_SPIN_CAP) { atomicAdd(&(bar)[XB_TMO], 1u); break; } } } } while (0)
struct XcdBarrier { unsigned* bar; unsigned x; volatile LAS unsigned* st; };
__device__ __forceinline__ XcdBarrier xcd_barrier_post(unsigned* bar, volatile LAS unsigned* st) {
    XcdBarrier b; b.bar = bar; b.x = xb_xcc_id(); b.st = st;
    if (threadIdx.x == 0) (void)xb_add(&bar[XB_XCNT(b.x)], 1u);
    return b;
}
__device__ __forceinline__ void xcd_barrier_complete(unsigned* bar, unsigned x, unsigned& nloc, unsigned& nx) {
    const unsigned G = gridDim.x * gridDim.y * gridDim.z;
    unsigned sum, cnt, mine, sp = 0u;
    for (;;) {
        sum = 0u; cnt = 0u; mine = 0u;
#pragma unroll
        for (unsigned j = 0; j < 16; ++j) { const unsigned c = xb_ld(&bar[XB_XCNT(j)]); sum += c; cnt += (c > 0u) ? 1u : 0u; mine = (j == x) ? c : mine; }
        if (sum == G) break;
        __builtin_amdgcn_s_sleep(1);
        if ((++sp & 255u) == 0u) { if (xb_ld(&bar[XB_TMO])) break; if (sp > XB_SPIN_CAP) { atomicAdd(&bar[XB_TMO], 1u); break; } }
    }
    nloc = mine > 0u ? mine : 1u; nx = cnt > 0u ? cnt : 1u;
}
__device__ __forceinline__ void xcd_barrier(const XcdBarrier& b) {
    asm volatile("s_waitcnt vmcnt(0)" ::: "memory");
    __syncthreads();
    if (threadIdx.x == 0) {
        unsigned* bar = b.bar;
        __builtin_amdgcn_s_waitcnt(0);
        unsigned nloc = b.st[0], nx = b.st[1];
        if (nloc == 0u) { xcd_barrier_complete(bar, b.x, nloc, nx); b.st[0] = nloc; b.st[1] = nx; }
        const unsigned old = xb_add(&bar[XB_XSUB(b.x)], 1u);
        const unsigned gen = old / nloc;
        if (old + 1u == (gen + 1u) * nloc) {
            __builtin_amdgcn_fence(__ATOMIC_RELEASE, "agent");
            asm volatile("s_waitcnt vmcnt(0)" ::: "memory");
            const unsigned og = xb_add(&bar[XB_TOP], 1u);
            const unsigned tg = og / nx;
            if (og + 1u == (tg + 1u) * nx) xb_add(&bar[XB_TOPGEN], 1u);
            else XB_SPIN(xb_ld(&bar[XB_TOPGEN]) == tg, bar);
            __builtin_amdgcn_fence(__ATOMIC_ACQUIRE, "agent");
            xb_add(&bar[XB_XGEN(b.x)], 1u);
            asm volatile("s_waitcnt vmcnt(0)" ::: "memory");
        } else {
            XB_SPIN(xb_ld(&bar[XB_XGEN(b.x)]) == gen, bar);
            __builtin_amdgcn_fence(__ATOMIC_ACQUIRE, "agent");
            asm volatile("s_waitcnt vmcnt(0)" ::: "memory");
        }
    }
    __syncthreads();
}

constexpr int LDS_BYTES = 147456;
#define GSYNC() xcd_barrier(xbar)
constexpr int MISC_OFF = LDS_BYTES - 64;

__global__ void __launch_bounds__(NT, 2) mega(P p) {
    extern __shared__ __attribute__((aligned(16))) unsigned char lds_raw[];
    LAS unsigned char* lds = (LAS unsigned char*)lds_raw;
    const int G = gridDim.x, bx = blockIdx.x;
    using namespace pg8;
    if (threadIdx.x < 16) ((LAS unsigned*)(lds + MISC_OFF))[threadIdx.x] = 0u;
    __syncthreads();
    const XcdBarrier xbar = xcd_barrier_post((unsigned*)p.ws, (volatile LAS unsigned*)(lds + MISC_OFF));

    ph_prep(p, lds);
    cg::this_grid().sync();
    ph_norm1(p, lds);
    GSYNC();
    {
        Gemm<DM, DM, DM> g{p.hx(), p.w_in_t()}; StaticOrder<NTOK, INC> S; S.init(G, bx);
        EpiInProj E{p.U(), p.kb(), (size_t)(p.qb() - p.kb()), p.vT(), p.ga(), 0};
        gemm_phase<EpiInProj, StaticOrder<NTOK, INC>, true, true>(lds, g, S, E);
        Gemm<DM, DM, DM> g2{p.hc(), p.w_in_t()}; StaticOrder<NCTX, CTXC> S2; S2.init(G, bx);
        EpiInProj E2{p.U(), p.kc(), 0, p.vcT(), p.ga(), 1};
        gemm_phase<EpiInProj, StaticOrder<NCTX, CTXC>, true, true>(lds, g2, S2, E2);
    }
    GSYNC();
    {
        Gemm<512, SSM_LD, 512, (long)SSM_ROWS * SSM_LD, 256L * 512> g{p.U(), p.Win()}; StaticOrder<SSM_ROWS, 256, 32> S; S.init(G, bx);
        EpiE E{p.E()};
        gemm_phase<EpiE, StaticOrder<SSM_ROWS, 256, 32>, true, true>(lds, g, S, E);
    }
    GSYNC();
    ph_carry(p);
    ph_na(p, lds);
    GSYNC();
    {
        Gemm<SSM_LD, SSM_LD, SSM_LD, (long)SSM_ROWS * SSM_LD, 512L * SSM_LD> g{p.U(), p.Kmat()}; StaticOrder<1024, 512, 32> S; S.init(G, bx);
        EpiZ E{p.z()};
        gemm_phase<EpiZ, StaticOrder<1024, 512, 32>, true, true>(lds, g, S, E);
    }
    GSYNC();
    {
        Gemm<512, 512, 512> g{p.z(), p.w_glu_t()}; StaticOrder<NTOK, 512> S; S.init(G, bx);
        EpiGlu E{p.gl(), p.z(), p.b_glu};
        gemm_phase<EpiGlu, StaticOrder<NTOK, 512>, true, true>(lds, g, S, E);
    }
    GSYNC();
    {
        Gemm<512, 512, 512> g{p.gl(), p.w_a_t()}; StaticOrder<NTOK, DM> S; S.init(G, bx);
        EpiBrA E{p.tbuf(), p.ga()};
        gemm_phase<EpiBrA, StaticOrder<NTOK, DM>, true, true>(lds, g, S, E);
        Gemm<512, 512, 512> g2{p.na(), p.w_b_t()};
        EpiBrB E2{p.merged(), p.tbuf(), p.gb()};
        gemm_phase<EpiBrB, StaticOrder<NTOK, DM>, true, true>(lds, g2, S, E2);
    }
    GSYNC();
    {
        Gemm<DM, DM, DM> g{p.merged(), p.w_out_t()}; StaticOrder<NTOK, DM> S; S.init(G, bx);
        EpiOut E{p.x, p.out, p.x1g(), p.mod(), p.norm2_g, p.rowss()};
        gemm_phase<EpiOut, StaticOrder<NTOK, DM>, true, true>(lds, g, S, E);
    }
    GSYNC();
    {
        Gemm<DM, DM, DM> g{p.x1g(), p.w_q_t()}; StaticOrder<NTOK, 2048> S; S.init(G, bx);
        EpiQ E{p.qp(), p.rowss(), p.c2()};
        gemm_phase<EpiQ, StaticOrder<NTOK, 2048>, true, true>(lds, g, S, E);
    }
    GSYNC();
    ph_peer_topk(p, lds);
    GSYNC();
    ph_peer_gather(p);
}

extern "C" void kernel_launch(void* const* d_in, const int* in_sizes, int n_in, void* d_out, int out_size, void* d_ws, size_t ws_size, hipStream_t stream) {
    static int grid = 0;
    if (grid == 0) {
        int dev = 0, cus = 0, per_cu = 0;
        (void)hipGetDevice(&dev);
        (void)hipDeviceGetAttribute(&cus, hipDeviceAttributeMultiprocessorCount, dev);
        (void)hipFuncSetAttribute((const void*)mega, hipFuncAttributeMaxDynamicSharedMemorySize, LDS_BYTES);
        (void)hipOccupancyMaxActiveBlocksPerMultiprocessor(&per_cu, (const void*)mega, NT, LDS_BYTES);
        if (per_cu < 1) { fprintf(stderr, "occupancy query says %d blocks per CU\n", per_cu); per_cu = 1; }
        grid = cus;
    }
    P p{};
    const float* const* in = (const float* const*)d_in;
    p.x = in[0]; p.c = in[1]; p.ctx = in[2]; p.c_ctx = in[3]; p.w_mod = in[4]; p.b_mod = in[5]; p.norm1_g = in[6]; p.norm2_g = in[7]; p.w_in = in[8];
    p.a_re = in[9]; p.a_im = in[10]; p.log_dt = in[11]; p.b_re = in[12]; p.b_im = in[13]; p.c_re = in[14]; p.c_im = in[15]; p.ssm_d = in[16];
    p.w_glu = in[17]; p.b_glu = in[18]; p.w_a = in[19]; p.w_b = in[20]; p.rpb = in[21]; p.w_out = in[22]; p.w_q = in[23]; p.subkeys = in[24];
    p.peer_u = in[25]; p.peer_v = in[26]; p.final_g = in[27];
    p.out = (float*)d_out;
    p.ws = (unsigned char*)d_ws;
    (void)hipMemsetAsync(d_ws, 0, 1 * MiB, stream);
    void* args[] = {&p};
    hipError_t e = hipLaunchCooperativeKernel((const void*)mega, dim3(grid), dim3(NT), args, LDS_BYTES, stream);
    if (e != hipSuccess) fprintf(stderr, "cooperative launch failed: %s (grid %d)\n", hipGetErrorString(e), grid);
}
```

```cpp
#include <hip/hip_runtime.h>
#include <hip/hip_cooperative_groups.h>
#include <cstdio>
#include <cstdint>
namespace cg = cooperative_groups;

#define LAS __attribute__((address_space(3)))
typedef unsigned short bf16_t;
typedef short bf16x8 __attribute__((ext_vector_type(8)));
typedef float f32x4 __attribute__((ext_vector_type(4)));
typedef float f32x2 __attribute__((ext_vector_type(2)));
typedef unsigned u32x4 __attribute__((ext_vector_type(4)));
typedef unsigned u32x2 __attribute__((ext_vector_type(2)));

constexpr int DM = 1024, NB = 8, SEQL = 4096, CTXL = 256, GW = 64, NTOK = NB * SEQL, NCTX = NB * CTXL;
constexpr int INC = 4096, CTXC = 1536;
constexpr int NT = 512, NWAVES = 8;
constexpr float EPSN = 1e-6f;
constexpr int SSM_ROWS = 1280;
constexpr int SSM_LD = 768;

__device__ __forceinline__ unsigned f2bf(float f) { unsigned u = __builtin_bit_cast(unsigned, f); return (u + 0x7fffu + ((u >> 16) & 1u)) >> 16; }
__device__ __forceinline__ unsigned pk2(float lo, float hi) { return f2bf(lo) | (f2bf(hi) << 16); }
__device__ __forceinline__ float bflo(unsigned w) { return __builtin_bit_cast(float, w << 16); }
__device__ __forceinline__ float bfhi(unsigned w) { return __builtin_bit_cast(float, w & 0xffff0000u); }
__device__ __forceinline__ float bf2f(bf16_t h) { return __builtin_bit_cast(float, (unsigned)h << 16); }

__device__ __forceinline__ float wave_sum(float v) {
#pragma unroll
    for (int o = 1; o < 64; o <<= 1) v += __shfl_xor(v, o);
    return v;
}
__device__ __forceinline__ float wave_max(float v) {
#pragma unroll
    for (int o = 1; o < 64; o <<= 1) v = fmaxf(v, __shfl_xor(v, o));
    return v;
}
__device__ __forceinline__ float sigmoidf_(float x) { return 1.f / (1.f + __expf(-x)); }
__device__ __forceinline__ float siluf_(float x) { return x / (1.f + __expf(-x)); }
__device__ __forceinline__ float gelu_tanh(float x) {
    const float k0 = 0.7978845608028654f, k1 = 0.044715f;
    const float u = k0 * (x + k1 * x * x * x);
    const float t = 1.f - 2.f / (1.f + __expf(2.f * u));
    return 0.5f * x * (1.f + t);
}

namespace pg8 {
#define PG8_LAS __attribute__((address_space(3)))
constexpr int BM = 256, BK = 64, HALF = 128, HTB = HALF * BK * 2  , STAGE_BYTES = 8 * HTB, NXCD = 8, WGM = 8;
__host__ __device__ __forceinline__ int lds_byte(int r, int c) { const int st = (r >> 4) * 2 + (c >> 5), rr = r & 15, cc = c & 31, ob = rr * 64 + cc * 2; return st * 1024 + (ob ^ (((ob >> 9) & 1) << 5)); }
__host__ __device__ __forceinline__ void stage_rc(int b, int& R, int& C) { const int st = b / 1024, sb = b % 1024, swz = sb ^ (((sb >> 9) & 1) << 5); R = (st >> 1) * 16 + swz / 64; C = (st & 1) * 32 + (swz % 64) / 2; }
__host__ __device__ __forceinline__ int perm32(int rho) { const int n = rho >> 4, i = rho & 15; return 8 * (i >> 2) + 4 * n + (i & 3); }

struct Unit { int pm, pn, g; };
template <int K_, int LDA, int LDB, long GSA = 0, long GSB = 0>
struct Gemm {
    const bf16_t* A; const bf16_t* Bt;
    static constexpr int K = K_, lda = LDA, ldb = LDB;
    __device__ __forceinline__ const char* abase(const Unit& u) const { return (const char*)(A + (size_t)u.g * GSA + (size_t)u.pm * BM * LDA); }
    __device__ __forceinline__ const char* bbase(const Unit& u) const { return (const char*)(Bt + (size_t)u.g * GSB + (size_t)u.pn * BM * LDB); }
};
template <int M, int N, int NGRP = 1>
struct StaticOrder {
    static constexpr int nM = M / BM, nN = N / BM, nwg = nM * nN;
    int G, c;
    __device__ void init(int G_, int c_) { G = G_; c = c_; }
    __device__ bool next(int i, Unit& u) const {
        const int L = i * G + c; if (L >= nwg * NGRP) return false;
        u.g = L / nwg;
        int wgid = L % nwg; { constexpr int q = nwg / NXCD, r = nwg % NXCD; const int xcd = wgid % NXCD, off = wgid / NXCD; wgid = (xcd < r ? xcd * (q + 1) : r * (q + 1) + (xcd - r) * q) + off; }
        constexpr int nig = WGM * nN; const int gid = wgid / nig, fm = gid * WGM, gsz = (nM - fm) < WGM ? (nM - fm) : WGM;
        u.pm = fm + ((wgid % nig) % gsz); u.pn = (wgid % nig) / gsz; return true;
    }
    __device__ __forceinline__ void a_ready(const Unit&) const {}
    __device__ __forceinline__ void done(const Unit&) const {}
};
__device__ __forceinline__ unsigned cvt_pk_bf16(float lo, float hi) { unsigned r; asm volatile("v_cvt_pk_bf16_f32 %0, %1, %2" : "=v"(r) : "v"(lo), "v"(hi)); return r; }
template <class Epi, class Sched, bool ALIGN_EPI = false, bool SP2 = false, class GemmT>
__device__ __forceinline__ void gemm_phase(PG8_LAS unsigned char* lds, const GemmT g, const Sched& S, const Epi& E) {
    int tid_ = threadIdx.x; asm volatile("" : "+v"(tid_));
    const int tid = tid_, wid = __builtin_amdgcn_readfirstlane(tid >> 6), lane = tid & 63, wr = wid >> 2, wc = wid & 3, fr = lane & 15, fq = lane >> 4;
    const int K = g.K, nt = K / BK;
    unsigned voffA[2], voffB[2];
#pragma unroll
    for (int i = 0; i < 2; ++i) { int R, C; stage_rc(tid * 16 + i * 8192, R, C); const int Rb = Epi::PERM ? ((R & ~31) + perm32(R & 31)) : R;
        voffA[i] = (unsigned)(R * g.lda + C) * 2u; voffB[i] = (unsigned)(Rb * g.ldb + C) * 2u; }
    const size_t kstep = (size_t)(BK * 2);
    const size_t hstepA = (size_t)HALF * g.lda * 2, hstepB = (size_t)HALF * g.ldb * 2;
    const unsigned ldsw = (unsigned)wid * 1024u;
    const int aoff = lds_byte(wr * 64 + fr, fq * 8), boff = lds_byte(wc * 32 + fr, fq * 8);
#define PG8_SA(b, h) (((b) * 2 + (h)) * HTB)
#define PG8_SB(b, h) ((4 + (b) * 2 + (h)) * HTB)
#define PG8_STAGE(bufoff, gbase, voff) do { _Pragma("unroll") for (int _i = 0; _i < 2; ++_i) \
        __builtin_amdgcn_global_load_lds((const unsigned*)((const char*)(gbase) + (voff)[_i]), (PG8_LAS unsigned*)(lds + (bufoff) + ldsw + _i * 8192), 16, 0, 0); } while (0)
#define PG8_LDA(dst, b, h) do { _Pragma("unroll") for (int m = 0; m < 4; ++m) _Pragma("unroll") for (int k = 0; k < 2; ++k) dst[m][k] = *(const PG8_LAS bf16x8*)(lds + PG8_SA(b, h) + aoff + m * 2048 + k * 1024); } while (0)
#define PG8_LDB(dst, b, h) do { _Pragma("unroll") for (int n = 0; n < 2; ++n) _Pragma("unroll") for (int k = 0; k < 2; ++k) dst[n][k] = *(const PG8_LAS bf16x8*)(lds + PG8_SB(b, h) + boff + n * 2048 + k * 1024); } while (0)
#define PG8_MMA(ai, bj, At, Bt) do { __builtin_amdgcn_s_setprio(1); _Pragma("unroll") for (int m = 0; m < 4; ++m) _Pragma("unroll") for (int n = 0; n < 2; ++n) _Pragma("unroll") for (int k = 0; k < 2; ++k) \
        acc[ai][bj][m][n] = __builtin_amdgcn_mfma_f32_16x16x32_bf16(Bt[n][k], At[m][k], acc[ai][bj][m][n], 0, 0, 0); __builtin_amdgcn_s_setprio(0); } while (0)
#define PG8_WAIT_V(n) asm volatile("s_waitcnt vmcnt(" #n ")" ::: "memory")
#define PG8_WAIT_L(n) asm volatile("s_waitcnt lgkmcnt(" #n ")" ::: "memory")
#define PG8_BAR __builtin_amdgcn_s_barrier()
#define PG8_SCHED __builtin_amdgcn_sched_barrier(0)
    Unit cur, nxt; int ui = 0;
    if (!S.next(0, cur)) return;
    f32x4 acc[2][2][4][2];
#pragma unroll
    for (int a = 0; a < 2; ++a)
#pragma unroll
        for (int b = 0; b < 2; ++b)
#pragma unroll
            for (int m = 0; m < 4; ++m)
#pragma unroll
                for (int n = 0; n < 2; ++n) acc[a][b][m][n] = (f32x4){0.f, 0.f, 0.f, 0.f};
    bf16x8 At[4][2], B0[2][2], B1[2][2];
    const char* cA = g.abase(cur); const char* cB = g.bbase(cur);
    S.a_ready(cur);
    if constexpr (SP2) {
        PG8_STAGE(PG8_SB(0, 0), cB, voffB); PG8_STAGE(PG8_SB(0, 1), cB + hstepB, voffB); PG8_STAGE(PG8_SA(0, 0), cA, voffA); PG8_STAGE(PG8_SA(0, 1), cA + hstepA, voffA);
        if (wr == 1) PG8_BAR;
        PG8_WAIT_V(2); PG8_BAR;
        PG8_STAGE(PG8_SB(1, 0), cB + kstep, voffB); PG8_STAGE(PG8_SA(1, 0), cA + kstep, voffA); PG8_STAGE(PG8_SB(1, 1), cB + hstepB + kstep, voffB);
        PG8_WAIT_V(6); PG8_BAR;
    } else {
        PG8_STAGE(PG8_SB(0, 0), cB, voffB); PG8_STAGE(PG8_SA(0, 0), cA, voffA); PG8_STAGE(PG8_SB(0, 1), cB + hstepB, voffB); PG8_STAGE(PG8_SA(0, 1), cA + hstepA, voffA);
        if (wr == 1) PG8_BAR;
        PG8_WAIT_V(4); PG8_BAR;
        PG8_STAGE(PG8_SB(1, 0), cB + kstep, voffB); PG8_STAGE(PG8_SA(1, 0), cA + kstep, voffA); PG8_STAGE(PG8_SB(1, 1), cB + hstepB + kstep, voffB);
        PG8_WAIT_V(6); PG8_BAR;
    }
    for (;;) {
        const bool has_next = S.next(ui + 1, nxt);
        const char* nA = has_next ? g.abase(nxt) : cA; const char* nB = has_next ? g.bbase(nxt) : cB;
        for (int t = 0; t < nt; t += 2) {
            const bool last = (t == nt - 2);
            const char* a1 = cA + (size_t)(t + 1) * kstep;
            const char* a2 = last ? nA : cA + (size_t)(t + 2) * kstep; const char* b2 = last ? nB : cB + (size_t)(t + 2) * kstep;
            const char* a3 = a2 + kstep; const char* b3 = b2 + kstep;
            if (last && has_next) S.a_ready(nxt);
            if constexpr (SP2) {
            PG8_LDB(B0, 0, 0); PG8_LDB(B1, 0, 1); PG8_SCHED; PG8_LDA(At, 0, 0); PG8_STAGE(PG8_SA(1, 1), a1 + hstepA, voffA);
            PG8_WAIT_V(8); PG8_WAIT_L(0); PG8_BAR; PG8_MMA(0, 0, At, B0); PG8_MMA(0, 1, At, B1); PG8_BAR; PG8_SCHED;
            PG8_LDA(At, 0, 1); PG8_STAGE(PG8_SB(0, 0), b2, voffB); PG8_STAGE(PG8_SB(0, 1), b2 + hstepB, voffB); PG8_STAGE(PG8_SA(0, 0), a2, voffA);
            PG8_WAIT_V(8); PG8_WAIT_L(0); PG8_BAR; PG8_MMA(1, 0, At, B0); PG8_MMA(1, 1, At, B1); PG8_BAR; PG8_SCHED;
            PG8_LDB(B0, 1, 0); PG8_LDB(B1, 1, 1); PG8_SCHED; PG8_LDA(At, 1, 0); PG8_STAGE(PG8_SA(0, 1), a2 + hstepA, voffA);
            PG8_WAIT_V(8); PG8_WAIT_L(0); PG8_BAR; PG8_MMA(0, 0, At, B0); PG8_MMA(0, 1, At, B1); PG8_BAR; PG8_SCHED;
            PG8_LDA(At, 1, 1); PG8_STAGE(PG8_SB(1, 0), b3, voffB); PG8_STAGE(PG8_SB(1, 1), b3 + hstepB, voffB); PG8_STAGE(PG8_SA(1, 0), a3, voffA);
            PG8_WAIT_V(8); PG8_WAIT_L(0); PG8_BAR; PG8_MMA(1, 0, At, B0); PG8_MMA(1, 1, At, B1); PG8_BAR; PG8_SCHED;
            } else {
            PG8_LDB(B0, 0, 0); PG8_SCHED; PG8_LDA(At, 0, 0); PG8_STAGE(PG8_SA(1, 1), a1 + hstepA, voffA);
            PG8_WAIT_L(8); PG8_BAR; PG8_WAIT_L(0); PG8_MMA(0, 0, At, B0); PG8_BAR; PG8_SCHED;
            PG8_LDB(B1, 0, 1); PG8_STAGE(PG8_SB(0, 0), b2, voffB);
            PG8_BAR; PG8_WAIT_L(0); PG8_MMA(0, 1, At, B1); PG8_BAR;
            PG8_LDA(At, 0, 1); PG8_STAGE(PG8_SA(0, 0), a2, voffA);
            PG8_BAR; PG8_WAIT_L(0); PG8_MMA(1, 0, At, B0); PG8_BAR; PG8_SCHED;
            PG8_STAGE(PG8_SB(0, 1), b2 + hstepB, voffB);
            PG8_WAIT_V(6); PG8_BAR; PG8_MMA(1, 1, At, B1); PG8_BAR;
            PG8_LDB(B0, 1, 0); PG8_SCHED; PG8_LDA(At, 1, 0); PG8_STAGE(PG8_SA(0, 1), a2 + hstepA, voffA);
            PG8_WAIT_L(8); PG8_BAR; PG8_WAIT_L(0); PG8_MMA(0, 0, At, B0); PG8_BAR; PG8_SCHED;
            PG8_LDB(B1, 1, 1); PG8_STAGE(PG8_SB(1, 0), b3, voffB);
            PG8_BAR; PG8_WAIT_L(0); PG8_MMA(0, 1, At, B1); PG8_BAR;
            PG8_LDA(At, 1, 1); PG8_STAGE(PG8_SA(1, 0), a3, voffA);
            PG8_BAR; PG8_WAIT_L(0); PG8_MMA(1, 0, At, B0); PG8_BAR; PG8_SCHED;
            PG8_STAGE(PG8_SB(1, 1), b3 + hstepB, voffB);
            PG8_WAIT_V(6); PG8_BAR; PG8_MMA(1, 1, At, B1); PG8_BAR;
            }
        }
        if constexpr (ALIGN_EPI) { if (wr == 0) PG8_BAR; }
        if constexpr (!Epi::AFTER_DRAIN) { E(acc, cur, wr, wc, fr, fq); S.done(cur); }
        if (!has_next) break;
#pragma unroll
        for (int a = 0; a < 2; ++a)
#pragma unroll
            for (int b = 0; b < 2; ++b)
#pragma unroll
                for (int m = 0; m < 4; ++m)
#pragma unroll
                    for (int n = 0; n < 2; ++n) acc[a][b][m][n] = (f32x4){0.f, 0.f, 0.f, 0.f};
        cur = nxt; cA = nA; cB = nB; ++ui;
        if constexpr (ALIGN_EPI) { if (wr == 1) PG8_BAR; }
    }
    PG8_WAIT_V(0);
    if constexpr (!ALIGN_EPI) { if (wr == 0) PG8_BAR; }
    PG8_BAR;
    if constexpr (Epi::AFTER_DRAIN) { E.fused(acc, cur, wr, wc, fr, fq, lds, wid, lane); S.done(cur); }
#undef PG8_SA
#undef PG8_SB
#undef PG8_STAGE
#undef PG8_LDA
#undef PG8_LDB
#undef PG8_MMA
#undef PG8_WAIT_V
#undef PG8_WAIT_L
#undef PG8_BAR
#undef PG8_SCHED
}
}

constexpr size_t MiB = 1u << 20;
struct P {
    const float *x, *c, *ctx, *c_ctx, *w_mod, *b_mod, *norm1_g, *norm2_g, *w_in;
    const float *a_re, *a_im, *log_dt, *b_re, *b_im, *c_re, *c_im, *ssm_d;
    const float *w_glu, *b_glu, *w_a, *w_b, *rpb, *w_out, *w_q, *subkeys, *peer_u, *peer_v, *final_g;
    float* out;
    unsigned char* ws;
    __device__ __forceinline__ float* rowss() const { return (float*)(ws + 512 * 1024); }
    __device__ __forceinline__ float* mod() const { return (float*)(ws + 1 * MiB); }
    __device__ __forceinline__ float* c2() const { return (float*)(ws + 1 * MiB + 256 * 1024); }
    __device__ __forceinline__ bf16_t* w_in_t() const { return (bf16_t*)(ws + 3 * MiB); }
    __device__ __forceinline__ bf16_t* w_glu_t() const { return (bf16_t*)(ws + 11 * MiB); }
    __device__ __forceinline__ bf16_t* w_a_t() const { return (bf16_t*)(ws + 12 * MiB); }
    __device__ __forceinline__ bf16_t* w_b_t() const { return (bf16_t*)(ws + 13 * MiB); }
    __device__ __forceinline__ bf16_t* w_out_t() const { return (bf16_t*)(ws + 14 * MiB); }
    __device__ __forceinline__ bf16_t* w_q_t() const { return (bf16_t*)(ws + 16 * MiB); }
    __device__ __forceinline__ bf16_t* Kmat() const { return (bf16_t*)(ws + 21 * MiB); }
    __device__ __forceinline__ bf16_t* Win() const { return (bf16_t*)(ws + 45 * MiB); }
    __device__ __forceinline__ float* lamT() const { return (float*)(ws + 53 * MiB); }
    __device__ __forceinline__ unsigned char* pu8() const { return ws + 54 * MiB; }
    __device__ __forceinline__ unsigned char* pv8() const { return ws + 70 * MiB; }
    __device__ __forceinline__ float* pisc() const { return (float*)(ws + 53 * MiB + 128 * 1024); }
    __device__ __forceinline__ bf16_t* ga() const { return (bf16_t*)(ws + 118 * MiB); }
    __device__ __forceinline__ bf16_t* gb() const { return (bf16_t*)(ws + 182 * MiB); }
    __device__ __forceinline__ bf16_t* x1g() const { return (bf16_t*)(ws + 118 * MiB); }
    __device__ __forceinline__ unsigned* topk() const { return (unsigned*)(ws + 182 * MiB); }
    __device__ __forceinline__ bf16_t* kb() const { return (bf16_t*)(ws + 246 * MiB); }
    __device__ __forceinline__ bf16_t* vT() const { return (bf16_t*)(ws + 278 * MiB); }
    __device__ __forceinline__ bf16_t* qb() const { return (bf16_t*)(ws + 310 * MiB); }
    __device__ __forceinline__ bf16_t* kc() const { return (bf16_t*)(ws + 342 * MiB); }
    __device__ __forceinline__ bf16_t* vcT() const { return (bf16_t*)(ws + 344 * MiB); }
    __device__ __forceinline__ bf16_t* U() const { return (bf16_t*)(ws + 346 * MiB); }
    __device__ __forceinline__ float* E() const { return (float*)(ws + 406 * MiB); }
    __device__ __forceinline__ bf16_t* merged() const { return (bf16_t*)(ws + 246 * MiB); }
    __device__ __forceinline__ float* tbuf() const { return (float*)(ws + 310 * MiB); }
    __device__ __forceinline__ bf16_t* qp() const { return (bf16_t*)(ws + 246 * MiB); }
    __device__ __forceinline__ bf16_t* hx() const { return (bf16_t*)out; }
    __device__ __forceinline__ bf16_t* hc() const { return (bf16_t*)((unsigned char*)out + 64 * MiB); }
    __device__ __forceinline__ bf16_t* na() const { return (bf16_t*)out; }
    __device__ __forceinline__ bf16_t* z() const { return (bf16_t*)((unsigned char*)out + 32 * MiB); }
    __device__ __forceinline__ bf16_t* gl() const { return (bf16_t*)((unsigned char*)out + 64 * MiB); }
};

namespace pg8 {
struct EpiInProj {
    static constexpr bool PERM = true, AFTER_DRAIN = false;
    bf16_t* U; bf16_t* d_kq; size_t kq_stride; bf16_t* d_vT; bf16_t* d_gate; int is_ctx;
    __device__ __forceinline__ void operator()(const f32x4 (&acc)[2][2][4][2], const Unit& u, int wr, int wc, int fr, int fq) const {
        if (u.pn < 2) {
#pragma unroll
            for (int ai = 0; ai < 2; ++ai)
#pragma unroll
                for (int m = 0; m < 4; ++m) {
                    const int row = u.pm * BM + ai * HALF + wr * 64 + m * 16 + fr;
                    const int n = is_ctx ? (1024 + (row >> 8) * 8 + ((row & 255) >> 5)) : ((row >> 12) * 128 + ((row & 4095) >> 5));
                    const int jj = row & 31;
#pragma unroll
                    for (int bj = 0; bj < 2; ++bj) {
                        const int col = u.pn * BM + bj * HALF + wc * 32 + 8 * fq;
                        const f32x4 v0 = acc[ai][bj][m][0], v1 = acc[ai][bj][m][1];
                        u32x4 w; w.x = cvt_pk_bf16(v0[0], v0[1]); w.y = cvt_pk_bf16(v0[2], v0[3]); w.z = cvt_pk_bf16(v1[0], v1[1]); w.w = cvt_pk_bf16(v1[2], v1[3]);
                        *(u32x4*)(U + ((size_t)((col >> 4) * SSM_ROWS + n) * SSM_LD + jj * 16 + (col & 15))) = w;
                    }
                    asm volatile("" ::: "memory");
                }
        } else if (u.pn == 4 || u.pn == 5) {
            const int RB = is_ctx ? (CTXL / 64) : (SEQL / 64);
#pragma unroll
            for (int ai = 0; ai < 2; ++ai)
#pragma unroll
                for (int m = 0; m < 4; ++m) {
                    const int row = u.pm * BM + ai * HALF + wr * 64 + m * 16 + fr;
                    const int b = is_ctx ? (row >> 8) : (row >> 12), t = is_ctx ? (row & 255) : (row & 4095);
#pragma unroll
                    for (int bj = 0; bj < 2; ++bj) {
                        const int col = u.pn * BM + bj * HALF + wc * 32 + 8 * fq - 1024;
                        bf16_t* dst = d_vT + ((size_t)((b * 8 + (col >> 6)) * RB + (t >> 6)) * 4096 + (col & 63) * 64 + (t & 63));
#pragma unroll
                        for (int n = 0; n < 2; ++n)
#pragma unroll
                            for (int i = 0; i < 4; ++i) dst[(n * 4 + i) * 64] = (bf16_t)f2bf(acc[ai][bj][m][n][i]);
                    }
                    asm volatile("" ::: "memory");
                }
        } else {
            bf16_t* base; int ld, c0;
            if (u.pn < 8) { const int which = (u.pn - 2) >> 2; base = d_kq + (size_t)which * kq_stride; ld = 512; c0 = 512 + which * 1024; }
            else { const int which = (u.pn - 8) >> 2; base = d_gate + (size_t)which * ((size_t)NTOK * DM); ld = DM; c0 = 2048 + which * 1024; }
#pragma unroll
            for (int ai = 0; ai < 2; ++ai)
#pragma unroll
                for (int m = 0; m < 4; ++m) {
                    const int row = u.pm * BM + ai * HALF + wr * 64 + m * 16 + fr;
#pragma unroll
                    for (int bj = 0; bj < 2; ++bj) {
                        const int col = u.pn * BM + bj * HALF + wc * 32 + 8 * fq - c0;
                        const f32x4 v0 = acc[ai][bj][m][0], v1 = acc[ai][bj][m][1];
                        u32x4 w; w.x = cvt_pk_bf16(v0[0], v0[1]); w.y = cvt_pk_bf16(v0[2], v0[3]); w.z = cvt_pk_bf16(v1[0], v1[1]); w.w = cvt_pk_bf16(v1[2], v1[3]);
                        *(u32x4*)(base + (size_t)row * ld + col) = w;
                    }
                    asm volatile("" ::: "memory");
                }
        }
    }
};
struct EpiGlu {
    static constexpr bool PERM = true, AFTER_DRAIN = false;
    bf16_t* gl; const bf16_t* z; const float* bias;
    __device__ __forceinline__ void operator()(const f32x4 (&acc)[2][2][4][2], const Unit& u, int wr, int wc, int fr, int fq) const {
#pragma unroll
        for (int ai = 0; ai < 2; ++ai)
#pragma unroll
            for (int m = 0; m < 4; ++m) {
                const int row = u.pm * BM + ai * HALF + wr * 64 + m * 16 + fr;
#pragma unroll
                for (int bj = 0; bj < 2; ++bj) {
                    const int col = u.pn * BM + bj * HALF + wc * 32 + 8 * fq;
                    const f32x4 v0 = acc[ai][bj][m][0], v1 = acc[ai][bj][m][1];
                    const f32x4 b0 = *(const f32x4*)(bias + col), b1 = *(const f32x4*)(bias + col + 4);
                    const u32x4 zz = *(const u32x4*)(z + (size_t)row * 512 + col);
                    float o[8];
                    o[0] = bflo(zz.x) * sigmoidf_(v0[0] + b0[0]); o[1] = bfhi(zz.x) * sigmoidf_(v0[1] + b0[1]);
                    o[2] = bflo(zz.y) * sigmoidf_(v0[2] + b0[2]); o[3] = bfhi(zz.y) * sigmoidf_(v0[3] + b0[3]);
                    o[4] = bflo(zz.z) * sigmoidf_(v1[0] + b1[0]); o[5] = bfhi(zz.z) * sigmoidf_(v1[1] + b1[1]);
                    o[6] = bflo(zz.w) * sigmoidf_(v1[2] + b1[2]); o[7] = bfhi(zz.w) * sigmoidf_(v1[3] + b1[3]);
                    u32x4 w; w.x = cvt_pk_bf16(o[0], o[1]); w.y = cvt_pk_bf16(o[2], o[3]); w.z = cvt_pk_bf16(o[4], o[5]); w.w = cvt_pk_bf16(o[6], o[7]);
                    *(u32x4*)(gl + (size_t)row * 512 + col) = w;
                }
            }
    }
};
struct EpiBrA {
    static constexpr bool PERM = true, AFTER_DRAIN = false;
    float* t; const bf16_t* ga;
    __device__ __forceinline__ void operator()(const f32x4 (&acc)[2][2][4][2], const Unit& u, int wr, int wc, int fr, int fq) const {
#pragma unroll
        for (int ai = 0; ai < 2; ++ai)
#pragma unroll
            for (int m = 0; m < 4; ++m) {
                const int row = u.pm * BM + ai * HALF + wr * 64 + m * 16 + fr;
#pragma unroll
                for (int bj = 0; bj < 2; ++bj) {
                    const int col = u.pn * BM + bj * HALF + wc * 32 + 8 * fq;
                    const f32x4 v0 = acc[ai][bj][m][0], v1 = acc[ai][bj][m][1];
                    const u32x4 gg = *(const u32x4*)(ga + (size_t)row * DM + col);
                    f32x4 o0, o1;
                    o0[0] = sigmoidf_(bflo(gg.x)) * v0[0]; o0[1] = sigmoidf_(bfhi(gg.x)) * v0[1]; o0[2] = sigmoidf_(bflo(gg.y)) * v0[2]; o0[3] = sigmoidf_(bfhi(gg.y)) * v0[3];
                    o1[0] = sigmoidf_(bflo(gg.z)) * v1[0]; o1[1] = sigmoidf_(bfhi(gg.z)) * v1[1]; o1[2] = sigmoidf_(bflo(gg.w)) * v1[2]; o1[3] = sigmoidf_(bfhi(gg.w)) * v1[3];
                    *(f32x4*)(t + (size_t)row * DM + col) = o0; *(f32x4*)(t + (size_t)row * DM + col + 4) = o1;
                }
            }
    }
};
struct EpiBrB {
    static constexpr bool PERM = true, AFTER_DRAIN = false;
    bf16_t* merged; const float* t; const bf16_t* gb;
    __device__ __forceinline__ void operator()(const f32x4 (&acc)[2][2][4][2], const Unit& u, int wr, int wc, int fr, int fq) const {
#pragma unroll
        for (int ai = 0; ai < 2; ++ai)
#pragma unroll
            for (int m = 0; m < 4; ++m) {
                const int row = u.pm * BM + ai * HALF + wr * 64 + m * 16 + fr;
#pragma unroll
                for (int bj = 0; bj < 2; ++bj) {
                    const int col = u.pn * BM + bj * HALF + wc * 32 + 8 * fq;
                    const f32x4 v0 = acc[ai][bj][m][0], v1 = acc[ai][bj][m][1];
                    const u32x4 gg = *(const u32x4*)(gb + (size_t)row * DM + col);
                    const f32x4 t0 = *(const f32x4*)(t + (size_t)row * DM + col), t1 = *(const f32x4*)(t + (size_t)row * DM + col + 4);
                    float o[8];
                    o[0] = t0[0] + sigmoidf_(bflo(gg.x)) * v0[0]; o[1] = t0[1] + sigmoidf_(bfhi(gg.x)) * v0[1]; o[2] = t0[2] + sigmoidf_(bflo(gg.y)) * v0[2]; o[3] = t0[3] + sigmoidf_(bfhi(gg.y)) * v0[3];
                    o[4] = t1[0] + sigmoidf_(bflo(gg.z)) * v1[0]; o[5] = t1[1] + sigmoidf_(bfhi(gg.z)) * v1[1]; o[6] = t1[2] + sigmoidf_(bflo(gg.w)) * v1[2]; o[7] = t1[3] + sigmoidf_(bfhi(gg.w)) * v1[3];
                    u32x4 w; w.x = cvt_pk_bf16(o[0], o[1]); w.y = cvt_pk_bf16(o[2], o[3]); w.z = cvt_pk_bf16(o[4], o[5]); w.w = cvt_pk_bf16(o[6], o[7]);
                    *(u32x4*)(merged + (size_t)row * DM + col) = w;
                }
            }
    }
};
struct EpiOut {
    static constexpr bool PERM = true, AFTER_DRAIN = false;
    const float* x; float* x1; bf16_t* x1g; const float* mod; const float* g2; float* rowss;
    __device__ __forceinline__ void operator()(const f32x4 (&acc)[2][2][4][2], const Unit& u, int wr, int wc, int fr, int fq) const {
#pragma unroll
        for (int ai = 0; ai < 2; ++ai)
#pragma unroll
            for (int m = 0; m < 4; ++m) {
                const int row = u.pm * BM + ai * HALF + wr * 64 + m * 16 + fr;
                const float* modb = mod + (size_t)(row >> 12) * (6 * DM);
                float ss = 0.f;
#pragma unroll
                for (int bj = 0; bj < 2; ++bj) {
                    const int col = u.pn * BM + bj * HALF + wc * 32 + 8 * fq;
#pragma unroll
                    for (int n = 0; n < 2; ++n) {
                        const int cc = col + 4 * n;
                        const f32x4 v = acc[ai][bj][m][n];
                        const f32x4 xx = *(const f32x4*)(x + (size_t)row * DM + cc);
                        const f32x4 g1 = *(const f32x4*)(modb + 2 * DM + cc), sc = *(const f32x4*)(modb + 4 * DM + cc), gg = *(const f32x4*)(g2 + cc);
                        const f32x4 o = xx + g1 * v;
                        *(f32x4*)(x1 + (size_t)row * DM + cc) = o;
                        ss += o[0] * o[0] + o[1] * o[1] + o[2] * o[2] + o[3] * o[3];
                        const f32x4 og = o * gg * (sc + 1.f);
                        u32x2 w; w.x = cvt_pk_bf16(og[0], og[1]); w.y = cvt_pk_bf16(og[2], og[3]);
                        *(u32x2*)(x1g + (size_t)row * DM + cc) = w;
                    }
                }
                ss += __shfl_xor(ss, 16); ss += __shfl_xor(ss, 32);
                if (fq == 0) atomicAdd(rowss + row, ss);
            }
    }
};
struct EpiQ {
    static constexpr bool PERM = true, AFTER_DRAIN = false;
    bf16_t* qp; const float* rowss; const float* c2;
    __device__ __forceinline__ void operator()(const f32x4 (&acc)[2][2][4][2], const Unit& u, int wr, int wc, int fr, int fq) const {
#pragma unroll
        for (int ai = 0; ai < 2; ++ai)
#pragma unroll
            for (int m = 0; m < 4; ++m) {
                const int row = u.pm * BM + ai * HALF + wr * 64 + m * 16 + fr;
                const float rstd = rsqrtf(rowss[row] * (1.f / DM) + EPSN);
                const float* cb = c2 + (size_t)(row >> 12) * 2048;
#pragma unroll
                for (int bj = 0; bj < 2; ++bj) {
                    const int col = u.pn * BM + bj * HALF + wc * 32 + 8 * fq;
                    const f32x4 v0 = acc[ai][bj][m][0] * rstd + *(const f32x4*)(cb + col), v1 = acc[ai][bj][m][1] * rstd + *(const f32x4*)(cb + col + 4);
                    u32x4 w; w.x = cvt_pk_bf16(v0[0], v0[1]); w.y = cvt_pk_bf16(v0[2], v0[3]); w.z = cvt_pk_bf16(v1[0], v1[1]); w.w = cvt_pk_bf16(v1[2], v1[3]);
                    *(u32x4*)(qp + (size_t)row * 2048 + col) = w;
                }
            }
    }
};
struct EpiE {
    static constexpr bool PERM = true, AFTER_DRAIN = false;
    float* E;
    __device__ __forceinline__ void operator()(const f32x4 (&acc)[2][2][4][2], const Unit& u, int wr, int wc, int fr, int fq) const {
#pragma unroll
        for (int ai = 0; ai < 2; ++ai)
#pragma unroll
            for (int m = 0; m < 4; ++m) {
                const int row = u.pm * BM + ai * HALF + wr * 64 + m * 16 + fr;
#pragma unroll
                for (int bj = 0; bj < 2; ++bj) {
                    const int col = u.pn * BM + bj * HALF + wc * 32 + 8 * fq;
                    float* d = E + ((size_t)(u.g * SSM_ROWS + row) * 256 + col);
                    *(f32x4*)d = acc[ai][bj][m][0]; *(f32x4*)(d + 4) = acc[ai][bj][m][1];
                }
            }
    }
};
struct EpiZ {
    static constexpr bool PERM = true, AFTER_DRAIN = false;
    bf16_t* z;
    __device__ __forceinline__ void operator()(const f32x4 (&acc)[2][2][4][2], const Unit& u, int wr, int wc, int fr, int fq) const {
#pragma unroll
        for (int ai = 0; ai < 2; ++ai)
#pragma unroll
            for (int m = 0; m < 4; ++m) {
                const int n = u.pm * BM + ai * HALF + wr * 64 + m * 16 + fr;
                const size_t tok0 = (size_t)(n >> 7) * SEQL + (size_t)(n & 127) * 32;
#pragma unroll
                for (int bj = 0; bj < 2; ++bj) {
                    const int col = u.pn * BM + bj * HALF + wc * 32 + 8 * fq;
                    const f32x4 v0 = acc[ai][bj][m][0], v1 = acc[ai][bj][m][1];
                    u32x4 w; w.x = cvt_pk_bf16(gelu_tanh(v0[0]), gelu_tanh(v0[1])); w.y = cvt_pk_bf16(gelu_tanh(v0[2]), gelu_tanh(v0[3]));
                    w.z = cvt_pk_bf16(gelu_tanh(v1[0]), gelu_tanh(v1[1])); w.w = cvt_pk_bf16(gelu_tanh(v1[2]), gelu_tanh(v1[3]));
                    *(u32x4*)(z + (tok0 + (col >> 4)) * 512 + u.g * 16 + (col & 15)) = w;
                }
            }
    }
};
}

__device__ __forceinline__ void sincos_d(double th, double& s, double& c) {
    const double twopi = 6.283185307179586476925, hpi = 1.570796326794896619231;
    th -= twopi * rint(th / twopi);
    const double q = rint(th / hpi); const double y = th - q * hpi, y2 = y * y;
    const double sy = y * (1.0 - y2 / 6.0 * (1.0 - y2 / 20.0 * (1.0 - y2 / 42.0 * (1.0 - y2 / 72.0 * (1.0 - y2 / 110.0 * (1.0 - y2 / 156.0 * (1.0 - y2 / 210.0)))))));
    const double cy = 1.0 - y2 / 2.0 * (1.0 - y2 / 12.0 * (1.0 - y2 / 30.0 * (1.0 - y2 / 56.0 * (1.0 - y2 / 90.0 * (1.0 - y2 / 132.0 * (1.0 - y2 / 182.0))))));
    const int qi = ((int)q) & 3;
    s = qi == 0 ? sy : (qi == 1 ? cy : (qi == 2 ? -sy : -cy));
    c = qi == 0 ? cy : (qi == 1 ? -sy : (qi == 2 ? -cy : sy));
}
__device__ __forceinline__ void ssm_prep_item(const P& p, LAS unsigned char* lds, int item) {
    const int g = item >> 2, qtr = item & 3, tid = threadIdx.x;
    LAS f32x2* lamk = (LAS f32x2*)lds;
    LAS f32x2* Bb = lamk + 2 * 64 * 33;
    LAS f32x2* Cc = Bb + 2 * 64 * 16;
    LAS float* Kc = (LAS float*)(Cc + 2 * 16 * 64);
    if (tid < 128) {
        const int d = tid >> 6, pp = tid & 63, gi = d * 32 + g;
        const double are = (double)p.a_re[gi * 64 + pp], aim = (double)p.a_im[gi * 64 + pp];
        const double dt = (double)expf(p.log_dt[gi]);
        const double er = exp(are * dt); double sn, cs; sincos_d(aim * dt, sn, cs);
        const double lr = er * cs, li = er * sn;
        double pr = 1.0, pi_ = 0.0;
        for (int k = 0; k <= 32; ++k) {
            lamk[(d * 64 + pp) * 33 + k] = (f32x2){(float)pr, (float)pi_};
            const double nr_ = pr * lr - pi_ * li, ni_ = pr * li + pi_ * lr; pr = nr_; pi_ = ni_;
        }
        if (qtr == 0) { const f32x2 l32 = lamk[(d * 64 + pp) * 33 + 32]; *(f32x2*)(p.lamT() + (size_t)(gi * 64 + pp) * 2) = l32; }
        const double nr = lr - 1.0, ni = li, den = are * are + aim * aim;
        const double qr = (nr * are + ni * aim) / den, qi = (ni * are - nr * aim) / den;
        for (int h = 0; h < 16; ++h) {
            const double br = (double)p.b_re[((size_t)gi * 64 + pp) * 16 + h], bi = (double)p.b_im[((size_t)gi * 64 + pp) * 16 + h];
            Bb[(d * 64 + pp) * 16 + h] = (f32x2){(float)(qr * br - qi * bi), (float)(qr * bi + qi * br)};
        }
    }
    for (int e = tid; e < 2 * 16 * 64; e += NT) {
        const int d = e >> 10, h = (e >> 6) & 15, pp = e & 63; const size_t src = ((size_t)(d * 32 + g) * 16 + h) * 64 + pp;
        Cc[e] = (f32x2){p.c_re[src], p.c_im[src]};
    }
    __syncthreads();
    for (int e = tid; e < 2 * 32 * 256; e += NT) {
        const int d = e >> 13, k = (e >> 8) & 31, h = (e >> 4) & 15, h2 = e & 15;
        float sacc = 0.f;
        for (int pp = 0; pp < 64; ++pp) {
            const f32x2 c = Cc[(d * 16 + h) * 64 + pp], l = lamk[(d * 64 + pp) * 33 + k], b = Bb[(d * 64 + pp) * 16 + h2];
            const float clr = c[0] * l[0] - c[1] * l[1], cli = c[0] * l[1] + c[1] * l[0];
            sacc += clr * b[0] - cli * b[1];
        }
        Kc[e] = sacc;
    }
    __syncthreads();
    for (int ch = tid; ch < 128 * 96; ch += NT) {
        const int mrow = 128 * qtr + ch / 96, k0 = (ch % 96) * 8, ii = mrow >> 4, h = mrow & 15;
        float v[8];
        if (k0 < 512) {
            const int jj = k0 >> 4, h20 = k0 & 15;
#pragma unroll
            for (int i = 0; i < 8; ++i) {
                const int h2 = h20 + i; float val = 0.f;
                if (ii >= jj) val += Kc[((0 * 32 + (ii - jj)) * 16 + h) * 16 + h2];
                if (jj >= ii) val += Kc[((1 * 32 + (jj - ii)) * 16 + h) * 16 + h2];
                if (ii == jj && h == h2) val += p.ssm_d[g * 16 + h];
                v[i] = val;
            }
        } else {
            const int sc = k0 - 512, d = sc >> 7, ri = (sc >> 6) & 1, p0 = sc & 63, e = d == 0 ? ii + 1 : 32 - ii;
#pragma unroll
            for (int i = 0; i < 8; ++i) {
                const int pp = p0 + i; const f32x2 c = Cc[(d * 16 + h) * 64 + pp], l = lamk[(d * 64 + pp) * 33 + e];
                const float clr = c[0] * l[0] - c[1] * l[1], cli = c[0] * l[1] + c[1] * l[0];
                v[i] = ri == 0 ? clr : -cli;
            }
        }
        u32x4 o; o.x = pk2(v[0], v[1]); o.y = pk2(v[2], v[3]); o.z = pk2(v[4], v[5]); o.w = pk2(v[6], v[7]);
        *(u32x4*)(p.Kmat() + ((size_t)(g * 512 + mrow) * SSM_LD + k0)) = o;
    }
    for (int ch = tid; ch < 64 * 64; ch += NT) {
        const int nrow = 64 * qtr + ch / 64, k0 = (ch % 64) * 8, d = nrow >> 7, ri = (nrow >> 6) & 1, pp = nrow & 63;
        const int jj = k0 >> 4, h20 = k0 & 15, e = d == 0 ? 31 - jj : jj;
        const f32x2 l = lamk[(d * 64 + pp) * 33 + e];
        float v[8];
#pragma unroll
        for (int i = 0; i < 8; ++i) { const f32x2 b = Bb[(d * 64 + pp) * 16 + h20 + i]; v[i] = ri == 0 ? (l[0] * b[0] - l[1] * b[1]) : (l[0] * b[1] + l[1] * b[0]); }
        u32x4 o; o.x = pk2(v[0], v[1]); o.y = pk2(v[2], v[3]); o.z = pk2(v[4], v[5]); o.w = pk2(v[6], v[7]);
        *(u32x4*)(p.Win() + ((size_t)(g * 256 + nrow) * 512 + k0)) = o;
    }
    __syncthreads();
}
__device__ __forceinline__ void ph_carry(const P& p) {
    int tid = threadIdx.x; asm volatile("" : "+v"(tid));
    if (tid >= 128) return;
    for (int gidx = blockIdx.x * 128 + tid; gidx < 32 * 8 * 2 * 64; gidx += gridDim.x * 128) {
        const int pp = gidx & 63, d = (gidx >> 6) & 1, b = (gidx >> 7) & 7, g = gidx >> 10;
        const f32x2 lt = *(const f32x2*)(p.lamT() + (size_t)((d * 32 + g) * 64 + pp) * 2);
        const float* Eg = p.E() + (size_t)g * SSM_ROWS * 256 + d * 128 + pp;
        bf16_t* Ug = p.U() + (size_t)g * SSM_ROWS * SSM_LD + 512 + d * 128 + pp;
        float fr = 0.f, fi = 0.f;
#pragma unroll
        for (int cc = 0; cc < 8; ++cc) {
            const int n = 1024 + b * 8 + (d == 0 ? cc : 7 - cc);
            const float er = Eg[(size_t)n * 256], ei = Eg[(size_t)n * 256 + 64];
            const float nr = lt[0] * fr - lt[1] * fi + er, ni = lt[0] * fi + lt[1] * fr + ei; fr = nr; fi = ni;
        }
#pragma unroll 8
        for (int c = 0; c < 128; ++c) {
            const int n = b * 128 + (d == 0 ? c : 127 - c);
            const float er = Eg[(size_t)n * 256], ei = Eg[(size_t)n * 256 + 64];
            Ug[(size_t)n * SSM_LD] = (bf16_t)f2bf(fr); Ug[(size_t)n * SSM_LD + 64] = (bf16_t)f2bf(fi);
            const float nr = lt[0] * fr - lt[1] * fi + er, ni = lt[0] * fi + lt[1] * fr + ei; fr = nr; fi = ni;
        }
    }
}


__device__ __forceinline__ void p0_transpose_item(const float* W, int K, int N, bf16_t* WT, LAS float* scr, int item, int lane) {
    const int nblk = N / 32, kb = item / nblk, nb = item % nblk, k0 = 64 * kb, n0 = 32 * nb;
#pragma unroll 8
    for (int i = 0; i < 32; ++i) { const int kk = 2 * i + (lane >> 5); scr[kk * 33 + (lane & 31)] = W[(size_t)(k0 + kk) * N + n0 + (lane & 31)]; }
    asm volatile("s_waitcnt lgkmcnt(0)" ::: "memory");
    const int c = lane & 7;
#pragma unroll
    for (int j = 0; j < 4; ++j) { const int n = (lane >> 3) + 8 * j; const LAS float* s = scr + (8 * c) * 33 + n;
        u32x4 o; o.x = pk2(s[0 * 33], s[1 * 33]); o.y = pk2(s[2 * 33], s[3 * 33]); o.z = pk2(s[4 * 33], s[5 * 33]); o.w = pk2(s[6 * 33], s[7 * 33]);
        *(u32x4*)(WT + (size_t)(n0 + n) * K + k0 + 8 * c) = o; }
    asm volatile("s_waitcnt lgkmcnt(0)" ::: "memory");
}

template <int NR, bool SILU>
__device__ __forceinline__ void gemv_block64(const float* const (&rows)[NR], const float* W, int ldw, int col0, const float* bias, float* y, int ldy, LAS float* scr) {
    const int wave = threadIdx.x >> 6, lane = threadIdx.x & 63;
    float acc[NR];
#pragma unroll
    for (int r = 0; r < NR; ++r) acc[r] = 0.f;
    const int kb = wave * 128;
#pragma unroll 4
    for (int k = kb; k < kb + 128; ++k) {
        const float w = W[(size_t)k * ldw + col0 + lane];
#pragma unroll
        for (int r = 0; r < NR; ++r) { const float s = rows[r][k]; acc[r] += (SILU ? siluf_(s) : s) * w; }
    }
#pragma unroll
    for (int r = 0; r < NR; ++r) scr[(wave * NR + r) * 64 + lane] = acc[r];
    __syncthreads();
    for (int e = threadIdx.x; e < NR * 64; e += NT) {
        const int r = e >> 6, l = e & 63; float s = 0.f;
#pragma unroll
        for (int w = 0; w < 8; ++w) s += scr[(w * NR + r) * 64 + l];
        y[(size_t)r * ldy + col0 + l] = s + (bias ? bias[col0 + l] : 0.f);
    }
    __syncthreads();
}

__device__ __forceinline__ void ph_prep(const P& p, LAS unsigned char* lds) {
    int tid_ = threadIdx.x; asm volatile("" : "+v"(tid_));
    const int wave = tid_ >> 6, lane = tid_ & 63, G = gridDim.x;
    for (int cb = blockIdx.x; cb < 96; cb += G) {
        const float* const rows[9] = {p.c, p.c + DM, p.c + 2 * DM, p.c + 3 * DM, p.c + 4 * DM, p.c + 5 * DM, p.c + 6 * DM, p.c + 7 * DM, p.c_ctx};
        gemv_block64<9, true>(rows, p.w_mod, 6 * DM, cb * 64, p.b_mod, p.mod(), 6 * DM, (LAS float*)lds);
    }
    for (int it = G - 1 - (int)blockIdx.x; it < 128; it += G) ssm_prep_item(p, lds, it);
    {
        LAS float* scr = (LAS float*)(lds + wave * 16384);
        const int gw = blockIdx.x * NWAVES + wave, NGW = G * NWAVES;
        constexpr int I_IN = (DM / 64) * (INC / 32), I_GLU = (512 / 64) * (512 / 32), I_A = (512 / 64) * (DM / 32), I_OUT = (DM / 64) * (DM / 32), I_Q = (DM / 64) * (2048 / 32);
        constexpr int NITEMS = I_IN + I_GLU + 2 * I_A + I_OUT + I_Q;
        for (int it = gw; it < NITEMS; it += NGW) {
            int r = it;
            if (r < I_IN) { p0_transpose_item(p.w_in, DM, INC, p.w_in_t(), scr, r, lane); continue; } r -= I_IN;
            if (r < I_GLU) { p0_transpose_item(p.w_glu, 512, 512, p.w_glu_t(), scr, r, lane); continue; } r -= I_GLU;
            if (r < I_A) { p0_transpose_item(p.w_a, 512, DM, p.w_a_t(), scr, r, lane); continue; } r -= I_A;
            if (r < I_A) { p0_transpose_item(p.w_b, 512, DM, p.w_b_t(), scr, r, lane); continue; } r -= I_A;
            if (r < I_OUT) { p0_transpose_item(p.w_out, DM, DM, p.w_out_t(), scr, r, lane); continue; } r -= I_OUT;
            p0_transpose_item(p.w_q, DM, 2048, p.w_q_t(), scr, r, lane);
        }
    }
    {
        const int gw = blockIdx.x * NWAVES + wave, NGW = G * NWAVES;
        for (int r = gw; r < 2 * 16384; r += NGW) {
            const bool second = r >= 16384; const int rr = second ? r - 16384 : r;
            const float* src = (second ? p.peer_v : p.peer_u) + (size_t)rr * DM + lane * 16;
            f32x4 v[4]; float am = 0.f;
#pragma unroll
            for (int j = 0; j < 4; ++j) { v[j] = *(const f32x4*)(src + 4 * j); am = fmaxf(am, fmaxf(fmaxf(fabsf(v[j][0]), fabsf(v[j][1])), fmaxf(fabsf(v[j][2]), fabsf(v[j][3])))); }
            am = wave_max(am);
            const float sc = am > 0.f ? 448.f / am : 1.f;
            u32x4 o;
#pragma unroll
            for (int j = 0; j < 4; ++j) { int w = 0; w = __builtin_amdgcn_cvt_pk_fp8_f32(v[j][0] * sc, v[j][1] * sc, w, false); w = __builtin_amdgcn_cvt_pk_fp8_f32(v[j][2] * sc, v[j][3] * sc, w, true); o[j] = (unsigned)w; }
            *(u32x4*)((second ? p.pv8() : p.pu8()) + (size_t)rr * DM + lane * 16) = o;
            if (lane == 0) p.pisc()[r] = am > 0.f ? am * (1.f / 448.f) : 1.f;
        }
    }
}

__device__ __forceinline__ void normmod_row_bf16(const float* src, bf16_t* dst, const float* g, const float* shift, const float* scale, int lane) {
    const f32x4* s = (const f32x4*)src;
    f32x4 v[4]; float ss = 0.f;
#pragma unroll
    for (int j = 0; j < 4; ++j) { v[j] = s[lane + 64 * j]; ss += v[j][0] * v[j][0] + v[j][1] * v[j][1] + v[j][2] * v[j][2] + v[j][3] * v[j][3]; }
    ss = wave_sum(ss);
    const float rstd = rsqrtf(ss * (1.f / DM) + EPSN);
#pragma unroll
    for (int j = 0; j < 4; ++j) {
        const int i4 = lane + 64 * j;
        const f32x4 gg = ((const f32x4*)g)[i4], sh = ((const f32x4*)shift)[i4], sc = ((const f32x4*)scale)[i4];
        const f32x4 o = v[j] * rstd * gg * (sc + 1.f) + sh;
        u32x2 w; w.x = pk2(o[0], o[1]); w.y = pk2(o[2], o[3]);
        *(u32x2*)(dst + (size_t)i4 * 4) = w;
    }
}
__device__ __forceinline__ void ph_norm1(const P& p, LAS unsigned char* lds) {
    int tid_ = threadIdx.x; asm volatile("" : "+v"(tid_));
    const int wave = tid_ >> 6, lane = tid_ & 63, G = gridDim.x;
    for (int cb = blockIdx.x; cb < 32; cb += G) {
        const float* m3 = p.mod() + 3 * DM;
        const float* const rows[8] = {m3, m3 + 6 * DM, m3 + 12 * DM, m3 + 18 * DM, m3 + 24 * DM, m3 + 30 * DM, m3 + 36 * DM, m3 + 42 * DM};
        gemv_block64<8, false>(rows, p.w_q, 2048, cb * 64, nullptr, p.c2(), 2048, (LAS float*)lds);
    }
    for (int r = blockIdx.x * NWAVES + wave; r < NTOK + NCTX; r += G * NWAVES) {
        if (r < NTOK) { const float* modb = p.mod() + (size_t)(r >> 12) * (6 * DM); normmod_row_bf16(p.x + (size_t)r * DM, p.hx() + (size_t)r * DM, p.norm1_g, modb, modb + DM, lane); }
        else { const int rc = r - NTOK; const float* modc = p.mod() + 8 * (6 * DM); normmod_row_bf16(p.ctx + (size_t)rc * DM, p.hc() + (size_t)rc * DM, p.norm1_g, modc, modc + DM, lane); }
    }
}

constexpr int RPB_LD = 128, RPB_PAD = 48;
__device__ __forceinline__ void ph_na(const P& p, LAS unsigned char* lds) {
    int tid_ = threadIdx.x; asm volatile("" : "+v"(tid_));
    const int tid = tid_, h = __builtin_amdgcn_readfirstlane(tid >> 6), lane = tid & 63, lt = lane & 15, lq = lane >> 4;
    constexpr float LOG2E = 1.4426950408889634f, CS = 0.125f * LOG2E;
    LAS float* rp = (LAS float*)lds;
    for (int e = tid; e < 8 * 15 * RPB_LD; e += NT) { const int c = (e & (RPB_LD - 1)) - RPB_PAD; rp[e] = (c >= 0 && c < 31) ? p.rpb[(e / RPB_LD) * 31 + c] * LOG2E : 0.f; }
    __syncthreads();
    const int pa = (lt >> 2) * 8 + (lt & 3);
    const unsigned lane_k = pa * 512 + lq * 8, lane_v = lt * 64 + lq * 8, lane_q = lt * 512 + lq * 8, lane_o = lt * 512 + lq * 4;
    for (int item = blockIdx.x; item < NB * GW; item += gridDim.x) {
        const int b = item >> 6, r = item & 63;
        int r0 = r - 4; r0 = r0 < 0 ? 0 : (r0 > 56 ? 56 : r0);
        const bf16_t* Kb = p.kb() + ((size_t)b * SEQL + (size_t)r0 * GW) * 512 + h * 64;
        const bf16_t* Kc = p.kc() + ((size_t)b * CTXL) * 512 + h * 64;
        const bf16_t* Vt = p.vT() + ((size_t)((b * 8 + h) * 64 + r0)) * 4096;
        const bf16_t* Vc = p.vcT() + ((size_t)((b * 8 + h) * 4)) * 4096;
        const bf16_t* Qb = p.qb() + ((size_t)b * SEQL + r * GW) * 512 + h * 64;
        bf16_t* Ob = p.na() + ((size_t)b * SEQL + r * GW) * 512 + h * 64;
        const LAS float* rph = rp + (h * 15 + (r0 - r + 7)) * RPB_LD;
        bf16x8 qf[4][2];
#pragma unroll
        for (int qt = 0; qt < 4; ++qt) { qf[qt][0] = *(const bf16x8*)(Qb + qt * 16 * 512 + lane_q); qf[qt][1] = *(const bf16x8*)(Qb + qt * 16 * 512 + 32 + lane_q); }
        f32x4 o[4][4]; float m[4], l[4];
#pragma unroll
        for (int qt = 0; qt < 4; ++qt) { m[qt] = -1e30f; l[qt] = 0.f;
#pragma unroll
            for (int d = 0; d < 4; ++d) o[qt][d] = (f32x4){0.f, 0.f, 0.f, 0.f}; }
        bf16x8 kf[2][2][2];
#pragma unroll
        for (int st = 0; st < 2; ++st)
#pragma unroll
            for (int ab = 0; ab < 2; ++ab) { kf[st][ab][0] = *(const bf16x8*)(Kb + (st * 32 + ab * 4) * 512 + lane_k); kf[st][ab][1] = *(const bf16x8*)(Kb + (st * 32 + ab * 4) * 512 + 32 + lane_k); }
#pragma unroll 1
        for (int i = 0; i < 8; ++i) {
            bf16x8 vf[2][4];
#pragma unroll
            for (int st = 0; st < 2; ++st)
#pragma unroll
                for (int d = 0; d < 4; ++d) vf[st][d] = *(const bf16x8*)(Vt + i * 4096 + d * 1024 + st * 32 + lane_v);
            const LAS float* rr_ = rph + i * RPB_LD;
#pragma unroll
            for (int half = 0; half < 2; ++half) {
                f32x4 s[2][2][2];
#pragma unroll
                for (int q2 = 0; q2 < 2; ++q2) {
                    const int qt = half * 2 + q2;
#pragma unroll
                    for (int st = 0; st < 2; ++st) {
                        if ((st == 0 && qt == 3) || (st == 1 && qt == 0)) continue;
#pragma unroll
                        for (int ab = 0; ab < 2; ++ab) {
                            f32x4 c = {0.f, 0.f, 0.f, 0.f};
                            c = __builtin_amdgcn_mfma_f32_16x16x32_bf16(kf[st][ab][0], qf[qt][0], c, 0, 0, 0);
                            c = __builtin_amdgcn_mfma_f32_16x16x32_bf16(kf[st][ab][1], qf[qt][1], c, 0, 0, 0);
                            s[q2][st][ab] = c;
                        }
                    }
                }
                if (half == 1) {
                    if (i < 7) {
#pragma unroll
                        for (int st = 0; st < 2; ++st)
#pragma unroll
                            for (int ab = 0; ab < 2; ++ab) { const bf16_t* kp = Kb + ((i + 1) * GW + st * 32 + ab * 4) * 512; kf[st][ab][0] = *(const bf16x8*)(kp + lane_k); kf[st][ab][1] = *(const bf16x8*)(kp + 32 + lane_k); }
                    } else {
#pragma unroll
                        for (int ab = 0; ab < 2; ++ab) { kf[0][ab][0] = *(const bf16x8*)(Kc + ab * 4 * 512 + lane_k); kf[0][ab][1] = *(const bf16x8*)(Kc + ab * 4 * 512 + 32 + lane_k); }
                    }
                }
#pragma unroll
                for (int q2 = 0; q2 < 2; ++q2) {
                    const int qt = half * 2 + q2;
                    const int qc = qt * 16 + lt; int c0 = qc - 8; c0 = c0 < 0 ? 0 : (c0 > 48 ? 48 : c0);
                    int wo = lq * 8 - c0; asm volatile("" : "+v"(wo));
                    float mx = -1e30f;
#pragma unroll
                    for (int st = 0; st < 2; ++st) {
                        if ((st == 0 && qt == 3) || (st == 1 && qt == 0)) continue;
                        const int kc0 = st * 32 + lq * 8, bbase = kc0 - qc + 15 + RPB_PAD;
#pragma unroll
                        for (int j = 0; j < 8; ++j) {
                            float t = s[q2][st][j >> 2][j & 3] * CS + rr_[bbase + j];
                            t = ((unsigned)(wo + st * 32 + j) < 16u) ? t : -1e30f;
                            s[q2][st][j >> 2][j & 3] = t; mx = fmaxf(mx, t);
                        }
                    }
                    mx = fmaxf(mx, __shfl_xor(mx, 16)); mx = fmaxf(mx, __shfl_xor(mx, 32));
                    const float mn = fmaxf(m[qt], mx), corr = __builtin_amdgcn_exp2f(m[qt] - mn);
                    m[qt] = mn; float ls = l[qt] * corr;
#pragma unroll
                    for (int d = 0; d < 4; ++d) o[qt][d] = o[qt][d] * corr;
#pragma unroll
                    for (int st = 0; st < 2; ++st) {
                        if ((st == 0 && qt == 3) || (st == 1 && qt == 0)) continue;
                        float pe[8];
#pragma unroll
                        for (int j = 0; j < 8; ++j) pe[j] = __builtin_amdgcn_exp2f(s[q2][st][j >> 2][j & 3] - mn);
                        ls += ((pe[0] + pe[1]) + (pe[2] + pe[3])) + ((pe[4] + pe[5]) + (pe[6] + pe[7]));
                        u32x4 pw; pw[0] = pg8::cvt_pk_bf16(pe[0], pe[1]); pw[1] = pg8::cvt_pk_bf16(pe[2], pe[3]); pw[2] = pg8::cvt_pk_bf16(pe[4], pe[5]); pw[3] = pg8::cvt_pk_bf16(pe[6], pe[7]);
                        const bf16x8 pf = __builtin_bit_cast(bf16x8, pw);
#pragma unroll
                        for (int d = 0; d < 4; ++d) o[qt][d] = __builtin_amdgcn_mfma_f32_16x16x32_bf16(vf[st][d], pf, o[qt][d], 0, 0, 0);
                    }
                    l[qt] = ls;
                }
            }
        }
#pragma unroll 1
        for (int cst = 0; cst < 8; ++cst) {
            bf16x8 vf[4];
#pragma unroll
            for (int d = 0; d < 4; ++d) vf[d] = *(const bf16x8*)(Vc + (cst >> 1) * 4096 + d * 1024 + (cst & 1) * 32 + lane_v);
            f32x4 s[4][2];
#pragma unroll
            for (int qt = 0; qt < 4; ++qt)
#pragma unroll
                for (int ab = 0; ab < 2; ++ab) {
                    f32x4 c = {0.f, 0.f, 0.f, 0.f};
                    c = __builtin_amdgcn_mfma_f32_16x16x32_bf16(kf[0][ab][0], qf[qt][0], c, 0, 0, 0);
                    c = __builtin_amdgcn_mfma_f32_16x16x32_bf16(kf[0][ab][1], qf[qt][1], c, 0, 0, 0);
                    s[qt][ab] = c;
                }
            if (cst < 7) {
#pragma unroll
                for (int ab = 0; ab < 2; ++ab) { const bf16_t* kp = Kc + ((cst + 1) * 32 + ab * 4) * 512; kf[0][ab][0] = *(const bf16x8*)(kp + lane_k); kf[0][ab][1] = *(const bf16x8*)(kp + 32 + lane_k); }
            }
#pragma unroll
            for (int qt = 0; qt < 4; ++qt) {
                float mx = -1e30f;
#pragma unroll
                for (int j = 0; j < 8; ++j) { const float t = s[qt][j >> 2][j & 3] * CS; s[qt][j >> 2][j & 3] = t; mx = fmaxf(mx, t); }
                mx = fmaxf(mx, __shfl_xor(mx, 16)); mx = fmaxf(mx, __shfl_xor(mx, 32));
                const float mn = fmaxf(m[qt], mx), corr = __builtin_amdgcn_exp2f(m[qt] - mn);
                m[qt] = mn;
#pragma unroll
                for (int d = 0; d < 4; ++d) o[qt][d] = o[qt][d] * corr;
                float pe[8];
#pragma unroll
                for (int j = 0; j < 8; ++j) pe[j] = __builtin_amdgcn_exp2f(s[qt][j >> 2][j & 3] - mn);
                l[qt] = l[qt] * corr + (((pe[0] + pe[1]) + (pe[2] + pe[3])) + ((pe[4] + pe[5]) + (pe[6] + pe[7])));
                u32x4 pw; pw[0] = pg8::cvt_pk_bf16(pe[0], pe[1]); pw[1] = pg8::cvt_pk_bf16(pe[2], pe[3]); pw[2] = pg8::cvt_pk_bf16(pe[4], pe[5]); pw[3] = pg8::cvt_pk_bf16(pe[6], pe[7]);
                const bf16x8 pf = __builtin_bit_cast(bf16x8, pw);
#pragma unroll
                for (int d = 0; d < 4; ++d) o[qt][d] = __builtin_amdgcn_mfma_f32_16x16x32_bf16(vf[d], pf, o[qt][d], 0, 0, 0);
            }
        }
#pragma unroll
        for (int qt = 0; qt < 4; ++qt) {
            float lv = l[qt]; lv += __shfl_xor(lv, 16); lv += __shfl_xor(lv, 32);
            const float inv = 1.f / lv;
            bf16_t* op = Ob + qt * 16 * 512 + lane_o;
#pragma unroll
            for (int d = 0; d < 4; ++d) { u32x2 w; w[0] = pg8::cvt_pk_bf16(o[qt][d][0] * inv, o[qt][d][1] * inv); w[1] = pg8::cvt_pk_bf16(o[qt][d][2] * inv, o[qt][d][3] * inv); *(u32x2*)(op + d * 16) = w; }
        }
    }
}

typedef __bf16 bf16x2_t __attribute__((ext_vector_type(2)));
__device__ __forceinline__ float dot2bf(unsigned a, unsigned b, float c) { return __builtin_amdgcn_fdot2_f32_bf16(__builtin_bit_cast(bf16x2_t, a), __builtin_bit_cast(bf16x2_t, b), c, false); }
__device__ __forceinline__ unsigned ordkey(float f) { unsigned u = __builtin_bit_cast(unsigned, f); return u ^ ((unsigned)((int)u >> 31) | 0x80000000u); }
__device__ __forceinline__ float unordkey(unsigned k) { return __builtin_bit_cast(float, k ^ ((k & 0x80000000u) ? 0x80000000u : 0xFFFFFFFFu)); }
template <bool DESC> __device__ __forceinline__ void cex(unsigned& a, unsigned& b) { const unsigned mx = a > b ? a : b, mn = a > b ? b : a; if (DESC) { a = mx; b = mn; } else { a = mn; b = mx; } }
__device__ __forceinline__ void sort16_desc(unsigned (&a)[16]) {
#pragma unroll
    for (int k = 2; k <= 16; k <<= 1)
#pragma unroll
        for (int j = k >> 1; j > 0; j >>= 1)
#pragma unroll
            for (int i = 0; i < 16; ++i) { const int l = i ^ j; if (l > i) { if ((i & k) == 0) cex<true>(a[i], a[l]); else cex<false>(a[i], a[l]); } }
}
__device__ __forceinline__ void merge16_desc(unsigned (&a)[16]) {
#pragma unroll
    for (int j = 8; j > 0; j >>= 1)
#pragma unroll
        for (int i = 0; i < 16; ++i) { const int l = i ^ j; if (l > i) cex<true>(a[i], a[l]); }
}
__device__ __forceinline__ void top16_merge(unsigned (&a)[16], const unsigned (&b)[16]) {
#pragma unroll
    for (int i = 0; i < 16; ++i) a[i] = a[i] > b[15 - i] ? a[i] : b[15 - i];
    merge16_desc(a);
}
struct PairTab { int i[52], j[52], n; };
constexpr PairTab make_pairs() { PairTab t{}; int n = 0; for (int i = 0; i < 16; ++i) for (int j = 0; j < 16; ++j) if ((i + 1) * (j + 1) <= 16) { t.i[n] = i; t.j[n] = j; ++n; } t.n = n; for (int k = n; k < 52; ++k) { t.i[k] = 0; t.j[k] = 0; } return t; }
constexpr PairTab PAIRS = make_pairs();
static_assert(PAIRS.n == 50, "50 candidate pairs");

constexpr int SK_LD = 136;
__device__ __forceinline__ void ph_peer_topk(const P& p, LAS unsigned char* lds) {
    int tid_ = threadIdx.x; asm volatile("" : "+v"(tid_));
    const int tid = tid_, wave = tid >> 6, lane = tid & 63;
    LAS bf16_t* sk = (LAS bf16_t*)lds;
    for (int e = tid; e < 2 * 128 * 16; e += NT) {
        const int row = e >> 4, c8 = (e & 15) * 8;
        const f32x4 a = *(const f32x4*)(p.subkeys + (size_t)row * 128 + c8), b = *(const f32x4*)(p.subkeys + (size_t)row * 128 + c8 + 4);
        u32x4 o; o.x = pk2(a[0], a[1]); o.y = pk2(a[2], a[3]); o.z = pk2(b[0], b[1]); o.w = pk2(b[2], b[3]);
        *(LAS u32x4*)(sk + row * SK_LD + c8) = o;
    }
    __syncthreads();
    const int lt = lane & 15, lq = lane >> 4;
    for (int tile = blockIdx.x * NWAVES + wave; tile < NTOK / 16; tile += gridDim.x * NWAVES) {
        const int tok = tile * 16 + lt;
        const bf16_t* qrow = p.qp() + (size_t)tok * 2048;
        for (int h = 0; h < 8; ++h) {
            unsigned s0[16], s1[16];
#pragma unroll
            for (int n = 0; n < 2; ++n) {
                bf16x8 bq[4];
#pragma unroll
                for (int ks = 0; ks < 4; ++ks) bq[ks] = *(const bf16x8*)(qrow + h * 256 + n * 128 + ks * 32 + lq * 8);
                unsigned a[16], b[16];
#pragma unroll
                for (int kb = 0; kb < 8; ++kb) {
                    f32x4 c = {0.f, 0.f, 0.f, 0.f};
#pragma unroll
                    for (int ks = 0; ks < 4; ++ks) {
                        const bf16x8 ak = *(const LAS bf16x8*)(sk + (n * 128 + kb * 16 + lt) * SK_LD + ks * 32 + lq * 8);
                        c = __builtin_amdgcn_mfma_f32_16x16x32_bf16(ak, bq[ks], c, 0, 0, 0);
                    }
#pragma unroll
                    for (int r = 0; r < 4; ++r) {
                        const unsigned key = (ordkey(c[r]) & ~127u) | (unsigned)(kb * 16 + lq * 4 + r);
                        if (kb < 4) a[kb * 4 + r] = key; else b[(kb - 4) * 4 + r] = key;
                    }
                    asm volatile("" ::: "memory");
                }
                sort16_desc(a); sort16_desc(b);
                top16_merge(a, b);
#pragma unroll
                for (int i = 0; i < 16; ++i) b[i] = __shfl_xor(a[i], 16);
                top16_merge(a, b);
#pragma unroll
                for (int i = 0; i < 16; ++i) b[i] = __shfl_xor(a[i], 32);
                top16_merge(a, b);
                if (n == 0) {
#pragma unroll
                    for (int i = 0; i < 16; ++i) s0[i] = a[i];
                } else {
#pragma unroll
                    for (int i = 0; i < 16; ++i) s1[i] = a[i];
                }
            }
            unsigned ck[16], ce_[13]; float cs[13];
#pragma unroll
            for (int s = 0; s < 13; ++s) {
                const unsigned k0 = lq == 0 ? s0[PAIRS.i[s * 4]] : (lq == 1 ? s0[PAIRS.i[s * 4 + 1]] : (lq == 2 ? s0[PAIRS.i[s * 4 + 2]] : s0[PAIRS.i[s * 4 + 3]]));
                const unsigned k1 = lq == 0 ? s1[PAIRS.j[s * 4]] : (lq == 1 ? s1[PAIRS.j[s * 4 + 1]] : (lq == 2 ? s1[PAIRS.j[s * 4 + 2]] : s1[PAIRS.j[s * 4 + 3]]));
                const float sum = unordkey(k0 & ~127u) + unordkey(k1 & ~127u);
                const bool valid = (s * 4 + lq) < PAIRS.n;
                cs[s] = sum; ce_[s] = (k0 & 127u) * 128u + (k1 & 127u);
                ck[s] = valid ? ((ordkey(sum) & ~63u) | (unsigned)(s * 4 + lq)) : 0u;
            }
            ck[13] = 0u; ck[14] = 0u; ck[15] = 0u;
            unsigned srt[16], ob[16];
#pragma unroll
            for (int i = 0; i < 16; ++i) srt[i] = ck[i];
            sort16_desc(srt);
#pragma unroll
            for (int i = 0; i < 16; ++i) ob[i] = __shfl_xor(srt[i], 16);
            top16_merge(srt, ob);
#pragma unroll
            for (int i = 0; i < 16; ++i) ob[i] = __shfl_xor(srt[i], 32);
            unsigned thr = 0xFFFFFFFFu;
#pragma unroll
            for (int i = 0; i < 16; ++i) { const unsigned v = srt[i] > ob[15 - i] ? srt[i] : ob[15 - i]; thr = v < thr ? v : thr; }
            const float mtop = unordkey(s0[0] & ~127u) + unordkey(s1[0] & ~127u);
            float zp = 0.f; int cnt = 0;
#pragma unroll
            for (int s = 0; s < 13; ++s) { const bool sel = ck[s] >= thr && ck[s] != 0u; const float e = sel ? __expf(cs[s] - mtop) : 0.f; cs[s] = e; zp += e; cnt += sel ? 1 : 0; }
            float z = zp; z += __shfl_xor(z, 16); z += __shfl_xor(z, 32);
            const float rz = 1.f / z;
            const int c0 = __shfl(cnt, lt), c1 = __shfl(cnt, lt + 16), c2 = __shfl(cnt, lt + 32);
            int pos = lq == 0 ? 0 : (lq == 1 ? c0 : (lq == 2 ? c0 + c1 : c0 + c1 + c2));
            u32x2* dst = (u32x2*)p.topk() + ((size_t)tok * 8 + h) * 16;
#pragma unroll
            for (int s = 0; s < 13; ++s) {
                const bool sel = ck[s] >= thr && ck[s] != 0u;
                if (sel) { u32x2 o; o.x = ce_[s]; o.y = __builtin_bit_cast(unsigned, cs[s] * rz); dst[pos] = o; ++pos; }
            }
        }
    }
}

__device__ __forceinline__ void ph_peer_gather(const P& p) {
    int tid_ = threadIdx.x; asm volatile("" : "+v"(tid_));
    const int wave = __builtin_amdgcn_readfirstlane(tid_ >> 6), lane = tid_ & 63;
    const float* isc = p.pisc();
    for (int tok = blockIdx.x * NWAVES + wave; tok < NTOK; tok += gridDim.x * NWAVES) {
        const int b = tok >> 12;
        const float* modb = p.mod() + (size_t)b * (6 * DM);
        float acc[16], hv[16];
        const float rstd2 = rsqrtf(p.rowss()[tok] * (1.f / DM) + EPSN);
#pragma unroll
        for (int j = 0; j < 4; ++j) {
            const int e0 = lane * 16 + j * 4;
            const f32x4 xv = *(const f32x4*)(p.out + (size_t)tok * DM + e0), gg = *(const f32x4*)(p.norm2_g + e0), sh = *(const f32x4*)(modb + 3 * DM + e0), sc = *(const f32x4*)(modb + 4 * DM + e0);
            const f32x4 h4 = xv * rstd2 * gg * (sc + 1.f) + sh;
#pragma unroll
            for (int i = 0; i < 4; ++i) { hv[j * 4 + i] = h4[i]; acc[j * 4 + i] = 0.f; }
        }
        const u32x2* tk = (const u32x2*)p.topk() + (size_t)tok * 128;
        const u32x2 ent0 = tk[lane], ent1 = tk[lane + 64];
        const unsigned e0x = ent0[0], e0y = ent0[1], e1x = ent1[0], e1y = ent1[1];
        const float isu0 = isc[e0x], isu1 = isc[e1x];
        const float gsv0 = __builtin_bit_cast(float, e0y) * isc[16384 + e0x], gsv1 = __builtin_bit_cast(float, e1y) * isc[16384 + e1x];
#pragma unroll 1
        for (int k0 = 0; k0 < 128; k0 += 8) {
            u32x4 uu[8], vv[8];
            const unsigned ex = k0 < 64 ? e0x : e1x, gxs = __builtin_bit_cast(unsigned, k0 < 64 ? gsv0 : gsv1), sxs = __builtin_bit_cast(unsigned, k0 < 64 ? isu0 : isu1);
#pragma unroll
            for (int i = 0; i < 8; ++i) {
                const unsigned e = __builtin_amdgcn_readlane(ex, (k0 + i) & 63);
                uu[i] = *(const u32x4*)(p.pu8() + (size_t)e * DM + lane * 16);
                vv[i] = *(const u32x4*)(p.pv8() + (size_t)e * DM + lane * 16);
            }
            float pd[8];
#pragma unroll
            for (int i = 0; i < 8; ++i) {
                float d = 0.f;
#pragma unroll
                for (int j = 0; j < 4; ++j) {
                    const int w = (int)uu[i][j];
                    const f32x2 lo = __builtin_amdgcn_cvt_pk_f32_fp8(w, false), hi = __builtin_amdgcn_cvt_pk_f32_fp8(w, true);
                    d += lo[0] * hv[j * 4] + lo[1] * hv[j * 4 + 1] + hi[0] * hv[j * 4 + 2] + hi[1] * hv[j * 4 + 3];
                }
                pd[i] = d;
            }
            float r4[4], r2[2], r1;
            { const bool hi = lane & 32;
#pragma unroll
              for (int i = 0; i < 4; ++i) { const float keep = hi ? pd[i + 4] : pd[i], send = hi ? pd[i] : pd[i + 4]; r4[i] = keep + __shfl_xor(send, 32); } }
            { const bool hi = lane & 16;
#pragma unroll
              for (int i = 0; i < 2; ++i) { const float keep = hi ? r4[i + 2] : r4[i], send = hi ? r4[i] : r4[i + 2]; r2[i] = keep + __shfl_xor(send, 16); } }
            { const bool hi = lane & 8; const float keep = hi ? r2[1] : r2[0], send = hi ? r2[0] : r2[1]; r1 = keep + __shfl_xor(send, 8); }
            r1 += __shfl_xor(r1, 4); r1 += __shfl_xor(r1, 2); r1 += __shfl_xor(r1, 1);
#pragma unroll
            for (int i = 0; i < 8; ++i) {
                const float sui = __builtin_bit_cast(float, __builtin_amdgcn_readlane(sxs, (k0 + i) & 63)), gki = __builtin_bit_cast(float, __builtin_amdgcn_readlane(gxs, (k0 + i) & 63));
                const float a = sui * __builtin_bit_cast(float, __builtin_amdgcn_readlane(__builtin_bit_cast(unsigned, r1), ((i >> 2) & 1) * 32 + ((i >> 1) & 1) * 16 + (i & 1) * 8));
                const float w = gki * gelu_tanh(a);
#pragma unroll
                for (int j = 0; j < 4; ++j) {
                    const int wv = (int)vv[i][j];
                    const f32x2 lo = __builtin_amdgcn_cvt_pk_f32_fp8(wv, false), hi = __builtin_amdgcn_cvt_pk_f32_fp8(wv, true);
                    acc[j * 4] += w * lo[0]; acc[j * 4 + 1] += w * lo[1]; acc[j * 4 + 2] += w * hi[0]; acc[j * 4 + 3] += w * hi[1];
                }
            }
        }
        float ss = 0.f; float x2[16];
#pragma unroll
        for (int j = 0; j < 4; ++j) {
            const int e0 = lane * 16 + j * 4;
            const f32x4 g2 = *(const f32x4*)(modb + 5 * DM + e0), xv = *(const f32x4*)(p.out + (size_t)tok * DM + e0);
#pragma unroll
            for (int i = 0; i < 4; ++i) { const int ix = j * 4 + i; x2[ix] = xv[i] + g2[i] * acc[ix]; ss += x2[ix] * x2[ix]; }
        }
        ss = wave_sum(ss);
        const float rstd = rsqrtf(ss * (1.f / DM) + EPSN);
#pragma unroll
        for (int j = 0; j < 4; ++j) {
            const int e0 = lane * 16 + j * 4;
            const f32x4 fg = *(const f32x4*)(p.final_g + e0);
            f32x4 o;
#pragma unroll
            for (int i = 0; i < 4; ++i) o[i] = x2[j * 4 + i] * rstd * fg[i];
            *(f32x4*)(p.out + (size_t)tok * DM + e0) = o;
        }
    }
}

#define XB_TMO      128
#define XB_XCNT(j)  (256  + 64 * (j))
#define XB_XSUB(j)  (1280 + 64 * (j))
#define XB_XGEN(j)  (2304 + 64 * (j))
#define XB_TOP      3328
#define XB_TOPGEN   3392
#define XCD_BAR_WORDS 3456
#define XB_SPIN_CAP (1u << 18)
__device__ __forceinline__ unsigned xb_ld(unsigned* p)              { return __hip_atomic_load(p, __ATOMIC_RELAXED, __HIP_MEMORY_SCOPE_AGENT); }
__device__ __forceinline__ unsigned xb_add(unsigned* p, unsigned v) { return __hip_atomic_fetch_add(p, v, __ATOMIC_RELAXED, __HIP_MEMORY_SCOPE_AGENT); }
__device__ __forceinline__ unsigned xb_xcc_id() { return (unsigned)__builtin_amdgcn_s_getreg((3 << 11) | 20) & 0xFu; }
#define XB_SPIN(cond, bar) do { unsigned _sp = 0; while (cond) { __builtin_amdgcn_s_sleep(1); \
    if ((++_sp & 255u) == 0u) { if (xb_ld(&(bar)[XB_TMO])) break; if (_sp > XB_SPIN_CAP) { atomicAdd(&(bar)[XB_TMO], 1u); break; } } } } while (0)
struct XcdBarrier { unsigned* bar; unsigned x; volatile LAS unsigned* st; };
__device__ __forceinline__ XcdBarrier xcd_barrier_post(unsigned* bar, volatile LAS unsigned* st) {
    XcdBarrier b; b.bar = bar; b.x = xb_xcc_id(); b.st = st;
    if (threadIdx.x == 0) (void)xb_add(&bar[XB_XCNT(b.x)], 1u);
    return b;
}
__device__ __forceinline__ void xcd_barrier_complete(unsigned* bar, unsigned x, unsigned& nloc, unsigned& nx) {
    const unsigned G = gridDim.x * gridDim.y * gridDim.z;
    unsigned sum, cnt, mine, sp = 0u;
    for (;;) {
        sum = 0u; cnt = 0u; mine = 0u;
#pragma unroll
        for (unsigned j = 0; j < 16; ++j) { const unsigned c = xb_ld(&bar[XB_XCNT(j)]); sum += c; cnt += (c > 0u) ? 1u : 0u; mine = (j == x) ? c : mine; }
        if (sum == G) break;
        __builtin_amdgcn_s_sleep(1);
        if ((++sp & 255u) == 0u) { if (xb_ld(&bar[XB_TMO])) break; if (sp > XB_SPIN_CAP) { atomicAdd(&bar[XB_TMO], 1u); break; } }
    }
    nloc = mine > 0u ? mine : 1u; nx = cnt > 0u ? cnt : 1u;
}
__device__ __forceinline__ void xcd_barrier(const XcdBarrier& b) {
    asm volatile("s_waitcnt vmcnt(0)" ::: "memory");
    __syncthreads();
    if (threadIdx.x == 0) {
        unsigned* bar = b.bar;
        __builtin_amdgcn_s_waitcnt(0);
        unsigned nloc = b.st[0], nx = b.st[1];
        if (nloc == 0u) { xcd_barrier_complete(bar, b.x, nloc, nx); b.st[0] = nloc; b.st[1] = nx; }
        const unsigned old = xb_add(&bar[XB_XSUB(b.x)], 1u);
        const unsigned gen = old / nloc;
        if (old + 1u == (gen + 1u) * nloc) {
            __builtin_amdgcn_fence(__ATOMIC_RELEASE, "agent");
            asm volatile("s_waitcnt vmcnt(0)" ::: "memory");
            const unsigned og = xb_add(&bar[XB_TOP], 1u);
            const unsigned tg = og / nx;
            if (og + 1u == (tg + 1u) * nx) xb_add(&bar[XB_TOPGEN], 1u);
            else XB_SPIN(xb_ld(&bar[XB_TOPGEN]) == tg, bar);
            __builtin_amdgcn_fence(__ATOMIC_ACQUIRE, "agent");
            xb_add(&bar[XB_XGEN(b.x)], 1u);
            asm volatile("s_waitcnt vmcnt(0)" ::: "memory");
        } else {
            XB_SPIN(xb_ld(&bar[XB_XGEN(b.x)]) == gen, bar);
            __builtin_amdgcn_fence(__ATOMIC_ACQUIRE, "agent");
            asm volatile("s_waitcnt vmcnt(0)" ::: "memory");
        }
    }
    __syncthreads();
}

constexpr int LDS_BYTES = 147456;
#define GSYNC() xcd_barrier(xbar)
constexpr int MISC_OFF = LDS_BYTES - 64;

__global__ void __launch_bounds__(NT, 2) mega(P p) {
    extern __shared__ __attribute__((aligned(16))) unsigned char lds_raw[];
    LAS unsigned char* lds = (LAS unsigned char*)lds_raw;
    const int G = gridDim.x, bx = blockIdx.x;
    using namespace pg8;
    if (threadIdx.x < 16) ((LAS unsigned*)(lds + MISC_OFF))[threadIdx.x] = 0u;
    __syncthreads();
    const XcdBarrier xbar = xcd_barrier_post((unsigned*)p.ws, (volatile LAS unsigned*)(lds + MISC_OFF));

    ph_prep(p, lds);
    cg::this_grid().sync();
    ph_norm1(p, lds);
    GSYNC();
    {
        Gemm<DM, DM, DM> g{p.hx(), p.w_in_t()}; StaticOrder<NTOK, INC> S; S.init(G, bx);
        EpiInProj E{p.U(), p.kb(), (size_t)(p.qb() - p.kb()), p.vT(), p.ga(), 0};
        gemm_phase<EpiInProj, StaticOrder<NTOK, INC>, true, true>(lds, g, S, E);
        Gemm<DM, DM, DM> g2{p.hc(), p.w_in_t()}; StaticOrder<NCTX, CTXC> S2; S2.init(G, bx);
        EpiInProj E2{p.U(), p.kc(), 0, p.vcT(), p.ga(), 1};
        gemm_phase<EpiInProj, StaticOrder<NCTX, CTXC>, true, true>(lds, g2, S2, E2);
    }
    GSYNC();
    {
        Gemm<512, SSM_LD, 512, (long)SSM_ROWS * SSM_LD, 256L * 512> g{p.U(), p.Win()}; StaticOrder<SSM_ROWS, 256, 32> S; S.init(G, bx);
        EpiE E{p.E()};
        gemm_phase<EpiE, StaticOrder<SSM_ROWS, 256, 32>, true, true>(lds, g, S, E);
    }
    GSYNC();
    ph_carry(p);
    ph_na(p, lds);
    GSYNC();
    {
        Gemm<SSM_LD, SSM_LD, SSM_LD, (long)SSM_ROWS * SSM_LD, 512L * SSM_LD> g{p.U(), p.Kmat()}; StaticOrder<1024, 512, 32> S; S.init(G, bx);
        EpiZ E{p.z()};
        gemm_phase<EpiZ, StaticOrder<1024, 512, 32>, true, true>(lds, g, S, E);
    }
    GSYNC();
    {
        Gemm<512, 512, 512> g{p.z(), p.w_glu_t()}; StaticOrder<NTOK, 512> S; S.init(G, bx);
        EpiGlu E{p.gl(), p.z(), p.b_glu};
        gemm_phase<EpiGlu, StaticOrder<NTOK, 512>, true, true>(lds, g, S, E);
    }
    GSYNC();
    {
        Gemm<512, 512, 512> g{p.gl(), p.w_a_t()}; StaticOrder<NTOK, DM> S; S.init(G, bx);
        EpiBrA E{p.tbuf(), p.ga()};
        gemm_phase<EpiBrA, StaticOrder<NTOK, DM>, true, true>(lds, g, S, E);
        Gemm<512, 512, 512> g2{p.na(), p.w_b_t()};
        EpiBrB E2{p.merged(), p.tbuf(), p.gb()};
        gemm_phase<EpiBrB, StaticOrder<NTOK, DM>, true, true>(lds, g2, S, E2);
    }
    GSYNC();
    {
        Gemm<DM, DM, DM> g{p.merged(), p.w_out_t()}; StaticOrder<NTOK, DM> S; S.init(G, bx);
        EpiOut E{p.x, p.out, p.x1g(), p.mod(), p.norm2_g, p.rowss()};
        gemm_phase<EpiOut, StaticOrder<NTOK, DM>, true, true>(lds, g, S, E);
    }
    GSYNC();
    {
        Gemm<DM, DM, DM> g{p.x1g(), p.w_q_t()}; StaticOrder<NTOK, 2048> S; S.init(G, bx);
        EpiQ E{p.qp(), p.rowss(), p.c2()};
        gemm_phase<EpiQ, StaticOrder<NTOK, 2048>, true, true>(lds, g, S, E);
    }
    GSYNC();
    ph_peer_topk(p, lds);
    GSYNC();
    ph_peer_gather(p);
}

extern "C" void kernel_launch(void* const* d_in, const int* in_sizes, int n_in, void* d_out, int out_size, void* d_ws, size_t ws_size, hipStream_t stream) {
    static int grid = 0;
    if (grid == 0) {
        int dev = 0, cus = 0, per_cu = 0;
        (void)hipGetDevice(&dev);
        (void)hipDeviceGetAttribute(&cus, hipDeviceAttributeMultiprocessorCount, dev);
        (void)hipFuncSetAttribute((const void*)mega, hipFuncAttributeMaxDynamicSharedMemorySize, LDS_BYTES);
        (void)hipOccupancyMaxActiveBlocksPerMultiprocessor(&per_cu, (const void*)mega, NT, LDS_BYTES);
        if (per_cu < 1) { fprintf(stderr, "occupancy query says %d blocks per CU\n", per_cu); per_cu = 1; }
        grid = cus;
    }
    P p{};
    const float* const* in = (const float* const*)d_in;
    p.x = in[0]; p.c = in[1]; p.ctx = in[2]; p.c_ctx = in[3]; p.w_mod = in[4]; p.b_mod = in[5]; p.norm1_g = in[6]; p.norm2_g = in[7]; p.w_in = in[8];
    p.a_re = in[9]; p.a_im = in[10]; p.log_dt = in[11]; p.b_re = in[12]; p.b_im = in[13]; p.c_re = in[14]; p.c_im = in[15]; p.ssm_d = in[16];
    p.w_glu = in[17]; p.b_glu = in[18]; p.w_a = in[19]; p.w_b = in[20]; p.rpb = in[21]; p.w_out = in[22]; p.w_q = in[23]; p.subkeys = in[24];
    p.peer_u = in[25]; p.peer_v = in[26]; p.final_g = in[27];
    p.out = (float*)d_out;
    p.ws = (unsigned char*)d_ws;
    (void)hipMemsetAsync(d_ws, 0, 1 * MiB, stream);
    void* args[] = {&p};
    hipError_t e = hipLaunchCooperativeKernel((const void*)mega, dim3(grid), dim3(NT), args, LDS_BYTES, stream);
    if (e != hipSuccess) fprintf(stderr, "cooperative launch failed: %s (grid %d)\n", hipGetErrorString(e), grid);
}
```

```cpp
#include <hip/hip_runtime.h>
#include <hip/hip_cooperative_groups.h>
#include <cstdio>
#include <cstdint>
namespace cg = cooperative_groups;

#define LAS __attribute__((address_space(3)))
typedef unsigned short bf16_t;
typedef short bf16x8 __attribute__((ext_vector_type(8)));
typedef float f32x4 __attribute__((ext_vector_type(4)));
typedef float f32x2 __attribute__((ext_vector_type(2)));
typedef unsigned u32x4 __attribute__((ext_vector_type(4)));
typedef unsigned u32x2 __attribute__((ext_vector_type(2)));

constexpr int DM = 1024, NB = 8, SEQL = 4096, CTXL = 256, GW = 64, NTOK = NB * SEQL, NCTX = NB * CTXL;
constexpr int INC = 4096, CTXC = 1536;
constexpr int NT = 512, NWAVES = 8;
constexpr float EPSN = 1e-6f;
constexpr int SSM_ROWS = 1280;
constexpr int SSM_LD = 768;

__device__ __forceinline__ unsigned f2bf(float f) { unsigned u = __builtin_bit_cast(unsigned, f); return (u + 0x7fffu + ((u >> 16) & 1u)) >> 16; }
__device__ __forceinline__ unsigned pk2(float lo, float hi) { return f2bf(lo) | (f2bf(hi) << 16); }
__device__ __forceinline__ float bflo(unsigned w) { return __builtin_bit_cast(float, w << 16); }
__device__ __forceinline__ float bfhi(unsigned w) { return __builtin_bit_cast(float, w & 0xffff0000u); }
__device__ __forceinline__ float bf2f(bf16_t h) { return __builtin_bit_cast(float, (unsigned)h << 16); }

__device__ __forceinline__ float wave_sum(float v) {
#pragma unroll
    for (int o = 1; o < 64; o <<= 1) v += __shfl_xor(v, o);
    return v;
}
__device__ __forceinline__ float wave_max(float v) {
#pragma unroll
    for (int o = 1; o < 64; o <<= 1) v = fmaxf(v, __shfl_xor(v, o));
    return v;
}
__device__ __forceinline__ float sigmoidf_(float x) { return 1.f / (1.f + __expf(-x)); }
__device__ __forceinline__ float siluf_(float x) { return x / (1.f + __expf(-x)); }
__device__ __forceinline__ float gelu_tanh(float x) {
    const float k0 = 0.7978845608028654f, k1 = 0.044715f;
    const float u = k0 * (x + k1 * x * x * x);
    const float t = 1.f - 2.f / (1.f + __expf(2.f * u));
    return 0.5f * x * (1.f + t);
}

namespace pg8 {
#define PG8_LAS __attribute__((address_space(3)))
constexpr int BM = 256, BK = 64, HALF = 128, HTB = HALF * BK * 2  , STAGE_BYTES = 8 * HTB, NXCD = 8, WGM = 8;
__host__ __device__ __forceinline__ int lds_byte(int r, int c) { const int st = (r >> 4) * 2 + (c >> 5), rr = r & 15, cc = c & 31, ob = rr * 64 + cc * 2; return st * 1024 + (ob ^ (((ob >> 9) & 1) << 5)); }
__host__ __device__ __forceinline__ void stage_rc(int b, int& R, int& C) { const int st = b / 1024, sb = b % 1024, swz = sb ^ (((sb >> 9) & 1) << 5); R = (st >> 1) * 16 + swz / 64; C = (st & 1) * 32 + (swz % 64) / 2; }
__host__ __device__ __forceinline__ int perm32(int rho) { const int n = rho >> 4, i = rho & 15; return 8 * (i >> 2) + 4 * n + (i & 3); }

struct Unit { int pm, pn, g; };
template <int K_, int LDA, int LDB, long GSA = 0, long GSB = 0>
struct Gemm {
    const bf16_t* A; const bf16_t* Bt;
    static constexpr int K = K_, lda = LDA, ldb = LDB;
    __device__ __forceinline__ const char* abase(const Unit& u) const { return (const char*)(A + (size_t)u.g * GSA + (size_t)u.pm * BM * LDA); }
    __device__ __forceinline__ const char* bbase(const Unit& u) const { return (const char*)(Bt + (size_t)u.g * GSB + (size_t)u.pn * BM * LDB); }
};
template <int M, int N, int NGRP = 1>
struct StaticOrder {
    static constexpr int nM = M / BM, nN = N / BM, nwg = nM * nN;
    int G, c;
    __device__ void init(int G_, int c_) { G = G_; c = c_; }
    __device__ bool next(int i, Unit& u) const {
        const int L = i * G + c; if (L >= nwg * NGRP) return false;
        u.g = L / nwg;
        int wgid = L % nwg; { constexpr int q = nwg / NXCD, r = nwg % NXCD; const int xcd = wgid % NXCD, off = wgid / NXCD; wgid = (xcd < r ? xcd * (q + 1) : r * (q + 1) + (xcd - r) * q) + off; }
        constexpr int nig = WGM * nN; const int gid = wgid / nig, fm = gid * WGM, gsz = (nM - fm) < WGM ? (nM - fm) : WGM;
        u.pm = fm + ((wgid % nig) % gsz); u.pn = (wgid % nig) / gsz; return true;
    }
    __device__ __forceinline__ void a_ready(const Unit&) const {}
    __device__ __forceinline__ void done(const Unit&) const {}
};
__device__ __forceinline__ unsigned cvt_pk_bf16(float lo, float hi) { unsigned r; asm volatile("v_cvt_pk_bf16_f32 %0, %1, %2" : "=v"(r) : "v"(lo), "v"(hi)); return r; }
template <class Epi, class Sched, bool ALIGN_EPI = false, bool SP2 = false, class GemmT>
__device__ __forceinline__ void gemm_phase(PG8_LAS unsigned char* lds, const GemmT g, const Sched& S, const Epi& E) {
    int tid_ = threadIdx.x; asm volatile("" : "+v"(tid_));
    const int tid = tid_, wid = __builtin_amdgcn_readfirstlane(tid >> 6), lane = tid & 63, wr = wid >> 2, wc = wid & 3, fr = lane & 15, fq = lane >> 4;
    const int K = g.K, nt = K / BK;
    unsigned voffA[2], voffB[2];
#pragma unroll
    for (int i = 0; i < 2; ++i) { int R, C; stage_rc(tid * 16 + i * 8192, R, C); const int Rb = Epi::PERM ? ((R & ~31) + perm32(R & 31)) : R;
        voffA[i] = (unsigned)(R * g.lda + C) * 2u; voffB[i] = (unsigned)(Rb * g.ldb + C) * 2u; }
    const size_t kstep = (size_t)(BK * 2);
    const size_t hstepA = (size_t)HALF * g.lda * 2, hstepB = (size_t)HALF * g.ldb * 2;
    const unsigned ldsw = (unsigned)wid * 1024u;
    const int aoff = lds_byte(wr * 64 + fr, fq * 8), boff = lds_byte(wc * 32 + fr, fq * 8);
#define PG8_SA(b, h) (((b) * 2 + (h)) * HTB)
#define PG8_SB(b, h) ((4 + (b) * 2 + (h)) * HTB)
#define PG8_STAGE(bufoff, gbase, voff) do { _Pragma("unroll") for (int _i = 0; _i < 2; ++_i) \
        __builtin_amdgcn_global_load_lds((const unsigned*)((const char*)(gbase) + (voff)[_i]), (PG8_LAS unsigned*)(lds + (bufoff) + ldsw + _i * 8192), 16, 0, 0); } while (0)
#define PG8_LDA(dst, b, h) do { _Pragma("unroll") for (int m = 0; m < 4; ++m) _Pragma("unroll") for (int k = 0; k < 2; ++k) dst[m][k] = *(const PG8_LAS bf16x8*)(lds + PG8_SA(b, h) + aoff + m * 2048 + k * 1024); } while (0)
#define PG8_LDB(dst, b, h) do { _Pragma("unroll") for (int n = 0; n < 2; ++n) _Pragma("unroll") for (int k = 0; k < 2; ++k) dst[n][k] = *(const PG8_LAS bf16x8*)(lds + PG8_SB(b, h) + boff + n * 2048 + k * 1024); } while (0)
#define PG8_MMA(ai, bj, At, Bt) do { __builtin_amdgcn_s_setprio(1); _Pragma("unroll") for (int m = 0; m < 4; ++m) _Pragma("unroll") for (int n = 0; n < 2; ++n) _Pragma("unroll") for (int k = 0; k < 2; ++k) \
        acc[ai][bj][m][n] = __builtin_amdgcn_mfma_f32_16x16x32_bf16(Bt[n][k], At[m][k], acc[ai][bj][m][n], 0, 0, 0); __builtin_amdgcn_s_setprio(0); } while (0)
#define PG8_WAIT_V(n) asm volatile("s_waitcnt vmcnt(" #n ")" ::: "memory")
#define PG8_WAIT_L(n) asm volatile("s_waitcnt lgkmcnt(" #n ")" ::: "memory")
#define PG8_BAR __builtin_amdgcn_s_barrier()
#define PG8_SCHED __builtin_amdgcn_sched_barrier(0)
    Unit cur, nxt; int ui = 0;
    if (!S.next(0, cur)) return;
    f32x4 acc[2][2][4][2];
#pragma unroll
    for (int a = 0; a < 2; ++a)
#pragma unroll
        for (int b = 0; b < 2; ++b)
#pragma unroll
            for (int m = 0; m < 4; ++m)
#pragma unroll
                for (int n = 0; n < 2; ++n) acc[a][b][m][n] = (f32x4){0.f, 0.f, 0.f, 0.f};
    bf16x8 At[4][2], B0[2][2], B1[2][2];
    const char* cA = g.abase(cur); const char* cB = g.bbase(cur);
    S.a_ready(cur);
    if constexpr (SP2) {
        PG8_STAGE(PG8_SB(0, 0), cB, voffB); PG8_STAGE(PG8_SB(0, 1), cB + hstepB, voffB); PG8_STAGE(PG8_SA(0, 0), cA, voffA); PG8_STAGE(PG8_SA(0, 1), cA + hstepA, voffA);
        if (wr == 1) PG8_BAR;
        PG8_WAIT_V(2); PG8_BAR;
        PG8_STAGE(PG8_SB(1, 0), cB + kstep, voffB); PG8_STAGE(PG8_SA(1, 0), cA + kstep, voffA); PG8_STAGE(PG8_SB(1, 1), cB + hstepB + kstep, voffB);
        PG8_WAIT_V(6); PG8_BAR;
    } else {
        PG8_STAGE(PG8_SB(0, 0), cB, voffB); PG8_STAGE(PG8_SA(0, 0), cA, voffA); PG8_STAGE(PG8_SB(0, 1), cB + hstepB, voffB); PG8_STAGE(PG8_SA(0, 1), cA + hstepA, voffA);
        if (wr == 1) PG8_BAR;
        PG8_WAIT_V(4); PG8_BAR;
        PG8_STAGE(PG8_SB(1, 0), cB + kstep, voffB); PG8_STAGE(PG8_SA(1, 0), cA + kstep, voffA); PG8_STAGE(PG8_SB(1, 1), cB + hstepB + kstep, voffB);
        PG8_WAIT_V(6); PG8_BAR;
    }
    for (;;) {
        const bool has_next = S.next(ui + 1, nxt);
        const char* nA = has_next ? g.abase(nxt) : cA; const char* nB = has_next ? g.bbase(nxt) : cB;
        for (int t = 0; t < nt; t += 2) {
            const bool last = (t == nt - 2);
            const char* a1 = cA + (size_t)(t + 1) * kstep;
            const char* a2 = last ? nA : cA + (size_t)(t + 2) * kstep; const char* b2 = last ? nB : cB + (size_t)(t + 2) * kstep;
            const char* a3 = a2 + kstep; const char* b3 = b2 + kstep;
            if (last && has_next) S.a_ready(nxt);
            if constexpr (SP2) {
            PG8_LDB(B0, 0, 0); PG8_LDB(B1, 0, 1); PG8_SCHED; PG8_LDA(At, 0, 0); PG8_STAGE(PG8_SA(1, 1), a1 + hstepA, voffA);
            PG8_WAIT_V(8); PG8_WAIT_L(0); PG8_BAR; PG8_MMA(0, 0, At, B0); PG8_MMA(0, 1, At, B1); PG8_BAR; PG8_SCHED;
            PG8_LDA(At, 0, 1); PG8_STAGE(PG8_SB(0, 0), b2, voffB); PG8_STAGE(PG8_SB(0, 1), b2 + hstepB, voffB); PG8_STAGE(PG8_SA(0, 0), a2, voffA);
            PG8_WAIT_V(8); PG8_WAIT_L(0); PG8_BAR; PG8_MMA(1, 0, At, B0); PG8_MMA(1, 1, At, B1); PG8_BAR; PG8_SCHED;
            PG8_LDB(B0, 1, 0); PG8_LDB(B1, 1, 1); PG8_SCHED; PG8_LDA(At, 1, 0); PG8_STAGE(PG8_SA(0, 1), a2 + hstepA, voffA);
            PG8_WAIT_V(8); PG8_WAIT_L(0); PG8_BAR; PG8_MMA(0, 0, At, B0); PG8_MMA(0, 1, At, B1); PG8_BAR; PG8_SCHED;
            PG8_LDA(At, 1, 1); PG8_STAGE(PG8_SB(1, 0), b3, voffB); PG8_STAGE(PG8_SB(1, 1), b3 + hstepB, voffB); PG8_STAGE(PG8_SA(1, 0), a3, voffA);
            PG8_WAIT_V(8); PG8_WAIT_L(0); PG8_BAR; PG8_MMA(1, 0, At, B0); PG8_MMA(1, 1, At, B1); PG8_BAR; PG8_SCHED;
            } else {
            PG8_LDB(B0, 0, 0); PG8_SCHED; PG8_LDA(At, 0, 0); PG8_STAGE(PG8_SA(1, 1), a1 + hstepA, voffA);
            PG8_WAIT_L(8); PG8_BAR; PG8_WAIT_L(0); PG8_MMA(0, 0, At, B0); PG8_BAR; PG8_SCHED;
            PG8_LDB(B1, 0, 1); PG8_STAGE(PG8_SB(0, 0), b2, voffB);
            PG8_BAR; PG8_WAIT_L(0); PG8_MMA(0, 1, At, B1); PG8_BAR;
            PG8_LDA(At, 0, 1); PG8_STAGE(PG8_SA(0, 0), a2, voffA);
            PG8_BAR; PG8_WAIT_L(0); PG8_MMA(1, 0, At, B0); PG8_BAR; PG8_SCHED;
            PG8_STAGE(PG8_SB(0, 1), b2 + hstepB, voffB);
            PG8_WAIT_V(6); PG8_BAR; PG8_MMA(1, 1, At, B1); PG8_BAR;
            PG8_LDB(B0, 1, 0); PG8_SCHED; PG8_LDA(At, 1, 0); PG8_STAGE(PG8_SA(0, 1), a2 + hstepA, voffA);
            PG8_WAIT_L(8); PG8_BAR; PG8_WAIT_L(0); PG8_MMA(0, 0, At, B0); PG8_BAR; PG8_SCHED;
            PG8_LDB(B1, 1, 1); PG8_STAGE(PG8_SB(1, 0), b3, voffB);
            PG8_BAR; PG8_WAIT_L(0); PG8_MMA(0, 1, At, B1); PG8_BAR;
            PG8_LDA(At, 1, 1); PG8_STAGE(PG8_SA(1, 0), a3, voffA);
            PG8_BAR; PG8_WAIT_L(0); PG8_MMA(1, 0, At, B0); PG8_BAR; PG8_SCHED;
            PG8_STAGE(PG8_SB(1, 1), b3 + hstepB, voffB);
            PG8_WAIT_V(6); PG8_BAR; PG8_MMA(1, 1, At, B1); PG8_BAR;
            }
        }
        if constexpr (ALIGN_EPI) { if (wr == 0) PG8_BAR; }
        if constexpr (!Epi::AFTER_DRAIN) { E(acc, cur, wr, wc, fr, fq); S.done(cur); }
        if (!has_next) break;
#pragma unroll
        for (int a = 0; a < 2; ++a)
#pragma unroll
            for (int b = 0; b < 2; ++b)
#pragma unroll
                for (int m = 0; m < 4; ++m)
#pragma unroll
                    for (int n = 0; n < 2; ++n) acc[a][b][m][n] = (f32x4){0.f, 0.f, 0.f, 0.f};
        cur = nxt; cA = nA; cB = nB; ++ui;
        if constexpr (ALIGN_EPI) { if (wr == 1) PG8_BAR; }
    }
    PG8_WAIT_V(0);
    if constexpr (!ALIGN_EPI) { if (wr == 0) PG8_BAR; }
    PG8_BAR;
    if constexpr (Epi::AFTER_DRAIN) { E.fused(acc, cur, wr, wc, fr, fq, lds, wid, lane); S.done(cur); }
#undef PG8_SA
#undef PG8_SB
#undef PG8_STAGE
#undef PG8_LDA
#undef PG8_LDB
#undef PG8_MMA
#undef PG8_WAIT_V
#undef PG8_WAIT_L
#undef PG8_BAR
#undef PG8_SCHED
}
}

constexpr size_t MiB = 1u << 20;
struct P {
    const float *x, *c, *ctx, *c_ctx, *w_mod, *b_mod, *norm1_g, *norm2_g, *w_in;
    const float *a_re, *a_im, *log_dt, *b_re, *b_im, *c_re, *c_im, *ssm_d;
    const float *w_glu, *b_glu, *w_a, *w_b, *rpb, *w_out, *w_q, *subkeys, *peer_u, *peer_v, *final_g;
    float* out;
    unsigned char* ws;
    __device__ __forceinline__ float* rowss() const { return (float*)(ws + 512 * 1024); }
    __device__ __forceinline__ float* mod() const { return (float*)(ws + 1 * MiB); }
    __device__ __forceinline__ float* c2() const { return (float*)(ws + 1 * MiB + 256 * 1024); }
    __device__ __forceinline__ bf16_t* w_in_t() const { return (bf16_t*)(ws + 3 * MiB); }
    __device__ __forceinline__ bf16_t* w_glu_t() const { return (bf16_t*)(ws + 11 * MiB); }
    __device__ __forceinline__ bf16_t* w_a_t() const { return (bf16_t*)(ws + 12 * MiB); }
    __device__ __forceinline__ bf16_t* w_b_t() const { return (bf16_t*)(ws + 13 * MiB); }
    __device__ __forceinline__ bf16_t* w_out_t() const { return (bf16_t*)(ws + 14 * MiB); }
    __device__ __forceinline__ bf16_t* w_q_t() const { return (bf16_t*)(ws + 16 * MiB); }
    __device__ __forceinline__ bf16_t* Kmat() const { return (bf16_t*)(ws + 21 * MiB); }
    __device__ __forceinline__ bf16_t* Win() const { return (bf16_t*)(ws + 45 * MiB); }
    __device__ __forceinline__ float* lamT() const { return (float*)(ws + 53 * MiB); }
    __device__ __forceinline__ unsigned char* pu8() const { return ws + 54 * MiB; }
    __device__ __forceinline__ unsigned char* pv8() const { return ws + 70 * MiB; }
    __device__ __forceinline__ float* pisc() const { return (float*)(ws + 53 * MiB + 128 * 1024); }
    __device__ __forceinline__ bf16_t* ga() const { return (bf16_t*)(ws + 118 * MiB); }
    __device__ __forceinline__ bf16_t* gb() const { return (bf16_t*)(ws + 182 * MiB); }
    __device__ __forceinline__ bf16_t* x1g() const { return (bf16_t*)(ws + 118 * MiB); }
    __device__ __forceinline__ unsigned* topk() const { return (unsigned*)(ws + 182 * MiB); }
    __device__ __forceinline__ float* gates() const { return (float*)(ws + 198 * MiB); }
    __device__ __forceinline__ bf16_t* kb() const { return (bf16_t*)(ws + 246 * MiB); }
    __device__ __forceinline__ bf16_t* vT() const { return (bf16_t*)(ws + 278 * MiB); }
    __device__ __forceinline__ bf16_t* qb() const { return (bf16_t*)(ws + 310 * MiB); }
    __device__ __forceinline__ bf16_t* kc() const { return (bf16_t*)(ws + 342 * MiB); }
    __device__ __forceinline__ bf16_t* vcT() const { return (bf16_t*)(ws + 344 * MiB); }
    __device__ __forceinline__ bf16_t* U() const { return (bf16_t*)(ws + 346 * MiB); }
    __device__ __forceinline__ float* E() const { return (float*)(ws + 406 * MiB); }
    __device__ __forceinline__ bf16_t* merged() const { return (bf16_t*)(ws + 246 * MiB); }
    __device__ __forceinline__ float* tbuf() const { return (float*)(ws + 310 * MiB); }
    __device__ __forceinline__ bf16_t* qp() const { return (bf16_t*)(ws + 246 * MiB); }
    __device__ __forceinline__ float* apart() const { return (float*)(ws + 246 * MiB); }
    __device__ __forceinline__ float* wl() const { return (float*)(ws + 374 * MiB); }
    __device__ __forceinline__ float* ss2() const { return (float*)(ws + 406 * MiB); }
    __device__ __forceinline__ unsigned* queues() const { return (unsigned*)(ws + 64 * 1024); }
    __device__ __forceinline__ bf16_t* hx() const { return (bf16_t*)out; }
    __device__ __forceinline__ bf16_t* hc() const { return (bf16_t*)((unsigned char*)out + 64 * MiB); }
    __device__ __forceinline__ bf16_t* na() const { return (bf16_t*)out; }
    __device__ __forceinline__ bf16_t* z() const { return (bf16_t*)((unsigned char*)out + 32 * MiB); }
    __device__ __forceinline__ bf16_t* gl() const { return (bf16_t*)((unsigned char*)out + 64 * MiB); }
};

namespace pg8 {
struct EpiInProj {
    static constexpr bool PERM = true, AFTER_DRAIN = false;
    bf16_t* U; bf16_t* d_kq; size_t kq_stride; bf16_t* d_vT; bf16_t* d_gate; int is_ctx;
    __device__ __forceinline__ void operator()(const f32x4 (&acc)[2][2][4][2], const Unit& u, int wr, int wc, int fr, int fq) const {
        if (u.pn < 2) {
#pragma unroll
            for (int ai = 0; ai < 2; ++ai)
#pragma unroll
                for (int m = 0; m < 4; ++m) {
                    const int row = u.pm * BM + ai * HALF + wr * 64 + m * 16 + fr;
                    const int n = is_ctx ? (1024 + (row >> 8) * 8 + ((row & 255) >> 5)) : ((row >> 12) * 128 + ((row & 4095) >> 5));
                    const int jj = row & 31;
#pragma unroll
                    for (int bj = 0; bj < 2; ++bj) {
                        const int col = u.pn * BM + bj * HALF + wc * 32 + 8 * fq;
                        const f32x4 v0 = acc[ai][bj][m][0], v1 = acc[ai][bj][m][1];
                        u32x4 w; w.x = cvt_pk_bf16(v0[0], v0[1]); w.y = cvt_pk_bf16(v0[2], v0[3]); w.z = cvt_pk_bf16(v1[0], v1[1]); w.w = cvt_pk_bf16(v1[2], v1[3]);
                        *(u32x4*)(U + ((size_t)((col >> 4) * SSM_ROWS + n) * SSM_LD + jj * 16 + (col & 15))) = w;
                    }
                    asm volatile("" ::: "memory");
                }
        } else if (u.pn == 4 || u.pn == 5) {
            const int RB = is_ctx ? (CTXL / 64) : (SEQL / 64);
#pragma unroll
            for (int ai = 0; ai < 2; ++ai)
#pragma unroll
                for (int m = 0; m < 4; ++m) {
                    const int row = u.pm * BM + ai * HALF + wr * 64 + m * 16 + fr;
                    const int b = is_ctx ? (row >> 8) : (row >> 12), t = is_ctx ? (row & 255) : (row & 4095);
#pragma unroll
                    for (int bj = 0; bj < 2; ++bj) {
                        const int col = u.pn * BM + bj * HALF + wc * 32 + 8 * fq - 1024;
                        bf16_t* dst = d_vT + ((size_t)((b * 8 + (col >> 6)) * RB + (t >> 6)) * 4096 + (col & 63) * 64 + (t & 63));
#pragma unroll
                        for (int n = 0; n < 2; ++n)
#pragma unroll
                            for (int i = 0; i < 4; ++i) dst[(n * 4 + i) * 64] = (bf16_t)f2bf(acc[ai][bj][m][n][i]);
                    }
                    asm volatile("" ::: "memory");
                }
        } else {
            bf16_t* base; int ld, c0;
            if (u.pn < 8) { const int which = (u.pn - 2) >> 2; base = d_kq + (size_t)which * kq_stride; ld = 512; c0 = 512 + which * 1024; }
            else { const int which = (u.pn - 8) >> 2; base = d_gate + (size_t)which * ((size_t)NTOK * DM); ld = DM; c0 = 2048 + which * 1024; }
#pragma unroll
            for (int ai = 0; ai < 2; ++ai)
#pragma unroll
                for (int m = 0; m < 4; ++m) {
                    const int row = u.pm * BM + ai * HALF + wr * 64 + m * 16 + fr;
#pragma unroll
                    for (int bj = 0; bj < 2; ++bj) {
                        const int col = u.pn * BM + bj * HALF + wc * 32 + 8 * fq - c0;
                        const f32x4 v0 = acc[ai][bj][m][0], v1 = acc[ai][bj][m][1];
                        u32x4 w; w.x = cvt_pk_bf16(v0[0], v0[1]); w.y = cvt_pk_bf16(v0[2], v0[3]); w.z = cvt_pk_bf16(v1[0], v1[1]); w.w = cvt_pk_bf16(v1[2], v1[3]);
                        *(u32x4*)(base + (size_t)row * ld + col) = w;
                    }
                    asm volatile("" ::: "memory");
                }
        }
    }
};
struct EpiGlu {
    static constexpr bool PERM = true, AFTER_DRAIN = false;
    bf16_t* gl; const bf16_t* z; const float* bias;
    __device__ __forceinline__ void operator()(const f32x4 (&acc)[2][2][4][2], const Unit& u, int wr, int wc, int fr, int fq) const {
#pragma unroll
        for (int ai = 0; ai < 2; ++ai)
#pragma unroll
            for (int m = 0; m < 4; ++m) {
                const int row = u.pm * BM + ai * HALF + wr * 64 + m * 16 + fr;
#pragma unroll
                for (int bj = 0; bj < 2; ++bj) {
                    const int col = u.pn * BM + bj * HALF + wc * 32 + 8 * fq;
                    const f32x4 v0 = acc[ai][bj][m][0], v1 = acc[ai][bj][m][1];
                    const f32x4 b0 = *(const f32x4*)(bias + col), b1 = *(const f32x4*)(bias + col + 4);
                    const u32x4 zz = *(const u32x4*)(z + (size_t)row * 512 + col);
                    float o[8];
                    o[0] = bflo(zz.x) * sigmoidf_(v0[0] + b0[0]); o[1] = bfhi(zz.x) * sigmoidf_(v0[1] + b0[1]);
                    o[2] = bflo(zz.y) * sigmoidf_(v0[2] + b0[2]); o[3] = bfhi(zz.y) * sigmoidf_(v0[3] + b0[3]);
                    o[4] = bflo(zz.z) * sigmoidf_(v1[0] + b1[0]); o[5] = bfhi(zz.z) * sigmoidf_(v1[1] + b1[1]);
                    o[6] = bflo(zz.w) * sigmoidf_(v1[2] + b1[2]); o[7] = bfhi(zz.w) * sigmoidf_(v1[3] + b1[3]);
                    u32x4 w; w.x = cvt_pk_bf16(o[0], o[1]); w.y = cvt_pk_bf16(o[2], o[3]); w.z = cvt_pk_bf16(o[4], o[5]); w.w = cvt_pk_bf16(o[6], o[7]);
                    *(u32x4*)(gl + (size_t)row * 512 + col) = w;
                }
            }
    }
};
struct EpiBrA {
    static constexpr bool PERM = true, AFTER_DRAIN = false;
    float* t; const bf16_t* ga;
    __device__ __forceinline__ void operator()(const f32x4 (&acc)[2][2][4][2], const Unit& u, int wr, int wc, int fr, int fq) const {
#pragma unroll
        for (int ai = 0; ai < 2; ++ai)
#pragma unroll
            for (int m = 0; m < 4; ++m) {
                const int row = u.pm * BM + ai * HALF + wr * 64 + m * 16 + fr;
#pragma unroll
                for (int bj = 0; bj < 2; ++bj) {
                    const int col = u.pn * BM + bj * HALF + wc * 32 + 8 * fq;
                    const f32x4 v0 = acc[ai][bj][m][0], v1 = acc[ai][bj][m][1];
                    const u32x4 gg = *(const u32x4*)(ga + (size_t)row * DM + col);
                    f32x4 o0, o1;
                    o0[0] = sigmoidf_(bflo(gg.x)) * v0[0]; o0[1] = sigmoidf_(bfhi(gg.x)) * v0[1]; o0[2] = sigmoidf_(bflo(gg.y)) * v0[2]; o0[3] = sigmoidf_(bfhi(gg.y)) * v0[3];
                    o1[0] = sigmoidf_(bflo(gg.z)) * v1[0]; o1[1] = sigmoidf_(bfhi(gg.z)) * v1[1]; o1[2] = sigmoidf_(bflo(gg.w)) * v1[2]; o1[3] = sigmoidf_(bfhi(gg.w)) * v1[3];
                    *(f32x4*)(t + (size_t)row * DM + col) = o0; *(f32x4*)(t + (size_t)row * DM + col + 4) = o1;
                }
            }
    }
};
struct EpiBrB {
    static constexpr bool PERM = true, AFTER_DRAIN = false;
    bf16_t* merged; const float* t; const bf16_t* gb;
    __device__ __forceinline__ void operator()(const f32x4 (&acc)[2][2][4][2], const Unit& u, int wr, int wc, int fr, int fq) const {
#pragma unroll
        for (int ai = 0; ai < 2; ++ai)
#pragma unroll
            for (int m = 0; m < 4; ++m) {
                const int row = u.pm * BM + ai * HALF + wr * 64 + m * 16 + fr;
#pragma unroll
                for (int bj = 0; bj < 2; ++bj) {
                    const int col = u.pn * BM + bj * HALF + wc * 32 + 8 * fq;
                    const f32x4 v0 = acc[ai][bj][m][0], v1 = acc[ai][bj][m][1];
                    const u32x4 gg = *(const u32x4*)(gb + (size_t)row * DM + col);
                    const f32x4 t0 = *(const f32x4*)(t + (size_t)row * DM + col), t1 = *(const f32x4*)(t + (size_t)row * DM + col + 4);
                    float o[8];
                    o[0] = t0[0] + sigmoidf_(bflo(gg.x)) * v0[0]; o[1] = t0[1] + sigmoidf_(bfhi(gg.x)) * v0[1]; o[2] = t0[2] + sigmoidf_(bflo(gg.y)) * v0[2]; o[3] = t0[3] + sigmoidf_(bfhi(gg.y)) * v0[3];
                    o[4] = t1[0] + sigmoidf_(bflo(gg.z)) * v1[0]; o[5] = t1[1] + sigmoidf_(bfhi(gg.z)) * v1[1]; o[6] = t1[2] + sigmoidf_(bflo(gg.w)) * v1[2]; o[7] = t1[3] + sigmoidf_(bfhi(gg.w)) * v1[3];
                    u32x4 w; w.x = cvt_pk_bf16(o[0], o[1]); w.y = cvt_pk_bf16(o[2], o[3]); w.z = cvt_pk_bf16(o[4], o[5]); w.w = cvt_pk_bf16(o[6], o[7]);
                    *(u32x4*)(merged + (size_t)row * DM + col) = w;
                }
            }
    }
};
struct EpiOut {
    static constexpr bool PERM = true, AFTER_DRAIN = false;
    const float* x; float* x1; bf16_t* x1g; const float* mod; const float* g2; float* rowss;
    __device__ __forceinline__ void operator()(const f32x4 (&acc)[2][2][4][2], const Unit& u, int wr, int wc, int fr, int fq) const {
#pragma unroll
        for (int ai = 0; ai < 2; ++ai)
#pragma unroll
            for (int m = 0; m < 4; ++m) {
                const int row = u.pm * BM + ai * HALF + wr * 64 + m * 16 + fr;
                const float* modb = mod + (size_t)(row >> 12) * (6 * DM);
                float ss = 0.f;
#pragma unroll
                for (int bj = 0; bj < 2; ++bj) {
                    const int col = u.pn * BM + bj * HALF + wc * 32 + 8 * fq;
#pragma unroll
                    for (int n = 0; n < 2; ++n) {
                        const int cc = col + 4 * n;
                        const f32x4 v = acc[ai][bj][m][n];
                        const f32x4 xx = *(const f32x4*)(x + (size_t)row * DM + cc);
                        const f32x4 g1 = *(const f32x4*)(modb + 2 * DM + cc), sc = *(const f32x4*)(modb + 4 * DM + cc), gg = *(const f32x4*)(g2 + cc);
                        const f32x4 o = xx + g1 * v;
                        *(f32x4*)(x1 + (size_t)row * DM + cc) = o;
                        ss += o[0] * o[0] + o[1] * o[1] + o[2] * o[2] + o[3] * o[3];
                        const f32x4 og = o * gg * (sc + 1.f);
                        u32x2 w; w.x = cvt_pk_bf16(og[0], og[1]); w.y = cvt_pk_bf16(og[2], og[3]);
                        *(u32x2*)(x1g + (size_t)row * DM + cc) = w;
                    }
                }
                ss += __shfl_xor(ss, 16); ss += __shfl_xor(ss, 32);
                if (fq == 0) atomicAdd(rowss + row, ss);
            }
    }
};
struct EpiQ {
    static constexpr bool PERM = true, AFTER_DRAIN = false;
    bf16_t* qp; const float* rowss; const float* c2;
    __device__ __forceinline__ void operator()(const f32x4 (&acc)[2][2][4][2], const Unit& u, int wr, int wc, int fr, int fq) const {
#pragma unroll
        for (int ai = 0; ai < 2; ++ai)
#pragma unroll
            for (int m = 0; m < 4; ++m) {
                const int row = u.pm * BM + ai * HALF + wr * 64 + m * 16 + fr;
                const float rstd = rsqrtf(rowss[row] * (1.f / DM) + EPSN);
                const float* cb = c2 + (size_t)(row >> 12) * 2048;
#pragma unroll
                for (int bj = 0; bj < 2; ++bj) {
                    const int col = u.pn * BM + bj * HALF + wc * 32 + 8 * fq;
                    const f32x4 v0 = acc[ai][bj][m][0] * rstd + *(const f32x4*)(cb + col), v1 = acc[ai][bj][m][1] * rstd + *(const f32x4*)(cb + col + 4);
                    u32x4 w; w.x = cvt_pk_bf16(v0[0], v0[1]); w.y = cvt_pk_bf16(v0[2], v0[3]); w.z = cvt_pk_bf16(v1[0], v1[1]); w.w = cvt_pk_bf16(v1[2], v1[3]);
                    *(u32x4*)(qp + (size_t)row * 2048 + col) = w;
                }
            }
    }
};
struct EpiE {
    static constexpr bool PERM = true, AFTER_DRAIN = false;
    float* E;
    __device__ __forceinline__ void operator()(const f32x4 (&acc)[2][2][4][2], const Unit& u, int wr, int wc, int fr, int fq) const {
#pragma unroll
        for (int ai = 0; ai < 2; ++ai)
#pragma unroll
            for (int m = 0; m < 4; ++m) {
                const int row = u.pm * BM + ai * HALF + wr * 64 + m * 16 + fr;
#pragma unroll
                for (int bj = 0; bj < 2; ++bj) {
                    const int col = u.pn * BM + bj * HALF + wc * 32 + 8 * fq;
                    float* d = E + ((size_t)(u.g * SSM_ROWS + row) * 256 + col);
                    *(f32x4*)d = acc[ai][bj][m][0]; *(f32x4*)(d + 4) = acc[ai][bj][m][1];
                }
            }
    }
};
struct EpiZ {
    static constexpr bool PERM = true, AFTER_DRAIN = false;
    bf16_t* z;
    __device__ __forceinline__ void operator()(const f32x4 (&acc)[2][2][4][2], const Unit& u, int wr, int wc, int fr, int fq) const {
#pragma unroll
        for (int ai = 0; ai < 2; ++ai)
#pragma unroll
            for (int m = 0; m < 4; ++m) {
                const int n = u.pm * BM + ai * HALF + wr * 64 + m * 16 + fr;
                const size_t tok0 = (size_t)(n >> 7) * SEQL + (size_t)(n & 127) * 32;
#pragma unroll
                for (int bj = 0; bj < 2; ++bj) {
                    const int col = u.pn * BM + bj * HALF + wc * 32 + 8 * fq;
                    const f32x4 v0 = acc[ai][bj][m][0], v1 = acc[ai][bj][m][1];
                    u32x4 w; w.x = cvt_pk_bf16(gelu_tanh(v0[0]), gelu_tanh(v0[1])); w.y = cvt_pk_bf16(gelu_tanh(v0[2]), gelu_tanh(v0[3]));
                    w.z = cvt_pk_bf16(gelu_tanh(v1[0]), gelu_tanh(v1[1])); w.w = cvt_pk_bf16(gelu_tanh(v1[2]), gelu_tanh(v1[3]));
                    *(u32x4*)(z + (tok0 + (col >> 4)) * 512 + u.g * 16 + (col & 15)) = w;
                }
            }
    }
};
}

__device__ __forceinline__ void sincos_d(double th, double& s, double& c) {
    const double twopi = 6.283185307179586476925, hpi = 1.570796326794896619231;
    th -= twopi * rint(th / twopi);
    const double q = rint(th / hpi); const double y = th - q * hpi, y2 = y * y;
    const double sy = y * (1.0 - y2 / 6.0 * (1.0 - y2 / 20.0 * (1.0 - y2 / 42.0 * (1.0 - y2 / 72.0 * (1.0 - y2 / 110.0 * (1.0 - y2 / 156.0 * (1.0 - y2 / 210.0)))))));
    const double cy = 1.0 - y2 / 2.0 * (1.0 - y2 / 12.0 * (1.0 - y2 / 30.0 * (1.0 - y2 / 56.0 * (1.0 - y2 / 90.0 * (1.0 - y2 / 132.0 * (1.0 - y2 / 182.0))))));
    const int qi = ((int)q) & 3;
    s = qi == 0 ? sy : (qi == 1 ? cy : (qi == 2 ? -sy : -cy));
    c = qi == 0 ? cy : (qi == 1 ? -sy : (qi == 2 ? -cy : sy));
}
__device__ __forceinline__ void ssm_prep_item(const P& p, LAS unsigned char* lds, int item) {
    const int g = item >> 2, qtr = item & 3, tid = threadIdx.x;
    LAS f32x2* lamk = (LAS f32x2*)lds;
    LAS f32x2* Bb = lamk + 2 * 64 * 33;
    LAS f32x2* Cc = Bb + 2 * 64 * 16;
    LAS float* Kc = (LAS float*)(Cc + 2 * 16 * 64);
    if (tid < 128) {
        const int d = tid >> 6, pp = tid & 63, gi = d * 32 + g;
        const double are = (double)p.a_re[gi * 64 + pp], aim = (double)p.a_im[gi * 64 + pp];
        const double dt = (double)expf(p.log_dt[gi]);
        const double er = exp(are * dt); double sn, cs; sincos_d(aim * dt, sn, cs);
        const double lr = er * cs, li = er * sn;
        double pr = 1.0, pi_ = 0.0;
        for (int k = 0; k <= 32; ++k) {
            lamk[(d * 64 + pp) * 33 + k] = (f32x2){(float)pr, (float)pi_};
            const double nr_ = pr * lr - pi_ * li, ni_ = pr * li + pi_ * lr; pr = nr_; pi_ = ni_;
        }
        if (qtr == 0) { const f32x2 l32 = lamk[(d * 64 + pp) * 33 + 32]; *(f32x2*)(p.lamT() + (size_t)(gi * 64 + pp) * 2) = l32; }
        const double nr = lr - 1.0, ni = li, den = are * are + aim * aim;
        const double qr = (nr * are + ni * aim) / den, qi = (ni * are - nr * aim) / den;
        for (int h = 0; h < 16; ++h) {
            const double br = (double)p.b_re[((size_t)gi * 64 + pp) * 16 + h], bi = (double)p.b_im[((size_t)gi * 64 + pp) * 16 + h];
            Bb[(d * 64 + pp) * 16 + h] = (f32x2){(float)(qr * br - qi * bi), (float)(qr * bi + qi * br)};
        }
    }
    for (int e = tid; e < 2 * 16 * 64; e += NT) {
        const int d = e >> 10, h = (e >> 6) & 15, pp = e & 63; const size_t src = ((size_t)(d * 32 + g) * 16 + h) * 64 + pp;
        Cc[e] = (f32x2){p.c_re[src], p.c_im[src]};
    }
    __syncthreads();
    for (int e = tid; e < 2 * 32 * 256; e += NT) {
        const int d = e >> 13, k = (e >> 8) & 31, h = (e >> 4) & 15, h2 = e & 15;
        float sacc = 0.f;
        for (int pp = 0; pp < 64; ++pp) {
            const f32x2 c = Cc[(d * 16 + h) * 64 + pp], l = lamk[(d * 64 + pp) * 33 + k], b = Bb[(d * 64 + pp) * 16 + h2];
            const float clr = c[0] * l[0] - c[1] * l[1], cli = c[0] * l[1] + c[1] * l[0];
            sacc += clr * b[0] - cli * b[1];
        }
        Kc[e] = sacc;
    }
    __syncthreads();
    for (int ch = tid; ch < 128 * 96; ch += NT) {
        const int mrow = 128 * qtr + ch / 96, k0 = (ch % 96) * 8, ii = mrow >> 4, h = mrow & 15;
        float v[8];
        if (k0 < 512) {
            const int jj = k0 >> 4, h20 = k0 & 15;
#pragma unroll
            for (int i = 0; i < 8; ++i) {
                const int h2 = h20 + i; float val = 0.f;
                if (ii >= jj) val += Kc[((0 * 32 + (ii - jj)) * 16 + h) * 16 + h2];
                if (jj >= ii) val += Kc[((1 * 32 + (jj - ii)) * 16 + h) * 16 + h2];
                if (ii == jj && h == h2) val += p.ssm_d[g * 16 + h];
                v[i] = val;
            }
        } else {
            const int sc = k0 - 512, d = sc >> 7, ri = (sc >> 6) & 1, p0 = sc & 63, e = d == 0 ? ii + 1 : 32 - ii;
#pragma unroll
            for (int i = 0; i < 8; ++i) {
                const int pp = p0 + i; const f32x2 c = Cc[(d * 16 + h) * 64 + pp], l = lamk[(d * 64 + pp) * 33 + e];
                const float clr = c[0] * l[0] - c[1] * l[1], cli = c[0] * l[1] + c[1] * l[0];
                v[i] = ri == 0 ? clr : -cli;
            }
        }
        u32x4 o; o.x = pk2(v[0], v[1]); o.y = pk2(v[2], v[3]); o.z = pk2(v[4], v[5]); o.w = pk2(v[6], v[7]);
        *(u32x4*)(p.Kmat() + ((size_t)(g * 512 + mrow) * SSM_LD + k0)) = o;
    }
    for (int ch = tid; ch < 64 * 64; ch += NT) {
        const int nrow = 64 * qtr + ch / 64, k0 = (ch % 64) * 8, d = nrow >> 7, ri = (nrow >> 6) & 1, pp = nrow & 63;
        const int jj = k0 >> 4, h20 = k0 & 15, e = d == 0 ? 31 - jj : jj;
        const f32x2 l = lamk[(d * 64 + pp) * 33 + e];
        float v[8];
#pragma unroll
        for (int i = 0; i < 8; ++i) { const f32x2 b = Bb[(d * 64 + pp) * 16 + h20 + i]; v[i] = ri == 0 ? (l[0] * b[0] - l[1] * b[1]) : (l[0] * b[1] + l[1] * b[0]); }
        u32x4 o; o.x = pk2(v[0], v[1]); o.y = pk2(v[2], v[3]); o.z = pk2(v[4], v[5]); o.w = pk2(v[6], v[7]);
        *(u32x4*)(p.Win() + ((size_t)(g * 256 + nrow) * 512 + k0)) = o;
    }
    __syncthreads();
}
__device__ __forceinline__ void ph_carry(const P& p) {
    int tid = threadIdx.x; asm volatile("" : "+v"(tid));
    if (tid >= 128) return;
    for (int gidx = blockIdx.x * 128 + tid; gidx < 32 * 8 * 2 * 64; gidx += gridDim.x * 128) {
        const int pp = gidx & 63, d = (gidx >> 6) & 1, b = (gidx >> 7) & 7, g = gidx >> 10;
        const f32x2 lt = *(const f32x2*)(p.lamT() + (size_t)((d * 32 + g) * 64 + pp) * 2);
        const float* Eg = p.E() + (size_t)g * SSM_ROWS * 256 + d * 128 + pp;
        bf16_t* Ug = p.U() + (size_t)g * SSM_ROWS * SSM_LD + 512 + d * 128 + pp;
        float fr = 0.f, fi = 0.f;
#pragma unroll
        for (int cc = 0; cc < 8; ++cc) {
            const int n = 1024 + b * 8 + (d == 0 ? cc : 7 - cc);
            const float er = Eg[(size_t)n * 256], ei = Eg[(size_t)n * 256 + 64];
            const float nr = lt[0] * fr - lt[1] * fi + er, ni = lt[0] * fi + lt[1] * fr + ei; fr = nr; fi = ni;
        }
#pragma unroll 8
        for (int c = 0; c < 128; ++c) {
            const int n = b * 128 + (d == 0 ? c : 127 - c);
            const float er = Eg[(size_t)n * 256], ei = Eg[(size_t)n * 256 + 64];
            Ug[(size_t)n * SSM_LD] = (bf16_t)f2bf(fr); Ug[(size_t)n * SSM_LD + 64] = (bf16_t)f2bf(fi);
            const float nr = lt[0] * fr - lt[1] * fi + er, ni = lt[0] * fi + lt[1] * fr + ei; fr = nr; fi = ni;
        }
    }
}


__device__ __forceinline__ void p0_transpose_item(const float* W, int K, int N, bf16_t* WT, LAS float* scr, int item, int lane) {
    const int nblk = N / 32, kb = item / nblk, nb = item % nblk, k0 = 64 * kb, n0 = 32 * nb;
#pragma unroll 8
    for (int i = 0; i < 32; ++i) { const int kk = 2 * i + (lane >> 5); scr[kk * 33 + (lane & 31)] = W[(size_t)(k0 + kk) * N + n0 + (lane & 31)]; }
    asm volatile("s_waitcnt lgkmcnt(0)" ::: "memory");
    const int c = lane & 7;
#pragma unroll
    for (int j = 0; j < 4; ++j) { const int n = (lane >> 3) + 8 * j; const LAS float* s = scr + (8 * c) * 33 + n;
        u32x4 o; o.x = pk2(s[0 * 33], s[1 * 33]); o.y = pk2(s[2 * 33], s[3 * 33]); o.z = pk2(s[4 * 33], s[5 * 33]); o.w = pk2(s[6 * 33], s[7 * 33]);
        *(u32x4*)(WT + (size_t)(n0 + n) * K + k0 + 8 * c) = o; }
    asm volatile("s_waitcnt lgkmcnt(0)" ::: "memory");
}

template <int NR, bool SILU>
__device__ __forceinline__ void gemv_block64(const float* const (&rows)[NR], const float* W, int ldw, int col0, const float* bias, float* y, int ldy, LAS float* scr) {
    const int wave = threadIdx.x >> 6, lane = threadIdx.x & 63;
    float acc[NR];
#pragma unroll
    for (int r = 0; r < NR; ++r) acc[r] = 0.f;
    const int kb = wave * 128;
#pragma unroll 4
    for (int k = kb; k < kb + 128; ++k) {
        const float w = W[(size_t)k * ldw + col0 + lane];
#pragma unroll
        for (int r = 0; r < NR; ++r) { const float s = rows[r][k]; acc[r] += (SILU ? siluf_(s) : s) * w; }
    }
#pragma unroll
    for (int r = 0; r < NR; ++r) scr[(wave * NR + r) * 64 + lane] = acc[r];
    __syncthreads();
    for (int e = threadIdx.x; e < NR * 64; e += NT) {
        const int r = e >> 6, l = e & 63; float s = 0.f;
#pragma unroll
        for (int w = 0; w < 8; ++w) s += scr[(w * NR + r) * 64 + l];
        y[(size_t)r * ldy + col0 + l] = s + (bias ? bias[col0 + l] : 0.f);
    }
    __syncthreads();
}

__device__ __forceinline__ void ph_prep(const P& p, LAS unsigned char* lds) {
    int tid_ = threadIdx.x; asm volatile("" : "+v"(tid_));
    const int wave = tid_ >> 6, lane = tid_ & 63, G = gridDim.x;
    for (int cb = blockIdx.x; cb < 96; cb += G) {
        const float* const rows[9] = {p.c, p.c + DM, p.c + 2 * DM, p.c + 3 * DM, p.c + 4 * DM, p.c + 5 * DM, p.c + 6 * DM, p.c + 7 * DM, p.c_ctx};
        gemv_block64<9, true>(rows, p.w_mod, 6 * DM, cb * 64, p.b_mod, p.mod(), 6 * DM, (LAS float*)lds);
    }
    for (int it = G - 1 - (int)blockIdx.x; it < 128; it += G) ssm_prep_item(p, lds, it);
    {
        LAS float* scr = (LAS float*)(lds + wave * 16384);
        const int gw = blockIdx.x * NWAVES + wave, NGW = G * NWAVES;
        constexpr int I_IN = (DM / 64) * (INC / 32), I_GLU = (512 / 64) * (512 / 32), I_A = (512 / 64) * (DM / 32), I_OUT = (DM / 64) * (DM / 32), I_Q = (DM / 64) * (2048 / 32);
        constexpr int NITEMS = I_IN + I_GLU + 2 * I_A + I_OUT + I_Q;
        for (int it = gw; it < NITEMS; it += NGW) {
            int r = it;
            if (r < I_IN) { p0_transpose_item(p.w_in, DM, INC, p.w_in_t(), scr, r, lane); continue; } r -= I_IN;
            if (r < I_GLU) { p0_transpose_item(p.w_glu, 512, 512, p.w_glu_t(), scr, r, lane); continue; } r -= I_GLU;
            if (r < I_A) { p0_transpose_item(p.w_a, 512, DM, p.w_a_t(), scr, r, lane); continue; } r -= I_A;
            if (r < I_A) { p0_transpose_item(p.w_b, 512, DM, p.w_b_t(), scr, r, lane); continue; } r -= I_A;
            if (r < I_OUT) { p0_transpose_item(p.w_out, DM, DM, p.w_out_t(), scr, r, lane); continue; } r -= I_OUT;
            p0_transpose_item(p.w_q, DM, 2048, p.w_q_t(), scr, r, lane);
        }
    }
    {
        const int gw = blockIdx.x * NWAVES + wave, NGW = G * NWAVES;
        for (int r = gw; r < 2 * 16384; r += NGW) {
            const bool second = r >= 16384; const int rr = second ? r - 16384 : r;
            const float* src = (second ? p.peer_v : p.peer_u) + (size_t)rr * DM + lane * 16;
            f32x4 v[4]; float am = 0.f;
#pragma unroll
            for (int j = 0; j < 4; ++j) { v[j] = *(const f32x4*)(src + 4 * j); am = fmaxf(am, fmaxf(fmaxf(fabsf(v[j][0]), fabsf(v[j][1])), fmaxf(fabsf(v[j][2]), fabsf(v[j][3])))); }
            am = wave_max(am);
            const float sc = am > 0.f ? 448.f / am : 1.f;
            u32x4 o;
#pragma unroll
            for (int j = 0; j < 4; ++j) { int w = 0; w = __builtin_amdgcn_cvt_pk_fp8_f32(v[j][0] * sc, v[j][1] * sc, w, false); w = __builtin_amdgcn_cvt_pk_fp8_f32(v[j][2] * sc, v[j][3] * sc, w, true); o[j] = (unsigned)w; }
            *(u32x4*)((second ? p.pv8() : p.pu8()) + (size_t)(lane >> 3) * (16384 * 128) + (size_t)rr * 128 + (lane & 7) * 16) = o;
            if (lane == 0) p.pisc()[r] = am > 0.f ? am * (1.f / 448.f) : 1.f;
        }
    }
}

__device__ __forceinline__ void normmod_row_bf16(const float* src, bf16_t* dst, const float* g, const float* shift, const float* scale, int lane) {
    const f32x4* s = (const f32x4*)src;
    f32x4 v[4]; float ss = 0.f;
#pragma unroll
    for (int j = 0; j < 4; ++j) { v[j] = s[lane + 64 * j]; ss += v[j][0] * v[j][0] + v[j][1] * v[j][1] + v[j][2] * v[j][2] + v[j][3] * v[j][3]; }
    ss = wave_sum(ss);
    const float rstd = rsqrtf(ss * (1.f / DM) + EPSN);
#pragma unroll
    for (int j = 0; j < 4; ++j) {
        const int i4 = lane + 64 * j;
        const f32x4 gg = ((const f32x4*)g)[i4], sh = ((const f32x4*)shift)[i4], sc = ((const f32x4*)scale)[i4];
        const f32x4 o = v[j] * rstd * gg * (sc + 1.f) + sh;
        u32x2 w; w.x = pk2(o[0], o[1]); w.y = pk2(o[2], o[3]);
        *(u32x2*)(dst + (size_t)i4 * 4) = w;
    }
}
__device__ __forceinline__ void ph_norm1(const P& p, LAS unsigned char* lds) {
    int tid_ = threadIdx.x; asm volatile("" : "+v"(tid_));
    const int wave = tid_ >> 6, lane = tid_ & 63, G = gridDim.x;
    for (int cb = blockIdx.x; cb < 32; cb += G) {
        const float* m3 = p.mod() + 3 * DM;
        const float* const rows[8] = {m3, m3 + 6 * DM, m3 + 12 * DM, m3 + 18 * DM, m3 + 24 * DM, m3 + 30 * DM, m3 + 36 * DM, m3 + 42 * DM};
        gemv_block64<8, false>(rows, p.w_q, 2048, cb * 64, nullptr, p.c2(), 2048, (LAS float*)lds);
    }
    for (int r = blockIdx.x * NWAVES + wave; r < NTOK + NCTX; r += G * NWAVES) {
        if (r < NTOK) { const float* modb = p.mod() + (size_t)(r >> 12) * (6 * DM); normmod_row_bf16(p.x + (size_t)r * DM, p.hx() + (size_t)r * DM, p.norm1_g, modb, modb + DM, lane); }
        else { const int rc = r - NTOK; const float* modc = p.mod() + 8 * (6 * DM); normmod_row_bf16(p.ctx + (size_t)rc * DM, p.hc() + (size_t)rc * DM, p.norm1_g, modc, modc + DM, lane); }
    }
}

constexpr int RPB_LD = 128, RPB_PAD = 48;
__device__ __forceinline__ void ph_na(const P& p, LAS unsigned char* lds) {
    int tid_ = threadIdx.x; asm volatile("" : "+v"(tid_));
    const int tid = tid_, h = __builtin_amdgcn_readfirstlane(tid >> 6), lane = tid & 63, lt = lane & 15, lq = lane >> 4;
    constexpr float LOG2E = 1.4426950408889634f, CS = 0.125f * LOG2E;
    LAS float* rp = (LAS float*)lds;
    for (int e = tid; e < 8 * 15 * RPB_LD; e += NT) { const int c = (e & (RPB_LD - 1)) - RPB_PAD; rp[e] = (c >= 0 && c < 31) ? p.rpb[(e / RPB_LD) * 31 + c] * LOG2E : 0.f; }
    __syncthreads();
    const int pa = (lt >> 2) * 8 + (lt & 3);
    const unsigned lane_k = pa * 512 + lq * 8, lane_v = lt * 64 + lq * 8, lane_q = lt * 512 + lq * 8, lane_o = lt * 512 + lq * 4;
    for (int item = blockIdx.x; item < NB * GW; item += gridDim.x) {
        const int b = item >> 6, r = item & 63;
        int r0 = r - 4; r0 = r0 < 0 ? 0 : (r0 > 56 ? 56 : r0);
        const bf16_t* Kb = p.kb() + ((size_t)b * SEQL + (size_t)r0 * GW) * 512 + h * 64;
        const bf16_t* Kc = p.kc() + ((size_t)b * CTXL) * 512 + h * 64;
        const bf16_t* Vt = p.vT() + ((size_t)((b * 8 + h) * 64 + r0)) * 4096;
        const bf16_t* Vc = p.vcT() + ((size_t)((b * 8 + h) * 4)) * 4096;
        const bf16_t* Qb = p.qb() + ((size_t)b * SEQL + r * GW) * 512 + h * 64;
        bf16_t* Ob = p.na() + ((size_t)b * SEQL + r * GW) * 512 + h * 64;
        const LAS float* rph = rp + (h * 15 + (r0 - r + 7)) * RPB_LD;
        bf16x8 qf[4][2];
#pragma unroll
        for (int qt = 0; qt < 4; ++qt) { qf[qt][0] = *(const bf16x8*)(Qb + qt * 16 * 512 + lane_q); qf[qt][1] = *(const bf16x8*)(Qb + qt * 16 * 512 + 32 + lane_q); }
        f32x4 o[4][4]; float m[4], l[4];
#pragma unroll
        for (int qt = 0; qt < 4; ++qt) { m[qt] = -1e30f; l[qt] = 0.f;
#pragma unroll
            for (int d = 0; d < 4; ++d) o[qt][d] = (f32x4){0.f, 0.f, 0.f, 0.f}; }
        bf16x8 kf[2][2][2];
#pragma unroll
        for (int st = 0; st < 2; ++st)
#pragma unroll
            for (int ab = 0; ab < 2; ++ab) { kf[st][ab][0] = *(const bf16x8*)(Kb + (st * 32 + ab * 4) * 512 + lane_k); kf[st][ab][1] = *(const bf16x8*)(Kb + (st * 32 + ab * 4) * 512 + 32 + lane_k); }
#pragma unroll 1
        for (int i = 0; i < 8; ++i) {
            bf16x8 vf[2][4];
#pragma unroll
            for (int st = 0; st < 2; ++st)
#pragma unroll
                for (int d = 0; d < 4; ++d) vf[st][d] = *(const bf16x8*)(Vt + i * 4096 + d * 1024 + st * 32 + lane_v);
            const LAS float* rr_ = rph + i * RPB_LD;
#pragma unroll
            for (int half = 0; half < 2; ++half) {
                f32x4 s[2][2][2];
#pragma unroll
                for (int q2 = 0; q2 < 2; ++q2) {
                    const int qt = half * 2 + q2;
#pragma unroll
                    for (int st = 0; st < 2; ++st) {
                        if ((st == 0 && qt == 3) || (st == 1 && qt == 0)) continue;
#pragma unroll
                        for (int ab = 0; ab < 2; ++ab) {
                            f32x4 c = {0.f, 0.f, 0.f, 0.f};
                            c = __builtin_amdgcn_mfma_f32_16x16x32_bf16(kf[st][ab][0], qf[qt][0], c, 0, 0, 0);
                            c = __builtin_amdgcn_mfma_f32_16x16x32_bf16(kf[st][ab][1], qf[qt][1], c, 0, 0, 0);
                            s[q2][st][ab] = c;
                        }
                    }
                }
                if (half == 1) {
                    if (i < 7) {
#pragma unroll
                        for (int st = 0; st < 2; ++st)
#pragma unroll
                            for (int ab = 0; ab < 2; ++ab) { const bf16_t* kp = Kb + ((i + 1) * GW + st * 32 + ab * 4) * 512; kf[st][ab][0] = *(const bf16x8*)(kp + lane_k); kf[st][ab][1] = *(const bf16x8*)(kp + 32 + lane_k); }
                    } else {
#pragma unroll
                        for (int ab = 0; ab < 2; ++ab) { kf[0][ab][0] = *(const bf16x8*)(Kc + ab * 4 * 512 + lane_k); kf[0][ab][1] = *(const bf16x8*)(Kc + ab * 4 * 512 + 32 + lane_k); }
                    }
                }
#pragma unroll
                for (int q2 = 0; q2 < 2; ++q2) {
                    const int qt = half * 2 + q2;
                    const int qc = qt * 16 + lt; int c0 = qc - 8; c0 = c0 < 0 ? 0 : (c0 > 48 ? 48 : c0);
                    int wo = lq * 8 - c0; asm volatile("" : "+v"(wo));
                    float mx = -1e30f;
#pragma unroll
                    for (int st = 0; st < 2; ++st) {
                        if ((st == 0 && qt == 3) || (st == 1 && qt == 0)) continue;
                        const int kc0 = st * 32 + lq * 8, bbase = kc0 - qc + 15 + RPB_PAD;
#pragma unroll
                        for (int j = 0; j < 8; ++j) {
                            float t = s[q2][st][j >> 2][j & 3] * CS + rr_[bbase + j];
                            t = ((unsigned)(wo + st * 32 + j) < 16u) ? t : -1e30f;
                            s[q2][st][j >> 2][j & 3] = t; mx = fmaxf(mx, t);
                        }
                    }
                    mx = fmaxf(mx, __shfl_xor(mx, 16)); mx = fmaxf(mx, __shfl_xor(mx, 32));
                    const float mn = fmaxf(m[qt], mx), corr = __builtin_amdgcn_exp2f(m[qt] - mn);
                    m[qt] = mn; float ls = l[qt] * corr;
#pragma unroll
                    for (int d = 0; d < 4; ++d) o[qt][d] = o[qt][d] * corr;
#pragma unroll
                    for (int st = 0; st < 2; ++st) {
                        if ((st == 0 && qt == 3) || (st == 1 && qt == 0)) continue;
                        float pe[8];
#pragma unroll
                        for (int j = 0; j < 8; ++j) pe[j] = __builtin_amdgcn_exp2f(s[q2][st][j >> 2][j & 3] - mn);
                        ls += ((pe[0] + pe[1]) + (pe[2] + pe[3])) + ((pe[4] + pe[5]) + (pe[6] + pe[7]));
                        u32x4 pw; pw[0] = pg8::cvt_pk_bf16(pe[0], pe[1]); pw[1] = pg8::cvt_pk_bf16(pe[2], pe[3]); pw[2] = pg8::cvt_pk_bf16(pe[4], pe[5]); pw[3] = pg8::cvt_pk_bf16(pe[6], pe[7]);
                        const bf16x8 pf = __builtin_bit_cast(bf16x8, pw);
#pragma unroll
                        for (int d = 0; d < 4; ++d) o[qt][d] = __builtin_amdgcn_mfma_f32_16x16x32_bf16(vf[st][d], pf, o[qt][d], 0, 0, 0);
                    }
                    l[qt] = ls;
                }
            }
        }
#pragma unroll 1
        for (int cst = 0; cst < 8; ++cst) {
            bf16x8 vf[4];
#pragma unroll
            for (int d = 0; d < 4; ++d) vf[d] = *(const bf16x8*)(Vc + (cst >> 1) * 4096 + d * 1024 + (cst & 1) * 32 + lane_v);
            f32x4 s[4][2];
#pragma unroll
            for (int qt = 0; qt < 4; ++qt)
#pragma unroll
                for (int ab = 0; ab < 2; ++ab) {
                    f32x4 c = {0.f, 0.f, 0.f, 0.f};
                    c = __builtin_amdgcn_mfma_f32_16x16x32_bf16(kf[0][ab][0], qf[qt][0], c, 0, 0, 0);
                    c = __builtin_amdgcn_mfma_f32_16x16x32_bf16(kf[0][ab][1], qf[qt][1], c, 0, 0, 0);
                    s[qt][ab] = c;
                }
            if (cst < 7) {
#pragma unroll
                for (int ab = 0; ab < 2; ++ab) { const bf16_t* kp = Kc + ((cst + 1) * 32 + ab * 4) * 512; kf[0][ab][0] = *(const bf16x8*)(kp + lane_k); kf[0][ab][1] = *(const bf16x8*)(kp + 32 + lane_k); }
            }
#pragma unroll
            for (int qt = 0; qt < 4; ++qt) {
                float mx = -1e30f;
#pragma unroll
                for (int j = 0; j < 8; ++j) { const float t = s[qt][j >> 2][j & 3] * CS; s[qt][j >> 2][j & 3] = t; mx = fmaxf(mx, t); }
                mx = fmaxf(mx, __shfl_xor(mx, 16)); mx = fmaxf(mx, __shfl_xor(mx, 32));
                const float mn = fmaxf(m[qt], mx), corr = __builtin_amdgcn_exp2f(m[qt] - mn);
                m[qt] = mn;
#pragma unroll
                for (int d = 0; d < 4; ++d) o[qt][d] = o[qt][d] * corr;
                float pe[8];
#pragma unroll
                for (int j = 0; j < 8; ++j) pe[j] = __builtin_amdgcn_exp2f(s[qt][j >> 2][j & 3] - mn);
                l[qt] = l[qt] * corr + (((pe[0] + pe[1]) + (pe[2] + pe[3])) + ((pe[4] + pe[5]) + (pe[6] + pe[7])));
                u32x4 pw; pw[0] = pg8::cvt_pk_bf16(pe[0], pe[1]); pw[1] = pg8::cvt_pk_bf16(pe[2], pe[3]); pw[2] = pg8::cvt_pk_bf16(pe[4], pe[5]); pw[3] = pg8::cvt_pk_bf16(pe[6], pe[7]);
                const bf16x8 pf = __builtin_bit_cast(bf16x8, pw);
#pragma unroll
                for (int d = 0; d < 4; ++d) o[qt][d] = __builtin_amdgcn_mfma_f32_16x16x32_bf16(vf[d], pf, o[qt][d], 0, 0, 0);
            }
        }
#pragma unroll
        for (int qt = 0; qt < 4; ++qt) {
            float lv = l[qt]; lv += __shfl_xor(lv, 16); lv += __shfl_xor(lv, 32);
            const float inv = 1.f / lv;
            bf16_t* op = Ob + qt * 16 * 512 + lane_o;
#pragma unroll
            for (int d = 0; d < 4; ++d) { u32x2 w; w[0] = pg8::cvt_pk_bf16(o[qt][d][0] * inv, o[qt][d][1] * inv); w[1] = pg8::cvt_pk_bf16(o[qt][d][2] * inv, o[qt][d][3] * inv); *(u32x2*)(op + d * 16) = w; }
        }
    }
}

typedef __bf16 bf16x2_t __attribute__((ext_vector_type(2)));
__device__ __forceinline__ float dot2bf(unsigned a, unsigned b, float c) { return __builtin_amdgcn_fdot2_f32_bf16(__builtin_bit_cast(bf16x2_t, a), __builtin_bit_cast(bf16x2_t, b), c, false); }
__device__ __forceinline__ unsigned ordkey(float f) { unsigned u = __builtin_bit_cast(unsigned, f); return u ^ ((unsigned)((int)u >> 31) | 0x80000000u); }
__device__ __forceinline__ float unordkey(unsigned k) { return __builtin_bit_cast(float, k ^ ((k & 0x80000000u) ? 0x80000000u : 0xFFFFFFFFu)); }
template <bool DESC> __device__ __forceinline__ void cex(unsigned& a, unsigned& b) { const unsigned mx = a > b ? a : b, mn = a > b ? b : a; if (DESC) { a = mx; b = mn; } else { a = mn; b = mx; } }
__device__ __forceinline__ void sort16_desc(unsigned (&a)[16]) {
#pragma unroll
    for (int k = 2; k <= 16; k <<= 1)
#pragma unroll
        for (int j = k >> 1; j > 0; j >>= 1)
#pragma unroll
            for (int i = 0; i < 16; ++i) { const int l = i ^ j; if (l > i) { if ((i & k) == 0) cex<true>(a[i], a[l]); else cex<false>(a[i], a[l]); } }
}
__device__ __forceinline__ void merge16_desc(unsigned (&a)[16]) {
#pragma unroll
    for (int j = 8; j > 0; j >>= 1)
#pragma unroll
        for (int i = 0; i < 16; ++i) { const int l = i ^ j; if (l > i) cex<true>(a[i], a[l]); }
}
__device__ __forceinline__ void top16_merge(unsigned (&a)[16], const unsigned (&b)[16]) {
#pragma unroll
    for (int i = 0; i < 16; ++i) a[i] = a[i] > b[15 - i] ? a[i] : b[15 - i];
    merge16_desc(a);
}
struct PairTab { int i[52], j[52], n; };
constexpr PairTab make_pairs() { PairTab t{}; int n = 0; for (int i = 0; i < 16; ++i) for (int j = 0; j < 16; ++j) if ((i + 1) * (j + 1) <= 16) { t.i[n] = i; t.j[n] = j; ++n; } t.n = n; for (int k = n; k < 52; ++k) { t.i[k] = 0; t.j[k] = 0; } return t; }
constexpr PairTab PAIRS = make_pairs();
static_assert(PAIRS.n == 50, "50 candidate pairs");

constexpr int SK_LD = 136;
__device__ __forceinline__ void ph_peer_topk(const P& p, LAS unsigned char* lds) {
    int tid_ = threadIdx.x; asm volatile("" : "+v"(tid_));
    const int tid = tid_, wave = tid >> 6, lane = tid & 63;
    LAS bf16_t* sk = (LAS bf16_t*)lds;
    for (int e = tid; e < 2 * 128 * 16; e += NT) {
        const int row = e >> 4, c8 = (e & 15) * 8;
        const f32x4 a = *(const f32x4*)(p.subkeys + (size_t)row * 128 + c8), b = *(const f32x4*)(p.subkeys + (size_t)row * 128 + c8 + 4);
        u32x4 o; o.x = pk2(a[0], a[1]); o.y = pk2(a[2], a[3]); o.z = pk2(b[0], b[1]); o.w = pk2(b[2], b[3]);
        *(LAS u32x4*)(sk + row * SK_LD + c8) = o;
    }
    __syncthreads();
    const int lt = lane & 15, lq = lane >> 4;
    for (int tile = blockIdx.x * NWAVES + wave; tile < NTOK / 16; tile += gridDim.x * NWAVES) {
        const int tok = tile * 16 + lt;
        const bf16_t* qrow = p.qp() + (size_t)tok * 2048;
        for (int h = 0; h < 8; ++h) {
            unsigned s0[16], s1[16];
#pragma unroll
            for (int n = 0; n < 2; ++n) {
                bf16x8 bq[4];
#pragma unroll
                for (int ks = 0; ks < 4; ++ks) bq[ks] = *(const bf16x8*)(qrow + h * 256 + n * 128 + ks * 32 + lq * 8);
                unsigned a[16], b[16];
#pragma unroll
                for (int kb = 0; kb < 8; ++kb) {
                    f32x4 c = {0.f, 0.f, 0.f, 0.f};
#pragma unroll
                    for (int ks = 0; ks < 4; ++ks) {
                        const bf16x8 ak = *(const LAS bf16x8*)(sk + (n * 128 + kb * 16 + lt) * SK_LD + ks * 32 + lq * 8);
                        c = __builtin_amdgcn_mfma_f32_16x16x32_bf16(ak, bq[ks], c, 0, 0, 0);
                    }
#pragma unroll
                    for (int r = 0; r < 4; ++r) {
                        const unsigned key = (ordkey(c[r]) & ~127u) | (unsigned)(kb * 16 + lq * 4 + r);
                        if (kb < 4) a[kb * 4 + r] = key; else b[(kb - 4) * 4 + r] = key;
                    }
                    asm volatile("" ::: "memory");
                }
                sort16_desc(a); sort16_desc(b);
                top16_merge(a, b);
#pragma unroll
                for (int i = 0; i < 16; ++i) b[i] = __shfl_xor(a[i], 16);
                top16_merge(a, b);
#pragma unroll
                for (int i = 0; i < 16; ++i) b[i] = __shfl_xor(a[i], 32);
                top16_merge(a, b);
                if (n == 0) {
#pragma unroll
                    for (int i = 0; i < 16; ++i) s0[i] = a[i];
                } else {
#pragma unroll
                    for (int i = 0; i < 16; ++i) s1[i] = a[i];
                }
            }
            unsigned ck[16], ce_[13]; float cs[13];
#pragma unroll
            for (int s = 0; s < 13; ++s) {
                const unsigned k0 = lq == 0 ? s0[PAIRS.i[s * 4]] : (lq == 1 ? s0[PAIRS.i[s * 4 + 1]] : (lq == 2 ? s0[PAIRS.i[s * 4 + 2]] : s0[PAIRS.i[s * 4 + 3]]));
                const unsigned k1 = lq == 0 ? s1[PAIRS.j[s * 4]] : (lq == 1 ? s1[PAIRS.j[s * 4 + 1]] : (lq == 2 ? s1[PAIRS.j[s * 4 + 2]] : s1[PAIRS.j[s * 4 + 3]]));
                const float sum = unordkey(k0 & ~127u) + unordkey(k1 & ~127u);
                const bool valid = (s * 4 + lq) < PAIRS.n;
                cs[s] = sum; ce_[s] = (k0 & 127u) * 128u + (k1 & 127u);
                ck[s] = valid ? ((ordkey(sum) & ~63u) | (unsigned)(s * 4 + lq)) : 0u;
            }
            ck[13] = 0u; ck[14] = 0u; ck[15] = 0u;
            unsigned srt[16], ob[16];
#pragma unroll
            for (int i = 0; i < 16; ++i) srt[i] = ck[i];
            sort16_desc(srt);
#pragma unroll
            for (int i = 0; i < 16; ++i) ob[i] = __shfl_xor(srt[i], 16);
            top16_merge(srt, ob);
#pragma unroll
            for (int i = 0; i < 16; ++i) ob[i] = __shfl_xor(srt[i], 32);
            unsigned thr = 0xFFFFFFFFu;
#pragma unroll
            for (int i = 0; i < 16; ++i) { const unsigned v = srt[i] > ob[15 - i] ? srt[i] : ob[15 - i]; thr = v < thr ? v : thr; }
            const float mtop = unordkey(s0[0] & ~127u) + unordkey(s1[0] & ~127u);
            float zp = 0.f; int cnt = 0;
#pragma unroll
            for (int s = 0; s < 13; ++s) { const bool sel = ck[s] >= thr && ck[s] != 0u; const float e = sel ? __expf(cs[s] - mtop) : 0.f; cs[s] = e; zp += e; cnt += sel ? 1 : 0; }
            float z = zp; z += __shfl_xor(z, 16); z += __shfl_xor(z, 32);
            const float rz = 1.f / z;
            const int c0 = __shfl(cnt, lt), c1 = __shfl(cnt, lt + 16), c2 = __shfl(cnt, lt + 32);
            int pos = lq == 0 ? 0 : (lq == 1 ? c0 : (lq == 2 ? c0 + c1 : c0 + c1 + c2));
            unsigned short* dste = (unsigned short*)p.topk() + ((size_t)tok * 8 + h) * 16; float* dstg = p.gates() + ((size_t)tok * 8 + h) * 16;
#pragma unroll
            for (int s = 0; s < 13; ++s) {
                const bool sel = ck[s] >= thr && ck[s] != 0u;
                if (sel) { dste[pos] = (unsigned short)ce_[s]; dstg[pos] = cs[s] * rz; ++pos; }
            }
        }
    }
}

__device__ __forceinline__ unsigned xcc_id() { return (unsigned)__builtin_amdgcn_s_getreg((3 << 11) | 20) & 7u; }
__device__ __forceinline__ int q_grab(unsigned* head, int lane) { unsigned v = 0u; if (lane == 0) v = __hip_atomic_fetch_add(head, 16u, __ATOMIC_RELAXED, __HIP_MEMORY_SCOPE_AGENT); return (int)__builtin_amdgcn_readfirstlane(v); }

__device__ __forceinline__ void g_ids(const unsigned short* tkrow, unsigned lo_g16, u32x4 (&ids)[2]) {
#pragma unroll
    for (int q = 0; q < 2; ++q) ids[q] = *(const u32x4*)(tkrow + lo_g16 + q * 8);
}
__device__ __forceinline__ void g_wts(const float* wrow, unsigned lo_g16, f32x4 (&wts)[4]) {
#pragma unroll
    for (int q = 0; q < 4; ++q) wts[q] = *(const f32x4*)(wrow + lo_g16 + q * 4);
}
__device__ __forceinline__ void g_rows8(const unsigned char* tb, unsigned lo_c16, const u32x4& idh, u32x4 (&rows)[8]) {
#pragma unroll
    for (int i = 0; i < 8; ++i) {
        const unsigned w = idh[i >> 1];
        const unsigned e = (i & 1) ? (w >> 16) : (w & 0xffffu);
        rows[i] = *(const u32x4*)(tb + ((e << 7) + lo_c16));
    }
}
__device__ __forceinline__ void fmac_(float& d, float a, float b) { asm("v_fmac_f32_e32 %0, %1, %2" : "+v"(d) : "v"(a), "v"(b)); }
__device__ __forceinline__ void g_dots8(const u32x4 (&uu)[8], const float (&hv)[16], float* pd) {
#pragma unroll
    for (int i = 0; i < 8; ++i) {
        float d = 0.f;
#pragma unroll
        for (int j = 0; j < 4; ++j) {
            const int w = (int)uu[i][j];
            const f32x2 lo = __builtin_amdgcn_cvt_pk_f32_fp8(w, false), hi = __builtin_amdgcn_cvt_pk_f32_fp8(w, true);
            fmac_(d, lo[0], hv[j * 4]); fmac_(d, lo[1], hv[j * 4 + 1]); fmac_(d, hi[0], hv[j * 4 + 2]); fmac_(d, hi[1], hv[j * 4 + 3]);
        }
        pd[i] = d;
    }
}
__device__ __forceinline__ void g_acc8(const u32x4 (&vv)[8], const f32x4& w0, const f32x4& w1, float (&acc)[16]) {
#pragma unroll
    for (int i = 0; i < 8; ++i) {
        const float w = i < 4 ? w0[i & 3] : w1[i & 3];
#pragma unroll
        for (int j = 0; j < 4; ++j) {
            const int wv = (int)vv[i][j];
            const f32x2 lo = __builtin_amdgcn_cvt_pk_f32_fp8(wv, false), hi = __builtin_amdgcn_cvt_pk_f32_fp8(wv, true);
            fmac_(acc[j * 4], w, lo[0]); fmac_(acc[j * 4 + 1], w, lo[1]); fmac_(acc[j * 4 + 2], w, hi[0]); fmac_(acc[j * 4 + 3], w, hi[1]);
        }
    }
}
template <int D4, int D2, int D1>
__device__ __forceinline__ void halve16(const float (&v)[16], int b4, int b2, int b1, float& o0, float& o1) {
    float r8[8], r4[4];
#pragma unroll
    for (int i = 0; i < 8; ++i) { const float keep = b4 ? v[i + 8] : v[i], send = b4 ? v[i] : v[i + 8]; r8[i] = keep + __shfl_xor(send, D4); }
#pragma unroll
    for (int i = 0; i < 4; ++i) { const float keep = b2 ? r8[i + 4] : r8[i], send = b2 ? r8[i] : r8[i + 4]; r4[i] = keep + __shfl_xor(send, D2); }
    { const float keep = b1 ? r4[2] : r4[0], send = b1 ? r4[0] : r4[2]; o0 = keep + __shfl_xor(send, D1); }
    { const float keep = b1 ? r4[3] : r4[1], send = b1 ? r4[1] : r4[3]; o1 = keep + __shfl_xor(send, D1); }
}

template <int WHICH>
__device__ __forceinline__ void ph_gather_sliced(const P& p) {
    int tid_ = threadIdx.x; asm volatile("" : "+v"(tid_));
    const int lane = tid_ & 63, c = lane & 7, g = lane >> 3;
    const unsigned xs = xcc_id();
    for (unsigned tr = 0; tr < 8; ++tr) {
        const int sl = (int)((xs + tr) & 7u);
        unsigned* head = p.queues() + (WHICH * 8 + sl) * 64;
        const unsigned char* tb = (WHICH == 0 ? p.pu8() : p.pv8()) + (size_t)sl * (16384 * 128);
        for (;;) {
            const int t0 = q_grab(head, lane);
            if (t0 >= NTOK) break;
            unsigned oc = c * 16, og = g * 16; asm volatile("" : "+v"(oc), "+v"(og));
            const unsigned short* idb = (const unsigned short*)p.topk() + (size_t)t0 * 128;
            const float* wb = p.wl() + (size_t)t0 * 128;
            const float* modb = p.mod() + (size_t)(t0 >> 12) * (6 * DM) + sl * 128;
            u32x4 idc[2], idn[2], RA[8], RB[8]; f32x4 wc[4], wn[4];
            g_ids(idb, og, idc); if (WHICH == 1) g_wts(wb, og, wc);
            g_rows8(tb, oc, idc[0], RA);
            if (WHICH == 0) {
                float A[16], Bs[16]; f32x4 xn[4];
                const float* xb = p.out + (size_t)t0 * DM + sl * 128;
#pragma unroll
                for (int j = 0; j < 4; ++j) {
                    const f32x4 gg = *(const f32x4*)(p.norm2_g + sl * 128 + oc + j * 4), sh = *(const f32x4*)(modb + 3 * DM + oc + j * 4), sc = *(const f32x4*)(modb + 4 * DM + oc + j * 4);
#pragma unroll
                    for (int i = 0; i < 4; ++i) { A[j * 4 + i] = gg[i] * (1.f + sc[i]); Bs[j * 4 + i] = sh[i]; }
                    xn[j] = *(const f32x4*)(xb + oc + j * 4);
                }
                const float rsl = rsqrtf(p.rowss()[t0 + (lane & 15)] * (1.f / DM) + EPSN);
#pragma unroll 1
                for (int t = t0; t < t0 + 16; ++t) {
                    const bool more = t + 1 < t0 + 16;
                    g_rows8(tb, oc, idc[1], RB);
                    float hv[16], pd[16];
                    const float rstd2 = __builtin_bit_cast(float, __builtin_amdgcn_readlane(__builtin_bit_cast(unsigned, rsl), t - t0));
#pragma unroll
                    for (int j = 0; j < 4; ++j)
#pragma unroll
                        for (int i = 0; i < 4; ++i) hv[j * 4 + i] = xn[j][i] * rstd2 * A[j * 4 + i] + Bs[j * 4 + i];
                    if (more) {
                        g_ids(idb + (t + 1 - t0) * 128, og, idn);
#pragma unroll
                        for (int j = 0; j < 4; ++j) xn[j] = *(const f32x4*)(xb + (size_t)(t + 1 - t0) * DM + oc + j * 4);
                    }
                    g_dots8(RA, hv, pd);
                    if (more) g_rows8(tb, oc, idn[0], RA);
                    g_dots8(RB, hv, pd + 8);
                    float o0, o1; halve16<4, 2, 1>(pd, c & 4, c & 2, c & 1, o0, o1);
                    const unsigned lo_st = og + 2 * (c & 1) + 4 * ((c >> 1) & 1) + 8 * ((c >> 2) & 1);
                    f32x2 st; st[0] = o0; st[1] = o1;
                    *(f32x2*)(p.apart() + ((size_t)sl * NTOK + t) * 128 + lo_st) = st;
#pragma unroll
                    for (int q = 0; q < 2; ++q) idc[q] = idn[q];
                }
            } else {
                const unsigned lo_col = oc + 2 * (g & 1) + 4 * ((g >> 1) & 1) + 8 * ((g >> 2) & 1);
                float* xb = p.out + (size_t)t0 * DM + sl * 128;
                const f32x2 g2 = *(const f32x2*)(modb + 5 * DM + lo_col);
                f32x2 x1n = *(const f32x2*)(xb + lo_col);
#pragma unroll 1
                for (int t = t0; t < t0 + 16; ++t) {
                    const bool more = t + 1 < t0 + 16;
                    g_rows8(tb, oc, idc[1], RB);
                    const f32x2 x1 = x1n;
                    if (more) { g_ids(idb + (t + 1 - t0) * 128, og, idn); g_wts(wb + (t + 1 - t0) * 128, og, wn); x1n = *(const f32x2*)(xb + (size_t)(t + 1 - t0) * DM + lo_col); }
                    float acc[16];
#pragma unroll
                    for (int i = 0; i < 16; ++i) acc[i] = 0.f;
                    g_acc8(RA, wc[0], wc[1], acc);
                    if (more) g_rows8(tb, oc, idn[0], RA);
                    g_acc8(RB, wc[2], wc[3], acc);
                    float o0, o1; halve16<32, 16, 8>(acc, g & 4, g & 2, g & 1, o0, o1);
                    f32x2 x2; x2[0] = x1[0] + g2[0] * o0; x2[1] = x1[1] + g2[1] * o1;
                    *(f32x2*)(xb + (size_t)(t - t0) * DM + lo_col) = x2;
                    const float ss = wave_sum(x2[0] * x2[0] + x2[1] * x2[1]);
                    if (lane == 0) p.ss2()[(size_t)sl * NTOK + t] = ss;
#pragma unroll
                    for (int q = 0; q < 2; ++q) idc[q] = idn[q];
#pragma unroll
                    for (int q = 0; q < 4; ++q) wc[q] = wn[q];
                }
            }
        }
    }
}
__device__ __forceinline__ void ph_gather_weights(const P& p) {
    int tid_ = threadIdx.x; asm volatile("" : "+v"(tid_));
    const size_t gsz = (size_t)gridDim.x * NT;
    const float* isc = p.pisc();
    for (size_t i = (size_t)blockIdx.x * NT + tid_; i < (size_t)NTOK * 128; i += gsz) {
        float a = 0.f;
#pragma unroll
        for (int sl = 0; sl < 8; ++sl) a += p.apart()[(size_t)sl * NTOK * 128 + i];
        const unsigned e = ((const unsigned short*)p.topk())[i]; const float gate = p.gates()[i];
        p.wl()[i] = gate * isc[16384 + e] * gelu_tanh(a * isc[e]);
    }
}
__device__ __forceinline__ void ph_final_norm(const P& p) {
    int tid_ = threadIdx.x; asm volatile("" : "+v"(tid_));
    const int wave = __builtin_amdgcn_readfirstlane(tid_ >> 6), lane = tid_ & 63;
    for (int tok = blockIdx.x * NWAVES + wave; tok < NTOK; tok += gridDim.x * NWAVES) {
        float ss = 0.f;
#pragma unroll
        for (int sl = 0; sl < 8; ++sl) ss += p.ss2()[(size_t)sl * NTOK + tok];
        const float rstd = rsqrtf(ss * (1.f / DM) + EPSN);
        f32x4* row = (f32x4*)(p.out + (size_t)tok * DM);
#pragma unroll
        for (int j = 0; j < 4; ++j) { const f32x4 v = row[lane + 64 * j], fg = ((const f32x4*)p.final_g)[lane + 64 * j]; row[lane + 64 * j] = v * rstd * fg; }
    }
}

#define XB_TMO      128
#define XB_XCNT(j)  (256  + 64 * (j))
#define XB_XSUB(j)  (1280 + 64 * (j))
#define XB_XGEN(j)  (2304 + 64 * (j))
#define XB_TOP      3328
#define XB_TOPGEN   3392
#define XCD_BAR_WORDS 3456
#define XB_SPIN_CAP (1u << 18)
__device__ __forceinline__ unsigned xb_ld(unsigned* p)              { return __hip_atomic_load(p, __ATOMIC_RELAXED, __HIP_MEMORY_SCOPE_AGENT); }
__device__ __forceinline__ unsigned xb_add(unsigned* p, unsigned v) { return __hip_atomic_fetch_add(p, v, __ATOMIC_RELAXED, __HIP_MEMORY_SCOPE_AGENT); }
__device__ __forceinline__ unsigned xb_xcc_id() { return (unsigned)__builtin_amdgcn_s_getreg((3 << 11) | 20) & 0xFu; }
#define XB_SPIN(cond, bar) do { unsigned _sp = 0; while (cond) { __builtin_amdgcn_s_sleep(1); \
    if ((++_sp & 255u) == 0u) { if (xb_ld(&(bar)[XB_TMO])) break; if (_sp > XB_SPIN_CAP) { atomicAdd(&(bar)[XB_TMO], 1u); break; } } } } while (0)
struct XcdBarrier { unsigned* bar; unsigned x; volatile LAS unsigned* st; };
__device__ __forceinline__ XcdBarrier xcd_barrier_post(unsigned* bar, volatile LAS unsigned* st) {
    XcdBarrier b; b.bar = bar; b.x = xb_xcc_id(); b.st = st;
    if (threadIdx.x == 0) (void)xb_add(&bar[XB_XCNT(b.x)], 1u);
    return b;
}
__device__ __forceinline__ void xcd_barrier_complete(unsigned* bar, unsigned x, unsigned& nloc, unsigned& nx) {
    const unsigned G = gridDim.x * gridDim.y * gridDim.z;
    unsigned sum, cnt, mine, sp = 0u;
    for (;;) {
        sum = 0u; cnt = 0u; mine = 0u;
#pragma unroll
        for (unsigned j = 0; j < 16; ++j) { const unsigned c = xb_ld(&bar[XB_XCNT(j)]); sum += c; cnt += (c > 0u) ? 1u : 0u; mine = (j == x) ? c : mine; }
        if (sum == G) break;
        __builtin_amdgcn_s_sleep(1);
        if ((++sp & 255u) == 0u) { if (xb_ld(&bar[XB_TMO])) break; if (sp > XB_SPIN_CAP) { atomicAdd(&bar[XB_TMO], 1u); break; } }
    }
    nloc = mine > 0u ? mine : 1u; nx = cnt > 0u ? cnt : 1u;
}
__device__ __forceinline__ void xcd_barrier(const XcdBarrier& b) {
    asm volatile("s_waitcnt vmcnt(0)" ::: "memory");
    __syncthreads();
    if (threadIdx.x == 0) {
        unsigned* bar = b.bar;
        __builtin_amdgcn_s_waitcnt(0);
        unsigned nloc = b.st[0], nx = b.st[1];
        if (nloc == 0u) { xcd_barrier_complete(bar, b.x, nloc, nx); b.st[0] = nloc; b.st[1] = nx; }
        const unsigned old = xb_add(&bar[XB_XSUB(b.x)], 1u);
        const unsigned gen = old / nloc;
        if (old + 1u == (gen + 1u) * nloc) {
            __builtin_amdgcn_fence(__ATOMIC_RELEASE, "agent");
            asm volatile("s_waitcnt vmcnt(0)" ::: "memory");
            const unsigned og = xb_add(&bar[XB_TOP], 1u);
            const unsigned tg = og / nx;
            if (og + 1u == (tg + 1u) * nx) xb_add(&bar[XB_TOPGEN], 1u);
            else XB_SPIN(xb_ld(&bar[XB_TOPGEN]) == tg, bar);
            __builtin_amdgcn_fence(__ATOMIC_ACQUIRE, "agent");
            xb_add(&bar[XB_XGEN(b.x)], 1u);
            asm volatile("s_waitcnt vmcnt(0)" ::: "memory");
        } else {
            XB_SPIN(xb_ld(&bar[XB_XGEN(b.x)]) == gen, bar);
            __builtin_amdgcn_fence(__ATOMIC_ACQUIRE, "agent");
            asm volatile("s_waitcnt vmcnt(0)" ::: "memory");
        }
    }
    __syncthreads();
}

constexpr int LDS_BYTES = 147456;
#define GSYNC() xcd_barrier(xbar)
constexpr int MISC_OFF = LDS_BYTES - 64;

__global__ void __launch_bounds__(NT, 2) mega(P p) {
    extern __shared__ __attribute__((aligned(16))) unsigned char lds_raw[];
    LAS unsigned char* lds = (LAS unsigned char*)lds_raw;
    const int G = gridDim.x, bx = blockIdx.x;
    using namespace pg8;
    if (threadIdx.x < 16) ((LAS unsigned*)(lds + MISC_OFF))[threadIdx.x] = 0u;
    __syncthreads();
    const XcdBarrier xbar = xcd_barrier_post((unsigned*)p.ws, (volatile LAS unsigned*)(lds + MISC_OFF));

    ph_prep(p, lds);
    cg::this_grid().sync();
    ph_norm1(p, lds);
    GSYNC();
    {
        Gemm<DM, DM, DM> g{p.hx(), p.w_in_t()}; StaticOrder<NTOK, INC> S; S.init(G, bx);
        EpiInProj E{p.U(), p.kb(), (size_t)(p.qb() - p.kb()), p.vT(), p.ga(), 0};
        gemm_phase<EpiInProj, StaticOrder<NTOK, INC>, true, true>(lds, g, S, E);
        Gemm<DM, DM, DM> g2{p.hc(), p.w_in_t()}; StaticOrder<NCTX, CTXC> S2; S2.init(G, bx);
        EpiInProj E2{p.U(), p.kc(), 0, p.vcT(), p.ga(), 1};
        gemm_phase<EpiInProj, StaticOrder<NCTX, CTXC>, true, true>(lds, g2, S2, E2);
    }
    GSYNC();
    {
        Gemm<512, SSM_LD, 512, (long)SSM_ROWS * SSM_LD, 256L * 512> g{p.U(), p.Win()}; StaticOrder<SSM_ROWS, 256, 32> S; S.init(G, bx);
        EpiE E{p.E()};
        gemm_phase<EpiE, StaticOrder<SSM_ROWS, 256, 32>, true, true>(lds, g, S, E);
    }
    GSYNC();
    ph_carry(p);
    ph_na(p, lds);
    GSYNC();
    {
        Gemm<SSM_LD, SSM_LD, SSM_LD, (long)SSM_ROWS * SSM_LD, 512L * SSM_LD> g{p.U(), p.Kmat()}; StaticOrder<1024, 512, 32> S; S.init(G, bx);
        EpiZ E{p.z()};
        gemm_phase<EpiZ, StaticOrder<1024, 512, 32>, true, true>(lds, g, S, E);
    }
    GSYNC();
    {
        Gemm<512, 512, 512> g{p.z(), p.w_glu_t()}; StaticOrder<NTOK, 512> S; S.init(G, bx);
        EpiGlu E{p.gl(), p.z(), p.b_glu};
        gemm_phase<EpiGlu, StaticOrder<NTOK, 512>, true, true>(lds, g, S, E);
    }
    GSYNC();
    {
        Gemm<512, 512, 512> g{p.gl(), p.w_a_t()}; StaticOrder<NTOK, DM> S; S.init(G, bx);
        EpiBrA E{p.tbuf(), p.ga()};
        gemm_phase<EpiBrA, StaticOrder<NTOK, DM>, true, true>(lds, g, S, E);
        Gemm<512, 512, 512> g2{p.na(), p.w_b_t()};
        EpiBrB E2{p.merged(), p.tbuf(), p.gb()};
        gemm_phase<EpiBrB, StaticOrder<NTOK, DM>, true, true>(lds, g2, S, E2);
    }
    GSYNC();
    {
        Gemm<DM, DM, DM> g{p.merged(), p.w_out_t()}; StaticOrder<NTOK, DM> S; S.init(G, bx);
        EpiOut E{p.x, p.out, p.x1g(), p.mod(), p.norm2_g, p.rowss()};
        gemm_phase<EpiOut, StaticOrder<NTOK, DM>, true, true>(lds, g, S, E);
    }
    GSYNC();
    {
        Gemm<DM, DM, DM> g{p.x1g(), p.w_q_t()}; StaticOrder<NTOK, 2048> S; S.init(G, bx);
        EpiQ E{p.qp(), p.rowss(), p.c2()};
        gemm_phase<EpiQ, StaticOrder<NTOK, 2048>, true, true>(lds, g, S, E);
    }
    GSYNC();
    ph_peer_topk(p, lds);
    GSYNC();
    ph_gather_sliced<0>(p);
    GSYNC();
    ph_gather_weights(p);
    GSYNC();
    ph_gather_sliced<1>(p);
    GSYNC();
    ph_final_norm(p);
}

extern "C" void kernel_launch(void* const* d_in, const int* in_sizes, int n_in, void* d_out, int out_size, void* d_ws, size_t ws_size, hipStream_t stream) {
    static int grid = 0;
    if (grid == 0) {
        int dev = 0, cus = 0, per_cu = 0;
        (void)hipGetDevice(&dev);
        (void)hipDeviceGetAttribute(&cus, hipDeviceAttributeMultiprocessorCount, dev);
        (void)hipFuncSetAttribute((const void*)mega, hipFuncAttributeMaxDynamicSharedMemorySize, LDS_BYTES);
        (void)hipOccupancyMaxActiveBlocksPerMultiprocessor(&per_cu, (const void*)mega, NT, LDS_BYTES);
        if (per_cu < 1) { fprintf(stderr, "occupancy query says %d blocks per CU\n", per_cu); per_cu = 1; }
        grid = cus;
    }
    P p{};
    const float* const* in = (const float* const*)d_in;
    p.x = in[0]; p.c = in[1]; p.ctx = in[2]; p.c_ctx = in[3]; p.w_mod = in[4]; p.b_mod = in[5]; p.norm1_g = in[6]; p.norm2_g = in[7]; p.w_in = in[8];
    p.a_re = in[9]; p.a_im = in[10]; p.log_dt = in[11]; p.b_re = in[12]; p.b_im = in[13]; p.c_re = in[14]; p.c_im = in[15]; p.ssm_d = in[16];
    p.w_glu = in[17]; p.b_glu = in[18]; p.w_a = in[19]; p.w_b = in[20]; p.rpb = in[21]; p.w_out = in[22]; p.w_q = in[23]; p.subkeys = in[24];
    p.peer_u = in[25]; p.peer_v = in[26]; p.final_g = in[27];
    p.out = (float*)d_out;
    p.ws = (unsigned char*)d_ws;
    (void)hipMemsetAsync(d_ws, 0, 1 * MiB, stream);
    void* args[] = {&p};
    hipError_t e = hipLaunchCooperativeKernel((const void*)mega, dim3(grid), dim3(NT), args, LDS_BYTES, stream);
    if (e != hipSuccess) fprintf(stderr, "cooperative launch failed: %s (grid %d)\n", hipGetErrorString(e), grid);
}
```

```cpp
#include <hip/hip_runtime.h>
#include <hip/hip_cooperative_groups.h>
#include <cstdio>
#include <cstdint>
namespace cg = cooperative_groups;

#define LAS __attribute__((address_space(3)))
typedef unsigned short bf16_t;
typedef short bf16x8 __attribute__((ext_vector_type(8)));
typedef float f32x4 __attribute__((ext_vector_type(4)));
typedef float f32x2 __attribute__((ext_vector_type(2)));
typedef unsigned u32x4 __attribute__((ext_vector_type(4)));
typedef unsigned u32x2 __attribute__((ext_vector_type(2)));

constexpr int DM = 1024, NB = 8, SEQL = 4096, CTXL = 256, GW = 64, NTOK = NB * SEQL, NCTX = NB * CTXL;
constexpr int INC = 4096, CTXC = 1536;
constexpr int NT = 512, NWAVES = 8;
constexpr float EPSN = 1e-6f;
constexpr int SSM_ROWS = 1280;
constexpr int SSM_LD = 768;

__device__ __forceinline__ unsigned f2bf(float f) { unsigned u = __builtin_bit_cast(unsigned, f); return (u + 0x7fffu + ((u >> 16) & 1u)) >> 16; }
__device__ __forceinline__ unsigned pk2(float lo, float hi) { return f2bf(lo) | (f2bf(hi) << 16); }
__device__ __forceinline__ float bflo(unsigned w) { return __builtin_bit_cast(float, w << 16); }
__device__ __forceinline__ float bfhi(unsigned w) { return __builtin_bit_cast(float, w & 0xffff0000u); }
__device__ __forceinline__ float bf2f(bf16_t h) { return __builtin_bit_cast(float, (unsigned)h << 16); }

__device__ __forceinline__ float wave_sum(float v) {
#pragma unroll
    for (int o = 1; o < 64; o <<= 1) v += __shfl_xor(v, o);
    return v;
}
__device__ __forceinline__ float wave_max(float v) {
#pragma unroll
    for (int o = 1; o < 64; o <<= 1) v = fmaxf(v, __shfl_xor(v, o));
    return v;
}
__device__ __forceinline__ float sigmoidf_(float x) { return 1.f / (1.f + __expf(-x)); }
__device__ __forceinline__ float siluf_(float x) { return x / (1.f + __expf(-x)); }
__device__ __forceinline__ float gelu_tanh(float x) {
    const float k0 = 0.7978845608028654f, k1 = 0.044715f;
    const float u = k0 * (x + k1 * x * x * x);
    const float t = 1.f - 2.f / (1.f + __expf(2.f * u));
    return 0.5f * x * (1.f + t);
}

namespace pg8 {
#define PG8_LAS __attribute__((address_space(3)))
constexpr int BM = 256, BK = 64, HALF = 128, HTB = HALF * BK * 2  , STAGE_BYTES = 8 * HTB, NXCD = 8, WGM = 8;
__host__ __device__ __forceinline__ int lds_byte(int r, int c) { const int st = (r >> 4) * 2 + (c >> 5), rr = r & 15, cc = c & 31, ob = rr * 64 + cc * 2; return st * 1024 + (ob ^ (((ob >> 9) & 1) << 5)); }
__host__ __device__ __forceinline__ void stage_rc(int b, int& R, int& C) { const int st = b / 1024, sb = b % 1024, swz = sb ^ (((sb >> 9) & 1) << 5); R = (st >> 1) * 16 + swz / 64; C = (st & 1) * 32 + (swz % 64) / 2; }
__host__ __device__ __forceinline__ int perm32(int rho) { const int n = rho >> 4, i = rho & 15; return 8 * (i >> 2) + 4 * n + (i & 3); }

struct Unit { int pm, pn, g; };
template <int K_, int LDA, int LDB, long GSA = 0, long GSB = 0>
struct Gemm {
    const bf16_t* A; const bf16_t* Bt;
    static constexpr int K = K_, lda = LDA, ldb = LDB;
    __device__ __forceinline__ const char* abase(const Unit& u) const { return (const char*)(A + (size_t)u.g * GSA + (size_t)u.pm * BM * LDA); }
    __device__ __forceinline__ const char* bbase(const Unit& u) const { return (const char*)(Bt + (size_t)u.g * GSB + (size_t)u.pn * BM * LDB); }
};
template <int M, int N, int NGRP = 1>
struct StaticOrder {
    static constexpr int nM = M / BM, nN = N / BM, nwg = nM * nN;
    int G, c;
    __device__ void init(int G_, int c_) { G = G_; c = c_; }
    __device__ bool next(int i, Unit& u) const {
        const int L = i * G + c; if (L >= nwg * NGRP) return false;
        u.g = L / nwg;
        int wgid = L % nwg; { constexpr int q = nwg / NXCD, r = nwg % NXCD; const int xcd = wgid % NXCD, off = wgid / NXCD; wgid = (xcd < r ? xcd * (q + 1) : r * (q + 1) + (xcd - r) * q) + off; }
        constexpr int nig = WGM * nN; const int gid = wgid / nig, fm = gid * WGM, gsz = (nM - fm) < WGM ? (nM - fm) : WGM;
        u.pm = fm + ((wgid % nig) % gsz); u.pn = (wgid % nig) / gsz; return true;
    }
    __device__ __forceinline__ void a_ready(const Unit&) const {}
    __device__ __forceinline__ void done(const Unit&) const {}
};
__device__ __forceinline__ unsigned cvt_pk_bf16(float lo, float hi) { unsigned r; asm volatile("v_cvt_pk_bf16_f32 %0, %1, %2" : "=v"(r) : "v"(lo), "v"(hi)); return r; }
template <class Epi, class Sched, bool ALIGN_EPI = false, bool SP2 = false, class GemmT>
__device__ __forceinline__ void gemm_phase(PG8_LAS unsigned char* lds, const GemmT g, const Sched& S, const Epi& E) {
    int tid_ = threadIdx.x; asm volatile("" : "+v"(tid_));
    const int tid = tid_, wid = __builtin_amdgcn_readfirstlane(tid >> 6), lane = tid & 63, wr = wid >> 2, wc = wid & 3, fr = lane & 15, fq = lane >> 4;
    const int K = g.K, nt = K / BK;
    unsigned voffA[2], voffB[2];
#pragma unroll
    for (int i = 0; i < 2; ++i) { int R, C; stage_rc(tid * 16 + i * 8192, R, C); const int Rb = Epi::PERM ? ((R & ~31) + perm32(R & 31)) : R;
        voffA[i] = (unsigned)(R * g.lda + C) * 2u; voffB[i] = (unsigned)(Rb * g.ldb + C) * 2u; }
    const size_t kstep = (size_t)(BK * 2);
    const size_t hstepA = (size_t)HALF * g.lda * 2, hstepB = (size_t)HALF * g.ldb * 2;
    const unsigned ldsw = (unsigned)wid * 1024u;
    const int aoff = lds_byte(wr * 64 + fr, fq * 8), boff = lds_byte(wc * 32 + fr, fq * 8);
#define PG8_SA(b, h) (((b) * 2 + (h)) * HTB)
#define PG8_SB(b, h) ((4 + (b) * 2 + (h)) * HTB)
#define PG8_STAGE(bufoff, gbase, voff) do { _Pragma("unroll") for (int _i = 0; _i < 2; ++_i) \
        __builtin_amdgcn_global_load_lds((const unsigned*)((const char*)(gbase) + (voff)[_i]), (PG8_LAS unsigned*)(lds + (bufoff) + ldsw + _i * 8192), 16, 0, 0); } while (0)
#define PG8_LDA(dst, b, h) do { _Pragma("unroll") for (int m = 0; m < 4; ++m) _Pragma("unroll") for (int k = 0; k < 2; ++k) dst[m][k] = *(const PG8_LAS bf16x8*)(lds + PG8_SA(b, h) + aoff + m * 2048 + k * 1024); } while (0)
#define PG8_LDB(dst, b, h) do { _Pragma("unroll") for (int n = 0; n < 2; ++n) _Pragma("unroll") for (int k = 0; k < 2; ++k) dst[n][k] = *(const PG8_LAS bf16x8*)(lds + PG8_SB(b, h) + boff + n * 2048 + k * 1024); } while (0)
#define PG8_MMA(ai, bj, At, Bt) do { __builtin_amdgcn_s_setprio(1); _Pragma("unroll") for (int m = 0; m < 4; ++m) _Pragma("unroll") for (int n = 0; n < 2; ++n) _Pragma("unroll") for (int k = 0; k < 2; ++k) \
        acc[ai][bj][m][n] = __builtin_amdgcn_mfma_f32_16x16x32_bf16(Bt[n][k], At[m][k], acc[ai][bj][m][n], 0, 0, 0); __builtin_amdgcn_s_setprio(0); } while (0)
#define PG8_WAIT_V(n) asm volatile("s_waitcnt vmcnt(" #n ")" ::: "memory")
#define PG8_WAIT_L(n) asm volatile("s_waitcnt lgkmcnt(" #n ")" ::: "memory")
#define PG8_BAR __builtin_amdgcn_s_barrier()
#define PG8_SCHED __builtin_amdgcn_sched_barrier(0)
    Unit cur, nxt; int ui = 0;
    if (!S.next(0, cur)) return;
    f32x4 acc[2][2][4][2];
#pragma unroll
    for (int a = 0; a < 2; ++a)
#pragma unroll
        for (int b = 0; b < 2; ++b)
#pragma unroll
            for (int m = 0; m < 4; ++m)
#pragma unroll
                for (int n = 0; n < 2; ++n) acc[a][b][m][n] = (f32x4){0.f, 0.f, 0.f, 0.f};
    bf16x8 At[4][2], B0[2][2], B1[2][2];
    const char* cA = g.abase(cur); const char* cB = g.bbase(cur);
    S.a_ready(cur);
    if constexpr (SP2) {
        PG8_STAGE(PG8_SB(0, 0), cB, voffB); PG8_STAGE(PG8_SB(0, 1), cB + hstepB, voffB); PG8_STAGE(PG8_SA(0, 0), cA, voffA); PG8_STAGE(PG8_SA(0, 1), cA + hstepA, voffA);
        if (wr == 1) PG8_BAR;
        PG8_WAIT_V(2); PG8_BAR;
        PG8_STAGE(PG8_SB(1, 0), cB + kstep, voffB); PG8_STAGE(PG8_SA(1, 0), cA + kstep, voffA); PG8_STAGE(PG8_SB(1, 1), cB + hstepB + kstep, voffB);
        PG8_WAIT_V(6); PG8_BAR;
    } else {
        PG8_STAGE(PG8_SB(0, 0), cB, voffB); PG8_STAGE(PG8_SA(0, 0), cA, voffA); PG8_STAGE(PG8_SB(0, 1), cB + hstepB, voffB); PG8_STAGE(PG8_SA(0, 1), cA + hstepA, voffA);
        if (wr == 1) PG8_BAR;
        PG8_WAIT_V(4); PG8_BAR;
        PG8_STAGE(PG8_SB(1, 0), cB + kstep, voffB); PG8_STAGE(PG8_SA(1, 0), cA + kstep, voffA); PG8_STAGE(PG8_SB(1, 1), cB + hstepB + kstep, voffB);
        PG8_WAIT_V(6); PG8_BAR;
    }
    for (;;) {
        const bool has_next = S.next(ui + 1, nxt);
        const char* nA = has_next ? g.abase(nxt) : cA; const char* nB = has_next ? g.bbase(nxt) : cB;
        for (int t = 0; t < nt; t += 2) {
            const bool last = (t == nt - 2);
            const char* a1 = cA + (size_t)(t + 1) * kstep;
            const char* a2 = last ? nA : cA + (size_t)(t + 2) * kstep; const char* b2 = last ? nB : cB + (size_t)(t + 2) * kstep;
            const char* a3 = a2 + kstep; const char* b3 = b2 + kstep;
            if (last && has_next) S.a_ready(nxt);
            if constexpr (SP2) {
            PG8_LDB(B0, 0, 0); PG8_LDB(B1, 0, 1); PG8_SCHED; PG8_LDA(At, 0, 0); PG8_STAGE(PG8_SA(1, 1), a1 + hstepA, voffA);
            PG8_WAIT_V(8); PG8_WAIT_L(0); PG8_BAR; PG8_MMA(0, 0, At, B0); PG8_MMA(0, 1, At, B1); PG8_BAR; PG8_SCHED;
            PG8_LDA(At, 0, 1); PG8_STAGE(PG8_SB(0, 0), b2, voffB); PG8_STAGE(PG8_SB(0, 1), b2 + hstepB, voffB); PG8_STAGE(PG8_SA(0, 0), a2, voffA);
            PG8_WAIT_V(8); PG8_WAIT_L(0); PG8_BAR; PG8_MMA(1, 0, At, B0); PG8_MMA(1, 1, At, B1); PG8_BAR; PG8_SCHED;
            PG8_LDB(B0, 1, 0); PG8_LDB(B1, 1, 1); PG8_SCHED; PG8_LDA(At, 1, 0); PG8_STAGE(PG8_SA(0, 1), a2 + hstepA, voffA);
            PG8_WAIT_V(8); PG8_WAIT_L(0); PG8_BAR; PG8_MMA(0, 0, At, B0); PG8_MMA(0, 1, At, B1); PG8_BAR; PG8_SCHED;
            PG8_LDA(At, 1, 1); PG8_STAGE(PG8_SB(1, 0), b3, voffB); PG8_STAGE(PG8_SB(1, 1), b3 + hstepB, voffB); PG8_STAGE(PG8_SA(1, 0), a3, voffA);
            PG8_WAIT_V(8); PG8_WAIT_L(0); PG8_BAR; PG8_MMA(1, 0, At, B0); PG8_MMA(1, 1, At, B1); PG8_BAR; PG8_SCHED;
            } else {
            PG8_LDB(B0, 0, 0); PG8_SCHED; PG8_LDA(At, 0, 0); PG8_STAGE(PG8_SA(1, 1), a1 + hstepA, voffA);
            PG8_WAIT_L(8); PG8_BAR; PG8_WAIT_L(0); PG8_MMA(0, 0, At, B0); PG8_BAR; PG8_SCHED;
            PG8_LDB(B1, 0, 1); PG8_STAGE(PG8_SB(0, 0), b2, voffB);
            PG8_BAR; PG8_WAIT_L(0); PG8_MMA(0, 1, At, B1); PG8_BAR;
            PG8_LDA(At, 0, 1); PG8_STAGE(PG8_SA(0, 0), a2, voffA);
            PG8_BAR; PG8_WAIT_L(0); PG8_MMA(1, 0, At, B0); PG8_BAR; PG8_SCHED;
            PG8_STAGE(PG8_SB(0, 1), b2 + hstepB, voffB);
            PG8_WAIT_V(6); PG8_BAR; PG8_MMA(1, 1, At, B1); PG8_BAR;
            PG8_LDB(B0, 1, 0); PG8_SCHED; PG8_LDA(At, 1, 0); PG8_STAGE(PG8_SA(0, 1), a2 + hstepA, voffA);
            PG8_WAIT_L(8); PG8_BAR; PG8_WAIT_L(0); PG8_MMA(0, 0, At, B0); PG8_BAR; PG8_SCHED;
            PG8_LDB(B1, 1, 1); PG8_STAGE(PG8_SB(1, 0), b3, voffB);
            PG8_BAR; PG8_WAIT_L(0); PG8_MMA(0, 1, At, B1); PG8_BAR;
            PG8_LDA(At, 1, 1); PG8_STAGE(PG8_SA(1, 0), a3, voffA);
            PG8_BAR; PG8_WAIT_L(0); PG8_MMA(1, 0, At, B0); PG8_BAR; PG8_SCHED;
            PG8_STAGE(PG8_SB(1, 1), b3 + hstepB, voffB);
            PG8_WAIT_V(6); PG8_BAR; PG8_MMA(1, 1, At, B1); PG8_BAR;
            }
        }
        if constexpr (ALIGN_EPI) { if (wr == 0) PG8_BAR; }
        if constexpr (!Epi::AFTER_DRAIN) { E(acc, cur, wr, wc, fr, fq); S.done(cur); }
        if (!has_next) break;
        if (!E.keep(cur)) {
#pragma unroll
        for (int a = 0; a < 2; ++a)
#pragma unroll
            for (int b = 0; b < 2; ++b)
#pragma unroll
                for (int m = 0; m < 4; ++m)
#pragma unroll
                    for (int n = 0; n < 2; ++n) acc[a][b][m][n] = (f32x4){0.f, 0.f, 0.f, 0.f};
        }
        cur = nxt; cA = nA; cB = nB; ++ui;
        if constexpr (ALIGN_EPI) { if (wr == 1) PG8_BAR; }
    }
    PG8_WAIT_V(0);
    if constexpr (!ALIGN_EPI) { if (wr == 0) PG8_BAR; }
    PG8_BAR;
    if constexpr (Epi::AFTER_DRAIN) { E.fused(acc, cur, wr, wc, fr, fq, lds, wid, lane); S.done(cur); }
#undef PG8_SA
#undef PG8_SB
#undef PG8_STAGE
#undef PG8_LDA
#undef PG8_LDB
#undef PG8_MMA
#undef PG8_WAIT_V
#undef PG8_WAIT_L
#undef PG8_BAR
#undef PG8_SCHED
}
}

constexpr size_t MiB = 1u << 20;
struct P {
    const float *x, *c, *ctx, *c_ctx, *w_mod, *b_mod, *norm1_g, *norm2_g, *w_in;
    const float *a_re, *a_im, *log_dt, *b_re, *b_im, *c_re, *c_im, *ssm_d;
    const float *w_glu, *b_glu, *w_a, *w_b, *rpb, *w_out, *w_q, *subkeys, *peer_u, *peer_v, *final_g;
    float* out;
    unsigned char* ws;
    __device__ __forceinline__ float* rowss() const { return (float*)(ws + 512 * 1024); }
    __device__ __forceinline__ float* mod() const { return (float*)(ws + 1 * MiB); }
    __device__ __forceinline__ float* c2() const { return (float*)(ws + 1 * MiB + 256 * 1024); }
    __device__ __forceinline__ bf16_t* w_in_t() const { return (bf16_t*)(ws + 3 * MiB); }
    __device__ __forceinline__ bf16_t* w_glu_t() const { return (bf16_t*)(ws + 11 * MiB); }
    __device__ __forceinline__ bf16_t* w_b_t() const { return (bf16_t*)(ws + 12 * MiB); }
    __device__ __forceinline__ bf16_t* w_a_t() const { return (bf16_t*)(ws + 13 * MiB); }
    __device__ __forceinline__ bf16_t* w_out_t() const { return (bf16_t*)(ws + 14 * MiB); }
    __device__ __forceinline__ bf16_t* w_q_t() const { return (bf16_t*)(ws + 16 * MiB); }
    __device__ __forceinline__ bf16_t* Kmat() const { return (bf16_t*)(ws + 21 * MiB); }
    __device__ __forceinline__ bf16_t* Win() const { return (bf16_t*)(ws + 45 * MiB); }
    __device__ __forceinline__ float* lamT() const { return (float*)(ws + 53 * MiB); }
    __device__ __forceinline__ unsigned char* pu8() const { return ws + 54 * MiB; }
    __device__ __forceinline__ unsigned char* pv8() const { return ws + 70 * MiB; }
    __device__ __forceinline__ float* pisc() const { return (float*)(ws + 53 * MiB + 128 * 1024); }
    __device__ __forceinline__ bf16_t* ga() const { return (bf16_t*)(ws + 118 * MiB); }
    __device__ __forceinline__ bf16_t* gb() const { return (bf16_t*)(ws + 182 * MiB); }
    __device__ __forceinline__ bf16_t* x1g() const { return (bf16_t*)(ws + 118 * MiB); }
    __device__ __forceinline__ unsigned* topk() const { return (unsigned*)(ws + 182 * MiB); }
    __device__ __forceinline__ float* gates() const { return (float*)(ws + 198 * MiB); }
    __device__ __forceinline__ bf16_t* kb() const { return (bf16_t*)(ws + 246 * MiB); }
    __device__ __forceinline__ bf16_t* vT() const { return (bf16_t*)(ws + 278 * MiB); }
    __device__ __forceinline__ bf16_t* qb() const { return (bf16_t*)(ws + 310 * MiB); }
    __device__ __forceinline__ bf16_t* kc() const { return (bf16_t*)(ws + 342 * MiB); }
    __device__ __forceinline__ bf16_t* vcT() const { return (bf16_t*)(ws + 344 * MiB); }
    __device__ __forceinline__ bf16_t* U() const { return (bf16_t*)(ws + 346 * MiB); }
    __device__ __forceinline__ float* E() const { return (float*)(ws + 406 * MiB); }
    __device__ __forceinline__ bf16_t* merged() const { return (bf16_t*)(ws + 246 * MiB); }
    __device__ __forceinline__ float* tbuf() const { return (float*)(ws + 310 * MiB); }
    __device__ __forceinline__ bf16_t* qp() const { return (bf16_t*)(ws + 246 * MiB); }
    __device__ __forceinline__ float* apart() const { return (float*)(ws + 246 * MiB); }
    __device__ __forceinline__ float* wl() const { return (float*)(ws + 374 * MiB); }
    __device__ __forceinline__ float* ss2() const { return (float*)(ws + 406 * MiB); }
    __device__ __forceinline__ unsigned* queues() const { return (unsigned*)(ws + 64 * 1024); }
    __device__ __forceinline__ bf16_t* hx() const { return (bf16_t*)out; }
    __device__ __forceinline__ bf16_t* hc() const { return (bf16_t*)((unsigned char*)out + 64 * MiB); }
    __device__ __forceinline__ bf16_t* na() const { return (bf16_t*)out; }
    __device__ __forceinline__ bf16_t* z() const { return (bf16_t*)((unsigned char*)out + 32 * MiB); }
    __device__ __forceinline__ bf16_t* gl() const { return (bf16_t*)((unsigned char*)out + 64 * MiB); }
};

namespace pg8 {
struct EpiInProj {
    static constexpr bool PERM = true, AFTER_DRAIN = false;
    __device__ __forceinline__ bool keep(const Unit&) const { return false; }
    bf16_t* U; bf16_t* d_kq; size_t kq_stride; bf16_t* d_vT; bf16_t* d_gate; int is_ctx;
    __device__ __forceinline__ void operator()(const f32x4 (&acc)[2][2][4][2], const Unit& u, int wr, int wc, int fr, int fq) const {
        if (u.pn < 2) {
#pragma unroll
            for (int ai = 0; ai < 2; ++ai)
#pragma unroll
                for (int m = 0; m < 4; ++m) {
                    const int row = u.pm * BM + ai * HALF + wr * 64 + m * 16 + fr;
                    const int n = is_ctx ? (1024 + (row >> 8) * 8 + ((row & 255) >> 5)) : ((row >> 12) * 128 + ((row & 4095) >> 5));
                    const int jj = row & 31;
#pragma unroll
                    for (int bj = 0; bj < 2; ++bj) {
                        const int col = u.pn * BM + bj * HALF + wc * 32 + 8 * fq;
                        const f32x4 v0 = acc[ai][bj][m][0], v1 = acc[ai][bj][m][1];
                        u32x4 w; w.x = cvt_pk_bf16(v0[0], v0[1]); w.y = cvt_pk_bf16(v0[2], v0[3]); w.z = cvt_pk_bf16(v1[0], v1[1]); w.w = cvt_pk_bf16(v1[2], v1[3]);
                        *(u32x4*)(U + ((size_t)((col >> 4) * SSM_ROWS + n) * SSM_LD + jj * 16 + (col & 15))) = w;
                    }
                    asm volatile("" ::: "memory");
                }
        } else if (u.pn == 4 || u.pn == 5) {
            const int RB = is_ctx ? (CTXL / 64) : (SEQL / 64);
#pragma unroll
            for (int ai = 0; ai < 2; ++ai)
#pragma unroll
                for (int m = 0; m < 4; ++m) {
                    const int row = u.pm * BM + ai * HALF + wr * 64 + m * 16 + fr;
                    const int b = is_ctx ? (row >> 8) : (row >> 12), t = is_ctx ? (row & 255) : (row & 4095);
#pragma unroll
                    for (int bj = 0; bj < 2; ++bj) {
                        const int col = u.pn * BM + bj * HALF + wc * 32 + 8 * fq - 1024;
                        bf16_t* dst = d_vT + ((size_t)((b * 8 + (col >> 6)) * RB + (t >> 6)) * 4096 + (col & 63) * 64 + (t & 63));
#pragma unroll
                        for (int n = 0; n < 2; ++n)
#pragma unroll
                            for (int i = 0; i < 4; ++i) dst[(n * 4 + i) * 64] = (bf16_t)f2bf(acc[ai][bj][m][n][i]);
                    }
                    asm volatile("" ::: "memory");
                }
        } else {
            bf16_t* base; int ld, c0;
            if (u.pn < 8) { const int which = (u.pn - 2) >> 2; base = d_kq + (size_t)which * kq_stride; ld = 512; c0 = 512 + which * 1024; }
            else { const int which = (u.pn - 8) >> 2; base = d_gate + (size_t)which * ((size_t)NTOK * DM); ld = DM; c0 = 2048 + which * 1024; }
#pragma unroll
            for (int ai = 0; ai < 2; ++ai)
#pragma unroll
                for (int m = 0; m < 4; ++m) {
                    const int row = u.pm * BM + ai * HALF + wr * 64 + m * 16 + fr;
#pragma unroll
                    for (int bj = 0; bj < 2; ++bj) {
                        const int col = u.pn * BM + bj * HALF + wc * 32 + 8 * fq - c0;
                        const f32x4 v0 = acc[ai][bj][m][0], v1 = acc[ai][bj][m][1];
                        u32x4 w; w.x = cvt_pk_bf16(v0[0], v0[1]); w.y = cvt_pk_bf16(v0[2], v0[3]); w.z = cvt_pk_bf16(v1[0], v1[1]); w.w = cvt_pk_bf16(v1[2], v1[3]);
                        *(u32x4*)(base + (size_t)row * ld + col) = w;
                    }
                    asm volatile("" ::: "memory");
                }
        }
    }
};
struct EpiGlu {
    static constexpr bool PERM = true, AFTER_DRAIN = false;
    __device__ __forceinline__ bool keep(const Unit&) const { return false; }
    bf16_t* gl; const bf16_t* z; const float* bias;
    __device__ __forceinline__ void operator()(const f32x4 (&acc)[2][2][4][2], const Unit& u, int wr, int wc, int fr, int fq) const {
#pragma unroll
        for (int ai = 0; ai < 2; ++ai)
#pragma unroll
            for (int m = 0; m < 4; ++m) {
                const int row = u.pm * BM + ai * HALF + wr * 64 + m * 16 + fr;
#pragma unroll
                for (int bj = 0; bj < 2; ++bj) {
                    const int col = u.pn * BM + bj * HALF + wc * 32 + 8 * fq;
                    const f32x4 v0 = acc[ai][bj][m][0], v1 = acc[ai][bj][m][1];
                    const f32x4 b0 = *(const f32x4*)(bias + col), b1 = *(const f32x4*)(bias + col + 4);
                    const u32x4 zz = *(const u32x4*)(z + (size_t)row * 512 + col);
                    float o[8];
                    o[0] = bflo(zz.x) * sigmoidf_(v0[0] + b0[0]); o[1] = bfhi(zz.x) * sigmoidf_(v0[1] + b0[1]);
                    o[2] = bflo(zz.y) * sigmoidf_(v0[2] + b0[2]); o[3] = bfhi(zz.y) * sigmoidf_(v0[3] + b0[3]);
                    o[4] = bflo(zz.z) * sigmoidf_(v1[0] + b1[0]); o[5] = bfhi(zz.z) * sigmoidf_(v1[1] + b1[1]);
                    o[6] = bflo(zz.w) * sigmoidf_(v1[2] + b1[2]); o[7] = bfhi(zz.w) * sigmoidf_(v1[3] + b1[3]);
                    u32x4 w; w.x = cvt_pk_bf16(o[0], o[1]); w.y = cvt_pk_bf16(o[2], o[3]); w.z = cvt_pk_bf16(o[4], o[5]); w.w = cvt_pk_bf16(o[6], o[7]);
                    *(u32x4*)(gl + (size_t)row * 512 + col) = w;
                }
            }
    }
};
template <int M, int N>
struct PairOrder {
    StaticOrder<M, N> S;
    __device__ void init(int G_, int c_) { S.init(G_, c_); }
    __device__ bool next(int i, Unit& u) const { if (!S.next(i >> 1, u)) return false; u.g = i & 1; return true; }
    __device__ __forceinline__ void a_ready(const Unit&) const {}
    __device__ __forceinline__ void done(const Unit&) const {}
};
struct EpiMerge {
    static constexpr bool PERM = true, AFTER_DRAIN = false;
    __device__ __forceinline__ bool keep(const Unit& u) const { return u.g == 0; }
    bf16_t* merged; const bf16_t* ga; const bf16_t* gb;
    __device__ __forceinline__ void operator()(f32x4 (&acc)[2][2][4][2], const Unit& u, int wr, int wc, int fr, int fq) const {
#pragma unroll
        for (int ai = 0; ai < 2; ++ai)
#pragma unroll
            for (int m = 0; m < 4; ++m) {
                const int row = u.pm * BM + ai * HALF + wr * 64 + m * 16 + fr;
#pragma unroll
                for (int bj = 0; bj < 2; ++bj) {
                    const int col = u.pn * BM + bj * HALF + wc * 32 + 8 * fq;
                    const u32x4 a4 = *(const u32x4*)(ga + (size_t)row * DM + col);
                    float sa[8];
#pragma unroll
                    for (int q = 0; q < 4; ++q) { sa[2 * q] = sigmoidf_(bflo(a4[q])); sa[2 * q + 1] = sigmoidf_(bfhi(a4[q])); }
                    if (u.g == 0) {
                        const u32x4 b4 = *(const u32x4*)(gb + (size_t)row * DM + col);
#pragma unroll
                        for (int q = 0; q < 4; ++q) {
                            const float r0 = sigmoidf_(bflo(b4[q])) / sa[2 * q], r1 = sigmoidf_(bfhi(b4[q])) / sa[2 * q + 1];
                            acc[ai][bj][m][q >> 1][(q & 1) * 2] *= r0; acc[ai][bj][m][q >> 1][(q & 1) * 2 + 1] *= r1;
                        }
                    } else {
                        const f32x4 v0 = acc[ai][bj][m][0], v1 = acc[ai][bj][m][1];
                        u32x4 w; w[0] = cvt_pk_bf16(v0[0] * sa[0], v0[1] * sa[1]); w[1] = cvt_pk_bf16(v0[2] * sa[2], v0[3] * sa[3]); w[2] = cvt_pk_bf16(v1[0] * sa[4], v1[1] * sa[5]); w[3] = cvt_pk_bf16(v1[2] * sa[6], v1[3] * sa[7]);
                        *(u32x4*)(merged + (size_t)row * DM + col) = w;
                    }
                }
                asm volatile("" ::: "memory");
            }
    }
};
struct EpiOut {
    static constexpr bool PERM = true, AFTER_DRAIN = false;
    __device__ __forceinline__ bool keep(const Unit&) const { return false; }
    const float* x; float* x1; bf16_t* x1g; const float* mod; const float* g2; float* rowss;
    __device__ __forceinline__ void operator()(const f32x4 (&acc)[2][2][4][2], const Unit& u, int wr, int wc, int fr, int fq) const {
#pragma unroll
        for (int ai = 0; ai < 2; ++ai)
#pragma unroll
            for (int m = 0; m < 4; ++m) {
                const int row = u.pm * BM + ai * HALF + wr * 64 + m * 16 + fr;
                const float* modb = mod + (size_t)(row >> 12) * (6 * DM);
                float ss = 0.f;
#pragma unroll
                for (int bj = 0; bj < 2; ++bj) {
                    const int col = u.pn * BM + bj * HALF + wc * 32 + 8 * fq;
#pragma unroll
                    for (int n = 0; n < 2; ++n) {
                        const int cc = col + 4 * n;
                        const f32x4 v = acc[ai][bj][m][n];
                        const f32x4 xx = *(const f32x4*)(x + (size_t)row * DM + cc);
                        const f32x4 g1 = *(const f32x4*)(modb + 2 * DM + cc), sc = *(const f32x4*)(modb + 4 * DM + cc), gg = *(const f32x4*)(g2 + cc);
                        const f32x4 o = xx + g1 * v;
                        *(f32x4*)(x1 + (size_t)row * DM + cc) = o;
                        ss += o[0] * o[0] + o[1] * o[1] + o[2] * o[2] + o[3] * o[3];
                        const f32x4 og = o * gg * (sc + 1.f);
                        u32x2 w; w.x = cvt_pk_bf16(og[0], og[1]); w.y = cvt_pk_bf16(og[2], og[3]);
                        *(u32x2*)(x1g + (size_t)row * DM + cc) = w;
                    }
                }
                ss += __shfl_xor(ss, 16); ss += __shfl_xor(ss, 32);
                if (fq == 0) atomicAdd(rowss + row, ss);
            }
    }
};
struct EpiQ {
    static constexpr bool PERM = true, AFTER_DRAIN = false;
    __device__ __forceinline__ bool keep(const Unit&) const { return false; }
    bf16_t* qp; const float* rowss; const float* c2;
    __device__ __forceinline__ void operator()(const f32x4 (&acc)[2][2][4][2], const Unit& u, int wr, int wc, int fr, int fq) const {
#pragma unroll
        for (int ai = 0; ai < 2; ++ai)
#pragma unroll
            for (int m = 0; m < 4; ++m) {
                const int row = u.pm * BM + ai * HALF + wr * 64 + m * 16 + fr;
                const float rstd = rsqrtf(rowss[row] * (1.f / DM) + EPSN);
                const float* cb = c2 + (size_t)(row >> 12) * 2048;
#pragma unroll
                for (int bj = 0; bj < 2; ++bj) {
                    const int col = u.pn * BM + bj * HALF + wc * 32 + 8 * fq;
                    const f32x4 v0 = acc[ai][bj][m][0] * rstd + *(const f32x4*)(cb + col), v1 = acc[ai][bj][m][1] * rstd + *(const f32x4*)(cb + col + 4);
                    u32x4 w; w.x = cvt_pk_bf16(v0[0], v0[1]); w.y = cvt_pk_bf16(v0[2], v0[3]); w.z = cvt_pk_bf16(v1[0], v1[1]); w.w = cvt_pk_bf16(v1[2], v1[3]);
                    *(u32x4*)(qp + (size_t)row * 2048 + col) = w;
                }
            }
    }
};
struct EpiE {
    static constexpr bool PERM = true, AFTER_DRAIN = false;
    __device__ __forceinline__ bool keep(const Unit&) const { return false; }
    float* E;
    __device__ __forceinline__ void operator()(const f32x4 (&acc)[2][2][4][2], const Unit& u, int wr, int wc, int fr, int fq) const {
#pragma unroll
        for (int ai = 0; ai < 2; ++ai)
#pragma unroll
            for (int m = 0; m < 4; ++m) {
                const int row = u.pm * BM + ai * HALF + wr * 64 + m * 16 + fr;
#pragma unroll
                for (int bj = 0; bj < 2; ++bj) {
                    const int col = u.pn * BM + bj * HALF + wc * 32 + 8 * fq;
                    float* d = E + ((size_t)(u.g * SSM_ROWS + row) * 256 + col);
                    *(f32x4*)d = acc[ai][bj][m][0]; *(f32x4*)(d + 4) = acc[ai][bj][m][1];
                }
            }
    }
};
struct EpiZ {
    static constexpr bool PERM = true, AFTER_DRAIN = false;
    __device__ __forceinline__ bool keep(const Unit&) const { return false; }
    bf16_t* z;
    __device__ __forceinline__ void operator()(const f32x4 (&acc)[2][2][4][2], const Unit& u, int wr, int wc, int fr, int fq) const {
#pragma unroll
        for (int ai = 0; ai < 2; ++ai)
#pragma unroll
            for (int m = 0; m < 4; ++m) {
                const int n = u.pm * BM + ai * HALF + wr * 64 + m * 16 + fr;
                const size_t tok0 = (size_t)(n >> 7) * SEQL + (size_t)(n & 127) * 32;
#pragma unroll
                for (int bj = 0; bj < 2; ++bj) {
                    const int col = u.pn * BM + bj * HALF + wc * 32 + 8 * fq;
                    const f32x4 v0 = acc[ai][bj][m][0], v1 = acc[ai][bj][m][1];
                    u32x4 w; w.x = cvt_pk_bf16(gelu_tanh(v0[0]), gelu_tanh(v0[1])); w.y = cvt_pk_bf16(gelu_tanh(v0[2]), gelu_tanh(v0[3]));
                    w.z = cvt_pk_bf16(gelu_tanh(v1[0]), gelu_tanh(v1[1])); w.w = cvt_pk_bf16(gelu_tanh(v1[2]), gelu_tanh(v1[3]));
                    *(u32x4*)(z + (tok0 + (col >> 4)) * 512 + u.g * 16 + (col & 15)) = w;
                }
            }
    }
};
}

__device__ __forceinline__ void sincos_d(double th, double& s, double& c) {
    const double twopi = 6.283185307179586476925, hpi = 1.570796326794896619231;
    th -= twopi * rint(th / twopi);
    const double q = rint(th / hpi); const double y = th - q * hpi, y2 = y * y;
    const double sy = y * (1.0 - y2 / 6.0 * (1.0 - y2 / 20.0 * (1.0 - y2 / 42.0 * (1.0 - y2 / 72.0 * (1.0 - y2 / 110.0 * (1.0 - y2 / 156.0 * (1.0 - y2 / 210.0)))))));
    const double cy = 1.0 - y2 / 2.0 * (1.0 - y2 / 12.0 * (1.0 - y2 / 30.0 * (1.0 - y2 / 56.0 * (1.0 - y2 / 90.0 * (1.0 - y2 / 132.0 * (1.0 - y2 / 182.0))))));
    const int qi = ((int)q) & 3;
    s = qi == 0 ? sy : (qi == 1 ? cy : (qi == 2 ? -sy : -cy));
    c = qi == 0 ? cy : (qi == 1 ? -sy : (qi == 2 ? -cy : sy));
}
__device__ __forceinline__ void ssm_prep_item(const P& p, LAS unsigned char* lds, int item) {
    const int g = item >> 2, qtr = item & 3, tid = threadIdx.x;
    LAS f32x2* lamk = (LAS f32x2*)lds;
    LAS f32x2* Bb = lamk + 2 * 64 * 33;
    LAS f32x2* Cc = Bb + 2 * 64 * 16;
    LAS float* Kc = (LAS float*)(Cc + 2 * 16 * 64);
    if (tid < 128) {
        const int d = tid >> 6, pp = tid & 63, gi = d * 32 + g;
        const double are = (double)p.a_re[gi * 64 + pp], aim = (double)p.a_im[gi * 64 + pp];
        const double dt = (double)expf(p.log_dt[gi]);
        const double er = exp(are * dt); double sn, cs; sincos_d(aim * dt, sn, cs);
        const double lr = er * cs, li = er * sn;
        double pr = 1.0, pi_ = 0.0;
        for (int k = 0; k <= 32; ++k) {
            lamk[(d * 64 + pp) * 33 + k] = (f32x2){(float)pr, (float)pi_};
            const double nr_ = pr * lr - pi_ * li, ni_ = pr * li + pi_ * lr; pr = nr_; pi_ = ni_;
        }
        if (qtr == 0) { const f32x2 l32 = lamk[(d * 64 + pp) * 33 + 32]; *(f32x2*)(p.lamT() + (size_t)(gi * 64 + pp) * 2) = l32; }
        const double nr = lr - 1.0, ni = li, den = are * are + aim * aim;
        const double qr = (nr * are + ni * aim) / den, qi = (ni * are - nr * aim) / den;
        for (int h = 0; h < 16; ++h) {
            const double br = (double)p.b_re[((size_t)gi * 64 + pp) * 16 + h], bi = (double)p.b_im[((size_t)gi * 64 + pp) * 16 + h];
            Bb[(d * 64 + pp) * 16 + h] = (f32x2){(float)(qr * br - qi * bi), (float)(qr * bi + qi * br)};
        }
    }
    for (int e = tid; e < 2 * 16 * 64; e += NT) {
        const int d = e >> 10, h = (e >> 6) & 15, pp = e & 63; const size_t src = ((size_t)(d * 32 + g) * 16 + h) * 64 + pp;
        Cc[e] = (f32x2){p.c_re[src], p.c_im[src]};
    }
    __syncthreads();
    for (int e = tid; e < 2 * 32 * 16; e += NT) {
        const int d = e >> 9, k = (e >> 4) & 31, h = e & 15;
        float sacc[16];
#pragma unroll
        for (int h2 = 0; h2 < 16; ++h2) sacc[h2] = 0.f;
        for (int pp = 0; pp < 64; ++pp) {
            const f32x2 c = Cc[(d * 16 + h) * 64 + pp], l = lamk[(d * 64 + pp) * 33 + k];
            const float clr = c[0] * l[0] - c[1] * l[1], cli = c[0] * l[1] + c[1] * l[0];
            const LAS f32x4* bp = (const LAS f32x4*)(Bb + (d * 64 + pp) * 16);
#pragma unroll
            for (int q = 0; q < 8; ++q) { const f32x4 b2 = bp[q]; sacc[2 * q] += clr * b2[0] - cli * b2[1]; sacc[2 * q + 1] += clr * b2[2] - cli * b2[3]; }
        }
#pragma unroll
        for (int h2 = 0; h2 < 16; ++h2) Kc[((d * 32 + k) * 16 + h) * 16 + h2] = sacc[h2];
    }
    __syncthreads();
    for (int ch = tid; ch < 128 * 96; ch += NT) {
        const int mrow = 128 * qtr + ch / 96, k0 = (ch % 96) * 8, ii = mrow >> 4, h = mrow & 15;
        float v[8];
        if (k0 < 512) {
            const int jj = k0 >> 4, h20 = k0 & 15;
#pragma unroll
            for (int i = 0; i < 8; ++i) {
                const int h2 = h20 + i; float val = 0.f;
                if (ii >= jj) val += Kc[((0 * 32 + (ii - jj)) * 16 + h) * 16 + h2];
                if (jj >= ii) val += Kc[((1 * 32 + (jj - ii)) * 16 + h) * 16 + h2];
                if (ii == jj && h == h2) val += p.ssm_d[g * 16 + h];
                v[i] = val;
            }
        } else {
            const int sc = k0 - 512, d = sc >> 7, ri = (sc >> 6) & 1, p0 = sc & 63, e = d == 0 ? ii + 1 : 32 - ii;
#pragma unroll
            for (int i = 0; i < 8; ++i) {
                const int pp = p0 + i; const f32x2 c = Cc[(d * 16 + h) * 64 + pp], l = lamk[(d * 64 + pp) * 33 + e];
                const float clr = c[0] * l[0] - c[1] * l[1], cli = c[0] * l[1] + c[1] * l[0];
                v[i] = ri == 0 ? clr : -cli;
            }
        }
        u32x4 o; o.x = pk2(v[0], v[1]); o.y = pk2(v[2], v[3]); o.z = pk2(v[4], v[5]); o.w = pk2(v[6], v[7]);
        *(u32x4*)(p.Kmat() + ((size_t)(g * 512 + mrow) * SSM_LD + k0)) = o;
    }
    for (int ch = tid; ch < 64 * 64; ch += NT) {
        const int nrow = 64 * qtr + ch / 64, k0 = (ch % 64) * 8, d = nrow >> 7, ri = (nrow >> 6) & 1, pp = nrow & 63;
        const int jj = k0 >> 4, h20 = k0 & 15, e = d == 0 ? 31 - jj : jj;
        const f32x2 l = lamk[(d * 64 + pp) * 33 + e];
        float v[8];
#pragma unroll
        for (int i = 0; i < 8; ++i) { const f32x2 b = Bb[(d * 64 + pp) * 16 + h20 + i]; v[i] = ri == 0 ? (l[0] * b[0] - l[1] * b[1]) : (l[0] * b[1] + l[1] * b[0]); }
        u32x4 o; o.x = pk2(v[0], v[1]); o.y = pk2(v[2], v[3]); o.z = pk2(v[4], v[5]); o.w = pk2(v[6], v[7]);
        *(u32x4*)(p.Win() + ((size_t)(g * 256 + nrow) * 512 + k0)) = o;
    }
    __syncthreads();
}
__device__ __forceinline__ void ph_carry(const P& p) {
    int tid = threadIdx.x; asm volatile("" : "+v"(tid));
    if (tid >= 128) return;
    for (int gidx = blockIdx.x * 128 + tid; gidx < 32 * 8 * 2 * 64; gidx += gridDim.x * 128) {
        const int pp = gidx & 63, d = (gidx >> 6) & 1, b = (gidx >> 7) & 7, g = gidx >> 10;
        const f32x2 lt = *(const f32x2*)(p.lamT() + (size_t)((d * 32 + g) * 64 + pp) * 2);
        const float* Eg = p.E() + (size_t)g * SSM_ROWS * 256 + d * 128 + pp;
        bf16_t* Ug = p.U() + (size_t)g * SSM_ROWS * SSM_LD + 512 + d * 128 + pp;
        float fr = 0.f, fi = 0.f;
#pragma unroll
        for (int cc = 0; cc < 8; ++cc) {
            const int n = 1024 + b * 8 + (d == 0 ? cc : 7 - cc);
            const float er = Eg[(size_t)n * 256], ei = Eg[(size_t)n * 256 + 64];
            const float nr = lt[0] * fr - lt[1] * fi + er, ni = lt[0] * fi + lt[1] * fr + ei; fr = nr; fi = ni;
        }
#pragma unroll 8
        for (int c = 0; c < 128; ++c) {
            const int n = b * 128 + (d == 0 ? c : 127 - c);
            const float er = Eg[(size_t)n * 256], ei = Eg[(size_t)n * 256 + 64];
            Ug[(size_t)n * SSM_LD] = (bf16_t)f2bf(fr); Ug[(size_t)n * SSM_LD + 64] = (bf16_t)f2bf(fi);
            const float nr = lt[0] * fr - lt[1] * fi + er, ni = lt[0] * fi + lt[1] * fr + ei; fr = nr; fi = ni;
        }
    }
}


__device__ __forceinline__ void p0_transpose_item(const float* W, int K, int N, bf16_t* WT, LAS float* scr, int item, int lane) {
    const int nblk = N / 32, kb = item / nblk, nb = item % nblk, k0 = 64 * kb, n0 = 32 * nb;
#pragma unroll 8
    for (int i = 0; i < 32; ++i) { const int kk = 2 * i + (lane >> 5); scr[kk * 33 + (lane & 31)] = W[(size_t)(k0 + kk) * N + n0 + (lane & 31)]; }
    asm volatile("s_waitcnt lgkmcnt(0)" ::: "memory");
    const int c = lane & 7;
#pragma unroll
    for (int j = 0; j < 4; ++j) { const int n = (lane >> 3) + 8 * j; const LAS float* s = scr + (8 * c) * 33 + n;
        u32x4 o; o.x = pk2(s[0 * 33], s[1 * 33]); o.y = pk2(s[2 * 33], s[3 * 33]); o.z = pk2(s[4 * 33], s[5 * 33]); o.w = pk2(s[6 * 33], s[7 * 33]);
        *(u32x4*)(WT + (size_t)(n0 + n) * K + k0 + 8 * c) = o; }
    asm volatile("s_waitcnt lgkmcnt(0)" ::: "memory");
}

template <int NR, bool SILU>
__device__ __forceinline__ void gemv_block64(const float* const (&rows)[NR], const float* W, int ldw, int col0, const float* bias, float* y, int ldy, LAS float* scr) {
    const int wave = threadIdx.x >> 6, lane = threadIdx.x & 63;
    LAS float* act = scr + 8 * NR * 64;
#pragma unroll
    for (int r = 0; r < NR; ++r) for (int k = threadIdx.x; k < DM; k += NT) { const float s = rows[r][k]; act[r * DM + k] = SILU ? siluf_(s) : s; }
    __syncthreads();
    float acc[NR];
#pragma unroll
    for (int r = 0; r < NR; ++r) acc[r] = 0.f;
    const int kb = wave * 128;
#pragma unroll 8
    for (int k = kb; k < kb + 128; ++k) {
        const float w = W[(size_t)k * ldw + col0 + lane];
#pragma unroll
        for (int r = 0; r < NR; ++r) acc[r] += act[r * DM + k] * w;
    }
#pragma unroll
    for (int r = 0; r < NR; ++r) scr[(wave * NR + r) * 64 + lane] = acc[r];
    __syncthreads();
    for (int e = threadIdx.x; e < NR * 64; e += NT) {
        const int r = e >> 6, l = e & 63; float s = 0.f;
#pragma unroll
        for (int w = 0; w < 8; ++w) s += scr[(w * NR + r) * 64 + l];
        y[(size_t)r * ldy + col0 + l] = s + (bias ? bias[col0 + l] : 0.f);
    }
    __syncthreads();
}

__device__ __forceinline__ void ph_prep(const P& p, LAS unsigned char* lds) {
    int tid_ = threadIdx.x; asm volatile("" : "+v"(tid_));
    const int wave = tid_ >> 6, lane = tid_ & 63, G = gridDim.x;
    for (int cb = blockIdx.x; cb < 96; cb += G) {
        const float* const rows[9] = {p.c, p.c + DM, p.c + 2 * DM, p.c + 3 * DM, p.c + 4 * DM, p.c + 5 * DM, p.c + 6 * DM, p.c + 7 * DM, p.c_ctx};
        gemv_block64<9, true>(rows, p.w_mod, 6 * DM, cb * 64, p.b_mod, p.mod(), 6 * DM, (LAS float*)lds);
    }
    for (int it = G - 1 - (int)blockIdx.x; it < 128; it += G) ssm_prep_item(p, lds, it);
    {
        LAS float* scr = (LAS float*)(lds + wave * 16384);
        const int gw = blockIdx.x * NWAVES + wave, NGW = G * NWAVES;
        constexpr int I_IN = (DM / 64) * (INC / 32), I_GLU = (512 / 64) * (512 / 32), I_A = (512 / 64) * (DM / 32), I_OUT = (DM / 64) * (DM / 32), I_Q = (DM / 64) * (2048 / 32);
        constexpr int NITEMS = I_IN + I_GLU + 2 * I_A + I_OUT + I_Q;
        for (int it = gw; it < NITEMS; it += NGW) {
            int r = it;
            if (r < I_IN) { p0_transpose_item(p.w_in, DM, INC, p.w_in_t(), scr, r, lane); continue; } r -= I_IN;
            if (r < I_GLU) { p0_transpose_item(p.w_glu, 512, 512, p.w_glu_t(), scr, r, lane); continue; } r -= I_GLU;
            if (r < I_A) { p0_transpose_item(p.w_a, 512, DM, p.w_a_t(), scr, r, lane); continue; } r -= I_A;
            if (r < I_A) { p0_transpose_item(p.w_b, 512, DM, p.w_b_t(), scr, r, lane); continue; } r -= I_A;
            if (r < I_OUT) { p0_transpose_item(p.w_out, DM, DM, p.w_out_t(), scr, r, lane); continue; } r -= I_OUT;
            p0_transpose_item(p.w_q, DM, 2048, p.w_q_t(), scr, r, lane);
        }
    }
}

__device__ __forceinline__ void bg_convert_tables(const P& p) {
    int tid_ = threadIdx.x; asm volatile("" : "+v"(tid_));
    const int lane = tid_ & 63;
    unsigned* head = p.queues() + 16 * 64;
    for (;;) {
        unsigned v = 0u; if (lane == 0) v = __hip_atomic_fetch_add(head, 4u, __ATOMIC_RELAXED, __HIP_MEMORY_SCOPE_AGENT);
        const int r0 = (int)__builtin_amdgcn_readfirstlane(v);
        if (r0 >= 2 * 16384) break;
        const bool second = r0 >= 16384; const int rr0 = second ? r0 - 16384 : r0;
        const float* src = (second ? p.peer_v : p.peer_u) + (size_t)rr0 * DM + lane * 16;
        unsigned char* dst = (second ? p.pv8() : p.pu8()) + (size_t)(lane >> 3) * (16384 * 128) + (size_t)rr0 * 128 + (lane & 7) * 16;
        f32x4 v4[4][4];
#pragma unroll
        for (int q = 0; q < 4; ++q)
#pragma unroll
            for (int j = 0; j < 4; ++j) v4[q][j] = *(const f32x4*)(src + q * DM + 4 * j);
        float inv = 1.f;
#pragma unroll
        for (int q = 0; q < 4; ++q) {
            float am = 0.f;
#pragma unroll
            for (int j = 0; j < 4; ++j) am = fmaxf(am, fmaxf(fmaxf(fabsf(v4[q][j][0]), fabsf(v4[q][j][1])), fmaxf(fabsf(v4[q][j][2]), fabsf(v4[q][j][3]))));
            am = wave_max(am);
            const float sc = am > 0.f ? 448.f / am : 1.f;
            u32x4 o;
#pragma unroll
            for (int j = 0; j < 4; ++j) { int w = 0; w = __builtin_amdgcn_cvt_pk_fp8_f32(v4[q][j][0] * sc, v4[q][j][1] * sc, w, false); w = __builtin_amdgcn_cvt_pk_fp8_f32(v4[q][j][2] * sc, v4[q][j][3] * sc, w, true); o[j] = (unsigned)w; }
            *(u32x4*)(dst + q * 128) = o;
            inv = lane == q ? (am > 0.f ? am * (1.f / 448.f) : 1.f) : inv;
        }
        if (lane < 4) p.pisc()[r0 + lane] = inv;
    }
}

__device__ __forceinline__ void normmod_row_bf16(const float* src, bf16_t* dst, const float* g, const float* shift, const float* scale, int lane) {
    const f32x4* s = (const f32x4*)src;
    f32x4 v[4]; float ss = 0.f;
#pragma unroll
    for (int j = 0; j < 4; ++j) { v[j] = s[lane + 64 * j]; ss += v[j][0] * v[j][0] + v[j][1] * v[j][1] + v[j][2] * v[j][2] + v[j][3] * v[j][3]; }
    ss = wave_sum(ss);
    const float rstd = rsqrtf(ss * (1.f / DM) + EPSN);
#pragma unroll
    for (int j = 0; j < 4; ++j) {
        const int i4 = lane + 64 * j;
        const f32x4 gg = ((const f32x4*)g)[i4], sh = ((const f32x4*)shift)[i4], sc = ((const f32x4*)scale)[i4];
        const f32x4 o = v[j] * rstd * gg * (sc + 1.f) + sh;
        u32x2 w; w.x = pk2(o[0], o[1]); w.y = pk2(o[2], o[3]);
        *(u32x2*)(dst + (size_t)i4 * 4) = w;
    }
}
__device__ __forceinline__ void ph_norm1(const P& p, LAS unsigned char* lds) {
    int tid_ = threadIdx.x; asm volatile("" : "+v"(tid_));
    const int wave = tid_ >> 6, lane = tid_ & 63, G = gridDim.x;
    for (int cb = blockIdx.x; cb < 32; cb += G) {
        const float* m3 = p.mod() + 3 * DM;
        const float* const rows[8] = {m3, m3 + 6 * DM, m3 + 12 * DM, m3 + 18 * DM, m3 + 24 * DM, m3 + 30 * DM, m3 + 36 * DM, m3 + 42 * DM};
        gemv_block64<8, false>(rows, p.w_q, 2048, cb * 64, nullptr, p.c2(), 2048, (LAS float*)lds);
    }
    for (int r = blockIdx.x * NWAVES + wave; r < NTOK + NCTX; r += G * NWAVES) {
        if (r < NTOK) { const float* modb = p.mod() + (size_t)(r >> 12) * (6 * DM); normmod_row_bf16(p.x + (size_t)r * DM, p.hx() + (size_t)r * DM, p.norm1_g, modb, modb + DM, lane); }
        else { const int rc = r - NTOK; const float* modc = p.mod() + 8 * (6 * DM); normmod_row_bf16(p.ctx + (size_t)rc * DM, p.hc() + (size_t)rc * DM, p.norm1_g, modc, modc + DM, lane); }
    }
}

constexpr int RPB_LD = 128, RPB_PAD = 48;
__device__ __forceinline__ void ph_na(const P& p, LAS unsigned char* lds) {
    int tid_ = threadIdx.x; asm volatile("" : "+v"(tid_));
    const int tid = tid_, h = __builtin_amdgcn_readfirstlane(tid >> 6), lane = tid & 63, lt = lane & 15, lq = lane >> 4;
    constexpr float LOG2E = 1.4426950408889634f, CS = 0.125f * LOG2E;
    LAS float* rp = (LAS float*)lds;
    for (int e = tid; e < 8 * 15 * RPB_LD; e += NT) { const int c = (e & (RPB_LD - 1)) - RPB_PAD; rp[e] = (c >= 0 && c < 31) ? p.rpb[(e / RPB_LD) * 31 + c] * LOG2E : 0.f; }
    __syncthreads();
    const int pa = (lt >> 2) * 8 + (lt & 3);
    const unsigned lane_k = pa * 512 + lq * 8, lane_v = lt * 64 + lq * 8, lane_q = lt * 512 + lq * 8, lane_o = lt * 512 + lq * 4;
    for (int item = blockIdx.x; item < NB * GW; item += gridDim.x) {
        const int b = item >> 6, r = item & 63;
        int r0 = r - 4; r0 = r0 < 0 ? 0 : (r0 > 56 ? 56 : r0);
        const bf16_t* Kb = p.kb() + ((size_t)b * SEQL + (size_t)r0 * GW) * 512 + h * 64;
        const bf16_t* Kc = p.kc() + ((size_t)b * CTXL) * 512 + h * 64;
        const bf16_t* Vt = p.vT() + ((size_t)((b * 8 + h) * 64 + r0)) * 4096;
        const bf16_t* Vc = p.vcT() + ((size_t)((b * 8 + h) * 4)) * 4096;
        const bf16_t* Qb = p.qb() + ((size_t)b * SEQL + r * GW) * 512 + h * 64;
        bf16_t* Ob = p.na() + ((size_t)b * SEQL + r * GW) * 512 + h * 64;
        const LAS float* rph = rp + (h * 15 + (r0 - r + 7)) * RPB_LD;
        bf16x8 qf[4][2];
#pragma unroll
        for (int qt = 0; qt < 4; ++qt) { qf[qt][0] = *(const bf16x8*)(Qb + qt * 16 * 512 + lane_q); qf[qt][1] = *(const bf16x8*)(Qb + qt * 16 * 512 + 32 + lane_q); }
        f32x4 o[4][4]; float m[4], l[4];
#pragma unroll
        for (int qt = 0; qt < 4; ++qt) { m[qt] = -1e30f; l[qt] = 0.f;
#pragma unroll
            for (int d = 0; d < 4; ++d) o[qt][d] = (f32x4){0.f, 0.f, 0.f, 0.f}; }
        bf16x8 kf[2][2][2];
#pragma unroll
        for (int st = 0; st < 2; ++st)
#pragma unroll
            for (int ab = 0; ab < 2; ++ab) { kf[st][ab][0] = *(const bf16x8*)(Kb + (st * 32 + ab * 4) * 512 + lane_k); kf[st][ab][1] = *(const bf16x8*)(Kb + (st * 32 + ab * 4) * 512 + 32 + lane_k); }
#pragma unroll 1
        for (int i = 0; i < 8; ++i) {
            bf16x8 vf[2][4];
#pragma unroll
            for (int st = 0; st < 2; ++st)
#pragma unroll
                for (int d = 0; d < 4; ++d) vf[st][d] = *(const bf16x8*)(Vt + i * 4096 + d * 1024 + st * 32 + lane_v);
            const LAS float* rr_ = rph + i * RPB_LD;
#pragma unroll
            for (int half = 0; half < 2; ++half) {
                f32x4 s[2][2][2];
#pragma unroll
                for (int q2 = 0; q2 < 2; ++q2) {
                    const int qt = half * 2 + q2;
#pragma unroll
                    for (int st = 0; st < 2; ++st) {
                        if ((st == 0 && qt == 3) || (st == 1 && qt == 0)) continue;
#pragma unroll
                        for (int ab = 0; ab < 2; ++ab) {
                            f32x4 c = {0.f, 0.f, 0.f, 0.f};
                            c = __builtin_amdgcn_mfma_f32_16x16x32_bf16(kf[st][ab][0], qf[qt][0], c, 0, 0, 0);
                            c = __builtin_amdgcn_mfma_f32_16x16x32_bf16(kf[st][ab][1], qf[qt][1], c, 0, 0, 0);
                            s[q2][st][ab] = c;
                        }
                    }
                }
                if (half == 1) {
                    if (i < 7) {
#pragma unroll
                        for (int st = 0; st < 2; ++st)
#pragma unroll
                            for (int ab = 0; ab < 2; ++ab) { const bf16_t* kp = Kb + ((i + 1) * GW + st * 32 + ab * 4) * 512; kf[st][ab][0] = *(const bf16x8*)(kp + lane_k); kf[st][ab][1] = *(const bf16x8*)(kp + 32 + lane_k); }
                    } else {
#pragma unroll
                        for (int ab = 0; ab < 2; ++ab) { kf[0][ab][0] = *(const bf16x8*)(Kc + ab * 4 * 512 + lane_k); kf[0][ab][1] = *(const bf16x8*)(Kc + ab * 4 * 512 + 32 + lane_k); }
                    }
                }
#pragma unroll
                for (int q2 = 0; q2 < 2; ++q2) {
                    const int qt = half * 2 + q2;
                    const int qc = qt * 16 + lt; int c0 = qc - 8; c0 = c0 < 0 ? 0 : (c0 > 48 ? 48 : c0);
                    int wo = lq * 8 - c0; asm volatile("" : "+v"(wo));
                    float mx = -1e30f;
#pragma unroll
                    for (int st = 0; st < 2; ++st) {
                        if ((st == 0 && qt == 3) || (st == 1 && qt == 0)) continue;
                        const int kc0 = st * 32 + lq * 8, bbase = kc0 - qc + 15 + RPB_PAD;
#pragma unroll
                        for (int j = 0; j < 8; ++j) {
                            float t = s[q2][st][j >> 2][j & 3] * CS + rr_[bbase + j];
                            t = ((unsigned)(wo + st * 32 + j) < 16u) ? t : -1e30f;
                            s[q2][st][j >> 2][j & 3] = t; mx = fmaxf(mx, t);
                        }
                    }
                    mx = fmaxf(mx, __shfl_xor(mx, 16)); mx = fmaxf(mx, __shfl_xor(mx, 32));
                    const float mn = fmaxf(m[qt], mx), corr = __builtin_amdgcn_exp2f(m[qt] - mn);
                    m[qt] = mn; float ls = l[qt] * corr;
#pragma unroll
                    for (int d = 0; d < 4; ++d) o[qt][d] = o[qt][d] * corr;
#pragma unroll
                    for (int st = 0; st < 2; ++st) {
                        if ((st == 0 && qt == 3) || (st == 1 && qt == 0)) continue;
                        float pe[8];
#pragma unroll
                        for (int j = 0; j < 8; ++j) pe[j] = __builtin_amdgcn_exp2f(s[q2][st][j >> 2][j & 3] - mn);
                        ls += ((pe[0] + pe[1]) + (pe[2] + pe[3])) + ((pe[4] + pe[5]) + (pe[6] + pe[7]));
                        u32x4 pw; pw[0] = pg8::cvt_pk_bf16(pe[0], pe[1]); pw[1] = pg8::cvt_pk_bf16(pe[2], pe[3]); pw[2] = pg8::cvt_pk_bf16(pe[4], pe[5]); pw[3] = pg8::cvt_pk_bf16(pe[6], pe[7]);
                        const bf16x8 pf = __builtin_bit_cast(bf16x8, pw);
#pragma unroll
                        for (int d = 0; d < 4; ++d) o[qt][d] = __builtin_amdgcn_mfma_f32_16x16x32_bf16(vf[st][d], pf, o[qt][d], 0, 0, 0);
                    }
                    l[qt] = ls;
                }
            }
        }
#pragma unroll 1
        for (int cst = 0; cst < 8; ++cst) {
            bf16x8 vf[4];
#pragma unroll
            for (int d = 0; d < 4; ++d) vf[d] = *(const bf16x8*)(Vc + (cst >> 1) * 4096 + d * 1024 + (cst & 1) * 32 + lane_v);
            f32x4 s[4][2];
#pragma unroll
            for (int qt = 0; qt < 4; ++qt)
#pragma unroll
                for (int ab = 0; ab < 2; ++ab) {
                    f32x4 c = {0.f, 0.f, 0.f, 0.f};
                    c = __builtin_amdgcn_mfma_f32_16x16x32_bf16(kf[0][ab][0], qf[qt][0], c, 0, 0, 0);
                    c = __builtin_amdgcn_mfma_f32_16x16x32_bf16(kf[0][ab][1], qf[qt][1], c, 0, 0, 0);
                    s[qt][ab] = c;
                }
            if (cst < 7) {
#pragma unroll
                for (int ab = 0; ab < 2; ++ab) { const bf16_t* kp = Kc + ((cst + 1) * 32 + ab * 4) * 512; kf[0][ab][0] = *(const bf16x8*)(kp + lane_k); kf[0][ab][1] = *(const bf16x8*)(kp + 32 + lane_k); }
            }
#pragma unroll
            for (int qt = 0; qt < 4; ++qt) {
                float mx = -1e30f;
#pragma unroll
                for (int j = 0; j < 8; ++j) { const float t = s[qt][j >> 2][j & 3] * CS; s[qt][j >> 2][j & 3] = t; mx = fmaxf(mx, t); }
                mx = fmaxf(mx, __shfl_xor(mx, 16)); mx = fmaxf(mx, __shfl_xor(mx, 32));
                const float mn = fmaxf(m[qt], mx), corr = __builtin_amdgcn_exp2f(m[qt] - mn);
                m[qt] = mn;
#pragma unroll
                for (int d = 0; d < 4; ++d) o[qt][d] = o[qt][d] * corr;
                float pe[8];
#pragma unroll
                for (int j = 0; j < 8; ++j) pe[j] = __builtin_amdgcn_exp2f(s[qt][j >> 2][j & 3] - mn);
                l[qt] = l[qt] * corr + (((pe[0] + pe[1]) + (pe[2] + pe[3])) + ((pe[4] + pe[5]) + (pe[6] + pe[7])));
                u32x4 pw; pw[0] = pg8::cvt_pk_bf16(pe[0], pe[1]); pw[1] = pg8::cvt_pk_bf16(pe[2], pe[3]); pw[2] = pg8::cvt_pk_bf16(pe[4], pe[5]); pw[3] = pg8::cvt_pk_bf16(pe[6], pe[7]);
                const bf16x8 pf = __builtin_bit_cast(bf16x8, pw);
#pragma unroll
                for (int d = 0; d < 4; ++d) o[qt][d] = __builtin_amdgcn_mfma_f32_16x16x32_bf16(vf[d], pf, o[qt][d], 0, 0, 0);
            }
        }
#pragma unroll
        for (int qt = 0; qt < 4; ++qt) {
            float lv = l[qt]; lv += __shfl_xor(lv, 16); lv += __shfl_xor(lv, 32);
            const float inv = 1.f / lv;
            bf16_t* op = Ob + qt * 16 * 512 + lane_o;
#pragma unroll
            for (int d = 0; d < 4; ++d) { u32x2 w; w[0] = pg8::cvt_pk_bf16(o[qt][d][0] * inv, o[qt][d][1] * inv); w[1] = pg8::cvt_pk_bf16(o[qt][d][2] * inv, o[qt][d][3] * inv); *(u32x2*)(op + d * 16) = w; }
        }
    }
}

typedef __bf16 bf16x2_t __attribute__((ext_vector_type(2)));
__device__ __forceinline__ float dot2bf(unsigned a, unsigned b, float c) { return __builtin_amdgcn_fdot2_f32_bf16(__builtin_bit_cast(bf16x2_t, a), __builtin_bit_cast(bf16x2_t, b), c, false); }
__device__ __forceinline__ unsigned ordkey(float f) { unsigned u = __builtin_bit_cast(unsigned, f); return u ^ ((unsigned)((int)u >> 31) | 0x80000000u); }
__device__ __forceinline__ float unordkey(unsigned k) { return __builtin_bit_cast(float, k ^ ((k & 0x80000000u) ? 0x80000000u : 0xFFFFFFFFu)); }
template <bool DESC> __device__ __forceinline__ void cex(unsigned& a, unsigned& b) { const unsigned mx = a > b ? a : b, mn = a > b ? b : a; if (DESC) { a = mx; b = mn; } else { a = mn; b = mx; } }
__device__ __forceinline__ void sort16_desc(unsigned (&a)[16]) {
#pragma unroll
    for (int k = 2; k <= 16; k <<= 1)
#pragma unroll
        for (int j = k >> 1; j > 0; j >>= 1)
#pragma unroll
            for (int i = 0; i < 16; ++i) { const int l = i ^ j; if (l > i) { if ((i & k) == 0) cex<true>(a[i], a[l]); else cex<false>(a[i], a[l]); } }
}
__device__ __forceinline__ void merge16_desc(unsigned (&a)[16]) {
#pragma unroll
    for (int j = 8; j > 0; j >>= 1)
#pragma unroll
        for (int i = 0; i < 16; ++i) { const int l = i ^ j; if (l > i) cex<true>(a[i], a[l]); }
}
__device__ __forceinline__ void top16_merge(unsigned (&a)[16], const unsigned (&b)[16]) {
#pragma unroll
    for (int i = 0; i < 16; ++i) a[i] = a[i] > b[15 - i] ? a[i] : b[15 - i];
    merge16_desc(a);
}
struct PairTab { int i[52], j[52], n; };
constexpr PairTab make_pairs() { PairTab t{}; int n = 0; for (int i = 0; i < 16; ++i) for (int j = 0; j < 16; ++j) if ((i + 1) * (j + 1) <= 16) { t.i[n] = i; t.j[n] = j; ++n; } t.n = n; for (int k = n; k < 52; ++k) { t.i[k] = 0; t.j[k] = 0; } return t; }
constexpr PairTab PAIRS = make_pairs();
static_assert(PAIRS.n == 50, "50 candidate pairs");

constexpr int SK_LD = 136;
__device__ __forceinline__ void ph_peer_topk(const P& p, LAS unsigned char* lds) {
    int tid_ = threadIdx.x; asm volatile("" : "+v"(tid_));
    const int tid = tid_, wave = tid >> 6, lane = tid & 63;
    LAS bf16_t* sk = (LAS bf16_t*)lds;
    for (int e = tid; e < 2 * 128 * 16; e += NT) {
        const int row = e >> 4, c8 = (e & 15) * 8;
        const f32x4 a = *(const f32x4*)(p.subkeys + (size_t)row * 128 + c8), b = *(const f32x4*)(p.subkeys + (size_t)row * 128 + c8 + 4);
        u32x4 o; o.x = pk2(a[0], a[1]); o.y = pk2(a[2], a[3]); o.z = pk2(b[0], b[1]); o.w = pk2(b[2], b[3]);
        *(LAS u32x4*)(sk + row * SK_LD + c8) = o;
    }
    __syncthreads();
    const int lt = lane & 15, lq = lane >> 4;
    for (int tile = blockIdx.x * NWAVES + wave; tile < NTOK / 16; tile += gridDim.x * NWAVES) {
        const int tok = tile * 16 + lt;
        const bf16_t* qrow = p.qp() + (size_t)tok * 2048;
        for (int h = 0; h < 8; ++h) {
            unsigned s0[16], s1[16];
#pragma unroll
            for (int n = 0; n < 2; ++n) {
                bf16x8 bq[4];
#pragma unroll
                for (int ks = 0; ks < 4; ++ks) bq[ks] = *(const bf16x8*)(qrow + h * 256 + n * 128 + ks * 32 + lq * 8);
                unsigned a[16], b[16];
#pragma unroll
                for (int kb = 0; kb < 8; ++kb) {
                    f32x4 c = {0.f, 0.f, 0.f, 0.f};
#pragma unroll
                    for (int ks = 0; ks < 4; ++ks) {
                        const bf16x8 ak = *(const LAS bf16x8*)(sk + (n * 128 + kb * 16 + lt) * SK_LD + ks * 32 + lq * 8);
                        c = __builtin_amdgcn_mfma_f32_16x16x32_bf16(ak, bq[ks], c, 0, 0, 0);
                    }
#pragma unroll
                    for (int r = 0; r < 4; ++r) {
                        const unsigned key = (ordkey(c[r]) & ~127u) | (unsigned)(kb * 16 + lq * 4 + r);
                        if (kb < 4) a[kb * 4 + r] = key; else b[(kb - 4) * 4 + r] = key;
                    }
                    asm volatile("" ::: "memory");
                }
                sort16_desc(a); sort16_desc(b);
                top16_merge(a, b);
#pragma unroll
                for (int i = 0; i < 16; ++i) b[i] = __shfl_xor(a[i], 16);
                top16_merge(a, b);
#pragma unroll
                for (int i = 0; i < 16; ++i) b[i] = __shfl_xor(a[i], 32);
                top16_merge(a, b);
                if (n == 0) {
#pragma unroll
                    for (int i = 0; i < 16; ++i) s0[i] = a[i];
                } else {
#pragma unroll
                    for (int i = 0; i < 16; ++i) s1[i] = a[i];
                }
            }
            unsigned ck[16], ce_[13]; float cs[13];
#pragma unroll
            for (int s = 0; s < 13; ++s) {
                const unsigned k0 = lq == 0 ? s0[PAIRS.i[s * 4]] : (lq == 1 ? s0[PAIRS.i[s * 4 + 1]] : (lq == 2 ? s0[PAIRS.i[s * 4 + 2]] : s0[PAIRS.i[s * 4 + 3]]));
                const unsigned k1 = lq == 0 ? s1[PAIRS.j[s * 4]] : (lq == 1 ? s1[PAIRS.j[s * 4 + 1]] : (lq == 2 ? s1[PAIRS.j[s * 4 + 2]] : s1[PAIRS.j[s * 4 + 3]]));
                const float sum = unordkey(k0 & ~127u) + unordkey(k1 & ~127u);
                const bool valid = (s * 4 + lq) < PAIRS.n;
                cs[s] = sum; ce_[s] = (k0 & 127u) * 128u + (k1 & 127u);
                ck[s] = valid ? ((ordkey(sum) & ~63u) | (unsigned)(s * 4 + lq)) : 0u;
            }
            ck[13] = 0u; ck[14] = 0u; ck[15] = 0u;
            unsigned srt[16], ob[16];
#pragma unroll
            for (int i = 0; i < 16; ++i) srt[i] = ck[i];
            sort16_desc(srt);
#pragma unroll
            for (int i = 0; i < 16; ++i) ob[i] = __shfl_xor(srt[i], 16);
            top16_merge(srt, ob);
#pragma unroll
            for (int i = 0; i < 16; ++i) ob[i] = __shfl_xor(srt[i], 32);
            unsigned thr = 0xFFFFFFFFu;
#pragma unroll
            for (int i = 0; i < 16; ++i) { const unsigned v = srt[i] > ob[15 - i] ? srt[i] : ob[15 - i]; thr = v < thr ? v : thr; }
            const float mtop = unordkey(s0[0] & ~127u) + unordkey(s1[0] & ~127u);
            float zp = 0.f; int cnt = 0;
#pragma unroll
            for (int s = 0; s < 13; ++s) { const bool sel = ck[s] >= thr && ck[s] != 0u; const float e = sel ? __expf(cs[s] - mtop) : 0.f; cs[s] = e; zp += e; cnt += sel ? 1 : 0; }
            float z = zp; z += __shfl_xor(z, 16); z += __shfl_xor(z, 32);
            const float rz = 1.f / z;
            const int c0 = __shfl(cnt, lt), c1 = __shfl(cnt, lt + 16), c2 = __shfl(cnt, lt + 32);
            int pos = lq == 0 ? 0 : (lq == 1 ? c0 : (lq == 2 ? c0 + c1 : c0 + c1 + c2));
            unsigned short* dste = (unsigned short*)p.topk() + ((size_t)tok * 8 + h) * 16; float* dstg = p.gates() + ((size_t)tok * 8 + h) * 16;
#pragma unroll
            for (int s = 0; s < 13; ++s) {
                const bool sel = ck[s] >= thr && ck[s] != 0u;
                if (sel) { dste[pos] = (unsigned short)ce_[s]; dstg[pos] = cs[s] * rz; ++pos; }
            }
        }
    }
}

__device__ __forceinline__ unsigned xcc_id() { return (unsigned)__builtin_amdgcn_s_getreg((3 << 11) | 20) & 7u; }
__device__ __forceinline__ int q_grab(unsigned* head, int lane) { unsigned v = 0u; if (lane == 0) v = __hip_atomic_fetch_add(head, 16u, __ATOMIC_RELAXED, __HIP_MEMORY_SCOPE_AGENT); return (int)__builtin_amdgcn_readfirstlane(v); }

__device__ __forceinline__ void g_ids(const unsigned short* tkrow, unsigned lo_g16, u32x4 (&ids)[2]) {
#pragma unroll
    for (int q = 0; q < 2; ++q) ids[q] = *(const u32x4*)(tkrow + lo_g16 + q * 8);
}
__device__ __forceinline__ void g_wts(const float* wrow, unsigned lo_g16, f32x4 (&wts)[4]) {
#pragma unroll
    for (int q = 0; q < 4; ++q) wts[q] = *(const f32x4*)(wrow + lo_g16 + q * 4);
}
__device__ __forceinline__ void g_rows8(const unsigned char* tb, unsigned lo_c16, const u32x4& idh, u32x4 (&rows)[8]) {
#pragma unroll
    for (int i = 0; i < 8; ++i) {
        const unsigned w = idh[i >> 1];
        const unsigned e = (i & 1) ? (w >> 16) : (w & 0xffffu);
        rows[i] = *(const u32x4*)(tb + ((e << 7) + lo_c16));
    }
}
__device__ __forceinline__ void fmac_(float& d, float a, float b) { asm("v_fmac_f32_e32 %0, %1, %2" : "+v"(d) : "v"(a), "v"(b)); }
typedef _Float16 f16x2 __attribute__((ext_vector_type(2)));
__device__ __forceinline__ void g_dots8(const u32x4 (&uu)[8], const f16x2 (&hp)[8], float* pd) {
#pragma unroll
    for (int i = 0; i < 8; ++i) {
        float d = 0.f;
#pragma unroll
        for (int j = 0; j < 4; ++j) {
            const unsigned w = uu[i][j];
            d = __builtin_amdgcn_fdot2(__builtin_amdgcn_cvt_scalef32_pk_f16_fp8(w, 1.0f, false), hp[j * 2], d, false);
            d = __builtin_amdgcn_fdot2(__builtin_amdgcn_cvt_scalef32_pk_f16_fp8(w, 1.0f, true), hp[j * 2 + 1], d, false);
        }
        pd[i] = d;
    }
}
__device__ __forceinline__ void g_acc8(const u32x4 (&vv)[8], const f32x4& w0, const f32x4& w1, float (&acc)[16]) {
#pragma unroll
    for (int i = 0; i < 8; ++i) {
        const float w = i < 4 ? w0[i & 3] : w1[i & 3];
#pragma unroll
        for (int j = 0; j < 4; ++j) {
            const int wv = (int)vv[i][j];
            const f32x2 lo = __builtin_amdgcn_cvt_pk_f32_fp8(wv, false), hi = __builtin_amdgcn_cvt_pk_f32_fp8(wv, true);
            fmac_(acc[j * 4], w, lo[0]); fmac_(acc[j * 4 + 1], w, lo[1]); fmac_(acc[j * 4 + 2], w, hi[0]); fmac_(acc[j * 4 + 3], w, hi[1]);
        }
    }
}
template <int D4, int D2, int D1>
__device__ __forceinline__ void halve16(const float (&v)[16], int b4, int b2, int b1, float& o0, float& o1) {
    float r8[8], r4[4];
#pragma unroll
    for (int i = 0; i < 8; ++i) { const float keep = b4 ? v[i + 8] : v[i], send = b4 ? v[i] : v[i + 8]; r8[i] = keep + __shfl_xor(send, D4); }
#pragma unroll
    for (int i = 0; i < 4; ++i) { const float keep = b2 ? r8[i + 4] : r8[i], send = b2 ? r8[i] : r8[i + 4]; r4[i] = keep + __shfl_xor(send, D2); }
    { const float keep = b1 ? r4[2] : r4[0], send = b1 ? r4[0] : r4[2]; o0 = keep + __shfl_xor(send, D1); }
    { const float keep = b1 ? r4[3] : r4[1], send = b1 ? r4[1] : r4[3]; o1 = keep + __shfl_xor(send, D1); }
}

template <int WHICH>
__device__ __forceinline__ void ph_gather_sliced(const P& p) {
    int tid_ = threadIdx.x; asm volatile("" : "+v"(tid_));
    const int lane = tid_ & 63, c = lane & 7, g = lane >> 3;
    const unsigned xs = xcc_id();
    for (unsigned tr = 0; tr < 8; ++tr) {
        const int sl = (int)((xs + tr) & 7u);
        unsigned* head = p.queues() + (WHICH * 8 + sl) * 64;
        const unsigned char* tb = (WHICH == 0 ? p.pu8() : p.pv8()) + (size_t)sl * (16384 * 128);
        for (;;) {
            const int t0 = q_grab(head, lane);
            if (t0 >= NTOK) break;
            unsigned oc = c * 16, og = g * 16; asm volatile("" : "+v"(oc), "+v"(og));
            const unsigned short* idb = (const unsigned short*)p.topk() + (size_t)t0 * 128;
            const float* wb = p.wl() + (size_t)t0 * 128;
            const float* modb = p.mod() + (size_t)(t0 >> 12) * (6 * DM) + sl * 128;
            u32x4 idc[2], idn[2], RA[8], RB[8]; f32x4 wc[4], wn[4];
            g_ids(idb, og, idc); if (WHICH == 1) g_wts(wb, og, wc);
            g_rows8(tb, oc, idc[0], RA);
            if (WHICH == 0) {
                float A[16], Bs[16]; f32x4 xn[4];
                const float* xb = p.out + (size_t)t0 * DM + sl * 128;
#pragma unroll
                for (int j = 0; j < 4; ++j) {
                    const f32x4 gg = *(const f32x4*)(p.norm2_g + sl * 128 + oc + j * 4), sh = *(const f32x4*)(modb + 3 * DM + oc + j * 4), sc = *(const f32x4*)(modb + 4 * DM + oc + j * 4);
#pragma unroll
                    for (int i = 0; i < 4; ++i) { A[j * 4 + i] = gg[i] * (1.f + sc[i]); Bs[j * 4 + i] = sh[i]; }
                    xn[j] = *(const f32x4*)(xb + oc + j * 4);
                }
                const float rsl = rsqrtf(p.rowss()[t0 + (lane & 15)] * (1.f / DM) + EPSN);
#pragma unroll 1
                for (int t = t0; t < t0 + 16; ++t) {
                    const bool more = t + 1 < t0 + 16;
                    g_rows8(tb, oc, idc[1], RB);
                    f16x2 hv[8]; float pd[16];
                    const float rstd2 = __builtin_bit_cast(float, __builtin_amdgcn_readlane(__builtin_bit_cast(unsigned, rsl), t - t0));
#pragma unroll
                    for (int j = 0; j < 4; ++j) {
                        hv[j * 2] = __builtin_bit_cast(f16x2, __builtin_amdgcn_cvt_pkrtz(xn[j][0] * rstd2 * A[j * 4] + Bs[j * 4], xn[j][1] * rstd2 * A[j * 4 + 1] + Bs[j * 4 + 1]));
                        hv[j * 2 + 1] = __builtin_bit_cast(f16x2, __builtin_amdgcn_cvt_pkrtz(xn[j][2] * rstd2 * A[j * 4 + 2] + Bs[j * 4 + 2], xn[j][3] * rstd2 * A[j * 4 + 3] + Bs[j * 4 + 3]));
                    }
                    if (more) {
                        g_ids(idb + (t + 1 - t0) * 128, og, idn);
#pragma unroll
                        for (int j = 0; j < 4; ++j) xn[j] = *(const f32x4*)(xb + (size_t)(t + 1 - t0) * DM + oc + j * 4);
                    }
                    g_dots8(RA, hv, pd);
                    if (more) g_rows8(tb, oc, idn[0], RA);
                    g_dots8(RB, hv, pd + 8);
                    float o0, o1; halve16<4, 2, 1>(pd, c & 4, c & 2, c & 1, o0, o1);
                    const unsigned lo_st = og + 2 * (c & 1) + 4 * ((c >> 1) & 1) + 8 * ((c >> 2) & 1);
                    f32x2 st; st[0] = o0; st[1] = o1;
                    *(f32x2*)(p.apart() + ((size_t)sl * NTOK + t) * 128 + lo_st) = st;
#pragma unroll
                    for (int q = 0; q < 2; ++q) idc[q] = idn[q];
                }
            } else {
                const unsigned lo_col = oc + 2 * (g & 1) + 4 * ((g >> 1) & 1) + 8 * ((g >> 2) & 1);
                float* xb = p.out + (size_t)t0 * DM + sl * 128;
                const f32x2 g2 = *(const f32x2*)(modb + 5 * DM + lo_col);
                f32x2 x1n = *(const f32x2*)(xb + lo_col);
#pragma unroll 1
                for (int t = t0; t < t0 + 16; ++t) {
                    const bool more = t + 1 < t0 + 16;
                    g_rows8(tb, oc, idc[1], RB);
                    const f32x2 x1 = x1n;
                    if (more) { g_ids(idb + (t + 1 - t0) * 128, og, idn); g_wts(wb + (t + 1 - t0) * 128, og, wn); x1n = *(const f32x2*)(xb + (size_t)(t + 1 - t0) * DM + lo_col); }
                    float acc[16];
#pragma unroll
                    for (int i = 0; i < 16; ++i) acc[i] = 0.f;
                    g_acc8(RA, wc[0], wc[1], acc);
                    if (more) g_rows8(tb, oc, idn[0], RA);
                    g_acc8(RB, wc[2], wc[3], acc);
                    float o0, o1; halve16<32, 16, 8>(acc, g & 4, g & 2, g & 1, o0, o1);
                    f32x2 x2; x2[0] = x1[0] + g2[0] * o0; x2[1] = x1[1] + g2[1] * o1;
                    *(f32x2*)(xb + (size_t)(t - t0) * DM + lo_col) = x2;
                    const float ss = wave_sum(x2[0] * x2[0] + x2[1] * x2[1]);
                    if (lane == 0) p.ss2()[(size_t)sl * NTOK + t] = ss;
#pragma unroll
                    for (int q = 0; q < 2; ++q) idc[q] = idn[q];
#pragma unroll
                    for (int q = 0; q < 4; ++q) wc[q] = wn[q];
                }
            }
        }
    }
}
__device__ __forceinline__ void ph_gather_weights(const P& p) {
    int tid_ = threadIdx.x; asm volatile("" : "+v"(tid_));
    const size_t gsz = (size_t)gridDim.x * NT;
    const float* isc = p.pisc();
    for (size_t i = (size_t)blockIdx.x * NT + tid_; i < (size_t)NTOK * 128; i += gsz) {
        float a = 0.f;
#pragma unroll
        for (int sl = 0; sl < 8; ++sl) a += p.apart()[(size_t)sl * NTOK * 128 + i];
        const unsigned e = ((const unsigned short*)p.topk())[i]; const float gate = p.gates()[i];
        p.wl()[i] = gate * isc[16384 + e] * gelu_tanh(a * isc[e]);
    }
}
__device__ __forceinline__ void ph_final_norm(const P& p) {
    int tid_ = threadIdx.x; asm volatile("" : "+v"(tid_));
    const int wave = __builtin_amdgcn_readfirstlane(tid_ >> 6), lane = tid_ & 63;
    for (int tok = blockIdx.x * NWAVES + wave; tok < NTOK; tok += gridDim.x * NWAVES) {
        float ss = 0.f;
#pragma unroll
        for (int sl = 0; sl < 8; ++sl) ss += p.ss2()[(size_t)sl * NTOK + tok];
        const float rstd = rsqrtf(ss * (1.f / DM) + EPSN);
        f32x4* row = (f32x4*)(p.out + (size_t)tok * DM);
#pragma unroll
        for (int j = 0; j < 4; ++j) { const f32x4 v = row[lane + 64 * j], fg = ((const f32x4*)p.final_g)[lane + 64 * j]; row[lane + 64 * j] = v * rstd * fg; }
    }
}

#define XB_TMO      128
#define XB_XCNT(j)  (256  + 64 * (j))
#define XB_XSUB(j)  (1280 + 64 * (j))
#define XB_XGEN(j)  (2304 + 64 * (j))
#define XB_TOP      3328
#define XB_TOPGEN   3392
#define XCD_BAR_WORDS 3456
#define XB_SPIN_CAP (1u << 18)
__device__ __forceinline__ unsigned xb_ld(unsigned* p)              { return __hip_atomic_load(p, __ATOMIC_RELAXED, __HIP_MEMORY_SCOPE_AGENT); }
__device__ __forceinline__ unsigned xb_add(unsigned* p, unsigned v) { return __hip_atomic_fetch_add(p, v, __ATOMIC_RELAXED, __HIP_MEMORY_SCOPE_AGENT); }
__device__ __forceinline__ unsigned xb_xcc_id() { return (unsigned)__builtin_amdgcn_s_getreg((3 << 11) | 20) & 0xFu; }
#define XB_SPIN(cond, bar) do { unsigned _sp = 0; while (cond) { __builtin_amdgcn_s_sleep(1); \
    if ((++_sp & 255u) == 0u) { if (xb_ld(&(bar)[XB_TMO])) break; if (_sp > XB_SPIN_CAP) { atomicAdd(&(bar)[XB_TMO], 1u); break; } } } } while (0)
struct XcdBarrier { unsigned* bar; unsigned x; volatile LAS unsigned* st; };
__device__ __forceinline__ XcdBarrier xcd_barrier_post(unsigned* bar, volatile LAS unsigned* st) {
    XcdBarrier b; b.bar = bar; b.x = xb_xcc_id(); b.st = st;
    if (threadIdx.x == 0) (void)xb_add(&bar[XB_XCNT(b.x)], 1u);
    return b;
}
__device__ __forceinline__ void xcd_barrier_complete(unsigned* bar, unsigned x, unsigned& nloc, unsigned& nx) {
    const unsigned G = gridDim.x * gridDim.y * gridDim.z;
    unsigned sum, cnt, mine, sp = 0u;
    for (;;) {
        sum = 0u; cnt = 0u; mine = 0u;
#pragma unroll
        for (unsigned j = 0; j < 16; ++j) { const unsigned c = xb_ld(&bar[XB_XCNT(j)]); sum += c; cnt += (c > 0u) ? 1u : 0u; mine = (j == x) ? c : mine; }
        if (sum == G) break;
        __builtin_amdgcn_s_sleep(1);
        if ((++sp & 255u) == 0u) { if (xb_ld(&bar[XB_TMO])) break; if (sp > XB_SPIN_CAP) { atomicAdd(&bar[XB_TMO], 1u); break; } }
    }
    nloc = mine > 0u ? mine : 1u; nx = cnt > 0u ? cnt : 1u;
}
__device__ __forceinline__ void xcd_barrier(const XcdBarrier& b) {
    asm volatile("s_waitcnt vmcnt(0)" ::: "memory");
    __syncthreads();
    if (threadIdx.x == 0) {
        unsigned* bar = b.bar;
        __builtin_amdgcn_s_waitcnt(0);
        unsigned nloc = b.st[0], nx = b.st[1];
        if (nloc == 0u) { xcd_barrier_complete(bar, b.x, nloc, nx); b.st[0] = nloc; b.st[1] = nx; }
        const unsigned old = xb_add(&bar[XB_XSUB(b.x)], 1u);
        const unsigned gen = old / nloc;
        if (old + 1u == (gen + 1u) * nloc) {
            __builtin_amdgcn_fence(__ATOMIC_RELEASE, "agent");
            asm volatile("s_waitcnt vmcnt(0)" ::: "memory");
            const unsigned og = xb_add(&bar[XB_TOP], 1u);
            const unsigned tg = og / nx;
            if (og + 1u == (tg + 1u) * nx) xb_add(&bar[XB_TOPGEN], 1u);
            else XB_SPIN(xb_ld(&bar[XB_TOPGEN]) == tg, bar);
            __builtin_amdgcn_fence(__ATOMIC_ACQUIRE, "agent");
            xb_add(&bar[XB_XGEN(b.x)], 1u);
            asm volatile("s_waitcnt vmcnt(0)" ::: "memory");
        } else {
            XB_SPIN(xb_ld(&bar[XB_XGEN(b.x)]) == gen, bar);
            __builtin_amdgcn_fence(__ATOMIC_ACQUIRE, "agent");
            asm volatile("s_waitcnt vmcnt(0)" ::: "memory");
        }
    }
    __syncthreads();
}

constexpr int LDS_BYTES = 147456;
#define GSYNC() xcd_barrier(xbar)
constexpr int MISC_OFF = LDS_BYTES - 64;

__global__ void __launch_bounds__(NT, 2) mega(P p) {
    extern __shared__ __attribute__((aligned(16))) unsigned char lds_raw[];
    LAS unsigned char* lds = (LAS unsigned char*)lds_raw;
    const int G = gridDim.x, bx = blockIdx.x;
    using namespace pg8;
    if (threadIdx.x < 16) ((LAS unsigned*)(lds + MISC_OFF))[threadIdx.x] = 0u;
    __syncthreads();
    const XcdBarrier xbar = xcd_barrier_post((unsigned*)p.ws, (volatile LAS unsigned*)(lds + MISC_OFF));

    ph_prep(p, lds);
    bg_convert_tables(p);
    cg::this_grid().sync();
    ph_norm1(p, lds);
    GSYNC();
    {
        Gemm<DM, DM, DM> g{p.hx(), p.w_in_t()}; StaticOrder<NTOK, INC> S; S.init(G, bx);
        EpiInProj E{p.U(), p.kb(), (size_t)(p.qb() - p.kb()), p.vT(), p.ga(), 0};
        gemm_phase<EpiInProj, StaticOrder<NTOK, INC>, true, true>(lds, g, S, E);
        Gemm<DM, DM, DM> g2{p.hc(), p.w_in_t()}; StaticOrder<NCTX, CTXC> S2; S2.init(G, bx);
        EpiInProj E2{p.U(), p.kc(), 0, p.vcT(), p.ga(), 1};
        gemm_phase<EpiInProj, StaticOrder<NCTX, CTXC>, true, true>(lds, g2, S2, E2);
    }
    GSYNC();
    {
        Gemm<512, SSM_LD, 512, (long)SSM_ROWS * SSM_LD, 256L * 512> g{p.U(), p.Win()}; StaticOrder<SSM_ROWS, 256, 32> S; S.init(G, bx);
        EpiE E{p.E()};
        gemm_phase<EpiE, StaticOrder<SSM_ROWS, 256, 32>, true, true>(lds, g, S, E);
    }
    GSYNC();
    ph_carry(p);
    ph_na(p, lds);
    GSYNC();
    {
        Gemm<SSM_LD, SSM_LD, SSM_LD, (long)SSM_ROWS * SSM_LD, 512L * SSM_LD> g{p.U(), p.Kmat()}; StaticOrder<1024, 512, 32> S; S.init(G, bx);
        EpiZ E{p.z()};
        gemm_phase<EpiZ, StaticOrder<1024, 512, 32>, true, true>(lds, g, S, E);
    }
    GSYNC();
    {
        Gemm<512, 512, 512> g{p.z(), p.w_glu_t()}; StaticOrder<NTOK, 512> S; S.init(G, bx);
        EpiGlu E{p.gl(), p.z(), p.b_glu};
        gemm_phase<EpiGlu, StaticOrder<NTOK, 512>, true, true>(lds, g, S, E);
    }
    GSYNC();
    {
        Gemm<512, 512, 512, 32L * 1024 * 1024, 512L * 1024> g{p.na(), p.w_b_t()}; PairOrder<NTOK, DM> S; S.init(G, bx);
        EpiMerge E{p.merged(), p.ga(), p.gb()};
        gemm_phase<EpiMerge, PairOrder<NTOK, DM>, true, true>(lds, g, S, E);
    }
    GSYNC();
    {
        Gemm<DM, DM, DM> g{p.merged(), p.w_out_t()}; StaticOrder<NTOK, DM> S; S.init(G, bx);
        EpiOut E{p.x, p.out, p.x1g(), p.mod(), p.norm2_g, p.rowss()};
        gemm_phase<EpiOut, StaticOrder<NTOK, DM>, true, true>(lds, g, S, E);
    }
    GSYNC();
    {
        Gemm<DM, DM, DM> g{p.x1g(), p.w_q_t()}; StaticOrder<NTOK, 2048> S; S.init(G, bx);
        EpiQ E{p.qp(), p.rowss(), p.c2()};
        gemm_phase<EpiQ, StaticOrder<NTOK, 2048>, true, true>(lds, g, S, E);
    }
    GSYNC();
    ph_peer_topk(p, lds);
    GSYNC();
    ph_gather_sliced<0>(p);
    GSYNC();
    ph_gather_weights(p);
    GSYNC();
    ph_gather_sliced<1>(p);
    GSYNC();
    ph_final_norm(p);
}

extern "C" void kernel_launch(void* const* d_in, const int* in_sizes, int n_in, void* d_out, int out_size, void* d_ws, size_t ws_size, hipStream_t stream) {
    static int grid = 0;
    if (grid == 0) {
        int dev = 0, cus = 0, per_cu = 0;
        (void)hipGetDevice(&dev);
        (void)hipDeviceGetAttribute(&cus, hipDeviceAttributeMultiprocessorCount, dev);
        (void)hipFuncSetAttribute((const void*)mega, hipFuncAttributeMaxDynamicSharedMemorySize, LDS_BYTES);
        (void)hipOccupancyMaxActiveBlocksPerMultiprocessor(&per_cu, (const void*)mega, NT, LDS_BYTES);
        if (per_cu < 1) { fprintf(stderr, "occupancy query says %d blocks per CU\n", per_cu); per_cu = 1; }
        grid = cus;
    }
    P p{};
    const float* const* in = (const float* const*)d_in;
    p.x = in[0]; p.c = in[1]; p.ctx = in[2]; p.c_ctx = in[3]; p.w_mod = in[4]; p.b_mod = in[5]; p.norm1_g = in[6]; p.norm2_g = in[7]; p.w_in = in[8];
    p.a_re = in[9]; p.a_im = in[10]; p.log_dt = in[11]; p.b_re = in[12]; p.b_im = in[13]; p.c_re = in[14]; p.c_im = in[15]; p.ssm_d = in[16];
    p.w_glu = in[17]; p.b_glu = in[18]; p.w_a = in[19]; p.w_b = in[20]; p.rpb = in[21]; p.w_out = in[22]; p.w_q = in[23]; p.subkeys = in[24];
    p.peer_u = in[25]; p.peer_v = in[26]; p.final_g = in[27];
    p.out = (float*)d_out;
    p.ws = (unsigned char*)d_ws;
    (void)hipMemsetAsync(d_ws, 0, 1 * MiB, stream);
    void* args[] = {&p};
    hipError_t e = hipLaunchCooperativeKernel((const void*)mega, dim3(grid), dim3(NT), args, LDS_BYTES, stream);
    if (e != hipSuccess) fprintf(stderr, "cooperative launch failed: %s (grid %d)\n", hipGetErrorString(e), grid);
}
```

```cpp
#include <hip/hip_runtime.h>
#include <hip/hip_cooperative_groups.h>
#include <cstdio>
#include <cstdint>
namespace cg = cooperative_groups;

#define LAS __attribute__((address_space(3)))
typedef unsigned short bf16_t;
typedef short bf16x8 __attribute__((ext_vector_type(8)));
typedef float f32x4 __attribute__((ext_vector_type(4)));
typedef float f32x2 __attribute__((ext_vector_type(2)));
typedef unsigned u32x4 __attribute__((ext_vector_type(4)));
typedef unsigned u32x2 __attribute__((ext_vector_type(2)));

constexpr int DM = 1024, NB = 8, SEQL = 4096, CTXL = 256, GW = 64, NTOK = NB * SEQL, NCTX = NB * CTXL;
constexpr int INC = 4096, CTXC = 1536;
constexpr int NT = 512, NWAVES = 8;
constexpr float EPSN = 1e-6f;
constexpr int SSM_ROWS = 1280;
constexpr int SSM_LD = 768;

__device__ __forceinline__ unsigned f2bf(float f) { unsigned u = __builtin_bit_cast(unsigned, f); return (u + 0x7fffu + ((u >> 16) & 1u)) >> 16; }
__device__ __forceinline__ unsigned pk2(float lo, float hi) { return f2bf(lo) | (f2bf(hi) << 16); }
__device__ __forceinline__ float bflo(unsigned w) { return __builtin_bit_cast(float, w << 16); }
__device__ __forceinline__ float bfhi(unsigned w) { return __builtin_bit_cast(float, w & 0xffff0000u); }
__device__ __forceinline__ float bf2f(bf16_t h) { return __builtin_bit_cast(float, (unsigned)h << 16); }

__device__ __forceinline__ float wave_sum(float v) {
#pragma unroll
    for (int o = 1; o < 64; o <<= 1) v += __shfl_xor(v, o);
    return v;
}
__device__ __forceinline__ float wave_max(float v) {
#pragma unroll
    for (int o = 1; o < 64; o <<= 1) v = fmaxf(v, __shfl_xor(v, o));
    return v;
}
__device__ __forceinline__ float frcp(float x) { return __builtin_amdgcn_rcpf(x); }
__device__ __forceinline__ float sigmoidf_(float x) { return frcp(1.f + __expf(-x)); }
__device__ __forceinline__ float siluf_(float x) { return x * frcp(1.f + __expf(-x)); }
__device__ __forceinline__ float gelu_tanh(float x) {
    const float k0 = 0.7978845608028654f, k1 = 0.044715f;
    const float u = k0 * (x + k1 * x * x * x);
    const float t = 1.f - 2.f * frcp(1.f + __expf(2.f * u));
    return 0.5f * x * (1.f + t);
}

namespace pg8 {
#define PG8_LAS __attribute__((address_space(3)))
constexpr int BM = 256, BK = 64, HALF = 128, HTB = HALF * BK * 2  , STAGE_BYTES = 8 * HTB, NXCD = 8, WGM = 8;
__host__ __device__ __forceinline__ int lds_byte(int r, int c) { const int st = (r >> 4) * 2 + (c >> 5), rr = r & 15, cc = c & 31, ob = rr * 64 + cc * 2; return st * 1024 + (ob ^ (((ob >> 9) & 1) << 5)); }
__host__ __device__ __forceinline__ void stage_rc(int b, int& R, int& C) { const int st = b / 1024, sb = b % 1024, swz = sb ^ (((sb >> 9) & 1) << 5); R = (st >> 1) * 16 + swz / 64; C = (st & 1) * 32 + (swz % 64) / 2; }
__host__ __device__ __forceinline__ int perm32(int rho) { const int n = rho >> 4, i = rho & 15; return 8 * (i >> 2) + 4 * n + (i & 3); }

struct Unit { int pm, pn, g; };
template <int K_, int LDA, int LDB, long GSA = 0, long GSB = 0>
struct Gemm {
    const bf16_t* A; const bf16_t* Bt;
    static constexpr int K = K_, lda = LDA, ldb = LDB;
    __device__ __forceinline__ const char* abase(const Unit& u) const { return (const char*)(A + (size_t)u.g * GSA + (size_t)u.pm * BM * LDA); }
    __device__ __forceinline__ const char* bbase(const Unit& u) const { return (const char*)(Bt + (size_t)u.g * GSB + (size_t)u.pn * BM * LDB); }
};
template <int M, int N, int NGRP = 1>
struct StaticOrder {
    static constexpr int nM = M / BM, nN = N / BM, nwg = nM * nN;
    int G, c;
    __device__ void init(int G_, int c_) { G = G_; c = c_; }
    __device__ bool next(int i, Unit& u) const {
        const int L = i * G + c; if (L >= nwg * NGRP) return false;
        u.g = L / nwg;
        int wgid = L % nwg; { constexpr int q = nwg / NXCD, r = nwg % NXCD; const int xcd = wgid % NXCD, off = wgid / NXCD; wgid = (xcd < r ? xcd * (q + 1) : r * (q + 1) + (xcd - r) * q) + off; }
        constexpr int nig = WGM * nN; const int gid = wgid / nig, fm = gid * WGM, gsz = (nM - fm) < WGM ? (nM - fm) : WGM;
        u.pm = fm + ((wgid % nig) % gsz); u.pn = (wgid % nig) / gsz; return true;
    }
    __device__ __forceinline__ void a_ready(const Unit&) const {}
    __device__ __forceinline__ void done(const Unit&) const {}
};
__device__ __forceinline__ unsigned cvt_pk_bf16(float lo, float hi) { unsigned r; asm volatile("v_cvt_pk_bf16_f32 %0, %1, %2" : "=v"(r) : "v"(lo), "v"(hi)); return r; }
template <class Epi, class Sched, bool ALIGN_EPI = false, bool SP2 = false, class GemmT>
__device__ __forceinline__ void gemm_phase(PG8_LAS unsigned char* lds, const GemmT g, const Sched& S, const Epi& E) {
    int tid_ = threadIdx.x; asm volatile("" : "+v"(tid_));
    const int tid = tid_, wid = __builtin_amdgcn_readfirstlane(tid >> 6), lane = tid & 63, wr = wid >> 2, wc = wid & 3, fr = lane & 15, fq = lane >> 4;
    const int K = g.K, nt = K / BK;
    unsigned voffA[2], voffB[2];
#pragma unroll
    for (int i = 0; i < 2; ++i) { int R, C; stage_rc(tid * 16 + i * 8192, R, C); const int Rb = Epi::PERM ? ((R & ~31) + perm32(R & 31)) : R;
        voffA[i] = (unsigned)(R * g.lda + C) * 2u; voffB[i] = (unsigned)(Rb * g.ldb + C) * 2u; }
    const size_t kstep = (size_t)(BK * 2);
    const size_t hstepA = (size_t)HALF * g.lda * 2, hstepB = (size_t)HALF * g.ldb * 2;
    const unsigned ldsw = (unsigned)wid * 1024u;
    const int aoff = lds_byte(wr * 64 + fr, fq * 8), boff = lds_byte(wc * 32 + fr, fq * 8);
#define PG8_SA(b, h) (((b) * 2 + (h)) * HTB)
#define PG8_SB(b, h) ((4 + (b) * 2 + (h)) * HTB)
#define PG8_STAGE(bufoff, gbase, voff) do { _Pragma("unroll") for (int _i = 0; _i < 2; ++_i) \
        __builtin_amdgcn_global_load_lds((const unsigned*)((const char*)(gbase) + (voff)[_i]), (PG8_LAS unsigned*)(lds + (bufoff) + ldsw + _i * 8192), 16, 0, 0); } while (0)
#define PG8_LDA(dst, b, h) do { _Pragma("unroll") for (int m = 0; m < 4; ++m) _Pragma("unroll") for (int k = 0; k < 2; ++k) dst[m][k] = *(const PG8_LAS bf16x8*)(lds + PG8_SA(b, h) + aoff + m * 2048 + k * 1024); } while (0)
#define PG8_LDB(dst, b, h) do { _Pragma("unroll") for (int n = 0; n < 2; ++n) _Pragma("unroll") for (int k = 0; k < 2; ++k) dst[n][k] = *(const PG8_LAS bf16x8*)(lds + PG8_SB(b, h) + boff + n * 2048 + k * 1024); } while (0)
#define PG8_MMA(ai, bj, At, Bt) do { __builtin_amdgcn_s_setprio(1); _Pragma("unroll") for (int m = 0; m < 4; ++m) _Pragma("unroll") for (int n = 0; n < 2; ++n) _Pragma("unroll") for (int k = 0; k < 2; ++k) \
        acc[ai][bj][m][n] = __builtin_amdgcn_mfma_f32_16x16x32_bf16(Bt[n][k], At[m][k], acc[ai][bj][m][n], 0, 0, 0); __builtin_amdgcn_s_setprio(0); } while (0)
#define PG8_WAIT_V(n) asm volatile("s_waitcnt vmcnt(" #n ")" ::: "memory")
#define PG8_WAIT_L(n) asm volatile("s_waitcnt lgkmcnt(" #n ")" ::: "memory")
#define PG8_BAR __builtin_amdgcn_s_barrier()
#define PG8_SCHED __builtin_amdgcn_sched_barrier(0)
    Unit cur, nxt; int ui = 0;
    if (!S.next(0, cur)) return;
    f32x4 acc[2][2][4][2];
#pragma unroll
    for (int a = 0; a < 2; ++a)
#pragma unroll
        for (int b = 0; b < 2; ++b)
#pragma unroll
            for (int m = 0; m < 4; ++m)
#pragma unroll
                for (int n = 0; n < 2; ++n) acc[a][b][m][n] = (f32x4){0.f, 0.f, 0.f, 0.f};
    bf16x8 At[4][2], B0[2][2], B1[2][2];
    const char* cA = g.abase(cur); const char* cB = g.bbase(cur);
    S.a_ready(cur);
    if constexpr (SP2) {
        PG8_STAGE(PG8_SB(0, 0), cB, voffB); PG8_STAGE(PG8_SB(0, 1), cB + hstepB, voffB); PG8_STAGE(PG8_SA(0, 0), cA, voffA); PG8_STAGE(PG8_SA(0, 1), cA + hstepA, voffA);
        if (wr == 1) PG8_BAR;
        PG8_WAIT_V(2); PG8_BAR;
        PG8_STAGE(PG8_SB(1, 0), cB + kstep, voffB); PG8_STAGE(PG8_SA(1, 0), cA + kstep, voffA); PG8_STAGE(PG8_SB(1, 1), cB + hstepB + kstep, voffB);
        PG8_WAIT_V(6); PG8_BAR;
    } else {
        PG8_STAGE(PG8_SB(0, 0), cB, voffB); PG8_STAGE(PG8_SA(0, 0), cA, voffA); PG8_STAGE(PG8_SB(0, 1), cB + hstepB, voffB); PG8_STAGE(PG8_SA(0, 1), cA + hstepA, voffA);
        if (wr == 1) PG8_BAR;
        PG8_WAIT_V(4); PG8_BAR;
        PG8_STAGE(PG8_SB(1, 0), cB + kstep, voffB); PG8_STAGE(PG8_SA(1, 0), cA + kstep, voffA); PG8_STAGE(PG8_SB(1, 1), cB + hstepB + kstep, voffB);
        PG8_WAIT_V(6); PG8_BAR;
    }
    for (;;) {
        const bool has_next = S.next(ui + 1, nxt);
        const char* nA = has_next ? g.abase(nxt) : cA; const char* nB = has_next ? g.bbase(nxt) : cB;
        for (int t = 0; t < nt; t += 2) {
            const bool last = (t == nt - 2);
            const char* a1 = cA + (size_t)(t + 1) * kstep;
            const char* a2 = last ? nA : cA + (size_t)(t + 2) * kstep; const char* b2 = last ? nB : cB + (size_t)(t + 2) * kstep;
            const char* a3 = a2 + kstep; const char* b3 = b2 + kstep;
            if (last && has_next) S.a_ready(nxt);
            if constexpr (SP2) {
            PG8_LDB(B0, 0, 0); PG8_LDB(B1, 0, 1); PG8_SCHED; PG8_LDA(At, 0, 0); PG8_STAGE(PG8_SA(1, 1), a1 + hstepA, voffA);
            PG8_WAIT_V(8); PG8_WAIT_L(0); PG8_BAR; PG8_MMA(0, 0, At, B0); PG8_MMA(0, 1, At, B1); PG8_BAR; PG8_SCHED;
            PG8_LDA(At, 0, 1); PG8_STAGE(PG8_SB(0, 0), b2, voffB); PG8_STAGE(PG8_SB(0, 1), b2 + hstepB, voffB); PG8_STAGE(PG8_SA(0, 0), a2, voffA);
            PG8_WAIT_V(8); PG8_WAIT_L(0); PG8_BAR; PG8_MMA(1, 0, At, B0); PG8_MMA(1, 1, At, B1); PG8_BAR; PG8_SCHED;
            PG8_LDB(B0, 1, 0); PG8_LDB(B1, 1, 1); PG8_SCHED; PG8_LDA(At, 1, 0); PG8_STAGE(PG8_SA(0, 1), a2 + hstepA, voffA);
            PG8_WAIT_V(8); PG8_WAIT_L(0); PG8_BAR; PG8_MMA(0, 0, At, B0); PG8_MMA(0, 1, At, B1); PG8_BAR; PG8_SCHED;
            PG8_LDA(At, 1, 1); PG8_STAGE(PG8_SB(1, 0), b3, voffB); PG8_STAGE(PG8_SB(1, 1), b3 + hstepB, voffB); PG8_STAGE(PG8_SA(1, 0), a3, voffA);
            PG8_WAIT_V(8); PG8_WAIT_L(0); PG8_BAR; PG8_MMA(1, 0, At, B0); PG8_MMA(1, 1, At, B1); PG8_BAR; PG8_SCHED;
            } else {
            PG8_LDB(B0, 0, 0); PG8_SCHED; PG8_LDA(At, 0, 0); PG8_STAGE(PG8_SA(1, 1), a1 + hstepA, voffA);
            PG8_WAIT_L(8); PG8_BAR; PG8_WAIT_L(0); PG8_MMA(0, 0, At, B0); PG8_BAR; PG8_SCHED;
            PG8_LDB(B1, 0, 1); PG8_STAGE(PG8_SB(0, 0), b2, voffB);
            PG8_BAR; PG8_WAIT_L(0); PG8_MMA(0, 1, At, B1); PG8_BAR;
            PG8_LDA(At, 0, 1); PG8_STAGE(PG8_SA(0, 0), a2, voffA);
            PG8_BAR; PG8_WAIT_L(0); PG8_MMA(1, 0, At, B0); PG8_BAR; PG8_SCHED;
            PG8_STAGE(PG8_SB(0, 1), b2 + hstepB, voffB);
            PG8_WAIT_V(6); PG8_BAR; PG8_MMA(1, 1, At, B1); PG8_BAR;
            PG8_LDB(B0, 1, 0); PG8_SCHED; PG8_LDA(At, 1, 0); PG8_STAGE(PG8_SA(0, 1), a2 + hstepA, voffA);
            PG8_WAIT_L(8); PG8_BAR; PG8_WAIT_L(0); PG8_MMA(0, 0, At, B0); PG8_BAR; PG8_SCHED;
            PG8_LDB(B1, 1, 1); PG8_STAGE(PG8_SB(1, 0), b3, voffB);
            PG8_BAR; PG8_WAIT_L(0); PG8_MMA(0, 1, At, B1); PG8_BAR;
            PG8_LDA(At, 1, 1); PG8_STAGE(PG8_SA(1, 0), a3, voffA);
            PG8_BAR; PG8_WAIT_L(0); PG8_MMA(1, 0, At, B0); PG8_BAR; PG8_SCHED;
            PG8_STAGE(PG8_SB(1, 1), b3 + hstepB, voffB);
            PG8_WAIT_V(6); PG8_BAR; PG8_MMA(1, 1, At, B1); PG8_BAR;
            }
        }
        if constexpr (ALIGN_EPI) { if (wr == 0) PG8_BAR; }
        if constexpr (!Epi::AFTER_DRAIN) { E(acc, cur, wr, wc, fr, fq); S.done(cur); }
        if (!has_next) break;
        if (!E.keep(cur)) {
#pragma unroll
        for (int a = 0; a < 2; ++a)
#pragma unroll
            for (int b = 0; b < 2; ++b)
#pragma unroll
                for (int m = 0; m < 4; ++m)
#pragma unroll
                    for (int n = 0; n < 2; ++n) acc[a][b][m][n] = (f32x4){0.f, 0.f, 0.f, 0.f};
        }
        cur = nxt; cA = nA; cB = nB; ++ui;
        if constexpr (ALIGN_EPI) { if (wr == 1) PG8_BAR; }
    }
    PG8_WAIT_V(0);
    if constexpr (!ALIGN_EPI) { if (wr == 0) PG8_BAR; }
    PG8_BAR;
    if constexpr (Epi::AFTER_DRAIN) { E.fused(acc, cur, wr, wc, fr, fq, lds, wid, lane); S.done(cur); }
#undef PG8_SA
#undef PG8_SB
#undef PG8_STAGE
#undef PG8_LDA
#undef PG8_LDB
#undef PG8_MMA
#undef PG8_WAIT_V
#undef PG8_WAIT_L
#undef PG8_BAR
#undef PG8_SCHED
}
}

constexpr size_t MiB = 1u << 20;
struct P {
    const float *x, *c, *ctx, *c_ctx, *w_mod, *b_mod, *norm1_g, *norm2_g, *w_in;
    const float *a_re, *a_im, *log_dt, *b_re, *b_im, *c_re, *c_im, *ssm_d;
    const float *w_glu, *b_glu, *w_a, *w_b, *rpb, *w_out, *w_q, *subkeys, *peer_u, *peer_v, *final_g;
    float* out;
    unsigned char* ws;
    __device__ __forceinline__ float* rowss() const { return (float*)(ws + 512 * 1024); }
    __device__ __forceinline__ float* mod() const { return (float*)(ws + 1 * MiB); }
    __device__ __forceinline__ float* c2() const { return (float*)(ws + 1 * MiB + 256 * 1024); }
    __device__ __forceinline__ bf16_t* w_in_t() const { return (bf16_t*)(ws + 3 * MiB); }
    __device__ __forceinline__ bf16_t* w_glu_t() const { return (bf16_t*)(ws + 11 * MiB); }
    __device__ __forceinline__ bf16_t* w_b_t() const { return (bf16_t*)(ws + 12 * MiB); }
    __device__ __forceinline__ bf16_t* w_a_t() const { return (bf16_t*)(ws + 13 * MiB); }
    __device__ __forceinline__ bf16_t* w_out_t() const { return (bf16_t*)(ws + 14 * MiB); }
    __device__ __forceinline__ bf16_t* w_q_t() const { return (bf16_t*)(ws + 16 * MiB); }
    __device__ __forceinline__ bf16_t* Kmat() const { return (bf16_t*)(ws + 21 * MiB); }
    __device__ __forceinline__ bf16_t* Win() const { return (bf16_t*)(ws + 45 * MiB); }
    __device__ __forceinline__ float* lamT() const { return (float*)(ws + 53 * MiB); }
    __device__ __forceinline__ unsigned char* pu8() const { return ws + 54 * MiB; }
    __device__ __forceinline__ unsigned char* pv8() const { return ws + 70 * MiB; }
    __device__ __forceinline__ float* pisc() const { return (float*)(ws + 53 * MiB + 128 * 1024); }
    __device__ __forceinline__ bf16_t* ga() const { return (bf16_t*)(ws + 118 * MiB); }
    __device__ __forceinline__ bf16_t* gb() const { return (bf16_t*)(ws + 182 * MiB); }
    __device__ __forceinline__ bf16_t* x1g() const { return (bf16_t*)(ws + 118 * MiB); }
    __device__ __forceinline__ unsigned* topk() const { return (unsigned*)(ws + 182 * MiB); }
    __device__ __forceinline__ float* gates() const { return (float*)(ws + 198 * MiB); }
    __device__ __forceinline__ bf16_t* kb() const { return (bf16_t*)(ws + 246 * MiB); }
    __device__ __forceinline__ bf16_t* vT() const { return (bf16_t*)(ws + 278 * MiB); }
    __device__ __forceinline__ bf16_t* qb() const { return (bf16_t*)(ws + 310 * MiB); }
    __device__ __forceinline__ bf16_t* kc() const { return (bf16_t*)(ws + 342 * MiB); }
    __device__ __forceinline__ bf16_t* vcT() const { return (bf16_t*)(ws + 344 * MiB); }
    __device__ __forceinline__ bf16_t* U() const { return (bf16_t*)(ws + 346 * MiB); }
    __device__ __forceinline__ float* E() const { return (float*)(ws + 406 * MiB); }
    __device__ __forceinline__ bf16_t* merged() const { return (bf16_t*)(ws + 246 * MiB); }
    __device__ __forceinline__ float* tbuf() const { return (float*)(ws + 310 * MiB); }
    __device__ __forceinline__ bf16_t* qp() const { return (bf16_t*)(ws + 246 * MiB); }
    __device__ __forceinline__ float* apart() const { return (float*)(ws + 246 * MiB); }
    __device__ __forceinline__ float* wl() const { return (float*)(ws + 374 * MiB); }
    __device__ __forceinline__ float* ss2() const { return (float*)(ws + 406 * MiB); }
    __device__ __forceinline__ unsigned* queues() const { return (unsigned*)(ws + 64 * 1024); }
    __device__ __forceinline__ bf16_t* hx() const { return (bf16_t*)out; }
    __device__ __forceinline__ bf16_t* hc() const { return (bf16_t*)((unsigned char*)out + 64 * MiB); }
    __device__ __forceinline__ bf16_t* na() const { return (bf16_t*)out; }
    __device__ __forceinline__ bf16_t* z() const { return (bf16_t*)((unsigned char*)out + 32 * MiB); }
    __device__ __forceinline__ bf16_t* gl() const { return (bf16_t*)((unsigned char*)out + 64 * MiB); }
};

namespace pg8 {
struct EpiInProj {
    static constexpr bool PERM = true, AFTER_DRAIN = false;
    __device__ __forceinline__ bool keep(const Unit&) const { return false; }
    bf16_t* U; bf16_t* d_kq; size_t kq_stride; bf16_t* d_vT; bf16_t* d_gate; int is_ctx;
    __device__ __forceinline__ void operator()(const f32x4 (&acc)[2][2][4][2], const Unit& u, int wr, int wc, int fr, int fq) const {
        if (u.pn < 2) {
#pragma unroll
            for (int ai = 0; ai < 2; ++ai)
#pragma unroll
                for (int m = 0; m < 4; ++m) {
                    const int row = u.pm * BM + ai * HALF + wr * 64 + m * 16 + fr;
                    const int n = is_ctx ? (1024 + (row >> 8) * 8 + ((row & 255) >> 5)) : ((row >> 12) * 128 + ((row & 4095) >> 5));
                    const int jj = row & 31;
#pragma unroll
                    for (int bj = 0; bj < 2; ++bj) {
                        const int col = u.pn * BM + bj * HALF + wc * 32 + 8 * fq;
                        const f32x4 v0 = acc[ai][bj][m][0], v1 = acc[ai][bj][m][1];
                        u32x4 w; w.x = cvt_pk_bf16(v0[0], v0[1]); w.y = cvt_pk_bf16(v0[2], v0[3]); w.z = cvt_pk_bf16(v1[0], v1[1]); w.w = cvt_pk_bf16(v1[2], v1[3]);
                        *(u32x4*)(U + ((size_t)((col >> 4) * SSM_ROWS + n) * SSM_LD + jj * 16 + (col & 15))) = w;
                    }
                    asm volatile("" ::: "memory");
                }
        } else if (u.pn == 4 || u.pn == 5) {
            const int RB = is_ctx ? (CTXL / 64) : (SEQL / 64);
#pragma unroll
            for (int ai = 0; ai < 2; ++ai)
#pragma unroll
                for (int m = 0; m < 4; ++m) {
                    const int row = u.pm * BM + ai * HALF + wr * 64 + m * 16 + fr;
                    const int b = is_ctx ? (row >> 8) : (row >> 12), t = is_ctx ? (row & 255) : (row & 4095);
#pragma unroll
                    for (int bj = 0; bj < 2; ++bj) {
                        const int col = u.pn * BM + bj * HALF + wc * 32 + 8 * fq - 1024;
                        bf16_t* dst = d_vT + ((size_t)((b * 8 + (col >> 6)) * RB + (t >> 6)) * 4096 + (col & 63) * 64 + (t & 63));
#pragma unroll
                        for (int n = 0; n < 2; ++n)
#pragma unroll
                            for (int i = 0; i < 4; ++i) dst[(n * 4 + i) * 64] = (bf16_t)f2bf(acc[ai][bj][m][n][i]);
                    }
                    asm volatile("" ::: "memory");
                }
        } else {
            bf16_t* base; int ld, c0;
            if (u.pn < 8) { const int which = (u.pn - 2) >> 2; base = d_kq + (size_t)which * kq_stride; ld = 512; c0 = 512 + which * 1024; }
            else { const int which = (u.pn - 8) >> 2; base = d_gate + (size_t)which * ((size_t)NTOK * DM); ld = DM; c0 = 2048 + which * 1024; }
#pragma unroll
            for (int ai = 0; ai < 2; ++ai)
#pragma unroll
                for (int m = 0; m < 4; ++m) {
                    const int row = u.pm * BM + ai * HALF + wr * 64 + m * 16 + fr;
#pragma unroll
                    for (int bj = 0; bj < 2; ++bj) {
                        const int col = u.pn * BM + bj * HALF + wc * 32 + 8 * fq - c0;
                        const f32x4 v0 = acc[ai][bj][m][0], v1 = acc[ai][bj][m][1];
                        u32x4 w; w.x = cvt_pk_bf16(v0[0], v0[1]); w.y = cvt_pk_bf16(v0[2], v0[3]); w.z = cvt_pk_bf16(v1[0], v1[1]); w.w = cvt_pk_bf16(v1[2], v1[3]);
                        *(u32x4*)(base + (size_t)row * ld + col) = w;
                    }
                    asm volatile("" ::: "memory");
                }
        }
    }
};
struct EpiGlu {
    static constexpr bool PERM = true, AFTER_DRAIN = false;
    __device__ __forceinline__ bool keep(const Unit&) const { return false; }
    bf16_t* gl; const bf16_t* z; const float* bias;
    __device__ __forceinline__ void operator()(const f32x4 (&acc)[2][2][4][2], const Unit& u, int wr, int wc, int fr, int fq) const {
#pragma unroll
        for (int ai = 0; ai < 2; ++ai)
#pragma unroll
            for (int m = 0; m < 4; ++m) {
                const int row = u.pm * BM + ai * HALF + wr * 64 + m * 16 + fr;
#pragma unroll
                for (int bj = 0; bj < 2; ++bj) {
                    const int col = u.pn * BM + bj * HALF + wc * 32 + 8 * fq;
                    const f32x4 v0 = acc[ai][bj][m][0], v1 = acc[ai][bj][m][1];
                    const f32x4 b0 = *(const f32x4*)(bias + col), b1 = *(const f32x4*)(bias + col + 4);
                    const u32x4 zz = *(const u32x4*)(z + (size_t)row * 512 + col);
                    float o[8];
                    o[0] = bflo(zz.x) * sigmoidf_(v0[0] + b0[0]); o[1] = bfhi(zz.x) * sigmoidf_(v0[1] + b0[1]);
                    o[2] = bflo(zz.y) * sigmoidf_(v0[2] + b0[2]); o[3] = bfhi(zz.y) * sigmoidf_(v0[3] + b0[3]);
                    o[4] = bflo(zz.z) * sigmoidf_(v1[0] + b1[0]); o[5] = bfhi(zz.z) * sigmoidf_(v1[1] + b1[1]);
                    o[6] = bflo(zz.w) * sigmoidf_(v1[2] + b1[2]); o[7] = bfhi(zz.w) * sigmoidf_(v1[3] + b1[3]);
                    u32x4 w; w.x = cvt_pk_bf16(o[0], o[1]); w.y = cvt_pk_bf16(o[2], o[3]); w.z = cvt_pk_bf16(o[4], o[5]); w.w = cvt_pk_bf16(o[6], o[7]);
                    *(u32x4*)(gl + (size_t)row * 512 + col) = w;
                }
            }
    }
};
template <int M, int N>
struct PairOrder {
    StaticOrder<M, N> S;
    __device__ void init(int G_, int c_) { S.init(G_, c_); }
    __device__ bool next(int i, Unit& u) const { if (!S.next(i >> 1, u)) return false; u.g = i & 1; return true; }
    __device__ __forceinline__ void a_ready(const Unit&) const {}
    __device__ __forceinline__ void done(const Unit&) const {}
};
struct EpiMerge {
    static constexpr bool PERM = true, AFTER_DRAIN = false;
    __device__ __forceinline__ bool keep(const Unit& u) const { return u.g == 0; }
    bf16_t* merged; const bf16_t* ga; const bf16_t* gb;
    __device__ __forceinline__ void operator()(f32x4 (&acc)[2][2][4][2], const Unit& u, int wr, int wc, int fr, int fq) const {
#pragma unroll
        for (int ai = 0; ai < 2; ++ai)
#pragma unroll
            for (int m = 0; m < 4; ++m) {
                const int row = u.pm * BM + ai * HALF + wr * 64 + m * 16 + fr;
#pragma unroll
                for (int bj = 0; bj < 2; ++bj) {
                    const int col = u.pn * BM + bj * HALF + wc * 32 + 8 * fq;
                    const u32x4 a4 = *(const u32x4*)(ga + (size_t)row * DM + col);
                    float sa[8];
#pragma unroll
                    for (int q = 0; q < 4; ++q) { sa[2 * q] = sigmoidf_(bflo(a4[q])); sa[2 * q + 1] = sigmoidf_(bfhi(a4[q])); }
                    if (u.g == 0) {
                        const u32x4 b4 = *(const u32x4*)(gb + (size_t)row * DM + col);
#pragma unroll
                        for (int q = 0; q < 4; ++q) {
                            const float r0 = sigmoidf_(bflo(b4[q])) * frcp(sa[2 * q]), r1 = sigmoidf_(bfhi(b4[q])) * frcp(sa[2 * q + 1]);
                            acc[ai][bj][m][q >> 1][(q & 1) * 2] *= r0; acc[ai][bj][m][q >> 1][(q & 1) * 2 + 1] *= r1;
                        }
                    } else {
                        const f32x4 v0 = acc[ai][bj][m][0], v1 = acc[ai][bj][m][1];
                        u32x4 w; w[0] = cvt_pk_bf16(v0[0] * sa[0], v0[1] * sa[1]); w[1] = cvt_pk_bf16(v0[2] * sa[2], v0[3] * sa[3]); w[2] = cvt_pk_bf16(v1[0] * sa[4], v1[1] * sa[5]); w[3] = cvt_pk_bf16(v1[2] * sa[6], v1[3] * sa[7]);
                        *(u32x4*)(merged + (size_t)row * DM + col) = w;
                    }
                }
                asm volatile("" ::: "memory");
            }
    }
};
struct EpiOut {
    static constexpr bool PERM = true, AFTER_DRAIN = false;
    __device__ __forceinline__ bool keep(const Unit&) const { return false; }
    const float* x; float* x1; bf16_t* x1g; const float* mod; const float* g2; float* rowss;
    __device__ __forceinline__ void operator()(const f32x4 (&acc)[2][2][4][2], const Unit& u, int wr, int wc, int fr, int fq) const {
#pragma unroll
        for (int ai = 0; ai < 2; ++ai)
#pragma unroll
            for (int m = 0; m < 4; ++m) {
                const int row = u.pm * BM + ai * HALF + wr * 64 + m * 16 + fr;
                const float* modb = mod + (size_t)(row >> 12) * (6 * DM);
                float ss = 0.f;
#pragma unroll
                for (int bj = 0; bj < 2; ++bj) {
                    const int col = u.pn * BM + bj * HALF + wc * 32 + 8 * fq;
#pragma unroll
                    for (int n = 0; n < 2; ++n) {
                        const int cc = col + 4 * n;
                        const f32x4 v = acc[ai][bj][m][n];
                        const f32x4 xx = *(const f32x4*)(x + (size_t)row * DM + cc);
                        const f32x4 g1 = *(const f32x4*)(modb + 2 * DM + cc), sc = *(const f32x4*)(modb + 4 * DM + cc), gg = *(const f32x4*)(g2 + cc);
                        const f32x4 o = xx + g1 * v;
                        *(f32x4*)(x1 + (size_t)row * DM + cc) = o;
                        ss += o[0] * o[0] + o[1] * o[1] + o[2] * o[2] + o[3] * o[3];
                        const f32x4 og = o * gg * (sc + 1.f);
                        u32x2 w; w.x = cvt_pk_bf16(og[0], og[1]); w.y = cvt_pk_bf16(og[2], og[3]);
                        *(u32x2*)(x1g + (size_t)row * DM + cc) = w;
                    }
                }
                ss += __shfl_xor(ss, 16); ss += __shfl_xor(ss, 32);
                if (fq == 0) atomicAdd(rowss + row, ss);
            }
    }
};
struct EpiQ {
    static constexpr bool PERM = true, AFTER_DRAIN = false;
    __device__ __forceinline__ bool keep(const Unit&) const { return false; }
    bf16_t* qp; const float* rowss; const float* c2;
    __device__ __forceinline__ void operator()(const f32x4 (&acc)[2][2][4][2], const Unit& u, int wr, int wc, int fr, int fq) const {
#pragma unroll
        for (int ai = 0; ai < 2; ++ai)
#pragma unroll
            for (int m = 0; m < 4; ++m) {
                const int row = u.pm * BM + ai * HALF + wr * 64 + m * 16 + fr;
                const float rstd = rsqrtf(rowss[row] * (1.f / DM) + EPSN);
                const float* cb = c2 + (size_t)(row >> 12) * 2048;
#pragma unroll
                for (int bj = 0; bj < 2; ++bj) {
                    const int col = u.pn * BM + bj * HALF + wc * 32 + 8 * fq;
                    const f32x4 v0 = acc[ai][bj][m][0] * rstd + *(const f32x4*)(cb + col), v1 = acc[ai][bj][m][1] * rstd + *(const f32x4*)(cb + col + 4);
                    u32x4 w; w.x = cvt_pk_bf16(v0[0], v0[1]); w.y = cvt_pk_bf16(v0[2], v0[3]); w.z = cvt_pk_bf16(v1[0], v1[1]); w.w = cvt_pk_bf16(v1[2], v1[3]);
                    *(u32x4*)(qp + (size_t)row * 2048 + col) = w;
                }
            }
    }
};
struct EpiE {
    static constexpr bool PERM = true, AFTER_DRAIN = false;
    __device__ __forceinline__ bool keep(const Unit&) const { return false; }
    float* E;
    __device__ __forceinline__ void operator()(const f32x4 (&acc)[2][2][4][2], const Unit& u, int wr, int wc, int fr, int fq) const {
#pragma unroll
        for (int ai = 0; ai < 2; ++ai)
#pragma unroll
            for (int m = 0; m < 4; ++m) {
                const int row = u.pm * BM + ai * HALF + wr * 64 + m * 16 + fr;
#pragma unroll
                for (int bj = 0; bj < 2; ++bj) {
                    const int col = u.pn * BM + bj * HALF + wc * 32 + 8 * fq;
                    float* d = E + ((size_t)(u.g * SSM_ROWS + row) * 256 + col);
                    *(f32x4*)d = acc[ai][bj][m][0]; *(f32x4*)(d + 4) = acc[ai][bj][m][1];
                }
            }
    }
};
struct EpiZ {
    static constexpr bool PERM = true, AFTER_DRAIN = false;
    __device__ __forceinline__ bool keep(const Unit&) const { return false; }
    bf16_t* z;
    __device__ __forceinline__ void operator()(const f32x4 (&acc)[2][2][4][2], const Unit& u, int wr, int wc, int fr, int fq) const {
#pragma unroll
        for (int ai = 0; ai < 2; ++ai)
#pragma unroll
            for (int m = 0; m < 4; ++m) {
                const int n = u.pm * BM + ai * HALF + wr * 64 + m * 16 + fr;
                const size_t tok0 = (size_t)(n >> 7) * SEQL + (size_t)(n & 127) * 32;
#pragma unroll
                for (int bj = 0; bj < 2; ++bj) {
                    const int col = u.pn * BM + bj * HALF + wc * 32 + 8 * fq;
                    const f32x4 v0 = acc[ai][bj][m][0], v1 = acc[ai][bj][m][1];
                    u32x4 w; w.x = cvt_pk_bf16(gelu_tanh(v0[0]), gelu_tanh(v0[1])); w.y = cvt_pk_bf16(gelu_tanh(v0[2]), gelu_tanh(v0[3]));
                    w.z = cvt_pk_bf16(gelu_tanh(v1[0]), gelu_tanh(v1[1])); w.w = cvt_pk_bf16(gelu_tanh(v1[2]), gelu_tanh(v1[3]));
                    *(u32x4*)(z + (tok0 + (col >> 4)) * 512 + u.g * 16 + (col & 15)) = w;
                }
            }
    }
};
}

__device__ __forceinline__ void sincos_d(double th, double& s, double& c) {
    const double twopi = 6.283185307179586476925, hpi = 1.570796326794896619231;
    th -= twopi * rint(th / twopi);
    const double q = rint(th / hpi); const double y = th - q * hpi, y2 = y * y;
    const double sy = y * (1.0 - y2 / 6.0 * (1.0 - y2 / 20.0 * (1.0 - y2 / 42.0 * (1.0 - y2 / 72.0 * (1.0 - y2 / 110.0 * (1.0 - y2 / 156.0 * (1.0 - y2 / 210.0)))))));
    const double cy = 1.0 - y2 / 2.0 * (1.0 - y2 / 12.0 * (1.0 - y2 / 30.0 * (1.0 - y2 / 56.0 * (1.0 - y2 / 90.0 * (1.0 - y2 / 132.0 * (1.0 - y2 / 182.0))))));
    const int qi = ((int)q) & 3;
    s = qi == 0 ? sy : (qi == 1 ? cy : (qi == 2 ? -sy : -cy));
    c = qi == 0 ? cy : (qi == 1 ? -sy : (qi == 2 ? -cy : sy));
}
__device__ __forceinline__ void ssm_prep_item(const P& p, LAS unsigned char* lds, int item) {
    const int g = item >> 2, qtr = item & 3, tid = threadIdx.x;
    LAS f32x2* lamk = (LAS f32x2*)lds;
    LAS f32x2* Bb = lamk + 2 * 64 * 33;
    LAS f32x2* Cc = Bb + 2 * 64 * 16;
    LAS float* Kc = (LAS float*)(Cc + 2 * 16 * 64);
    if (tid < 128) {
        const int d = tid >> 6, pp = tid & 63, gi = d * 32 + g;
        const double are = (double)p.a_re[gi * 64 + pp], aim = (double)p.a_im[gi * 64 + pp];
        const double dt = (double)expf(p.log_dt[gi]);
        const double er = exp(are * dt); double sn, cs; sincos_d(aim * dt, sn, cs);
        const double lr = er * cs, li = er * sn;
        double pr = 1.0, pi_ = 0.0;
        for (int k = 0; k <= 32; ++k) {
            lamk[(d * 64 + pp) * 33 + k] = (f32x2){(float)pr, (float)pi_};
            const double nr_ = pr * lr - pi_ * li, ni_ = pr * li + pi_ * lr; pr = nr_; pi_ = ni_;
        }
        if (qtr == 0) { const f32x2 l32 = lamk[(d * 64 + pp) * 33 + 32]; *(f32x2*)(p.lamT() + (size_t)(gi * 64 + pp) * 2) = l32; }
        const double nr = lr - 1.0, ni = li, den = are * are + aim * aim;
        const double qr = (nr * are + ni * aim) / den, qi = (ni * are - nr * aim) / den;
        for (int h = 0; h < 16; ++h) {
            const double br = (double)p.b_re[((size_t)gi * 64 + pp) * 16 + h], bi = (double)p.b_im[((size_t)gi * 64 + pp) * 16 + h];
            Bb[(d * 64 + pp) * 16 + h] = (f32x2){(float)(qr * br - qi * bi), (float)(qr * bi + qi * br)};
        }
    }
    for (int e = tid; e < 2 * 16 * 64; e += NT) {
        const int d = e >> 10, h = (e >> 6) & 15, pp = e & 63; const size_t src = ((size_t)(d * 32 + g) * 16 + h) * 64 + pp;
        Cc[e] = (f32x2){p.c_re[src], p.c_im[src]};
    }
    __syncthreads();
    for (int e = tid; e < 2 * 32 * 16; e += NT) {
        const int d = e >> 9, k = (e >> 4) & 31, h = e & 15;
        float sacc[16];
#pragma unroll
        for (int h2 = 0; h2 < 16; ++h2) sacc[h2] = 0.f;
        for (int pp = 0; pp < 64; ++pp) {
            const f32x2 c = Cc[(d * 16 + h) * 64 + pp], l = lamk[(d * 64 + pp) * 33 + k];
            const float clr = c[0] * l[0] - c[1] * l[1], cli = c[0] * l[1] + c[1] * l[0];
            const LAS f32x4* bp = (const LAS f32x4*)(Bb + (d * 64 + pp) * 16);
#pragma unroll
            for (int q = 0; q < 8; ++q) { const f32x4 b2 = bp[q]; sacc[2 * q] += clr * b2[0] - cli * b2[1]; sacc[2 * q + 1] += clr * b2[2] - cli * b2[3]; }
        }
#pragma unroll
        for (int h2 = 0; h2 < 16; ++h2) Kc[((d * 32 + k) * 16 + h) * 16 + h2] = sacc[h2];
    }
    __syncthreads();
    for (int ch = tid; ch < 128 * 96; ch += NT) {
        const int mrow = 128 * qtr + ch / 96, k0 = (ch % 96) * 8, ii = mrow >> 4, h = mrow & 15;
        float v[8];
        if (k0 < 512) {
            const int jj = k0 >> 4, h20 = k0 & 15;
#pragma unroll
            for (int i = 0; i < 8; ++i) {
                const int h2 = h20 + i; float val = 0.f;
                if (ii >= jj) val += Kc[((0 * 32 + (ii - jj)) * 16 + h) * 16 + h2];
                if (jj >= ii) val += Kc[((1 * 32 + (jj - ii)) * 16 + h) * 16 + h2];
                if (ii == jj && h == h2) val += p.ssm_d[g * 16 + h];
                v[i] = val;
            }
        } else {
            const int sc = k0 - 512, d = sc >> 7, ri = (sc >> 6) & 1, p0 = sc & 63, e = d == 0 ? ii + 1 : 32 - ii;
#pragma unroll
            for (int i = 0; i < 8; ++i) {
                const int pp = p0 + i; const f32x2 c = Cc[(d * 16 + h) * 64 + pp], l = lamk[(d * 64 + pp) * 33 + e];
                const float clr = c[0] * l[0] - c[1] * l[1], cli = c[0] * l[1] + c[1] * l[0];
                v[i] = ri == 0 ? clr : -cli;
            }
        }
        u32x4 o; o.x = pk2(v[0], v[1]); o.y = pk2(v[2], v[3]); o.z = pk2(v[4], v[5]); o.w = pk2(v[6], v[7]);
        *(u32x4*)(p.Kmat() + ((size_t)(g * 512 + mrow) * SSM_LD + k0)) = o;
    }
    for (int ch = tid; ch < 64 * 64; ch += NT) {
        const int nrow = 64 * qtr + ch / 64, k0 = (ch % 64) * 8, d = nrow >> 7, ri = (nrow >> 6) & 1, pp = nrow & 63;
        const int jj = k0 >> 4, h20 = k0 & 15, e = d == 0 ? 31 - jj : jj;
        const f32x2 l = lamk[(d * 64 + pp) * 33 + e];
        float v[8];
#pragma unroll
        for (int i = 0; i < 8; ++i) { const f32x2 b = Bb[(d * 64 + pp) * 16 + h20 + i]; v[i] = ri == 0 ? (l[0] * b[0] - l[1] * b[1]) : (l[0] * b[1] + l[1] * b[0]); }
        u32x4 o; o.x = pk2(v[0], v[1]); o.y = pk2(v[2], v[3]); o.z = pk2(v[4], v[5]); o.w = pk2(v[6], v[7]);
        *(u32x4*)(p.Win() + ((size_t)(g * 256 + nrow) * 512 + k0)) = o;
    }
    __syncthreads();
}
__device__ __forceinline__ void ph_carry(const P& p) {
    int tid = threadIdx.x; asm volatile("" : "+v"(tid));
    if (tid >= 128) return;
    for (int gidx = blockIdx.x * 128 + tid; gidx < 32 * 8 * 2 * 64; gidx += gridDim.x * 128) {
        const int pp = gidx & 63, d = (gidx >> 6) & 1, b = (gidx >> 7) & 7, g = gidx >> 10;
        const f32x2 lt = *(const f32x2*)(p.lamT() + (size_t)((d * 32 + g) * 64 + pp) * 2);
        const float* Eg = p.E() + (size_t)g * SSM_ROWS * 256 + d * 128 + pp;
        bf16_t* Ug = p.U() + (size_t)g * SSM_ROWS * SSM_LD + 512 + d * 128 + pp;
        float fr = 0.f, fi = 0.f;
#pragma unroll
        for (int cc = 0; cc < 8; ++cc) {
            const int n = 1024 + b * 8 + (d == 0 ? cc : 7 - cc);
            const float er = Eg[(size_t)n * 256], ei = Eg[(size_t)n * 256 + 64];
            const float nr = lt[0] * fr - lt[1] * fi + er, ni = lt[0] * fi + lt[1] * fr + ei; fr = nr; fi = ni;
        }
#pragma unroll 8
        for (int c = 0; c < 128; ++c) {
            const int n = b * 128 + (d == 0 ? c : 127 - c);
            const float er = Eg[(size_t)n * 256], ei = Eg[(size_t)n * 256 + 64];
            Ug[(size_t)n * SSM_LD] = (bf16_t)f2bf(fr); Ug[(size_t)n * SSM_LD + 64] = (bf16_t)f2bf(fi);
            const float nr = lt[0] * fr - lt[1] * fi + er, ni = lt[0] * fi + lt[1] * fr + ei; fr = nr; fi = ni;
        }
    }
}


__device__ __forceinline__ void p0_transpose_item(const float* W, int K, int N, bf16_t* WT, LAS float* scr, int item, int lane) {
    const int nblk = N / 32, kb = item / nblk, nb = item % nblk, k0 = 64 * kb, n0 = 32 * nb;
#pragma unroll 8
    for (int i = 0; i < 32; ++i) { const int kk = 2 * i + (lane >> 5); scr[kk * 33 + (lane & 31)] = W[(size_t)(k0 + kk) * N + n0 + (lane & 31)]; }
    asm volatile("s_waitcnt lgkmcnt(0)" ::: "memory");
    const int c = lane & 7;
#pragma unroll
    for (int j = 0; j < 4; ++j) { const int n = (lane >> 3) + 8 * j; const LAS float* s = scr + (8 * c) * 33 + n;
        u32x4 o; o.x = pk2(s[0 * 33], s[1 * 33]); o.y = pk2(s[2 * 33], s[3 * 33]); o.z = pk2(s[4 * 33], s[5 * 33]); o.w = pk2(s[6 * 33], s[7 * 33]);
        *(u32x4*)(WT + (size_t)(n0 + n) * K + k0 + 8 * c) = o; }
    asm volatile("s_waitcnt lgkmcnt(0)" ::: "memory");
}

template <int NR, bool SILU>
__device__ __forceinline__ void gemv_block64(const float* const (&rows)[NR], const float* W, int ldw, int col0, const float* bias, float* y, int ldy, LAS float* scr) {
    const int wave = threadIdx.x >> 6, lane = threadIdx.x & 63;
    LAS float* act = scr + 8 * NR * 64;
#pragma unroll
    for (int r = 0; r < NR; ++r) for (int k = threadIdx.x; k < DM; k += NT) { const float s = rows[r][k]; act[r * DM + k] = SILU ? siluf_(s) : s; }
    __syncthreads();
    float acc[NR];
#pragma unroll
    for (int r = 0; r < NR; ++r) acc[r] = 0.f;
    const int kb = wave * 128;
#pragma unroll 8
    for (int k = kb; k < kb + 128; ++k) {
        const float w = W[(size_t)k * ldw + col0 + lane];
#pragma unroll
        for (int r = 0; r < NR; ++r) acc[r] += act[r * DM + k] * w;
    }
#pragma unroll
    for (int r = 0; r < NR; ++r) scr[(wave * NR + r) * 64 + lane] = acc[r];
    __syncthreads();
    for (int e = threadIdx.x; e < NR * 64; e += NT) {
        const int r = e >> 6, l = e & 63; float s = 0.f;
#pragma unroll
        for (int w = 0; w < 8; ++w) s += scr[(w * NR + r) * 64 + l];
        y[(size_t)r * ldy + col0 + l] = s + (bias ? bias[col0 + l] : 0.f);
    }
    __syncthreads();
}

__device__ __forceinline__ void ph_prep(const P& p, LAS unsigned char* lds) {
    int tid_ = threadIdx.x; asm volatile("" : "+v"(tid_));
    const int wave = tid_ >> 6, lane = tid_ & 63, G = gridDim.x;
    for (int cb = blockIdx.x; cb < 96; cb += G) {
        const float* const rows[9] = {p.c, p.c + DM, p.c + 2 * DM, p.c + 3 * DM, p.c + 4 * DM, p.c + 5 * DM, p.c + 6 * DM, p.c + 7 * DM, p.c_ctx};
        gemv_block64<9, true>(rows, p.w_mod, 6 * DM, cb * 64, p.b_mod, p.mod(), 6 * DM, (LAS float*)lds);
    }
    for (int it = G - 1 - (int)blockIdx.x; it < 128; it += G) ssm_prep_item(p, lds, it);
    {
        LAS float* scr = (LAS float*)(lds + wave * 16384);
        const int gw = blockIdx.x * NWAVES + wave, NGW = G * NWAVES;
        constexpr int I_IN = (DM / 64) * (INC / 32), I_GLU = (512 / 64) * (512 / 32), I_A = (512 / 64) * (DM / 32), I_OUT = (DM / 64) * (DM / 32), I_Q = (DM / 64) * (2048 / 32);
        constexpr int NITEMS = I_IN + I_GLU + 2 * I_A + I_OUT + I_Q;
        for (int it = gw; it < NITEMS; it += NGW) {
            int r = it;
            if (r < I_IN) { p0_transpose_item(p.w_in, DM, INC, p.w_in_t(), scr, r, lane); continue; } r -= I_IN;
            if (r < I_GLU) { p0_transpose_item(p.w_glu, 512, 512, p.w_glu_t(), scr, r, lane); continue; } r -= I_GLU;
            if (r < I_A) { p0_transpose_item(p.w_a, 512, DM, p.w_a_t(), scr, r, lane); continue; } r -= I_A;
            if (r < I_A) { p0_transpose_item(p.w_b, 512, DM, p.w_b_t(), scr, r, lane); continue; } r -= I_A;
            if (r < I_OUT) { p0_transpose_item(p.w_out, DM, DM, p.w_out_t(), scr, r, lane); continue; } r -= I_OUT;
            p0_transpose_item(p.w_q, DM, 2048, p.w_q_t(), scr, r, lane);
        }
    }
}

__device__ __forceinline__ void bg_convert_tables(const P& p) {
    int tid_ = threadIdx.x; asm volatile("" : "+v"(tid_));
    const int lane = tid_ & 63;
    unsigned* head = p.queues() + 16 * 64;
    for (;;) {
        unsigned v = 0u; if (lane == 0) v = __hip_atomic_fetch_add(head, 4u, __ATOMIC_RELAXED, __HIP_MEMORY_SCOPE_AGENT);
        const int r0 = (int)__builtin_amdgcn_readfirstlane(v);
        if (r0 >= 2 * 16384) break;
        const bool second = r0 >= 16384; const int rr0 = second ? r0 - 16384 : r0;
        const float* src = (second ? p.peer_v : p.peer_u) + (size_t)rr0 * DM + lane * 16;
        unsigned char* dst = (second ? p.pv8() : p.pu8()) + (size_t)(lane >> 3) * (16384 * 128) + (size_t)rr0 * 128 + (lane & 7) * 16;
        f32x4 v4[4][4];
#pragma unroll
        for (int q = 0; q < 4; ++q)
#pragma unroll
            for (int j = 0; j < 4; ++j) v4[q][j] = *(const f32x4*)(src + q * DM + 4 * j);
        float inv = 1.f;
#pragma unroll
        for (int q = 0; q < 4; ++q) {
            float am = 0.f;
#pragma unroll
            for (int j = 0; j < 4; ++j) am = fmaxf(am, fmaxf(fmaxf(fabsf(v4[q][j][0]), fabsf(v4[q][j][1])), fmaxf(fabsf(v4[q][j][2]), fabsf(v4[q][j][3]))));
            am = wave_max(am);
            const float sc = am > 0.f ? 448.f / am : 1.f;
            u32x4 o;
#pragma unroll
            for (int j = 0; j < 4; ++j) { int w = 0; w = __builtin_amdgcn_cvt_pk_fp8_f32(v4[q][j][0] * sc, v4[q][j][1] * sc, w, false); w = __builtin_amdgcn_cvt_pk_fp8_f32(v4[q][j][2] * sc, v4[q][j][3] * sc, w, true); o[j] = (unsigned)w; }
            *(u32x4*)(dst + q * 128) = o;
            inv = lane == q ? (am > 0.f ? am * (1.f / 448.f) : 1.f) : inv;
        }
        if (lane < 4) p.pisc()[r0 + lane] = inv;
    }
}

__device__ __forceinline__ void normmod_row_bf16(const float* src, bf16_t* dst, const float* g, const float* shift, const float* scale, int lane) {
    const f32x4* s = (const f32x4*)src;
    f32x4 v[4]; float ss = 0.f;
#pragma unroll
    for (int j = 0; j < 4; ++j) { v[j] = s[lane + 64 * j]; ss += v[j][0] * v[j][0] + v[j][1] * v[j][1] + v[j][2] * v[j][2] + v[j][3] * v[j][3]; }
    ss = wave_sum(ss);
    const float rstd = rsqrtf(ss * (1.f / DM) + EPSN);
#pragma unroll
    for (int j = 0; j < 4; ++j) {
        const int i4 = lane + 64 * j;
        const f32x4 gg = ((const f32x4*)g)[i4], sh = ((const f32x4*)shift)[i4], sc = ((const f32x4*)scale)[i4];
        const f32x4 o = v[j] * rstd * gg * (sc + 1.f) + sh;
        u32x2 w; w.x = pk2(o[0], o[1]); w.y = pk2(o[2], o[3]);
        *(u32x2*)(dst + (size_t)i4 * 4) = w;
    }
}
__device__ __forceinline__ void ph_norm1(const P& p, LAS unsigned char* lds) {
    int tid_ = threadIdx.x; asm volatile("" : "+v"(tid_));
    const int wave = tid_ >> 6, lane = tid_ & 63, G = gridDim.x;
    for (int cb = blockIdx.x; cb < 32; cb += G) {
        const float* m3 = p.mod() + 3 * DM;
        const float* const rows[8] = {m3, m3 + 6 * DM, m3 + 12 * DM, m3 + 18 * DM, m3 + 24 * DM, m3 + 30 * DM, m3 + 36 * DM, m3 + 42 * DM};
        gemv_block64<8, false>(rows, p.w_q, 2048, cb * 64, nullptr, p.c2(), 2048, (LAS float*)lds);
    }
    for (int r = blockIdx.x * NWAVES + wave; r < NTOK + NCTX; r += G * NWAVES) {
        if (r < NTOK) { const float* modb = p.mod() + (size_t)(r >> 12) * (6 * DM); normmod_row_bf16(p.x + (size_t)r * DM, p.hx() + (size_t)r * DM, p.norm1_g, modb, modb + DM, lane); }
        else { const int rc = r - NTOK; const float* modc = p.mod() + 8 * (6 * DM); normmod_row_bf16(p.ctx + (size_t)rc * DM, p.hc() + (size_t)rc * DM, p.norm1_g, modc, modc + DM, lane); }
    }
}

constexpr int RPB_LD = 128, RPB_PAD = 48;
__device__ __forceinline__ void ph_na(const P& p, LAS unsigned char* lds) {
    int tid_ = threadIdx.x; asm volatile("" : "+v"(tid_));
    const int tid = tid_, h = __builtin_amdgcn_readfirstlane(tid >> 6), lane = tid & 63, lt = lane & 15, lq = lane >> 4;
    constexpr float LOG2E = 1.4426950408889634f, CS = 0.125f * LOG2E;
    LAS float* rp = (LAS float*)lds;
    for (int e = tid; e < 8 * 15 * RPB_LD; e += NT) { const int c = (e & (RPB_LD - 1)) - RPB_PAD; rp[e] = (c >= 0 && c < 31) ? p.rpb[(e / RPB_LD) * 31 + c] * LOG2E : 0.f; }
    __syncthreads();
    const int pa = (lt >> 2) * 8 + (lt & 3);
    const unsigned lane_k = pa * 512 + lq * 8, lane_v = lt * 64 + lq * 8, lane_q = lt * 512 + lq * 8, lane_o = lt * 512 + lq * 4;
    for (int item = blockIdx.x; item < NB * GW; item += gridDim.x) {
        const int b = item >> 6, r = item & 63;
        int r0 = r - 4; r0 = r0 < 0 ? 0 : (r0 > 56 ? 56 : r0);
        const bf16_t* Kb = p.kb() + ((size_t)b * SEQL + (size_t)r0 * GW) * 512 + h * 64;
        const bf16_t* Kc = p.kc() + ((size_t)b * CTXL) * 512 + h * 64;
        const bf16_t* Vt = p.vT() + ((size_t)((b * 8 + h) * 64 + r0)) * 4096;
        const bf16_t* Vc = p.vcT() + ((size_t)((b * 8 + h) * 4)) * 4096;
        const bf16_t* Qb = p.qb() + ((size_t)b * SEQL + r * GW) * 512 + h * 64;
        bf16_t* Ob = p.na() + ((size_t)b * SEQL + r * GW) * 512 + h * 64;
        const LAS float* rph = rp + (h * 15 + (r0 - r + 7)) * RPB_LD;
        bf16x8 qf[4][2];
#pragma unroll
        for (int qt = 0; qt < 4; ++qt) { qf[qt][0] = *(const bf16x8*)(Qb + qt * 16 * 512 + lane_q); qf[qt][1] = *(const bf16x8*)(Qb + qt * 16 * 512 + 32 + lane_q); }
        f32x4 o[4][4]; float m[4], l[4];
#pragma unroll
        for (int qt = 0; qt < 4; ++qt) { m[qt] = -1e30f; l[qt] = 0.f;
#pragma unroll
            for (int d = 0; d < 4; ++d) o[qt][d] = (f32x4){0.f, 0.f, 0.f, 0.f}; }
        bf16x8 kf[2][2][2];
#pragma unroll
        for (int st = 0; st < 2; ++st)
#pragma unroll
            for (int ab = 0; ab < 2; ++ab) { kf[st][ab][0] = *(const bf16x8*)(Kb + (st * 32 + ab * 4) * 512 + lane_k); kf[st][ab][1] = *(const bf16x8*)(Kb + (st * 32 + ab * 4) * 512 + 32 + lane_k); }
#pragma unroll 1
        for (int i = 0; i < 8; ++i) {
            bf16x8 vf[2][4];
#pragma unroll
            for (int st = 0; st < 2; ++st)
#pragma unroll
                for (int d = 0; d < 4; ++d) vf[st][d] = *(const bf16x8*)(Vt + i * 4096 + d * 1024 + st * 32 + lane_v);
            const LAS float* rr_ = rph + i * RPB_LD;
#pragma unroll
            for (int half = 0; half < 2; ++half) {
                f32x4 s[2][2][2];
#pragma unroll
                for (int q2 = 0; q2 < 2; ++q2) {
                    const int qt = half * 2 + q2;
#pragma unroll
                    for (int st = 0; st < 2; ++st) {
                        if ((st == 0 && qt == 3) || (st == 1 && qt == 0)) continue;
#pragma unroll
                        for (int ab = 0; ab < 2; ++ab) {
                            f32x4 c = {0.f, 0.f, 0.f, 0.f};
                            c = __builtin_amdgcn_mfma_f32_16x16x32_bf16(kf[st][ab][0], qf[qt][0], c, 0, 0, 0);
                            c = __builtin_amdgcn_mfma_f32_16x16x32_bf16(kf[st][ab][1], qf[qt][1], c, 0, 0, 0);
                            s[q2][st][ab] = c;
                        }
                    }
                }
                if (half == 1) {
                    if (i < 7) {
#pragma unroll
                        for (int st = 0; st < 2; ++st)
#pragma unroll
                            for (int ab = 0; ab < 2; ++ab) { const bf16_t* kp = Kb + ((i + 1) * GW + st * 32 + ab * 4) * 512; kf[st][ab][0] = *(const bf16x8*)(kp + lane_k); kf[st][ab][1] = *(const bf16x8*)(kp + 32 + lane_k); }
                    } else {
#pragma unroll
                        for (int ab = 0; ab < 2; ++ab) { kf[0][ab][0] = *(const bf16x8*)(Kc + ab * 4 * 512 + lane_k); kf[0][ab][1] = *(const bf16x8*)(Kc + ab * 4 * 512 + 32 + lane_k); }
                    }
                }
#pragma unroll
                for (int q2 = 0; q2 < 2; ++q2) {
                    const int qt = half * 2 + q2;
                    const int qc = qt * 16 + lt; int c0 = qc - 8; c0 = c0 < 0 ? 0 : (c0 > 48 ? 48 : c0);
                    int wo = lq * 8 - c0; asm volatile("" : "+v"(wo));
                    float mx = -1e30f;
#pragma unroll
                    for (int st = 0; st < 2; ++st) {
                        if ((st == 0 && qt == 3) || (st == 1 && qt == 0)) continue;
                        const int kc0 = st * 32 + lq * 8, bbase = kc0 - qc + 15 + RPB_PAD;
#pragma unroll
                        for (int j = 0; j < 8; ++j) {
                            float t = s[q2][st][j >> 2][j & 3] * CS + rr_[bbase + j];
                            t = ((unsigned)(wo + st * 32 + j) < 16u) ? t : -1e30f;
                            s[q2][st][j >> 2][j & 3] = t; mx = fmaxf(mx, t);
                        }
                    }
                    mx = fmaxf(mx, __shfl_xor(mx, 16)); mx = fmaxf(mx, __shfl_xor(mx, 32));
                    const float mn = fmaxf(m[qt], mx), corr = __builtin_amdgcn_exp2f(m[qt] - mn);
                    m[qt] = mn; float ls = l[qt] * corr;
#pragma unroll
                    for (int d = 0; d < 4; ++d) o[qt][d] = o[qt][d] * corr;
#pragma unroll
                    for (int st = 0; st < 2; ++st) {
                        if ((st == 0 && qt == 3) || (st == 1 && qt == 0)) continue;
                        float pe[8];
#pragma unroll
                        for (int j = 0; j < 8; ++j) pe[j] = __builtin_amdgcn_exp2f(s[q2][st][j >> 2][j & 3] - mn);
                        ls += ((pe[0] + pe[1]) + (pe[2] + pe[3])) + ((pe[4] + pe[5]) + (pe[6] + pe[7]));
                        u32x4 pw; pw[0] = pg8::cvt_pk_bf16(pe[0], pe[1]); pw[1] = pg8::cvt_pk_bf16(pe[2], pe[3]); pw[2] = pg8::cvt_pk_bf16(pe[4], pe[5]); pw[3] = pg8::cvt_pk_bf16(pe[6], pe[7]);
                        const bf16x8 pf = __builtin_bit_cast(bf16x8, pw);
#pragma unroll
                        for (int d = 0; d < 4; ++d) o[qt][d] = __builtin_amdgcn_mfma_f32_16x16x32_bf16(vf[st][d], pf, o[qt][d], 0, 0, 0);
                    }
                    l[qt] = ls;
                }
            }
        }
#pragma unroll 1
        for (int cst = 0; cst < 8; ++cst) {
            bf16x8 vf[4];
#pragma unroll
            for (int d = 0; d < 4; ++d) vf[d] = *(const bf16x8*)(Vc + (cst >> 1) * 4096 + d * 1024 + (cst & 1) * 32 + lane_v);
            f32x4 s[4][2];
#pragma unroll
            for (int qt = 0; qt < 4; ++qt)
#pragma unroll
                for (int ab = 0; ab < 2; ++ab) {
                    f32x4 c = {0.f, 0.f, 0.f, 0.f};
                    c = __builtin_amdgcn_mfma_f32_16x16x32_bf16(kf[0][ab][0], qf[qt][0], c, 0, 0, 0);
                    c = __builtin_amdgcn_mfma_f32_16x16x32_bf16(kf[0][ab][1], qf[qt][1], c, 0, 0, 0);
                    s[qt][ab] = c;
                }
            if (cst < 7) {
#pragma unroll
                for (int ab = 0; ab < 2; ++ab) { const bf16_t* kp = Kc + ((cst + 1) * 32 + ab * 4) * 512; kf[0][ab][0] = *(const bf16x8*)(kp + lane_k); kf[0][ab][1] = *(const bf16x8*)(kp + 32 + lane_k); }
            }
#pragma unroll
            for (int qt = 0; qt < 4; ++qt) {
                float mx = -1e30f;
#pragma unroll
                for (int j = 0; j < 8; ++j) { const float t = s[qt][j >> 2][j & 3] * CS; s[qt][j >> 2][j & 3] = t; mx = fmaxf(mx, t); }
                mx = fmaxf(mx, __shfl_xor(mx, 16)); mx = fmaxf(mx, __shfl_xor(mx, 32));
                const float mn = fmaxf(m[qt], mx), corr = __builtin_amdgcn_exp2f(m[qt] - mn);
                m[qt] = mn;
#pragma unroll
                for (int d = 0; d < 4; ++d) o[qt][d] = o[qt][d] * corr;
                float pe[8];
#pragma unroll
                for (int j = 0; j < 8; ++j) pe[j] = __builtin_amdgcn_exp2f(s[qt][j >> 2][j & 3] - mn);
                l[qt] = l[qt] * corr + (((pe[0] + pe[1]) + (pe[2] + pe[3])) + ((pe[4] + pe[5]) + (pe[6] + pe[7])));
                u32x4 pw; pw[0] = pg8::cvt_pk_bf16(pe[0], pe[1]); pw[1] = pg8::cvt_pk_bf16(pe[2], pe[3]); pw[2] = pg8::cvt_pk_bf16(pe[4], pe[5]); pw[3] = pg8::cvt_pk_bf16(pe[6], pe[7]);
                const bf16x8 pf = __builtin_bit_cast(bf16x8, pw);
#pragma unroll
                for (int d = 0; d < 4; ++d) o[qt][d] = __builtin_amdgcn_mfma_f32_16x16x32_bf16(vf[d], pf, o[qt][d], 0, 0, 0);
            }
        }
#pragma unroll
        for (int qt = 0; qt < 4; ++qt) {
            float lv = l[qt]; lv += __shfl_xor(lv, 16); lv += __shfl_xor(lv, 32);
            const float inv = frcp(lv);
            bf16_t* op = Ob + qt * 16 * 512 + lane_o;
#pragma unroll
            for (int d = 0; d < 4; ++d) { u32x2 w; w[0] = pg8::cvt_pk_bf16(o[qt][d][0] * inv, o[qt][d][1] * inv); w[1] = pg8::cvt_pk_bf16(o[qt][d][2] * inv, o[qt][d][3] * inv); *(u32x2*)(op + d * 16) = w; }
        }
    }
}

typedef __bf16 bf16x2_t __attribute__((ext_vector_type(2)));
__device__ __forceinline__ float dot2bf(unsigned a, unsigned b, float c) { return __builtin_amdgcn_fdot2_f32_bf16(__builtin_bit_cast(bf16x2_t, a), __builtin_bit_cast(bf16x2_t, b), c, false); }
__device__ __forceinline__ unsigned ordkey(float f) { unsigned u = __builtin_bit_cast(unsigned, f); return u ^ ((unsigned)((int)u >> 31) | 0x80000000u); }
__device__ __forceinline__ float unordkey(unsigned k) { return __builtin_bit_cast(float, k ^ ((k & 0x80000000u) ? 0x80000000u : 0xFFFFFFFFu)); }
template <bool DESC> __device__ __forceinline__ void cex(unsigned& a, unsigned& b) { const unsigned mx = a > b ? a : b, mn = a > b ? b : a; if (DESC) { a = mx; b = mn; } else { a = mn; b = mx; } }
__device__ __forceinline__ void sort16_desc(unsigned (&a)[16]) {
#pragma unroll
    for (int k = 2; k <= 16; k <<= 1)
#pragma unroll
        for (int j = k >> 1; j > 0; j >>= 1)
#pragma unroll
            for (int i = 0; i < 16; ++i) { const int l = i ^ j; if (l > i) { if ((i & k) == 0) cex<true>(a[i], a[l]); else cex<false>(a[i], a[l]); } }
}
__device__ __forceinline__ void merge16_desc(unsigned (&a)[16]) {
#pragma unroll
    for (int j = 8; j > 0; j >>= 1)
#pragma unroll
        for (int i = 0; i < 16; ++i) { const int l = i ^ j; if (l > i) cex<true>(a[i], a[l]); }
}
__device__ __forceinline__ void top16_merge(unsigned (&a)[16], const unsigned (&b)[16]) {
#pragma unroll
    for (int i = 0; i < 16; ++i) a[i] = a[i] > b[15 - i] ? a[i] : b[15 - i];
    merge16_desc(a);
}
struct PairTab { int i[52], j[52], n; };
constexpr PairTab make_pairs() { PairTab t{}; int n = 0; for (int i = 0; i < 16; ++i) for (int j = 0; j < 16; ++j) if ((i + 1) * (j + 1) <= 16) { t.i[n] = i; t.j[n] = j; ++n; } t.n = n; for (int k = n; k < 52; ++k) { t.i[k] = 0; t.j[k] = 0; } return t; }
constexpr PairTab PAIRS = make_pairs();
static_assert(PAIRS.n == 50, "50 candidate pairs");

constexpr int SK_LD = 136;
__device__ __forceinline__ void ph_peer_topk(const P& p, LAS unsigned char* lds) {
    int tid_ = threadIdx.x; asm volatile("" : "+v"(tid_));
    const int tid = tid_, wave = tid >> 6, lane = tid & 63;
    LAS bf16_t* sk = (LAS bf16_t*)lds;
    for (int e = tid; e < 2 * 128 * 16; e += NT) {
        const int row = e >> 4, c8 = (e & 15) * 8;
        const f32x4 a = *(const f32x4*)(p.subkeys + (size_t)row * 128 + c8), b = *(const f32x4*)(p.subkeys + (size_t)row * 128 + c8 + 4);
        u32x4 o; o.x = pk2(a[0], a[1]); o.y = pk2(a[2], a[3]); o.z = pk2(b[0], b[1]); o.w = pk2(b[2], b[3]);
        *(LAS u32x4*)(sk + row * SK_LD + c8) = o;
    }
    __syncthreads();
    const int lt = lane & 15, lq = lane >> 4;
    for (int tile = blockIdx.x * NWAVES + wave; tile < NTOK / 16; tile += gridDim.x * NWAVES) {
        const int tok = tile * 16 + lt;
        const bf16_t* qrow = p.qp() + (size_t)tok * 2048;
        for (int h = 0; h < 8; ++h) {
            unsigned s0[16], s1[16];
#pragma unroll
            for (int n = 0; n < 2; ++n) {
                bf16x8 bq[4];
#pragma unroll
                for (int ks = 0; ks < 4; ++ks) bq[ks] = *(const bf16x8*)(qrow + h * 256 + n * 128 + ks * 32 + lq * 8);
                unsigned a[16], b[16];
#pragma unroll
                for (int kb = 0; kb < 8; ++kb) {
                    f32x4 c = {0.f, 0.f, 0.f, 0.f};
#pragma unroll
                    for (int ks = 0; ks < 4; ++ks) {
                        const bf16x8 ak = *(const LAS bf16x8*)(sk + (n * 128 + kb * 16 + lt) * SK_LD + ks * 32 + lq * 8);
                        c = __builtin_amdgcn_mfma_f32_16x16x32_bf16(ak, bq[ks], c, 0, 0, 0);
                    }
#pragma unroll
                    for (int r = 0; r < 4; ++r) {
                        const unsigned key = (ordkey(c[r]) & ~127u) | (unsigned)(kb * 16 + lq * 4 + r);
                        if (kb < 4) a[kb * 4 + r] = key; else b[(kb - 4) * 4 + r] = key;
                    }
                    asm volatile("" ::: "memory");
                }
                sort16_desc(a); sort16_desc(b);
                top16_merge(a, b);
#pragma unroll
                for (int i = 0; i < 16; ++i) b[i] = __shfl_xor(a[i], 16);
                top16_merge(a, b);
#pragma unroll
                for (int i = 0; i < 16; ++i) b[i] = __shfl_xor(a[i], 32);
                top16_merge(a, b);
                if (n == 0) {
#pragma unroll
                    for (int i = 0; i < 16; ++i) s0[i] = a[i];
                } else {
#pragma unroll
                    for (int i = 0; i < 16; ++i) s1[i] = a[i];
                }
            }
            unsigned ck[16], ce_[13]; float cs[13];
#pragma unroll
            for (int s = 0; s < 13; ++s) {
                const unsigned k0 = lq == 0 ? s0[PAIRS.i[s * 4]] : (lq == 1 ? s0[PAIRS.i[s * 4 + 1]] : (lq == 2 ? s0[PAIRS.i[s * 4 + 2]] : s0[PAIRS.i[s * 4 + 3]]));
                const unsigned k1 = lq == 0 ? s1[PAIRS.j[s * 4]] : (lq == 1 ? s1[PAIRS.j[s * 4 + 1]] : (lq == 2 ? s1[PAIRS.j[s * 4 + 2]] : s1[PAIRS.j[s * 4 + 3]]));
                const float sum = unordkey(k0 & ~127u) + unordkey(k1 & ~127u);
                const bool valid = (s * 4 + lq) < PAIRS.n;
                cs[s] = sum; ce_[s] = (k0 & 127u) * 128u + (k1 & 127u);
                ck[s] = valid ? ((ordkey(sum) & ~63u) | (unsigned)(s * 4 + lq)) : 0u;
            }
            ck[13] = 0u; ck[14] = 0u; ck[15] = 0u;
            unsigned srt[16], ob[16];
#pragma unroll
            for (int i = 0; i < 16; ++i) srt[i] = ck[i];
            sort16_desc(srt);
#pragma unroll
            for (int i = 0; i < 16; ++i) ob[i] = __shfl_xor(srt[i], 16);
            top16_merge(srt, ob);
#pragma unroll
            for (int i = 0; i < 16; ++i) ob[i] = __shfl_xor(srt[i], 32);
            unsigned thr = 0xFFFFFFFFu;
#pragma unroll
            for (int i = 0; i < 16; ++i) { const unsigned v = srt[i] > ob[15 - i] ? srt[i] : ob[15 - i]; thr = v < thr ? v : thr; }
            const float mtop = unordkey(s0[0] & ~127u) + unordkey(s1[0] & ~127u);
            float zp = 0.f; int cnt = 0;
#pragma unroll
            for (int s = 0; s < 13; ++s) { const bool sel = ck[s] >= thr && ck[s] != 0u; const float e = sel ? __expf(cs[s] - mtop) : 0.f; cs[s] = e; zp += e; cnt += sel ? 1 : 0; }
            float z = zp; z += __shfl_xor(z, 16); z += __shfl_xor(z, 32);
            const float rz = frcp(z);
            const int c0 = __shfl(cnt, lt), c1 = __shfl(cnt, lt + 16), c2 = __shfl(cnt, lt + 32);
            int pos = lq == 0 ? 0 : (lq == 1 ? c0 : (lq == 2 ? c0 + c1 : c0 + c1 + c2));
            unsigned short* dste = (unsigned short*)p.topk() + ((size_t)tok * 8 + h) * 16; float* dstg = p.gates() + ((size_t)tok * 8 + h) * 16;
#pragma unroll
            for (int s = 0; s < 13; ++s) {
                const bool sel = ck[s] >= thr && ck[s] != 0u;
                if (sel) { dste[pos] = (unsigned short)ce_[s]; dstg[pos] = cs[s] * rz; ++pos; }
            }
        }
    }
}

__device__ __forceinline__ unsigned xcc_id() { return (unsigned)__builtin_amdgcn_s_getreg((3 << 11) | 20) & 7u; }
__device__ __forceinline__ int q_grab(unsigned* head, int lane) { unsigned v = 0u; if (lane == 0) v = __hip_atomic_fetch_add(head, 16u, __ATOMIC_RELAXED, __HIP_MEMORY_SCOPE_AGENT); return (int)__builtin_amdgcn_readfirstlane(v); }

__device__ __forceinline__ void g_ids(const unsigned short* tkrow, unsigned lo_g16, u32x4 (&ids)[2]) {
#pragma unroll
    for (int q = 0; q < 2; ++q) ids[q] = *(const u32x4*)(tkrow + lo_g16 + q * 8);
}
__device__ __forceinline__ void g_wts(const float* wrow, unsigned lo_g16, f32x4 (&wts)[4]) {
#pragma unroll
    for (int q = 0; q < 4; ++q) wts[q] = *(const f32x4*)(wrow + lo_g16 + q * 4);
}
__device__ __forceinline__ void g_rows8(const unsigned char* tb, unsigned lo_c16, const u32x4& idh, u32x4 (&rows)[8]) {
#pragma unroll
    for (int i = 0; i < 8; ++i) {
        const unsigned w = idh[i >> 1];
        const unsigned e = (i & 1) ? (w >> 16) : (w & 0xffffu);
        rows[i] = *(const u32x4*)(tb + ((e << 7) + lo_c16));
    }
}
__device__ __forceinline__ void fmac_(float& d, float a, float b) { asm("v_fmac_f32_e32 %0, %1, %2" : "+v"(d) : "v"(a), "v"(b)); }
typedef _Float16 f16x2 __attribute__((ext_vector_type(2)));
__device__ __forceinline__ void g_dots8(const u32x4 (&uu)[8], const f16x2 (&hp)[8], float* pd) {
#pragma unroll
    for (int i = 0; i < 8; ++i) {
        float d = 0.f;
#pragma unroll
        for (int j = 0; j < 4; ++j) {
            const unsigned w = uu[i][j];
            d = __builtin_amdgcn_fdot2(__builtin_amdgcn_cvt_scalef32_pk_f16_fp8(w, 1.0f, false), hp[j * 2], d, false);
            d = __builtin_amdgcn_fdot2(__builtin_amdgcn_cvt_scalef32_pk_f16_fp8(w, 1.0f, true), hp[j * 2 + 1], d, false);
        }
        pd[i] = d;
    }
}
__device__ __forceinline__ void g_acc8(const u32x4 (&vv)[8], const f32x4& w0, const f32x4& w1, float (&acc)[16]) {
#pragma unroll
    for (int i = 0; i < 8; ++i) {
        const float w = i < 4 ? w0[i & 3] : w1[i & 3];
#pragma unroll
        for (int j = 0; j < 4; ++j) {
            const int wv = (int)vv[i][j];
            const f32x2 lo = __builtin_amdgcn_cvt_pk_f32_fp8(wv, false), hi = __builtin_amdgcn_cvt_pk_f32_fp8(wv, true);
            fmac_(acc[j * 4], w, lo[0]); fmac_(acc[j * 4 + 1], w, lo[1]); fmac_(acc[j * 4 + 2], w, hi[0]); fmac_(acc[j * 4 + 3], w, hi[1]);
        }
    }
}
template <int D4, int D2, int D1>
__device__ __forceinline__ void halve16(const float (&v)[16], int b4, int b2, int b1, float& o0, float& o1) {
    float r8[8], r4[4];
#pragma unroll
    for (int i = 0; i < 8; ++i) { const float keep = b4 ? v[i + 8] : v[i], send = b4 ? v[i] : v[i + 8]; r8[i] = keep + __shfl_xor(send, D4); }
#pragma unroll
    for (int i = 0; i < 4; ++i) { const float keep = b2 ? r8[i + 4] : r8[i], send = b2 ? r8[i] : r8[i + 4]; r4[i] = keep + __shfl_xor(send, D2); }
    { const float keep = b1 ? r4[2] : r4[0], send = b1 ? r4[0] : r4[2]; o0 = keep + __shfl_xor(send, D1); }
    { const float keep = b1 ? r4[3] : r4[1], send = b1 ? r4[1] : r4[3]; o1 = keep + __shfl_xor(send, D1); }
}

template <int WHICH>
__device__ __forceinline__ void ph_gather_sliced(const P& p) {
    int tid_ = threadIdx.x; asm volatile("" : "+v"(tid_));
    const int lane = tid_ & 63, c = lane & 7, g = lane >> 3;
    const unsigned xs = xcc_id();
    for (unsigned tr = 0; tr < 8; ++tr) {
        const int sl = (int)((xs + tr) & 7u);
        unsigned* head = p.queues() + (WHICH * 8 + sl) * 64;
        const unsigned char* tb = (WHICH == 0 ? p.pu8() : p.pv8()) + (size_t)sl * (16384 * 128);
        for (;;) {
            const int t0 = q_grab(head, lane);
            if (t0 >= NTOK) break;
            unsigned oc = c * 16, og = g * 16; asm volatile("" : "+v"(oc), "+v"(og));
            const unsigned short* idb = (const unsigned short*)p.topk() + (size_t)t0 * 128;
            const float* wb = p.wl() + (size_t)t0 * 128;
            const float* modb = p.mod() + (size_t)(t0 >> 12) * (6 * DM) + sl * 128;
            u32x4 idc[2], idn[2], RA[8], RB[8]; f32x4 wc[4], wn[4];
            g_ids(idb, og, idc); if (WHICH == 1) g_wts(wb, og, wc);
            g_rows8(tb, oc, idc[0], RA);
            if (WHICH == 0) {
                float A[16], Bs[16]; f32x4 xn[4];
                const float* xb = p.out + (size_t)t0 * DM + sl * 128;
#pragma unroll
                for (int j = 0; j < 4; ++j) {
                    const f32x4 gg = *(const f32x4*)(p.norm2_g + sl * 128 + oc + j * 4), sh = *(const f32x4*)(modb + 3 * DM + oc + j * 4), sc = *(const f32x4*)(modb + 4 * DM + oc + j * 4);
#pragma unroll
                    for (int i = 0; i < 4; ++i) { A[j * 4 + i] = gg[i] * (1.f + sc[i]); Bs[j * 4 + i] = sh[i]; }
                    xn[j] = *(const f32x4*)(xb + oc + j * 4);
                }
                const float rsl = rsqrtf(p.rowss()[t0 + (lane & 15)] * (1.f / DM) + EPSN);
#pragma unroll 1
                for (int t = t0; t < t0 + 16; ++t) {
                    const bool more = t + 1 < t0 + 16;
                    g_rows8(tb, oc, idc[1], RB);
                    f16x2 hv[8]; float pd[16];
                    const float rstd2 = __builtin_bit_cast(float, __builtin_amdgcn_readlane(__builtin_bit_cast(unsigned, rsl), t - t0));
#pragma unroll
                    for (int j = 0; j < 4; ++j) {
                        hv[j * 2] = __builtin_bit_cast(f16x2, __builtin_amdgcn_cvt_pkrtz(xn[j][0] * rstd2 * A[j * 4] + Bs[j * 4], xn[j][1] * rstd2 * A[j * 4 + 1] + Bs[j * 4 + 1]));
                        hv[j * 2 + 1] = __builtin_bit_cast(f16x2, __builtin_amdgcn_cvt_pkrtz(xn[j][2] * rstd2 * A[j * 4 + 2] + Bs[j * 4 + 2], xn[j][3] * rstd2 * A[j * 4 + 3] + Bs[j * 4 + 3]));
                    }
                    if (more) {
                        g_ids(idb + (t + 1 - t0) * 128, og, idn);
#pragma unroll
                        for (int j = 0; j < 4; ++j) xn[j] = *(const f32x4*)(xb + (size_t)(t + 1 - t0) * DM + oc + j * 4);
                    }
                    g_dots8(RA, hv, pd);
                    if (more) g_rows8(tb, oc, idn[0], RA);
                    g_dots8(RB, hv, pd + 8);
                    float o0, o1; halve16<4, 2, 1>(pd, c & 4, c & 2, c & 1, o0, o1);
                    const unsigned lo_st = og + 2 * (c & 1) + 4 * ((c >> 1) & 1) + 8 * ((c >> 2) & 1);
                    f32x2 st; st[0] = o0; st[1] = o1;
                    *(f32x2*)(p.apart() + ((size_t)sl * NTOK + t) * 128 + lo_st) = st;
#pragma unroll
                    for (int q = 0; q < 2; ++q) idc[q] = idn[q];
                }
            } else {
                const unsigned lo_col = oc + 2 * (g & 1) + 4 * ((g >> 1) & 1) + 8 * ((g >> 2) & 1);
                float* xb = p.out + (size_t)t0 * DM + sl * 128;
                const f32x2 g2 = *(const f32x2*)(modb + 5 * DM + lo_col);
                f32x2 x1n = *(const f32x2*)(xb + lo_col);
#pragma unroll 1
                for (int t = t0; t < t0 + 16; ++t) {
                    const bool more = t + 1 < t0 + 16;
                    g_rows8(tb, oc, idc[1], RB);
                    const f32x2 x1 = x1n;
                    if (more) { g_ids(idb + (t + 1 - t0) * 128, og, idn); g_wts(wb + (t + 1 - t0) * 128, og, wn); x1n = *(const f32x2*)(xb + (size_t)(t + 1 - t0) * DM + lo_col); }
                    float acc[16];
#pragma unroll
                    for (int i = 0; i < 16; ++i) acc[i] = 0.f;
                    g_acc8(RA, wc[0], wc[1], acc);
                    if (more) g_rows8(tb, oc, idn[0], RA);
                    g_acc8(RB, wc[2], wc[3], acc);
                    float o0, o1; halve16<32, 16, 8>(acc, g & 4, g & 2, g & 1, o0, o1);
                    f32x2 x2; x2[0] = x1[0] + g2[0] * o0; x2[1] = x1[1] + g2[1] * o1;
                    *(f32x2*)(xb + (size_t)(t - t0) * DM + lo_col) = x2;
                    const float ss = wave_sum(x2[0] * x2[0] + x2[1] * x2[1]);
                    if (lane == 0) p.ss2()[(size_t)sl * NTOK + t] = ss;
#pragma unroll
                    for (int q = 0; q < 2; ++q) idc[q] = idn[q];
#pragma unroll
                    for (int q = 0; q < 4; ++q) wc[q] = wn[q];
                }
            }
        }
    }
}
__device__ __forceinline__ void ph_gather_weights(const P& p) {
    int tid_ = threadIdx.x; asm volatile("" : "+v"(tid_));
    const size_t gsz = (size_t)gridDim.x * NT;
    const float* isc = p.pisc();
    for (size_t i = (size_t)blockIdx.x * NT + tid_; i < (size_t)NTOK * 128; i += gsz) {
        float a = 0.f;
#pragma unroll
        for (int sl = 0; sl < 8; ++sl) a += p.apart()[(size_t)sl * NTOK * 128 + i];
        const unsigned e = ((const unsigned short*)p.topk())[i]; const float gate = p.gates()[i];
        p.wl()[i] = gate * isc[16384 + e] * gelu_tanh(a * isc[e]);
    }
}
__device__ __forceinline__ void ph_final_norm(const P& p) {
    int tid_ = threadIdx.x; asm volatile("" : "+v"(tid_));
    const int wave = __builtin_amdgcn_readfirstlane(tid_ >> 6), lane = tid_ & 63;
    for (int tok = blockIdx.x * NWAVES + wave; tok < NTOK; tok += gridDim.x * NWAVES) {
        float ss = 0.f;
#pragma unroll
        for (int sl = 0; sl < 8; ++sl) ss += p.ss2()[(size_t)sl * NTOK + tok];
        const float rstd = rsqrtf(ss * (1.f / DM) + EPSN);
        f32x4* row = (f32x4*)(p.out + (size_t)tok * DM);
#pragma unroll
        for (int j = 0; j < 4; ++j) { const f32x4 v = row[lane + 64 * j], fg = ((const f32x4*)p.final_g)[lane + 64 * j]; row[lane + 64 * j] = v * rstd * fg; }
    }
}

#define XB_TMO      128
#define XB_XCNT(j)  (256  + 64 * (j))
#define XB_XSUB(j)  (1280 + 64 * (j))
#define XB_XGEN(j)  (2304 + 64 * (j))
#define XB_TOP      3328
#define XB_TOPGEN   3392
#define XCD_BAR_WORDS 3456
#define XB_SPIN_CAP (1u << 18)
__device__ __forceinline__ unsigned xb_ld(unsigned* p)              { return __hip_atomic_load(p, __ATOMIC_RELAXED, __HIP_MEMORY_SCOPE_AGENT); }
__device__ __forceinline__ unsigned xb_add(unsigned* p, unsigned v) { return __hip_atomic_fetch_add(p, v, __ATOMIC_RELAXED, __HIP_MEMORY_SCOPE_AGENT); }
__device__ __forceinline__ unsigned xb_xcc_id() { return (unsigned)__builtin_amdgcn_s_getreg((3 << 11) | 20) & 0xFu; }
#define XB_SPIN(cond, bar) do { unsigned _sp = 0; while (cond) { __builtin_amdgcn_s_sleep(1); \
    if ((++_sp & 255u) == 0u) { if (xb_ld(&(bar)[XB_TMO])) break; if (_sp > XB_SPIN_CAP) { atomicAdd(&(bar)[XB_TMO], 1u); break; } } } } while (0)
struct XcdBarrier { unsigned* bar; unsigned x; volatile LAS unsigned* st; };
__device__ __forceinline__ XcdBarrier xcd_barrier_post(unsigned* bar, volatile LAS unsigned* st) {
    XcdBarrier b; b.bar = bar; b.x = xb_xcc_id(); b.st = st;
    if (threadIdx.x == 0) (void)xb_add(&bar[XB_XCNT(b.x)], 1u);
    return b;
}
__device__ __forceinline__ void xcd_barrier_complete(unsigned* bar, unsigned x, unsigned& nloc, unsigned& nx) {
    const unsigned G = gridDim.x * gridDim.y * gridDim.z;
    unsigned sum, cnt, mine, sp = 0u;
    for (;;) {
        sum = 0u; cnt = 0u; mine = 0u;
#pragma unroll
        for (unsigned j = 0; j < 16; ++j) { const unsigned c = xb_ld(&bar[XB_XCNT(j)]); sum += c; cnt += (c > 0u) ? 1u : 0u; mine = (j == x) ? c : mine; }
        if (sum == G) break;
        __builtin_amdgcn_s_sleep(1);
        if ((++sp & 255u) == 0u) { if (xb_ld(&bar[XB_TMO])) break; if (sp > XB_SPIN_CAP) { atomicAdd(&bar[XB_TMO], 1u); break; } }
    }
    nloc = mine > 0u ? mine : 1u; nx = cnt > 0u ? cnt : 1u;
}
__device__ __forceinline__ void xcd_barrier(const XcdBarrier& b) {
    asm volatile("s_waitcnt vmcnt(0)" ::: "memory");
    __syncthreads();
    if (threadIdx.x == 0) {
        unsigned* bar = b.bar;
        __builtin_amdgcn_s_waitcnt(0);
        unsigned nloc = b.st[0], nx = b.st[1];
        if (nloc == 0u) { xcd_barrier_complete(bar, b.x, nloc, nx); b.st[0] = nloc; b.st[1] = nx; }
        const unsigned old = xb_add(&bar[XB_XSUB(b.x)], 1u);
        const unsigned gen = old / nloc;
        if (old + 1u == (gen + 1u) * nloc) {
            __builtin_amdgcn_fence(__ATOMIC_RELEASE, "agent");
            asm volatile("s_waitcnt vmcnt(0)" ::: "memory");
            const unsigned og = xb_add(&bar[XB_TOP], 1u);
            const unsigned tg = og / nx;
            if (og + 1u == (tg + 1u) * nx) xb_add(&bar[XB_TOPGEN], 1u);
            else XB_SPIN(xb_ld(&bar[XB_TOPGEN]) == tg, bar);
            __builtin_amdgcn_fence(__ATOMIC_ACQUIRE, "agent");
            xb_add(&bar[XB_XGEN(b.x)], 1u);
            asm volatile("s_waitcnt vmcnt(0)" ::: "memory");
        } else {
            XB_SPIN(xb_ld(&bar[XB_XGEN(b.x)]) == gen, bar);
            __builtin_amdgcn_fence(__ATOMIC_ACQUIRE, "agent");
            asm volatile("s_waitcnt vmcnt(0)" ::: "memory");
        }
    }
    __syncthreads();
}

constexpr int LDS_BYTES = 147456;
#define GSYNC() xcd_barrier(xbar)
constexpr int MISC_OFF = LDS_BYTES - 64;

__global__ void __launch_bounds__(NT, 2) mega(P p) {
    extern __shared__ __attribute__((aligned(16))) unsigned char lds_raw[];
    LAS unsigned char* lds = (LAS unsigned char*)lds_raw;
    const int G = gridDim.x, bx = blockIdx.x;
    using namespace pg8;
    if (threadIdx.x < 16) ((LAS unsigned*)(lds + MISC_OFF))[threadIdx.x] = 0u;
    __syncthreads();
    const XcdBarrier xbar = xcd_barrier_post((unsigned*)p.ws, (volatile LAS unsigned*)(lds + MISC_OFF));

    ph_prep(p, lds);
    bg_convert_tables(p);
    cg::this_grid().sync();
    ph_norm1(p, lds);
    GSYNC();
    {
        Gemm<DM, DM, DM> g{p.hx(), p.w_in_t()}; StaticOrder<NTOK, INC> S; S.init(G, bx);
        EpiInProj E{p.U(), p.kb(), (size_t)(p.qb() - p.kb()), p.vT(), p.ga(), 0};
        gemm_phase<EpiInProj, StaticOrder<NTOK, INC>, true, true>(lds, g, S, E);
        Gemm<DM, DM, DM> g2{p.hc(), p.w_in_t()}; StaticOrder<NCTX, CTXC> S2; S2.init(G, bx);
        EpiInProj E2{p.U(), p.kc(), 0, p.vcT(), p.ga(), 1};
        gemm_phase<EpiInProj, StaticOrder<NCTX, CTXC>, true, true>(lds, g2, S2, E2);
    }
    GSYNC();
    {
        Gemm<512, SSM_LD, 512, (long)SSM_ROWS * SSM_LD, 256L * 512> g{p.U(), p.Win()}; StaticOrder<SSM_ROWS, 256, 32> S; S.init(G, bx);
        EpiE E{p.E()};
        gemm_phase<EpiE, StaticOrder<SSM_ROWS, 256, 32>, true, true>(lds, g, S, E);
    }
    GSYNC();
    ph_carry(p);
    ph_na(p, lds);
    GSYNC();
    {
        Gemm<SSM_LD, SSM_LD, SSM_LD, (long)SSM_ROWS * SSM_LD, 512L * SSM_LD> g{p.U(), p.Kmat()}; StaticOrder<1024, 512, 32> S; S.init(G, bx);
        EpiZ E{p.z()};
        gemm_phase<EpiZ, StaticOrder<1024, 512, 32>, true, true>(lds, g, S, E);
    }
    GSYNC();
    {
        Gemm<512, 512, 512> g{p.z(), p.w_glu_t()}; StaticOrder<NTOK, 512> S; S.init(G, bx);
        EpiGlu E{p.gl(), p.z(), p.b_glu};
        gemm_phase<EpiGlu, StaticOrder<NTOK, 512>, true, true>(lds, g, S, E);
    }
    GSYNC();
    {
        Gemm<512, 512, 512, 32L * 1024 * 1024, 512L * 1024> g{p.na(), p.w_b_t()}; PairOrder<NTOK, DM> S; S.init(G, bx);
        EpiMerge E{p.merged(), p.ga(), p.gb()};
        gemm_phase<EpiMerge, PairOrder<NTOK, DM>, true, true>(lds, g, S, E);
    }
    GSYNC();
    {
        Gemm<DM, DM, DM> g{p.merged(), p.w_out_t()}; StaticOrder<NTOK, DM> S; S.init(G, bx);
        EpiOut E{p.x, p.out, p.x1g(), p.mod(), p.norm2_g, p.rowss()};
        gemm_phase<EpiOut, StaticOrder<NTOK, DM>, true, true>(lds, g, S, E);
    }
    GSYNC();
    {
        Gemm<DM, DM, DM> g{p.x1g(), p.w_q_t()}; StaticOrder<NTOK, 2048> S; S.init(G, bx);
        EpiQ E{p.qp(), p.rowss(), p.c2()};
        gemm_phase<EpiQ, StaticOrder<NTOK, 2048>, true, true>(lds, g, S, E);
    }
    GSYNC();
    ph_peer_topk(p, lds);
    GSYNC();
    ph_gather_sliced<0>(p);
    GSYNC();
    ph_gather_weights(p);
    GSYNC();
    ph_gather_sliced<1>(p);
    GSYNC();
    ph_final_norm(p);
}

extern "C" void kernel_launch(void* const* d_in, const int* in_sizes, int n_in, void* d_out, int out_size, void* d_ws, size_t ws_size, hipStream_t stream) {
    static int grid = 0;
    if (grid == 0) {
        int dev = 0, cus = 0, per_cu = 0;
        (void)hipGetDevice(&dev);
        (void)hipDeviceGetAttribute(&cus, hipDeviceAttributeMultiprocessorCount, dev);
        (void)hipFuncSetAttribute((const void*)mega, hipFuncAttributeMaxDynamicSharedMemorySize, LDS_BYTES);
        (void)hipOccupancyMaxActiveBlocksPerMultiprocessor(&per_cu, (const void*)mega, NT, LDS_BYTES);
        if (per_cu < 1) { fprintf(stderr, "occupancy query says %d blocks per CU\n", per_cu); per_cu = 1; }
        grid = cus;
    }
    P p{};
    const float* const* in = (const float* const*)d_in;
    p.x = in[0]; p.c = in[1]; p.ctx = in[2]; p.c_ctx = in[3]; p.w_mod = in[4]; p.b_mod = in[5]; p.norm1_g = in[6]; p.norm2_g = in[7]; p.w_in = in[8];
    p.a_re = in[9]; p.a_im = in[10]; p.log_dt = in[11]; p.b_re = in[12]; p.b_im = in[13]; p.c_re = in[14]; p.c_im = in[15]; p.ssm_d = in[16];
    p.w_glu = in[17]; p.b_glu = in[18]; p.w_a = in[19]; p.w_b = in[20]; p.rpb = in[21]; p.w_out = in[22]; p.w_q = in[23]; p.subkeys = in[24];
    p.peer_u = in[25]; p.peer_v = in[26]; p.final_g = in[27];
    p.out = (float*)d_out;
    p.ws = (unsigned char*)d_ws;
    (void)hipMemsetAsync(d_ws, 0, 1 * MiB, stream);
    void* args[] = {&p};
    hipError_t e = hipLaunchCooperativeKernel((const void*)mega, dim3(grid), dim3(NT), args, LDS_BYTES, stream);
    if (e != hipSuccess) fprintf(stderr, "cooperative launch failed: %s (grid %d)\n", hipGetErrorString(e), grid);
}
```

```cpp
#include <hip/hip_runtime.h>
#include <hip/hip_cooperative_groups.h>
#include <cstdio>
#include <cstdint>
namespace cg = cooperative_groups;

#define LAS __attribute__((address_space(3)))
typedef unsigned short bf16_t;
typedef short bf16x8 __attribute__((ext_vector_type(8)));
typedef float f32x4 __attribute__((ext_vector_type(4)));
typedef float f32x2 __attribute__((ext_vector_type(2)));
typedef unsigned u32x4 __attribute__((ext_vector_type(4)));
typedef unsigned u32x2 __attribute__((ext_vector_type(2)));

constexpr int DM = 1024, NB = 8, SEQL = 4096, CTXL = 256, GW = 64, NTOK = NB * SEQL, NCTX = NB * CTXL;
constexpr int INC = 4096, CTXC = 1536;
constexpr int NT = 512, NWAVES = 8;
constexpr float EPSN = 1e-6f;
constexpr int SSM_ROWS = 1280;
constexpr int SSM_LD = 768;

__device__ __forceinline__ unsigned f2bf(float f) { unsigned u = __builtin_bit_cast(unsigned, f); return (u + 0x7fffu + ((u >> 16) & 1u)) >> 16; }
__device__ __forceinline__ unsigned pk2(float lo, float hi) { return f2bf(lo) | (f2bf(hi) << 16); }
__device__ __forceinline__ float bflo(unsigned w) { return __builtin_bit_cast(float, w << 16); }
__device__ __forceinline__ float bfhi(unsigned w) { return __builtin_bit_cast(float, w & 0xffff0000u); }
__device__ __forceinline__ float bf2f(bf16_t h) { return __builtin_bit_cast(float, (unsigned)h << 16); }

__device__ __forceinline__ float wave_sum(float v) {
#pragma unroll
    for (int o = 1; o < 64; o <<= 1) v += __shfl_xor(v, o);
    return v;
}
__device__ __forceinline__ float wave_max(float v) {
#pragma unroll
    for (int o = 1; o < 64; o <<= 1) v = fmaxf(v, __shfl_xor(v, o));
    return v;
}
__device__ __forceinline__ float frcp(float x) { return __builtin_amdgcn_rcpf(x); }
__device__ __forceinline__ float sigmoidf_(float x) { return frcp(1.f + __expf(-x)); }
__device__ __forceinline__ float siluf_(float x) { return x * frcp(1.f + __expf(-x)); }
__device__ __forceinline__ float gelu_tanh(float x) {
    const float k0 = 0.7978845608028654f, k1 = 0.044715f;
    const float u = k0 * (x + k1 * x * x * x);
    const float t = 1.f - 2.f * frcp(1.f + __expf(2.f * u));
    return 0.5f * x * (1.f + t);
}

namespace pg8 {
#define PG8_LAS __attribute__((address_space(3)))
constexpr int BM = 256, BK = 64, HALF = 128, HTB = HALF * BK * 2  , STAGE_BYTES = 8 * HTB, NXCD = 8, WGM = 8;
__host__ __device__ __forceinline__ int lds_byte(int r, int c) { const int st = (r >> 4) * 2 + (c >> 5), rr = r & 15, cc = c & 31, ob = rr * 64 + cc * 2; return st * 1024 + (ob ^ (((ob >> 9) & 1) << 5)); }
__host__ __device__ __forceinline__ void stage_rc(int b, int& R, int& C) { const int st = b / 1024, sb = b % 1024, swz = sb ^ (((sb >> 9) & 1) << 5); R = (st >> 1) * 16 + swz / 64; C = (st & 1) * 32 + (swz % 64) / 2; }
__host__ __device__ __forceinline__ int perm32(int rho) { const int n = rho >> 4, i = rho & 15; return 8 * (i >> 2) + 4 * n + (i & 3); }

struct Unit { int pm, pn, g; };
template <int K_, int LDA, int LDB, long GSA = 0, long GSB = 0>
struct Gemm {
    const bf16_t* A; const bf16_t* Bt;
    static constexpr int K = K_, lda = LDA, ldb = LDB;
    __device__ __forceinline__ const char* abase(const Unit& u) const { return (const char*)(A + (size_t)u.g * GSA + (size_t)u.pm * BM * LDA); }
    __device__ __forceinline__ const char* bbase(const Unit& u) const { return (const char*)(Bt + (size_t)u.g * GSB + (size_t)u.pn * BM * LDB); }
};
template <int M, int N, int NGRP = 1>
struct StaticOrder {
    static constexpr int nM = M / BM, nN = N / BM, nwg = nM * nN;
    int G, c;
    __device__ void init(int G_, int c_) { G = G_; c = c_; }
    __device__ bool next(int i, Unit& u) const {
        const int L = i * G + c; if (L >= nwg * NGRP) return false;
        u.g = L / nwg;
        int wgid = L % nwg; { constexpr int q = nwg / NXCD, r = nwg % NXCD; const int xcd = wgid % NXCD, off = wgid / NXCD; wgid = (xcd < r ? xcd * (q + 1) : r * (q + 1) + (xcd - r) * q) + off; }
        constexpr int nig = WGM * nN; const int gid = wgid / nig, fm = gid * WGM, gsz = (nM - fm) < WGM ? (nM - fm) : WGM;
        u.pm = fm + ((wgid % nig) % gsz); u.pn = (wgid % nig) / gsz; return true;
    }
    __device__ __forceinline__ void a_ready(const Unit&) const {}
    __device__ __forceinline__ void done(const Unit&) const {}
};
__device__ __forceinline__ unsigned cvt_pk_bf16(float lo, float hi) { unsigned r; asm volatile("v_cvt_pk_bf16_f32 %0, %1, %2" : "=v"(r) : "v"(lo), "v"(hi)); return r; }
template <class Epi, class Sched, bool ALIGN_EPI = false, bool SP2 = false, class GemmT>
__device__ __forceinline__ void gemm_phase(PG8_LAS unsigned char* lds, const GemmT g, const Sched& S, const Epi& E) {
    int tid_ = threadIdx.x; asm volatile("" : "+v"(tid_));
    const int tid = tid_, wid = __builtin_amdgcn_readfirstlane(tid >> 6), lane = tid & 63, wr = wid >> 2, wc = wid & 3, fr = lane & 15, fq = lane >> 4;
    const int K = g.K, nt = K / BK;
    unsigned voffA[2], voffB[2];
#pragma unroll
    for (int i = 0; i < 2; ++i) { int R, C; stage_rc(tid * 16 + i * 8192, R, C); const int Rb = Epi::PERM ? ((R & ~31) + perm32(R & 31)) : R;
        voffA[i] = (unsigned)(R * g.lda + C) * 2u; voffB[i] = (unsigned)(Rb * g.ldb + C) * 2u; }
    const size_t kstep = (size_t)(BK * 2);
    const size_t hstepA = (size_t)HALF * g.lda * 2, hstepB = (size_t)HALF * g.ldb * 2;
    const unsigned ldsw = (unsigned)wid * 1024u;
    const int aoff = lds_byte(wr * 64 + fr, fq * 8), boff = lds_byte(wc * 32 + fr, fq * 8);
#define PG8_SA(b, h) (((b) * 2 + (h)) * HTB)
#define PG8_SB(b, h) ((4 + (b) * 2 + (h)) * HTB)
#define PG8_STAGE(bufoff, gbase, voff) do { _Pragma("unroll") for (int _i = 0; _i < 2; ++_i) \
        __builtin_amdgcn_global_load_lds((const unsigned*)((const char*)(gbase) + (voff)[_i]), (PG8_LAS unsigned*)(lds + (bufoff) + ldsw + _i * 8192), 16, 0, 0); } while (0)
#define PG8_LDA(dst, b, h) do { _Pragma("unroll") for (int m = 0; m < 4; ++m) _Pragma("unroll") for (int k = 0; k < 2; ++k) dst[m][k] = *(const PG8_LAS bf16x8*)(lds + PG8_SA(b, h) + aoff + m * 2048 + k * 1024); } while (0)
#define PG8_LDB(dst, b, h) do { _Pragma("unroll") for (int n = 0; n < 2; ++n) _Pragma("unroll") for (int k = 0; k < 2; ++k) dst[n][k] = *(const PG8_LAS bf16x8*)(lds + PG8_SB(b, h) + boff + n * 2048 + k * 1024); } while (0)
#define PG8_MMA(ai, bj, At, Bt) do { __builtin_amdgcn_s_setprio(1); _Pragma("unroll") for (int m = 0; m < 4; ++m) _Pragma("unroll") for (int n = 0; n < 2; ++n) _Pragma("unroll") for (int k = 0; k < 2; ++k) \
        acc[ai][bj][m][n] = __builtin_amdgcn_mfma_f32_16x16x32_bf16(Bt[n][k], At[m][k], acc[ai][bj][m][n], 0, 0, 0); __builtin_amdgcn_s_setprio(0); } while (0)
#define PG8_WAIT_V(n) asm volatile("s_waitcnt vmcnt(" #n ")" ::: "memory")
#define PG8_WAIT_L(n) asm volatile("s_waitcnt lgkmcnt(" #n ")" ::: "memory")
#define PG8_BAR __builtin_amdgcn_s_barrier()
#define PG8_SCHED __builtin_amdgcn_sched_barrier(0)
    Unit cur, nxt; int ui = 0;
    if (!S.next(0, cur)) return;
    f32x4 acc[2][2][4][2];
#pragma unroll
    for (int a = 0; a < 2; ++a)
#pragma unroll
        for (int b = 0; b < 2; ++b)
#pragma unroll
            for (int m = 0; m < 4; ++m)
#pragma unroll
                for (int n = 0; n < 2; ++n) acc[a][b][m][n] = (f32x4){0.f, 0.f, 0.f, 0.f};
    bf16x8 At[4][2], B0[2][2], B1[2][2];
    const char* cA = g.abase(cur); const char* cB = g.bbase(cur);
    S.a_ready(cur);
    if constexpr (SP2) {
        PG8_STAGE(PG8_SB(0, 0), cB, voffB); PG8_STAGE(PG8_SB(0, 1), cB + hstepB, voffB); PG8_STAGE(PG8_SA(0, 0), cA, voffA); PG8_STAGE(PG8_SA(0, 1), cA + hstepA, voffA);
        if (wr == 1) PG8_BAR;
        PG8_WAIT_V(2); PG8_BAR;
        PG8_STAGE(PG8_SB(1, 0), cB + kstep, voffB); PG8_STAGE(PG8_SA(1, 0), cA + kstep, voffA); PG8_STAGE(PG8_SB(1, 1), cB + hstepB + kstep, voffB);
        PG8_WAIT_V(6); PG8_BAR;
    } else {
        PG8_STAGE(PG8_SB(0, 0), cB, voffB); PG8_STAGE(PG8_SA(0, 0), cA, voffA); PG8_STAGE(PG8_SB(0, 1), cB + hstepB, voffB); PG8_STAGE(PG8_SA(0, 1), cA + hstepA, voffA);
        if (wr == 1) PG8_BAR;
        PG8_WAIT_V(4); PG8_BAR;
        PG8_STAGE(PG8_SB(1, 0), cB + kstep, voffB); PG8_STAGE(PG8_SA(1, 0), cA + kstep, voffA); PG8_STAGE(PG8_SB(1, 1), cB + hstepB + kstep, voffB);
        PG8_WAIT_V(6); PG8_BAR;
    }
    for (;;) {
        const bool has_next = S.next(ui + 1, nxt);
        const char* nA = has_next ? g.abase(nxt) : cA; const char* nB = has_next ? g.bbase(nxt) : cB;
        for (int t = 0; t < nt; t += 2) {
            const bool last = (t == nt - 2);
            const char* a1 = cA + (size_t)(t + 1) * kstep;
            const char* a2 = last ? nA : cA + (size_t)(t + 2) * kstep; const char* b2 = last ? nB : cB + (size_t)(t + 2) * kstep;
            const char* a3 = a2 + kstep; const char* b3 = b2 + kstep;
            if (last && has_next) S.a_ready(nxt);
            if constexpr (SP2) {
            PG8_LDB(B0, 0, 0); PG8_LDB(B1, 0, 1); PG8_SCHED; PG8_LDA(At, 0, 0); PG8_STAGE(PG8_SA(1, 1), a1 + hstepA, voffA);
            PG8_WAIT_V(8); PG8_WAIT_L(0); PG8_BAR; PG8_MMA(0, 0, At, B0); PG8_MMA(0, 1, At, B1); PG8_BAR; PG8_SCHED;
            PG8_LDA(At, 0, 1); PG8_STAGE(PG8_SB(0, 0), b2, voffB); PG8_STAGE(PG8_SB(0, 1), b2 + hstepB, voffB); PG8_STAGE(PG8_SA(0, 0), a2, voffA);
            PG8_WAIT_V(8); PG8_WAIT_L(0); PG8_BAR; PG8_MMA(1, 0, At, B0); PG8_MMA(1, 1, At, B1); PG8_BAR; PG8_SCHED;
            PG8_LDB(B0, 1, 0); PG8_LDB(B1, 1, 1); PG8_SCHED; PG8_LDA(At, 1, 0); PG8_STAGE(PG8_SA(0, 1), a2 + hstepA, voffA);
            PG8_WAIT_V(8); PG8_WAIT_L(0); PG8_BAR; PG8_MMA(0, 0, At, B0); PG8_MMA(0, 1, At, B1); PG8_BAR; PG8_SCHED;
            PG8_LDA(At, 1, 1); PG8_STAGE(PG8_SB(1, 0), b3, voffB); PG8_STAGE(PG8_SB(1, 1), b3 + hstepB, voffB); PG8_STAGE(PG8_SA(1, 0), a3, voffA);
            PG8_WAIT_V(8); PG8_WAIT_L(0); PG8_BAR; PG8_MMA(1, 0, At, B0); PG8_MMA(1, 1, At, B1); PG8_BAR; PG8_SCHED;
            } else {
            PG8_LDB(B0, 0, 0); PG8_SCHED; PG8_LDA(At, 0, 0); PG8_STAGE(PG8_SA(1, 1), a1 + hstepA, voffA);
            PG8_WAIT_L(8); PG8_BAR; PG8_WAIT_L(0); PG8_MMA(0, 0, At, B0); PG8_BAR; PG8_SCHED;
            PG8_LDB(B1, 0, 1); PG8_STAGE(PG8_SB(0, 0), b2, voffB);
            PG8_BAR; PG8_WAIT_L(0); PG8_MMA(0, 1, At, B1); PG8_BAR;
            PG8_LDA(At, 0, 1); PG8_STAGE(PG8_SA(0, 0), a2, voffA);
            PG8_BAR; PG8_WAIT_L(0); PG8_MMA(1, 0, At, B0); PG8_BAR; PG8_SCHED;
            PG8_STAGE(PG8_SB(0, 1), b2 + hstepB, voffB);
            PG8_WAIT_V(6); PG8_BAR; PG8_MMA(1, 1, At, B1); PG8_BAR;
            PG8_LDB(B0, 1, 0); PG8_SCHED; PG8_LDA(At, 1, 0); PG8_STAGE(PG8_SA(0, 1), a2 + hstepA, voffA);
            PG8_WAIT_L(8); PG8_BAR; PG8_WAIT_L(0); PG8_MMA(0, 0, At, B0); PG8_BAR; PG8_SCHED;
            PG8_LDB(B1, 1, 1); PG8_STAGE(PG8_SB(1, 0), b3, voffB);
            PG8_BAR; PG8_WAIT_L(0); PG8_MMA(0, 1, At, B1); PG8_BAR;
            PG8_LDA(At, 1, 1); PG8_STAGE(PG8_SA(1, 0), a3, voffA);
            PG8_BAR; PG8_WAIT_L(0); PG8_MMA(1, 0, At, B0); PG8_BAR; PG8_SCHED;
            PG8_STAGE(PG8_SB(1, 1), b3 + hstepB, voffB);
            PG8_WAIT_V(6); PG8_BAR; PG8_MMA(1, 1, At, B1); PG8_BAR;
            }
        }
        if constexpr (ALIGN_EPI) { if (wr == 0) PG8_BAR; }
        if constexpr (!Epi::AFTER_DRAIN) { E(acc, cur, wr, wc, fr, fq); S.done(cur); }
        if (!has_next) break;
        if (!E.keep(cur)) {
#pragma unroll
        for (int a = 0; a < 2; ++a)
#pragma unroll
            for (int b = 0; b < 2; ++b)
#pragma unroll
                for (int m = 0; m < 4; ++m)
#pragma unroll
                    for (int n = 0; n < 2; ++n) acc[a][b][m][n] = (f32x4){0.f, 0.f, 0.f, 0.f};
        }
        cur = nxt; cA = nA; cB = nB; ++ui;
        if constexpr (ALIGN_EPI) { if (wr == 1) PG8_BAR; }
    }
    PG8_WAIT_V(0);
    if constexpr (!ALIGN_EPI) { if (wr == 0) PG8_BAR; }
    PG8_BAR;
    if constexpr (Epi::AFTER_DRAIN) { E.fused(acc, cur, wr, wc, fr, fq, lds, wid, lane); S.done(cur); }
#undef PG8_SA
#undef PG8_SB
#undef PG8_STAGE
#undef PG8_LDA
#undef PG8_LDB
#undef PG8_MMA
#undef PG8_WAIT_V
#undef PG8_WAIT_L
#undef PG8_BAR
#undef PG8_SCHED
}
}

constexpr size_t MiB = 1u << 20;
struct P {
    const float *x, *c, *ctx, *c_ctx, *w_mod, *b_mod, *norm1_g, *norm2_g, *w_in;
    const float *a_re, *a_im, *log_dt, *b_re, *b_im, *c_re, *c_im, *ssm_d;
    const float *w_glu, *b_glu, *w_a, *w_b, *rpb, *w_out, *w_q, *subkeys, *peer_u, *peer_v, *final_g;
    float* out;
    unsigned char* ws;
    __device__ __forceinline__ unsigned long long* rowss() const { return (unsigned long long*)(ws + 512 * 1024); }
    __device__ __forceinline__ float* mod() const { return (float*)(ws + 1 * MiB); }
    __device__ __forceinline__ float* c2() const { return (float*)(ws + 1 * MiB + 256 * 1024); }
    __device__ __forceinline__ bf16_t* w_in_t() const { return (bf16_t*)(ws + 3 * MiB); }
    __device__ __forceinline__ bf16_t* w_glu_t() const { return (bf16_t*)(ws + 11 * MiB); }
    __device__ __forceinline__ bf16_t* w_b_t() const { return (bf16_t*)(ws + 12 * MiB); }
    __device__ __forceinline__ bf16_t* w_a_t() const { return (bf16_t*)(ws + 13 * MiB); }
    __device__ __forceinline__ bf16_t* w_out_t() const { return (bf16_t*)(ws + 14 * MiB); }
    __device__ __forceinline__ bf16_t* w_q_t() const { return (bf16_t*)(ws + 16 * MiB); }
    __device__ __forceinline__ bf16_t* Kmat() const { return (bf16_t*)(ws + 21 * MiB); }
    __device__ __forceinline__ bf16_t* Win() const { return (bf16_t*)(ws + 45 * MiB); }
    __device__ __forceinline__ float* lamT() const { return (float*)(ws + 53 * MiB); }
    __device__ __forceinline__ unsigned char* pu8() const { return ws + 54 * MiB; }
    __device__ __forceinline__ unsigned char* pv8() const { return ws + 70 * MiB; }
    __device__ __forceinline__ float* pisc() const { return (float*)(ws + 53 * MiB + 128 * 1024); }
    __device__ __forceinline__ float* pisc_u() const { return (float*)(ws + 53 * MiB + 256 * 1024); }
    __device__ __forceinline__ bf16_t* ga() const { return (bf16_t*)(ws + 118 * MiB); }
    __device__ __forceinline__ bf16_t* gb() const { return (bf16_t*)(ws + 182 * MiB); }
    __device__ __forceinline__ bf16_t* x1g() const { return (bf16_t*)(ws + 118 * MiB); }
    __device__ __forceinline__ unsigned* topk() const { return (unsigned*)(ws + 182 * MiB); }
    __device__ __forceinline__ float* gates() const { return (float*)(ws + 198 * MiB); }
    __device__ __forceinline__ bf16_t* kb() const { return (bf16_t*)(ws + 246 * MiB); }
    __device__ __forceinline__ bf16_t* vT() const { return (bf16_t*)(ws + 278 * MiB); }
    __device__ __forceinline__ bf16_t* qb() const { return (bf16_t*)(ws + 310 * MiB); }
    __device__ __forceinline__ bf16_t* kc() const { return (bf16_t*)(ws + 342 * MiB); }
    __device__ __forceinline__ bf16_t* vcT() const { return (bf16_t*)(ws + 344 * MiB); }
    __device__ __forceinline__ bf16_t* U() const { return (bf16_t*)(ws + 346 * MiB); }
    __device__ __forceinline__ float* E() const { return (float*)(ws + 406 * MiB); }
    __device__ __forceinline__ bf16_t* merged() const { return (bf16_t*)(ws + 246 * MiB); }
    __device__ __forceinline__ bf16_t* qp() const { return (bf16_t*)(ws + 246 * MiB); }
    __device__ __forceinline__ float* apart() const { return (float*)(ws + 246 * MiB); }
    __device__ __forceinline__ float* wl() const { return (float*)(ws + 374 * MiB); }
    __device__ __forceinline__ float* ss2() const { return (float*)(ws + 406 * MiB); }
    __device__ __forceinline__ bf16_t* x1b() const { return (bf16_t*)(ws + 406 * MiB); }
    __device__ __forceinline__ unsigned* queues() const { return (unsigned*)(ws + 64 * 1024); }
    __device__ __forceinline__ bf16_t* hx() const { return (bf16_t*)out; }
    __device__ __forceinline__ bf16_t* hc() const { return (bf16_t*)((unsigned char*)out + 64 * MiB); }
    __device__ __forceinline__ bf16_t* na() const { return (bf16_t*)out; }
    __device__ __forceinline__ bf16_t* z() const { return (bf16_t*)((unsigned char*)out + 32 * MiB); }
    __device__ __forceinline__ bf16_t* gl() const { return (bf16_t*)((unsigned char*)out + 64 * MiB); }
};

constexpr float SS_FIX = 1099511627776.f, SS_UNFIX = 1.f / 1099511627776.f;
__device__ __forceinline__ float rstd_from_fix(unsigned long long v) { return rsqrtf((float)v * (SS_UNFIX / DM) + EPSN); }
namespace pg8 {
struct EpiInProj {
    static constexpr bool PERM = true, AFTER_DRAIN = false;
    __device__ __forceinline__ bool keep(const Unit&) const { return false; }
    bf16_t* U; bf16_t* d_kq; size_t kq_stride; bf16_t* d_vT; bf16_t* d_gate; int is_ctx;
    __device__ __forceinline__ void operator()(const f32x4 (&acc)[2][2][4][2], const Unit& u, int wr, int wc, int fr, int fq) const {
        if (u.pn < 2) {
#pragma unroll
            for (int ai = 0; ai < 2; ++ai)
#pragma unroll
                for (int m = 0; m < 4; ++m) {
                    const int row = u.pm * BM + ai * HALF + wr * 64 + m * 16 + fr;
                    const int n = is_ctx ? (1024 + (row >> 8) * 8 + ((row & 255) >> 5)) : ((row >> 12) * 128 + ((row & 4095) >> 5));
                    const int jj = row & 31;
#pragma unroll
                    for (int bj = 0; bj < 2; ++bj) {
                        const int col = u.pn * BM + bj * HALF + wc * 32 + 8 * fq;
                        const f32x4 v0 = acc[ai][bj][m][0], v1 = acc[ai][bj][m][1];
                        u32x4 w; w.x = cvt_pk_bf16(v0[0], v0[1]); w.y = cvt_pk_bf16(v0[2], v0[3]); w.z = cvt_pk_bf16(v1[0], v1[1]); w.w = cvt_pk_bf16(v1[2], v1[3]);
                        *(u32x4*)(U + ((size_t)((col >> 4) * SSM_ROWS + n) * SSM_LD + jj * 16 + (col & 15))) = w;
                    }
                    asm volatile("" ::: "memory");
                }
        } else if (u.pn == 4 || u.pn == 5) {
            const int RB = is_ctx ? (CTXL / 64) : (SEQL / 64);
#pragma unroll
            for (int ai = 0; ai < 2; ++ai)
#pragma unroll
                for (int m = 0; m < 4; ++m) {
                    const int row = u.pm * BM + ai * HALF + wr * 64 + m * 16 + fr;
                    const int b = is_ctx ? (row >> 8) : (row >> 12), t = is_ctx ? (row & 255) : (row & 4095);
#pragma unroll
                    for (int bj = 0; bj < 2; ++bj) {
                        const int col = u.pn * BM + bj * HALF + wc * 32 + 8 * fq - 1024;
                        bf16_t* dst = d_vT + ((size_t)((b * 8 + (col >> 6)) * RB + (t >> 6)) * 4096 + (col & 63) * 64 + (t & 63));
#pragma unroll
                        for (int n = 0; n < 2; ++n)
#pragma unroll
                            for (int i = 0; i < 4; ++i) dst[(n * 4 + i) * 64] = (bf16_t)f2bf(acc[ai][bj][m][n][i]);
                    }
                    asm volatile("" ::: "memory");
                }
        } else {
            bf16_t* base; int ld, c0;
            if (u.pn < 8) { const int which = (u.pn - 2) >> 2; base = d_kq + (size_t)which * kq_stride; ld = 512; c0 = 512 + which * 1024; }
            else { const int which = (u.pn - 8) >> 2; base = d_gate + (size_t)which * ((size_t)NTOK * DM); ld = DM; c0 = 2048 + which * 1024; }
#pragma unroll
            for (int ai = 0; ai < 2; ++ai)
#pragma unroll
                for (int m = 0; m < 4; ++m) {
                    const int row = u.pm * BM + ai * HALF + wr * 64 + m * 16 + fr;
#pragma unroll
                    for (int bj = 0; bj < 2; ++bj) {
                        const int col = u.pn * BM + bj * HALF + wc * 32 + 8 * fq - c0;
                        const f32x4 v0 = acc[ai][bj][m][0], v1 = acc[ai][bj][m][1];
                        u32x4 w; w.x = cvt_pk_bf16(v0[0], v0[1]); w.y = cvt_pk_bf16(v0[2], v0[3]); w.z = cvt_pk_bf16(v1[0], v1[1]); w.w = cvt_pk_bf16(v1[2], v1[3]);
                        *(u32x4*)(base + (size_t)row * ld + col) = w;
                    }
                    asm volatile("" ::: "memory");
                }
        }
    }
};
struct EpiGlu {
    static constexpr bool PERM = true, AFTER_DRAIN = false;
    __device__ __forceinline__ bool keep(const Unit&) const { return false; }
    bf16_t* gl; const bf16_t* z; const float* bias;
    __device__ __forceinline__ void operator()(const f32x4 (&acc)[2][2][4][2], const Unit& u, int wr, int wc, int fr, int fq) const {
#pragma unroll
        for (int ai = 0; ai < 2; ++ai)
#pragma unroll
            for (int m = 0; m < 4; ++m) {
                const int row = u.pm * BM + ai * HALF + wr * 64 + m * 16 + fr;
#pragma unroll
                for (int bj = 0; bj < 2; ++bj) {
                    const int col = u.pn * BM + bj * HALF + wc * 32 + 8 * fq;
                    const f32x4 v0 = acc[ai][bj][m][0], v1 = acc[ai][bj][m][1];
                    const f32x4 b0 = *(const f32x4*)(bias + col), b1 = *(const f32x4*)(bias + col + 4);
                    const u32x4 zz = *(const u32x4*)(z + (size_t)row * 512 + col);
                    float o[8];
                    o[0] = bflo(zz.x) * sigmoidf_(v0[0] + b0[0]); o[1] = bfhi(zz.x) * sigmoidf_(v0[1] + b0[1]);
                    o[2] = bflo(zz.y) * sigmoidf_(v0[2] + b0[2]); o[3] = bfhi(zz.y) * sigmoidf_(v0[3] + b0[3]);
                    o[4] = bflo(zz.z) * sigmoidf_(v1[0] + b1[0]); o[5] = bfhi(zz.z) * sigmoidf_(v1[1] + b1[1]);
                    o[6] = bflo(zz.w) * sigmoidf_(v1[2] + b1[2]); o[7] = bfhi(zz.w) * sigmoidf_(v1[3] + b1[3]);
                    u32x4 w; w.x = cvt_pk_bf16(o[0], o[1]); w.y = cvt_pk_bf16(o[2], o[3]); w.z = cvt_pk_bf16(o[4], o[5]); w.w = cvt_pk_bf16(o[6], o[7]);
                    *(u32x4*)(gl + (size_t)row * 512 + col) = w;
                }
            }
    }
};
template <int M, int N>
struct PairOrder {
    StaticOrder<M, N> S;
    __device__ void init(int G_, int c_) { S.init(G_, c_); }
    __device__ bool next(int i, Unit& u) const { if (!S.next(i >> 1, u)) return false; u.g = i & 1; return true; }
    __device__ __forceinline__ void a_ready(const Unit&) const {}
    __device__ __forceinline__ void done(const Unit&) const {}
};
struct EpiMerge {
    static constexpr bool PERM = true, AFTER_DRAIN = false;
    __device__ __forceinline__ bool keep(const Unit& u) const { return u.g == 0; }
    bf16_t* merged; const bf16_t* ga; const bf16_t* gb;
    __device__ __forceinline__ void operator()(f32x4 (&acc)[2][2][4][2], const Unit& u, int wr, int wc, int fr, int fq) const {
#pragma unroll
        for (int ai = 0; ai < 2; ++ai)
#pragma unroll
            for (int m = 0; m < 4; ++m) {
                const int row = u.pm * BM + ai * HALF + wr * 64 + m * 16 + fr;
#pragma unroll
                for (int bj = 0; bj < 2; ++bj) {
                    const int col = u.pn * BM + bj * HALF + wc * 32 + 8 * fq;
                    const u32x4 a4 = *(const u32x4*)(ga + (size_t)row * DM + col);
                    float sa[8];
#pragma unroll
                    for (int q = 0; q < 4; ++q) { sa[2 * q] = sigmoidf_(bflo(a4[q])); sa[2 * q + 1] = sigmoidf_(bfhi(a4[q])); }
                    if (u.g == 0) {
                        const u32x4 b4 = *(const u32x4*)(gb + (size_t)row * DM + col);
#pragma unroll
                        for (int q = 0; q < 4; ++q) {
                            const float r0 = sigmoidf_(bflo(b4[q])) * frcp(sa[2 * q]), r1 = sigmoidf_(bfhi(b4[q])) * frcp(sa[2 * q + 1]);
                            acc[ai][bj][m][q >> 1][(q & 1) * 2] *= r0; acc[ai][bj][m][q >> 1][(q & 1) * 2 + 1] *= r1;
                        }
                    } else {
                        const f32x4 v0 = acc[ai][bj][m][0], v1 = acc[ai][bj][m][1];
                        u32x4 w; w[0] = cvt_pk_bf16(v0[0] * sa[0], v0[1] * sa[1]); w[1] = cvt_pk_bf16(v0[2] * sa[2], v0[3] * sa[3]); w[2] = cvt_pk_bf16(v1[0] * sa[4], v1[1] * sa[5]); w[3] = cvt_pk_bf16(v1[2] * sa[6], v1[3] * sa[7]);
                        *(u32x4*)(merged + (size_t)row * DM + col) = w;
                    }
                }
                asm volatile("" ::: "memory");
            }
    }
};
struct EpiOut {
    static constexpr bool PERM = true, AFTER_DRAIN = false;
    __device__ __forceinline__ bool keep(const Unit&) const { return false; }
    const float* x; bf16_t* x1; bf16_t* x1g; const float* mod; const float* g2; unsigned long long* rowss;
    __device__ __forceinline__ void operator()(const f32x4 (&acc)[2][2][4][2], const Unit& u, int wr, int wc, int fr, int fq) const {
#pragma unroll
        for (int ai = 0; ai < 2; ++ai)
#pragma unroll
            for (int m = 0; m < 4; ++m) {
                const int row = u.pm * BM + ai * HALF + wr * 64 + m * 16 + fr;
                const float* modb = mod + (size_t)(row >> 12) * (6 * DM);
                float ss = 0.f;
#pragma unroll
                for (int bj = 0; bj < 2; ++bj) {
                    const int col = u.pn * BM + bj * HALF + wc * 32 + 8 * fq;
#pragma unroll
                    for (int n = 0; n < 2; ++n) {
                        const int cc = col + 4 * n;
                        const f32x4 v = acc[ai][bj][m][n];
                        const f32x4 xx = *(const f32x4*)(x + (size_t)row * DM + cc);
                        const f32x4 g1 = *(const f32x4*)(modb + 2 * DM + cc), sc = *(const f32x4*)(modb + 4 * DM + cc), gg = *(const f32x4*)(g2 + cc);
                        const f32x4 o = xx + g1 * v;
                        { u32x2 w1; w1.x = cvt_pk_bf16(o[0], o[1]); w1.y = cvt_pk_bf16(o[2], o[3]); *(u32x2*)(x1 + (size_t)row * DM + cc) = w1; }
                        ss += o[0] * o[0] + o[1] * o[1] + o[2] * o[2] + o[3] * o[3];
                        const f32x4 og = o * gg * (sc + 1.f);
                        u32x2 w; w.x = cvt_pk_bf16(og[0], og[1]); w.y = cvt_pk_bf16(og[2], og[3]);
                        *(u32x2*)(x1g + (size_t)row * DM + cc) = w;
                    }
                }
                ss += __shfl_xor(ss, 16); ss += __shfl_xor(ss, 32);
                if (fq == 0) atomicAdd(rowss + row, (unsigned long long)(ss * SS_FIX));
            }
    }
};
struct EpiQ {
    static constexpr bool PERM = true, AFTER_DRAIN = false;
    __device__ __forceinline__ bool keep(const Unit&) const { return false; }
    bf16_t* qp; const unsigned long long* rowss; const float* c2;
    __device__ __forceinline__ void operator()(const f32x4 (&acc)[2][2][4][2], const Unit& u, int wr, int wc, int fr, int fq) const {
#pragma unroll
        for (int ai = 0; ai < 2; ++ai)
#pragma unroll
            for (int m = 0; m < 4; ++m) {
                const int row = u.pm * BM + ai * HALF + wr * 64 + m * 16 + fr;
                const float rstd = rstd_from_fix(rowss[row]);
                const float* cb = c2 + (size_t)(row >> 12) * 2048;
#pragma unroll
                for (int bj = 0; bj < 2; ++bj) {
                    const int col = u.pn * BM + bj * HALF + wc * 32 + 8 * fq;
                    const f32x4 v0 = acc[ai][bj][m][0] * rstd + *(const f32x4*)(cb + col), v1 = acc[ai][bj][m][1] * rstd + *(const f32x4*)(cb + col + 4);
                    u32x4 w; w.x = cvt_pk_bf16(v0[0], v0[1]); w.y = cvt_pk_bf16(v0[2], v0[3]); w.z = cvt_pk_bf16(v1[0], v1[1]); w.w = cvt_pk_bf16(v1[2], v1[3]);
                    *(u32x4*)(qp + (size_t)row * 2048 + col) = w;
                }
            }
    }
};
struct EpiE {
    static constexpr bool PERM = true, AFTER_DRAIN = false;
    __device__ __forceinline__ bool keep(const Unit&) const { return false; }
    float* E;
    __device__ __forceinline__ void operator()(const f32x4 (&acc)[2][2][4][2], const Unit& u, int wr, int wc, int fr, int fq) const {
#pragma unroll
        for (int ai = 0; ai < 2; ++ai)
#pragma unroll
            for (int m = 0; m < 4; ++m) {
                const int row = u.pm * BM + ai * HALF + wr * 64 + m * 16 + fr;
#pragma unroll
                for (int bj = 0; bj < 2; ++bj) {
                    const int col = u.pn * BM + bj * HALF + wc * 32 + 8 * fq;
                    float* d = E + ((size_t)(u.g * SSM_ROWS + row) * 256 + col);
                    *(f32x4*)d = acc[ai][bj][m][0]; *(f32x4*)(d + 4) = acc[ai][bj][m][1];
                }
            }
    }
};
struct EpiZ {
    static constexpr bool PERM = true, AFTER_DRAIN = false;
    __device__ __forceinline__ bool keep(const Unit&) const { return false; }
    bf16_t* z;
    __device__ __forceinline__ void operator()(const f32x4 (&acc)[2][2][4][2], const Unit& u, int wr, int wc, int fr, int fq) const {
#pragma unroll
        for (int ai = 0; ai < 2; ++ai)
#pragma unroll
            for (int m = 0; m < 4; ++m) {
                const int n = u.pm * BM + ai * HALF + wr * 64 + m * 16 + fr;
                const size_t tok0 = (size_t)(n >> 7) * SEQL + (size_t)(n & 127) * 32;
#pragma unroll
                for (int bj = 0; bj < 2; ++bj) {
                    const int col = u.pn * BM + bj * HALF + wc * 32 + 8 * fq;
                    const f32x4 v0 = acc[ai][bj][m][0], v1 = acc[ai][bj][m][1];
                    u32x4 w; w.x = cvt_pk_bf16(gelu_tanh(v0[0]), gelu_tanh(v0[1])); w.y = cvt_pk_bf16(gelu_tanh(v0[2]), gelu_tanh(v0[3]));
                    w.z = cvt_pk_bf16(gelu_tanh(v1[0]), gelu_tanh(v1[1])); w.w = cvt_pk_bf16(gelu_tanh(v1[2]), gelu_tanh(v1[3]));
                    *(u32x4*)(z + (tok0 + (col >> 4)) * 512 + u.g * 16 + (col & 15)) = w;
                }
            }
    }
};
}

__device__ __forceinline__ void sincos_d(double th, double& s, double& c) {
    const double twopi = 6.283185307179586476925, hpi = 1.570796326794896619231;
    th -= twopi * rint(th / twopi);
    const double q = rint(th / hpi); const double y = th - q * hpi, y2 = y * y;
    const double sy = y * (1.0 - y2 / 6.0 * (1.0 - y2 / 20.0 * (1.0 - y2 / 42.0 * (1.0 - y2 / 72.0 * (1.0 - y2 / 110.0 * (1.0 - y2 / 156.0 * (1.0 - y2 / 210.0)))))));
    const double cy = 1.0 - y2 / 2.0 * (1.0 - y2 / 12.0 * (1.0 - y2 / 30.0 * (1.0 - y2 / 56.0 * (1.0 - y2 / 90.0 * (1.0 - y2 / 132.0 * (1.0 - y2 / 182.0))))));
    const int qi = ((int)q) & 3;
    s = qi == 0 ? sy : (qi == 1 ? cy : (qi == 2 ? -sy : -cy));
    c = qi == 0 ? cy : (qi == 1 ? -sy : (qi == 2 ? -cy : sy));
}
__device__ __forceinline__ void ssm_prep_item(const P& p, LAS unsigned char* lds, int item) {
    const int g = item >> 2, qtr = item & 3, tid = threadIdx.x;
    LAS f32x2* lamk = (LAS f32x2*)lds;
    LAS f32x2* Bb = lamk + 2 * 64 * 33;
    LAS f32x2* Cc = Bb + 2 * 64 * 16;
    LAS float* Kc = (LAS float*)(Cc + 2 * 16 * 64);
    if (tid < 128) {
        const int d = tid >> 6, pp = tid & 63, gi = d * 32 + g;
        const double are = (double)p.a_re[gi * 64 + pp], aim = (double)p.a_im[gi * 64 + pp];
        const double dt = (double)expf(p.log_dt[gi]);
        const double er = exp(are * dt); double sn, cs; sincos_d(aim * dt, sn, cs);
        const double lr = er * cs, li = er * sn;
        double pr = 1.0, pi_ = 0.0;
        for (int k = 0; k <= 32; ++k) {
            lamk[(d * 64 + pp) * 33 + k] = (f32x2){(float)pr, (float)pi_};
            const double nr_ = pr * lr - pi_ * li, ni_ = pr * li + pi_ * lr; pr = nr_; pi_ = ni_;
        }
        if (qtr == 0) { const f32x2 l32 = lamk[(d * 64 + pp) * 33 + 32]; *(f32x2*)(p.lamT() + (size_t)(gi * 64 + pp) * 2) = l32; }
        const double nr = lr - 1.0, ni = li, den = are * are + aim * aim;
        const double qr = (nr * are + ni * aim) / den, qi = (ni * are - nr * aim) / den;
        f32x4 brv[4], biv[4];
#pragma unroll
        for (int q = 0; q < 4; ++q) { brv[q] = *(const f32x4*)(p.b_re + ((size_t)gi * 64 + pp) * 16 + 4 * q); biv[q] = *(const f32x4*)(p.b_im + ((size_t)gi * 64 + pp) * 16 + 4 * q); }
#pragma unroll
        for (int h = 0; h < 16; ++h) {
            const double br = (double)brv[h >> 2][h & 3], bi = (double)biv[h >> 2][h & 3];
            Bb[(d * 64 + pp) * 16 + h] = (f32x2){(float)(qr * br - qi * bi), (float)(qr * bi + qi * br)};
        }
    }
    for (int e = tid; e < 2 * 16 * 64; e += NT) {
        const int d = e >> 10, h = (e >> 6) & 15, pp = e & 63; const size_t src = ((size_t)(d * 32 + g) * 16 + h) * 64 + pp;
        Cc[e] = (f32x2){p.c_re[src], p.c_im[src]};
    }
    __syncthreads();
    {
        const int wv = __builtin_amdgcn_readfirstlane(tid >> 6), lane = tid & 63, lm = lane & 15, kq = lane >> 4, d = wv >> 2;
        bf16x8 bop[4];
#pragma unroll
        for (int ks = 0; ks < 4; ++ks) {
            u32x4 w;
#pragma unroll
            for (int j = 0; j < 4; ++j) { const f32x2 bb = Bb[(d * 64 + ks * 16 + kq * 4 + j) * 16 + lm]; w[j] = pk2(bb[0], bb[1]); }
            bop[ks] = __builtin_bit_cast(bf16x8, w);
        }
#pragma unroll 1
        for (int k = (wv & 3) * 8; k < (wv & 3) * 8 + 8; ++k) {
            f32x4 acc = {0.f, 0.f, 0.f, 0.f};
#pragma unroll
            for (int ks = 0; ks < 4; ++ks) {
                u32x4 w;
#pragma unroll
                for (int j = 0; j < 4; ++j) {
                    const int pp = ks * 16 + kq * 4 + j;
                    const f32x2 c = Cc[(d * 16 + lm) * 64 + pp], l = lamk[(d * 64 + pp) * 33 + k];
                    w[j] = pk2(c[0] * l[0] - c[1] * l[1], -(c[0] * l[1] + c[1] * l[0]));
                }
                acc = __builtin_amdgcn_mfma_f32_16x16x32_bf16(__builtin_bit_cast(bf16x8, w), bop[ks], acc, 0, 0, 0);
            }
#pragma unroll
            for (int r = 0; r < 4; ++r) Kc[((d * 32 + k) * 16 + kq * 4 + r) * 16 + lm] = acc[r];
        }
    }
    __syncthreads();
    for (int ch = tid; ch < 128 * 96; ch += NT) {
        const int mrow = 128 * qtr + ch / 96, k0 = (ch % 96) * 8, ii = mrow >> 4, h = mrow & 15;
        float v[8];
        if (k0 < 512) {
            const int jj = k0 >> 4, h20 = k0 & 15;
#pragma unroll
            for (int i = 0; i < 8; ++i) {
                const int h2 = h20 + i; float val = 0.f;
                if (ii >= jj) val += Kc[((0 * 32 + (ii - jj)) * 16 + h) * 16 + h2];
                if (jj >= ii) val += Kc[((1 * 32 + (jj - ii)) * 16 + h) * 16 + h2];
                if (ii == jj && h == h2) val += p.ssm_d[g * 16 + h];
                v[i] = val;
            }
        } else {
            const int sc = k0 - 512, d = sc >> 7, ri = (sc >> 6) & 1, p0 = sc & 63, e = d == 0 ? ii + 1 : 32 - ii;
#pragma unroll
            for (int i = 0; i < 8; ++i) {
                const int pp = p0 + i; const f32x2 c = Cc[(d * 16 + h) * 64 + pp], l = lamk[(d * 64 + pp) * 33 + e];
                const float clr = c[0] * l[0] - c[1] * l[1], cli = c[0] * l[1] + c[1] * l[0];
                v[i] = ri == 0 ? clr : -cli;
            }
        }
        u32x4 o; o.x = pg8::cvt_pk_bf16(v[0], v[1]); o.y = pg8::cvt_pk_bf16(v[2], v[3]); o.z = pg8::cvt_pk_bf16(v[4], v[5]); o.w = pg8::cvt_pk_bf16(v[6], v[7]);
        *(u32x4*)(p.Kmat() + ((size_t)(g * 512 + mrow) * SSM_LD + k0)) = o;
    }
    for (int ch = tid; ch < 64 * 64; ch += NT) {
        const int nrow = 64 * qtr + ch / 64, k0 = (ch % 64) * 8, d = nrow >> 7, ri = (nrow >> 6) & 1, pp = nrow & 63;
        const int jj = k0 >> 4, h20 = k0 & 15, e = d == 0 ? 31 - jj : jj;
        const f32x2 l = lamk[(d * 64 + pp) * 33 + e];
        float v[8];
#pragma unroll
        for (int i = 0; i < 8; ++i) { const f32x2 b = Bb[(d * 64 + pp) * 16 + h20 + i]; v[i] = ri == 0 ? (l[0] * b[0] - l[1] * b[1]) : (l[0] * b[1] + l[1] * b[0]); }
        u32x4 o; o.x = pg8::cvt_pk_bf16(v[0], v[1]); o.y = pg8::cvt_pk_bf16(v[2], v[3]); o.z = pg8::cvt_pk_bf16(v[4], v[5]); o.w = pg8::cvt_pk_bf16(v[6], v[7]);
        *(u32x4*)(p.Win() + ((size_t)(g * 256 + nrow) * 512 + k0)) = o;
    }
    __syncthreads();
}
__device__ __forceinline__ void ph_carry(const P& p) {
    int tid = threadIdx.x; asm volatile("" : "+v"(tid));
    if (tid >= 128) return;
    for (int gidx = blockIdx.x * 128 + tid; gidx < 32 * 8 * 2 * 64; gidx += gridDim.x * 128) {
        const int pp = gidx & 63, d = (gidx >> 6) & 1, b = (gidx >> 7) & 7, g = gidx >> 10;
        const f32x2 lt = *(const f32x2*)(p.lamT() + (size_t)((d * 32 + g) * 64 + pp) * 2);
        const float* Eg = p.E() + (size_t)g * SSM_ROWS * 256 + d * 128 + pp;
        bf16_t* Ug = p.U() + (size_t)g * SSM_ROWS * SSM_LD + 512 + d * 128 + pp;
        float fr = 0.f, fi = 0.f;
#pragma unroll
        for (int cc = 0; cc < 8; ++cc) {
            const int n = 1024 + b * 8 + (d == 0 ? cc : 7 - cc);
            const float er = Eg[(size_t)n * 256], ei = Eg[(size_t)n * 256 + 64];
            const float nr = lt[0] * fr - lt[1] * fi + er, ni = lt[0] * fi + lt[1] * fr + ei; fr = nr; fi = ni;
        }
#pragma unroll 8
        for (int c = 0; c < 128; ++c) {
            const int n = b * 128 + (d == 0 ? c : 127 - c);
            const float er = Eg[(size_t)n * 256], ei = Eg[(size_t)n * 256 + 64];
            Ug[(size_t)n * SSM_LD] = (bf16_t)f2bf(fr); Ug[(size_t)n * SSM_LD + 64] = (bf16_t)f2bf(fi);
            const float nr = lt[0] * fr - lt[1] * fi + er, ni = lt[0] * fi + lt[1] * fr + ei; fr = nr; fi = ni;
        }
    }
}


__device__ __forceinline__ void p0_transpose_item(const float* W, int K, int N, bf16_t* WT, LAS float* scr, int item, int lane) {
    const int nblk = N / 32, kb = item / nblk, nb = item % nblk, k0 = 64 * kb, n0 = 32 * nb;
#pragma unroll 8
    for (int i = 0; i < 32; ++i) { const int kk = 2 * i + (lane >> 5); scr[kk * 33 + (lane & 31)] = W[(size_t)(k0 + kk) * N + n0 + (lane & 31)]; }
    asm volatile("s_waitcnt lgkmcnt(0)" ::: "memory");
    const int c = lane & 7;
#pragma unroll
    for (int j = 0; j < 4; ++j) { const int n = (lane >> 3) + 8 * j; const LAS float* s = scr + (8 * c) * 33 + n;
        u32x4 o; o.x = pk2(s[0 * 33], s[1 * 33]); o.y = pk2(s[2 * 33], s[3 * 33]); o.z = pk2(s[4 * 33], s[5 * 33]); o.w = pk2(s[6 * 33], s[7 * 33]);
        *(u32x4*)(WT + (size_t)(n0 + n) * K + k0 + 8 * c) = o; }
    asm volatile("s_waitcnt lgkmcnt(0)" ::: "memory");
}

template <int NR, bool SILU>
__device__ __forceinline__ void gemv_block64(const float* const (&rows)[NR], const float* W, int ldw, int col0, const float* bias, float* y, int ldy, LAS float* scr) {
    const int wave = threadIdx.x >> 6, lane = threadIdx.x & 63;
    LAS float* act = scr + 8 * NR * 64;
#pragma unroll
    for (int r = 0; r < NR; ++r) for (int k = threadIdx.x; k < DM; k += NT) { const float s = rows[r][k]; act[r * DM + k] = SILU ? siluf_(s) : s; }
    __syncthreads();
    float acc[NR];
#pragma unroll
    for (int r = 0; r < NR; ++r) acc[r] = 0.f;
    const int kb = wave * 128;
#pragma unroll 32
    for (int k = kb; k < kb + 128; ++k) {
        const float w = W[(size_t)k * ldw + col0 + lane];
#pragma unroll
        for (int r = 0; r < NR; ++r) acc[r] += act[r * DM + k] * w;
    }
#pragma unroll
    for (int r = 0; r < NR; ++r) scr[(wave * NR + r) * 64 + lane] = acc[r];
    __syncthreads();
    for (int e = threadIdx.x; e < NR * 64; e += NT) {
        const int r = e >> 6, l = e & 63; float s = 0.f;
#pragma unroll
        for (int w = 0; w < 8; ++w) s += scr[(w * NR + r) * 64 + l];
        y[(size_t)r * ldy + col0 + l] = s + (bias ? bias[col0 + l] : 0.f);
    }
    __syncthreads();
}

__device__ __forceinline__ void ph_prep(const P& p, LAS unsigned char* lds) {
    int tid_ = threadIdx.x; asm volatile("" : "+v"(tid_));
    const int wave = tid_ >> 6, lane = tid_ & 63, G = gridDim.x;
    for (int cb = blockIdx.x; cb < 96; cb += G) {
        const float* const rows[9] = {p.c, p.c + DM, p.c + 2 * DM, p.c + 3 * DM, p.c + 4 * DM, p.c + 5 * DM, p.c + 6 * DM, p.c + 7 * DM, p.c_ctx};
        gemv_block64<9, true>(rows, p.w_mod, 6 * DM, cb * 64, p.b_mod, p.mod(), 6 * DM, (LAS float*)lds);
    }
    {
        LAS float* scr = (LAS float*)(lds + wave * 16384);
        const int gw = blockIdx.x * NWAVES + wave, NGW = G * NWAVES;
        constexpr int I_IN = (DM / 64) * (INC / 32), I_GLU = (512 / 64) * (512 / 32), I_A = (512 / 64) * (DM / 32), I_OUT = (DM / 64) * (DM / 32), I_Q = (DM / 64) * (2048 / 32);
        constexpr int NITEMS = I_IN + I_GLU + 2 * I_A + I_OUT + I_Q;
        for (int it = gw; it < NITEMS; it += NGW) {
            int r = it;
            if (r < I_IN) { p0_transpose_item(p.w_in, DM, INC, p.w_in_t(), scr, r, lane); continue; } r -= I_IN;
            if (r < I_GLU) { p0_transpose_item(p.w_glu, 512, 512, p.w_glu_t(), scr, r, lane); continue; } r -= I_GLU;
            if (r < I_A) { p0_transpose_item(p.w_a, 512, DM, p.w_a_t(), scr, r, lane); continue; } r -= I_A;
            if (r < I_A) { p0_transpose_item(p.w_b, 512, DM, p.w_b_t(), scr, r, lane); continue; } r -= I_A;
            if (r < I_OUT) { p0_transpose_item(p.w_out, DM, DM, p.w_out_t(), scr, r, lane); continue; } r -= I_OUT;
            p0_transpose_item(p.w_q, DM, 2048, p.w_q_t(), scr, r, lane);
        }
    }
}

template <int CTRL> __device__ __forceinline__ int dpp_i(int v) { return __builtin_amdgcn_update_dpp(0, v, CTRL, 0xf, 0xf, true); }
template <int CTRL> __device__ __forceinline__ float dpp_f(float v) { return __builtin_bit_cast(float, __builtin_amdgcn_update_dpp(0, __builtin_bit_cast(int, v), CTRL, 0xf, 0xf, true)); }
constexpr int DPP_XOR1 = 0xB1, DPP_XOR2 = 0x4E, DPP_HMIRROR = 0x141, DPP_ROR8 = 0x128;
constexpr float I8_MAGIC = 12582912.f;
__device__ __forceinline__ unsigned pack4_i8(float t0, float t1, float t2, float t3) {
    const unsigned p01 = __builtin_amdgcn_perm(__builtin_bit_cast(unsigned, t1), __builtin_bit_cast(unsigned, t0), 0x0c0c0400u);
    const unsigned p23 = __builtin_amdgcn_perm(__builtin_bit_cast(unsigned, t3), __builtin_bit_cast(unsigned, t2), 0x0c0c0400u);
    return __builtin_amdgcn_perm(p23, p01, 0x05040100u);
}
__device__ __forceinline__ void bg_convert_tables(const P& p) {
    int tid_ = threadIdx.x; asm volatile("" : "+v"(tid_));
    const int lane = tid_ & 63;
    unsigned* head = p.queues() + 16 * 64;
    for (;;) {
        unsigned v = 0u; if (lane == 0) v = __hip_atomic_fetch_add(head, 32u, __ATOMIC_RELAXED, __HIP_MEMORY_SCOPE_AGENT);
        const int rg = (int)__builtin_amdgcn_readfirstlane(v);
        if (rg >= 2 * 16384) break;
#pragma unroll 1
      for (int r0 = rg; r0 < rg + 32; r0 += 4) {
        const bool second = r0 >= 16384; const int rr0 = second ? r0 - 16384 : r0;
        const float* src = (second ? p.peer_v : p.peer_u) + (size_t)rr0 * DM + lane * 16;
        unsigned char* dst = (second ? p.pv8() : p.pu8()) + (size_t)(lane >> 3) * (16384 * 128) + (size_t)rr0 * 128 + (lane & 7) * 16;
        f32x4 v4[4][4];
#pragma unroll
        for (int q = 0; q < 4; ++q)
#pragma unroll
            for (int j = 0; j < 4; ++j) v4[q][j] = *(const f32x4*)(src + q * DM + 4 * j);
        float inv = 1.f;
#pragma unroll
        for (int q = 0; q < 4; ++q) {
            float am = 0.f;
#pragma unroll
            for (int j = 0; j < 4; ++j) am = fmaxf(am, fmaxf(fmaxf(fabsf(v4[q][j][0]), fabsf(v4[q][j][1])), fmaxf(fabsf(v4[q][j][2]), fabsf(v4[q][j][3]))));
            am = wave_max(am);
            const float top = 6.f;
            const float sc = am > 0.f ? top / am : 1.f;
            if (second) {
                u32x2 o2;
#pragma unroll
                for (int jj = 0; jj < 2; ++jj) {
                    unsigned w = 0u;
                    w = __builtin_amdgcn_cvt_scalef32_pk_fp4_f32(w, v4[q][jj * 2][0] * sc, v4[q][jj * 2][1] * sc, 1.0f, 0);
                    w = __builtin_amdgcn_cvt_scalef32_pk_fp4_f32(w, v4[q][jj * 2][2] * sc, v4[q][jj * 2][3] * sc, 1.0f, 1);
                    w = __builtin_amdgcn_cvt_scalef32_pk_fp4_f32(w, v4[q][jj * 2 + 1][0] * sc, v4[q][jj * 2 + 1][1] * sc, 1.0f, 2);
                    w = __builtin_amdgcn_cvt_scalef32_pk_fp4_f32(w, v4[q][jj * 2 + 1][2] * sc, v4[q][jj * 2 + 1][3] * sc, 1.0f, 3);
                    o2[jj] = w;
                }
                *(u32x2*)(p.pv8() + (size_t)(lane >> 4) * (16384 * 128) + (size_t)(rr0 + q) * 128 + (lane & 15) * 8) = o2;
                inv = lane == q ? (am > 0.f ? am / top : 1.f) : inv;
            } else {
                float a16 = 0.f;
#pragma unroll
                for (int j = 0; j < 4; ++j) a16 = fmaxf(a16, fmaxf(fmaxf(fabsf(v4[q][j][0]), fabsf(v4[q][j][1])), fmaxf(fabsf(v4[q][j][2]), fabsf(v4[q][j][3]))));
                a16 = fmaxf(a16, dpp_f<DPP_XOR1>(a16)); a16 = fmaxf(a16, dpp_f<DPP_XOR2>(a16)); a16 = fmaxf(a16, dpp_f<DPP_HMIRROR>(a16)); a16 = fmaxf(a16, dpp_f<DPP_ROR8>(a16));
                const float s4 = a16 > 0.f ? 7.f / a16 : 1.f;
                u32x2 o2;
#pragma unroll
                for (int jj = 0; jj < 2; ++jj) {
                    unsigned w = 0u;
#pragma unroll
                    for (int k = 0; k < 8; ++k) { const float t = v4[q][jj * 2 + (k >> 2)][k & 3] * s4 + I8_MAGIC; w |= (__builtin_bit_cast(unsigned, t) & 15u) << (4 * k); }
                    o2[jj] = w;
                }
                *(u32x2*)(p.pu8() + (size_t)(lane >> 4) * (16384 * 128) + (size_t)(rr0 + q) * 128 + (lane & 15) * 8) = o2;
                if ((lane & 15) == 0) p.pisc_u()[(size_t)(rr0 + q) * 4 + (lane >> 4)] = a16 > 0.f ? a16 * (1.f / 7.f) : 1.f;
            }
        }
        if (second && lane < 4) p.pisc()[r0 + lane] = inv;
      }
    }
}

__device__ __forceinline__ void normmod_row_bf16(const float* src, bf16_t* dst, const float* g, const float* shift, const float* scale, int lane) {
    const f32x4* s = (const f32x4*)src;
    f32x4 v[4]; float ss = 0.f;
#pragma unroll
    for (int j = 0; j < 4; ++j) { v[j] = s[lane + 64 * j]; ss += v[j][0] * v[j][0] + v[j][1] * v[j][1] + v[j][2] * v[j][2] + v[j][3] * v[j][3]; }
    ss = wave_sum(ss);
    const float rstd = rsqrtf(ss * (1.f / DM) + EPSN);
#pragma unroll
    for (int j = 0; j < 4; ++j) {
        const int i4 = lane + 64 * j;
        const f32x4 gg = ((const f32x4*)g)[i4], sh = ((const f32x4*)shift)[i4], sc = ((const f32x4*)scale)[i4];
        const f32x4 o = v[j] * rstd * gg * (sc + 1.f) + sh;
        u32x2 w; w.x = pk2(o[0], o[1]); w.y = pk2(o[2], o[3]);
        *(u32x2*)(dst + (size_t)i4 * 4) = w;
    }
}
__device__ __forceinline__ void ph_norm1(const P& p, LAS unsigned char* lds) {
    int tid_ = threadIdx.x; asm volatile("" : "+v"(tid_));
    const int wave = tid_ >> 6, lane = tid_ & 63, G = gridDim.x;
    const int gw = blockIdx.x * NWAVES + __builtin_amdgcn_readfirstlane(wave), NGW = G * NWAVES;
    for (int r4 = gw; r4 < NTOK / 4; r4 += NGW) {
        const int r = r4 * 4;
        const f32x4* s = (const f32x4*)(p.x + (size_t)r * DM);
        f32x4 v[4][4];
#pragma unroll
        for (int k = 0; k < 4; ++k)
#pragma unroll
            for (int j = 0; j < 4; ++j) v[k][j] = s[k * (DM / 4) + lane + 64 * j];
        const float* modb = p.mod() + (size_t)(r >> 12) * (6 * DM);
#pragma unroll
        for (int k = 0; k < 4; ++k) {
            float ss = 0.f;
#pragma unroll
            for (int j = 0; j < 4; ++j) ss += v[k][j][0] * v[k][j][0] + v[k][j][1] * v[k][j][1] + v[k][j][2] * v[k][j][2] + v[k][j][3] * v[k][j][3];
            ss = wave_sum(ss);
            const float rstd = rsqrtf(ss * (1.f / DM) + EPSN);
            bf16_t* dst = p.hx() + (size_t)(r + k) * DM;
#pragma unroll
            for (int j = 0; j < 4; ++j) {
                const int i4 = lane + 64 * j;
                const f32x4 gg = ((const f32x4*)p.norm1_g)[i4], sh = ((const f32x4*)modb)[i4], sc = ((const f32x4*)(modb + DM))[i4];
                const f32x4 o = v[k][j] * rstd * gg * (sc + 1.f) + sh;
                u32x2 w; w.x = pk2(o[0], o[1]); w.y = pk2(o[2], o[3]);
                *(u32x2*)(dst + (size_t)i4 * 4) = w;
            }
        }
    }
    for (int rc = gw; rc < NCTX; rc += NGW) { const float* modc = p.mod() + 8 * (6 * DM); normmod_row_bf16(p.ctx + (size_t)rc * DM, p.hc() + (size_t)rc * DM, p.norm1_g, modc, modc + DM, lane); }
}

constexpr int RPB_LD = 128, RPB_PAD = 48;
__device__ __forceinline__ void ph_na(const P& p, LAS unsigned char* lds) {
    int tid_ = threadIdx.x; asm volatile("" : "+v"(tid_));
    const int tid = tid_, h = __builtin_amdgcn_readfirstlane(tid >> 6), lane = tid & 63, lt = lane & 15, lq = lane >> 4;
    constexpr float LOG2E = 1.4426950408889634f, CS = 0.125f * LOG2E;
    LAS float* rp = (LAS float*)lds;
    for (int e = tid; e < 8 * 15 * RPB_LD; e += NT) { const int c = (e & (RPB_LD - 1)) - RPB_PAD; rp[e] = (c >= 0 && c < 31) ? p.rpb[(e / RPB_LD) * 31 + c] * LOG2E : 0.f; }
    __syncthreads();
    const int pa = (lt >> 2) * 8 + (lt & 3);
    const unsigned lane_k = pa * 512 + lq * 8, lane_v = lt * 64 + lq * 8, lane_q = lt * 512 + lq * 8, lane_o = lt * 512 + lq * 4;
    for (int item = blockIdx.x; item < NB * GW; item += gridDim.x) {
        const int b = item >> 6, r = item & 63;
        int r0 = r - 4; r0 = r0 < 0 ? 0 : (r0 > 56 ? 56 : r0);
        const bf16_t* Kb = p.kb() + ((size_t)b * SEQL + (size_t)r0 * GW) * 512 + h * 64;
        const bf16_t* Kc = p.kc() + ((size_t)b * CTXL) * 512 + h * 64;
        const bf16_t* Vt = p.vT() + ((size_t)((b * 8 + h) * 64 + r0)) * 4096;
        const bf16_t* Vc = p.vcT() + ((size_t)((b * 8 + h) * 4)) * 4096;
        const bf16_t* Qb = p.qb() + ((size_t)b * SEQL + r * GW) * 512 + h * 64;
        bf16_t* Ob = p.na() + ((size_t)b * SEQL + r * GW) * 512 + h * 64;
        const LAS float* rph = rp + (h * 15 + (r0 - r + 7)) * RPB_LD;
        bf16x8 qf[4][2];
#pragma unroll
        for (int qt = 0; qt < 4; ++qt) { qf[qt][0] = *(const bf16x8*)(Qb + qt * 16 * 512 + lane_q); qf[qt][1] = *(const bf16x8*)(Qb + qt * 16 * 512 + 32 + lane_q); }
        f32x4 o[4][4]; float m[4], l[4];
#pragma unroll
        for (int qt = 0; qt < 4; ++qt) { m[qt] = -1e30f; l[qt] = 0.f;
#pragma unroll
            for (int d = 0; d < 4; ++d) o[qt][d] = (f32x4){0.f, 0.f, 0.f, 0.f}; }
        bf16x8 kf[2][2][2];
#pragma unroll
        for (int st = 0; st < 2; ++st)
#pragma unroll
            for (int ab = 0; ab < 2; ++ab) { kf[st][ab][0] = *(const bf16x8*)(Kb + (st * 32 + ab * 4) * 512 + lane_k); kf[st][ab][1] = *(const bf16x8*)(Kb + (st * 32 + ab * 4) * 512 + 32 + lane_k); }
#pragma unroll 1
        for (int i = 0; i < 8; ++i) {
            bf16x8 vf[2][4];
#pragma unroll
            for (int st = 0; st < 2; ++st)
#pragma unroll
                for (int d = 0; d < 4; ++d) vf[st][d] = *(const bf16x8*)(Vt + i * 4096 + d * 1024 + st * 32 + lane_v);
            const LAS float* rr_ = rph + i * RPB_LD;
#pragma unroll
            for (int half = 0; half < 2; ++half) {
                f32x4 s[2][2][2];
#pragma unroll
                for (int q2 = 0; q2 < 2; ++q2) {
                    const int qt = half * 2 + q2;
#pragma unroll
                    for (int st = 0; st < 2; ++st) {
                        if ((st == 0 && qt == 3) || (st == 1 && qt == 0)) continue;
#pragma unroll
                        for (int ab = 0; ab < 2; ++ab) {
                            f32x4 c = {0.f, 0.f, 0.f, 0.f};
                            c = __builtin_amdgcn_mfma_f32_16x16x32_bf16(kf[st][ab][0], qf[qt][0], c, 0, 0, 0);
                            c = __builtin_amdgcn_mfma_f32_16x16x32_bf16(kf[st][ab][1], qf[qt][1], c, 0, 0, 0);
                            s[q2][st][ab] = c;
                        }
                    }
                }
                if (half == 1) {
                    if (i < 7) {
#pragma unroll
                        for (int st = 0; st < 2; ++st)
#pragma unroll
                            for (int ab = 0; ab < 2; ++ab) { const bf16_t* kp = Kb + ((i + 1) * GW + st * 32 + ab * 4) * 512; kf[st][ab][0] = *(const bf16x8*)(kp + lane_k); kf[st][ab][1] = *(const bf16x8*)(kp + 32 + lane_k); }
                    } else {
#pragma unroll
                        for (int ab = 0; ab < 2; ++ab) { kf[0][ab][0] = *(const bf16x8*)(Kc + ab * 4 * 512 + lane_k); kf[0][ab][1] = *(const bf16x8*)(Kc + ab * 4 * 512 + 32 + lane_k); }
                    }
                }
#pragma unroll
                for (int q2 = 0; q2 < 2; ++q2) {
                    const int qt = half * 2 + q2;
                    const int qc = qt * 16 + lt; int c0 = qc - 8; c0 = c0 < 0 ? 0 : (c0 > 48 ? 48 : c0);
                    int wo = lq * 8 - c0; asm volatile("" : "+v"(wo));
                    float mx = -1e30f;
#pragma unroll
                    for (int st = 0; st < 2; ++st) {
                        if ((st == 0 && qt == 3) || (st == 1 && qt == 0)) continue;
                        const int kc0 = st * 32 + lq * 8, bbase = kc0 - qc + 15 + RPB_PAD;
#pragma unroll
                        for (int j = 0; j < 8; ++j) {
                            float t = s[q2][st][j >> 2][j & 3] * CS + rr_[bbase + j];
                            t = ((unsigned)(wo + st * 32 + j) < 16u) ? t : -1e30f;
                            s[q2][st][j >> 2][j & 3] = t; mx = fmaxf(mx, t);
                        }
                    }
                    mx = fmaxf(mx, __shfl_xor(mx, 16)); mx = fmaxf(mx, __shfl_xor(mx, 32));
                    const float mn = fmaxf(m[qt], mx), corr = __builtin_amdgcn_exp2f(m[qt] - mn);
                    m[qt] = mn; float ls = l[qt] * corr;
#pragma unroll
                    for (int d = 0; d < 4; ++d) o[qt][d] = o[qt][d] * corr;
#pragma unroll
                    for (int st = 0; st < 2; ++st) {
                        if ((st == 0 && qt == 3) || (st == 1 && qt == 0)) continue;
                        float pe[8];
#pragma unroll
                        for (int j = 0; j < 8; ++j) pe[j] = __builtin_amdgcn_exp2f(s[q2][st][j >> 2][j & 3] - mn);
                        ls += ((pe[0] + pe[1]) + (pe[2] + pe[3])) + ((pe[4] + pe[5]) + (pe[6] + pe[7]));
                        u32x4 pw; pw[0] = pg8::cvt_pk_bf16(pe[0], pe[1]); pw[1] = pg8::cvt_pk_bf16(pe[2], pe[3]); pw[2] = pg8::cvt_pk_bf16(pe[4], pe[5]); pw[3] = pg8::cvt_pk_bf16(pe[6], pe[7]);
                        const bf16x8 pf = __builtin_bit_cast(bf16x8, pw);
#pragma unroll
                        for (int d = 0; d < 4; ++d) o[qt][d] = __builtin_amdgcn_mfma_f32_16x16x32_bf16(vf[st][d], pf, o[qt][d], 0, 0, 0);
                    }
                    l[qt] = ls;
                }
            }
        }
#pragma unroll 1
        for (int cst = 0; cst < 8; ++cst) {
            bf16x8 vf[4];
#pragma unroll
            for (int d = 0; d < 4; ++d) vf[d] = *(const bf16x8*)(Vc + (cst >> 1) * 4096 + d * 1024 + (cst & 1) * 32 + lane_v);
            f32x4 s[4][2];
#pragma unroll
            for (int qt = 0; qt < 4; ++qt)
#pragma unroll
                for (int ab = 0; ab < 2; ++ab) {
                    f32x4 c = {0.f, 0.f, 0.f, 0.f};
                    c = __builtin_amdgcn_mfma_f32_16x16x32_bf16(kf[0][ab][0], qf[qt][0], c, 0, 0, 0);
                    c = __builtin_amdgcn_mfma_f32_16x16x32_bf16(kf[0][ab][1], qf[qt][1], c, 0, 0, 0);
                    s[qt][ab] = c;
                }
            if (cst < 7) {
#pragma unroll
                for (int ab = 0; ab < 2; ++ab) { const bf16_t* kp = Kc + ((cst + 1) * 32 + ab * 4) * 512; kf[0][ab][0] = *(const bf16x8*)(kp + lane_k); kf[0][ab][1] = *(const bf16x8*)(kp + 32 + lane_k); }
            }
#pragma unroll
            for (int qt = 0; qt < 4; ++qt) {
                float mx = -1e30f;
#pragma unroll
                for (int j = 0; j < 8; ++j) { const float t = s[qt][j >> 2][j & 3] * CS; s[qt][j >> 2][j & 3] = t; mx = fmaxf(mx, t); }
                mx = fmaxf(mx, __shfl_xor(mx, 16)); mx = fmaxf(mx, __shfl_xor(mx, 32));
                const float mn = fmaxf(m[qt], mx), corr = __builtin_amdgcn_exp2f(m[qt] - mn);
                m[qt] = mn;
#pragma unroll
                for (int d = 0; d < 4; ++d) o[qt][d] = o[qt][d] * corr;
                float pe[8];
#pragma unroll
                for (int j = 0; j < 8; ++j) pe[j] = __builtin_amdgcn_exp2f(s[qt][j >> 2][j & 3] - mn);
                l[qt] = l[qt] * corr + (((pe[0] + pe[1]) + (pe[2] + pe[3])) + ((pe[4] + pe[5]) + (pe[6] + pe[7])));
                u32x4 pw; pw[0] = pg8::cvt_pk_bf16(pe[0], pe[1]); pw[1] = pg8::cvt_pk_bf16(pe[2], pe[3]); pw[2] = pg8::cvt_pk_bf16(pe[4], pe[5]); pw[3] = pg8::cvt_pk_bf16(pe[6], pe[7]);
                const bf16x8 pf = __builtin_bit_cast(bf16x8, pw);
#pragma unroll
                for (int d = 0; d < 4; ++d) o[qt][d] = __builtin_amdgcn_mfma_f32_16x16x32_bf16(vf[d], pf, o[qt][d], 0, 0, 0);
            }
        }
#pragma unroll
        for (int qt = 0; qt < 4; ++qt) {
            float lv = l[qt]; lv += __shfl_xor(lv, 16); lv += __shfl_xor(lv, 32);
            const float inv = frcp(lv);
            bf16_t* op = Ob + qt * 16 * 512 + lane_o;
#pragma unroll
            for (int d = 0; d < 4; ++d) { u32x2 w; w[0] = pg8::cvt_pk_bf16(o[qt][d][0] * inv, o[qt][d][1] * inv); w[1] = pg8::cvt_pk_bf16(o[qt][d][2] * inv, o[qt][d][3] * inv); *(u32x2*)(op + d * 16) = w; }
        }
    }
}

typedef __bf16 bf16x2_t __attribute__((ext_vector_type(2)));
__device__ __forceinline__ float dot2bf(unsigned a, unsigned b, float c) { return __builtin_amdgcn_fdot2_f32_bf16(__builtin_bit_cast(bf16x2_t, a), __builtin_bit_cast(bf16x2_t, b), c, false); }
__device__ __forceinline__ unsigned ordkey(float f) { unsigned u = __builtin_bit_cast(unsigned, f); return u ^ ((unsigned)((int)u >> 31) | 0x80000000u); }
__device__ __forceinline__ float unordkey(unsigned k) { return __builtin_bit_cast(float, k ^ ((k & 0x80000000u) ? 0x80000000u : 0xFFFFFFFFu)); }
__device__ __forceinline__ float kmax(float a, float b) { float r; asm("v_max_f32 %0, %1, %2" : "=v"(r) : "v"(a), "v"(b)); return r; }
__device__ __forceinline__ float kmin(float a, float b) { float r; asm("v_min_f32 %0, %1, %2" : "=v"(r) : "v"(a), "v"(b)); return r; }
template <bool DESC> __device__ __forceinline__ void cex(float& a, float& b) { const float mx = kmax(a, b), mn = kmin(a, b); if (DESC) { a = mx; b = mn; } else { a = mn; b = mx; } }
__device__ __forceinline__ void sort16_desc(float (&a)[16]) {
#pragma unroll
    for (int k = 2; k <= 16; k <<= 1)
#pragma unroll
        for (int j = k >> 1; j > 0; j >>= 1)
#pragma unroll
            for (int i = 0; i < 16; ++i) { const int l = i ^ j; if (l > i) { if ((i & k) == 0) cex<true>(a[i], a[l]); else cex<false>(a[i], a[l]); } }
}
__device__ __forceinline__ void merge16_desc(float (&a)[16]) {
#pragma unroll
    for (int j = 8; j > 0; j >>= 1)
#pragma unroll
        for (int i = 0; i < 16; ++i) { const int l = i ^ j; if (l > i) cex<true>(a[i], a[l]); }
}
__device__ __forceinline__ void top16_merge(float (&a)[16], const float (&b)[16]) {
#pragma unroll
    for (int i = 0; i < 16; ++i) a[i] = kmax(a[i], b[15 - i]);
    merge16_desc(a);
}
__device__ __forceinline__ unsigned kbits(float k) { return __builtin_bit_cast(unsigned, k); }
__device__ __forceinline__ float kscore(float k) { return __builtin_bit_cast(float, __builtin_bit_cast(unsigned, k) & ~127u); }
struct PairTab { int i[52], j[52], n; };
constexpr PairTab make_pairs() { PairTab t{}; int n = 0; for (int i = 0; i < 16; ++i) for (int j = 0; j < 16; ++j) if ((i + 1) * (j + 1) <= 16) { t.i[n] = i; t.j[n] = j; ++n; } t.n = n; for (int k = n; k < 52; ++k) { t.i[k] = 0; t.j[k] = 0; } return t; }
constexpr PairTab PAIRS = make_pairs();
static_assert(PAIRS.n == 50, "50 candidate pairs");

constexpr int SK_LD = 136;
__device__ __forceinline__ void ph_peer_topk(const P& p, LAS unsigned char* lds) {
    int tid_ = threadIdx.x; asm volatile("" : "+v"(tid_));
    const int tid = tid_, wave = tid >> 6, lane = tid & 63;
    LAS bf16_t* sk = (LAS bf16_t*)lds;
    for (int e = tid; e < 2 * 128 * 16; e += NT) {
        const int row = e >> 4, c8 = (e & 15) * 8;
        const f32x4 a = *(const f32x4*)(p.subkeys + (size_t)row * 128 + c8), b = *(const f32x4*)(p.subkeys + (size_t)row * 128 + c8 + 4);
        u32x4 o; o.x = pk2(a[0], a[1]); o.y = pk2(a[2], a[3]); o.z = pk2(b[0], b[1]); o.w = pk2(b[2], b[3]);
        *(LAS u32x4*)(sk + row * SK_LD + c8) = o;
    }
    __syncthreads();
    const int lt = lane & 15, lq = lane >> 4;
    for (int tile = blockIdx.x * NWAVES + wave; tile < NTOK / 16; tile += gridDim.x * NWAVES) {
        const int tok = tile * 16 + lt;
        const bf16_t* qrow = p.qp() + (size_t)tok * 2048;
        for (int h = 0; h < 8; ++h) {
            float s0[16], s1[16];
#pragma unroll
            for (int n = 0; n < 2; ++n) {
                bf16x8 bq[4];
#pragma unroll
                for (int ks = 0; ks < 4; ++ks) bq[ks] = *(const bf16x8*)(qrow + h * 256 + n * 128 + ks * 32 + lq * 8);
                float a[16], b[16];
#pragma unroll
                for (int kb = 0; kb < 8; ++kb) {
                    f32x4 c = {0.f, 0.f, 0.f, 0.f};
#pragma unroll
                    for (int ks = 0; ks < 4; ++ks) {
                        const bf16x8 ak = *(const LAS bf16x8*)(sk + (n * 128 + kb * 16 + lt) * SK_LD + ks * 32 + lq * 8);
                        c = __builtin_amdgcn_mfma_f32_16x16x32_bf16(ak, bq[ks], c, 0, 0, 0);
                    }
#pragma unroll
                    for (int r = 0; r < 4; ++r) {
                        const float cr = c[r];
                        const float key = __builtin_bit_cast(float, (__builtin_bit_cast(unsigned, cr) & ~127u) | (unsigned)(kb * 16 + lq * 4 + r));
                        if (kb < 4) a[kb * 4 + r] = key; else b[(kb - 4) * 4 + r] = key;
                    }
                    asm volatile("" ::: "memory");
                }
                sort16_desc(a); sort16_desc(b);
                top16_merge(a, b);
#pragma unroll
                for (int i = 0; i < 16; ++i) b[i] = __shfl_xor(a[i], 16);
                top16_merge(a, b);
#pragma unroll
                for (int i = 0; i < 16; ++i) b[i] = __shfl_xor(a[i], 32);
                top16_merge(a, b);
                if (n == 0) {
#pragma unroll
                    for (int i = 0; i < 16; ++i) s0[i] = a[i];
                } else {
#pragma unroll
                    for (int i = 0; i < 16; ++i) s1[i] = a[i];
                }
            }
            float ck[16], cs[13]; unsigned ce_[13];
#pragma unroll
            for (int s = 0; s < 13; ++s) {
                const float k0 = lq == 0 ? s0[PAIRS.i[s * 4]] : (lq == 1 ? s0[PAIRS.i[s * 4 + 1]] : (lq == 2 ? s0[PAIRS.i[s * 4 + 2]] : s0[PAIRS.i[s * 4 + 3]]));
                const float k1 = lq == 0 ? s1[PAIRS.j[s * 4]] : (lq == 1 ? s1[PAIRS.j[s * 4 + 1]] : (lq == 2 ? s1[PAIRS.j[s * 4 + 2]] : s1[PAIRS.j[s * 4 + 3]]));
                const float sum = kscore(k0) + kscore(k1);
                const bool valid = (s * 4 + lq) < PAIRS.n;
                cs[s] = sum; ce_[s] = (kbits(k0) & 127u) * 128u + (kbits(k1) & 127u);
                ck[s] = valid ? __builtin_bit_cast(float, (__builtin_bit_cast(unsigned, sum) & ~63u) | (unsigned)(s * 4 + lq)) : -__builtin_inff();
            }
            ck[13] = -__builtin_inff(); ck[14] = -__builtin_inff(); ck[15] = -__builtin_inff();
            float srt[16], ob[16];
#pragma unroll
            for (int i = 0; i < 16; ++i) srt[i] = ck[i];
            sort16_desc(srt);
#pragma unroll
            for (int i = 0; i < 16; ++i) ob[i] = __shfl_xor(srt[i], 16);
            top16_merge(srt, ob);
#pragma unroll
            for (int i = 0; i < 16; ++i) ob[i] = __shfl_xor(srt[i], 32);
            float thr = __builtin_inff();
#pragma unroll
            for (int i = 0; i < 16; ++i) thr = kmin(thr, kmax(srt[i], ob[15 - i]));
            const float mtop = kscore(s0[0]) + kscore(s1[0]);
            float zp = 0.f; int cnt = 0;
#pragma unroll
            for (int s = 0; s < 13; ++s) { const bool sel = ck[s] >= thr; const float e = sel ? __expf(cs[s] - mtop) : 0.f; cs[s] = e; zp += e; cnt += sel ? 1 : 0; }
            float z = zp; z += __shfl_xor(z, 16); z += __shfl_xor(z, 32);
            const float rz = frcp(z);
            const int c0 = __shfl(cnt, lt), c1 = __shfl(cnt, lt + 16), c2 = __shfl(cnt, lt + 32);
            int pos = lq == 0 ? 0 : (lq == 1 ? c0 : (lq == 2 ? c0 + c1 : c0 + c1 + c2));
            unsigned short* dste = (unsigned short*)p.topk() + ((size_t)tok * 8 + h) * 16; float* dstg = p.gates() + ((size_t)tok * 8 + h) * 16;
#pragma unroll
            for (int s = 0; s < 13; ++s) {
                const bool sel = ck[s] >= thr;
                if (sel) { dste[pos] = (unsigned short)ce_[s]; dstg[pos] = cs[s] * rz; ++pos; }
            }
        }
    }
}

__device__ __forceinline__ unsigned xcc_id() { return (unsigned)__builtin_amdgcn_s_getreg((3 << 11) | 20) & 7u; }
__device__ __forceinline__ int q_grab(unsigned* head, int lane) { unsigned v = 0u; if (lane == 0) v = __hip_atomic_fetch_add(head, 16u, __ATOMIC_RELAXED, __HIP_MEMORY_SCOPE_AGENT); return (int)__builtin_amdgcn_readfirstlane(v); }

__device__ __forceinline__ void g_ids(const unsigned short* tkrow, unsigned lo_g16, u32x4 (&ids)[2]) {
#pragma unroll
    for (int q = 0; q < 2; ++q) ids[q] = *(const u32x4*)(tkrow + lo_g16 + q * 8);
}
__device__ __forceinline__ void g_wts(const float* wrow, unsigned lo_g16, u32x4 (&wts)[4]) {
#pragma unroll
    for (int q = 0; q < 4; ++q) wts[q] = *(const u32x4*)(wrow + lo_g16 + q * 4);
}
__device__ __forceinline__ void g_rows8(const unsigned char* tb, unsigned lo_c16, const u32x4& idh, u32x4 (&rows)[8]) {
#pragma unroll
    for (int i = 0; i < 8; ++i) {
        const unsigned w = idh[i >> 1];
        unsigned off; const unsigned k128 = 128u;
        if (i & 1) asm("v_mad_u32_u16 %0, %1, %2, %3 op_sel:[1,0,0,0]" : "=v"(off) : "v"(w), "s"(k128), "v"(lo_c16));
        else asm("v_mad_u32_u16 %0, %1, %2, %3" : "=v"(off) : "v"(w), "s"(k128), "v"(lo_c16));
        rows[i] = *(const u32x4*)(tb + off);
    }
}
typedef _Float16 f16x2 __attribute__((ext_vector_type(2)));
__device__ __forceinline__ void g_dots8_i4(const u32x4 (&uu)[8], const unsigned (&hqh)[4], const unsigned (&hql)[4], int* pd) {
#pragma unroll
    for (int i = 0; i < 8; ++i) {
        int dh = 0, dl = 0;
#pragma unroll
        for (int j = 0; j < 4; ++j) { dh = __builtin_amdgcn_sdot8((int)uu[i][j], (int)hqh[j], dh, false); dl = __builtin_amdgcn_sdot8((int)uu[i][j], (int)hql[j], dl, false); }
        pd[i] = dh * 16 + dl;
    }
}
__device__ __forceinline__ void halve16_c8(const int (&v)[16], int b4, int b2, int b1, int& o0, int& o1) {
    int r8[8], r4[4];
#pragma unroll
    for (int i = 0; i < 8; ++i) { const int keep = b4 ? v[i + 8] : v[i], send = b4 ? v[i] : v[i + 8]; r8[i] = keep + dpp_i<DPP_HMIRROR>(send); }
#pragma unroll
    for (int i = 0; i < 4; ++i) { const int keep = b2 ? r8[i + 4] : r8[i], send = b2 ? r8[i] : r8[i + 4]; r4[i] = keep + dpp_i<DPP_XOR2>(send); }
    { const int keep = b1 ? r4[2] : r4[0], send = b1 ? r4[0] : r4[2]; o0 = keep + dpp_i<DPP_XOR1>(send); }
    { const int keep = b1 ? r4[3] : r4[1], send = b1 ? r4[1] : r4[3]; o1 = keep + dpp_i<DPP_XOR1>(send); }
}
template <bool FIRST>
__device__ __forceinline__ void g_acc8q(const u32x4 (&vv)[8], const u32x4& w0, const u32x4& w1, f16x2 (&acc)[16]) {
#pragma unroll
    for (int i = 0; i < 8; ++i) {
        const unsigned wu = i < 4 ? w0[i & 3] : w1[i & 3];
        const f16x2 w = __builtin_bit_cast(f16x2, wu);
#pragma unroll
        for (int j = 0; j < 4; ++j) {
            const unsigned wv = vv[i][j];
            const f16x2 v0 = __builtin_bit_cast(f16x2, __builtin_amdgcn_cvt_scalef32_pk_f16_fp4(wv, 0.00390625f, 0)), v1 = __builtin_bit_cast(f16x2, __builtin_amdgcn_cvt_scalef32_pk_f16_fp4(wv, 0.00390625f, 1));
            const f16x2 v2 = __builtin_bit_cast(f16x2, __builtin_amdgcn_cvt_scalef32_pk_f16_fp4(wv, 0.00390625f, 2)), v3 = __builtin_bit_cast(f16x2, __builtin_amdgcn_cvt_scalef32_pk_f16_fp4(wv, 0.00390625f, 3));
            if (FIRST && i == 0) { acc[j * 4 + 0] = v0 * w; acc[j * 4 + 1] = v1 * w; acc[j * 4 + 2] = v2 * w; acc[j * 4 + 3] = v3 * w; }
            else { acc[j * 4 + 0] = __builtin_elementwise_fma(v0, w, acc[j * 4 + 0]); acc[j * 4 + 1] = __builtin_elementwise_fma(v1, w, acc[j * 4 + 1]);
                   acc[j * 4 + 2] = __builtin_elementwise_fma(v2, w, acc[j * 4 + 2]); acc[j * 4 + 3] = __builtin_elementwise_fma(v3, w, acc[j * 4 + 3]); }
        }
    }
}
__device__ __forceinline__ void halve16h(const f16x2 (&v)[16], int b1, f16x2& o0, f16x2& o1) {
    f16x2 r8[8], r4[4];
#pragma unroll
    for (int i = 0; i < 8; ++i) { const u32x2 sw = __builtin_amdgcn_permlane32_swap(__builtin_bit_cast(unsigned, v[i]), __builtin_bit_cast(unsigned, v[i + 8]), false, false);
        const unsigned s0 = sw[0], s1 = sw[1];
        r8[i] = __builtin_bit_cast(f16x2, s0) + __builtin_bit_cast(f16x2, s1); }
#pragma unroll
    for (int i = 0; i < 4; ++i) { const u32x2 sw = __builtin_amdgcn_permlane16_swap(__builtin_bit_cast(unsigned, r8[i]), __builtin_bit_cast(unsigned, r8[i + 4]), false, false);
        const unsigned s0 = sw[0], s1 = sw[1];
        r4[i] = __builtin_bit_cast(f16x2, s0) + __builtin_bit_cast(f16x2, s1); }
#pragma unroll
    for (int i = 0; i < 2; ++i) {
        const unsigned keep = __builtin_bit_cast(unsigned, b1 ? r4[i + 2] : r4[i]), send = __builtin_bit_cast(unsigned, b1 ? r4[i] : r4[i + 2]);
        const f16x2 r = __builtin_bit_cast(f16x2, keep) + __builtin_bit_cast(f16x2, (unsigned)__builtin_amdgcn_update_dpp(0, (int)send, 0x128, 0xf, 0xf, true));
        if (i == 0) o0 = r; else o1 = r;
    }
}

template <int WHICH>
__device__ __forceinline__ void ph_gather_sliced(const P& p, LAS unsigned char* lds) {
    int tid_ = threadIdx.x; asm volatile("" : "+v"(tid_));
    const int lane = tid_ & 63, c = lane & 7, g = lane >> 3;
    LAS unsigned char* wlds = lds + __builtin_amdgcn_readfirstlane(tid_ >> 6) * 8192;
    const unsigned xs = xcc_id();
    constexpr int NSL = 4, SLW = DM / NSL;
    for (unsigned tr = 0; tr < NSL; ++tr) {
        const int sl = (int)((xs + tr) & (unsigned)(NSL - 1));
        unsigned* head = p.queues() + (WHICH * 8 + sl) * 64;
        const unsigned char* tb = (WHICH == 0 ? p.pu8() : p.pv8()) + (size_t)sl * (16384 * 128);
        for (;;) {
            const int t0 = q_grab(head, lane);
            if (t0 >= NTOK) break;
            unsigned oc = c * 16, og = g * 16; asm volatile("" : "+v"(oc), "+v"(og));
            const unsigned short* idb = (const unsigned short*)p.topk() + (size_t)t0 * 128;
            const float* wb = p.wl() + (size_t)t0 * 128;
            const float* modb = p.mod() + (size_t)(t0 >> 12) * (6 * DM) + sl * SLW;
            u32x4 idc[2], idn[2], RA[8], RB[8], wc[4];
            g_ids(idb, og, idc); if (WHICH == 1) g_wts(wb, og, wc);
            g_rows8(tb, oc, idc[0], RA);
            if (WHICH == 0) {
                {
                    unsigned l4 = lane * 4; asm volatile("" : "+v"(l4));
                    const bf16_t* xg = p.x1b() + (size_t)t0 * DM + sl * SLW;
                    f32x4 A, Bs;
                    { const f32x4 gg = *(const f32x4*)(p.norm2_g + sl * SLW + l4), sh = *(const f32x4*)(modb + 3 * DM + l4), sc = *(const f32x4*)(modb + 4 * DM + l4);
#pragma unroll
                      for (int i = 0; i < 4; ++i) { A[i] = gg[i] * (1.f + sc[i]); Bs[i] = sh[i]; } }
                    const float rsl = rstd_from_fix(p.rowss()[t0 + (lane & 15)]);
                    {
                        u32x2 xw[16];
#pragma unroll
                        for (int k = 0; k < 16; ++k) xw[k] = *(const u32x2*)(xg + (size_t)k * DM + l4);
#pragma unroll
                        for (int k = 0; k < 16; ++k) {
                            const int tk = k;
                            const float rstd = __builtin_bit_cast(float, __builtin_amdgcn_readlane(__builtin_bit_cast(unsigned, rsl), tk));
                            float h[4], am = 0.f;
                            const unsigned x01 = xw[k][0], x23 = xw[k][1];
                            const float xf[4] = {bflo(x01), bfhi(x01), bflo(x23), bfhi(x23)};
#pragma unroll
                            for (int i = 0; i < 4; ++i) { h[i] = xf[i] * rstd * A[i] + Bs[i]; am = fmaxf(am, fabsf(h[i])); }
                            am = fmaxf(am, dpp_f<DPP_XOR1>(am)); am = fmaxf(am, dpp_f<DPP_XOR2>(am)); am = fmaxf(am, dpp_f<DPP_HMIRROR>(am)); am = fmaxf(am, dpp_f<DPP_ROR8>(am));
                            { const u32x2 sw = __builtin_amdgcn_permlane16_swap(__builtin_bit_cast(unsigned, am), __builtin_bit_cast(unsigned, am), false, false); const unsigned s0 = sw[0], s1 = sw[1];
                              am = fmaxf(__builtin_bit_cast(float, s0), __builtin_bit_cast(float, s1)); }
                            { const u32x2 sw = __builtin_amdgcn_permlane32_swap(__builtin_bit_cast(unsigned, am), __builtin_bit_cast(unsigned, am), false, false); const unsigned s0 = sw[0], s1 = sw[1];
                              am = fmaxf(__builtin_bit_cast(float, s0), __builtin_bit_cast(float, s1)); }
                            am = fmaxf(am, 1e-30f);
                            const float hs = 119.f * frcp(am);
                            unsigned whi = 0u, wlo = 0u;
#pragma unroll
                            for (int i = 0; i < 4; ++i) {
                                const unsigned qb = __builtin_bit_cast(unsigned, h[i] * hs + I8_MAGIC);
                                wlo |= (qb & 15u) << (4 * i);
                                whi |= (((qb + 8u) >> 4) & 15u) << (4 * i);
                            }
                            *(LAS unsigned short*)(wlds + tk * 256 + lane * 2) = (unsigned short)whi;
                            *(LAS unsigned short*)(wlds + tk * 256 + 128 + lane * 2) = (unsigned short)wlo;
                            *(LAS float*)(wlds + 4096 + tk * 4) = am * (1.f / 119.f);
                        }
                    }
                    asm volatile("s_waitcnt lgkmcnt(0)" ::: "memory");
                }
                const unsigned lo_st = og + 2 * (c & 1) + 4 * ((c >> 1) & 1) + 8 * ((c >> 2) & 1);
                float* apb = p.apart() + ((size_t)sl * NTOK + t0) * 128;
#define G1_TOKEN(tt, IDC, IDN, MORE) do { \
                    g_rows8(tb, oc, IDC[1], RB); \
                    if (MORE) g_ids(idb + ((tt) + 1) * 128, og, IDN); \
                    const u32x4 hh4 = *(const LAS u32x4*)(wlds + (tt) * 256 + oc), hl4 = *(const LAS u32x4*)(wlds + (tt) * 256 + 128 + oc); \
                    const float hinv = *(const LAS float*)(wlds + 4096 + (tt) * 4); \
                    const unsigned hqh[4] = {hh4[0], hh4[1], hh4[2], hh4[3]}, hql[4] = {hl4[0], hl4[1], hl4[2], hl4[3]}; \
                    int pd[16]; \
                    g_dots8_i4(RA, hqh, hql, pd); \
                    if (MORE) g_rows8(tb, oc, IDN[0], RA); \
                    g_dots8_i4(RB, hqh, hql, pd + 8); \
                    int o0, o1; halve16_c8(pd, c & 4, c & 2, c & 1, o0, o1); \
                    f32x2 st; st[0] = (float)o0 * hinv; st[1] = (float)o1 * hinv; \
                    *(f32x2*)(apb + (tt) * 128 + lo_st) = st; } while (0)
#pragma unroll 1
                for (int tt = 0; tt < 16; tt += 2) {
                    G1_TOKEN(tt, idc, idn, true);
                    const bool more = tt + 2 < 16;
                    G1_TOKEN(tt + 1, idn, idc, more);
                }
#undef G1_TOKEN
            } else {
                const unsigned lo_col = 2 * oc + 4 * (g & 1) + 8 * ((g >> 1) & 1) + 16 * ((g >> 2) & 1);
                bf16_t* xb = p.x1b() + (size_t)t0 * DM + sl * SLW;
                const f32x4 g2 = *(const f32x4*)(modb + 5 * DM + lo_col);
                u32x2 x1n = *(const u32x2*)(xb + lo_col);
                u32x4 wd[4];
#define G2_TOKEN(tt, IDC, IDN, WC, WN, MORE) do { \
                    g_rows8(tb, oc, IDC[1], RB); \
                    const unsigned x01 = x1n[0], x23 = x1n[1]; \
                    if (MORE) { g_ids(idb + ((tt) + 1) * 128, og, IDN); g_wts(wb + ((tt) + 1) * 128, og, WN); x1n = *(const u32x2*)(xb + (size_t)((tt) + 1) * DM + lo_col); } \
                    f16x2 acc[16]; \
                    g_acc8q<true>(RA, WC[0], WC[1], acc); \
                    if (MORE) g_rows8(tb, oc, IDN[0], RA); \
                    g_acc8q<false>(RB, WC[2], WC[3], acc); \
                    f16x2 oa, ob; halve16h(acc, g & 1, oa, ob); \
                    u32x2 x2; x2[0] = pg8::cvt_pk_bf16(bflo(x01) + g2[0] * (float)oa[0], bfhi(x01) + g2[1] * (float)oa[1]); x2[1] = pg8::cvt_pk_bf16(bflo(x23) + g2[2] * (float)ob[0], bfhi(x23) + g2[3] * (float)ob[1]); \
                    *(u32x2*)(xb + (size_t)(tt) * DM + lo_col) = x2; } while (0)
#pragma unroll 1
                for (int tt = 0; tt < 16; tt += 2) {
                    G2_TOKEN(tt, idc, idn, wc, wd, true);
                    const bool more = tt + 2 < 16;
                    G2_TOKEN(tt + 1, idn, idc, wd, wc, more);
                }
#undef G2_TOKEN
            }
        }
    }
}
__device__ __forceinline__ void ph_gather_weights(const P& p) {
    int tid_ = threadIdx.x; asm volatile("" : "+v"(tid_));
    const size_t gsz = (size_t)gridDim.x * NT;
    const float* isc = p.pisc();
    for (size_t i = (size_t)blockIdx.x * NT + tid_; i < (size_t)NTOK * 128; i += gsz) {
        const unsigned e = ((const unsigned short*)p.topk())[i]; const float gate = p.gates()[i];
        const f32x4 su = *(const f32x4*)(p.pisc_u() + (size_t)e * 4);
        float a = 0.f;
#pragma unroll
        for (int sl = 0; sl < 4; ++sl) a += p.apart()[(size_t)sl * NTOK * 128 + i] * su[sl];
        const float w = gate * isc[16384 + e] * gelu_tanh(a) * 256.f;
        const unsigned short hw = __builtin_bit_cast(unsigned short, (_Float16)w);
        ((unsigned*)p.wl())[i] = (unsigned)hw | ((unsigned)hw << 16);
    }
}
__device__ __forceinline__ void ph_final_norm(const P& p) {
    int tid_ = threadIdx.x; asm volatile("" : "+v"(tid_));
    const int wave = __builtin_amdgcn_readfirstlane(tid_ >> 6), lane = tid_ & 63;
    for (int t4 = blockIdx.x * NWAVES + wave; t4 < NTOK / 4; t4 += gridDim.x * NWAVES) {
        const u32x4* src = (const u32x4*)(p.x1b() + (size_t)t4 * 4 * DM);
        f32x4* row = (f32x4*)(p.out + (size_t)t4 * 4 * DM);
        u32x4 vw[4][2];
#pragma unroll
        for (int k = 0; k < 4; ++k)
#pragma unroll
            for (int j = 0; j < 2; ++j) vw[k][j] = src[k * (DM / 8) + lane + 64 * j];
#pragma unroll
        for (int k = 0; k < 4; ++k) {
            f32x4 v[4]; float ss = 0.f;
#pragma unroll
            for (int j = 0; j < 2; ++j) {
                const unsigned w0 = vw[k][j][0], w1 = vw[k][j][1], w2 = vw[k][j][2], w3 = vw[k][j][3];
                v[j * 2] = (f32x4){bflo(w0), bfhi(w0), bflo(w1), bfhi(w1)}; v[j * 2 + 1] = (f32x4){bflo(w2), bfhi(w2), bflo(w3), bfhi(w3)};
            }
#pragma unroll
            for (int j = 0; j < 4; ++j) ss += v[j][0] * v[j][0] + v[j][1] * v[j][1] + v[j][2] * v[j][2] + v[j][3] * v[j][3];
            ss = wave_sum(ss);
            const float rstd = rsqrtf(ss * (1.f / DM) + EPSN);
#pragma unroll
            for (int j = 0; j < 4; ++j) { const int i4 = (lane + 64 * (j >> 1)) * 2 + (j & 1); const f32x4 fg = ((const f32x4*)p.final_g)[i4]; row[k * (DM / 4) + i4] = v[j] * rstd * fg; }
        }
    }
}

#define XB_TMO      128
#define XB_XCNT(j)  (256  + 64 * (j))
#define XB_XSUB(j)  (1280 + 64 * (j))
#define XB_XGEN(j)  (2304 + 64 * (j))
#define XB_TOP      3328
#define XB_TOPGEN   3392
#define XCD_BAR_WORDS 3456
#define XB_SPIN_CAP (1u << 18)
__device__ __forceinline__ unsigned xb_ld(unsigned* p)              { return __hip_atomic_load(p, __ATOMIC_RELAXED, __HIP_MEMORY_SCOPE_AGENT); }
__device__ __forceinline__ unsigned xb_add(unsigned* p, unsigned v) { return __hip_atomic_fetch_add(p, v, __ATOMIC_RELAXED, __HIP_MEMORY_SCOPE_AGENT); }
__device__ __forceinline__ unsigned xb_xcc_id() { return (unsigned)__builtin_amdgcn_s_getreg((3 << 11) | 20) & 0xFu; }
#define XB_SPIN(cond, bar) do { unsigned _sp = 0; while (cond) { __builtin_amdgcn_s_sleep(1); \
    if ((++_sp & 255u) == 0u) { if (xb_ld(&(bar)[XB_TMO])) break; if (_sp > XB_SPIN_CAP) { atomicAdd(&(bar)[XB_TMO], 1u); break; } } } } while (0)
struct XcdBarrier { unsigned* bar; unsigned x; volatile LAS unsigned* st; };
__device__ __forceinline__ XcdBarrier xcd_barrier_post(unsigned* bar, volatile LAS unsigned* st) {
    XcdBarrier b; b.bar = bar; b.x = xb_xcc_id(); b.st = st;
    if (threadIdx.x == 0) (void)xb_add(&bar[XB_XCNT(b.x)], 1u);
    return b;
}
__device__ __forceinline__ void xcd_barrier_complete(unsigned* bar, unsigned x, unsigned& nloc, unsigned& nx) {
    const unsigned G = gridDim.x * gridDim.y * gridDim.z;
    unsigned sum, cnt, mine, sp = 0u;
    for (;;) {
        sum = 0u; cnt = 0u; mine = 0u;
#pragma unroll
        for (unsigned j = 0; j < 16; ++j) { const unsigned c = xb_ld(&bar[XB_XCNT(j)]); sum += c; cnt += (c > 0u) ? 1u : 0u; mine = (j == x) ? c : mine; }
        if (sum == G) break;
        __builtin_amdgcn_s_sleep(1);
        if ((++sp & 255u) == 0u) { if (xb_ld(&bar[XB_TMO])) break; if (sp > XB_SPIN_CAP) { atomicAdd(&bar[XB_TMO], 1u); break; } }
    }
    nloc = mine > 0u ? mine : 1u; nx = cnt > 0u ? cnt : 1u;
}
__device__ __forceinline__ void xcd_barrier(const XcdBarrier& b) {
    asm volatile("s_waitcnt vmcnt(0)" ::: "memory");
    __syncthreads();
    if (threadIdx.x == 0) {
        unsigned* bar = b.bar;
        __builtin_amdgcn_s_waitcnt(0);
        unsigned nloc = b.st[0], nx = b.st[1];
        if (nloc == 0u) { xcd_barrier_complete(bar, b.x, nloc, nx); b.st[0] = nloc; b.st[1] = nx; }
        const unsigned old = xb_add(&bar[XB_XSUB(b.x)], 1u);
        const unsigned gen = old / nloc;
        if (old + 1u == (gen + 1u) * nloc) {
            __builtin_amdgcn_fence(__ATOMIC_RELEASE, "agent");
            asm volatile("s_waitcnt vmcnt(0)" ::: "memory");
            const unsigned og = xb_add(&bar[XB_TOP], 1u);
            const unsigned tg = og / nx;
            if (og + 1u == (tg + 1u) * nx) xb_add(&bar[XB_TOPGEN], 1u);
            else XB_SPIN(xb_ld(&bar[XB_TOPGEN]) == tg, bar);
            __builtin_amdgcn_fence(__ATOMIC_ACQUIRE, "agent");
            xb_add(&bar[XB_XGEN(b.x)], 1u);
            asm volatile("s_waitcnt vmcnt(0)" ::: "memory");
        } else {
            XB_SPIN(xb_ld(&bar[XB_XGEN(b.x)]) == gen, bar);
            __builtin_amdgcn_fence(__ATOMIC_ACQUIRE, "agent");
            asm volatile("s_waitcnt vmcnt(0)" ::: "memory");
        }
    }
    __syncthreads();
}

constexpr int LDS_BYTES = 147456;
#define GSYNC() xcd_barrier(xbar)
constexpr int MISC_OFF = LDS_BYTES - 64;

__global__ void __launch_bounds__(NT, 2) mega(P p) {
    extern __shared__ __attribute__((aligned(16))) unsigned char lds_raw[];
    LAS unsigned char* lds = (LAS unsigned char*)lds_raw;
    const int G = gridDim.x, bx = blockIdx.x;
    using namespace pg8;
    if (threadIdx.x < 16) ((LAS unsigned*)(lds + MISC_OFF))[threadIdx.x] = 0u;
    for (unsigned i = (unsigned)bx * NT + threadIdx.x; i < (1u << 20) / 8u; i += (unsigned)G * NT) ((unsigned long long*)p.ws)[i] = 0ull;
    cg::this_grid().sync();
    const XcdBarrier xbar = xcd_barrier_post((unsigned*)p.ws, (volatile LAS unsigned*)(lds + MISC_OFF));

    ph_prep(p, lds);
    GSYNC();
    ph_norm1(p, lds);
    GSYNC();
    {
        Gemm<DM, DM, DM> g{p.hx(), p.w_in_t()}; StaticOrder<NTOK, INC> S; S.init(G, bx);
        EpiInProj E{p.U(), p.kb(), (size_t)(p.qb() - p.kb()), p.vT(), p.ga(), 0};
        gemm_phase<EpiInProj, StaticOrder<NTOK, INC>, true, true>(lds, g, S, E);
        Gemm<DM, DM, DM> g2{p.hc(), p.w_in_t()}; StaticOrder<NCTX, CTXC> S2; S2.init(G, bx);
        EpiInProj E2{p.U(), p.kc(), 0, p.vcT(), p.ga(), 1};
        gemm_phase<EpiInProj, StaticOrder<NCTX, CTXC>, true, true>(lds, g2, S2, E2);
    }
    for (int it = (bx + G - 48 % G) % G; it < 128; it += G) ssm_prep_item(p, lds, it);
    for (int cb = (bx + G - 176 % G) % G; cb < 32; cb += G) {
        const float* m3 = p.mod() + 3 * DM;
        const float* const rows[8] = {m3, m3 + 6 * DM, m3 + 12 * DM, m3 + 18 * DM, m3 + 24 * DM, m3 + 30 * DM, m3 + 36 * DM, m3 + 42 * DM};
        gemv_block64<8, false>(rows, p.w_q, 2048, cb * 64, nullptr, p.c2(), 2048, (LAS float*)lds);
    }
    bg_convert_tables(p);
    GSYNC();
    {
        Gemm<512, SSM_LD, 512, (long)SSM_ROWS * SSM_LD, 256L * 512> g{p.U(), p.Win()}; StaticOrder<SSM_ROWS, 256, 32> S; S.init(G, bx);
        EpiE E{p.E()};
        gemm_phase<EpiE, StaticOrder<SSM_ROWS, 256, 32>, true, true>(lds, g, S, E);
    }
    GSYNC();
    ph_carry(p);
    ph_na(p, lds);
    GSYNC();
    {
        Gemm<SSM_LD, SSM_LD, SSM_LD, (long)SSM_ROWS * SSM_LD, 512L * SSM_LD> g{p.U(), p.Kmat()}; StaticOrder<1024, 512, 32> S; S.init(G, bx);
        EpiZ E{p.z()};
        gemm_phase<EpiZ, StaticOrder<1024, 512, 32>, true, true>(lds, g, S, E);
    }
    GSYNC();
    {
        Gemm<512, 512, 512> g{p.z(), p.w_glu_t()}; StaticOrder<NTOK, 512> S; S.init(G, bx);
        EpiGlu E{p.gl(), p.z(), p.b_glu};
        gemm_phase<EpiGlu, StaticOrder<NTOK, 512>, true, true>(lds, g, S, E);
    }
    GSYNC();
    {
        Gemm<512, 512, 512, 32L * 1024 * 1024, 512L * 1024> g{p.na(), p.w_b_t()}; PairOrder<NTOK, DM> S; S.init(G, bx);
        EpiMerge E{p.merged(), p.ga(), p.gb()};
        gemm_phase<EpiMerge, PairOrder<NTOK, DM>, true, true>(lds, g, S, E);
    }
    GSYNC();
    {
        Gemm<DM, DM, DM> g{p.merged(), p.w_out_t()}; StaticOrder<NTOK, DM> S; S.init(G, bx);
        EpiOut E{p.x, p.x1b(), p.x1g(), p.mod(), p.norm2_g, p.rowss()};
        gemm_phase<EpiOut, StaticOrder<NTOK, DM>, true, true>(lds, g, S, E);
    }
    GSYNC();
    {
        Gemm<DM, DM, DM> g{p.x1g(), p.w_q_t()}; StaticOrder<NTOK, 2048> S; S.init(G, bx);
        EpiQ E{p.qp(), p.rowss(), p.c2()};
        gemm_phase<EpiQ, StaticOrder<NTOK, 2048>, true, true>(lds, g, S, E);
    }
    GSYNC();
    ph_peer_topk(p, lds);
    GSYNC();
    ph_gather_sliced<0>(p, lds);
    GSYNC();
    ph_gather_weights(p);
    GSYNC();
    ph_gather_sliced<1>(p, lds);
    GSYNC();
    ph_final_norm(p);
}

extern "C" void kernel_launch(void* const* d_in, const int* in_sizes, int n_in, void* d_out, int out_size, void* d_ws, size_t ws_size, hipStream_t stream) {
    static int grid = 0;
    if (grid == 0) {
        int dev = 0, cus = 0, per_cu = 0;
        (void)hipGetDevice(&dev);
        (void)hipDeviceGetAttribute(&cus, hipDeviceAttributeMultiprocessorCount, dev);
        (void)hipFuncSetAttribute((const void*)mega, hipFuncAttributeMaxDynamicSharedMemorySize, LDS_BYTES);
        (void)hipOccupancyMaxActiveBlocksPerMultiprocessor(&per_cu, (const void*)mega, NT, LDS_BYTES);
        if (per_cu < 1) { fprintf(stderr, "occupancy query says %d blocks per CU\n", per_cu); per_cu = 1; }
        grid = cus;
    }
    P p{};
    const float* const* in = (const float* const*)d_in;
    p.x = in[0]; p.c = in[1]; p.ctx = in[2]; p.c_ctx = in[3]; p.w_mod = in[4]; p.b_mod = in[5]; p.norm1_g = in[6]; p.norm2_g = in[7]; p.w_in = in[8];
    p.a_re = in[9]; p.a_im = in[10]; p.log_dt = in[11]; p.b_re = in[12]; p.b_im = in[13]; p.c_re = in[14]; p.c_im = in[15]; p.ssm_d = in[16];
    p.w_glu = in[17]; p.b_glu = in[18]; p.w_a = in[19]; p.w_b = in[20]; p.rpb = in[21]; p.w_out = in[22]; p.w_q = in[23]; p.subkeys = in[24];
    p.peer_u = in[25]; p.peer_v = in[26]; p.final_g = in[27];
    p.out = (float*)d_out;
    p.ws = (unsigned char*)d_ws;
    void* args[] = {&p};
    hipError_t e = hipLaunchCooperativeKernel((const void*)mega, dim3(grid), dim3(NT), args, LDS_BYTES, stream);
    if (e != hipSuccess) fprintf(stderr, "cooperative launch failed: %s (grid %d)\n", hipGetErrorString(e), grid);
}
```

```cpp
#include <hip/hip_runtime.h>
#include <hip/hip_cooperative_groups.h>
#include <cstdio>
#include <cstdint>
namespace cg = cooperative_groups;

#define LAS __attribute__((address_space(3)))
typedef unsigned short bf16_t;
typedef short bf16x8 __attribute__((ext_vector_type(8)));
typedef float f32x4 __attribute__((ext_vector_type(4)));
typedef float f32x2 __attribute__((ext_vector_type(2)));
typedef unsigned u32x4 __attribute__((ext_vector_type(4)));
typedef unsigned u32x2 __attribute__((ext_vector_type(2)));

constexpr int DM = 1024, NB = 8, SEQL = 4096, CTXL = 256, GW = 64, NTOK = NB * SEQL, NCTX = NB * CTXL;
constexpr int INC = 4096, CTXC = 1536;
constexpr int NT = 512, NWAVES = 8;
constexpr float EPSN = 1e-6f;
constexpr int SSM_ROWS = 1280;
constexpr int SSM_LD = 768;

__device__ __forceinline__ unsigned f2bf(float f) { unsigned u = __builtin_bit_cast(unsigned, f); return (u + 0x7fffu + ((u >> 16) & 1u)) >> 16; }
__device__ __forceinline__ unsigned pk2(float lo, float hi) { return f2bf(lo) | (f2bf(hi) << 16); }
__device__ __forceinline__ float bflo(unsigned w) { return __builtin_bit_cast(float, w << 16); }
__device__ __forceinline__ float bfhi(unsigned w) { return __builtin_bit_cast(float, w & 0xffff0000u); }
__device__ __forceinline__ float bf2f(bf16_t h) { return __builtin_bit_cast(float, (unsigned)h << 16); }

__device__ __forceinline__ float wave_sum(float v) {
#pragma unroll
    for (int o = 1; o < 64; o <<= 1) v += __shfl_xor(v, o);
    return v;
}
__device__ __forceinline__ float wave_max(float v) {
#pragma unroll
    for (int o = 1; o < 64; o <<= 1) v = fmaxf(v, __shfl_xor(v, o));
    return v;
}
__device__ __forceinline__ float frcp(float x) { return __builtin_amdgcn_rcpf(x); }
__device__ __forceinline__ float sigmoidf_(float x) { return frcp(1.f + __expf(-x)); }
__device__ __forceinline__ float siluf_(float x) { return x * frcp(1.f + __expf(-x)); }
__device__ __forceinline__ float gelu_tanh(float x) {
    const float k0 = 0.7978845608028654f, k1 = 0.044715f;
    const float u = k0 * (x + k1 * x * x * x);
    const float t = 1.f - 2.f * frcp(1.f + __expf(2.f * u));
    return 0.5f * x * (1.f + t);
}

namespace pg8 {
#define PG8_LAS __attribute__((address_space(3)))
constexpr int BM = 256, BK = 64, HALF = 128, HTB = HALF * BK * 2  , STAGE_BYTES = 8 * HTB, NXCD = 8, WGM = 8;
__host__ __device__ __forceinline__ int lds_byte(int r, int c) { const int st = (r >> 4) * 2 + (c >> 5), rr = r & 15, cc = c & 31, ob = rr * 64 + cc * 2; return st * 1024 + (ob ^ (((ob >> 9) & 1) << 5)); }
__host__ __device__ __forceinline__ void stage_rc(int b, int& R, int& C) { const int st = b / 1024, sb = b % 1024, swz = sb ^ (((sb >> 9) & 1) << 5); R = (st >> 1) * 16 + swz / 64; C = (st & 1) * 32 + (swz % 64) / 2; }
__host__ __device__ __forceinline__ int perm32(int rho) { const int n = rho >> 4, i = rho & 15; return 8 * (i >> 2) + 4 * n + (i & 3); }

struct Unit { int pm, pn, g; };
template <int K_, int LDA, int LDB, long GSA = 0, long GSB = 0, bool FP8_ = false>
struct Gemm {
    const bf16_t* A; const bf16_t* Bt;
    static constexpr int K = K_, lda = LDA, ldb = LDB; static constexpr bool FP8 = FP8_;
    __device__ __forceinline__ const char* abase(const Unit& u) const { return (const char*)(A + (size_t)u.g * GSA + (size_t)u.pm * BM * LDA); }
    __device__ __forceinline__ const char* bbase(const Unit& u) const { return (const char*)(Bt + (size_t)u.g * GSB + (size_t)u.pn * BM * LDB); }
};
template <int M, int N, int NGRP = 1>
struct StaticOrder {
    static constexpr int nM = M / BM, nN = N / BM, nwg = nM * nN;
    int G, c;
    __device__ void init(int G_, int c_) { G = G_; c = c_; }
    __device__ bool next(int i, Unit& u) const {
        const int L = i * G + c; if (L >= nwg * NGRP) return false;
        u.g = L / nwg;
        int wgid = L % nwg; { constexpr int q = nwg / NXCD, r = nwg % NXCD; const int xcd = wgid % NXCD, off = wgid / NXCD; wgid = (xcd < r ? xcd * (q + 1) : r * (q + 1) + (xcd - r) * q) + off; }
        constexpr int nig = WGM * nN; const int gid = wgid / nig, fm = gid * WGM, gsz = (nM - fm) < WGM ? (nM - fm) : WGM;
        u.pm = fm + ((wgid % nig) % gsz); u.pn = (wgid % nig) / gsz; return true;
    }
    __device__ __forceinline__ void a_ready(const Unit&) const {}
    __device__ __forceinline__ void done(const Unit&) const {}
};
__device__ __forceinline__ unsigned cvt_pk_bf16(float lo, float hi) { unsigned r; asm volatile("v_cvt_pk_bf16_f32 %0, %1, %2" : "=v"(r) : "v"(lo), "v"(hi)); return r; }
typedef long i64x2 __attribute__((ext_vector_type(2)));
template <class Epi, class Sched, bool ALIGN_EPI = false, bool SP2 = false, class GemmT>
__device__ __forceinline__ void gemm_phase(PG8_LAS unsigned char* lds, const GemmT g, const Sched& S, const Epi& E) {
    int tid_ = threadIdx.x; asm volatile("" : "+v"(tid_));
    const int tid = tid_, wid = __builtin_amdgcn_readfirstlane(tid >> 6), lane = tid & 63, wr = wid >> 2, wc = wid & 3, fr = lane & 15, fq = lane >> 4;
    const int K = g.K, nt = K / BK;
    unsigned voffA[2], voffB[2];
#pragma unroll
    for (int i = 0; i < 2; ++i) { int R, C; stage_rc(tid * 16 + i * 8192, R, C); const int Rb = Epi::PERM ? ((R & ~31) + perm32(R & 31)) : R;
        voffA[i] = (unsigned)(R * g.lda + C) * 2u; voffB[i] = (unsigned)(Rb * g.ldb + C) * 2u; }
    const size_t kstep = (size_t)(BK * 2);
    const size_t hstepA = (size_t)HALF * g.lda * 2, hstepB = (size_t)HALF * g.ldb * 2;
    const unsigned ldsw = (unsigned)wid * 1024u;
    const int aoff = lds_byte(wr * 64 + fr, fq * 8), boff = lds_byte(wc * 32 + fr, fq * 8);
#define PG8_SA(b, h) (((b) * 2 + (h)) * HTB)
#define PG8_SB(b, h) ((4 + (b) * 2 + (h)) * HTB)
#define PG8_STAGE(bufoff, gbase, voff) do { _Pragma("unroll") for (int _i = 0; _i < 2; ++_i) \
        __builtin_amdgcn_global_load_lds((const unsigned*)((const char*)(gbase) + (voff)[_i]), (PG8_LAS unsigned*)(lds + (bufoff) + ldsw + _i * 8192), 16, 0, 0); } while (0)
#define PG8_LDA(dst, b, h) do { _Pragma("unroll") for (int m = 0; m < 4; ++m) _Pragma("unroll") for (int k = 0; k < 2; ++k) dst[m][k] = *(const PG8_LAS bf16x8*)(lds + PG8_SA(b, h) + aoff + m * 2048 + k * 1024); } while (0)
#define PG8_LDB(dst, b, h) do { _Pragma("unroll") for (int n = 0; n < 2; ++n) _Pragma("unroll") for (int k = 0; k < 2; ++k) dst[n][k] = *(const PG8_LAS bf16x8*)(lds + PG8_SB(b, h) + boff + n * 2048 + k * 1024); } while (0)
#define PG8_MMA(ai, bj, At, Bt) do { __builtin_amdgcn_s_setprio(1); _Pragma("unroll") for (int m = 0; m < 4; ++m) _Pragma("unroll") for (int n = 0; n < 2; ++n) _Pragma("unroll") for (int k = 0; k < 2; ++k) { \
        if constexpr (GemmT::FP8) { const i64x2 b2_ = __builtin_bit_cast(i64x2, Bt[n][k]), a2_ = __builtin_bit_cast(i64x2, At[m][k]); const long bl_ = b2_[0], bh_ = b2_[1], al_ = a2_[0], ah_ = a2_[1]; \
            acc[ai][bj][m][n] = __builtin_amdgcn_mfma_f32_16x16x32_fp8_fp8(bl_, al_, acc[ai][bj][m][n], 0, 0, 0); acc[ai][bj][m][n] = __builtin_amdgcn_mfma_f32_16x16x32_fp8_fp8(bh_, ah_, acc[ai][bj][m][n], 0, 0, 0); } \
        else acc[ai][bj][m][n] = __builtin_amdgcn_mfma_f32_16x16x32_bf16(Bt[n][k], At[m][k], acc[ai][bj][m][n], 0, 0, 0); } __builtin_amdgcn_s_setprio(0); } while (0)
#define PG8_WAIT_V(n) asm volatile("s_waitcnt vmcnt(" #n ")" ::: "memory")
#define PG8_WAIT_L(n) asm volatile("s_waitcnt lgkmcnt(" #n ")" ::: "memory")
#define PG8_BAR __builtin_amdgcn_s_barrier()
#define PG8_SCHED __builtin_amdgcn_sched_barrier(0)
    Unit cur, nxt; int ui = 0;
    if (!S.next(0, cur)) return;
    f32x4 acc[2][2][4][2];
#pragma unroll
    for (int a = 0; a < 2; ++a)
#pragma unroll
        for (int b = 0; b < 2; ++b)
#pragma unroll
            for (int m = 0; m < 4; ++m)
#pragma unroll
                for (int n = 0; n < 2; ++n) acc[a][b][m][n] = (f32x4){0.f, 0.f, 0.f, 0.f};
    bf16x8 At[4][2], B0[2][2], B1[2][2];
    const char* cA = g.abase(cur); const char* cB = g.bbase(cur);
    S.a_ready(cur);
    if constexpr (SP2) {
        PG8_STAGE(PG8_SB(0, 0), cB, voffB); PG8_STAGE(PG8_SB(0, 1), cB + hstepB, voffB); PG8_STAGE(PG8_SA(0, 0), cA, voffA); PG8_STAGE(PG8_SA(0, 1), cA + hstepA, voffA);
        if (wr == 1) PG8_BAR;
        PG8_WAIT_V(2); PG8_BAR;
        PG8_STAGE(PG8_SB(1, 0), cB + kstep, voffB); PG8_STAGE(PG8_SA(1, 0), cA + kstep, voffA); PG8_STAGE(PG8_SB(1, 1), cB + hstepB + kstep, voffB);
        PG8_WAIT_V(6); PG8_BAR;
    } else {
        PG8_STAGE(PG8_SB(0, 0), cB, voffB); PG8_STAGE(PG8_SA(0, 0), cA, voffA); PG8_STAGE(PG8_SB(0, 1), cB + hstepB, voffB); PG8_STAGE(PG8_SA(0, 1), cA + hstepA, voffA);
        if (wr == 1) PG8_BAR;
        PG8_WAIT_V(4); PG8_BAR;
        PG8_STAGE(PG8_SB(1, 0), cB + kstep, voffB); PG8_STAGE(PG8_SA(1, 0), cA + kstep, voffA); PG8_STAGE(PG8_SB(1, 1), cB + hstepB + kstep, voffB);
        PG8_WAIT_V(6); PG8_BAR;
    }
    for (;;) {
        const bool has_next = S.next(ui + 1, nxt);
        const char* nA = has_next ? g.abase(nxt) : cA; const char* nB = has_next ? g.bbase(nxt) : cB;
        for (int t = 0; t < nt; t += 2) {
            const bool last = (t == nt - 2);
            const char* a1 = cA + (size_t)(t + 1) * kstep;
            const char* a2 = last ? nA : cA + (size_t)(t + 2) * kstep; const char* b2 = last ? nB : cB + (size_t)(t + 2) * kstep;
            const char* a3 = a2 + kstep; const char* b3 = b2 + kstep;
            if (last && has_next) S.a_ready(nxt);
            if constexpr (SP2) {
            PG8_LDB(B0, 0, 0); PG8_LDB(B1, 0, 1); PG8_SCHED; PG8_LDA(At, 0, 0); PG8_STAGE(PG8_SA(1, 1), a1 + hstepA, voffA);
            PG8_WAIT_V(8); PG8_WAIT_L(0); PG8_BAR; PG8_MMA(0, 0, At, B0); PG8_MMA(0, 1, At, B1); PG8_BAR; PG8_SCHED;
            PG8_LDA(At, 0, 1); PG8_STAGE(PG8_SB(0, 0), b2, voffB); PG8_STAGE(PG8_SB(0, 1), b2 + hstepB, voffB); PG8_STAGE(PG8_SA(0, 0), a2, voffA);
            PG8_WAIT_V(8); PG8_WAIT_L(0); PG8_BAR; PG8_MMA(1, 0, At, B0); PG8_MMA(1, 1, At, B1); PG8_BAR; PG8_SCHED;
            PG8_LDB(B0, 1, 0); PG8_LDB(B1, 1, 1); PG8_SCHED; PG8_LDA(At, 1, 0); PG8_STAGE(PG8_SA(0, 1), a2 + hstepA, voffA);
            PG8_WAIT_V(8); PG8_WAIT_L(0); PG8_BAR; PG8_MMA(0, 0, At, B0); PG8_MMA(0, 1, At, B1); PG8_BAR; PG8_SCHED;
            PG8_LDA(At, 1, 1); PG8_STAGE(PG8_SB(1, 0), b3, voffB); PG8_STAGE(PG8_SB(1, 1), b3 + hstepB, voffB); PG8_STAGE(PG8_SA(1, 0), a3, voffA);
            PG8_WAIT_V(8); PG8_WAIT_L(0); PG8_BAR; PG8_MMA(1, 0, At, B0); PG8_MMA(1, 1, At, B1); PG8_BAR; PG8_SCHED;
            } else {
            PG8_LDB(B0, 0, 0); PG8_SCHED; PG8_LDA(At, 0, 0); PG8_STAGE(PG8_SA(1, 1), a1 + hstepA, voffA);
            PG8_WAIT_L(8); PG8_BAR; PG8_WAIT_L(0); PG8_MMA(0, 0, At, B0); PG8_BAR; PG8_SCHED;
            PG8_LDB(B1, 0, 1); PG8_STAGE(PG8_SB(0, 0), b2, voffB);
            PG8_BAR; PG8_WAIT_L(0); PG8_MMA(0, 1, At, B1); PG8_BAR;
            PG8_LDA(At, 0, 1); PG8_STAGE(PG8_SA(0, 0), a2, voffA);
            PG8_BAR; PG8_WAIT_L(0); PG8_MMA(1, 0, At, B0); PG8_BAR; PG8_SCHED;
            PG8_STAGE(PG8_SB(0, 1), b2 + hstepB, voffB);
            PG8_WAIT_V(6); PG8_BAR; PG8_MMA(1, 1, At, B1); PG8_BAR;
            PG8_LDB(B0, 1, 0); PG8_SCHED; PG8_LDA(At, 1, 0); PG8_STAGE(PG8_SA(0, 1), a2 + hstepA, voffA);
            PG8_WAIT_L(8); PG8_BAR; PG8_WAIT_L(0); PG8_MMA(0, 0, At, B0); PG8_BAR; PG8_SCHED;
            PG8_LDB(B1, 1, 1); PG8_STAGE(PG8_SB(1, 0), b3, voffB);
            PG8_BAR; PG8_WAIT_L(0); PG8_MMA(0, 1, At, B1); PG8_BAR;
            PG8_LDA(At, 1, 1); PG8_STAGE(PG8_SA(1, 0), a3, voffA);
            PG8_BAR; PG8_WAIT_L(0); PG8_MMA(1, 0, At, B0); PG8_BAR; PG8_SCHED;
            PG8_STAGE(PG8_SB(1, 1), b3 + hstepB, voffB);
            PG8_WAIT_V(6); PG8_BAR; PG8_MMA(1, 1, At, B1); PG8_BAR;
            }
        }
        if constexpr (ALIGN_EPI) { if (wr == 0) PG8_BAR; }
        if constexpr (!Epi::AFTER_DRAIN) { E(acc, cur, wr, wc, fr, fq); S.done(cur); }
        if (!has_next) break;
        if (!E.keep(cur)) {
#pragma unroll
        for (int a = 0; a < 2; ++a)
#pragma unroll
            for (int b = 0; b < 2; ++b)
#pragma unroll
                for (int m = 0; m < 4; ++m)
#pragma unroll
                    for (int n = 0; n < 2; ++n) acc[a][b][m][n] = (f32x4){0.f, 0.f, 0.f, 0.f};
        }
        cur = nxt; cA = nA; cB = nB; ++ui;
        if constexpr (ALIGN_EPI) { if (wr == 1) PG8_BAR; }
    }
    PG8_WAIT_V(0);
    if constexpr (!ALIGN_EPI) { if (wr == 0) PG8_BAR; }
    PG8_BAR;
    if constexpr (Epi::AFTER_DRAIN) { E.fused(acc, cur, wr, wc, fr, fq, lds, wid, lane); S.done(cur); }
#undef PG8_SA
#undef PG8_SB
#undef PG8_STAGE
#undef PG8_LDA
#undef PG8_LDB
#undef PG8_MMA
#undef PG8_WAIT_V
#undef PG8_WAIT_L
#undef PG8_BAR
#undef PG8_SCHED
}
}

constexpr size_t MiB = 1u << 20;
struct P {
    const float *x, *c, *ctx, *c_ctx, *w_mod, *b_mod, *norm1_g, *norm2_g, *w_in;
    const float *a_re, *a_im, *log_dt, *b_re, *b_im, *c_re, *c_im, *ssm_d;
    const float *w_glu, *b_glu, *w_a, *w_b, *rpb, *w_out, *w_q, *subkeys, *peer_u, *peer_v, *final_g;
    float* out;
    unsigned char* ws;
    __device__ __forceinline__ unsigned long long* rowss() const { return (unsigned long long*)(ws + 512 * 1024); }
    __device__ __forceinline__ float* mod() const { return (float*)(ws + 1 * MiB); }
    __device__ __forceinline__ float* c2() const { return (float*)(ws + 1 * MiB + 256 * 1024); }
    __device__ __forceinline__ bf16_t* w_in_t() const { return (bf16_t*)(ws + 3 * MiB); }
    __device__ __forceinline__ bf16_t* w_glu_t() const { return (bf16_t*)(ws + 11 * MiB); }
    __device__ __forceinline__ bf16_t* w_b_t() const { return (bf16_t*)(ws + 12 * MiB); }
    __device__ __forceinline__ bf16_t* w_a_t() const { return (bf16_t*)(ws + 13 * MiB); }
    __device__ __forceinline__ bf16_t* w_out_t() const { return (bf16_t*)(ws + 14 * MiB); }
    __device__ __forceinline__ bf16_t* w_q_t() const { return (bf16_t*)(ws + 16 * MiB); }
    __device__ __forceinline__ bf16_t* Kmat() const { return (bf16_t*)(ws + 21 * MiB); }
    __device__ __forceinline__ bf16_t* Win() const { return (bf16_t*)(ws + 45 * MiB); }
    __device__ __forceinline__ float* lamT() const { return (float*)(ws + 53 * MiB); }
    __device__ __forceinline__ unsigned char* pu8() const { return ws + 54 * MiB; }
    __device__ __forceinline__ unsigned char* pv8() const { return ws + 70 * MiB; }
    __device__ __forceinline__ float* pisc() const { return (float*)(ws + 53 * MiB + 128 * 1024); }
    __device__ __forceinline__ float* pisc_u() const { return (float*)(ws + 53 * MiB + 256 * 1024); }
    __device__ __forceinline__ bf16_t* ga() const { return (bf16_t*)(ws + 118 * MiB); }
    __device__ __forceinline__ bf16_t* gb() const { return (bf16_t*)(ws + 182 * MiB); }
    __device__ __forceinline__ bf16_t* x1g() const { return (bf16_t*)(ws + 118 * MiB); }
    __device__ __forceinline__ unsigned* topk() const { return (unsigned*)(ws + 182 * MiB); }
    __device__ __forceinline__ float* gates() const { return (float*)(ws + 198 * MiB); }
    __device__ __forceinline__ bf16_t* kb() const { return (bf16_t*)(ws + 246 * MiB); }
    __device__ __forceinline__ bf16_t* vT() const { return (bf16_t*)(ws + 278 * MiB); }
    __device__ __forceinline__ bf16_t* qb() const { return (bf16_t*)(ws + 310 * MiB); }
    __device__ __forceinline__ bf16_t* kc() const { return (bf16_t*)(ws + 342 * MiB); }
    __device__ __forceinline__ bf16_t* vcT() const { return (bf16_t*)(ws + 344 * MiB); }
    __device__ __forceinline__ bf16_t* U() const { return (bf16_t*)(ws + 346 * MiB); }
    __device__ __forceinline__ float* E() const { return (float*)(ws + 406 * MiB); }
    __device__ __forceinline__ bf16_t* merged() const { return (bf16_t*)(ws + 246 * MiB); }
    __device__ __forceinline__ bf16_t* qp() const { return (bf16_t*)(ws + 246 * MiB); }
    __device__ __forceinline__ float* apart() const { return (float*)(ws + 246 * MiB); }
    __device__ __forceinline__ float* wl() const { return (float*)(ws + 374 * MiB); }
    __device__ __forceinline__ float* ss2() const { return (float*)(ws + 406 * MiB); }
    __device__ __forceinline__ bf16_t* x1b() const { return (bf16_t*)(ws + 406 * MiB); }
    __device__ __forceinline__ unsigned* queues() const { return (unsigned*)(ws + 64 * 1024); }
    __device__ __forceinline__ bf16_t* hx() const { return (bf16_t*)out; }
    __device__ __forceinline__ bf16_t* hc() const { return (bf16_t*)((unsigned char*)out + 64 * MiB); }
    __device__ __forceinline__ bf16_t* na() const { return (bf16_t*)out; }
    __device__ __forceinline__ bf16_t* z() const { return (bf16_t*)((unsigned char*)out + 32 * MiB); }
    __device__ __forceinline__ bf16_t* gl() const { return (bf16_t*)((unsigned char*)out + 64 * MiB); }
};

constexpr float SS_FIX = 1099511627776.f, SS_UNFIX = 1.f / 1099511627776.f;
__device__ __forceinline__ float rstd_from_fix(unsigned long long v) { return rsqrtf((float)v * (SS_UNFIX / DM) + EPSN); }
constexpr float WIN_SCALE = 32.f;
__device__ __forceinline__ unsigned pk4_fp8(float a, float b, float c, float d) { int w = 0; w = __builtin_amdgcn_cvt_pk_fp8_f32(a, b, w, false); w = __builtin_amdgcn_cvt_pk_fp8_f32(c, d, w, true); return (unsigned)w; }
namespace pg8 {
struct EpiInProj {
    static constexpr bool PERM = true, AFTER_DRAIN = false;
    __device__ __forceinline__ bool keep(const Unit&) const { return false; }
    bf16_t* U; bf16_t* d_kq; size_t kq_stride; bf16_t* d_vT; bf16_t* d_gate; int is_ctx;
    __device__ __forceinline__ void operator()(const f32x4 (&acc)[2][2][4][2], const Unit& u, int wr, int wc, int fr, int fq) const {
        if (u.pn < 2) {
#pragma unroll
            for (int ai = 0; ai < 2; ++ai)
#pragma unroll
                for (int m = 0; m < 4; ++m) {
                    const int row = u.pm * BM + ai * HALF + wr * 64 + m * 16 + fr;
                    const int n = is_ctx ? (1024 + (row >> 8) * 8 + ((row & 255) >> 5)) : ((row >> 12) * 128 + ((row & 4095) >> 5));
                    const int jj = row & 31;
#pragma unroll
                    for (int bj = 0; bj < 2; ++bj) {
                        const int col = u.pn * BM + bj * HALF + wc * 32 + 8 * fq;
                        const f32x4 v0 = acc[ai][bj][m][0] * (1.f / WIN_SCALE), v1 = acc[ai][bj][m][1] * (1.f / WIN_SCALE);
                        u32x4 w; w.x = cvt_pk_bf16(v0[0], v0[1]); w.y = cvt_pk_bf16(v0[2], v0[3]); w.z = cvt_pk_bf16(v1[0], v1[1]); w.w = cvt_pk_bf16(v1[2], v1[3]);
                        *(u32x4*)(U + ((size_t)((col >> 4) * SSM_ROWS + n) * SSM_LD + jj * 16 + (col & 15))) = w;
                    }
                    asm volatile("" ::: "memory");
                }
        } else if (u.pn == 4 || u.pn == 5) {
            const int RB = is_ctx ? (CTXL / 64) : (SEQL / 64);
#pragma unroll
            for (int ai = 0; ai < 2; ++ai)
#pragma unroll
                for (int m = 0; m < 4; ++m) {
                    const int row = u.pm * BM + ai * HALF + wr * 64 + m * 16 + fr;
                    const int b = is_ctx ? (row >> 8) : (row >> 12), t = is_ctx ? (row & 255) : (row & 4095);
#pragma unroll
                    for (int bj = 0; bj < 2; ++bj) {
                        const int col = u.pn * BM + bj * HALF + wc * 32 + 8 * fq - 1024;
                        bf16_t* dst = d_vT + ((size_t)((b * 8 + (col >> 6)) * RB + (t >> 6)) * 4096 + (col & 63) * 64 + (t & 63));
#pragma unroll
                        for (int n = 0; n < 2; ++n)
#pragma unroll
                            for (int i = 0; i < 4; ++i) dst[(n * 4 + i) * 64] = (bf16_t)f2bf(acc[ai][bj][m][n][i] * (1.f / WIN_SCALE));
                    }
                    asm volatile("" ::: "memory");
                }
        } else {
            bf16_t* base; int ld, c0;
            if (u.pn < 8) { const int which = (u.pn - 2) >> 2; base = d_kq + (size_t)which * kq_stride; ld = 512; c0 = 512 + which * 1024; }
            else { const int which = (u.pn - 8) >> 2; base = d_gate + (size_t)which * ((size_t)NTOK * DM); ld = DM; c0 = 2048 + which * 1024; }
#pragma unroll
            for (int ai = 0; ai < 2; ++ai)
#pragma unroll
                for (int m = 0; m < 4; ++m) {
                    const int row = u.pm * BM + ai * HALF + wr * 64 + m * 16 + fr;
#pragma unroll
                    for (int bj = 0; bj < 2; ++bj) {
                        const int col = u.pn * BM + bj * HALF + wc * 32 + 8 * fq - c0;
                        const f32x4 v0 = acc[ai][bj][m][0] * (1.f / WIN_SCALE), v1 = acc[ai][bj][m][1] * (1.f / WIN_SCALE);
                        u32x4 w; w.x = cvt_pk_bf16(v0[0], v0[1]); w.y = cvt_pk_bf16(v0[2], v0[3]); w.z = cvt_pk_bf16(v1[0], v1[1]); w.w = cvt_pk_bf16(v1[2], v1[3]);
                        *(u32x4*)(base + (size_t)row * ld + col) = w;
                    }
                    asm volatile("" ::: "memory");
                }
        }
    }
};
struct EpiGlu {
    static constexpr bool PERM = true, AFTER_DRAIN = false;
    __device__ __forceinline__ bool keep(const Unit&) const { return false; }
    bf16_t* gl; const bf16_t* z; const float* bias;
    __device__ __forceinline__ void operator()(const f32x4 (&acc)[2][2][4][2], const Unit& u, int wr, int wc, int fr, int fq) const {
#pragma unroll
        for (int ai = 0; ai < 2; ++ai)
#pragma unroll
            for (int m = 0; m < 4; ++m) {
                const int row = u.pm * BM + ai * HALF + wr * 64 + m * 16 + fr;
#pragma unroll
                for (int bj = 0; bj < 2; ++bj) {
                    const int col = u.pn * BM + bj * HALF + wc * 32 + 8 * fq;
                    const f32x4 v0 = acc[ai][bj][m][0], v1 = acc[ai][bj][m][1];
                    const f32x4 b0 = *(const f32x4*)(bias + col), b1 = *(const f32x4*)(bias + col + 4);
                    const u32x4 zz = *(const u32x4*)(z + (size_t)row * 512 + col);
                    float o[8];
                    o[0] = bflo(zz.x) * sigmoidf_(v0[0] + b0[0]); o[1] = bfhi(zz.x) * sigmoidf_(v0[1] + b0[1]);
                    o[2] = bflo(zz.y) * sigmoidf_(v0[2] + b0[2]); o[3] = bfhi(zz.y) * sigmoidf_(v0[3] + b0[3]);
                    o[4] = bflo(zz.z) * sigmoidf_(v1[0] + b1[0]); o[5] = bfhi(zz.z) * sigmoidf_(v1[1] + b1[1]);
                    o[6] = bflo(zz.w) * sigmoidf_(v1[2] + b1[2]); o[7] = bfhi(zz.w) * sigmoidf_(v1[3] + b1[3]);
                    u32x4 w; w.x = cvt_pk_bf16(o[0], o[1]); w.y = cvt_pk_bf16(o[2], o[3]); w.z = cvt_pk_bf16(o[4], o[5]); w.w = cvt_pk_bf16(o[6], o[7]);
                    *(u32x4*)(gl + (size_t)row * 512 + col) = w;
                }
            }
    }
};
template <int M, int N>
struct PairOrder {
    StaticOrder<M, N> S;
    __device__ void init(int G_, int c_) { S.init(G_, c_); }
    __device__ bool next(int i, Unit& u) const { if (!S.next(i >> 1, u)) return false; u.g = i & 1; return true; }
    __device__ __forceinline__ void a_ready(const Unit&) const {}
    __device__ __forceinline__ void done(const Unit&) const {}
};
struct EpiMerge {
    static constexpr bool PERM = true, AFTER_DRAIN = false;
    __device__ __forceinline__ bool keep(const Unit& u) const { return u.g == 0; }
    bf16_t* merged; const bf16_t* ga; const bf16_t* gb;
    __device__ __forceinline__ void operator()(f32x4 (&acc)[2][2][4][2], const Unit& u, int wr, int wc, int fr, int fq) const {
#pragma unroll
        for (int ai = 0; ai < 2; ++ai)
#pragma unroll
            for (int m = 0; m < 4; ++m) {
                const int row = u.pm * BM + ai * HALF + wr * 64 + m * 16 + fr;
#pragma unroll
                for (int bj = 0; bj < 2; ++bj) {
                    const int col = u.pn * BM + bj * HALF + wc * 32 + 8 * fq;
                    const u32x4 a4 = *(const u32x4*)(ga + (size_t)row * DM + col);
                    float sa[8];
#pragma unroll
                    for (int q = 0; q < 4; ++q) { sa[2 * q] = sigmoidf_(bflo(a4[q])); sa[2 * q + 1] = sigmoidf_(bfhi(a4[q])); }
                    if (u.g == 0) {
                        const u32x4 b4 = *(const u32x4*)(gb + (size_t)row * DM + col);
#pragma unroll
                        for (int q = 0; q < 4; ++q) {
                            const float r0 = sigmoidf_(bflo(b4[q])) * frcp(sa[2 * q]), r1 = sigmoidf_(bfhi(b4[q])) * frcp(sa[2 * q + 1]);
                            acc[ai][bj][m][q >> 1][(q & 1) * 2] *= r0; acc[ai][bj][m][q >> 1][(q & 1) * 2 + 1] *= r1;
                        }
                    } else {
                        const f32x4 v0 = acc[ai][bj][m][0], v1 = acc[ai][bj][m][1];
                        u32x4 w; w[0] = cvt_pk_bf16(v0[0] * sa[0], v0[1] * sa[1]); w[1] = cvt_pk_bf16(v0[2] * sa[2], v0[3] * sa[3]); w[2] = cvt_pk_bf16(v1[0] * sa[4], v1[1] * sa[5]); w[3] = cvt_pk_bf16(v1[2] * sa[6], v1[3] * sa[7]);
                        *(u32x4*)(merged + (size_t)row * DM + col) = w;
                    }
                }
                asm volatile("" ::: "memory");
            }
    }
};
struct EpiOut {
    static constexpr bool PERM = true, AFTER_DRAIN = false;
    __device__ __forceinline__ bool keep(const Unit&) const { return false; }
    const float* x; bf16_t* x1; bf16_t* x1g; const float* mod; const float* g2; unsigned long long* rowss;
    __device__ __forceinline__ void operator()(const f32x4 (&acc)[2][2][4][2], const Unit& u, int wr, int wc, int fr, int fq) const {
#pragma unroll
        for (int ai = 0; ai < 2; ++ai)
#pragma unroll
            for (int m = 0; m < 4; ++m) {
                const int row = u.pm * BM + ai * HALF + wr * 64 + m * 16 + fr;
                const float* modb = mod + (size_t)(row >> 12) * (6 * DM);
                float ss = 0.f;
#pragma unroll
                for (int bj = 0; bj < 2; ++bj) {
                    const int col = u.pn * BM + bj * HALF + wc * 32 + 8 * fq;
#pragma unroll
                    for (int n = 0; n < 2; ++n) {
                        const int cc = col + 4 * n;
                        const f32x4 v = acc[ai][bj][m][n];
                        const f32x4 xx = *(const f32x4*)(x + (size_t)row * DM + cc);
                        const f32x4 g1 = *(const f32x4*)(modb + 2 * DM + cc), sc = *(const f32x4*)(modb + 4 * DM + cc), gg = *(const f32x4*)(g2 + cc);
                        const f32x4 o = xx + g1 * v;
                        { u32x2 w1; w1.x = cvt_pk_bf16(o[0], o[1]); w1.y = cvt_pk_bf16(o[2], o[3]); *(u32x2*)(x1 + (size_t)row * DM + cc) = w1; }
                        ss += o[0] * o[0] + o[1] * o[1] + o[2] * o[2] + o[3] * o[3];
                        const f32x4 og = o * gg * (sc + 1.f);
                        u32x2 w; w.x = cvt_pk_bf16(og[0], og[1]); w.y = cvt_pk_bf16(og[2], og[3]);
                        *(u32x2*)(x1g + (size_t)row * DM + cc) = w;
                    }
                }
                ss += __shfl_xor(ss, 16); ss += __shfl_xor(ss, 32);
                if (fq == 0) atomicAdd(rowss + row, (unsigned long long)(ss * SS_FIX));
            }
    }
};
struct EpiQ {
    static constexpr bool PERM = true, AFTER_DRAIN = false;
    __device__ __forceinline__ bool keep(const Unit&) const { return false; }
    bf16_t* qp; const unsigned long long* rowss; const float* c2;
    __device__ __forceinline__ void operator()(const f32x4 (&acc)[2][2][4][2], const Unit& u, int wr, int wc, int fr, int fq) const {
#pragma unroll
        for (int ai = 0; ai < 2; ++ai)
#pragma unroll
            for (int m = 0; m < 4; ++m) {
                const int row = u.pm * BM + ai * HALF + wr * 64 + m * 16 + fr;
                const float rstd = rstd_from_fix(rowss[row]);
                const float* cb = c2 + (size_t)(row >> 12) * 2048;
#pragma unroll
                for (int bj = 0; bj < 2; ++bj) {
                    const int col = u.pn * BM + bj * HALF + wc * 32 + 8 * fq;
                    const f32x4 v0 = acc[ai][bj][m][0] * rstd + *(const f32x4*)(cb + col), v1 = acc[ai][bj][m][1] * rstd + *(const f32x4*)(cb + col + 4);
                    u32x4 w; w.x = cvt_pk_bf16(v0[0], v0[1]); w.y = cvt_pk_bf16(v0[2], v0[3]); w.z = cvt_pk_bf16(v1[0], v1[1]); w.w = cvt_pk_bf16(v1[2], v1[3]);
                    *(u32x4*)(qp + (size_t)row * 2048 + col) = w;
                }
            }
    }
};
struct EpiE {
    static constexpr bool PERM = true, AFTER_DRAIN = false;
    __device__ __forceinline__ bool keep(const Unit&) const { return false; }
    float* E;
    __device__ __forceinline__ void operator()(const f32x4 (&acc)[2][2][4][2], const Unit& u, int wr, int wc, int fr, int fq) const {
#pragma unroll
        for (int ai = 0; ai < 2; ++ai)
#pragma unroll
            for (int m = 0; m < 4; ++m) {
                const int row = u.pm * BM + ai * HALF + wr * 64 + m * 16 + fr;
#pragma unroll
                for (int bj = 0; bj < 2; ++bj) {
                    const int col = u.pn * BM + bj * HALF + wc * 32 + 8 * fq;
                    float* d = E + ((size_t)(u.g * SSM_ROWS + row) * 256 + col);
                    *(f32x4*)d = acc[ai][bj][m][0]; *(f32x4*)(d + 4) = acc[ai][bj][m][1];
                }
            }
    }
};
struct EpiZ {
    static constexpr bool PERM = true, AFTER_DRAIN = false;
    __device__ __forceinline__ bool keep(const Unit&) const { return false; }
    bf16_t* z;
    __device__ __forceinline__ void operator()(const f32x4 (&acc)[2][2][4][2], const Unit& u, int wr, int wc, int fr, int fq) const {
#pragma unroll
        for (int ai = 0; ai < 2; ++ai)
#pragma unroll
            for (int m = 0; m < 4; ++m) {
                const int n = u.pm * BM + ai * HALF + wr * 64 + m * 16 + fr;
                const size_t tok0 = (size_t)(n >> 7) * SEQL + (size_t)(n & 127) * 32;
#pragma unroll
                for (int bj = 0; bj < 2; ++bj) {
                    const int col = u.pn * BM + bj * HALF + wc * 32 + 8 * fq;
                    const f32x4 v0 = acc[ai][bj][m][0], v1 = acc[ai][bj][m][1];
                    u32x4 w; w.x = cvt_pk_bf16(gelu_tanh(v0[0]), gelu_tanh(v0[1])); w.y = cvt_pk_bf16(gelu_tanh(v0[2]), gelu_tanh(v0[3]));
                    w.z = cvt_pk_bf16(gelu_tanh(v1[0]), gelu_tanh(v1[1])); w.w = cvt_pk_bf16(gelu_tanh(v1[2]), gelu_tanh(v1[3]));
                    *(u32x4*)(z + (tok0 + (col >> 4)) * 512 + u.g * 16 + (col & 15)) = w;
                }
            }
    }
};
}

__device__ __forceinline__ void sincos_d(double th, double& s, double& c) {
    const double twopi = 6.283185307179586476925, hpi = 1.570796326794896619231;
    th -= twopi * rint(th / twopi);
    const double q = rint(th / hpi); const double y = th - q * hpi, y2 = y * y;
    const double sy = y * (1.0 - y2 / 6.0 * (1.0 - y2 / 20.0 * (1.0 - y2 / 42.0 * (1.0 - y2 / 72.0 * (1.0 - y2 / 110.0 * (1.0 - y2 / 156.0 * (1.0 - y2 / 210.0)))))));
    const double cy = 1.0 - y2 / 2.0 * (1.0 - y2 / 12.0 * (1.0 - y2 / 30.0 * (1.0 - y2 / 56.0 * (1.0 - y2 / 90.0 * (1.0 - y2 / 132.0 * (1.0 - y2 / 182.0))))));
    const int qi = ((int)q) & 3;
    s = qi == 0 ? sy : (qi == 1 ? cy : (qi == 2 ? -sy : -cy));
    c = qi == 0 ? cy : (qi == 1 ? -sy : (qi == 2 ? -cy : sy));
}
__device__ __forceinline__ void ssm_prep_item(const P& p, LAS unsigned char* lds, int item) {
    const int g = item >> 2, qtr = item & 3, tid = threadIdx.x;
    LAS f32x2* lamk = (LAS f32x2*)lds;
    LAS f32x2* Bb = lamk + 2 * 64 * 33;
    LAS f32x2* Cc = Bb + 2 * 64 * 16;
    LAS float* Kc = (LAS float*)(Cc + 2 * 16 * 64);
    if (tid < 128) {
        const int d = tid >> 6, pp = tid & 63, gi = d * 32 + g;
        const double are = (double)p.a_re[gi * 64 + pp], aim = (double)p.a_im[gi * 64 + pp];
        const double dt = (double)expf(p.log_dt[gi]);
        const double er = exp(are * dt); double sn, cs; sincos_d(aim * dt, sn, cs);
        const double lr = er * cs, li = er * sn;
        double pr = 1.0, pi_ = 0.0;
        for (int k = 0; k <= 32; ++k) {
            lamk[(d * 64 + pp) * 33 + k] = (f32x2){(float)pr, (float)pi_};
            const double nr_ = pr * lr - pi_ * li, ni_ = pr * li + pi_ * lr; pr = nr_; pi_ = ni_;
        }
        if (qtr == 0) { const f32x2 l32 = lamk[(d * 64 + pp) * 33 + 32]; *(f32x2*)(p.lamT() + (size_t)(gi * 64 + pp) * 2) = l32; }
        const double nr = lr - 1.0, ni = li, den = are * are + aim * aim;
        const double qr = (nr * are + ni * aim) / den, qi = (ni * are - nr * aim) / den;
        f32x4 brv[4], biv[4];
#pragma unroll
        for (int q = 0; q < 4; ++q) { brv[q] = *(const f32x4*)(p.b_re + ((size_t)gi * 64 + pp) * 16 + 4 * q); biv[q] = *(const f32x4*)(p.b_im + ((size_t)gi * 64 + pp) * 16 + 4 * q); }
#pragma unroll
        for (int h = 0; h < 16; ++h) {
            const double br = (double)brv[h >> 2][h & 3], bi = (double)biv[h >> 2][h & 3];
            Bb[(d * 64 + pp) * 16 + h] = (f32x2){(float)(qr * br - qi * bi), (float)(qr * bi + qi * br)};
        }
    }
    for (int e = tid; e < 2 * 16 * 64; e += NT) {
        const int d = e >> 10, h = (e >> 6) & 15, pp = e & 63; const size_t src = ((size_t)(d * 32 + g) * 16 + h) * 64 + pp;
        Cc[e] = (f32x2){p.c_re[src], p.c_im[src]};
    }
    __syncthreads();
    {
        const int wv = __builtin_amdgcn_readfirstlane(tid >> 6), lane = tid & 63, lm = lane & 15, kq = lane >> 4, d = wv >> 2;
        bf16x8 bop[4];
#pragma unroll
        for (int ks = 0; ks < 4; ++ks) {
            u32x4 w;
#pragma unroll
            for (int j = 0; j < 4; ++j) { const f32x2 bb = Bb[(d * 64 + ks * 16 + kq * 4 + j) * 16 + lm]; w[j] = pk2(bb[0], bb[1]); }
            bop[ks] = __builtin_bit_cast(bf16x8, w);
        }
#pragma unroll 1
        for (int k = (wv & 3) * 8; k < (wv & 3) * 8 + 8; ++k) {
            f32x4 acc = {0.f, 0.f, 0.f, 0.f};
#pragma unroll
            for (int ks = 0; ks < 4; ++ks) {
                u32x4 w;
#pragma unroll
                for (int j = 0; j < 4; ++j) {
                    const int pp = ks * 16 + kq * 4 + j;
                    const f32x2 c = Cc[(d * 16 + lm) * 64 + pp], l = lamk[(d * 64 + pp) * 33 + k];
                    w[j] = pk2(c[0] * l[0] - c[1] * l[1], -(c[0] * l[1] + c[1] * l[0]));
                }
                acc = __builtin_amdgcn_mfma_f32_16x16x32_bf16(__builtin_bit_cast(bf16x8, w), bop[ks], acc, 0, 0, 0);
            }
#pragma unroll
            for (int r = 0; r < 4; ++r) Kc[((d * 32 + k) * 16 + kq * 4 + r) * 16 + lm] = acc[r];
        }
    }
    __syncthreads();
    for (int ch = tid; ch < 128 * 96; ch += NT) {
        const int mrow = 128 * qtr + ch / 96, k0 = (ch % 96) * 8, ii = mrow >> 4, h = mrow & 15;
        float v[8];
        if (k0 < 512) {
            const int jj = k0 >> 4, h20 = k0 & 15;
#pragma unroll
            for (int i = 0; i < 8; ++i) {
                const int h2 = h20 + i; float val = 0.f;
                if (ii >= jj) val += Kc[((0 * 32 + (ii - jj)) * 16 + h) * 16 + h2];
                if (jj >= ii) val += Kc[((1 * 32 + (jj - ii)) * 16 + h) * 16 + h2];
                if (ii == jj && h == h2) val += p.ssm_d[g * 16 + h];
                v[i] = val;
            }
        } else {
            const int sc = k0 - 512, d = sc >> 7, ri = (sc >> 6) & 1, p0 = sc & 63, e = d == 0 ? ii + 1 : 32 - ii;
#pragma unroll
            for (int i = 0; i < 8; ++i) {
                const int pp = p0 + i; const f32x2 c = Cc[(d * 16 + h) * 64 + pp], l = lamk[(d * 64 + pp) * 33 + e];
                const float clr = c[0] * l[0] - c[1] * l[1], cli = c[0] * l[1] + c[1] * l[0];
                v[i] = ri == 0 ? clr : -cli;
            }
        }
        u32x4 o; o.x = pg8::cvt_pk_bf16(v[0], v[1]); o.y = pg8::cvt_pk_bf16(v[2], v[3]); o.z = pg8::cvt_pk_bf16(v[4], v[5]); o.w = pg8::cvt_pk_bf16(v[6], v[7]);
        *(u32x4*)(p.Kmat() + ((size_t)(g * 512 + mrow) * SSM_LD + k0)) = o;
    }
    for (int ch = tid; ch < 64 * 64; ch += NT) {
        const int nrow = 64 * qtr + ch / 64, k0 = (ch % 64) * 8, d = nrow >> 7, ri = (nrow >> 6) & 1, pp = nrow & 63;
        const int jj = k0 >> 4, h20 = k0 & 15, e = d == 0 ? 31 - jj : jj;
        const f32x2 l = lamk[(d * 64 + pp) * 33 + e];
        float v[8];
#pragma unroll
        for (int i = 0; i < 8; ++i) { const f32x2 b = Bb[(d * 64 + pp) * 16 + h20 + i]; v[i] = ri == 0 ? (l[0] * b[0] - l[1] * b[1]) : (l[0] * b[1] + l[1] * b[0]); }
        u32x4 o; o.x = pg8::cvt_pk_bf16(v[0], v[1]); o.y = pg8::cvt_pk_bf16(v[2], v[3]); o.z = pg8::cvt_pk_bf16(v[4], v[5]); o.w = pg8::cvt_pk_bf16(v[6], v[7]);
        *(u32x4*)(p.Win() + ((size_t)(g * 256 + nrow) * 512 + k0)) = o;
    }
    __syncthreads();
}
__device__ __forceinline__ void ph_carry(const P& p) {
    int tid = threadIdx.x; asm volatile("" : "+v"(tid));
    if (tid >= 128) return;
    for (int gidx = blockIdx.x * 128 + tid; gidx < 32 * 8 * 2 * 64; gidx += gridDim.x * 128) {
        const int pp = gidx & 63, d = (gidx >> 6) & 1, b = (gidx >> 7) & 7, g = gidx >> 10;
        const f32x2 lt = *(const f32x2*)(p.lamT() + (size_t)((d * 32 + g) * 64 + pp) * 2);
        const float* Eg = p.E() + (size_t)g * SSM_ROWS * 256 + d * 128 + pp;
        bf16_t* Ug = p.U() + (size_t)g * SSM_ROWS * SSM_LD + 512 + d * 128 + pp;
        float fr = 0.f, fi = 0.f;
#pragma unroll
        for (int cc = 0; cc < 8; ++cc) {
            const int n = 1024 + b * 8 + (d == 0 ? cc : 7 - cc);
            const float er = Eg[(size_t)n * 256], ei = Eg[(size_t)n * 256 + 64];
            const float nr = lt[0] * fr - lt[1] * fi + er, ni = lt[0] * fi + lt[1] * fr + ei; fr = nr; fi = ni;
        }
#pragma unroll 8
        for (int c = 0; c < 128; ++c) {
            const int n = b * 128 + (d == 0 ? c : 127 - c);
            const float er = Eg[(size_t)n * 256], ei = Eg[(size_t)n * 256 + 64];
            Ug[(size_t)n * SSM_LD] = (bf16_t)f2bf(fr); Ug[(size_t)n * SSM_LD + 64] = (bf16_t)f2bf(fi);
            const float nr = lt[0] * fr - lt[1] * fi + er, ni = lt[0] * fi + lt[1] * fr + ei; fr = nr; fi = ni;
        }
    }
}


__device__ __forceinline__ void p0_transpose_item_fp8(const float* W, int K, int N, unsigned char* WT, float scale, LAS float* scr, int item, int lane) {
    const int nblk = N / 32, kb = item / nblk, nb = item % nblk, k0 = 64 * kb, n0 = 32 * nb;
#pragma unroll 8
    for (int i = 0; i < 32; ++i) { const int kk = 2 * i + (lane >> 5); scr[kk * 33 + (lane & 31)] = W[(size_t)(k0 + kk) * N + n0 + (lane & 31)]; }
    asm volatile("s_waitcnt lgkmcnt(0)" ::: "memory");
    const int c = lane & 7;
#pragma unroll
    for (int j = 0; j < 4; ++j) { const int n = (lane >> 3) + 8 * j; const LAS float* s = scr + (8 * c) * 33 + n;
        u32x2 o; o.x = pk4_fp8(s[0 * 33] * scale, s[1 * 33] * scale, s[2 * 33] * scale, s[3 * 33] * scale); o.y = pk4_fp8(s[4 * 33] * scale, s[5 * 33] * scale, s[6 * 33] * scale, s[7 * 33] * scale);
        *(u32x2*)(WT + (size_t)(n0 + n) * K + k0 + 8 * c) = o; }
    asm volatile("s_waitcnt lgkmcnt(0)" ::: "memory");
}
__device__ __forceinline__ void p0_transpose_item(const float* W, int K, int N, bf16_t* WT, LAS float* scr, int item, int lane) {
    const int nblk = N / 32, kb = item / nblk, nb = item % nblk, k0 = 64 * kb, n0 = 32 * nb;
#pragma unroll 8
    for (int i = 0; i < 32; ++i) { const int kk = 2 * i + (lane >> 5); scr[kk * 33 + (lane & 31)] = W[(size_t)(k0 + kk) * N + n0 + (lane & 31)]; }
    asm volatile("s_waitcnt lgkmcnt(0)" ::: "memory");
    const int c = lane & 7;
#pragma unroll
    for (int j = 0; j < 4; ++j) { const int n = (lane >> 3) + 8 * j; const LAS float* s = scr + (8 * c) * 33 + n;
        u32x4 o; o.x = pk2(s[0 * 33], s[1 * 33]); o.y = pk2(s[2 * 33], s[3 * 33]); o.z = pk2(s[4 * 33], s[5 * 33]); o.w = pk2(s[6 * 33], s[7 * 33]);
        *(u32x4*)(WT + (size_t)(n0 + n) * K + k0 + 8 * c) = o; }
    asm volatile("s_waitcnt lgkmcnt(0)" ::: "memory");
}

template <int NR, bool SILU>
__device__ __forceinline__ void gemv_block64(const float* const (&rows)[NR], const float* W, int ldw, int col0, const float* bias, float* y, int ldy, LAS float* scr) {
    const int wave = threadIdx.x >> 6, lane = threadIdx.x & 63;
    LAS float* act = scr + 8 * NR * 64;
#pragma unroll
    for (int r = 0; r < NR; ++r) for (int k = threadIdx.x; k < DM; k += NT) { const float s = rows[r][k]; act[r * DM + k] = SILU ? siluf_(s) : s; }
    __syncthreads();
    float acc[NR];
#pragma unroll
    for (int r = 0; r < NR; ++r) acc[r] = 0.f;
    const int kb = wave * 128;
#pragma unroll 32
    for (int k = kb; k < kb + 128; ++k) {
        const float w = W[(size_t)k * ldw + col0 + lane];
#pragma unroll
        for (int r = 0; r < NR; ++r) acc[r] += act[r * DM + k] * w;
    }
#pragma unroll
    for (int r = 0; r < NR; ++r) scr[(wave * NR + r) * 64 + lane] = acc[r];
    __syncthreads();
    for (int e = threadIdx.x; e < NR * 64; e += NT) {
        const int r = e >> 6, l = e & 63; float s = 0.f;
#pragma unroll
        for (int w = 0; w < 8; ++w) s += scr[(w * NR + r) * 64 + l];
        y[(size_t)r * ldy + col0 + l] = s + (bias ? bias[col0 + l] : 0.f);
    }
    __syncthreads();
}

__device__ __forceinline__ void ph_prep(const P& p, LAS unsigned char* lds) {
    int tid_ = threadIdx.x; asm volatile("" : "+v"(tid_));
    const int wave = tid_ >> 6, lane = tid_ & 63, G = gridDim.x;
    for (int cb = blockIdx.x; cb < 96; cb += G) {
        const float* const rows[9] = {p.c, p.c + DM, p.c + 2 * DM, p.c + 3 * DM, p.c + 4 * DM, p.c + 5 * DM, p.c + 6 * DM, p.c + 7 * DM, p.c_ctx};
        gemv_block64<9, true>(rows, p.w_mod, 6 * DM, cb * 64, p.b_mod, p.mod(), 6 * DM, (LAS float*)lds);
    }
    {
        LAS float* scr = (LAS float*)(lds + wave * 16384);
        const int gw = blockIdx.x * NWAVES + wave, NGW = G * NWAVES;
        constexpr int I_IN = (DM / 64) * (INC / 32), I_GLU = (512 / 64) * (512 / 32), I_A = (512 / 64) * (DM / 32), I_OUT = (DM / 64) * (DM / 32), I_Q = (DM / 64) * (2048 / 32);
        constexpr int NITEMS = I_IN + I_GLU + 2 * I_A + I_OUT + I_Q;
        for (int it = gw; it < NITEMS; it += NGW) {
            int r = it;
            if (r < I_IN) { p0_transpose_item_fp8(p.w_in, DM, INC, (unsigned char*)p.w_in_t(), WIN_SCALE, scr, r, lane); continue; } r -= I_IN;
            if (r < I_GLU) { p0_transpose_item(p.w_glu, 512, 512, p.w_glu_t(), scr, r, lane); continue; } r -= I_GLU;
            if (r < I_A) { p0_transpose_item(p.w_a, 512, DM, p.w_a_t(), scr, r, lane); continue; } r -= I_A;
            if (r < I_A) { p0_transpose_item(p.w_b, 512, DM, p.w_b_t(), scr, r, lane); continue; } r -= I_A;
            if (r < I_OUT) { p0_transpose_item(p.w_out, DM, DM, p.w_out_t(), scr, r, lane); continue; } r -= I_OUT;
            p0_transpose_item(p.w_q, DM, 2048, p.w_q_t(), scr, r, lane);
        }
    }
}

template <int CTRL> __device__ __forceinline__ int dpp_i(int v) { return __builtin_amdgcn_update_dpp(0, v, CTRL, 0xf, 0xf, true); }
template <int CTRL> __device__ __forceinline__ float dpp_f(float v) { return __builtin_bit_cast(float, __builtin_amdgcn_update_dpp(0, __builtin_bit_cast(int, v), CTRL, 0xf, 0xf, true)); }
constexpr int DPP_XOR1 = 0xB1, DPP_XOR2 = 0x4E, DPP_HMIRROR = 0x141, DPP_ROR8 = 0x128;
constexpr float I8_MAGIC = 12582912.f;
__device__ __forceinline__ unsigned pack4_i8(float t0, float t1, float t2, float t3) {
    const unsigned p01 = __builtin_amdgcn_perm(__builtin_bit_cast(unsigned, t1), __builtin_bit_cast(unsigned, t0), 0x0c0c0400u);
    const unsigned p23 = __builtin_amdgcn_perm(__builtin_bit_cast(unsigned, t3), __builtin_bit_cast(unsigned, t2), 0x0c0c0400u);
    return __builtin_amdgcn_perm(p23, p01, 0x05040100u);
}
__device__ __forceinline__ void bg_convert_tables(const P& p) {
    int tid_ = threadIdx.x; asm volatile("" : "+v"(tid_));
    const int lane = tid_ & 63;
    unsigned* head = p.queues() + 16 * 64;
    for (;;) {
        unsigned v = 0u; if (lane == 0) v = __hip_atomic_fetch_add(head, 32u, __ATOMIC_RELAXED, __HIP_MEMORY_SCOPE_AGENT);
        const int rg = (int)__builtin_amdgcn_readfirstlane(v);
        if (rg >= 2 * 16384) break;
#pragma unroll 1
      for (int r0 = rg; r0 < rg + 32; r0 += 4) {
        const bool second = r0 >= 16384; const int rr0 = second ? r0 - 16384 : r0;
        const float* src = (second ? p.peer_v : p.peer_u) + (size_t)rr0 * DM + lane * 16;
        unsigned char* dst = (second ? p.pv8() : p.pu8()) + (size_t)(lane >> 3) * (16384 * 128) + (size_t)rr0 * 128 + (lane & 7) * 16;
        f32x4 v4[4][4];
#pragma unroll
        for (int q = 0; q < 4; ++q)
#pragma unroll
            for (int j = 0; j < 4; ++j) v4[q][j] = *(const f32x4*)(src + q * DM + 4 * j);
        float inv = 1.f;
#pragma unroll
        for (int q = 0; q < 4; ++q) {
            float am = 0.f;
#pragma unroll
            for (int j = 0; j < 4; ++j) am = fmaxf(am, fmaxf(fmaxf(fabsf(v4[q][j][0]), fabsf(v4[q][j][1])), fmaxf(fabsf(v4[q][j][2]), fabsf(v4[q][j][3]))));
            am = wave_max(am);
            const float top = 6.f;
            const float sc = am > 0.f ? top / am : 1.f;
            if (second) {
                u32x2 o2;
#pragma unroll
                for (int jj = 0; jj < 2; ++jj) {
                    unsigned w = 0u;
                    w = __builtin_amdgcn_cvt_scalef32_pk_fp4_f32(w, v4[q][jj * 2][0] * sc, v4[q][jj * 2][1] * sc, 1.0f, 0);
                    w = __builtin_amdgcn_cvt_scalef32_pk_fp4_f32(w, v4[q][jj * 2][2] * sc, v4[q][jj * 2][3] * sc, 1.0f, 1);
                    w = __builtin_amdgcn_cvt_scalef32_pk_fp4_f32(w, v4[q][jj * 2 + 1][0] * sc, v4[q][jj * 2 + 1][1] * sc, 1.0f, 2);
                    w = __builtin_amdgcn_cvt_scalef32_pk_fp4_f32(w, v4[q][jj * 2 + 1][2] * sc, v4[q][jj * 2 + 1][3] * sc, 1.0f, 3);
                    o2[jj] = w;
                }
                *(u32x2*)(p.pv8() + (size_t)(lane >> 4) * (16384 * 128) + (size_t)(rr0 + q) * 128 + (lane & 15) * 8) = o2;
                inv = lane == q ? (am > 0.f ? am / top : 1.f) : inv;
            } else {
                float a16 = 0.f;
#pragma unroll
                for (int j = 0; j < 4; ++j) a16 = fmaxf(a16, fmaxf(fmaxf(fabsf(v4[q][j][0]), fabsf(v4[q][j][1])), fmaxf(fabsf(v4[q][j][2]), fabsf(v4[q][j][3]))));
                a16 = fmaxf(a16, dpp_f<DPP_XOR1>(a16)); a16 = fmaxf(a16, dpp_f<DPP_XOR2>(a16)); a16 = fmaxf(a16, dpp_f<DPP_HMIRROR>(a16)); a16 = fmaxf(a16, dpp_f<DPP_ROR8>(a16));
                const float s4 = a16 > 0.f ? 7.f / a16 : 1.f;
                u32x2 o2;
#pragma unroll
                for (int jj = 0; jj < 2; ++jj) {
                    unsigned w = 0u;
#pragma unroll
                    for (int k = 0; k < 8; ++k) { const float t = v4[q][jj * 2 + (k >> 2)][k & 3] * s4 + I8_MAGIC; w |= (__builtin_bit_cast(unsigned, t) & 15u) << (4 * k); }
                    o2[jj] = w;
                }
                *(u32x2*)(p.pu8() + (size_t)(lane >> 4) * (16384 * 128) + (size_t)(rr0 + q) * 128 + (lane & 15) * 8) = o2;
                if ((lane & 15) == 0) p.pisc_u()[(size_t)(rr0 + q) * 4 + (lane >> 4)] = a16 > 0.f ? a16 * (1.f / 7.f) : 1.f;
            }
        }
        if (second && lane < 4) p.pisc()[r0 + lane] = inv;
      }
    }
}

__device__ __forceinline__ void normmod_row_bf16(const float* src, bf16_t* dst, const float* g, const float* shift, const float* scale, int lane) {
    const f32x4* s = (const f32x4*)src;
    f32x4 v[4]; float ss = 0.f;
#pragma unroll
    for (int j = 0; j < 4; ++j) { v[j] = s[lane + 64 * j]; ss += v[j][0] * v[j][0] + v[j][1] * v[j][1] + v[j][2] * v[j][2] + v[j][3] * v[j][3]; }
    ss = wave_sum(ss);
    const float rstd = rsqrtf(ss * (1.f / DM) + EPSN);
#pragma unroll
    for (int j = 0; j < 4; ++j) {
        const int i4 = lane + 64 * j;
        const f32x4 gg = ((const f32x4*)g)[i4], sh = ((const f32x4*)shift)[i4], sc = ((const f32x4*)scale)[i4];
        const f32x4 o = v[j] * rstd * gg * (sc + 1.f) + sh;
        *(unsigned*)((unsigned char*)dst + (size_t)i4 * 4) = pk4_fp8(o[0], o[1], o[2], o[3]);
    }
}
__device__ __forceinline__ void ph_norm1(const P& p, LAS unsigned char* lds) {
    int tid_ = threadIdx.x; asm volatile("" : "+v"(tid_));
    const int wave = tid_ >> 6, lane = tid_ & 63, G = gridDim.x;
    const int gw = blockIdx.x * NWAVES + __builtin_amdgcn_readfirstlane(wave), NGW = G * NWAVES;
    for (int r4 = gw; r4 < NTOK / 4; r4 += NGW) {
        const int r = r4 * 4;
        const f32x4* s = (const f32x4*)(p.x + (size_t)r * DM);
        f32x4 v[4][4];
#pragma unroll
        for (int k = 0; k < 4; ++k)
#pragma unroll
            for (int j = 0; j < 4; ++j) v[k][j] = s[k * (DM / 4) + lane + 64 * j];
        const float* modb = p.mod() + (size_t)(r >> 12) * (6 * DM);
#pragma unroll
        for (int k = 0; k < 4; ++k) {
            float ss = 0.f;
#pragma unroll
            for (int j = 0; j < 4; ++j) ss += v[k][j][0] * v[k][j][0] + v[k][j][1] * v[k][j][1] + v[k][j][2] * v[k][j][2] + v[k][j][3] * v[k][j][3];
            ss = wave_sum(ss);
            const float rstd = rsqrtf(ss * (1.f / DM) + EPSN);
            unsigned char* dst = (unsigned char*)p.hx() + (size_t)(r + k) * DM;
#pragma unroll
            for (int j = 0; j < 4; ++j) {
                const int i4 = lane + 64 * j;
                const f32x4 gg = ((const f32x4*)p.norm1_g)[i4], sh = ((const f32x4*)modb)[i4], sc = ((const f32x4*)(modb + DM))[i4];
                const f32x4 o = v[k][j] * rstd * gg * (sc + 1.f) + sh;
                *(unsigned*)(dst + (size_t)i4 * 4) = pk4_fp8(o[0], o[1], o[2], o[3]);
            }
        }
    }
    for (int rc = gw; rc < NCTX; rc += NGW) { const float* modc = p.mod() + 8 * (6 * DM); normmod_row_bf16(p.ctx + (size_t)rc * DM, (bf16_t*)((unsigned char*)p.hc() + (size_t)rc * DM), p.norm1_g, modc, modc + DM, lane); }
}

constexpr int RPB_LD = 128, RPB_PAD = 48;
__device__ __forceinline__ void ph_na(const P& p, LAS unsigned char* lds) {
    int tid_ = threadIdx.x; asm volatile("" : "+v"(tid_));
    const int tid = tid_, h = __builtin_amdgcn_readfirstlane(tid >> 6), lane = tid & 63, lt = lane & 15, lq = lane >> 4;
    constexpr float LOG2E = 1.4426950408889634f, CS = 0.125f * LOG2E;
    LAS float* rp = (LAS float*)lds;
    for (int e = tid; e < 8 * 15 * RPB_LD; e += NT) { const int c = (e & (RPB_LD - 1)) - RPB_PAD; rp[e] = (c >= 0 && c < 31) ? p.rpb[(e / RPB_LD) * 31 + c] * LOG2E : 0.f; }
    __syncthreads();
    const int pa = (lt >> 2) * 8 + (lt & 3);
    const unsigned lane_k = pa * 512 + lq * 8, lane_v = lt * 64 + lq * 8, lane_q = lt * 512 + lq * 8, lane_o = lt * 512 + lq * 4;
    for (int item = blockIdx.x; item < NB * GW; item += gridDim.x) {
        const int b = item >> 6, r = item & 63;
        int r0 = r - 4; r0 = r0 < 0 ? 0 : (r0 > 56 ? 56 : r0);
        const bf16_t* Kb = p.kb() + ((size_t)b * SEQL + (size_t)r0 * GW) * 512 + h * 64;
        const bf16_t* Kc = p.kc() + ((size_t)b * CTXL) * 512 + h * 64;
        const bf16_t* Vt = p.vT() + ((size_t)((b * 8 + h) * 64 + r0)) * 4096;
        const bf16_t* Vc = p.vcT() + ((size_t)((b * 8 + h) * 4)) * 4096;
        const bf16_t* Qb = p.qb() + ((size_t)b * SEQL + r * GW) * 512 + h * 64;
        bf16_t* Ob = p.na() + ((size_t)b * SEQL + r * GW) * 512 + h * 64;
        const LAS float* rph = rp + (h * 15 + (r0 - r + 7)) * RPB_LD;
        bf16x8 qf[4][2];
#pragma unroll
        for (int qt = 0; qt < 4; ++qt) { qf[qt][0] = *(const bf16x8*)(Qb + qt * 16 * 512 + lane_q); qf[qt][1] = *(const bf16x8*)(Qb + qt * 16 * 512 + 32 + lane_q); }
        f32x4 o[4][4]; float m[4], l[4];
#pragma unroll
        for (int qt = 0; qt < 4; ++qt) { m[qt] = -1e30f; l[qt] = 0.f;
#pragma unroll
            for (int d = 0; d < 4; ++d) o[qt][d] = (f32x4){0.f, 0.f, 0.f, 0.f}; }
        bf16x8 kf[2][2][2];
#pragma unroll
        for (int st = 0; st < 2; ++st)
#pragma unroll
            for (int ab = 0; ab < 2; ++ab) { kf[st][ab][0] = *(const bf16x8*)(Kb + (st * 32 + ab * 4) * 512 + lane_k); kf[st][ab][1] = *(const bf16x8*)(Kb + (st * 32 + ab * 4) * 512 + 32 + lane_k); }
#pragma unroll 1
        for (int i = 0; i < 8; ++i) {
            bf16x8 vf[2][4];
#pragma unroll
            for (int st = 0; st < 2; ++st)
#pragma unroll
                for (int d = 0; d < 4; ++d) vf[st][d] = *(const bf16x8*)(Vt + i * 4096 + d * 1024 + st * 32 + lane_v);
            const LAS float* rr_ = rph + i * RPB_LD;
#pragma unroll
            for (int half = 0; half < 2; ++half) {
                f32x4 s[2][2][2];
#pragma unroll
                for (int q2 = 0; q2 < 2; ++q2) {
                    const int qt = half * 2 + q2;
#pragma unroll
                    for (int st = 0; st < 2; ++st) {
                        if ((st == 0 && qt == 3) || (st == 1 && qt == 0)) continue;
#pragma unroll
                        for (int ab = 0; ab < 2; ++ab) {
                            f32x4 c = {0.f, 0.f, 0.f, 0.f};
                            c = __builtin_amdgcn_mfma_f32_16x16x32_bf16(kf[st][ab][0], qf[qt][0], c, 0, 0, 0);
                            c = __builtin_amdgcn_mfma_f32_16x16x32_bf16(kf[st][ab][1], qf[qt][1], c, 0, 0, 0);
                            s[q2][st][ab] = c;
                        }
                    }
                }
                if (half == 1) {
                    if (i < 7) {
#pragma unroll
                        for (int st = 0; st < 2; ++st)
#pragma unroll
                            for (int ab = 0; ab < 2; ++ab) { const bf16_t* kp = Kb + ((i + 1) * GW + st * 32 + ab * 4) * 512; kf[st][ab][0] = *(const bf16x8*)(kp + lane_k); kf[st][ab][1] = *(const bf16x8*)(kp + 32 + lane_k); }
                    } else {
#pragma unroll
                        for (int ab = 0; ab < 2; ++ab) { kf[0][ab][0] = *(const bf16x8*)(Kc + ab * 4 * 512 + lane_k); kf[0][ab][1] = *(const bf16x8*)(Kc + ab * 4 * 512 + 32 + lane_k); }
                    }
                }
#pragma unroll
                for (int q2 = 0; q2 < 2; ++q2) {
                    const int qt = half * 2 + q2;
                    const int qc = qt * 16 + lt; int c0 = qc - 8; c0 = c0 < 0 ? 0 : (c0 > 48 ? 48 : c0);
                    int wo = lq * 8 - c0; asm volatile("" : "+v"(wo));
                    float mx = -1e30f;
#pragma unroll
                    for (int st = 0; st < 2; ++st) {
                        if ((st == 0 && qt == 3) || (st == 1 && qt == 0)) continue;
                        const int kc0 = st * 32 + lq * 8, bbase = kc0 - qc + 15 + RPB_PAD;
#pragma unroll
                        for (int j = 0; j < 8; ++j) {
                            float t = s[q2][st][j >> 2][j & 3] * CS + rr_[bbase + j];
                            t = ((unsigned)(wo + st * 32 + j) < 16u) ? t : -1e30f;
                            s[q2][st][j >> 2][j & 3] = t; mx = fmaxf(mx, t);
                        }
                    }
                    mx = fmaxf(mx, __shfl_xor(mx, 16)); mx = fmaxf(mx, __shfl_xor(mx, 32));
                    const float mn = fmaxf(m[qt], mx), corr = __builtin_amdgcn_exp2f(m[qt] - mn);
                    m[qt] = mn; float ls = l[qt] * corr;
#pragma unroll
                    for (int d = 0; d < 4; ++d) o[qt][d] = o[qt][d] * corr;
#pragma unroll
                    for (int st = 0; st < 2; ++st) {
                        if ((st == 0 && qt == 3) || (st == 1 && qt == 0)) continue;
                        float pe[8];
#pragma unroll
                        for (int j = 0; j < 8; ++j) pe[j] = __builtin_amdgcn_exp2f(s[q2][st][j >> 2][j & 3] - mn);
                        ls += ((pe[0] + pe[1]) + (pe[2] + pe[3])) + ((pe[4] + pe[5]) + (pe[6] + pe[7]));
                        u32x4 pw; pw[0] = pg8::cvt_pk_bf16(pe[0], pe[1]); pw[1] = pg8::cvt_pk_bf16(pe[2], pe[3]); pw[2] = pg8::cvt_pk_bf16(pe[4], pe[5]); pw[3] = pg8::cvt_pk_bf16(pe[6], pe[7]);
                        const bf16x8 pf = __builtin_bit_cast(bf16x8, pw);
#pragma unroll
                        for (int d = 0; d < 4; ++d) o[qt][d] = __builtin_amdgcn_mfma_f32_16x16x32_bf16(vf[st][d], pf, o[qt][d], 0, 0, 0);
                    }
                    l[qt] = ls;
                }
            }
        }
#pragma unroll 1
        for (int cst = 0; cst < 8; ++cst) {
            bf16x8 vf[4];
#pragma unroll
            for (int d = 0; d < 4; ++d) vf[d] = *(const bf16x8*)(Vc + (cst >> 1) * 4096 + d * 1024 + (cst & 1) * 32 + lane_v);
            f32x4 s[4][2];
#pragma unroll
            for (int qt = 0; qt < 4; ++qt)
#pragma unroll
                for (int ab = 0; ab < 2; ++ab) {
                    f32x4 c = {0.f, 0.f, 0.f, 0.f};
                    c = __builtin_amdgcn_mfma_f32_16x16x32_bf16(kf[0][ab][0], qf[qt][0], c, 0, 0, 0);
                    c = __builtin_amdgcn_mfma_f32_16x16x32_bf16(kf[0][ab][1], qf[qt][1], c, 0, 0, 0);
                    s[qt][ab] = c;
                }
            if (cst < 7) {
#pragma unroll
                for (int ab = 0; ab < 2; ++ab) { const bf16_t* kp = Kc + ((cst + 1) * 32 + ab * 4) * 512; kf[0][ab][0] = *(const bf16x8*)(kp + lane_k); kf[0][ab][1] = *(const bf16x8*)(kp + 32 + lane_k); }
            }
#pragma unroll
            for (int qt = 0; qt < 4; ++qt) {
                float mx = -1e30f;
#pragma unroll
                for (int j = 0; j < 8; ++j) { const float t = s[qt][j >> 2][j & 3] * CS; s[qt][j >> 2][j & 3] = t; mx = fmaxf(mx, t); }
                mx = fmaxf(mx, __shfl_xor(mx, 16)); mx = fmaxf(mx, __shfl_xor(mx, 32));
                const float mn = fmaxf(m[qt], mx), corr = __builtin_amdgcn_exp2f(m[qt] - mn);
                m[qt] = mn;
#pragma unroll
                for (int d = 0; d < 4; ++d) o[qt][d] = o[qt][d] * corr;
                float pe[8];
#pragma unroll
                for (int j = 0; j < 8; ++j) pe[j] = __builtin_amdgcn_exp2f(s[qt][j >> 2][j & 3] - mn);
                l[qt] = l[qt] * corr + (((pe[0] + pe[1]) + (pe[2] + pe[3])) + ((pe[4] + pe[5]) + (pe[6] + pe[7])));
                u32x4 pw; pw[0] = pg8::cvt_pk_bf16(pe[0], pe[1]); pw[1] = pg8::cvt_pk_bf16(pe[2], pe[3]); pw[2] = pg8::cvt_pk_bf16(pe[4], pe[5]); pw[3] = pg8::cvt_pk_bf16(pe[6], pe[7]);
                const bf16x8 pf = __builtin_bit_cast(bf16x8, pw);
#pragma unroll
                for (int d = 0; d < 4; ++d) o[qt][d] = __builtin_amdgcn_mfma_f32_16x16x32_bf16(vf[d], pf, o[qt][d], 0, 0, 0);
            }
        }
#pragma unroll
        for (int qt = 0; qt < 4; ++qt) {
            float lv = l[qt]; lv += __shfl_xor(lv, 16); lv += __shfl_xor(lv, 32);
            const float inv = frcp(lv);
            bf16_t* op = Ob + qt * 16 * 512 + lane_o;
#pragma unroll
            for (int d = 0; d < 4; ++d) { u32x2 w; w[0] = pg8::cvt_pk_bf16(o[qt][d][0] * inv, o[qt][d][1] * inv); w[1] = pg8::cvt_pk_bf16(o[qt][d][2] * inv, o[qt][d][3] * inv); *(u32x2*)(op + d * 16) = w; }
        }
    }
}

typedef __bf16 bf16x2_t __attribute__((ext_vector_type(2)));
__device__ __forceinline__ float dot2bf(unsigned a, unsigned b, float c) { return __builtin_amdgcn_fdot2_f32_bf16(__builtin_bit_cast(bf16x2_t, a), __builtin_bit_cast(bf16x2_t, b), c, false); }
__device__ __forceinline__ unsigned ordkey(float f) { unsigned u = __builtin_bit_cast(unsigned, f); return u ^ ((unsigned)((int)u >> 31) | 0x80000000u); }
__device__ __forceinline__ float unordkey(unsigned k) { return __builtin_bit_cast(float, k ^ ((k & 0x80000000u) ? 0x80000000u : 0xFFFFFFFFu)); }
__device__ __forceinline__ float kmax(float a, float b) { float r; asm("v_max_f32 %0, %1, %2" : "=v"(r) : "v"(a), "v"(b)); return r; }
__device__ __forceinline__ float kmin(float a, float b) { float r; asm("v_min_f32 %0, %1, %2" : "=v"(r) : "v"(a), "v"(b)); return r; }
template <bool DESC> __device__ __forceinline__ void cex(float& a, float& b) { const float mx = kmax(a, b), mn = kmin(a, b); if (DESC) { a = mx; b = mn; } else { a = mn; b = mx; } }
__device__ __forceinline__ void sort16_desc(float (&a)[16]) {
#pragma unroll
    for (int k = 2; k <= 16; k <<= 1)
#pragma unroll
        for (int j = k >> 1; j > 0; j >>= 1)
#pragma unroll
            for (int i = 0; i < 16; ++i) { const int l = i ^ j; if (l > i) { if ((i & k) == 0) cex<true>(a[i], a[l]); else cex<false>(a[i], a[l]); } }
}
__device__ __forceinline__ void merge16_desc(float (&a)[16]) {
#pragma unroll
    for (int j = 8; j > 0; j >>= 1)
#pragma unroll
        for (int i = 0; i < 16; ++i) { const int l = i ^ j; if (l > i) cex<true>(a[i], a[l]); }
}
__device__ __forceinline__ void top16_merge(float (&a)[16], const float (&b)[16]) {
#pragma unroll
    for (int i = 0; i < 16; ++i) a[i] = kmax(a[i], b[15 - i]);
    merge16_desc(a);
}
__device__ __forceinline__ unsigned kbits(float k) { return __builtin_bit_cast(unsigned, k); }
__device__ __forceinline__ float kscore(float k) { return __builtin_bit_cast(float, __builtin_bit_cast(unsigned, k) & ~127u); }
struct PairTab { int i[52], j[52], n; };
constexpr PairTab make_pairs() { PairTab t{}; int n = 0; for (int i = 0; i < 16; ++i) for (int j = 0; j < 16; ++j) if ((i + 1) * (j + 1) <= 16) { t.i[n] = i; t.j[n] = j; ++n; } t.n = n; for (int k = n; k < 52; ++k) { t.i[k] = 0; t.j[k] = 0; } return t; }
constexpr PairTab PAIRS = make_pairs();
static_assert(PAIRS.n == 50, "50 candidate pairs");

constexpr int SK_LD = 136;
__device__ __forceinline__ void ph_peer_topk(const P& p, LAS unsigned char* lds) {
    int tid_ = threadIdx.x; asm volatile("" : "+v"(tid_));
    const int tid = tid_, wave = tid >> 6, lane = tid & 63;
    LAS bf16_t* sk = (LAS bf16_t*)lds;
    for (int e = tid; e < 2 * 128 * 16; e += NT) {
        const int row = e >> 4, c8 = (e & 15) * 8;
        const f32x4 a = *(const f32x4*)(p.subkeys + (size_t)row * 128 + c8), b = *(const f32x4*)(p.subkeys + (size_t)row * 128 + c8 + 4);
        u32x4 o; o.x = pk2(a[0], a[1]); o.y = pk2(a[2], a[3]); o.z = pk2(b[0], b[1]); o.w = pk2(b[2], b[3]);
        *(LAS u32x4*)(sk + row * SK_LD + c8) = o;
    }
    __syncthreads();
    const int lt = lane & 15, lq = lane >> 4;
    for (int tile = blockIdx.x * NWAVES + wave; tile < NTOK / 16; tile += gridDim.x * NWAVES) {
        const int tok = tile * 16 + lt;
        const bf16_t* qrow = p.qp() + (size_t)tok * 2048;
        for (int h = 0; h < 8; ++h) {
            float s0[16], s1[16];
#pragma unroll
            for (int n = 0; n < 2; ++n) {
                bf16x8 bq[4];
#pragma unroll
                for (int ks = 0; ks < 4; ++ks) bq[ks] = *(const bf16x8*)(qrow + h * 256 + n * 128 + ks * 32 + lq * 8);
                float a[16], b[16];
#pragma unroll
                for (int kb = 0; kb < 8; ++kb) {
                    f32x4 c = {0.f, 0.f, 0.f, 0.f};
#pragma unroll
                    for (int ks = 0; ks < 4; ++ks) {
                        const bf16x8 ak = *(const LAS bf16x8*)(sk + (n * 128 + kb * 16 + lt) * SK_LD + ks * 32 + lq * 8);
                        c = __builtin_amdgcn_mfma_f32_16x16x32_bf16(ak, bq[ks], c, 0, 0, 0);
                    }
#pragma unroll
                    for (int r = 0; r < 4; ++r) {
                        const float cr = c[r];
                        const float key = __builtin_bit_cast(float, (__builtin_bit_cast(unsigned, cr) & ~127u) | (unsigned)(kb * 16 + lq * 4 + r));
                        if (kb < 4) a[kb * 4 + r] = key; else b[(kb - 4) * 4 + r] = key;
                    }
                    asm volatile("" ::: "memory");
                }
                sort16_desc(a); sort16_desc(b);
                top16_merge(a, b);
#pragma unroll
                for (int i = 0; i < 16; ++i) b[i] = __shfl_xor(a[i], 16);
                top16_merge(a, b);
#pragma unroll
                for (int i = 0; i < 16; ++i) b[i] = __shfl_xor(a[i], 32);
                top16_merge(a, b);
                if (n == 0) {
#pragma unroll
                    for (int i = 0; i < 16; ++i) s0[i] = a[i];
                } else {
#pragma unroll
                    for (int i = 0; i < 16; ++i) s1[i] = a[i];
                }
            }
            float ck[16], cs[13]; unsigned ce_[13];
#pragma unroll
            for (int s = 0; s < 13; ++s) {
                const float k0 = lq == 0 ? s0[PAIRS.i[s * 4]] : (lq == 1 ? s0[PAIRS.i[s * 4 + 1]] : (lq == 2 ? s0[PAIRS.i[s * 4 + 2]] : s0[PAIRS.i[s * 4 + 3]]));
                const float k1 = lq == 0 ? s1[PAIRS.j[s * 4]] : (lq == 1 ? s1[PAIRS.j[s * 4 + 1]] : (lq == 2 ? s1[PAIRS.j[s * 4 + 2]] : s1[PAIRS.j[s * 4 + 3]]));
                const float sum = kscore(k0) + kscore(k1);
                const bool valid = (s * 4 + lq) < PAIRS.n;
                cs[s] = sum; ce_[s] = (kbits(k0) & 127u) * 128u + (kbits(k1) & 127u);
                ck[s] = valid ? __builtin_bit_cast(float, (__builtin_bit_cast(unsigned, sum) & ~63u) | (unsigned)(s * 4 + lq)) : -__builtin_inff();
            }
            ck[13] = -__builtin_inff(); ck[14] = -__builtin_inff(); ck[15] = -__builtin_inff();
            float srt[16], ob[16];
#pragma unroll
            for (int i = 0; i < 16; ++i) srt[i] = ck[i];
            sort16_desc(srt);
#pragma unroll
            for (int i = 0; i < 16; ++i) ob[i] = __shfl_xor(srt[i], 16);
            top16_merge(srt, ob);
#pragma unroll
            for (int i = 0; i < 16; ++i) ob[i] = __shfl_xor(srt[i], 32);
            float thr = __builtin_inff();
#pragma unroll
            for (int i = 0; i < 16; ++i) thr = kmin(thr, kmax(srt[i], ob[15 - i]));
            const float mtop = kscore(s0[0]) + kscore(s1[0]);
            float zp = 0.f; int cnt = 0;
#pragma unroll
            for (int s = 0; s < 13; ++s) { const bool sel = ck[s] >= thr; const float e = sel ? __expf(cs[s] - mtop) : 0.f; cs[s] = e; zp += e; cnt += sel ? 1 : 0; }
            float z = zp; z += __shfl_xor(z, 16); z += __shfl_xor(z, 32);
            const float rz = frcp(z);
            const int c0 = __shfl(cnt, lt), c1 = __shfl(cnt, lt + 16), c2 = __shfl(cnt, lt + 32);
            int pos = lq == 0 ? 0 : (lq == 1 ? c0 : (lq == 2 ? c0 + c1 : c0 + c1 + c2));
            unsigned short* dste = (unsigned short*)p.topk() + ((size_t)tok * 8 + h) * 16; float* dstg = p.gates() + ((size_t)tok * 8 + h) * 16;
#pragma unroll
            for (int s = 0; s < 13; ++s) {
                const bool sel = ck[s] >= thr;
                if (sel) { dste[pos] = (unsigned short)ce_[s]; dstg[pos] = cs[s] * rz; ++pos; }
            }
        }
    }
}

__device__ __forceinline__ unsigned xcc_id() { return (unsigned)__builtin_amdgcn_s_getreg((3 << 11) | 20) & 7u; }
__device__ __forceinline__ int q_grab(unsigned* head, int lane) { unsigned v = 0u; if (lane == 0) v = __hip_atomic_fetch_add(head, 16u, __ATOMIC_RELAXED, __HIP_MEMORY_SCOPE_AGENT); return (int)__builtin_amdgcn_readfirstlane(v); }

__device__ __forceinline__ void g_ids(const unsigned short* tkrow, unsigned lo_g16, u32x4 (&ids)[2]) {
#pragma unroll
    for (int q = 0; q < 2; ++q) ids[q] = *(const u32x4*)(tkrow + lo_g16 + q * 8);
}
__device__ __forceinline__ void g_wts(const float* wrow, unsigned lo_g16, u32x4 (&wts)[4]) {
#pragma unroll
    for (int q = 0; q < 4; ++q) wts[q] = *(const u32x4*)(wrow + lo_g16 + q * 4);
}
__device__ __forceinline__ void g_rows8(const unsigned char* tb, unsigned lo_c16, const u32x4& idh, u32x4 (&rows)[8]) {
#pragma unroll
    for (int i = 0; i < 8; ++i) {
        const unsigned w = idh[i >> 1];
        unsigned off; const unsigned k128 = 128u;
        if (i & 1) asm("v_mad_u32_u16 %0, %1, %2, %3 op_sel:[1,0,0,0]" : "=v"(off) : "v"(w), "s"(k128), "v"(lo_c16));
        else asm("v_mad_u32_u16 %0, %1, %2, %3" : "=v"(off) : "v"(w), "s"(k128), "v"(lo_c16));
        rows[i] = *(const u32x4*)(tb + off);
    }
}
typedef _Float16 f16x2 __attribute__((ext_vector_type(2)));
__device__ __forceinline__ void g_dots8_i4(const u32x4 (&uu)[8], const unsigned (&hqh)[4], const unsigned (&hql)[4], int* pd) {
#pragma unroll
    for (int i = 0; i < 8; ++i) {
        int dh = 0, dl = 0;
#pragma unroll
        for (int j = 0; j < 4; ++j) { dh = __builtin_amdgcn_sdot8((int)uu[i][j], (int)hqh[j], dh, false); dl = __builtin_amdgcn_sdot8((int)uu[i][j], (int)hql[j], dl, false); }
        pd[i] = dh * 16 + dl;
    }
}
__device__ __forceinline__ void halve16_c8(const int (&v)[16], int b4, int b2, int b1, int& o0, int& o1) {
    int r8[8], r4[4];
#pragma unroll
    for (int i = 0; i < 8; ++i) { const int keep = b4 ? v[i + 8] : v[i], send = b4 ? v[i] : v[i + 8]; r8[i] = keep + dpp_i<DPP_HMIRROR>(send); }
#pragma unroll
    for (int i = 0; i < 4; ++i) { const int keep = b2 ? r8[i + 4] : r8[i], send = b2 ? r8[i] : r8[i + 4]; r4[i] = keep + dpp_i<DPP_XOR2>(send); }
    { const int keep = b1 ? r4[2] : r4[0], send = b1 ? r4[0] : r4[2]; o0 = keep + dpp_i<DPP_XOR1>(send); }
    { const int keep = b1 ? r4[3] : r4[1], send = b1 ? r4[1] : r4[3]; o1 = keep + dpp_i<DPP_XOR1>(send); }
}
template <bool FIRST>
__device__ __forceinline__ void g_acc8q(const u32x4 (&vv)[8], const u32x4& w0, const u32x4& w1, f16x2 (&acc)[16]) {
#pragma unroll
    for (int i = 0; i < 8; ++i) {
        const unsigned wu = i < 4 ? w0[i & 3] : w1[i & 3];
        const f16x2 w = __builtin_bit_cast(f16x2, wu);
#pragma unroll
        for (int j = 0; j < 4; ++j) {
            const unsigned wv = vv[i][j];
            const f16x2 v0 = __builtin_bit_cast(f16x2, __builtin_amdgcn_cvt_scalef32_pk_f16_fp4(wv, 0.00390625f, 0)), v1 = __builtin_bit_cast(f16x2, __builtin_amdgcn_cvt_scalef32_pk_f16_fp4(wv, 0.00390625f, 1));
            const f16x2 v2 = __builtin_bit_cast(f16x2, __builtin_amdgcn_cvt_scalef32_pk_f16_fp4(wv, 0.00390625f, 2)), v3 = __builtin_bit_cast(f16x2, __builtin_amdgcn_cvt_scalef32_pk_f16_fp4(wv, 0.00390625f, 3));
            if (FIRST && i == 0) { acc[j * 4 + 0] = v0 * w; acc[j * 4 + 1] = v1 * w; acc[j * 4 + 2] = v2 * w; acc[j * 4 + 3] = v3 * w; }
            else { acc[j * 4 + 0] = __builtin_elementwise_fma(v0, w, acc[j * 4 + 0]); acc[j * 4 + 1] = __builtin_elementwise_fma(v1, w, acc[j * 4 + 1]);
                   acc[j * 4 + 2] = __builtin_elementwise_fma(v2, w, acc[j * 4 + 2]); acc[j * 4 + 3] = __builtin_elementwise_fma(v3, w, acc[j * 4 + 3]); }
        }
    }
}
__device__ __forceinline__ void halve16h(const f16x2 (&v)[16], int b1, f16x2& o0, f16x2& o1) {
    f16x2 r8[8], r4[4];
#pragma unroll
    for (int i = 0; i < 8; ++i) { const u32x2 sw = __builtin_amdgcn_permlane32_swap(__builtin_bit_cast(unsigned, v[i]), __builtin_bit_cast(unsigned, v[i + 8]), false, false);
        const unsigned s0 = sw[0], s1 = sw[1];
        r8[i] = __builtin_bit_cast(f16x2, s0) + __builtin_bit_cast(f16x2, s1); }
#pragma unroll
    for (int i = 0; i < 4; ++i) { const u32x2 sw = __builtin_amdgcn_permlane16_swap(__builtin_bit_cast(unsigned, r8[i]), __builtin_bit_cast(unsigned, r8[i + 4]), false, false);
        const unsigned s0 = sw[0], s1 = sw[1];
        r4[i] = __builtin_bit_cast(f16x2, s0) + __builtin_bit_cast(f16x2, s1); }
#pragma unroll
    for (int i = 0; i < 2; ++i) {
        const unsigned keep = __builtin_bit_cast(unsigned, b1 ? r4[i + 2] : r4[i]), send = __builtin_bit_cast(unsigned, b1 ? r4[i] : r4[i + 2]);
        const f16x2 r = __builtin_bit_cast(f16x2, keep) + __builtin_bit_cast(f16x2, (unsigned)__builtin_amdgcn_update_dpp(0, (int)send, 0x128, 0xf, 0xf, true));
        if (i == 0) o0 = r; else o1 = r;
    }
}

template <int WHICH>
__device__ __forceinline__ void ph_gather_sliced(const P& p, LAS unsigned char* lds) {
    int tid_ = threadIdx.x; asm volatile("" : "+v"(tid_));
    const int lane = tid_ & 63, c = lane & 7, g = lane >> 3;
    LAS unsigned char* wlds = lds + __builtin_amdgcn_readfirstlane(tid_ >> 6) * 8192;
    const unsigned xs = xcc_id();
    constexpr int NSL = 4, SLW = DM / NSL;
    for (unsigned tr = 0; tr < NSL; ++tr) {
        const int sl = (int)((xs + tr) & (unsigned)(NSL - 1));
        unsigned* head = p.queues() + (WHICH * 8 + sl) * 64;
        const unsigned char* tb = (WHICH == 0 ? p.pu8() : p.pv8()) + (size_t)sl * (16384 * 128);
        for (;;) {
            const int t0 = q_grab(head, lane);
            if (t0 >= NTOK) break;
            unsigned oc = c * 16, og = g * 16; asm volatile("" : "+v"(oc), "+v"(og));
            const unsigned short* idb = (const unsigned short*)p.topk() + (size_t)t0 * 128;
            const float* wb = p.wl() + (size_t)t0 * 128;
            const float* modb = p.mod() + (size_t)(t0 >> 12) * (6 * DM) + sl * SLW;
            u32x4 idc[2], idn[2], RA[8], RB[8], wc[4];
            g_ids(idb, og, idc); if (WHICH == 1) g_wts(wb, og, wc);
            g_rows8(tb, oc, idc[0], RA);
            if (WHICH == 0) {
                {
                    unsigned l4 = lane * 4; asm volatile("" : "+v"(l4));
                    const bf16_t* xg = p.x1b() + (size_t)t0 * DM + sl * SLW;
                    f32x4 A, Bs;
                    { const f32x4 gg = *(const f32x4*)(p.norm2_g + sl * SLW + l4), sh = *(const f32x4*)(modb + 3 * DM + l4), sc = *(const f32x4*)(modb + 4 * DM + l4);
#pragma unroll
                      for (int i = 0; i < 4; ++i) { A[i] = gg[i] * (1.f + sc[i]); Bs[i] = sh[i]; } }
                    const float rsl = rstd_from_fix(p.rowss()[t0 + (lane & 15)]);
                    {
                        u32x2 xw[16];
#pragma unroll
                        for (int k = 0; k < 16; ++k) xw[k] = *(const u32x2*)(xg + (size_t)k * DM + l4);
#pragma unroll
                        for (int k = 0; k < 16; ++k) {
                            const int tk = k;
                            const float rstd = __builtin_bit_cast(float, __builtin_amdgcn_readlane(__builtin_bit_cast(unsigned, rsl), tk));
                            float h[4], am = 0.f;
                            const unsigned x01 = xw[k][0], x23 = xw[k][1];
                            const float xf[4] = {bflo(x01), bfhi(x01), bflo(x23), bfhi(x23)};
#pragma unroll
                            for (int i = 0; i < 4; ++i) { h[i] = xf[i] * rstd * A[i] + Bs[i]; am = fmaxf(am, fabsf(h[i])); }
                            am = fmaxf(am, dpp_f<DPP_XOR1>(am)); am = fmaxf(am, dpp_f<DPP_XOR2>(am)); am = fmaxf(am, dpp_f<DPP_HMIRROR>(am)); am = fmaxf(am, dpp_f<DPP_ROR8>(am));
                            { const u32x2 sw = __builtin_amdgcn_permlane16_swap(__builtin_bit_cast(unsigned, am), __builtin_bit_cast(unsigned, am), false, false); const unsigned s0 = sw[0], s1 = sw[1];
                              am = fmaxf(__builtin_bit_cast(float, s0), __builtin_bit_cast(float, s1)); }
                            { const u32x2 sw = __builtin_amdgcn_permlane32_swap(__builtin_bit_cast(unsigned, am), __builtin_bit_cast(unsigned, am), false, false); const unsigned s0 = sw[0], s1 = sw[1];
                              am = fmaxf(__builtin_bit_cast(float, s0), __builtin_bit_cast(float, s1)); }
                            am = fmaxf(am, 1e-30f);
                            const float hs = 119.f * frcp(am);
                            unsigned whi = 0u, wlo = 0u;
#pragma unroll
                            for (int i = 0; i < 4; ++i) {
                                const unsigned qb = __builtin_bit_cast(unsigned, h[i] * hs + I8_MAGIC);
                                wlo |= (qb & 15u) << (4 * i);
                                whi |= (((qb + 8u) >> 4) & 15u) << (4 * i);
                            }
                            *(LAS unsigned short*)(wlds + tk * 256 + lane * 2) = (unsigned short)whi;
                            *(LAS unsigned short*)(wlds + tk * 256 + 128 + lane * 2) = (unsigned short)wlo;
                            *(LAS float*)(wlds + 4096 + tk * 4) = am * (1.f / 119.f);
                        }
                    }
                    asm volatile("s_waitcnt lgkmcnt(0)" ::: "memory");
                }
                const unsigned lo_st = og + 2 * (c & 1) + 4 * ((c >> 1) & 1) + 8 * ((c >> 2) & 1);
                float* apb = p.apart() + ((size_t)sl * NTOK + t0) * 128;
#define G1_TOKEN(tt, IDC, IDN, MORE) do { \
                    g_rows8(tb, oc, IDC[1], RB); \
                    if (MORE) g_ids(idb + ((tt) + 1) * 128, og, IDN); \
                    const u32x4 hh4 = *(const LAS u32x4*)(wlds + (tt) * 256 + oc), hl4 = *(const LAS u32x4*)(wlds + (tt) * 256 + 128 + oc); \
                    const float hinv = *(const LAS float*)(wlds + 4096 + (tt) * 4); \
                    const unsigned hqh[4] = {hh4[0], hh4[1], hh4[2], hh4[3]}, hql[4] = {hl4[0], hl4[1], hl4[2], hl4[3]}; \
                    int pd[16]; \
                    g_dots8_i4(RA, hqh, hql, pd); \
                    if (MORE) g_rows8(tb, oc, IDN[0], RA); \
                    g_dots8_i4(RB, hqh, hql, pd + 8); \
                    int o0, o1; halve16_c8(pd, c & 4, c & 2, c & 1, o0, o1); \
                    f32x2 st; st[0] = (float)o0 * hinv; st[1] = (float)o1 * hinv; \
                    *(f32x2*)(apb + (tt) * 128 + lo_st) = st; } while (0)
#pragma unroll 1
                for (int tt = 0; tt < 16; tt += 2) {
                    G1_TOKEN(tt, idc, idn, true);
                    const bool more = tt + 2 < 16;
                    G1_TOKEN(tt + 1, idn, idc, more);
                }
#undef G1_TOKEN
            } else {
                const unsigned lo_col = 2 * oc + 4 * (g & 1) + 8 * ((g >> 1) & 1) + 16 * ((g >> 2) & 1);
                bf16_t* xb = p.x1b() + (size_t)t0 * DM + sl * SLW;
                const f32x4 g2 = *(const f32x4*)(modb + 5 * DM + lo_col);
                u32x2 x1n = *(const u32x2*)(xb + lo_col);
                u32x4 wd[4];
#define G2_TOKEN(tt, IDC, IDN, WC, WN, MORE) do { \
                    g_rows8(tb, oc, IDC[1], RB); \
                    const unsigned x01 = x1n[0], x23 = x1n[1]; \
                    if (MORE) { g_ids(idb + ((tt) + 1) * 128, og, IDN); g_wts(wb + ((tt) + 1) * 128, og, WN); x1n = *(const u32x2*)(xb + (size_t)((tt) + 1) * DM + lo_col); } \
                    f16x2 acc[16]; \
                    g_acc8q<true>(RA, WC[0], WC[1], acc); \
                    if (MORE) g_rows8(tb, oc, IDN[0], RA); \
                    g_acc8q<false>(RB, WC[2], WC[3], acc); \
                    f16x2 oa, ob; halve16h(acc, g & 1, oa, ob); \
                    u32x2 x2; x2[0] = pg8::cvt_pk_bf16(bflo(x01) + g2[0] * (float)oa[0], bfhi(x01) + g2[1] * (float)oa[1]); x2[1] = pg8::cvt_pk_bf16(bflo(x23) + g2[2] * (float)ob[0], bfhi(x23) + g2[3] * (float)ob[1]); \
                    *(u32x2*)(xb + (size_t)(tt) * DM + lo_col) = x2; } while (0)
#pragma unroll 1
                for (int tt = 0; tt < 16; tt += 2) {
                    G2_TOKEN(tt, idc, idn, wc, wd, true);
                    const bool more = tt + 2 < 16;
                    G2_TOKEN(tt + 1, idn, idc, wd, wc, more);
                }
#undef G2_TOKEN
            }
        }
    }
}
__device__ __forceinline__ void ph_gather_weights(const P& p) {
    int tid_ = threadIdx.x; asm volatile("" : "+v"(tid_));
    const size_t gsz = (size_t)gridDim.x * NT;
    const float* isc = p.pisc();
    for (size_t i = (size_t)blockIdx.x * NT + tid_; i < (size_t)NTOK * 128; i += gsz) {
        const unsigned e = ((const unsigned short*)p.topk())[i]; const float gate = p.gates()[i];
        const f32x4 su = *(const f32x4*)(p.pisc_u() + (size_t)e * 4);
        float a = 0.f;
#pragma unroll
        for (int sl = 0; sl < 4; ++sl) a += p.apart()[(size_t)sl * NTOK * 128 + i] * su[sl];
        const float w = gate * isc[16384 + e] * gelu_tanh(a) * 256.f;
        const unsigned short hw = __builtin_bit_cast(unsigned short, (_Float16)w);
        ((unsigned*)p.wl())[i] = (unsigned)hw | ((unsigned)hw << 16);
    }
}
__device__ __forceinline__ void ph_final_norm(const P& p) {
    int tid_ = threadIdx.x; asm volatile("" : "+v"(tid_));
    const int wave = __builtin_amdgcn_readfirstlane(tid_ >> 6), lane = tid_ & 63;
    for (int t4 = blockIdx.x * NWAVES + wave; t4 < NTOK / 4; t4 += gridDim.x * NWAVES) {
        const u32x4* src = (const u32x4*)(p.x1b() + (size_t)t4 * 4 * DM);
        f32x4* row = (f32x4*)(p.out + (size_t)t4 * 4 * DM);
        u32x4 vw[4][2];
#pragma unroll
        for (int k = 0; k < 4; ++k)
#pragma unroll
            for (int j = 0; j < 2; ++j) vw[k][j] = src[k * (DM / 8) + lane + 64 * j];
#pragma unroll
        for (int k = 0; k < 4; ++k) {
            f32x4 v[4]; float ss = 0.f;
#pragma unroll
            for (int j = 0; j < 2; ++j) {
                const unsigned w0 = vw[k][j][0], w1 = vw[k][j][1], w2 = vw[k][j][2], w3 = vw[k][j][3];
                v[j * 2] = (f32x4){bflo(w0), bfhi(w0), bflo(w1), bfhi(w1)}; v[j * 2 + 1] = (f32x4){bflo(w2), bfhi(w2), bflo(w3), bfhi(w3)};
            }
#pragma unroll
            for (int j = 0; j < 4; ++j) ss += v[j][0] * v[j][0] + v[j][1] * v[j][1] + v[j][2] * v[j][2] + v[j][3] * v[j][3];
            ss = wave_sum(ss);
            const float rstd = rsqrtf(ss * (1.f / DM) + EPSN);
#pragma unroll
            for (int j = 0; j < 4; ++j) { const int i4 = (lane + 64 * (j >> 1)) * 2 + (j & 1); const f32x4 fg = ((const f32x4*)p.final_g)[i4]; row[k * (DM / 4) + i4] = v[j] * rstd * fg; }
        }
    }
}

#define XB_TMO      128
#define XB_XCNT(j)  (256  + 64 * (j))
#define XB_XSUB(j)  (1280 + 64 * (j))
#define XB_XGEN(j)  (2304 + 64 * (j))
#define XB_TOP      3328
#define XB_TOPGEN   3392
#define XCD_BAR_WORDS 3456
#define XB_SPIN_CAP (1u << 18)
__device__ __forceinline__ unsigned xb_ld(unsigned* p)              { return __hip_atomic_load(p, __ATOMIC_RELAXED, __HIP_MEMORY_SCOPE_AGENT); }
__device__ __forceinline__ unsigned xb_add(unsigned* p, unsigned v) { return __hip_atomic_fetch_add(p, v, __ATOMIC_RELAXED, __HIP_MEMORY_SCOPE_AGENT); }
__device__ __forceinline__ unsigned xb_xcc_id() { return (unsigned)__builtin_amdgcn_s_getreg((3 << 11) | 20) & 0xFu; }
#define XB_SPIN(cond, bar) do { unsigned _sp = 0; while (cond) { __builtin_amdgcn_s_sleep(1); \
    if ((++_sp & 255u) == 0u) { if (xb_ld(&(bar)[XB_TMO])) break; if (_sp > XB_SPIN_CAP) { atomicAdd(&(bar)[XB_TMO], 1u); break; } } } } while (0)
struct XcdBarrier { unsigned* bar; unsigned x; volatile LAS unsigned* st; };
__device__ __forceinline__ XcdBarrier xcd_barrier_post(unsigned* bar, volatile LAS unsigned* st) {
    XcdBarrier b; b.bar = bar; b.x = xb_xcc_id(); b.st = st;
    if (threadIdx.x == 0) (void)xb_add(&bar[XB_XCNT(b.x)], 1u);
    return b;
}
__device__ __forceinline__ void xcd_barrier_complete(unsigned* bar, unsigned x, unsigned& nloc, unsigned& nx) {
    const unsigned G = gridDim.x * gridDim.y * gridDim.z;
    unsigned sum, cnt, mine, sp = 0u;
    for (;;) {
        sum = 0u; cnt = 0u; mine = 0u;
#pragma unroll
        for (unsigned j = 0; j < 16; ++j) { const unsigned c = xb_ld(&bar[XB_XCNT(j)]); sum += c; cnt += (c > 0u) ? 1u : 0u; mine = (j == x) ? c : mine; }
        if (sum == G) break;
        __builtin_amdgcn_s_sleep(1);
        if ((++sp & 255u) == 0u) { if (xb_ld(&bar[XB_TMO])) break; if (sp > XB_SPIN_CAP) { atomicAdd(&bar[XB_TMO], 1u); break; } }
    }
    nloc = mine > 0u ? mine : 1u; nx = cnt > 0u ? cnt : 1u;
}
__device__ __forceinline__ void xcd_barrier(const XcdBarrier& b) {
    asm volatile("s_waitcnt vmcnt(0)" ::: "memory");
    __syncthreads();
    if (threadIdx.x == 0) {
        unsigned* bar = b.bar;
        __builtin_amdgcn_s_waitcnt(0);
        unsigned nloc = b.st[0], nx = b.st[1];
        if (nloc == 0u) { xcd_barrier_complete(bar, b.x, nloc, nx); b.st[0] = nloc; b.st[1] = nx; }
        const unsigned old = xb_add(&bar[XB_XSUB(b.x)], 1u);
        const unsigned gen = old / nloc;
        if (old + 1u == (gen + 1u) * nloc) {
            __builtin_amdgcn_fence(__ATOMIC_RELEASE, "agent");
            asm volatile("s_waitcnt vmcnt(0)" ::: "memory");
            const unsigned og = xb_add(&bar[XB_TOP], 1u);
            const unsigned tg = og / nx;
            if (og + 1u == (tg + 1u) * nx) xb_add(&bar[XB_TOPGEN], 1u);
            else XB_SPIN(xb_ld(&bar[XB_TOPGEN]) == tg, bar);
            __builtin_amdgcn_fence(__ATOMIC_ACQUIRE, "agent");
            xb_add(&bar[XB_XGEN(b.x)], 1u);
            asm volatile("s_waitcnt vmcnt(0)" ::: "memory");
        } else {
            XB_SPIN(xb_ld(&bar[XB_XGEN(b.x)]) == gen, bar);
            __builtin_amdgcn_fence(__ATOMIC_ACQUIRE, "agent");
            asm volatile("s_waitcnt vmcnt(0)" ::: "memory");
        }
    }
    __syncthreads();
}

constexpr int LDS_BYTES = 147456;
#define GSYNC() xcd_barrier(xbar)
constexpr int MISC_OFF = LDS_BYTES - 64;

__global__ void __launch_bounds__(NT, 2) mega(P p) {
    extern __shared__ __attribute__((aligned(16))) unsigned char lds_raw[];
    LAS unsigned char* lds = (LAS unsigned char*)lds_raw;
    const int G = gridDim.x, bx = blockIdx.x;
    using namespace pg8;
    if (threadIdx.x < 16) ((LAS unsigned*)(lds + MISC_OFF))[threadIdx.x] = 0u;
    for (unsigned i = (unsigned)bx * NT + threadIdx.x; i < (1u << 20) / 8u; i += (unsigned)G * NT) ((unsigned long long*)p.ws)[i] = 0ull;
    cg::this_grid().sync();
    const XcdBarrier xbar = xcd_barrier_post((unsigned*)p.ws, (volatile LAS unsigned*)(lds + MISC_OFF));

    ph_prep(p, lds);
    GSYNC();
    ph_norm1(p, lds);
    GSYNC();
    {
        Gemm<DM / 2, DM / 2, DM / 2, 0, 0, true> g{p.hx(), p.w_in_t()}; StaticOrder<NTOK, INC> S; S.init(G, bx);
        EpiInProj E{p.U(), p.kb(), (size_t)(p.qb() - p.kb()), p.vT(), p.ga(), 0};
        gemm_phase<EpiInProj, StaticOrder<NTOK, INC>, true, true>(lds, g, S, E);
        Gemm<DM / 2, DM / 2, DM / 2, 0, 0, true> g2{p.hc(), p.w_in_t()}; StaticOrder<NCTX, CTXC> S2; S2.init(G, bx);
        EpiInProj E2{p.U(), p.kc(), 0, p.vcT(), p.ga(), 1};
        gemm_phase<EpiInProj, StaticOrder<NCTX, CTXC>, true, true>(lds, g2, S2, E2);
    }
    for (int it = bx - 48; it >= 0 && it < 128; it += G) ssm_prep_item(p, lds, it);
    for (int cb = bx - 176; cb >= 0 && cb < 32; cb += G) {
        const float* m3 = p.mod() + 3 * DM;
        const float* const rows[8] = {m3, m3 + 6 * DM, m3 + 12 * DM, m3 + 18 * DM, m3 + 24 * DM, m3 + 30 * DM, m3 + 36 * DM, m3 + 42 * DM};
        gemv_block64<8, false>(rows, p.w_q, 2048, cb * 64, nullptr, p.c2(), 2048, (LAS float*)lds);
    }
    bg_convert_tables(p);
    GSYNC();
    {
        Gemm<512, SSM_LD, 512, (long)SSM_ROWS * SSM_LD, 256L * 512> g{p.U(), p.Win()}; StaticOrder<SSM_ROWS, 256, 32> S; S.init(G, bx);
        EpiE E{p.E()};
        gemm_phase<EpiE, StaticOrder<SSM_ROWS, 256, 32>, true, true>(lds, g, S, E);
    }
    GSYNC();
    ph_carry(p);
    ph_na(p, lds);
    GSYNC();
    {
        Gemm<SSM_LD, SSM_LD, SSM_LD, (long)SSM_ROWS * SSM_LD, 512L * SSM_LD> g{p.U(), p.Kmat()}; StaticOrder<1024, 512, 32> S; S.init(G, bx);
        EpiZ E{p.z()};
        gemm_phase<EpiZ, StaticOrder<1024, 512, 32>, true, true>(lds, g, S, E);
    }
    GSYNC();
    {
        Gemm<512, 512, 512> g{p.z(), p.w_glu_t()}; StaticOrder<NTOK, 512> S; S.init(G, bx);
        EpiGlu E{p.gl(), p.z(), p.b_glu};
        gemm_phase<EpiGlu, StaticOrder<NTOK, 512>, true, true>(lds, g, S, E);
    }
    GSYNC();
    {
        Gemm<512, 512, 512, 32L * 1024 * 1024, 512L * 1024> g{p.na(), p.w_b_t()}; PairOrder<NTOK, DM> S; S.init(G, bx);
        EpiMerge E{p.merged(), p.ga(), p.gb()};
        gemm_phase<EpiMerge, PairOrder<NTOK, DM>, true, true>(lds, g, S, E);
    }
    GSYNC();
    {
        Gemm<DM, DM, DM> g{p.merged(), p.w_out_t()}; StaticOrder<NTOK, DM> S; S.init(G, bx);
        EpiOut E{p.x, p.x1b(), p.x1g(), p.mod(), p.norm2_g, p.rowss()};
        gemm_phase<EpiOut, StaticOrder<NTOK, DM>, true, true>(lds, g, S, E);
    }
    GSYNC();
    {
        Gemm<DM, DM, DM> g{p.x1g(), p.w_q_t()}; StaticOrder<NTOK, 2048> S; S.init(G, bx);
        EpiQ E{p.qp(), p.rowss(), p.c2()};
        gemm_phase<EpiQ, StaticOrder<NTOK, 2048>, true, true>(lds, g, S, E);
    }
    GSYNC();
    ph_peer_topk(p, lds);
    GSYNC();
    ph_gather_sliced<0>(p, lds);
    GSYNC();
    ph_gather_weights(p);
    GSYNC();
    ph_gather_sliced<1>(p, lds);
    GSYNC();
    ph_final_norm(p);
}

extern "C" void kernel_launch(void* const* d_in, const int* in_sizes, int n_in, void* d_out, int out_size, void* d_ws, size_t ws_size, hipStream_t stream) {
    static int grid = 0;
    if (grid == 0) {
        int dev = 0, cus = 0, per_cu = 0;
        (void)hipGetDevice(&dev);
        (void)hipDeviceGetAttribute(&cus, hipDeviceAttributeMultiprocessorCount, dev);
        (void)hipFuncSetAttribute((const void*)mega, hipFuncAttributeMaxDynamicSharedMemorySize, LDS_BYTES);
        (void)hipOccupancyMaxActiveBlocksPerMultiprocessor(&per_cu, (const void*)mega, NT, LDS_BYTES);
        if (per_cu < 1) { fprintf(stderr, "occupancy query says %d blocks per CU\n", per_cu); per_cu = 1; }
        grid = cus;
    }
    P p{};
    const float* const* in = (const float* const*)d_in;
    p.x = in[0]; p.c = in[1]; p.ctx = in[2]; p.c_ctx = in[3]; p.w_mod = in[4]; p.b_mod = in[5]; p.norm1_g = in[6]; p.norm2_g = in[7]; p.w_in = in[8];
    p.a_re = in[9]; p.a_im = in[10]; p.log_dt = in[11]; p.b_re = in[12]; p.b_im = in[13]; p.c_re = in[14]; p.c_im = in[15]; p.ssm_d = in[16];
    p.w_glu = in[17]; p.b_glu = in[18]; p.w_a = in[19]; p.w_b = in[20]; p.rpb = in[21]; p.w_out = in[22]; p.w_q = in[23]; p.subkeys = in[24];
    p.peer_u = in[25]; p.peer_v = in[26]; p.final_g = in[27];
    p.out = (float*)d_out;
    p.ws = (unsigned char*)d_ws;
    void* args[] = {&p};
    hipError_t e = hipLaunchCooperativeKernel((const void*)mega, dim3(grid), dim3(NT), args, LDS_BYTES, stream);
    if (e != hipSuccess) fprintf(stderr, "cooperative launch failed: %s (grid %d)\n", hipGetErrorString(e), grid);
}
```

```cpp
#include <hip/hip_runtime.h>
#include <hip/hip_cooperative_groups.h>
#include <cstdio>
#include <cstdint>
namespace cg = cooperative_groups;

#define LAS __attribute__((address_space(3)))
typedef unsigned short bf16_t;
typedef short bf16x8 __attribute__((ext_vector_type(8)));
typedef float f32x4 __attribute__((ext_vector_type(4)));
typedef float f32x2 __attribute__((ext_vector_type(2)));
typedef unsigned u32x4 __attribute__((ext_vector_type(4)));
typedef unsigned u32x2 __attribute__((ext_vector_type(2)));

constexpr int DM = 1024, NB = 8, SEQL = 4096, CTXL = 256, GW = 64, NTOK = NB * SEQL, NCTX = NB * CTXL;
constexpr int INC = 4096, CTXC = 1536;
constexpr int NT = 512, NWAVES = 8;
constexpr float EPSN = 1e-6f;
constexpr int SSM_ROWS = 1280;
constexpr int SSM_LD = 768;

__device__ __forceinline__ unsigned f2bf(float f) { unsigned u = __builtin_bit_cast(unsigned, f); return (u + 0x7fffu + ((u >> 16) & 1u)) >> 16; }
__device__ __forceinline__ unsigned pk2(float lo, float hi) { return f2bf(lo) | (f2bf(hi) << 16); }
__device__ __forceinline__ float bflo(unsigned w) { return __builtin_bit_cast(float, w << 16); }
__device__ __forceinline__ float bfhi(unsigned w) { return __builtin_bit_cast(float, w & 0xffff0000u); }
__device__ __forceinline__ float bf2f(bf16_t h) { return __builtin_bit_cast(float, (unsigned)h << 16); }

__device__ __forceinline__ float wave_sum(float v) {
#pragma unroll
    for (int o = 1; o < 64; o <<= 1) v += __shfl_xor(v, o);
    return v;
}
__device__ __forceinline__ float wave_max(float v) {
#pragma unroll
    for (int o = 1; o < 64; o <<= 1) v = fmaxf(v, __shfl_xor(v, o));
    return v;
}
__device__ __forceinline__ float frcp(float x) { return __builtin_amdgcn_rcpf(x); }
__device__ __forceinline__ float sigmoidf_(float x) { return frcp(1.f + __expf(-x)); }
__device__ __forceinline__ float siluf_(float x) { return x * frcp(1.f + __expf(-x)); }
__device__ __forceinline__ float gelu_tanh(float x) {
    const float k0 = 0.7978845608028654f, k1 = 0.044715f;
    const float u = k0 * (x + k1 * x * x * x);
    const float t = 1.f - 2.f * frcp(1.f + __expf(2.f * u));
    return 0.5f * x * (1.f + t);
}

namespace pg8 {
#define PG8_LAS __attribute__((address_space(3)))
constexpr int BM = 256, BK = 64, HALF = 128, HTB = HALF * BK * 2  , STAGE_BYTES = 8 * HTB, NXCD = 8, WGM = 8;
__host__ __device__ __forceinline__ int lds_byte(int r, int c) { const int st = (r >> 4) * 2 + (c >> 5), rr = r & 15, cc = c & 31, ob = rr * 64 + cc * 2; return st * 1024 + (ob ^ (((ob >> 9) & 1) << 5)); }
__host__ __device__ __forceinline__ void stage_rc(int b, int& R, int& C) { const int st = b / 1024, sb = b % 1024, swz = sb ^ (((sb >> 9) & 1) << 5); R = (st >> 1) * 16 + swz / 64; C = (st & 1) * 32 + (swz % 64) / 2; }
__host__ __device__ __forceinline__ int perm32(int rho) { const int n = rho >> 4, i = rho & 15; return 8 * (i >> 2) + 4 * n + (i & 3); }

struct Unit { int pm, pn, g; };
template <int K_, int LDA, int LDB, long GSA = 0, long GSB = 0, bool FP8_ = false>
struct Gemm {
    const bf16_t* A; const bf16_t* Bt;
    static constexpr int K = K_, lda = LDA, ldb = LDB; static constexpr bool FP8 = FP8_;
    __device__ __forceinline__ const char* abase(const Unit& u) const { return (const char*)(A + (size_t)u.g * GSA + (size_t)u.pm * BM * LDA); }
    __device__ __forceinline__ const char* bbase(const Unit& u) const { return (const char*)(Bt + (size_t)u.g * GSB + (size_t)u.pn * BM * LDB); }
};
template <int M, int N, int NGRP = 1>
struct StaticOrder {
    static constexpr int nM = M / BM, nN = N / BM, nwg = nM * nN;
    int G, c;
    __device__ void init(int G_, int c_) { G = G_; c = c_; }
    __device__ bool next(int i, Unit& u) const {
        const int L = i * G + c; if (L >= nwg * NGRP) return false;
        u.g = L / nwg;
        int wgid = L % nwg; { constexpr int q = nwg / NXCD, r = nwg % NXCD; const int xcd = wgid % NXCD, off = wgid / NXCD; wgid = (xcd < r ? xcd * (q + 1) : r * (q + 1) + (xcd - r) * q) + off; }
        constexpr int nig = WGM * nN; const int gid = wgid / nig, fm = gid * WGM, gsz = (nM - fm) < WGM ? (nM - fm) : WGM;
        u.pm = fm + ((wgid % nig) % gsz); u.pn = (wgid % nig) / gsz; return true;
    }
    __device__ __forceinline__ void a_ready(const Unit&) const {}
    __device__ __forceinline__ void done(const Unit&) const {}
};
__device__ __forceinline__ unsigned cvt_pk_bf16(float lo, float hi) { unsigned r; asm volatile("v_cvt_pk_bf16_f32 %0, %1, %2" : "=v"(r) : "v"(lo), "v"(hi)); return r; }
typedef long i64x2 __attribute__((ext_vector_type(2)));
template <class Epi, class Sched, bool ALIGN_EPI = false, bool SP2 = false, class GemmT>
__device__ __forceinline__ void gemm_phase(PG8_LAS unsigned char* lds, const GemmT g, const Sched& S, const Epi& E) {
    int tid_ = threadIdx.x; asm volatile("" : "+v"(tid_));
    const int tid = tid_, wid = __builtin_amdgcn_readfirstlane(tid >> 6), lane = tid & 63, wr = wid >> 2, wc = wid & 3, fr = lane & 15, fq = lane >> 4;
    const int K = g.K, nt = K / BK;
    unsigned voffA[2], voffB[2];
#pragma unroll
    for (int i = 0; i < 2; ++i) { int R, C; stage_rc(tid * 16 + i * 8192, R, C); const int Rb = Epi::PERM ? ((R & ~31) + perm32(R & 31)) : R;
        voffA[i] = (unsigned)(R * g.lda + C) * 2u; voffB[i] = (unsigned)(Rb * g.ldb + C) * 2u; }
    const size_t kstep = (size_t)(BK * 2);
    const size_t hstepA = (size_t)HALF * g.lda * 2, hstepB = (size_t)HALF * g.ldb * 2;
    const unsigned ldsw = (unsigned)wid * 1024u;
    const int aoff = lds_byte(wr * 64 + fr, fq * 8), boff = lds_byte(wc * 32 + fr, fq * 8);
#define PG8_SA(b, h) (((b) * 2 + (h)) * HTB)
#define PG8_SB(b, h) ((4 + (b) * 2 + (h)) * HTB)
#define PG8_STAGE(bufoff, gbase, voff) do { _Pragma("unroll") for (int _i = 0; _i < 2; ++_i) \
        __builtin_amdgcn_global_load_lds((const unsigned*)((const char*)(gbase) + (voff)[_i]), (PG8_LAS unsigned*)(lds + (bufoff) + ldsw + _i * 8192), 16, 0, 0); } while (0)
#define PG8_LDA(dst, b, h) do { _Pragma("unroll") for (int m = 0; m < 4; ++m) _Pragma("unroll") for (int k = 0; k < 2; ++k) dst[m][k] = *(const PG8_LAS bf16x8*)(lds + PG8_SA(b, h) + aoff + m * 2048 + k * 1024); } while (0)
#define PG8_LDB(dst, b, h) do { _Pragma("unroll") for (int n = 0; n < 2; ++n) _Pragma("unroll") for (int k = 0; k < 2; ++k) dst[n][k] = *(const PG8_LAS bf16x8*)(lds + PG8_SB(b, h) + boff + n * 2048 + k * 1024); } while (0)
#define PG8_MMA(ai, bj, At, Bt) do { __builtin_amdgcn_s_setprio(1); _Pragma("unroll") for (int m = 0; m < 4; ++m) _Pragma("unroll") for (int n = 0; n < 2; ++n) _Pragma("unroll") for (int k = 0; k < 2; ++k) { \
        if constexpr (GemmT::FP8) { const i64x2 b2_ = __builtin_bit_cast(i64x2, Bt[n][k]), a2_ = __builtin_bit_cast(i64x2, At[m][k]); const long bl_ = b2_[0], bh_ = b2_[1], al_ = a2_[0], ah_ = a2_[1]; \
            acc[ai][bj][m][n] = __builtin_amdgcn_mfma_f32_16x16x32_fp8_fp8(bl_, al_, acc[ai][bj][m][n], 0, 0, 0); acc[ai][bj][m][n] = __builtin_amdgcn_mfma_f32_16x16x32_fp8_fp8(bh_, ah_, acc[ai][bj][m][n], 0, 0, 0); } \
        else acc[ai][bj][m][n] = __builtin_amdgcn_mfma_f32_16x16x32_bf16(Bt[n][k], At[m][k], acc[ai][bj][m][n], 0, 0, 0); } __builtin_amdgcn_s_setprio(0); } while (0)
#define PG8_WAIT_V(n) asm volatile("s_waitcnt vmcnt(" #n ")" ::: "memory")
#define PG8_WAIT_L(n) asm volatile("s_waitcnt lgkmcnt(" #n ")" ::: "memory")
#define PG8_BAR __builtin_amdgcn_s_barrier()
#define PG8_SCHED __builtin_amdgcn_sched_barrier(0)
    Unit cur, nxt; int ui = 0;
    if (!S.next(0, cur)) return;
    f32x4 acc[2][2][4][2];
#pragma unroll
    for (int a = 0; a < 2; ++a)
#pragma unroll
        for (int b = 0; b < 2; ++b)
#pragma unroll
            for (int m = 0; m < 4; ++m)
#pragma unroll
                for (int n = 0; n < 2; ++n) acc[a][b][m][n] = (f32x4){0.f, 0.f, 0.f, 0.f};
    bf16x8 At[4][2], B0[2][2], B1[2][2];
    const char* cA = g.abase(cur); const char* cB = g.bbase(cur);
    S.a_ready(cur);
    if constexpr (SP2) {
        PG8_STAGE(PG8_SB(0, 0), cB, voffB); PG8_STAGE(PG8_SB(0, 1), cB + hstepB, voffB); PG8_STAGE(PG8_SA(0, 0), cA, voffA); PG8_STAGE(PG8_SA(0, 1), cA + hstepA, voffA);
        if (wr == 1) PG8_BAR;
        PG8_WAIT_V(2); PG8_BAR;
        PG8_STAGE(PG8_SB(1, 0), cB + kstep, voffB); PG8_STAGE(PG8_SA(1, 0), cA + kstep, voffA); PG8_STAGE(PG8_SB(1, 1), cB + hstepB + kstep, voffB);
        PG8_WAIT_V(6); PG8_BAR;
    } else {
        PG8_STAGE(PG8_SB(0, 0), cB, voffB); PG8_STAGE(PG8_SA(0, 0), cA, voffA); PG8_STAGE(PG8_SB(0, 1), cB + hstepB, voffB); PG8_STAGE(PG8_SA(0, 1), cA + hstepA, voffA);
        if (wr == 1) PG8_BAR;
        PG8_WAIT_V(4); PG8_BAR;
        PG8_STAGE(PG8_SB(1, 0), cB + kstep, voffB); PG8_STAGE(PG8_SA(1, 0), cA + kstep, voffA); PG8_STAGE(PG8_SB(1, 1), cB + hstepB + kstep, voffB);
        PG8_WAIT_V(6); PG8_BAR;
    }
    for (;;) {
        const bool has_next = S.next(ui + 1, nxt);
        const char* nA = has_next ? g.abase(nxt) : cA; const char* nB = has_next ? g.bbase(nxt) : cB;
        for (int t = 0; t < nt; t += 2) {
            const bool last = (t == nt - 2);
            const char* a1 = cA + (size_t)(t + 1) * kstep;
            const char* a2 = last ? nA : cA + (size_t)(t + 2) * kstep; const char* b2 = last ? nB : cB + (size_t)(t + 2) * kstep;
            const char* a3 = a2 + kstep; const char* b3 = b2 + kstep;
            if (last && has_next) S.a_ready(nxt);
            if constexpr (SP2) {
            PG8_LDB(B0, 0, 0); PG8_LDB(B1, 0, 1); PG8_SCHED; PG8_LDA(At, 0, 0); PG8_STAGE(PG8_SA(1, 1), a1 + hstepA, voffA);
            PG8_WAIT_V(8); PG8_WAIT_L(0); PG8_BAR; PG8_MMA(0, 0, At, B0); PG8_MMA(0, 1, At, B1); PG8_BAR; PG8_SCHED;
            PG8_LDA(At, 0, 1); PG8_STAGE(PG8_SB(0, 0), b2, voffB); PG8_STAGE(PG8_SB(0, 1), b2 + hstepB, voffB); PG8_STAGE(PG8_SA(0, 0), a2, voffA);
            PG8_WAIT_V(8); PG8_WAIT_L(0); PG8_BAR; PG8_MMA(1, 0, At, B0); PG8_MMA(1, 1, At, B1); PG8_BAR; PG8_SCHED;
            PG8_LDB(B0, 1, 0); PG8_LDB(B1, 1, 1); PG8_SCHED; PG8_LDA(At, 1, 0); PG8_STAGE(PG8_SA(0, 1), a2 + hstepA, voffA);
            PG8_WAIT_V(8); PG8_WAIT_L(0); PG8_BAR; PG8_MMA(0, 0, At, B0); PG8_MMA(0, 1, At, B1); PG8_BAR; PG8_SCHED;
            PG8_LDA(At, 1, 1); PG8_STAGE(PG8_SB(1, 0), b3, voffB); PG8_STAGE(PG8_SB(1, 1), b3 + hstepB, voffB); PG8_STAGE(PG8_SA(1, 0), a3, voffA);
            PG8_WAIT_V(8); PG8_WAIT_L(0); PG8_BAR; PG8_MMA(1, 0, At, B0); PG8_MMA(1, 1, At, B1); PG8_BAR; PG8_SCHED;
            } else {
            PG8_LDB(B0, 0, 0); PG8_SCHED; PG8_LDA(At, 0, 0); PG8_STAGE(PG8_SA(1, 1), a1 + hstepA, voffA);
            PG8_WAIT_L(8); PG8_BAR; PG8_WAIT_L(0); PG8_MMA(0, 0, At, B0); PG8_BAR; PG8_SCHED;
            PG8_LDB(B1, 0, 1); PG8_STAGE(PG8_SB(0, 0), b2, voffB);
            PG8_BAR; PG8_WAIT_L(0); PG8_MMA(0, 1, At, B1); PG8_BAR;
            PG8_LDA(At, 0, 1); PG8_STAGE(PG8_SA(0, 0), a2, voffA);
            PG8_BAR; PG8_WAIT_L(0); PG8_MMA(1, 0, At, B0); PG8_BAR; PG8_SCHED;
            PG8_STAGE(PG8_SB(0, 1), b2 + hstepB, voffB);
            PG8_WAIT_V(6); PG8_BAR; PG8_MMA(1, 1, At, B1); PG8_BAR;
            PG8_LDB(B0, 1, 0); PG8_SCHED; PG8_LDA(At, 1, 0); PG8_STAGE(PG8_SA(0, 1), a2 + hstepA, voffA);
            PG8_WAIT_L(8); PG8_BAR; PG8_WAIT_L(0); PG8_MMA(0, 0, At, B0); PG8_BAR; PG8_SCHED;
            PG8_LDB(B1, 1, 1); PG8_STAGE(PG8_SB(1, 0), b3, voffB);
            PG8_BAR; PG8_WAIT_L(0); PG8_MMA(0, 1, At, B1); PG8_BAR;
            PG8_LDA(At, 1, 1); PG8_STAGE(PG8_SA(1, 0), a3, voffA);
            PG8_BAR; PG8_WAIT_L(0); PG8_MMA(1, 0, At, B0); PG8_BAR; PG8_SCHED;
            PG8_STAGE(PG8_SB(1, 1), b3 + hstepB, voffB);
            PG8_WAIT_V(6); PG8_BAR; PG8_MMA(1, 1, At, B1); PG8_BAR;
            }
        }
        if constexpr (ALIGN_EPI) { if (wr == 0) PG8_BAR; }
        if constexpr (!Epi::AFTER_DRAIN) { E(acc, cur, wr, wc, fr, fq); S.done(cur); }
        if (!has_next) break;
        if (!E.keep(cur)) {
#pragma unroll
        for (int a = 0; a < 2; ++a)
#pragma unroll
            for (int b = 0; b < 2; ++b)
#pragma unroll
                for (int m = 0; m < 4; ++m)
#pragma unroll
                    for (int n = 0; n < 2; ++n) acc[a][b][m][n] = (f32x4){0.f, 0.f, 0.f, 0.f};
        }
        cur = nxt; cA = nA; cB = nB; ++ui;
        if constexpr (ALIGN_EPI) { if (wr == 1) PG8_BAR; }
    }
    PG8_WAIT_V(0);
    if constexpr (!ALIGN_EPI) { if (wr == 0) PG8_BAR; }
    PG8_BAR;
    if constexpr (Epi::AFTER_DRAIN) { E.fused(acc, cur, wr, wc, fr, fq, lds, wid, lane); S.done(cur); }
#undef PG8_SA
#undef PG8_SB
#undef PG8_STAGE
#undef PG8_LDA
#undef PG8_LDB
#undef PG8_MMA
#undef PG8_WAIT_V
#undef PG8_WAIT_L
#undef PG8_BAR
#undef PG8_SCHED
}
}

constexpr size_t MiB = 1u << 20;
struct P {
    const float *x, *c, *ctx, *c_ctx, *w_mod, *b_mod, *norm1_g, *norm2_g, *w_in;
    const float *a_re, *a_im, *log_dt, *b_re, *b_im, *c_re, *c_im, *ssm_d;
    const float *w_glu, *b_glu, *w_a, *w_b, *rpb, *w_out, *w_q, *subkeys, *peer_u, *peer_v, *final_g;
    float* out;
    unsigned char* ws;
    __device__ __forceinline__ unsigned long long* rowss() const { return (unsigned long long*)(ws + 512 * 1024); }
    __device__ __forceinline__ float* mod() const { return (float*)(ws + 1 * MiB); }
    __device__ __forceinline__ float* c2() const { return (float*)(ws + 1 * MiB + 256 * 1024); }
    __device__ __forceinline__ bf16_t* w_in_t() const { return (bf16_t*)(ws + 3 * MiB); }
    __device__ __forceinline__ bf16_t* w_glu_t() const { return (bf16_t*)(ws + 11 * MiB); }
    __device__ __forceinline__ bf16_t* w_b_t() const { return (bf16_t*)(ws + 12 * MiB); }
    __device__ __forceinline__ bf16_t* w_a_t() const { return (bf16_t*)(ws + 13 * MiB); }
    __device__ __forceinline__ bf16_t* w_out_t() const { return (bf16_t*)(ws + 14 * MiB); }
    __device__ __forceinline__ bf16_t* w_q_t() const { return (bf16_t*)(ws + 16 * MiB); }
    __device__ __forceinline__ bf16_t* Kmat() const { return (bf16_t*)(ws + 21 * MiB); }
    __device__ __forceinline__ bf16_t* Win() const { return (bf16_t*)(ws + 45 * MiB); }
    __device__ __forceinline__ float* lamT() const { return (float*)(ws + 53 * MiB); }
    __device__ __forceinline__ unsigned char* pu8() const { return ws + 54 * MiB; }
    __device__ __forceinline__ unsigned char* pv8() const { return ws + 70 * MiB; }
    __device__ __forceinline__ float* pisc() const { return (float*)(ws + 53 * MiB + 128 * 1024); }
    __device__ __forceinline__ float* pisc_u() const { return (float*)(ws + 53 * MiB + 256 * 1024); }
    __device__ __forceinline__ bf16_t* ga() const { return (bf16_t*)(ws + 118 * MiB); }
    __device__ __forceinline__ bf16_t* gb() const { return (bf16_t*)(ws + 182 * MiB); }
    __device__ __forceinline__ bf16_t* x1g() const { return (bf16_t*)(ws + 118 * MiB); }
    __device__ __forceinline__ unsigned* topk() const { return (unsigned*)(ws + 182 * MiB); }
    __device__ __forceinline__ float* gates() const { return (float*)(ws + 198 * MiB); }
    __device__ __forceinline__ bf16_t* kb() const { return (bf16_t*)(ws + 246 * MiB); }
    __device__ __forceinline__ bf16_t* vT() const { return (bf16_t*)(ws + 278 * MiB); }
    __device__ __forceinline__ bf16_t* qb() const { return (bf16_t*)(ws + 310 * MiB); }
    __device__ __forceinline__ bf16_t* kc() const { return (bf16_t*)(ws + 342 * MiB); }
    __device__ __forceinline__ bf16_t* vcT() const { return (bf16_t*)(ws + 344 * MiB); }
    __device__ __forceinline__ bf16_t* U() const { return (bf16_t*)(ws + 346 * MiB); }
    __device__ __forceinline__ float* E() const { return (float*)(ws + 406 * MiB); }
    __device__ __forceinline__ bf16_t* merged() const { return (bf16_t*)(ws + 246 * MiB); }
    __device__ __forceinline__ bf16_t* qp() const { return (bf16_t*)(ws + 246 * MiB); }
    __device__ __forceinline__ float* apart() const { return (float*)(ws + 246 * MiB); }
    __device__ __forceinline__ float* wl() const { return (float*)(ws + 374 * MiB); }
    __device__ __forceinline__ float* ss2() const { return (float*)(ws + 406 * MiB); }
    __device__ __forceinline__ bf16_t* x1b() const { return (bf16_t*)(ws + 406 * MiB); }
    __device__ __forceinline__ unsigned* queues() const { return (unsigned*)(ws + 64 * 1024); }
    __device__ __forceinline__ bf16_t* hx() const { return (bf16_t*)out; }
    __device__ __forceinline__ bf16_t* hc() const { return (bf16_t*)((unsigned char*)out + 64 * MiB); }
    __device__ __forceinline__ bf16_t* na() const { return (bf16_t*)out; }
    __device__ __forceinline__ bf16_t* z() const { return (bf16_t*)((unsigned char*)out + 32 * MiB); }
    __device__ __forceinline__ bf16_t* gl() const { return (bf16_t*)((unsigned char*)out + 64 * MiB); }
};

constexpr float SS_FIX = 1099511627776.f, SS_UNFIX = 1.f / 1099511627776.f;
__device__ __forceinline__ float rstd_from_fix(unsigned long long v) { return rsqrtf((float)v * (SS_UNFIX / DM) + EPSN); }
constexpr float ACT8 = 8.f;
constexpr float WIN_SCALE = 32.f;
__device__ __forceinline__ unsigned pk4_fp8(float a, float b, float c, float d) { int w = 0; w = __builtin_amdgcn_cvt_pk_fp8_f32(a, b, w, false); w = __builtin_amdgcn_cvt_pk_fp8_f32(c, d, w, true); return (unsigned)w; }
namespace pg8 {
struct EpiInProj {
    static constexpr bool PERM = true, AFTER_DRAIN = false;
    __device__ __forceinline__ bool keep(const Unit&) const { return false; }
    bf16_t* U; bf16_t* d_kq; size_t kq_stride; bf16_t* d_vT; bf16_t* d_gate; int is_ctx;
    __device__ __forceinline__ void operator()(const f32x4 (&acc)[2][2][4][2], const Unit& u, int wr, int wc, int fr, int fq) const {
        if (u.pn < 2) {
#pragma unroll
            for (int ai = 0; ai < 2; ++ai)
#pragma unroll
                for (int m = 0; m < 4; ++m) {
                    const int row = u.pm * BM + ai * HALF + wr * 64 + m * 16 + fr;
                    const int n = is_ctx ? (1024 + (row >> 8) * 8 + ((row & 255) >> 5)) : ((row >> 12) * 128 + ((row & 4095) >> 5));
                    const int jj = row & 31;
#pragma unroll
                    for (int bj = 0; bj < 2; ++bj) {
                        const int col = u.pn * BM + bj * HALF + wc * 32 + 8 * fq;
                        const f32x4 v0 = acc[ai][bj][m][0] * (1.f / WIN_SCALE), v1 = acc[ai][bj][m][1] * (1.f / WIN_SCALE);
                        u32x4 w; w.x = cvt_pk_bf16(v0[0], v0[1]); w.y = cvt_pk_bf16(v0[2], v0[3]); w.z = cvt_pk_bf16(v1[0], v1[1]); w.w = cvt_pk_bf16(v1[2], v1[3]);
                        *(u32x4*)(U + ((size_t)((col >> 4) * SSM_ROWS + n) * SSM_LD + jj * 16 + (col & 15))) = w;
                    }
                    asm volatile("" ::: "memory");
                }
        } else if (u.pn == 4 || u.pn == 5) {
            const int RB = is_ctx ? (CTXL / 64) : (SEQL / 64);
#pragma unroll
            for (int ai = 0; ai < 2; ++ai)
#pragma unroll
                for (int m = 0; m < 4; ++m) {
                    const int row = u.pm * BM + ai * HALF + wr * 64 + m * 16 + fr;
                    const int b = is_ctx ? (row >> 8) : (row >> 12), t = is_ctx ? (row & 255) : (row & 4095);
#pragma unroll
                    for (int bj = 0; bj < 2; ++bj) {
                        const int col = u.pn * BM + bj * HALF + wc * 32 + 8 * fq - 1024;
                        bf16_t* dst = d_vT + ((size_t)((b * 8 + (col >> 6)) * RB + (t >> 6)) * 4096 + (col & 63) * 64 + (t & 63));
#pragma unroll
                        for (int n = 0; n < 2; ++n)
#pragma unroll
                            for (int i = 0; i < 4; ++i) dst[(n * 4 + i) * 64] = (bf16_t)f2bf(acc[ai][bj][m][n][i] * (1.f / WIN_SCALE));
                    }
                    asm volatile("" ::: "memory");
                }
        } else {
            bf16_t* base; int ld, c0;
            if (u.pn < 8) { const int which = (u.pn - 2) >> 2; base = d_kq + (size_t)which * kq_stride; ld = 512; c0 = 512 + which * 1024; }
            else { const int which = (u.pn - 8) >> 2; base = d_gate + (size_t)which * ((size_t)NTOK * DM); ld = DM; c0 = 2048 + which * 1024; }
#pragma unroll
            for (int ai = 0; ai < 2; ++ai)
#pragma unroll
                for (int m = 0; m < 4; ++m) {
                    const int row = u.pm * BM + ai * HALF + wr * 64 + m * 16 + fr;
#pragma unroll
                    for (int bj = 0; bj < 2; ++bj) {
                        const int col = u.pn * BM + bj * HALF + wc * 32 + 8 * fq - c0;
                        const f32x4 v0 = acc[ai][bj][m][0] * (1.f / WIN_SCALE), v1 = acc[ai][bj][m][1] * (1.f / WIN_SCALE);
                        u32x4 w; w.x = cvt_pk_bf16(v0[0], v0[1]); w.y = cvt_pk_bf16(v0[2], v0[3]); w.z = cvt_pk_bf16(v1[0], v1[1]); w.w = cvt_pk_bf16(v1[2], v1[3]);
                        *(u32x4*)(base + (size_t)row * ld + col) = w;
                    }
                    asm volatile("" ::: "memory");
                }
        }
    }
};
struct EpiGlu {
    static constexpr bool PERM = true, AFTER_DRAIN = false;
    __device__ __forceinline__ bool keep(const Unit&) const { return false; }
    bf16_t* gl; const bf16_t* z; const float* bias;
    __device__ __forceinline__ void operator()(const f32x4 (&acc)[2][2][4][2], const Unit& u, int wr, int wc, int fr, int fq) const {
#pragma unroll
        for (int ai = 0; ai < 2; ++ai)
#pragma unroll
            for (int m = 0; m < 4; ++m) {
                const int row = u.pm * BM + ai * HALF + wr * 64 + m * 16 + fr;
#pragma unroll
                for (int bj = 0; bj < 2; ++bj) {
                    const int col = u.pn * BM + bj * HALF + wc * 32 + 8 * fq;
                    const f32x4 v0 = acc[ai][bj][m][0], v1 = acc[ai][bj][m][1];
                    const f32x4 b0 = *(const f32x4*)(bias + col), b1 = *(const f32x4*)(bias + col + 4);
                    const u32x4 zz = *(const u32x4*)(z + (size_t)row * 512 + col);
                    float o[8];
                    o[0] = bflo(zz.x) * sigmoidf_(v0[0] + b0[0]); o[1] = bfhi(zz.x) * sigmoidf_(v0[1] + b0[1]);
                    o[2] = bflo(zz.y) * sigmoidf_(v0[2] + b0[2]); o[3] = bfhi(zz.y) * sigmoidf_(v0[3] + b0[3]);
                    o[4] = bflo(zz.z) * sigmoidf_(v1[0] + b1[0]); o[5] = bfhi(zz.z) * sigmoidf_(v1[1] + b1[1]);
                    o[6] = bflo(zz.w) * sigmoidf_(v1[2] + b1[2]); o[7] = bfhi(zz.w) * sigmoidf_(v1[3] + b1[3]);
                    u32x2 w; w.x = pk4_fp8(o[0] * ACT8, o[1] * ACT8, o[2] * ACT8, o[3] * ACT8); w.y = pk4_fp8(o[4] * ACT8, o[5] * ACT8, o[6] * ACT8, o[7] * ACT8);
                    *(u32x2*)((unsigned char*)gl + (size_t)row * 512 + col) = w;
                }
            }
    }
};
template <int M, int N>
struct PairOrder {
    StaticOrder<M, N> S;
    __device__ void init(int G_, int c_) { S.init(G_, c_); }
    __device__ bool next(int i, Unit& u) const { if (!S.next(i >> 1, u)) return false; u.g = i & 1; return true; }
    __device__ __forceinline__ void a_ready(const Unit&) const {}
    __device__ __forceinline__ void done(const Unit&) const {}
};
struct EpiMerge {
    static constexpr bool PERM = true, AFTER_DRAIN = false;
    __device__ __forceinline__ bool keep(const Unit& u) const { return u.g == 0; }
    bf16_t* merged; const bf16_t* ga; const bf16_t* gb;
    __device__ __forceinline__ void operator()(f32x4 (&acc)[2][2][4][2], const Unit& u, int wr, int wc, int fr, int fq) const {
#pragma unroll
        for (int ai = 0; ai < 2; ++ai)
#pragma unroll
            for (int m = 0; m < 4; ++m) {
                const int row = u.pm * BM + ai * HALF + wr * 64 + m * 16 + fr;
#pragma unroll
                for (int bj = 0; bj < 2; ++bj) {
                    const int col = u.pn * BM + bj * HALF + wc * 32 + 8 * fq;
                    const u32x4 a4 = *(const u32x4*)(ga + (size_t)row * DM + col);
                    float sa[8];
#pragma unroll
                    for (int q = 0; q < 4; ++q) { sa[2 * q] = sigmoidf_(bflo(a4[q])); sa[2 * q + 1] = sigmoidf_(bfhi(a4[q])); }
                    if (u.g == 0) {
                        const u32x4 b4 = *(const u32x4*)(gb + (size_t)row * DM + col);
#pragma unroll
                        for (int q = 0; q < 4; ++q) {
                            const float r0 = sigmoidf_(bflo(b4[q])) * frcp(sa[2 * q]), r1 = sigmoidf_(bfhi(b4[q])) * frcp(sa[2 * q + 1]);
                            acc[ai][bj][m][q >> 1][(q & 1) * 2] *= r0; acc[ai][bj][m][q >> 1][(q & 1) * 2 + 1] *= r1;
                        }
                    } else {
                        const f32x4 v0 = acc[ai][bj][m][0], v1 = acc[ai][bj][m][1];
                        constexpr float f = ACT8 / (ACT8 * WIN_SCALE);
                        u32x2 w; w[0] = pk4_fp8(v0[0] * sa[0] * f, v0[1] * sa[1] * f, v0[2] * sa[2] * f, v0[3] * sa[3] * f); w[1] = pk4_fp8(v1[0] * sa[4] * f, v1[1] * sa[5] * f, v1[2] * sa[6] * f, v1[3] * sa[7] * f);
                        *(u32x2*)((unsigned char*)merged + (size_t)row * DM + col) = w;
                    }
                }
                asm volatile("" ::: "memory");
            }
    }
};
struct EpiOut {
    static constexpr bool PERM = true, AFTER_DRAIN = false;
    __device__ __forceinline__ bool keep(const Unit&) const { return false; }
    const float* x; bf16_t* x1; bf16_t* x1g; const float* mod; const float* g2; unsigned long long* rowss;
    __device__ __forceinline__ void operator()(const f32x4 (&acc)[2][2][4][2], const Unit& u, int wr, int wc, int fr, int fq) const {
#pragma unroll
        for (int ai = 0; ai < 2; ++ai)
#pragma unroll
            for (int m = 0; m < 4; ++m) {
                const int row = u.pm * BM + ai * HALF + wr * 64 + m * 16 + fr;
                const float* modb = mod + (size_t)(row >> 12) * (6 * DM);
                float ss = 0.f;
#pragma unroll
                for (int bj = 0; bj < 2; ++bj) {
                    const int col = u.pn * BM + bj * HALF + wc * 32 + 8 * fq;
#pragma unroll
                    for (int n = 0; n < 2; ++n) {
                        const int cc = col + 4 * n;
                        const f32x4 v = acc[ai][bj][m][n] * (1.f / (ACT8 * WIN_SCALE));
                        const f32x4 xx = *(const f32x4*)(x + (size_t)row * DM + cc);
                        const f32x4 g1 = *(const f32x4*)(modb + 2 * DM + cc), sc = *(const f32x4*)(modb + 4 * DM + cc), gg = *(const f32x4*)(g2 + cc);
                        const f32x4 o = xx + g1 * v;
                        { u32x2 w1; w1.x = cvt_pk_bf16(o[0], o[1]); w1.y = cvt_pk_bf16(o[2], o[3]); *(u32x2*)(x1 + (size_t)row * DM + cc) = w1; }
                        ss += o[0] * o[0] + o[1] * o[1] + o[2] * o[2] + o[3] * o[3];
                        const f32x4 og = o * gg * (sc + 1.f);
                        u32x2 w; w.x = cvt_pk_bf16(og[0], og[1]); w.y = cvt_pk_bf16(og[2], og[3]);
                        *(u32x2*)(x1g + (size_t)row * DM + cc) = w;
                    }
                }
                ss += __shfl_xor(ss, 16); ss += __shfl_xor(ss, 32);
                if (fq == 0) atomicAdd(rowss + row, (unsigned long long)(ss * SS_FIX));
            }
    }
};
struct EpiQ {
    static constexpr bool PERM = true, AFTER_DRAIN = false;
    __device__ __forceinline__ bool keep(const Unit&) const { return false; }
    bf16_t* qp; const unsigned long long* rowss; const float* c2;
    __device__ __forceinline__ void operator()(const f32x4 (&acc)[2][2][4][2], const Unit& u, int wr, int wc, int fr, int fq) const {
#pragma unroll
        for (int ai = 0; ai < 2; ++ai)
#pragma unroll
            for (int m = 0; m < 4; ++m) {
                const int row = u.pm * BM + ai * HALF + wr * 64 + m * 16 + fr;
                const float rstd = rstd_from_fix(rowss[row]);
                const float* cb = c2 + (size_t)(row >> 12) * 2048;
#pragma unroll
                for (int bj = 0; bj < 2; ++bj) {
                    const int col = u.pn * BM + bj * HALF + wc * 32 + 8 * fq;
                    const f32x4 v0 = acc[ai][bj][m][0] * rstd + *(const f32x4*)(cb + col), v1 = acc[ai][bj][m][1] * rstd + *(const f32x4*)(cb + col + 4);
                    u32x4 w; w.x = cvt_pk_bf16(v0[0], v0[1]); w.y = cvt_pk_bf16(v0[2], v0[3]); w.z = cvt_pk_bf16(v1[0], v1[1]); w.w = cvt_pk_bf16(v1[2], v1[3]);
                    *(u32x4*)(qp + (size_t)row * 2048 + col) = w;
                }
            }
    }
};
struct EpiE {
    static constexpr bool PERM = true, AFTER_DRAIN = false;
    __device__ __forceinline__ bool keep(const Unit&) const { return false; }
    float* E;
    __device__ __forceinline__ void operator()(const f32x4 (&acc)[2][2][4][2], const Unit& u, int wr, int wc, int fr, int fq) const {
#pragma unroll
        for (int ai = 0; ai < 2; ++ai)
#pragma unroll
            for (int m = 0; m < 4; ++m) {
                const int row = u.pm * BM + ai * HALF + wr * 64 + m * 16 + fr;
#pragma unroll
                for (int bj = 0; bj < 2; ++bj) {
                    const int col = u.pn * BM + bj * HALF + wc * 32 + 8 * fq;
                    float* d = E + ((size_t)(u.g * SSM_ROWS + row) * 256 + col);
                    *(f32x4*)d = acc[ai][bj][m][0]; *(f32x4*)(d + 4) = acc[ai][bj][m][1];
                }
            }
    }
};
struct EpiZ {
    static constexpr bool PERM = true, AFTER_DRAIN = false;
    __device__ __forceinline__ bool keep(const Unit&) const { return false; }
    bf16_t* z;
    __device__ __forceinline__ void operator()(const f32x4 (&acc)[2][2][4][2], const Unit& u, int wr, int wc, int fr, int fq) const {
#pragma unroll
        for (int ai = 0; ai < 2; ++ai)
#pragma unroll
            for (int m = 0; m < 4; ++m) {
                const int n = u.pm * BM + ai * HALF + wr * 64 + m * 16 + fr;
                const size_t tok0 = (size_t)(n >> 7) * SEQL + (size_t)(n & 127) * 32;
#pragma unroll
                for (int bj = 0; bj < 2; ++bj) {
                    const int col = u.pn * BM + bj * HALF + wc * 32 + 8 * fq;
                    const f32x4 v0 = acc[ai][bj][m][0], v1 = acc[ai][bj][m][1];
                    u32x4 w; w.x = cvt_pk_bf16(gelu_tanh(v0[0]), gelu_tanh(v0[1])); w.y = cvt_pk_bf16(gelu_tanh(v0[2]), gelu_tanh(v0[3]));
                    w.z = cvt_pk_bf16(gelu_tanh(v1[0]), gelu_tanh(v1[1])); w.w = cvt_pk_bf16(gelu_tanh(v1[2]), gelu_tanh(v1[3]));
                    *(u32x4*)(z + (tok0 + (col >> 4)) * 512 + u.g * 16 + (col & 15)) = w;
                }
            }
    }
};
}

__device__ __forceinline__ void sincos_d(double th, double& s, double& c) {
    const double twopi = 6.283185307179586476925, hpi = 1.570796326794896619231;
    th -= twopi * rint(th / twopi);
    const double q = rint(th / hpi); const double y = th - q * hpi, y2 = y * y;
    const double sy = y * (1.0 - y2 / 6.0 * (1.0 - y2 / 20.0 * (1.0 - y2 / 42.0 * (1.0 - y2 / 72.0 * (1.0 - y2 / 110.0 * (1.0 - y2 / 156.0 * (1.0 - y2 / 210.0)))))));
    const double cy = 1.0 - y2 / 2.0 * (1.0 - y2 / 12.0 * (1.0 - y2 / 30.0 * (1.0 - y2 / 56.0 * (1.0 - y2 / 90.0 * (1.0 - y2 / 132.0 * (1.0 - y2 / 182.0))))));
    const int qi = ((int)q) & 3;
    s = qi == 0 ? sy : (qi == 1 ? cy : (qi == 2 ? -sy : -cy));
    c = qi == 0 ? cy : (qi == 1 ? -sy : (qi == 2 ? -cy : sy));
}
__device__ __forceinline__ void ssm_prep_item(const P& p, LAS unsigned char* lds, int item) {
    const int g = item >> 2, qtr = item & 3, tid = threadIdx.x;
    LAS f32x2* lamk = (LAS f32x2*)lds;
    LAS f32x2* Bb = lamk + 2 * 64 * 33;
    LAS f32x2* Cc = Bb + 2 * 64 * 16;
    LAS float* Kc = (LAS float*)(Cc + 2 * 16 * 64);
    if (tid < 128) {
        const int d = tid >> 6, pp = tid & 63, gi = d * 32 + g;
        const double are = (double)p.a_re[gi * 64 + pp], aim = (double)p.a_im[gi * 64 + pp];
        const double dt = (double)expf(p.log_dt[gi]);
        const double er = exp(are * dt); double sn, cs; sincos_d(aim * dt, sn, cs);
        const double lr = er * cs, li = er * sn;
        double pr = 1.0, pi_ = 0.0;
        for (int k = 0; k <= 32; ++k) {
            lamk[(d * 64 + pp) * 33 + k] = (f32x2){(float)pr, (float)pi_};
            const double nr_ = pr * lr - pi_ * li, ni_ = pr * li + pi_ * lr; pr = nr_; pi_ = ni_;
        }
        if (qtr == 0) { const f32x2 l32 = lamk[(d * 64 + pp) * 33 + 32]; *(f32x2*)(p.lamT() + (size_t)(gi * 64 + pp) * 2) = l32; }
        const double nr = lr - 1.0, ni = li, den = are * are + aim * aim;
        const double qr = (nr * are + ni * aim) / den, qi = (ni * are - nr * aim) / den;
        f32x4 brv[4], biv[4];
#pragma unroll
        for (int q = 0; q < 4; ++q) { brv[q] = *(const f32x4*)(p.b_re + ((size_t)gi * 64 + pp) * 16 + 4 * q); biv[q] = *(const f32x4*)(p.b_im + ((size_t)gi * 64 + pp) * 16 + 4 * q); }
#pragma unroll
        for (int h = 0; h < 16; ++h) {
            const double br = (double)brv[h >> 2][h & 3], bi = (double)biv[h >> 2][h & 3];
            Bb[(d * 64 + pp) * 16 + h] = (f32x2){(float)(qr * br - qi * bi), (float)(qr * bi + qi * br)};
        }
    }
    for (int e = tid; e < 2 * 16 * 64; e += NT) {
        const int d = e >> 10, h = (e >> 6) & 15, pp = e & 63; const size_t src = ((size_t)(d * 32 + g) * 16 + h) * 64 + pp;
        Cc[e] = (f32x2){p.c_re[src], p.c_im[src]};
    }
    __syncthreads();
    {
        const int wv = __builtin_amdgcn_readfirstlane(tid >> 6), lane = tid & 63, lm = lane & 15, kq = lane >> 4, d = wv >> 2;
        bf16x8 bop[4];
#pragma unroll
        for (int ks = 0; ks < 4; ++ks) {
            u32x4 w;
#pragma unroll
            for (int j = 0; j < 4; ++j) { const f32x2 bb = Bb[(d * 64 + ks * 16 + kq * 4 + j) * 16 + lm]; w[j] = pk2(bb[0], bb[1]); }
            bop[ks] = __builtin_bit_cast(bf16x8, w);
        }
#pragma unroll 1
        for (int k = (wv & 3) * 8; k < (wv & 3) * 8 + 8; ++k) {
            f32x4 acc = {0.f, 0.f, 0.f, 0.f};
#pragma unroll
            for (int ks = 0; ks < 4; ++ks) {
                u32x4 w;
#pragma unroll
                for (int j = 0; j < 4; ++j) {
                    const int pp = ks * 16 + kq * 4 + j;
                    const f32x2 c = Cc[(d * 16 + lm) * 64 + pp], l = lamk[(d * 64 + pp) * 33 + k];
                    w[j] = pk2(c[0] * l[0] - c[1] * l[1], -(c[0] * l[1] + c[1] * l[0]));
                }
                acc = __builtin_amdgcn_mfma_f32_16x16x32_bf16(__builtin_bit_cast(bf16x8, w), bop[ks], acc, 0, 0, 0);
            }
#pragma unroll
            for (int r = 0; r < 4; ++r) Kc[((d * 32 + k) * 16 + kq * 4 + r) * 16 + lm] = acc[r];
        }
    }
    __syncthreads();
    for (int ch = tid; ch < 128 * 96; ch += NT) {
        const int mrow = 128 * qtr + ch / 96, k0 = (ch % 96) * 8, ii = mrow >> 4, h = mrow & 15;
        float v[8];
        if (k0 < 512) {
            const int jj = k0 >> 4, h20 = k0 & 15;
#pragma unroll
            for (int i = 0; i < 8; ++i) {
                const int h2 = h20 + i; float val = 0.f;
                if (ii >= jj) val += Kc[((0 * 32 + (ii - jj)) * 16 + h) * 16 + h2];
                if (jj >= ii) val += Kc[((1 * 32 + (jj - ii)) * 16 + h) * 16 + h2];
                if (ii == jj && h == h2) val += p.ssm_d[g * 16 + h];
                v[i] = val;
            }
        } else {
            const int sc = k0 - 512, d = sc >> 7, ri = (sc >> 6) & 1, p0 = sc & 63, e = d == 0 ? ii + 1 : 32 - ii;
#pragma unroll
            for (int i = 0; i < 8; ++i) {
                const int pp = p0 + i; const f32x2 c = Cc[(d * 16 + h) * 64 + pp], l = lamk[(d * 64 + pp) * 33 + e];
                const float clr = c[0] * l[0] - c[1] * l[1], cli = c[0] * l[1] + c[1] * l[0];
                v[i] = ri == 0 ? clr : -cli;
            }
        }
        u32x4 o; o.x = pg8::cvt_pk_bf16(v[0], v[1]); o.y = pg8::cvt_pk_bf16(v[2], v[3]); o.z = pg8::cvt_pk_bf16(v[4], v[5]); o.w = pg8::cvt_pk_bf16(v[6], v[7]);
        *(u32x4*)(p.Kmat() + ((size_t)(g * 512 + mrow) * SSM_LD + k0)) = o;
    }
    for (int ch = tid; ch < 64 * 64; ch += NT) {
        const int nrow = 64 * qtr + ch / 64, k0 = (ch % 64) * 8, d = nrow >> 7, ri = (nrow >> 6) & 1, pp = nrow & 63;
        const int jj = k0 >> 4, h20 = k0 & 15, e = d == 0 ? 31 - jj : jj;
        const f32x2 l = lamk[(d * 64 + pp) * 33 + e];
        float v[8];
#pragma unroll
        for (int i = 0; i < 8; ++i) { const f32x2 b = Bb[(d * 64 + pp) * 16 + h20 + i]; v[i] = ri == 0 ? (l[0] * b[0] - l[1] * b[1]) : (l[0] * b[1] + l[1] * b[0]); }
        u32x4 o; o.x = pg8::cvt_pk_bf16(v[0], v[1]); o.y = pg8::cvt_pk_bf16(v[2], v[3]); o.z = pg8::cvt_pk_bf16(v[4], v[5]); o.w = pg8::cvt_pk_bf16(v[6], v[7]);
        *(u32x4*)(p.Win() + ((size_t)(g * 256 + nrow) * 512 + k0)) = o;
    }
    __syncthreads();
}
__device__ __forceinline__ void ph_carry(const P& p) {
    int tid = threadIdx.x; asm volatile("" : "+v"(tid));
    if (tid >= 128) return;
    for (int gidx = blockIdx.x * 128 + tid; gidx < 32 * 8 * 2 * 64; gidx += gridDim.x * 128) {
        const int pp = gidx & 63, d = (gidx >> 6) & 1, b = (gidx >> 7) & 7, g = gidx >> 10;
        const f32x2 lt = *(const f32x2*)(p.lamT() + (size_t)((d * 32 + g) * 64 + pp) * 2);
        const float* Eg = p.E() + (size_t)g * SSM_ROWS * 256 + d * 128 + pp;
        bf16_t* Ug = p.U() + (size_t)g * SSM_ROWS * SSM_LD + 512 + d * 128 + pp;
        float fr = 0.f, fi = 0.f;
#pragma unroll
        for (int cc = 0; cc < 8; ++cc) {
            const int n = 1024 + b * 8 + (d == 0 ? cc : 7 - cc);
            const float er = Eg[(size_t)n * 256], ei = Eg[(size_t)n * 256 + 64];
            const float nr = lt[0] * fr - lt[1] * fi + er, ni = lt[0] * fi + lt[1] * fr + ei; fr = nr; fi = ni;
        }
#pragma unroll 8
        for (int c = 0; c < 128; ++c) {
            const int n = b * 128 + (d == 0 ? c : 127 - c);
            const float er = Eg[(size_t)n * 256], ei = Eg[(size_t)n * 256 + 64];
            Ug[(size_t)n * SSM_LD] = (bf16_t)f2bf(fr); Ug[(size_t)n * SSM_LD + 64] = (bf16_t)f2bf(fi);
            const float nr = lt[0] * fr - lt[1] * fi + er, ni = lt[0] * fi + lt[1] * fr + ei; fr = nr; fi = ni;
        }
    }
}


__device__ __forceinline__ void p0_transpose_item_fp8(const float* W, int K, int N, unsigned char* WT, float scale, LAS float* scr, int item, int lane) {
    const int nblk = N / 32, kb = item / nblk, nb = item % nblk, k0 = 64 * kb, n0 = 32 * nb;
#pragma unroll 8
    for (int i = 0; i < 32; ++i) { const int kk = 2 * i + (lane >> 5); scr[kk * 33 + (lane & 31)] = W[(size_t)(k0 + kk) * N + n0 + (lane & 31)]; }
    asm volatile("s_waitcnt lgkmcnt(0)" ::: "memory");
    const int c = lane & 7;
#pragma unroll
    for (int j = 0; j < 4; ++j) { const int n = (lane >> 3) + 8 * j; const LAS float* s = scr + (8 * c) * 33 + n;
        u32x2 o; o.x = pk4_fp8(s[0 * 33] * scale, s[1 * 33] * scale, s[2 * 33] * scale, s[3 * 33] * scale); o.y = pk4_fp8(s[4 * 33] * scale, s[5 * 33] * scale, s[6 * 33] * scale, s[7 * 33] * scale);
        *(u32x2*)(WT + (size_t)(n0 + n) * K + k0 + 8 * c) = o; }
    asm volatile("s_waitcnt lgkmcnt(0)" ::: "memory");
}
__device__ __forceinline__ void p0_transpose_item(const float* W, int K, int N, bf16_t* WT, LAS float* scr, int item, int lane) {
    const int nblk = N / 32, kb = item / nblk, nb = item % nblk, k0 = 64 * kb, n0 = 32 * nb;
#pragma unroll 8
    for (int i = 0; i < 32; ++i) { const int kk = 2 * i + (lane >> 5); scr[kk * 33 + (lane & 31)] = W[(size_t)(k0 + kk) * N + n0 + (lane & 31)]; }
    asm volatile("s_waitcnt lgkmcnt(0)" ::: "memory");
    const int c = lane & 7;
#pragma unroll
    for (int j = 0; j < 4; ++j) { const int n = (lane >> 3) + 8 * j; const LAS float* s = scr + (8 * c) * 33 + n;
        u32x4 o; o.x = pk2(s[0 * 33], s[1 * 33]); o.y = pk2(s[2 * 33], s[3 * 33]); o.z = pk2(s[4 * 33], s[5 * 33]); o.w = pk2(s[6 * 33], s[7 * 33]);
        *(u32x4*)(WT + (size_t)(n0 + n) * K + k0 + 8 * c) = o; }
    asm volatile("s_waitcnt lgkmcnt(0)" ::: "memory");
}

template <int NR, bool SILU>
__device__ __forceinline__ void gemv_block64(const float* const (&rows)[NR], const float* W, int ldw, int col0, const float* bias, float* y, int ldy, LAS float* scr) {
    const int wave = threadIdx.x >> 6, lane = threadIdx.x & 63;
    LAS float* act = scr + 8 * NR * 64;
#pragma unroll
    for (int r = 0; r < NR; ++r) for (int k = threadIdx.x; k < DM; k += NT) { const float s = rows[r][k]; act[r * DM + k] = SILU ? siluf_(s) : s; }
    __syncthreads();
    float acc[NR];
#pragma unroll
    for (int r = 0; r < NR; ++r) acc[r] = 0.f;
    const int kb = wave * 128;
#pragma unroll 32
    for (int k = kb; k < kb + 128; ++k) {
        const float w = W[(size_t)k * ldw + col0 + lane];
#pragma unroll
        for (int r = 0; r < NR; ++r) acc[r] += act[r * DM + k] * w;
    }
#pragma unroll
    for (int r = 0; r < NR; ++r) scr[(wave * NR + r) * 64 + lane] = acc[r];
    __syncthreads();
    for (int e = threadIdx.x; e < NR * 64; e += NT) {
        const int r = e >> 6, l = e & 63; float s = 0.f;
#pragma unroll
        for (int w = 0; w < 8; ++w) s += scr[(w * NR + r) * 64 + l];
        y[(size_t)r * ldy + col0 + l] = s + (bias ? bias[col0 + l] : 0.f);
    }
    __syncthreads();
}

__device__ __forceinline__ void ph_prep(const P& p, LAS unsigned char* lds) {
    int tid_ = threadIdx.x; asm volatile("" : "+v"(tid_));
    const int wave = tid_ >> 6, lane = tid_ & 63, G = gridDim.x;
    for (int cb = blockIdx.x; cb < 96; cb += G) {
        const float* const rows[9] = {p.c, p.c + DM, p.c + 2 * DM, p.c + 3 * DM, p.c + 4 * DM, p.c + 5 * DM, p.c + 6 * DM, p.c + 7 * DM, p.c_ctx};
        gemv_block64<9, true>(rows, p.w_mod, 6 * DM, cb * 64, p.b_mod, p.mod(), 6 * DM, (LAS float*)lds);
    }
    {
        LAS float* scr = (LAS float*)(lds + wave * 16384);
        const int gw = blockIdx.x * NWAVES + wave, NGW = G * NWAVES;
        constexpr int I_IN = (DM / 64) * (INC / 32), I_GLU = (512 / 64) * (512 / 32), I_A = (512 / 64) * (DM / 32), I_OUT = (DM / 64) * (DM / 32), I_Q = (DM / 64) * (2048 / 32);
        constexpr int NITEMS = I_IN + I_GLU + 2 * I_A + I_OUT + I_Q;
        for (int it = gw; it < NITEMS; it += NGW) {
            int r = it;
            if (r < I_IN) { p0_transpose_item_fp8(p.w_in, DM, INC, (unsigned char*)p.w_in_t(), WIN_SCALE, scr, r, lane); continue; } r -= I_IN;
            if (r < I_GLU) { p0_transpose_item(p.w_glu, 512, 512, p.w_glu_t(), scr, r, lane); continue; } r -= I_GLU;
            if (r < I_A) { p0_transpose_item_fp8(p.w_a, 512, DM, (unsigned char*)p.w_a_t(), WIN_SCALE, scr, r, lane); continue; } r -= I_A;
            if (r < I_A) { p0_transpose_item_fp8(p.w_b, 512, DM, (unsigned char*)p.w_b_t(), WIN_SCALE, scr, r, lane); continue; } r -= I_A;
            if (r < I_OUT) { p0_transpose_item_fp8(p.w_out, DM, DM, (unsigned char*)p.w_out_t(), WIN_SCALE, scr, r, lane); continue; } r -= I_OUT;
            p0_transpose_item(p.w_q, DM, 2048, p.w_q_t(), scr, r, lane);
        }
    }
}

template <int CTRL> __device__ __forceinline__ int dpp_i(int v) { return __builtin_amdgcn_update_dpp(0, v, CTRL, 0xf, 0xf, true); }
template <int CTRL> __device__ __forceinline__ float dpp_f(float v) { return __builtin_bit_cast(float, __builtin_amdgcn_update_dpp(0, __builtin_bit_cast(int, v), CTRL, 0xf, 0xf, true)); }
constexpr int DPP_XOR1 = 0xB1, DPP_XOR2 = 0x4E, DPP_HMIRROR = 0x141, DPP_ROR8 = 0x128;
constexpr float I8_MAGIC = 12582912.f;
__device__ __forceinline__ unsigned pack4_i8(float t0, float t1, float t2, float t3) {
    const unsigned p01 = __builtin_amdgcn_perm(__builtin_bit_cast(unsigned, t1), __builtin_bit_cast(unsigned, t0), 0x0c0c0400u);
    const unsigned p23 = __builtin_amdgcn_perm(__builtin_bit_cast(unsigned, t3), __builtin_bit_cast(unsigned, t2), 0x0c0c0400u);
    return __builtin_amdgcn_perm(p23, p01, 0x05040100u);
}
__device__ __forceinline__ void bg_convert_tables(const P& p) {
    int tid_ = threadIdx.x; asm volatile("" : "+v"(tid_));
    const int lane = tid_ & 63;
    unsigned* head = p.queues() + 16 * 64;
    for (;;) {
        unsigned v = 0u; if (lane == 0) v = __hip_atomic_fetch_add(head, 32u, __ATOMIC_RELAXED, __HIP_MEMORY_SCOPE_AGENT);
        const int rg = (int)__builtin_amdgcn_readfirstlane(v);
        if (rg >= 2 * 16384) break;
#pragma unroll 1
      for (int r0 = rg; r0 < rg + 32; r0 += 4) {
        const bool second = r0 >= 16384; const int rr0 = second ? r0 - 16384 : r0;
        const float* src = (second ? p.peer_v : p.peer_u) + (size_t)rr0 * DM + lane * 16;
        unsigned char* dst = (second ? p.pv8() : p.pu8()) + (size_t)(lane >> 3) * (16384 * 128) + (size_t)rr0 * 128 + (lane & 7) * 16;
        f32x4 v4[4][4];
#pragma unroll
        for (int q = 0; q < 4; ++q)
#pragma unroll
            for (int j = 0; j < 4; ++j) v4[q][j] = *(const f32x4*)(src + q * DM + 4 * j);
        float inv = 1.f;
#pragma unroll
        for (int q = 0; q < 4; ++q) {
            float am = 0.f;
#pragma unroll
            for (int j = 0; j < 4; ++j) am = fmaxf(am, fmaxf(fmaxf(fabsf(v4[q][j][0]), fabsf(v4[q][j][1])), fmaxf(fabsf(v4[q][j][2]), fabsf(v4[q][j][3]))));
            am = wave_max(am);
            const float top = 6.f;
            const float sc = am > 0.f ? top / am : 1.f;
            if (second) {
                u32x2 o2;
#pragma unroll
                for (int jj = 0; jj < 2; ++jj) {
                    unsigned w = 0u;
                    w = __builtin_amdgcn_cvt_scalef32_pk_fp4_f32(w, v4[q][jj * 2][0] * sc, v4[q][jj * 2][1] * sc, 1.0f, 0);
                    w = __builtin_amdgcn_cvt_scalef32_pk_fp4_f32(w, v4[q][jj * 2][2] * sc, v4[q][jj * 2][3] * sc, 1.0f, 1);
                    w = __builtin_amdgcn_cvt_scalef32_pk_fp4_f32(w, v4[q][jj * 2 + 1][0] * sc, v4[q][jj * 2 + 1][1] * sc, 1.0f, 2);
                    w = __builtin_amdgcn_cvt_scalef32_pk_fp4_f32(w, v4[q][jj * 2 + 1][2] * sc, v4[q][jj * 2 + 1][3] * sc, 1.0f, 3);
                    o2[jj] = w;
                }
                *(u32x2*)(p.pv8() + (size_t)(lane >> 4) * (16384 * 128) + (size_t)(rr0 + q) * 128 + (lane & 15) * 8) = o2;
                inv = lane == q ? (am > 0.f ? am / top : 1.f) : inv;
            } else {
                float a16 = 0.f;
#pragma unroll
                for (int j = 0; j < 4; ++j) a16 = fmaxf(a16, fmaxf(fmaxf(fabsf(v4[q][j][0]), fabsf(v4[q][j][1])), fmaxf(fabsf(v4[q][j][2]), fabsf(v4[q][j][3]))));
                a16 = fmaxf(a16, dpp_f<DPP_XOR1>(a16)); a16 = fmaxf(a16, dpp_f<DPP_XOR2>(a16)); a16 = fmaxf(a16, dpp_f<DPP_HMIRROR>(a16)); a16 = fmaxf(a16, dpp_f<DPP_ROR8>(a16));
                const float s4 = a16 > 0.f ? 7.f / a16 : 1.f;
                u32x2 o2;
#pragma unroll
                for (int jj = 0; jj < 2; ++jj) {
                    unsigned w = 0u;
#pragma unroll
                    for (int k = 0; k < 8; ++k) { const float t = v4[q][jj * 2 + (k >> 2)][k & 3] * s4 + I8_MAGIC; w |= (__builtin_bit_cast(unsigned, t) & 15u) << (4 * k); }
                    o2[jj] = w;
                }
                *(u32x2*)(p.pu8() + (size_t)(lane >> 4) * (16384 * 128) + (size_t)(rr0 + q) * 128 + (lane & 15) * 8) = o2;
                if ((lane & 15) == 0) p.pisc_u()[(size_t)(rr0 + q) * 4 + (lane >> 4)] = a16 > 0.f ? a16 * (1.f / 7.f) : 1.f;
            }
        }
        if (second && lane < 4) p.pisc()[r0 + lane] = inv;
      }
    }
}

__device__ __forceinline__ void normmod_row_bf16(const float* src, bf16_t* dst, const float* g, const float* shift, const float* scale, int lane) {
    const f32x4* s = (const f32x4*)src;
    f32x4 v[4]; float ss = 0.f;
#pragma unroll
    for (int j = 0; j < 4; ++j) { v[j] = s[lane + 64 * j]; ss += v[j][0] * v[j][0] + v[j][1] * v[j][1] + v[j][2] * v[j][2] + v[j][3] * v[j][3]; }
    ss = wave_sum(ss);
    const float rstd = rsqrtf(ss * (1.f / DM) + EPSN);
#pragma unroll
    for (int j = 0; j < 4; ++j) {
        const int i4 = lane + 64 * j;
        const f32x4 gg = ((const f32x4*)g)[i4], sh = ((const f32x4*)shift)[i4], sc = ((const f32x4*)scale)[i4];
        const f32x4 o = v[j] * rstd * gg * (sc + 1.f) + sh;
        *(unsigned*)((unsigned char*)dst + (size_t)i4 * 4) = pk4_fp8(o[0], o[1], o[2], o[3]);
    }
}
__device__ __forceinline__ void ph_norm1(const P& p, LAS unsigned char* lds) {
    int tid_ = threadIdx.x; asm volatile("" : "+v"(tid_));
    const int wave = tid_ >> 6, lane = tid_ & 63, G = gridDim.x;
    const int gw = blockIdx.x * NWAVES + __builtin_amdgcn_readfirstlane(wave), NGW = G * NWAVES;
    for (int r4 = gw; r4 < NTOK / 4; r4 += NGW) {
        const int r = r4 * 4;
        const f32x4* s = (const f32x4*)(p.x + (size_t)r * DM);
        f32x4 v[4][4];
#pragma unroll
        for (int k = 0; k < 4; ++k)
#pragma unroll
            for (int j = 0; j < 4; ++j) v[k][j] = s[k * (DM / 4) + lane + 64 * j];
        const float* modb = p.mod() + (size_t)(r >> 12) * (6 * DM);
#pragma unroll
        for (int k = 0; k < 4; ++k) {
            float ss = 0.f;
#pragma unroll
            for (int j = 0; j < 4; ++j) ss += v[k][j][0] * v[k][j][0] + v[k][j][1] * v[k][j][1] + v[k][j][2] * v[k][j][2] + v[k][j][3] * v[k][j][3];
            ss = wave_sum(ss);
            const float rstd = rsqrtf(ss * (1.f / DM) + EPSN);
            unsigned char* dst = (unsigned char*)p.hx() + (size_t)(r + k) * DM;
#pragma unroll
            for (int j = 0; j < 4; ++j) {
                const int i4 = lane + 64 * j;
                const f32x4 gg = ((const f32x4*)p.norm1_g)[i4], sh = ((const f32x4*)modb)[i4], sc = ((const f32x4*)(modb + DM))[i4];
                const f32x4 o = v[k][j] * rstd * gg * (sc + 1.f) + sh;
                *(unsigned*)(dst + (size_t)i4 * 4) = pk4_fp8(o[0], o[1], o[2], o[3]);
            }
        }
    }
    for (int rc = gw; rc < NCTX; rc += NGW) { const float* modc = p.mod() + 8 * (6 * DM); normmod_row_bf16(p.ctx + (size_t)rc * DM, (bf16_t*)((unsigned char*)p.hc() + (size_t)rc * DM), p.norm1_g, modc, modc + DM, lane); }
}

constexpr int RPB_LD = 128, RPB_PAD = 48;
__device__ __forceinline__ void ph_na(const P& p, LAS unsigned char* lds) {
    int tid_ = threadIdx.x; asm volatile("" : "+v"(tid_));
    const int tid = tid_, h = __builtin_amdgcn_readfirstlane(tid >> 6), lane = tid & 63, lt = lane & 15, lq = lane >> 4;
    constexpr float LOG2E = 1.4426950408889634f, CS = 0.125f * LOG2E;
    LAS float* rp = (LAS float*)lds;
    for (int e = tid; e < 8 * 15 * RPB_LD; e += NT) { const int c = (e & (RPB_LD - 1)) - RPB_PAD; rp[e] = (c >= 0 && c < 31) ? p.rpb[(e / RPB_LD) * 31 + c] * LOG2E : 0.f; }
    __syncthreads();
    const int pa = (lt >> 2) * 8 + (lt & 3);
    const unsigned lane_k = pa * 512 + lq * 8, lane_v = lt * 64 + lq * 8, lane_q = lt * 512 + lq * 8, lane_o = lt * 512 + lq * 4;
    for (int item = blockIdx.x; item < NB * GW; item += gridDim.x) {
        const int b = item >> 6, r = item & 63;
        int r0 = r - 4; r0 = r0 < 0 ? 0 : (r0 > 56 ? 56 : r0);
        const bf16_t* Kb = p.kb() + ((size_t)b * SEQL + (size_t)r0 * GW) * 512 + h * 64;
        const bf16_t* Kc = p.kc() + ((size_t)b * CTXL) * 512 + h * 64;
        const bf16_t* Vt = p.vT() + ((size_t)((b * 8 + h) * 64 + r0)) * 4096;
        const bf16_t* Vc = p.vcT() + ((size_t)((b * 8 + h) * 4)) * 4096;
        const bf16_t* Qb = p.qb() + ((size_t)b * SEQL + r * GW) * 512 + h * 64;
        unsigned char* Ob = (unsigned char*)p.na() + ((size_t)b * SEQL + r * GW) * 512 + h * 64;
        const LAS float* rph = rp + (h * 15 + (r0 - r + 7)) * RPB_LD;
        bf16x8 qf[4][2];
#pragma unroll
        for (int qt = 0; qt < 4; ++qt) { qf[qt][0] = *(const bf16x8*)(Qb + qt * 16 * 512 + lane_q); qf[qt][1] = *(const bf16x8*)(Qb + qt * 16 * 512 + 32 + lane_q); }
        f32x4 o[4][4]; float m[4], l[4];
#pragma unroll
        for (int qt = 0; qt < 4; ++qt) { m[qt] = -1e30f; l[qt] = 0.f;
#pragma unroll
            for (int d = 0; d < 4; ++d) o[qt][d] = (f32x4){0.f, 0.f, 0.f, 0.f}; }
        bf16x8 kf[2][2][2];
#pragma unroll
        for (int st = 0; st < 2; ++st)
#pragma unroll
            for (int ab = 0; ab < 2; ++ab) { kf[st][ab][0] = *(const bf16x8*)(Kb + (st * 32 + ab * 4) * 512 + lane_k); kf[st][ab][1] = *(const bf16x8*)(Kb + (st * 32 + ab * 4) * 512 + 32 + lane_k); }
#pragma unroll 1
        for (int i = 0; i < 8; ++i) {
            bf16x8 vf[2][4];
#pragma unroll
            for (int st = 0; st < 2; ++st)
#pragma unroll
                for (int d = 0; d < 4; ++d) vf[st][d] = *(const bf16x8*)(Vt + i * 4096 + d * 1024 + st * 32 + lane_v);
            const LAS float* rr_ = rph + i * RPB_LD;
#pragma unroll
            for (int half = 0; half < 2; ++half) {
                f32x4 s[2][2][2];
#pragma unroll
                for (int q2 = 0; q2 < 2; ++q2) {
                    const int qt = half * 2 + q2;
#pragma unroll
                    for (int st = 0; st < 2; ++st) {
                        if ((st == 0 && qt == 3) || (st == 1 && qt == 0)) continue;
#pragma unroll
                        for (int ab = 0; ab < 2; ++ab) {
                            f32x4 c = {0.f, 0.f, 0.f, 0.f};
                            c = __builtin_amdgcn_mfma_f32_16x16x32_bf16(kf[st][ab][0], qf[qt][0], c, 0, 0, 0);
                            c = __builtin_amdgcn_mfma_f32_16x16x32_bf16(kf[st][ab][1], qf[qt][1], c, 0, 0, 0);
                            s[q2][st][ab] = c;
                        }
                    }
                }
                if (half == 1) {
                    if (i < 7) {
#pragma unroll
                        for (int st = 0; st < 2; ++st)
#pragma unroll
                            for (int ab = 0; ab < 2; ++ab) { const bf16_t* kp = Kb + ((i + 1) * GW + st * 32 + ab * 4) * 512; kf[st][ab][0] = *(const bf16x8*)(kp + lane_k); kf[st][ab][1] = *(const bf16x8*)(kp + 32 + lane_k); }
                    } else {
#pragma unroll
                        for (int ab = 0; ab < 2; ++ab) { kf[0][ab][0] = *(const bf16x8*)(Kc + ab * 4 * 512 + lane_k); kf[0][ab][1] = *(const bf16x8*)(Kc + ab * 4 * 512 + 32 + lane_k); }
                    }
                }
#pragma unroll
                for (int q2 = 0; q2 < 2; ++q2) {
                    const int qt = half * 2 + q2;
                    const int qc = qt * 16 + lt; int c0 = qc - 8; c0 = c0 < 0 ? 0 : (c0 > 48 ? 48 : c0);
                    int wo = lq * 8 - c0; asm volatile("" : "+v"(wo));
                    float mx = -1e30f;
#pragma unroll
                    for (int st = 0; st < 2; ++st) {
                        if ((st == 0 && qt == 3) || (st == 1 && qt == 0)) continue;
                        const int kc0 = st * 32 + lq * 8, bbase = kc0 - qc + 15 + RPB_PAD;
#pragma unroll
                        for (int j = 0; j < 8; ++j) {
                            float t = s[q2][st][j >> 2][j & 3] * CS + rr_[bbase + j];
                            t = ((unsigned)(wo + st * 32 + j) < 16u) ? t : -1e30f;
                            s[q2][st][j >> 2][j & 3] = t; mx = fmaxf(mx, t);
                        }
                    }
                    mx = fmaxf(mx, __shfl_xor(mx, 16)); mx = fmaxf(mx, __shfl_xor(mx, 32));
                    const float mn = fmaxf(m[qt], mx), corr = __builtin_amdgcn_exp2f(m[qt] - mn);
                    m[qt] = mn; float ls = l[qt] * corr;
#pragma unroll
                    for (int d = 0; d < 4; ++d) o[qt][d] = o[qt][d] * corr;
#pragma unroll
                    for (int st = 0; st < 2; ++st) {
                        if ((st == 0 && qt == 3) || (st == 1 && qt == 0)) continue;
                        float pe[8];
#pragma unroll
                        for (int j = 0; j < 8; ++j) pe[j] = __builtin_amdgcn_exp2f(s[q2][st][j >> 2][j & 3] - mn);
                        ls += ((pe[0] + pe[1]) + (pe[2] + pe[3])) + ((pe[4] + pe[5]) + (pe[6] + pe[7]));
                        u32x4 pw; pw[0] = pg8::cvt_pk_bf16(pe[0], pe[1]); pw[1] = pg8::cvt_pk_bf16(pe[2], pe[3]); pw[2] = pg8::cvt_pk_bf16(pe[4], pe[5]); pw[3] = pg8::cvt_pk_bf16(pe[6], pe[7]);
                        const bf16x8 pf = __builtin_bit_cast(bf16x8, pw);
#pragma unroll
                        for (int d = 0; d < 4; ++d) o[qt][d] = __builtin_amdgcn_mfma_f32_16x16x32_bf16(vf[st][d], pf, o[qt][d], 0, 0, 0);
                    }
                    l[qt] = ls;
                }
            }
        }
#pragma unroll 1
        for (int cst = 0; cst < 8; ++cst) {
            bf16x8 vf[4];
#pragma unroll
            for (int d = 0; d < 4; ++d) vf[d] = *(const bf16x8*)(Vc + (cst >> 1) * 4096 + d * 1024 + (cst & 1) * 32 + lane_v);
            f32x4 s[4][2];
#pragma unroll
            for (int qt = 0; qt < 4; ++qt)
#pragma unroll
                for (int ab = 0; ab < 2; ++ab) {
                    f32x4 c = {0.f, 0.f, 0.f, 0.f};
                    c = __builtin_amdgcn_mfma_f32_16x16x32_bf16(kf[0][ab][0], qf[qt][0], c, 0, 0, 0);
                    c = __builtin_amdgcn_mfma_f32_16x16x32_bf16(kf[0][ab][1], qf[qt][1], c, 0, 0, 0);
                    s[qt][ab] = c;
                }
            if (cst < 7) {
#pragma unroll
                for (int ab = 0; ab < 2; ++ab) { const bf16_t* kp = Kc + ((cst + 1) * 32 + ab * 4) * 512; kf[0][ab][0] = *(const bf16x8*)(kp + lane_k); kf[0][ab][1] = *(const bf16x8*)(kp + 32 + lane_k); }
            }
#pragma unroll
            for (int qt = 0; qt < 4; ++qt) {
                float mx = -1e30f;
#pragma unroll
                for (int j = 0; j < 8; ++j) { const float t = s[qt][j >> 2][j & 3] * CS; s[qt][j >> 2][j & 3] = t; mx = fmaxf(mx, t); }
                mx = fmaxf(mx, __shfl_xor(mx, 16)); mx = fmaxf(mx, __shfl_xor(mx, 32));
                const float mn = fmaxf(m[qt], mx), corr = __builtin_amdgcn_exp2f(m[qt] - mn);
                m[qt] = mn;
#pragma unroll
                for (int d = 0; d < 4; ++d) o[qt][d] = o[qt][d] * corr;
                float pe[8];
#pragma unroll
                for (int j = 0; j < 8; ++j) pe[j] = __builtin_amdgcn_exp2f(s[qt][j >> 2][j & 3] - mn);
                l[qt] = l[qt] * corr + (((pe[0] + pe[1]) + (pe[2] + pe[3])) + ((pe[4] + pe[5]) + (pe[6] + pe[7])));
                u32x4 pw; pw[0] = pg8::cvt_pk_bf16(pe[0], pe[1]); pw[1] = pg8::cvt_pk_bf16(pe[2], pe[3]); pw[2] = pg8::cvt_pk_bf16(pe[4], pe[5]); pw[3] = pg8::cvt_pk_bf16(pe[6], pe[7]);
                const bf16x8 pf = __builtin_bit_cast(bf16x8, pw);
#pragma unroll
                for (int d = 0; d < 4; ++d) o[qt][d] = __builtin_amdgcn_mfma_f32_16x16x32_bf16(vf[d], pf, o[qt][d], 0, 0, 0);
            }
        }
#pragma unroll
        for (int qt = 0; qt < 4; ++qt) {
            float lv = l[qt]; lv += __shfl_xor(lv, 16); lv += __shfl_xor(lv, 32);
            const float inv = frcp(lv);
            const float inv8 = inv * ACT8;
            unsigned char* op = Ob + qt * 16 * 512 + lane_o;
#pragma unroll
            for (int d = 0; d < 4; ++d) *(unsigned*)(op + d * 16) = pk4_fp8(o[qt][d][0] * inv8, o[qt][d][1] * inv8, o[qt][d][2] * inv8, o[qt][d][3] * inv8);
        }
    }
}

typedef __bf16 bf16x2_t __attribute__((ext_vector_type(2)));
__device__ __forceinline__ float dot2bf(unsigned a, unsigned b, float c) { return __builtin_amdgcn_fdot2_f32_bf16(__builtin_bit_cast(bf16x2_t, a), __builtin_bit_cast(bf16x2_t, b), c, false); }
__device__ __forceinline__ unsigned ordkey(float f) { unsigned u = __builtin_bit_cast(unsigned, f); return u ^ ((unsigned)((int)u >> 31) | 0x80000000u); }
__device__ __forceinline__ float unordkey(unsigned k) { return __builtin_bit_cast(float, k ^ ((k & 0x80000000u) ? 0x80000000u : 0xFFFFFFFFu)); }
__device__ __forceinline__ float kmax(float a, float b) { float r; asm("v_max_f32 %0, %1, %2" : "=v"(r) : "v"(a), "v"(b)); return r; }
__device__ __forceinline__ float kmin(float a, float b) { float r; asm("v_min_f32 %0, %1, %2" : "=v"(r) : "v"(a), "v"(b)); return r; }
template <bool DESC> __device__ __forceinline__ void cex(float& a, float& b) { const float mx = kmax(a, b), mn = kmin(a, b); if (DESC) { a = mx; b = mn; } else { a = mn; b = mx; } }
__device__ __forceinline__ void sort16_desc(float (&a)[16]) {
#pragma unroll
    for (int k = 2; k <= 16; k <<= 1)
#pragma unroll
        for (int j = k >> 1; j > 0; j >>= 1)
#pragma unroll
            for (int i = 0; i < 16; ++i) { const int l = i ^ j; if (l > i) { if ((i & k) == 0) cex<true>(a[i], a[l]); else cex<false>(a[i], a[l]); } }
}
__device__ __forceinline__ void merge16_desc(float (&a)[16]) {
#pragma unroll
    for (int j = 8; j > 0; j >>= 1)
#pragma unroll
        for (int i = 0; i < 16; ++i) { const int l = i ^ j; if (l > i) cex<true>(a[i], a[l]); }
}
__device__ __forceinline__ void top16_merge(float (&a)[16], const float (&b)[16]) {
#pragma unroll
    for (int i = 0; i < 16; ++i) a[i] = kmax(a[i], b[15 - i]);
    merge16_desc(a);
}
__device__ __forceinline__ unsigned kbits(float k) { return __builtin_bit_cast(unsigned, k); }
__device__ __forceinline__ float kscore(float k) { return __builtin_bit_cast(float, __builtin_bit_cast(unsigned, k) & ~127u); }
struct PairTab { int i[52], j[52], n; };
constexpr PairTab make_pairs() { PairTab t{}; int n = 0; for (int i = 0; i < 16; ++i) for (int j = 0; j < 16; ++j) if ((i + 1) * (j + 1) <= 16) { t.i[n] = i; t.j[n] = j; ++n; } t.n = n; for (int k = n; k < 52; ++k) { t.i[k] = 0; t.j[k] = 0; } return t; }
constexpr PairTab PAIRS = make_pairs();
static_assert(PAIRS.n == 50, "50 candidate pairs");

constexpr int SK_LD = 136;
__device__ __forceinline__ void ph_peer_topk(const P& p, LAS unsigned char* lds) {
    int tid_ = threadIdx.x; asm volatile("" : "+v"(tid_));
    const int tid = tid_, wave = tid >> 6, lane = tid & 63;
    LAS bf16_t* sk = (LAS bf16_t*)lds;
    for (int e = tid; e < 2 * 128 * 16; e += NT) {
        const int row = e >> 4, c8 = (e & 15) * 8;
        const f32x4 a = *(const f32x4*)(p.subkeys + (size_t)row * 128 + c8), b = *(const f32x4*)(p.subkeys + (size_t)row * 128 + c8 + 4);
        u32x4 o; o.x = pk2(a[0], a[1]); o.y = pk2(a[2], a[3]); o.z = pk2(b[0], b[1]); o.w = pk2(b[2], b[3]);
        *(LAS u32x4*)(sk + row * SK_LD + c8) = o;
    }
    __syncthreads();
    const int lt = lane & 15, lq = lane >> 4;
    for (int tile = blockIdx.x * NWAVES + wave; tile < NTOK / 16; tile += gridDim.x * NWAVES) {
        const int tok = tile * 16 + lt;
        const bf16_t* qrow = p.qp() + (size_t)tok * 2048;
        for (int h = 0; h < 8; ++h) {
            float s0[16], s1[16];
#pragma unroll
            for (int n = 0; n < 2; ++n) {
                bf16x8 bq[4];
#pragma unroll
                for (int ks = 0; ks < 4; ++ks) bq[ks] = *(const bf16x8*)(qrow + h * 256 + n * 128 + ks * 32 + lq * 8);
                float a[16], b[16];
#pragma unroll
                for (int kb = 0; kb < 8; ++kb) {
                    f32x4 c = {0.f, 0.f, 0.f, 0.f};
#pragma unroll
                    for (int ks = 0; ks < 4; ++ks) {
                        const bf16x8 ak = *(const LAS bf16x8*)(sk + (n * 128 + kb * 16 + lt) * SK_LD + ks * 32 + lq * 8);
                        c = __builtin_amdgcn_mfma_f32_16x16x32_bf16(ak, bq[ks], c, 0, 0, 0);
                    }
#pragma unroll
                    for (int r = 0; r < 4; ++r) {
                        const float cr = c[r];
                        const float key = __builtin_bit_cast(float, (__builtin_bit_cast(unsigned, cr) & ~127u) | (unsigned)(kb * 16 + lq * 4 + r));
                        if (kb < 4) a[kb * 4 + r] = key; else b[(kb - 4) * 4 + r] = key;
                    }
                    asm volatile("" ::: "memory");
                }
                sort16_desc(a); sort16_desc(b);
                top16_merge(a, b);
#pragma unroll
                for (int i = 0; i < 16; ++i) b[i] = __shfl_xor(a[i], 16);
                top16_merge(a, b);
#pragma unroll
                for (int i = 0; i < 16; ++i) b[i] = __shfl_xor(a[i], 32);
                top16_merge(a, b);
                if (n == 0) {
#pragma unroll
                    for (int i = 0; i < 16; ++i) s0[i] = a[i];
                } else {
#pragma unroll
                    for (int i = 0; i < 16; ++i) s1[i] = a[i];
                }
            }
            float ck[16], cs[13]; unsigned ce_[13];
#pragma unroll
            for (int s = 0; s < 13; ++s) {
                const float k0 = lq == 0 ? s0[PAIRS.i[s * 4]] : (lq == 1 ? s0[PAIRS.i[s * 4 + 1]] : (lq == 2 ? s0[PAIRS.i[s * 4 + 2]] : s0[PAIRS.i[s * 4 + 3]]));
                const float k1 = lq == 0 ? s1[PAIRS.j[s * 4]] : (lq == 1 ? s1[PAIRS.j[s * 4 + 1]] : (lq == 2 ? s1[PAIRS.j[s * 4 + 2]] : s1[PAIRS.j[s * 4 + 3]]));
                const float sum = kscore(k0) + kscore(k1);
                const bool valid = (s * 4 + lq) < PAIRS.n;
                cs[s] = sum; ce_[s] = (kbits(k0) & 127u) * 128u + (kbits(k1) & 127u);
                ck[s] = valid ? __builtin_bit_cast(float, (__builtin_bit_cast(unsigned, sum) & ~63u) | (unsigned)(s * 4 + lq)) : -__builtin_inff();
            }
            ck[13] = -__builtin_inff(); ck[14] = -__builtin_inff(); ck[15] = -__builtin_inff();
            float srt[16], ob[16];
#pragma unroll
            for (int i = 0; i < 16; ++i) srt[i] = ck[i];
            sort16_desc(srt);
#pragma unroll
            for (int i = 0; i < 16; ++i) ob[i] = __shfl_xor(srt[i], 16);
            top16_merge(srt, ob);
#pragma unroll
            for (int i = 0; i < 16; ++i) ob[i] = __shfl_xor(srt[i], 32);
            float thr = __builtin_inff();
#pragma unroll
            for (int i = 0; i < 16; ++i) thr = kmin(thr, kmax(srt[i], ob[15 - i]));
            const float mtop = kscore(s0[0]) + kscore(s1[0]);
            float zp = 0.f; int cnt = 0;
#pragma unroll
            for (int s = 0; s < 13; ++s) { const bool sel = ck[s] >= thr; const float e = sel ? __expf(cs[s] - mtop) : 0.f; cs[s] = e; zp += e; cnt += sel ? 1 : 0; }
            float z = zp; z += __shfl_xor(z, 16); z += __shfl_xor(z, 32);
            const float rz = frcp(z);
            const int c0 = __shfl(cnt, lt), c1 = __shfl(cnt, lt + 16), c2 = __shfl(cnt, lt + 32);
            int pos = lq == 0 ? 0 : (lq == 1 ? c0 : (lq == 2 ? c0 + c1 : c0 + c1 + c2));
            unsigned short* dste = (unsigned short*)p.topk() + ((size_t)tok * 8 + h) * 16; float* dstg = p.gates() + ((size_t)tok * 8 + h) * 16;
#pragma unroll
            for (int s = 0; s < 13; ++s) {
                const bool sel = ck[s] >= thr;
                if (sel) { dste[pos] = (unsigned short)ce_[s]; dstg[pos] = cs[s] * rz; ++pos; }
            }
        }
    }
}

__device__ __forceinline__ unsigned xcc_id() { return (unsigned)__builtin_amdgcn_s_getreg((3 << 11) | 20) & 7u; }
__device__ __forceinline__ int q_grab(unsigned* head, int lane) { unsigned v = 0u; if (lane == 0) v = __hip_atomic_fetch_add(head, 16u, __ATOMIC_RELAXED, __HIP_MEMORY_SCOPE_AGENT); return (int)__builtin_amdgcn_readfirstlane(v); }

__device__ __forceinline__ void g_ids(const unsigned short* tkrow, unsigned lo_g16, u32x4 (&ids)[2]) {
#pragma unroll
    for (int q = 0; q < 2; ++q) ids[q] = *(const u32x4*)(tkrow + lo_g16 + q * 8);
}
__device__ __forceinline__ void g_wts(const float* wrow, unsigned lo_g16, u32x4 (&wts)[4]) {
#pragma unroll
    for (int q = 0; q < 4; ++q) wts[q] = *(const u32x4*)(wrow + lo_g16 + q * 4);
}
__device__ __forceinline__ void g_rows8(const unsigned char* tb, unsigned lo_c16, const u32x4& idh, u32x4 (&rows)[8]) {
#pragma unroll
    for (int i = 0; i < 8; ++i) {
        const unsigned w = idh[i >> 1];
        unsigned off; const unsigned k128 = 128u;
        if (i & 1) asm("v_mad_u32_u16 %0, %1, %2, %3 op_sel:[1,0,0,0]" : "=v"(off) : "v"(w), "s"(k128), "v"(lo_c16));
        else asm("v_mad_u32_u16 %0, %1, %2, %3" : "=v"(off) : "v"(w), "s"(k128), "v"(lo_c16));
        rows[i] = *(const u32x4*)(tb + off);
    }
}
typedef _Float16 f16x2 __attribute__((ext_vector_type(2)));
__device__ __forceinline__ void g_dots8_i4(const u32x4 (&uu)[8], const unsigned (&hqh)[4], const unsigned (&hql)[4], int* pd) {
#pragma unroll
    for (int i = 0; i < 8; ++i) {
        int dh = 0, dl = 0;
#pragma unroll
        for (int j = 0; j < 4; ++j) { dh = __builtin_amdgcn_sdot8((int)uu[i][j], (int)hqh[j], dh, false); dl = __builtin_amdgcn_sdot8((int)uu[i][j], (int)hql[j], dl, false); }
        pd[i] = dh * 16 + dl;
    }
}
__device__ __forceinline__ void halve16_c8(const int (&v)[16], int b4, int b2, int b1, int& o0, int& o1) {
    int r8[8], r4[4];
#pragma unroll
    for (int i = 0; i < 8; ++i) { const int keep = b4 ? v[i + 8] : v[i], send = b4 ? v[i] : v[i + 8]; r8[i] = keep + dpp_i<DPP_HMIRROR>(send); }
#pragma unroll
    for (int i = 0; i < 4; ++i) { const int keep = b2 ? r8[i + 4] : r8[i], send = b2 ? r8[i] : r8[i + 4]; r4[i] = keep + dpp_i<DPP_XOR2>(send); }
    { const int keep = b1 ? r4[2] : r4[0], send = b1 ? r4[0] : r4[2]; o0 = keep + dpp_i<DPP_XOR1>(send); }
    { const int keep = b1 ? r4[3] : r4[1], send = b1 ? r4[1] : r4[3]; o1 = keep + dpp_i<DPP_XOR1>(send); }
}
template <bool FIRST>
__device__ __forceinline__ void g_acc8q(const u32x4 (&vv)[8], const u32x4& w0, const u32x4& w1, f16x2 (&acc)[16]) {
#pragma unroll
    for (int i = 0; i < 8; ++i) {
        const unsigned wu = i < 4 ? w0[i & 3] : w1[i & 3];
        const f16x2 w = __builtin_bit_cast(f16x2, wu);
#pragma unroll
        for (int j = 0; j < 4; ++j) {
            const unsigned wv = vv[i][j];
            const f16x2 v0 = __builtin_bit_cast(f16x2, __builtin_amdgcn_cvt_scalef32_pk_f16_fp4(wv, 0.00390625f, 0)), v1 = __builtin_bit_cast(f16x2, __builtin_amdgcn_cvt_scalef32_pk_f16_fp4(wv, 0.00390625f, 1));
            const f16x2 v2 = __builtin_bit_cast(f16x2, __builtin_amdgcn_cvt_scalef32_pk_f16_fp4(wv, 0.00390625f, 2)), v3 = __builtin_bit_cast(f16x2, __builtin_amdgcn_cvt_scalef32_pk_f16_fp4(wv, 0.00390625f, 3));
            if (FIRST && i == 0) { acc[j * 4 + 0] = v0 * w; acc[j * 4 + 1] = v1 * w; acc[j * 4 + 2] = v2 * w; acc[j * 4 + 3] = v3 * w; }
            else { acc[j * 4 + 0] = __builtin_elementwise_fma(v0, w, acc[j * 4 + 0]); acc[j * 4 + 1] = __builtin_elementwise_fma(v1, w, acc[j * 4 + 1]);
                   acc[j * 4 + 2] = __builtin_elementwise_fma(v2, w, acc[j * 4 + 2]); acc[j * 4 + 3] = __builtin_elementwise_fma(v3, w, acc[j * 4 + 3]); }
        }
    }
}
__device__ __forceinline__ void halve16h(const f16x2 (&v)[16], int b1, f16x2& o0, f16x2& o1) {
    f16x2 r8[8], r4[4];
#pragma unroll
    for (int i = 0; i < 8; ++i) { const u32x2 sw = __builtin_amdgcn_permlane32_swap(__builtin_bit_cast(unsigned, v[i]), __builtin_bit_cast(unsigned, v[i + 8]), false, false);
        const unsigned s0 = sw[0], s1 = sw[1];
        r8[i] = __builtin_bit_cast(f16x2, s0) + __builtin_bit_cast(f16x2, s1); }
#pragma unroll
    for (int i = 0; i < 4; ++i) { const u32x2 sw = __builtin_amdgcn_permlane16_swap(__builtin_bit_cast(unsigned, r8[i]), __builtin_bit_cast(unsigned, r8[i + 4]), false, false);
        const unsigned s0 = sw[0], s1 = sw[1];
        r4[i] = __builtin_bit_cast(f16x2, s0) + __builtin_bit_cast(f16x2, s1); }
#pragma unroll
    for (int i = 0; i < 2; ++i) {
        const unsigned keep = __builtin_bit_cast(unsigned, b1 ? r4[i + 2] : r4[i]), send = __builtin_bit_cast(unsigned, b1 ? r4[i] : r4[i + 2]);
        const f16x2 r = __builtin_bit_cast(f16x2, keep) + __builtin_bit_cast(f16x2, (unsigned)__builtin_amdgcn_update_dpp(0, (int)send, 0x128, 0xf, 0xf, true));
        if (i == 0) o0 = r; else o1 = r;
    }
}

template <int WHICH>
__device__ __forceinline__ void ph_gather_sliced(const P& p, LAS unsigned char* lds) {
    int tid_ = threadIdx.x; asm volatile("" : "+v"(tid_));
    const int lane = tid_ & 63, c = lane & 7, g = lane >> 3;
    LAS unsigned char* wlds = lds + __builtin_amdgcn_readfirstlane(tid_ >> 6) * 8192;
    const unsigned xs = xcc_id();
    constexpr int NSL = 4, SLW = DM / NSL;
    for (unsigned tr = 0; tr < NSL; ++tr) {
        const int sl = (int)((xs + tr) & (unsigned)(NSL - 1));
        unsigned* head = p.queues() + (WHICH * 8 + sl) * 64;
        const unsigned char* tb = (WHICH == 0 ? p.pu8() : p.pv8()) + (size_t)sl * (16384 * 128);
        for (;;) {
            const int t0 = q_grab(head, lane);
            if (t0 >= NTOK) break;
            unsigned oc = c * 16, og = g * 16; asm volatile("" : "+v"(oc), "+v"(og));
            const unsigned short* idb = (const unsigned short*)p.topk() + (size_t)t0 * 128;
            const float* wb = p.wl() + (size_t)t0 * 128;
            const float* modb = p.mod() + (size_t)(t0 >> 12) * (6 * DM) + sl * SLW;
            u32x4 idc[2], idn[2], RA[8], RB[8], wc[4];
            g_ids(idb, og, idc); if (WHICH == 1) g_wts(wb, og, wc);
            g_rows8(tb, oc, idc[0], RA);
            if (WHICH == 0) {
                {
                    unsigned l4 = lane * 4; asm volatile("" : "+v"(l4));
                    const bf16_t* xg = p.x1b() + (size_t)t0 * DM + sl * SLW;
                    f32x4 A, Bs;
                    { const f32x4 gg = *(const f32x4*)(p.norm2_g + sl * SLW + l4), sh = *(const f32x4*)(modb + 3 * DM + l4), sc = *(const f32x4*)(modb + 4 * DM + l4);
#pragma unroll
                      for (int i = 0; i < 4; ++i) { A[i] = gg[i] * (1.f + sc[i]); Bs[i] = sh[i]; } }
                    const float rsl = rstd_from_fix(p.rowss()[t0 + (lane & 15)]);
                    {
                        u32x2 xw[16];
#pragma unroll
                        for (int k = 0; k < 16; ++k) xw[k] = *(const u32x2*)(xg + (size_t)k * DM + l4);
#pragma unroll
                        for (int k = 0; k < 16; ++k) {
                            const int tk = k;
                            const float rstd = __builtin_bit_cast(float, __builtin_amdgcn_readlane(__builtin_bit_cast(unsigned, rsl), tk));
                            float h[4], am = 0.f;
                            const unsigned x01 = xw[k][0], x23 = xw[k][1];
                            const float xf[4] = {bflo(x01), bfhi(x01), bflo(x23), bfhi(x23)};
#pragma unroll
                            for (int i = 0; i < 4; ++i) { h[i] = xf[i] * rstd * A[i] + Bs[i]; am = fmaxf(am, fabsf(h[i])); }
                            am = fmaxf(am, dpp_f<DPP_XOR1>(am)); am = fmaxf(am, dpp_f<DPP_XOR2>(am)); am = fmaxf(am, dpp_f<DPP_HMIRROR>(am)); am = fmaxf(am, dpp_f<DPP_ROR8>(am));
                            { const u32x2 sw = __builtin_amdgcn_permlane16_swap(__builtin_bit_cast(unsigned, am), __builtin_bit_cast(unsigned, am), false, false); const unsigned s0 = sw[0], s1 = sw[1];
                              am = fmaxf(__builtin_bit_cast(float, s0), __builtin_bit_cast(float, s1)); }
                            { const u32x2 sw = __builtin_amdgcn_permlane32_swap(__builtin_bit_cast(unsigned, am), __builtin_bit_cast(unsigned, am), false, false); const unsigned s0 = sw[0], s1 = sw[1];
                              am = fmaxf(__builtin_bit_cast(float, s0), __builtin_bit_cast(float, s1)); }
                            am = fmaxf(am, 1e-30f);
                            const float hs = 119.f * frcp(am);
                            unsigned whi = 0u, wlo = 0u;
#pragma unroll
                            for (int i = 0; i < 4; ++i) {
                                const unsigned qb = __builtin_bit_cast(unsigned, h[i] * hs + I8_MAGIC);
                                wlo |= (qb & 15u) << (4 * i);
                                whi |= (((qb + 8u) >> 4) & 15u) << (4 * i);
                            }
                            *(LAS unsigned short*)(wlds + tk * 256 + lane * 2) = (unsigned short)whi;
                            *(LAS unsigned short*)(wlds + tk * 256 + 128 + lane * 2) = (unsigned short)wlo;
                            *(LAS float*)(wlds + 4096 + tk * 4) = am * (1.f / 119.f);
                        }
                    }
                    asm volatile("s_waitcnt lgkmcnt(0)" ::: "memory");
                }
                const unsigned lo_st = og + 2 * (c & 1) + 4 * ((c >> 1) & 1) + 8 * ((c >> 2) & 1);
                float* apb = p.apart() + ((size_t)sl * NTOK + t0) * 128;
#define G1_TOKEN(tt, IDC, IDN, MORE) do { \
                    g_rows8(tb, oc, IDC[1], RB); \
                    if (MORE) g_ids(idb + ((tt) + 1) * 128, og, IDN); \
                    const u32x4 hh4 = *(const LAS u32x4*)(wlds + (tt) * 256 + oc), hl4 = *(const LAS u32x4*)(wlds + (tt) * 256 + 128 + oc); \
                    const float hinv = *(const LAS float*)(wlds + 4096 + (tt) * 4); \
                    const unsigned hqh[4] = {hh4[0], hh4[1], hh4[2], hh4[3]}, hql[4] = {hl4[0], hl4[1], hl4[2], hl4[3]}; \
                    int pd[16]; \
                    g_dots8_i4(RA, hqh, hql, pd); \
                    if (MORE) g_rows8(tb, oc, IDN[0], RA); \
                    g_dots8_i4(RB, hqh, hql, pd + 8); \
                    int o0, o1; halve16_c8(pd, c & 4, c & 2, c & 1, o0, o1); \
                    f32x2 st; st[0] = (float)o0 * hinv; st[1] = (float)o1 * hinv; \
                    *(f32x2*)(apb + (tt) * 128 + lo_st) = st; } while (0)
#pragma unroll 1
                for (int tt = 0; tt < 16; tt += 2) {
                    G1_TOKEN(tt, idc, idn, true);
                    const bool more = tt + 2 < 16;
                    G1_TOKEN(tt + 1, idn, idc, more);
                }
#undef G1_TOKEN
            } else {
                const unsigned lo_col = 2 * oc + 4 * (g & 1) + 8 * ((g >> 1) & 1) + 16 * ((g >> 2) & 1);
                bf16_t* xb = p.x1b() + (size_t)t0 * DM + sl * SLW;
                const f32x4 g2 = *(const f32x4*)(modb + 5 * DM + lo_col);
                u32x2 x1n = *(const u32x2*)(xb + lo_col);
                u32x4 wd[4];
#define G2_TOKEN(tt, IDC, IDN, WC, WN, MORE) do { \
                    g_rows8(tb, oc, IDC[1], RB); \
                    const unsigned x01 = x1n[0], x23 = x1n[1]; \
                    if (MORE) { g_ids(idb + ((tt) + 1) * 128, og, IDN); g_wts(wb + ((tt) + 1) * 128, og, WN); x1n = *(const u32x2*)(xb + (size_t)((tt) + 1) * DM + lo_col); } \
                    f16x2 acc[16]; \
                    g_acc8q<true>(RA, WC[0], WC[1], acc); \
                    if (MORE) g_rows8(tb, oc, IDN[0], RA); \
                    g_acc8q<false>(RB, WC[2], WC[3], acc); \
                    f16x2 oa, ob; halve16h(acc, g & 1, oa, ob); \
                    u32x2 x2; x2[0] = pg8::cvt_pk_bf16(bflo(x01) + g2[0] * (float)oa[0], bfhi(x01) + g2[1] * (float)oa[1]); x2[1] = pg8::cvt_pk_bf16(bflo(x23) + g2[2] * (float)ob[0], bfhi(x23) + g2[3] * (float)ob[1]); \
                    *(u32x2*)(xb + (size_t)(tt) * DM + lo_col) = x2; } while (0)
#pragma unroll 1
                for (int tt = 0; tt < 16; tt += 2) {
                    G2_TOKEN(tt, idc, idn, wc, wd, true);
                    const bool more = tt + 2 < 16;
                    G2_TOKEN(tt + 1, idn, idc, wd, wc, more);
                }
#undef G2_TOKEN
            }
        }
    }
}
__device__ __forceinline__ void ph_gather_weights(const P& p) {
    int tid_ = threadIdx.x; asm volatile("" : "+v"(tid_));
    const size_t gsz = (size_t)gridDim.x * NT;
    const float* isc = p.pisc();
    for (size_t i = (size_t)blockIdx.x * NT + tid_; i < (size_t)NTOK * 128; i += gsz) {
        const unsigned e = ((const unsigned short*)p.topk())[i]; const float gate = p.gates()[i];
        const f32x4 su = *(const f32x4*)(p.pisc_u() + (size_t)e * 4);
        float a = 0.f;
#pragma unroll
        for (int sl = 0; sl < 4; ++sl) a += p.apart()[(size_t)sl * NTOK * 128 + i] * su[sl];
        const float w = gate * isc[16384 + e] * gelu_tanh(a) * 256.f;
        const unsigned short hw = __builtin_bit_cast(unsigned short, (_Float16)w);
        ((unsigned*)p.wl())[i] = (unsigned)hw | ((unsigned)hw << 16);
    }
}
__device__ __forceinline__ void ph_final_norm(const P& p) {
    int tid_ = threadIdx.x; asm volatile("" : "+v"(tid_));
    const int wave = __builtin_amdgcn_readfirstlane(tid_ >> 6), lane = tid_ & 63;
    for (int t4 = blockIdx.x * NWAVES + wave; t4 < NTOK / 4; t4 += gridDim.x * NWAVES) {
        const u32x4* src = (const u32x4*)(p.x1b() + (size_t)t4 * 4 * DM);
        f32x4* row = (f32x4*)(p.out + (size_t)t4 * 4 * DM);
        u32x4 vw[4][2];
#pragma unroll
        for (int k = 0; k < 4; ++k)
#pragma unroll
            for (int j = 0; j < 2; ++j) vw[k][j] = src[k * (DM / 8) + lane + 64 * j];
#pragma unroll
        for (int k = 0; k < 4; ++k) {
            f32x4 v[4]; float ss = 0.f;
#pragma unroll
            for (int j = 0; j < 2; ++j) {
                const unsigned w0 = vw[k][j][0], w1 = vw[k][j][1], w2 = vw[k][j][2], w3 = vw[k][j][3];
                v[j * 2] = (f32x4){bflo(w0), bfhi(w0), bflo(w1), bfhi(w1)}; v[j * 2 + 1] = (f32x4){bflo(w2), bfhi(w2), bflo(w3), bfhi(w3)};
            }
#pragma unroll
            for (int j = 0; j < 4; ++j) ss += v[j][0] * v[j][0] + v[j][1] * v[j][1] + v[j][2] * v[j][2] + v[j][3] * v[j][3];
            ss = wave_sum(ss);
            const float rstd = rsqrtf(ss * (1.f / DM) + EPSN);
#pragma unroll
            for (int j = 0; j < 4; ++j) { const int i4 = (lane + 64 * (j >> 1)) * 2 + (j & 1); const f32x4 fg = ((const f32x4*)p.final_g)[i4]; row[k * (DM / 4) + i4] = v[j] * rstd * fg; }
        }
    }
}

#define XB_TMO      128
#define XB_XCNT(j)  (256  + 64 * (j))
#define XB_XSUB(j)  (1280 + 64 * (j))
#define XB_XGEN(j)  (2304 + 64 * (j))
#define XB_TOP      3328
#define XB_TOPGEN   3392
#define XCD_BAR_WORDS 3456
#define XB_SPIN_CAP (1u << 18)
__device__ __forceinline__ unsigned xb_ld(unsigned* p)              { return __hip_atomic_load(p, __ATOMIC_RELAXED, __HIP_MEMORY_SCOPE_AGENT); }
__device__ __forceinline__ unsigned xb_add(unsigned* p, unsigned v) { return __hip_atomic_fetch_add(p, v, __ATOMIC_RELAXED, __HIP_MEMORY_SCOPE_AGENT); }
__device__ __forceinline__ unsigned xb_xcc_id() { return (unsigned)__builtin_amdgcn_s_getreg((3 << 11) | 20) & 0xFu; }
#define XB_SPIN(cond, bar) do { unsigned _sp = 0; while (cond) { __builtin_amdgcn_s_sleep(1); \
    if ((++_sp & 255u) == 0u) { if (xb_ld(&(bar)[XB_TMO])) break; if (_sp > XB_SPIN_CAP) { atomicAdd(&(bar)[XB_TMO], 1u); break; } } } } while (0)
struct XcdBarrier { unsigned* bar; unsigned x; volatile LAS unsigned* st; };
__device__ __forceinline__ XcdBarrier xcd_barrier_post(unsigned* bar, volatile LAS unsigned* st) {
    XcdBarrier b; b.bar = bar; b.x = xb_xcc_id(); b.st = st;
    if (threadIdx.x == 0) (void)xb_add(&bar[XB_XCNT(b.x)], 1u);
    return b;
}
__device__ __forceinline__ void xcd_barrier_complete(unsigned* bar, unsigned x, unsigned& nloc, unsigned& nx) {
    const unsigned G = gridDim.x * gridDim.y * gridDim.z;
    unsigned sum, cnt, mine, sp = 0u;
    for (;;) {
        sum = 0u; cnt = 0u; mine = 0u;
#pragma unroll
        for (unsigned j = 0; j < 16; ++j) { const unsigned c = xb_ld(&bar[XB_XCNT(j)]); sum += c; cnt += (c > 0u) ? 1u : 0u; mine = (j == x) ? c : mine; }
        if (sum == G) break;
        __builtin_amdgcn_s_sleep(1);
        if ((++sp & 255u) == 0u) { if (xb_ld(&bar[XB_TMO])) break; if (sp > XB_SPIN_CAP) { atomicAdd(&bar[XB_TMO], 1u); break; } }
    }
    nloc = mine > 0u ? mine : 1u; nx = cnt > 0u ? cnt : 1u;
}
__device__ __forceinline__ void xcd_barrier(const XcdBarrier& b) {
    asm volatile("s_waitcnt vmcnt(0)" ::: "memory");
    __syncthreads();
    if (threadIdx.x == 0) {
        unsigned* bar = b.bar;
        __builtin_amdgcn_s_waitcnt(0);
        unsigned nloc = b.st[0], nx = b.st[1];
        if (nloc == 0u) { xcd_barrier_complete(bar, b.x, nloc, nx); b.st[0] = nloc; b.st[1] = nx; }
        const unsigned old = xb_add(&bar[XB_XSUB(b.x)], 1u);
        const unsigned gen = old / nloc;
        if (old + 1u == (gen + 1u) * nloc) {
            __builtin_amdgcn_fence(__ATOMIC_RELEASE, "agent");
            asm volatile("s_waitcnt vmcnt(0)" ::: "memory");
            const unsigned og = xb_add(&bar[XB_TOP], 1u);
            const unsigned tg = og / nx;
            if (og + 1u == (tg + 1u) * nx) xb_add(&bar[XB_TOPGEN], 1u);
            else XB_SPIN(xb_ld(&bar[XB_TOPGEN]) == tg, bar);
            __builtin_amdgcn_fence(__ATOMIC_ACQUIRE, "agent");
            xb_add(&bar[XB_XGEN(b.x)], 1u);
            asm volatile("s_waitcnt vmcnt(0)" ::: "memory");
        } else {
            XB_SPIN(xb_ld(&bar[XB_XGEN(b.x)]) == gen, bar);
            __builtin_amdgcn_fence(__ATOMIC_ACQUIRE, "agent");
            asm volatile("s_waitcnt vmcnt(0)" ::: "memory");
        }
    }
    __syncthreads();
}

constexpr int LDS_BYTES = 147456;
#define GSYNC() xcd_barrier(xbar)
constexpr int MISC_OFF = LDS_BYTES - 64;

__global__ void __launch_bounds__(NT, 2) mega(P p) {
    extern __shared__ __attribute__((aligned(16))) unsigned char lds_raw[];
    LAS unsigned char* lds = (LAS unsigned char*)lds_raw;
    const int G = gridDim.x, bx = blockIdx.x;
    using namespace pg8;
    if (threadIdx.x < 16) ((LAS unsigned*)(lds + MISC_OFF))[threadIdx.x] = 0u;
    for (unsigned i = (unsigned)bx * NT + threadIdx.x; i < (1u << 20) / 8u; i += (unsigned)G * NT) ((unsigned long long*)p.ws)[i] = 0ull;
    cg::this_grid().sync();
    const XcdBarrier xbar = xcd_barrier_post((unsigned*)p.ws, (volatile LAS unsigned*)(lds + MISC_OFF));

    ph_prep(p, lds);
    GSYNC();
    ph_norm1(p, lds);
    GSYNC();
    {
        Gemm<DM / 2, DM / 2, DM / 2, 0, 0, true> g{p.hx(), p.w_in_t()}; StaticOrder<NTOK, INC> S; S.init(G, bx);
        EpiInProj E{p.U(), p.kb(), (size_t)(p.qb() - p.kb()), p.vT(), p.ga(), 0};
        gemm_phase<EpiInProj, StaticOrder<NTOK, INC>, true, true>(lds, g, S, E);
        Gemm<DM / 2, DM / 2, DM / 2, 0, 0, true> g2{p.hc(), p.w_in_t()}; StaticOrder<NCTX, CTXC> S2; S2.init(G, bx);
        EpiInProj E2{p.U(), p.kc(), 0, p.vcT(), p.ga(), 1};
        gemm_phase<EpiInProj, StaticOrder<NCTX, CTXC>, true, true>(lds, g2, S2, E2);
    }
    for (int it = bx - 48; it >= 0 && it < 128; it += G) ssm_prep_item(p, lds, it);
    for (int cb = bx - 176; cb >= 0 && cb < 32; cb += G) {
        const float* m3 = p.mod() + 3 * DM;
        const float* const rows[8] = {m3, m3 + 6 * DM, m3 + 12 * DM, m3 + 18 * DM, m3 + 24 * DM, m3 + 30 * DM, m3 + 36 * DM, m3 + 42 * DM};
        gemv_block64<8, false>(rows, p.w_q, 2048, cb * 64, nullptr, p.c2(), 2048, (LAS float*)lds);
    }
    bg_convert_tables(p);
    GSYNC();
    {
        Gemm<512, SSM_LD, 512, (long)SSM_ROWS * SSM_LD, 256L * 512> g{p.U(), p.Win()}; StaticOrder<SSM_ROWS, 256, 32> S; S.init(G, bx);
        EpiE E{p.E()};
        gemm_phase<EpiE, StaticOrder<SSM_ROWS, 256, 32>, true, true>(lds, g, S, E);
    }
    GSYNC();
    ph_carry(p);
    ph_na(p, lds);
    GSYNC();
    {
        Gemm<SSM_LD, SSM_LD, SSM_LD, (long)SSM_ROWS * SSM_LD, 512L * SSM_LD> g{p.U(), p.Kmat()}; StaticOrder<1024, 512, 32> S; S.init(G, bx);
        EpiZ E{p.z()};
        gemm_phase<EpiZ, StaticOrder<1024, 512, 32>, true, true>(lds, g, S, E);
    }
    GSYNC();
    {
        Gemm<512, 512, 512> g{p.z(), p.w_glu_t()}; StaticOrder<NTOK, 512> S; S.init(G, bx);
        EpiGlu E{p.gl(), p.z(), p.b_glu};
        gemm_phase<EpiGlu, StaticOrder<NTOK, 512>, true, true>(lds, g, S, E);
    }
    GSYNC();
    {
        Gemm<256, 256, 256, 32L * 1024 * 1024, 512L * 1024, true> g{p.na(), p.w_b_t()}; PairOrder<NTOK, DM> S; S.init(G, bx);
        EpiMerge E{p.merged(), p.ga(), p.gb()};
        gemm_phase<EpiMerge, PairOrder<NTOK, DM>, true, true>(lds, g, S, E);
    }
    GSYNC();
    {
        Gemm<DM / 2, DM / 2, DM / 2, 0, 0, true> g{p.merged(), p.w_out_t()}; StaticOrder<NTOK, DM> S; S.init(G, bx);
        EpiOut E{p.x, p.x1b(), p.x1g(), p.mod(), p.norm2_g, p.rowss()};
        gemm_phase<EpiOut, StaticOrder<NTOK, DM>, true, true>(lds, g, S, E);
    }
    GSYNC();
    {
        Gemm<DM, DM, DM> g{p.x1g(), p.w_q_t()}; StaticOrder<NTOK, 2048> S; S.init(G, bx);
        EpiQ E{p.qp(), p.rowss(), p.c2()};
        gemm_phase<EpiQ, StaticOrder<NTOK, 2048>, true, true>(lds, g, S, E);
    }
    GSYNC();
    ph_peer_topk(p, lds);
    GSYNC();
    ph_gather_sliced<0>(p, lds);
    GSYNC();
    ph_gather_weights(p);
    GSYNC();
    ph_gather_sliced<1>(p, lds);
    GSYNC();
    ph_final_norm(p);
}

extern "C" void kernel_launch(void* const* d_in, const int* in_sizes, int n_in, void* d_out, int out_size, void* d_ws, size_t ws_size, hipStream_t stream) {
    static int grid = 0;
    if (grid == 0) {
        int dev = 0, cus = 0, per_cu = 0;
        (void)hipGetDevice(&dev);
        (void)hipDeviceGetAttribute(&cus, hipDeviceAttributeMultiprocessorCount, dev);
        (void)hipFuncSetAttribute((const void*)mega, hipFuncAttributeMaxDynamicSharedMemorySize, LDS_BYTES);
        (void)hipOccupancyMaxActiveBlocksPerMultiprocessor(&per_cu, (const void*)mega, NT, LDS_BYTES);
        if (per_cu < 1) { fprintf(stderr, "occupancy query says %d blocks per CU\n", per_cu); per_cu = 1; }
        grid = cus;
    }
    P p{};
    const float* const* in = (const float* const*)d_in;
    p.x = in[0]; p.c = in[1]; p.ctx = in[2]; p.c_ctx = in[3]; p.w_mod = in[4]; p.b_mod = in[5]; p.norm1_g = in[6]; p.norm2_g = in[7]; p.w_in = in[8];
    p.a_re = in[9]; p.a_im = in[10]; p.log_dt = in[11]; p.b_re = in[12]; p.b_im = in[13]; p.c_re = in[14]; p.c_im = in[15]; p.ssm_d = in[16];
    p.w_glu = in[17]; p.b_glu = in[18]; p.w_a = in[19]; p.w_b = in[20]; p.rpb = in[21]; p.w_out = in[22]; p.w_q = in[23]; p.subkeys = in[24];
    p.peer_u = in[25]; p.peer_v = in[26]; p.final_g = in[27];
    p.out = (float*)d_out;
    p.ws = (unsigned char*)d_ws;
    void* args[] = {&p};
    hipError_t e = hipLaunchCooperativeKernel((const void*)mega, dim3(grid), dim3(NT), args, LDS_BYTES, stream);
    if (e != hipSuccess) fprintf(stderr, "cooperative launch failed: %s (grid %d)\n", hipGetErrorString(e), grid);
}
```

```cpp
#include <hip/hip_runtime.h>
#include <hip/hip_cooperative_groups.h>
#include <cstdio>
#include <cstdint>
namespace cg = cooperative_groups;

#define LAS __attribute__((address_space(3)))
typedef unsigned short bf16_t;
typedef short bf16x8 __attribute__((ext_vector_type(8)));
typedef float f32x4 __attribute__((ext_vector_type(4)));
typedef float f32x2 __attribute__((ext_vector_type(2)));
typedef unsigned u32x4 __attribute__((ext_vector_type(4)));
typedef unsigned u32x2 __attribute__((ext_vector_type(2)));

constexpr int DM = 1024, NB = 8, SEQL = 4096, CTXL = 256, GW = 64, NTOK = NB * SEQL, NCTX = NB * CTXL;
constexpr int INC = 4096, CTXC = 1536;
constexpr int NT = 512, NWAVES = 8;
constexpr float EPSN = 1e-6f;
constexpr int SSM_ROWS = 1280;
constexpr int SSM_LD = 768;

__device__ __forceinline__ unsigned f2bf(float f) { unsigned u = __builtin_bit_cast(unsigned, f); return (u + 0x7fffu + ((u >> 16) & 1u)) >> 16; }
__device__ __forceinline__ unsigned pk2(float lo, float hi) { return f2bf(lo) | (f2bf(hi) << 16); }
__device__ __forceinline__ float bflo(unsigned w) { return __builtin_bit_cast(float, w << 16); }
__device__ __forceinline__ float bfhi(unsigned w) { return __builtin_bit_cast(float, w & 0xffff0000u); }
__device__ __forceinline__ float bf2f(bf16_t h) { return __builtin_bit_cast(float, (unsigned)h << 16); }

__device__ __forceinline__ float wave_sum(float v) {
#pragma unroll
    for (int o = 1; o < 64; o <<= 1) v += __shfl_xor(v, o);
    return v;
}
__device__ __forceinline__ float wave_max(float v) {
#pragma unroll
    for (int o = 1; o < 64; o <<= 1) v = fmaxf(v, __shfl_xor(v, o));
    return v;
}
__device__ __forceinline__ float frcp(float x) { return __builtin_amdgcn_rcpf(x); }
__device__ __forceinline__ float sigmoidf_(float x) { return frcp(1.f + __expf(-x)); }
__device__ __forceinline__ float siluf_(float x) { return x * frcp(1.f + __expf(-x)); }
__device__ __forceinline__ float gelu_tanh(float x) {
    const float k0 = 0.7978845608028654f, k1 = 0.044715f;
    const float u = k0 * (x + k1 * x * x * x);
    const float t = 1.f - 2.f * frcp(1.f + __expf(2.f * u));
    return 0.5f * x * (1.f + t);
}

namespace pg8 {
#define PG8_LAS __attribute__((address_space(3)))
constexpr int BM = 256, BK = 64, HALF = 128, HTB = HALF * BK * 2  , STAGE_BYTES = 8 * HTB, NXCD = 8, WGM = 8;
__host__ __device__ __forceinline__ int lds_byte(int r, int c) { const int st = (r >> 4) * 2 + (c >> 5), rr = r & 15, cc = c & 31, ob = rr * 64 + cc * 2; return st * 1024 + (ob ^ (((ob >> 9) & 1) << 5)); }
__host__ __device__ __forceinline__ void stage_rc(int b, int& R, int& C) { const int st = b / 1024, sb = b % 1024, swz = sb ^ (((sb >> 9) & 1) << 5); R = (st >> 1) * 16 + swz / 64; C = (st & 1) * 32 + (swz % 64) / 2; }
__host__ __device__ __forceinline__ int perm32(int rho) { const int n = rho >> 4, i = rho & 15; return 8 * (i >> 2) + 4 * n + (i & 3); }

struct Unit { int pm, pn, g; };
template <int K_, int LDA, int LDB, long GSA = 0, long GSB = 0, bool FP8_ = false>
struct Gemm {
    const bf16_t* A; const bf16_t* Bt;
    static constexpr int K = K_, lda = LDA, ldb = LDB; static constexpr bool FP8 = FP8_;
    __device__ __forceinline__ const char* abase(const Unit& u) const { return (const char*)(A + (size_t)u.g * GSA + (size_t)u.pm * BM * LDA); }
    __device__ __forceinline__ const char* bbase(const Unit& u) const { return (const char*)(Bt + (size_t)u.g * GSB + (size_t)u.pn * BM * LDB); }
};
template <int M, int N, int NGRP = 1>
struct StaticOrder {
    static constexpr int nM = M / BM, nN = N / BM, nwg = nM * nN;
    int G, c;
    __device__ void init(int G_, int c_) { G = G_; c = c_; }
    __device__ bool next(int i, Unit& u) const {
        const int L = i * G + c; if (L >= nwg * NGRP) return false;
        u.g = L / nwg;
        int wgid = L % nwg; { constexpr int q = nwg / NXCD, r = nwg % NXCD; const int xcd = wgid % NXCD, off = wgid / NXCD; wgid = (xcd < r ? xcd * (q + 1) : r * (q + 1) + (xcd - r) * q) + off; }
        constexpr int nig = WGM * nN; const int gid = wgid / nig, fm = gid * WGM, gsz = (nM - fm) < WGM ? (nM - fm) : WGM;
        u.pm = fm + ((wgid % nig) % gsz); u.pn = (wgid % nig) / gsz; return true;
    }
    __device__ __forceinline__ void a_ready(const Unit&) const {}
    __device__ __forceinline__ void done(const Unit&) const {}
};
__device__ __forceinline__ unsigned cvt_pk_bf16(float lo, float hi) { unsigned r; asm volatile("v_cvt_pk_bf16_f32 %0, %1, %2" : "=v"(r) : "v"(lo), "v"(hi)); return r; }
typedef int i32x4 __attribute__((ext_vector_type(4)));
typedef int i32x8 __attribute__((ext_vector_type(8)));
template <class Epi, class Sched, bool ALIGN_EPI = false, bool SP2 = false, class GemmT>
__device__ __forceinline__ void gemm_phase(PG8_LAS unsigned char* lds, const GemmT g, const Sched& S, const Epi& E) {
    int tid_ = threadIdx.x; asm volatile("" : "+v"(tid_));
    const int tid = tid_, wid = __builtin_amdgcn_readfirstlane(tid >> 6), lane = tid & 63, wr = wid >> 2, wc = wid & 3, fr = lane & 15, fq = lane >> 4;
    const int K = g.K, nt = K / BK;
    unsigned voffA[2], voffB[2];
#pragma unroll
    for (int i = 0; i < 2; ++i) { int R, C; stage_rc(tid * 16 + i * 8192, R, C); const int Rb = Epi::PERM ? ((R & ~31) + perm32(R & 31)) : R;
        voffA[i] = (unsigned)(R * g.lda + C) * 2u; voffB[i] = (unsigned)(Rb * g.ldb + C) * 2u; }
    const size_t kstep = (size_t)(BK * 2);
    const size_t hstepA = (size_t)HALF * g.lda * 2, hstepB = (size_t)HALF * g.ldb * 2;
    const unsigned ldsw = (unsigned)wid * 1024u;
    const int aoff = lds_byte(wr * 64 + fr, fq * 8), boff = lds_byte(wc * 32 + fr, fq * 8);
#define PG8_SA(b, h) (((b) * 2 + (h)) * HTB)
#define PG8_SB(b, h) ((4 + (b) * 2 + (h)) * HTB)
#define PG8_STAGE(bufoff, gbase, voff) do { _Pragma("unroll") for (int _i = 0; _i < 2; ++_i) \
        __builtin_amdgcn_global_load_lds((const unsigned*)((const char*)(gbase) + (voff)[_i]), (PG8_LAS unsigned*)(lds + (bufoff) + ldsw + _i * 8192), 16, 0, 0); } while (0)
#define PG8_LDA(dst, b, h) do { if constexpr (GemmT::FP8) { _Pragma("unroll") for (int m = 0; m < 4; ++m) dst##8[m] = __builtin_shufflevector(*(const PG8_LAS i32x4*)(lds + PG8_SA(b, h) + aoff + m * 2048), *(const PG8_LAS i32x4*)(lds + PG8_SA(b, h) + aoff + m * 2048 + 1024), 0, 1, 2, 3, 4, 5, 6, 7); } \
        else { _Pragma("unroll") for (int m = 0; m < 4; ++m) _Pragma("unroll") for (int k = 0; k < 2; ++k) dst[m][k] = *(const PG8_LAS bf16x8*)(lds + PG8_SA(b, h) + aoff + m * 2048 + k * 1024); } } while (0)
#define PG8_LDB(dst, b, h) do { if constexpr (GemmT::FP8) { _Pragma("unroll") for (int n = 0; n < 2; ++n) dst##8[n] = __builtin_shufflevector(*(const PG8_LAS i32x4*)(lds + PG8_SB(b, h) + boff + n * 2048), *(const PG8_LAS i32x4*)(lds + PG8_SB(b, h) + boff + n * 2048 + 1024), 0, 1, 2, 3, 4, 5, 6, 7); } \
        else { _Pragma("unroll") for (int n = 0; n < 2; ++n) _Pragma("unroll") for (int k = 0; k < 2; ++k) dst[n][k] = *(const PG8_LAS bf16x8*)(lds + PG8_SB(b, h) + boff + n * 2048 + k * 1024); } } while (0)
#define PG8_MMA(ai, bj, At, Bt) do { __builtin_amdgcn_s_setprio(1); \
        if constexpr (GemmT::FP8) { __builtin_amdgcn_sched_barrier(0); _Pragma("unroll") for (int m = 0; m < 4; ++m) _Pragma("unroll") for (int n = 0; n < 2; ++n) \
            { acc[ai][bj][m][n] = __builtin_amdgcn_mfma_scale_f32_16x16x128_f8f6f4(Bt##8[n], At##8[m], acc[ai][bj][m][n], 0, 0, 0, 0x7f7f7f7f, 0, 0x7f7f7f7f); asm volatile("" : "+v"(acc[ai][bj][m][n])); } __builtin_amdgcn_sched_barrier(0); } \
        else { _Pragma("unroll") for (int m = 0; m < 4; ++m) _Pragma("unroll") for (int n = 0; n < 2; ++n) _Pragma("unroll") for (int k = 0; k < 2; ++k) \
            acc[ai][bj][m][n] = __builtin_amdgcn_mfma_f32_16x16x32_bf16(Bt[n][k], At[m][k], acc[ai][bj][m][n], 0, 0, 0); } __builtin_amdgcn_s_setprio(0); } while (0)
#define PG8_WAIT_V(n) asm volatile("s_waitcnt vmcnt(" #n ")" ::: "memory")
#define PG8_WAIT_L(n) asm volatile("s_waitcnt lgkmcnt(" #n ")" ::: "memory")
#define PG8_BAR __builtin_amdgcn_s_barrier()
#define PG8_SCHED __builtin_amdgcn_sched_barrier(0)
    Unit cur, nxt; int ui = 0;
    if (!S.next(0, cur)) return;
    f32x4 acc[2][2][4][2];
#pragma unroll
    for (int a = 0; a < 2; ++a)
#pragma unroll
        for (int b = 0; b < 2; ++b)
#pragma unroll
            for (int m = 0; m < 4; ++m)
#pragma unroll
                for (int n = 0; n < 2; ++n) acc[a][b][m][n] = (f32x4){0.f, 0.f, 0.f, 0.f};
    bf16x8 At[4][2], B0[2][2], B1[2][2];
    i32x8 At8[4], B08[2], B18[2];
    const char* cA = g.abase(cur); const char* cB = g.bbase(cur);
    S.a_ready(cur);
    if constexpr (SP2) {
        PG8_STAGE(PG8_SB(0, 0), cB, voffB); PG8_STAGE(PG8_SB(0, 1), cB + hstepB, voffB); PG8_STAGE(PG8_SA(0, 0), cA, voffA); PG8_STAGE(PG8_SA(0, 1), cA + hstepA, voffA);
        if (wr == 1) PG8_BAR;
        PG8_WAIT_V(2); PG8_BAR;
        PG8_STAGE(PG8_SB(1, 0), cB + kstep, voffB); PG8_STAGE(PG8_SA(1, 0), cA + kstep, voffA); PG8_STAGE(PG8_SB(1, 1), cB + hstepB + kstep, voffB);
        PG8_WAIT_V(6); PG8_BAR;
    } else {
        PG8_STAGE(PG8_SB(0, 0), cB, voffB); PG8_STAGE(PG8_SA(0, 0), cA, voffA); PG8_STAGE(PG8_SB(0, 1), cB + hstepB, voffB); PG8_STAGE(PG8_SA(0, 1), cA + hstepA, voffA);
        if (wr == 1) PG8_BAR;
        PG8_WAIT_V(4); PG8_BAR;
        PG8_STAGE(PG8_SB(1, 0), cB + kstep, voffB); PG8_STAGE(PG8_SA(1, 0), cA + kstep, voffA); PG8_STAGE(PG8_SB(1, 1), cB + hstepB + kstep, voffB);
        PG8_WAIT_V(6); PG8_BAR;
    }
    for (;;) {
        const bool has_next = S.next(ui + 1, nxt);
        const char* nA = has_next ? g.abase(nxt) : cA; const char* nB = has_next ? g.bbase(nxt) : cB;
        for (int t = 0; t < nt; t += 2) {
            const bool last = (t == nt - 2);
            const char* a1 = cA + (size_t)(t + 1) * kstep;
            const char* a2 = last ? nA : cA + (size_t)(t + 2) * kstep; const char* b2 = last ? nB : cB + (size_t)(t + 2) * kstep;
            const char* a3 = a2 + kstep; const char* b3 = b2 + kstep;
            if (last && has_next) S.a_ready(nxt);
            if constexpr (SP2) {
            PG8_LDB(B0, 0, 0); PG8_LDB(B1, 0, 1); PG8_SCHED; PG8_LDA(At, 0, 0); PG8_STAGE(PG8_SA(1, 1), a1 + hstepA, voffA);
            PG8_WAIT_V(8); PG8_WAIT_L(0); PG8_BAR; PG8_MMA(0, 0, At, B0); PG8_MMA(0, 1, At, B1); PG8_BAR; PG8_SCHED;
            PG8_LDA(At, 0, 1); PG8_STAGE(PG8_SB(0, 0), b2, voffB); PG8_STAGE(PG8_SB(0, 1), b2 + hstepB, voffB); PG8_STAGE(PG8_SA(0, 0), a2, voffA);
            PG8_WAIT_V(8); PG8_WAIT_L(0); PG8_BAR; PG8_MMA(1, 0, At, B0); PG8_MMA(1, 1, At, B1); PG8_BAR; PG8_SCHED;
            PG8_LDB(B0, 1, 0); PG8_LDB(B1, 1, 1); PG8_SCHED; PG8_LDA(At, 1, 0); PG8_STAGE(PG8_SA(0, 1), a2 + hstepA, voffA);
            PG8_WAIT_V(8); PG8_WAIT_L(0); PG8_BAR; PG8_MMA(0, 0, At, B0); PG8_MMA(0, 1, At, B1); PG8_BAR; PG8_SCHED;
            PG8_LDA(At, 1, 1); PG8_STAGE(PG8_SB(1, 0), b3, voffB); PG8_STAGE(PG8_SB(1, 1), b3 + hstepB, voffB); PG8_STAGE(PG8_SA(1, 0), a3, voffA);
            PG8_WAIT_V(8); PG8_WAIT_L(0); PG8_BAR; PG8_MMA(1, 0, At, B0); PG8_MMA(1, 1, At, B1); PG8_BAR; PG8_SCHED;
            } else {
            PG8_LDB(B0, 0, 0); PG8_SCHED; PG8_LDA(At, 0, 0); PG8_STAGE(PG8_SA(1, 1), a1 + hstepA, voffA);
            PG8_WAIT_L(8); PG8_BAR; PG8_WAIT_L(0); PG8_MMA(0, 0, At, B0); PG8_BAR; PG8_SCHED;
            PG8_LDB(B1, 0, 1); PG8_STAGE(PG8_SB(0, 0), b2, voffB);
            PG8_BAR; PG8_WAIT_L(0); PG8_MMA(0, 1, At, B1); PG8_BAR;
            PG8_LDA(At, 0, 1); PG8_STAGE(PG8_SA(0, 0), a2, voffA);
            PG8_BAR; PG8_WAIT_L(0); PG8_MMA(1, 0, At, B0); PG8_BAR; PG8_SCHED;
            PG8_STAGE(PG8_SB(0, 1), b2 + hstepB, voffB);
            PG8_WAIT_V(6); PG8_BAR; PG8_MMA(1, 1, At, B1); PG8_BAR;
            PG8_LDB(B0, 1, 0); PG8_SCHED; PG8_LDA(At, 1, 0); PG8_STAGE(PG8_SA(0, 1), a2 + hstepA, voffA);
            PG8_WAIT_L(8); PG8_BAR; PG8_WAIT_L(0); PG8_MMA(0, 0, At, B0); PG8_BAR; PG8_SCHED;
            PG8_LDB(B1, 1, 1); PG8_STAGE(PG8_SB(1, 0), b3, voffB);
            PG8_BAR; PG8_WAIT_L(0); PG8_MMA(0, 1, At, B1); PG8_BAR;
            PG8_LDA(At, 1, 1); PG8_STAGE(PG8_SA(1, 0), a3, voffA);
            PG8_BAR; PG8_WAIT_L(0); PG8_MMA(1, 0, At, B0); PG8_BAR; PG8_SCHED;
            PG8_STAGE(PG8_SB(1, 1), b3 + hstepB, voffB);
            PG8_WAIT_V(6); PG8_BAR; PG8_MMA(1, 1, At, B1); PG8_BAR;
            }
        }
        if constexpr (ALIGN_EPI) { if (wr == 0) PG8_BAR; }
        if constexpr (!Epi::AFTER_DRAIN) { E(acc, cur, wr, wc, fr, fq); S.done(cur); }
        if (!has_next) break;
        if (!E.keep(cur)) {
#pragma unroll
        for (int a = 0; a < 2; ++a)
#pragma unroll
            for (int b = 0; b < 2; ++b)
#pragma unroll
                for (int m = 0; m < 4; ++m)
#pragma unroll
                    for (int n = 0; n < 2; ++n) acc[a][b][m][n] = (f32x4){0.f, 0.f, 0.f, 0.f};
        }
        cur = nxt; cA = nA; cB = nB; ++ui;
        if constexpr (ALIGN_EPI) { if (wr == 1) PG8_BAR; }
    }
    PG8_WAIT_V(0);
    if constexpr (!ALIGN_EPI) { if (wr == 0) PG8_BAR; }
    PG8_BAR;
    if constexpr (Epi::AFTER_DRAIN) { E.fused(acc, cur, wr, wc, fr, fq, lds, wid, lane); S.done(cur); }
#undef PG8_SA
#undef PG8_SB
#undef PG8_STAGE
#undef PG8_LDA
#undef PG8_LDB
#undef PG8_MMA
#undef PG8_WAIT_V
#undef PG8_WAIT_L
#undef PG8_BAR
#undef PG8_SCHED
}
}

constexpr size_t MiB = 1u << 20;
struct P {
    const float *x, *c, *ctx, *c_ctx, *w_mod, *b_mod, *norm1_g, *norm2_g, *w_in;
    const float *a_re, *a_im, *log_dt, *b_re, *b_im, *c_re, *c_im, *ssm_d;
    const float *w_glu, *b_glu, *w_a, *w_b, *rpb, *w_out, *w_q, *subkeys, *peer_u, *peer_v, *final_g;
    float* out;
    unsigned char* ws;
    __device__ __forceinline__ unsigned long long* rowss() const { return (unsigned long long*)(ws + 512 * 1024); }
    __device__ __forceinline__ float* mod() const { return (float*)(ws + 1 * MiB); }
    __device__ __forceinline__ float* c2() const { return (float*)(ws + 1 * MiB + 256 * 1024); }
    __device__ __forceinline__ bf16_t* w_in_t() const { return (bf16_t*)(ws + 3 * MiB); }
    __device__ __forceinline__ bf16_t* w_glu_t() const { return (bf16_t*)(ws + 11 * MiB); }
    __device__ __forceinline__ bf16_t* w_b_t() const { return (bf16_t*)(ws + 12 * MiB); }
    __device__ __forceinline__ bf16_t* w_a_t() const { return (bf16_t*)(ws + 13 * MiB); }
    __device__ __forceinline__ bf16_t* w_out_t() const { return (bf16_t*)(ws + 14 * MiB); }
    __device__ __forceinline__ bf16_t* w_q_t() const { return (bf16_t*)(ws + 16 * MiB); }
    __device__ __forceinline__ bf16_t* Kmat() const { return (bf16_t*)(ws + 21 * MiB); }
    __device__ __forceinline__ bf16_t* Win() const { return (bf16_t*)(ws + 45 * MiB); }
    __device__ __forceinline__ float* lamT() const { return (float*)(ws + 53 * MiB); }
    __device__ __forceinline__ unsigned char* pu8() const { return ws + 54 * MiB; }
    __device__ __forceinline__ unsigned char* pv8() const { return ws + 70 * MiB; }
    __device__ __forceinline__ float* pisc() const { return (float*)(ws + 53 * MiB + 128 * 1024); }
    __device__ __forceinline__ float* pisc_u() const { return (float*)(ws + 53 * MiB + 256 * 1024); }
    __device__ __forceinline__ bf16_t* ga() const { return (bf16_t*)(ws + 118 * MiB); }
    __device__ __forceinline__ bf16_t* gb() const { return (bf16_t*)(ws + 182 * MiB); }
    __device__ __forceinline__ bf16_t* x1g() const { return (bf16_t*)(ws + 118 * MiB); }
    __device__ __forceinline__ unsigned* topk() const { return (unsigned*)(ws + 182 * MiB); }
    __device__ __forceinline__ float* gates() const { return (float*)(ws + 198 * MiB); }
    __device__ __forceinline__ bf16_t* kb() const { return (bf16_t*)(ws + 246 * MiB); }
    __device__ __forceinline__ bf16_t* vT() const { return (bf16_t*)(ws + 278 * MiB); }
    __device__ __forceinline__ bf16_t* qb() const { return (bf16_t*)(ws + 310 * MiB); }
    __device__ __forceinline__ bf16_t* kc() const { return (bf16_t*)(ws + 342 * MiB); }
    __device__ __forceinline__ bf16_t* vcT() const { return (bf16_t*)(ws + 344 * MiB); }
    __device__ __forceinline__ bf16_t* U() const { return (bf16_t*)(ws + 346 * MiB); }
    __device__ __forceinline__ float* E() const { return (float*)(ws + 406 * MiB); }
    __device__ __forceinline__ bf16_t* merged() const { return (bf16_t*)(ws + 246 * MiB); }
    __device__ __forceinline__ bf16_t* qp() const { return (bf16_t*)(ws + 246 * MiB); }
    __device__ __forceinline__ float* apart() const { return (float*)(ws + 246 * MiB); }
    __device__ __forceinline__ float* wl() const { return (float*)(ws + 374 * MiB); }
    __device__ __forceinline__ float* ss2() const { return (float*)(ws + 406 * MiB); }
    __device__ __forceinline__ bf16_t* x1b() const { return (bf16_t*)(ws + 406 * MiB); }
    __device__ __forceinline__ unsigned* queues() const { return (unsigned*)(ws + 64 * 1024); }
    __device__ __forceinline__ bf16_t* hx() const { return (bf16_t*)out; }
    __device__ __forceinline__ bf16_t* hc() const { return (bf16_t*)((unsigned char*)out + 64 * MiB); }
    __device__ __forceinline__ bf16_t* na() const { return (bf16_t*)out; }
    __device__ __forceinline__ bf16_t* z() const { return (bf16_t*)((unsigned char*)out + 32 * MiB); }
    __device__ __forceinline__ bf16_t* gl() const { return (bf16_t*)((unsigned char*)out + 64 * MiB); }
};

constexpr float SS_FIX = 1099511627776.f, SS_UNFIX = 1.f / 1099511627776.f;
__device__ __forceinline__ float rstd_from_fix(unsigned long long v) { return rsqrtf((float)v * (SS_UNFIX / DM) + EPSN); }
constexpr float ACT8 = 8.f;
constexpr float WIN_SCALE = 32.f;
__device__ __forceinline__ unsigned pk4_fp8(float a, float b, float c, float d) { int w = 0; w = __builtin_amdgcn_cvt_pk_fp8_f32(a, b, w, false); w = __builtin_amdgcn_cvt_pk_fp8_f32(c, d, w, true); return (unsigned)w; }
namespace pg8 {
struct EpiInProj {
    static constexpr bool PERM = true, AFTER_DRAIN = false;
    __device__ __forceinline__ bool keep(const Unit&) const { return false; }
    bf16_t* U; bf16_t* d_kq; size_t kq_stride; bf16_t* d_vT; bf16_t* d_gate; int is_ctx;
    __device__ __forceinline__ void operator()(const f32x4 (&acc)[2][2][4][2], const Unit& u, int wr, int wc, int fr, int fq) const {
        if (u.pn < 2) {
#pragma unroll
            for (int ai = 0; ai < 2; ++ai)
#pragma unroll
                for (int m = 0; m < 4; ++m) {
                    const int row = u.pm * BM + ai * HALF + wr * 64 + m * 16 + fr;
                    const int n = is_ctx ? (1024 + (row >> 8) * 8 + ((row & 255) >> 5)) : ((row >> 12) * 128 + ((row & 4095) >> 5));
                    const int jj = row & 31;
#pragma unroll
                    for (int bj = 0; bj < 2; ++bj) {
                        const int col = u.pn * BM + bj * HALF + wc * 32 + 8 * fq;
                        const f32x4 v0 = acc[ai][bj][m][0] * (1.f / WIN_SCALE), v1 = acc[ai][bj][m][1] * (1.f / WIN_SCALE);
                        u32x4 w; w.x = cvt_pk_bf16(v0[0], v0[1]); w.y = cvt_pk_bf16(v0[2], v0[3]); w.z = cvt_pk_bf16(v1[0], v1[1]); w.w = cvt_pk_bf16(v1[2], v1[3]);
                        *(u32x4*)(U + ((size_t)((col >> 4) * SSM_ROWS + n) * SSM_LD + jj * 16 + (col & 15))) = w;
                    }
                    asm volatile("" ::: "memory");
                }
        } else if (u.pn == 4 || u.pn == 5) {
            const int RB = is_ctx ? (CTXL / 64) : (SEQL / 64);
#pragma unroll
            for (int ai = 0; ai < 2; ++ai)
#pragma unroll
                for (int m = 0; m < 4; ++m) {
                    const int row = u.pm * BM + ai * HALF + wr * 64 + m * 16 + fr;
                    const int b = is_ctx ? (row >> 8) : (row >> 12), t = is_ctx ? (row & 255) : (row & 4095);
#pragma unroll
                    for (int bj = 0; bj < 2; ++bj) {
                        const int col = u.pn * BM + bj * HALF + wc * 32 + 8 * fq - 1024;
                        bf16_t* dst = d_vT + ((size_t)((b * 8 + (col >> 6)) * RB + (t >> 6)) * 4096 + (col & 63) * 64 + (t & 63));
#pragma unroll
                        for (int n = 0; n < 2; ++n)
#pragma unroll
                            for (int i = 0; i < 4; ++i) dst[(n * 4 + i) * 64] = (bf16_t)f2bf(acc[ai][bj][m][n][i] * (1.f / WIN_SCALE));
                    }
                    asm volatile("" ::: "memory");
                }
        } else {
            bf16_t* base; int ld, c0;
            if (u.pn < 8) { const int which = (u.pn - 2) >> 2; base = d_kq + (size_t)which * kq_stride; ld = 512; c0 = 512 + which * 1024; }
            else { const int which = (u.pn - 8) >> 2; base = d_gate + (size_t)which * ((size_t)NTOK * DM); ld = DM; c0 = 2048 + which * 1024; }
#pragma unroll
            for (int ai = 0; ai < 2; ++ai)
#pragma unroll
                for (int m = 0; m < 4; ++m) {
                    const int row = u.pm * BM + ai * HALF + wr * 64 + m * 16 + fr;
#pragma unroll
                    for (int bj = 0; bj < 2; ++bj) {
                        const int col = u.pn * BM + bj * HALF + wc * 32 + 8 * fq - c0;
                        const f32x4 v0 = acc[ai][bj][m][0] * (1.f / WIN_SCALE), v1 = acc[ai][bj][m][1] * (1.f / WIN_SCALE);
                        u32x4 w; w.x = cvt_pk_bf16(v0[0], v0[1]); w.y = cvt_pk_bf16(v0[2], v0[3]); w.z = cvt_pk_bf16(v1[0], v1[1]); w.w = cvt_pk_bf16(v1[2], v1[3]);
                        *(u32x4*)(base + (size_t)row * ld + col) = w;
                    }
                    asm volatile("" ::: "memory");
                }
        }
    }
};
struct EpiGlu {
    static constexpr bool PERM = true, AFTER_DRAIN = false;
    __device__ __forceinline__ bool keep(const Unit&) const { return false; }
    bf16_t* gl; const bf16_t* z; const float* bias;
    __device__ __forceinline__ void operator()(const f32x4 (&acc)[2][2][4][2], const Unit& u, int wr, int wc, int fr, int fq) const {
#pragma unroll
        for (int ai = 0; ai < 2; ++ai)
#pragma unroll
            for (int m = 0; m < 4; ++m) {
                const int row = u.pm * BM + ai * HALF + wr * 64 + m * 16 + fr;
#pragma unroll
                for (int bj = 0; bj < 2; ++bj) {
                    const int col = u.pn * BM + bj * HALF + wc * 32 + 8 * fq;
                    const f32x4 v0 = acc[ai][bj][m][0], v1 = acc[ai][bj][m][1];
                    const f32x4 b0 = *(const f32x4*)(bias + col), b1 = *(const f32x4*)(bias + col + 4);
                    const u32x4 zz = *(const u32x4*)(z + (size_t)row * 512 + col);
                    float o[8];
                    o[0] = bflo(zz.x) * sigmoidf_(v0[0] + b0[0]); o[1] = bfhi(zz.x) * sigmoidf_(v0[1] + b0[1]);
                    o[2] = bflo(zz.y) * sigmoidf_(v0[2] + b0[2]); o[3] = bfhi(zz.y) * sigmoidf_(v0[3] + b0[3]);
                    o[4] = bflo(zz.z) * sigmoidf_(v1[0] + b1[0]); o[5] = bfhi(zz.z) * sigmoidf_(v1[1] + b1[1]);
                    o[6] = bflo(zz.w) * sigmoidf_(v1[2] + b1[2]); o[7] = bfhi(zz.w) * sigmoidf_(v1[3] + b1[3]);
                    u32x2 w; w.x = pk4_fp8(o[0] * ACT8, o[1] * ACT8, o[2] * ACT8, o[3] * ACT8); w.y = pk4_fp8(o[4] * ACT8, o[5] * ACT8, o[6] * ACT8, o[7] * ACT8);
                    *(u32x2*)((unsigned char*)gl + (size_t)row * 512 + col) = w;
                }
            }
    }
};
template <int M, int N>
struct PairOrder {
    StaticOrder<M, N> S;
    __device__ void init(int G_, int c_) { S.init(G_, c_); }
    __device__ bool next(int i, Unit& u) const { if (!S.next(i >> 1, u)) return false; u.g = i & 1; return true; }
    __device__ __forceinline__ void a_ready(const Unit&) const {}
    __device__ __forceinline__ void done(const Unit&) const {}
};
struct EpiMerge {
    static constexpr bool PERM = true, AFTER_DRAIN = false;
    __device__ __forceinline__ bool keep(const Unit& u) const { return u.g == 0; }
    bf16_t* merged; const bf16_t* ga; const bf16_t* gb;
    __device__ __forceinline__ void operator()(f32x4 (&acc)[2][2][4][2], const Unit& u, int wr, int wc, int fr, int fq) const {
#pragma unroll
        for (int ai = 0; ai < 2; ++ai)
#pragma unroll
            for (int m = 0; m < 4; ++m) {
                const int row = u.pm * BM + ai * HALF + wr * 64 + m * 16 + fr;
#pragma unroll
                for (int bj = 0; bj < 2; ++bj) {
                    const int col = u.pn * BM + bj * HALF + wc * 32 + 8 * fq;
                    const u32x4 a4 = *(const u32x4*)(ga + (size_t)row * DM + col);
                    float sa[8];
#pragma unroll
                    for (int q = 0; q < 4; ++q) { sa[2 * q] = sigmoidf_(bflo(a4[q])); sa[2 * q + 1] = sigmoidf_(bfhi(a4[q])); }
                    if (u.g == 0) {
                        const u32x4 b4 = *(const u32x4*)(gb + (size_t)row * DM + col);
#pragma unroll
                        for (int q = 0; q < 4; ++q) {
                            const float r0 = sigmoidf_(bflo(b4[q])) * frcp(sa[2 * q]), r1 = sigmoidf_(bfhi(b4[q])) * frcp(sa[2 * q + 1]);
                            acc[ai][bj][m][q >> 1][(q & 1) * 2] *= r0; acc[ai][bj][m][q >> 1][(q & 1) * 2 + 1] *= r1;
                        }
                    } else {
                        const f32x4 v0 = acc[ai][bj][m][0], v1 = acc[ai][bj][m][1];
                        constexpr float f = ACT8 / (ACT8 * WIN_SCALE);
                        u32x2 w; w[0] = pk4_fp8(v0[0] * sa[0] * f, v0[1] * sa[1] * f, v0[2] * sa[2] * f, v0[3] * sa[3] * f); w[1] = pk4_fp8(v1[0] * sa[4] * f, v1[1] * sa[5] * f, v1[2] * sa[6] * f, v1[3] * sa[7] * f);
                        *(u32x2*)((unsigned char*)merged + (size_t)row * DM + col) = w;
                    }
                }
                asm volatile("" ::: "memory");
            }
    }
};
struct EpiOut {
    static constexpr bool PERM = true, AFTER_DRAIN = false;
    __device__ __forceinline__ bool keep(const Unit&) const { return false; }
    const float* x; bf16_t* x1; bf16_t* x1g; const float* mod; const float* g2; unsigned long long* rowss;
    __device__ __forceinline__ void operator()(const f32x4 (&acc)[2][2][4][2], const Unit& u, int wr, int wc, int fr, int fq) const {
#pragma unroll
        for (int ai = 0; ai < 2; ++ai)
#pragma unroll
            for (int m = 0; m < 4; ++m) {
                const int row = u.pm * BM + ai * HALF + wr * 64 + m * 16 + fr;
                const float* modb = mod + (size_t)(row >> 12) * (6 * DM);
                float ss = 0.f;
#pragma unroll
                for (int bj = 0; bj < 2; ++bj) {
                    const int col = u.pn * BM + bj * HALF + wc * 32 + 8 * fq;
#pragma unroll
                    for (int n = 0; n < 2; ++n) {
                        const int cc = col + 4 * n;
                        const f32x4 v = acc[ai][bj][m][n] * (1.f / (ACT8 * WIN_SCALE));
                        const f32x4 xx = *(const f32x4*)(x + (size_t)row * DM + cc);
                        const f32x4 g1 = *(const f32x4*)(modb + 2 * DM + cc), sc = *(const f32x4*)(modb + 4 * DM + cc), gg = *(const f32x4*)(g2 + cc);
                        const f32x4 o = xx + g1 * v;
                        { u32x2 w1; w1.x = cvt_pk_bf16(o[0], o[1]); w1.y = cvt_pk_bf16(o[2], o[3]); *(u32x2*)(x1 + (size_t)row * DM + cc) = w1; }
                        ss += o[0] * o[0] + o[1] * o[1] + o[2] * o[2] + o[3] * o[3];
                        const f32x4 og = o * gg * (sc + 1.f);
                        u32x2 w; w.x = cvt_pk_bf16(og[0], og[1]); w.y = cvt_pk_bf16(og[2], og[3]);
                        *(u32x2*)(x1g + (size_t)row * DM + cc) = w;
                    }
                }
                ss += __shfl_xor(ss, 16); ss += __shfl_xor(ss, 32);
                if (fq == 0) atomicAdd(rowss + row, (unsigned long long)(ss * SS_FIX));
            }
    }
};
struct EpiQ {
    static constexpr bool PERM = true, AFTER_DRAIN = false;
    __device__ __forceinline__ bool keep(const Unit&) const { return false; }
    bf16_t* qp; const unsigned long long* rowss; const float* c2;
    __device__ __forceinline__ void operator()(const f32x4 (&acc)[2][2][4][2], const Unit& u, int wr, int wc, int fr, int fq) const {
#pragma unroll
        for (int ai = 0; ai < 2; ++ai)
#pragma unroll
            for (int m = 0; m < 4; ++m) {
                const int row = u.pm * BM + ai * HALF + wr * 64 + m * 16 + fr;
                const float rstd = rstd_from_fix(rowss[row]);
                const float* cb = c2 + (size_t)(row >> 12) * 2048;
#pragma unroll
                for (int bj = 0; bj < 2; ++bj) {
                    const int col = u.pn * BM + bj * HALF + wc * 32 + 8 * fq;
                    const f32x4 v0 = acc[ai][bj][m][0] * rstd + *(const f32x4*)(cb + col), v1 = acc[ai][bj][m][1] * rstd + *(const f32x4*)(cb + col + 4);
                    u32x4 w; w.x = cvt_pk_bf16(v0[0], v0[1]); w.y = cvt_pk_bf16(v0[2], v0[3]); w.z = cvt_pk_bf16(v1[0], v1[1]); w.w = cvt_pk_bf16(v1[2], v1[3]);
                    *(u32x4*)(qp + (size_t)row * 2048 + col) = w;
                }
            }
    }
};
struct EpiE {
    static constexpr bool PERM = true, AFTER_DRAIN = false;
    __device__ __forceinline__ bool keep(const Unit&) const { return false; }
    float* E;
    __device__ __forceinline__ void operator()(const f32x4 (&acc)[2][2][4][2], const Unit& u, int wr, int wc, int fr, int fq) const {
#pragma unroll
        for (int ai = 0; ai < 2; ++ai)
#pragma unroll
            for (int m = 0; m < 4; ++m) {
                const int row = u.pm * BM + ai * HALF + wr * 64 + m * 16 + fr;
#pragma unroll
                for (int bj = 0; bj < 2; ++bj) {
                    const int col = u.pn * BM + bj * HALF + wc * 32 + 8 * fq;
                    float* d = E + ((size_t)(u.g * SSM_ROWS + row) * 256 + col);
                    *(f32x4*)d = acc[ai][bj][m][0]; *(f32x4*)(d + 4) = acc[ai][bj][m][1];
                }
            }
    }
};
struct EpiZ {
    static constexpr bool PERM = true, AFTER_DRAIN = false;
    __device__ __forceinline__ bool keep(const Unit&) const { return false; }
    bf16_t* z;
    __device__ __forceinline__ void operator()(const f32x4 (&acc)[2][2][4][2], const Unit& u, int wr, int wc, int fr, int fq) const {
#pragma unroll
        for (int ai = 0; ai < 2; ++ai)
#pragma unroll
            for (int m = 0; m < 4; ++m) {
                const int n = u.pm * BM + ai * HALF + wr * 64 + m * 16 + fr;
                const size_t tok0 = (size_t)(n >> 7) * SEQL + (size_t)(n & 127) * 32;
#pragma unroll
                for (int bj = 0; bj < 2; ++bj) {
                    const int col = u.pn * BM + bj * HALF + wc * 32 + 8 * fq;
                    const f32x4 v0 = acc[ai][bj][m][0], v1 = acc[ai][bj][m][1];
                    u32x4 w; w.x = cvt_pk_bf16(gelu_tanh(v0[0]), gelu_tanh(v0[1])); w.y = cvt_pk_bf16(gelu_tanh(v0[2]), gelu_tanh(v0[3]));
                    w.z = cvt_pk_bf16(gelu_tanh(v1[0]), gelu_tanh(v1[1])); w.w = cvt_pk_bf16(gelu_tanh(v1[2]), gelu_tanh(v1[3]));
                    *(u32x4*)(z + (tok0 + (col >> 4)) * 512 + u.g * 16 + (col & 15)) = w;
                }
            }
    }
};
}

__device__ __forceinline__ void sincos_d(double th, double& s, double& c) {
    const double twopi = 6.283185307179586476925, hpi = 1.570796326794896619231;
    th -= twopi * rint(th / twopi);
    const double q = rint(th / hpi); const double y = th - q * hpi, y2 = y * y;
    const double sy = y * (1.0 - y2 / 6.0 * (1.0 - y2 / 20.0 * (1.0 - y2 / 42.0 * (1.0 - y2 / 72.0 * (1.0 - y2 / 110.0 * (1.0 - y2 / 156.0 * (1.0 - y2 / 210.0)))))));
    const double cy = 1.0 - y2 / 2.0 * (1.0 - y2 / 12.0 * (1.0 - y2 / 30.0 * (1.0 - y2 / 56.0 * (1.0 - y2 / 90.0 * (1.0 - y2 / 132.0 * (1.0 - y2 / 182.0))))));
    const int qi = ((int)q) & 3;
    s = qi == 0 ? sy : (qi == 1 ? cy : (qi == 2 ? -sy : -cy));
    c = qi == 0 ? cy : (qi == 1 ? -sy : (qi == 2 ? -cy : sy));
}
__device__ __forceinline__ void ssm_prep_item(const P& p, LAS unsigned char* lds, int item) {
    const int g = item >> 2, qtr = item & 3, tid = threadIdx.x;
    LAS f32x2* lamk = (LAS f32x2*)lds;
    LAS f32x2* Bb = lamk + 2 * 64 * 33;
    LAS f32x2* Cc = Bb + 2 * 64 * 16;
    LAS float* Kc = (LAS float*)(Cc + 2 * 16 * 64);
    if (tid < 128) {
        const int d = tid >> 6, pp = tid & 63, gi = d * 32 + g;
        const double are = (double)p.a_re[gi * 64 + pp], aim = (double)p.a_im[gi * 64 + pp];
        const double dt = (double)expf(p.log_dt[gi]);
        const double er = exp(are * dt); double sn, cs; sincos_d(aim * dt, sn, cs);
        const double lr = er * cs, li = er * sn;
        double pr = 1.0, pi_ = 0.0;
        for (int k = 0; k <= 32; ++k) {
            lamk[(d * 64 + pp) * 33 + k] = (f32x2){(float)pr, (float)pi_};
            const double nr_ = pr * lr - pi_ * li, ni_ = pr * li + pi_ * lr; pr = nr_; pi_ = ni_;
        }
        if (qtr == 0) { const f32x2 l32 = lamk[(d * 64 + pp) * 33 + 32]; *(f32x2*)(p.lamT() + (size_t)(gi * 64 + pp) * 2) = l32; }
        const double nr = lr - 1.0, ni = li, den = are * are + aim * aim;
        const double qr = (nr * are + ni * aim) / den, qi = (ni * are - nr * aim) / den;
        f32x4 brv[4], biv[4];
#pragma unroll
        for (int q = 0; q < 4; ++q) { brv[q] = *(const f32x4*)(p.b_re + ((size_t)gi * 64 + pp) * 16 + 4 * q); biv[q] = *(const f32x4*)(p.b_im + ((size_t)gi * 64 + pp) * 16 + 4 * q); }
#pragma unroll
        for (int h = 0; h < 16; ++h) {
            const double br = (double)brv[h >> 2][h & 3], bi = (double)biv[h >> 2][h & 3];
            Bb[(d * 64 + pp) * 16 + h] = (f32x2){(float)(qr * br - qi * bi), (float)(qr * bi + qi * br)};
        }
    }
    for (int e = tid; e < 2 * 16 * 64; e += NT) {
        const int d = e >> 10, h = (e >> 6) & 15, pp = e & 63; const size_t src = ((size_t)(d * 32 + g) * 16 + h) * 64 + pp;
        Cc[e] = (f32x2){p.c_re[src], p.c_im[src]};
    }
    __syncthreads();
    {
        const int wv = __builtin_amdgcn_readfirstlane(tid >> 6), lane = tid & 63, lm = lane & 15, kq = lane >> 4, d = wv >> 2;
        bf16x8 bop[4];
#pragma unroll
        for (int ks = 0; ks < 4; ++ks) {
            u32x4 w;
#pragma unroll
            for (int j = 0; j < 4; ++j) { const f32x2 bb = Bb[(d * 64 + ks * 16 + kq * 4 + j) * 16 + lm]; w[j] = pk2(bb[0], bb[1]); }
            bop[ks] = __builtin_bit_cast(bf16x8, w);
        }
#pragma unroll 1
        for (int k = (wv & 3) * 8; k < (wv & 3) * 8 + 8; ++k) {
            f32x4 acc = {0.f, 0.f, 0.f, 0.f};
#pragma unroll
            for (int ks = 0; ks < 4; ++ks) {
                u32x4 w;
#pragma unroll
                for (int j = 0; j < 4; ++j) {
                    const int pp = ks * 16 + kq * 4 + j;
                    const f32x2 c = Cc[(d * 16 + lm) * 64 + pp], l = lamk[(d * 64 + pp) * 33 + k];
                    w[j] = pk2(c[0] * l[0] - c[1] * l[1], -(c[0] * l[1] + c[1] * l[0]));
                }
                acc = __builtin_amdgcn_mfma_f32_16x16x32_bf16(__builtin_bit_cast(bf16x8, w), bop[ks], acc, 0, 0, 0);
            }
#pragma unroll
            for (int r = 0; r < 4; ++r) Kc[((d * 32 + k) * 16 + kq * 4 + r) * 16 + lm] = acc[r];
        }
    }
    __syncthreads();
    for (int ch = tid; ch < 128 * 96; ch += NT) {
        const int mrow = 128 * qtr + ch / 96, k0 = (ch % 96) * 8, ii = mrow >> 4, h = mrow & 15;
        float v[8];
        if (k0 < 512) {
            const int jj = k0 >> 4, h20 = k0 & 15;
#pragma unroll
            for (int i = 0; i < 8; ++i) {
                const int h2 = h20 + i; float val = 0.f;
                if (ii >= jj) val += Kc[((0 * 32 + (ii - jj)) * 16 + h) * 16 + h2];
                if (jj >= ii) val += Kc[((1 * 32 + (jj - ii)) * 16 + h) * 16 + h2];
                if (ii == jj && h == h2) val += p.ssm_d[g * 16 + h];
                v[i] = val;
            }
        } else {
            const int sc = k0 - 512, d = sc >> 7, ri = (sc >> 6) & 1, p0 = sc & 63, e = d == 0 ? ii + 1 : 32 - ii;
#pragma unroll
            for (int i = 0; i < 8; ++i) {
                const int pp = p0 + i; const f32x2 c = Cc[(d * 16 + h) * 64 + pp], l = lamk[(d * 64 + pp) * 33 + e];
                const float clr = c[0] * l[0] - c[1] * l[1], cli = c[0] * l[1] + c[1] * l[0];
                v[i] = ri == 0 ? clr : -cli;
            }
        }
        u32x4 o; o.x = pg8::cvt_pk_bf16(v[0], v[1]); o.y = pg8::cvt_pk_bf16(v[2], v[3]); o.z = pg8::cvt_pk_bf16(v[4], v[5]); o.w = pg8::cvt_pk_bf16(v[6], v[7]);
        *(u32x4*)(p.Kmat() + ((size_t)(g * 512 + mrow) * SSM_LD + k0)) = o;
    }
    for (int ch = tid; ch < 64 * 64; ch += NT) {
        const int nrow = 64 * qtr + ch / 64, k0 = (ch % 64) * 8, d = nrow >> 7, ri = (nrow >> 6) & 1, pp = nrow & 63;
        const int jj = k0 >> 4, h20 = k0 & 15, e = d == 0 ? 31 - jj : jj;
        const f32x2 l = lamk[(d * 64 + pp) * 33 + e];
        float v[8];
#pragma unroll
        for (int i = 0; i < 8; ++i) { const f32x2 b = Bb[(d * 64 + pp) * 16 + h20 + i]; v[i] = ri == 0 ? (l[0] * b[0] - l[1] * b[1]) : (l[0] * b[1] + l[1] * b[0]); }
        u32x4 o; o.x = pg8::cvt_pk_bf16(v[0], v[1]); o.y = pg8::cvt_pk_bf16(v[2], v[3]); o.z = pg8::cvt_pk_bf16(v[4], v[5]); o.w = pg8::cvt_pk_bf16(v[6], v[7]);
        *(u32x4*)(p.Win() + ((size_t)(g * 256 + nrow) * 512 + k0)) = o;
    }
    __syncthreads();
}
__device__ __forceinline__ void ph_carry(const P& p) {
    int tid = threadIdx.x; asm volatile("" : "+v"(tid));
    if (tid >= 128) return;
    for (int gidx = blockIdx.x * 128 + tid; gidx < 32 * 8 * 2 * 64; gidx += gridDim.x * 128) {
        const int pp = gidx & 63, d = (gidx >> 6) & 1, b = (gidx >> 7) & 7, g = gidx >> 10;
        const f32x2 lt = *(const f32x2*)(p.lamT() + (size_t)((d * 32 + g) * 64 + pp) * 2);
        const float* Eg = p.E() + (size_t)g * SSM_ROWS * 256 + d * 128 + pp;
        bf16_t* Ug = p.U() + (size_t)g * SSM_ROWS * SSM_LD + 512 + d * 128 + pp;
        float fr = 0.f, fi = 0.f;
#pragma unroll
        for (int cc = 0; cc < 8; ++cc) {
            const int n = 1024 + b * 8 + (d == 0 ? cc : 7 - cc);
            const float er = Eg[(size_t)n * 256], ei = Eg[(size_t)n * 256 + 64];
            const float nr = lt[0] * fr - lt[1] * fi + er, ni = lt[0] * fi + lt[1] * fr + ei; fr = nr; fi = ni;
        }
#pragma unroll 8
        for (int c = 0; c < 128; ++c) {
            const int n = b * 128 + (d == 0 ? c : 127 - c);
            const float er = Eg[(size_t)n * 256], ei = Eg[(size_t)n * 256 + 64];
            Ug[(size_t)n * SSM_LD] = (bf16_t)f2bf(fr); Ug[(size_t)n * SSM_LD + 64] = (bf16_t)f2bf(fi);
            const float nr = lt[0] * fr - lt[1] * fi + er, ni = lt[0] * fi + lt[1] * fr + ei; fr = nr; fi = ni;
        }
    }
}


__device__ __forceinline__ void p0_transpose_item_fp8(const float* W, int K, int N, unsigned char* WT, float scale, LAS float* scr, int item, int lane) {
    const int nblk = N / 32, kb = item / nblk, nb = item % nblk, k0 = 64 * kb, n0 = 32 * nb;
#pragma unroll 8
    for (int i = 0; i < 32; ++i) { const int kk = 2 * i + (lane >> 5); scr[kk * 33 + (lane & 31)] = W[(size_t)(k0 + kk) * N + n0 + (lane & 31)]; }
    asm volatile("s_waitcnt lgkmcnt(0)" ::: "memory");
    const int c = lane & 7;
#pragma unroll
    for (int j = 0; j < 4; ++j) { const int n = (lane >> 3) + 8 * j; const LAS float* s = scr + (8 * c) * 33 + n;
        u32x2 o; o.x = pk4_fp8(s[0 * 33] * scale, s[1 * 33] * scale, s[2 * 33] * scale, s[3 * 33] * scale); o.y = pk4_fp8(s[4 * 33] * scale, s[5 * 33] * scale, s[6 * 33] * scale, s[7 * 33] * scale);
        *(u32x2*)(WT + (size_t)(n0 + n) * K + k0 + 8 * c) = o; }
    asm volatile("s_waitcnt lgkmcnt(0)" ::: "memory");
}
__device__ __forceinline__ void p0_transpose_item(const float* W, int K, int N, bf16_t* WT, LAS float* scr, int item, int lane) {
    const int nblk = N / 32, kb = item / nblk, nb = item % nblk, k0 = 64 * kb, n0 = 32 * nb;
#pragma unroll 8
    for (int i = 0; i < 32; ++i) { const int kk = 2 * i + (lane >> 5); scr[kk * 33 + (lane & 31)] = W[(size_t)(k0 + kk) * N + n0 + (lane & 31)]; }
    asm volatile("s_waitcnt lgkmcnt(0)" ::: "memory");
    const int c = lane & 7;
#pragma unroll
    for (int j = 0; j < 4; ++j) { const int n = (lane >> 3) + 8 * j; const LAS float* s = scr + (8 * c) * 33 + n;
        u32x4 o; o.x = pk2(s[0 * 33], s[1 * 33]); o.y = pk2(s[2 * 33], s[3 * 33]); o.z = pk2(s[4 * 33], s[5 * 33]); o.w = pk2(s[6 * 33], s[7 * 33]);
        *(u32x4*)(WT + (size_t)(n0 + n) * K + k0 + 8 * c) = o; }
    asm volatile("s_waitcnt lgkmcnt(0)" ::: "memory");
}

template <int NR, bool SILU>
__device__ __forceinline__ void gemv_block64(const float* const (&rows)[NR], const float* W, int ldw, int col0, const float* bias, float* y, int ldy, LAS float* scr) {
    const int wave = threadIdx.x >> 6, lane = threadIdx.x & 63;
    LAS float* act = scr + 8 * NR * 64;
#pragma unroll
    for (int r = 0; r < NR; ++r) for (int k = threadIdx.x; k < DM; k += NT) { const float s = rows[r][k]; act[r * DM + k] = SILU ? siluf_(s) : s; }
    __syncthreads();
    float acc[NR];
#pragma unroll
    for (int r = 0; r < NR; ++r) acc[r] = 0.f;
    const int kb = wave * 128;
#pragma unroll 32
    for (int k = kb; k < kb + 128; ++k) {
        const float w = W[(size_t)k * ldw + col0 + lane];
#pragma unroll
        for (int r = 0; r < NR; ++r) acc[r] += act[r * DM + k] * w;
    }
#pragma unroll
    for (int r = 0; r < NR; ++r) scr[(wave * NR + r) * 64 + lane] = acc[r];
    __syncthreads();
    for (int e = threadIdx.x; e < NR * 64; e += NT) {
        const int r = e >> 6, l = e & 63; float s = 0.f;
#pragma unroll
        for (int w = 0; w < 8; ++w) s += scr[(w * NR + r) * 64 + l];
        y[(size_t)r * ldy + col0 + l] = s + (bias ? bias[col0 + l] : 0.f);
    }
    __syncthreads();
}

__device__ __forceinline__ void ph_prep(const P& p, LAS unsigned char* lds) {
    int tid_ = threadIdx.x; asm volatile("" : "+v"(tid_));
    const int wave = tid_ >> 6, lane = tid_ & 63, G = gridDim.x;
    for (int cb = blockIdx.x; cb < 96; cb += G) {
        const float* const rows[9] = {p.c, p.c + DM, p.c + 2 * DM, p.c + 3 * DM, p.c + 4 * DM, p.c + 5 * DM, p.c + 6 * DM, p.c + 7 * DM, p.c_ctx};
        gemv_block64<9, true>(rows, p.w_mod, 6 * DM, cb * 64, p.b_mod, p.mod(), 6 * DM, (LAS float*)lds);
    }
    {
        LAS float* scr = (LAS float*)(lds + wave * 16384);
        const int gw = blockIdx.x * NWAVES + wave, NGW = G * NWAVES;
        constexpr int I_IN = (DM / 64) * (INC / 32), I_GLU = (512 / 64) * (512 / 32), I_A = (512 / 64) * (DM / 32), I_OUT = (DM / 64) * (DM / 32), I_Q = (DM / 64) * (2048 / 32);
        constexpr int NITEMS = I_IN + I_GLU + 2 * I_A + I_OUT + I_Q;
        for (int it = gw; it < NITEMS; it += NGW) {
            int r = it;
            if (r < I_IN) { p0_transpose_item_fp8(p.w_in, DM, INC, (unsigned char*)p.w_in_t(), WIN_SCALE, scr, r, lane); continue; } r -= I_IN;
            if (r < I_GLU) { p0_transpose_item(p.w_glu, 512, 512, p.w_glu_t(), scr, r, lane); continue; } r -= I_GLU;
            if (r < I_A) { p0_transpose_item_fp8(p.w_a, 512, DM, (unsigned char*)p.w_a_t(), WIN_SCALE, scr, r, lane); continue; } r -= I_A;
            if (r < I_A) { p0_transpose_item_fp8(p.w_b, 512, DM, (unsigned char*)p.w_b_t(), WIN_SCALE, scr, r, lane); continue; } r -= I_A;
            if (r < I_OUT) { p0_transpose_item_fp8(p.w_out, DM, DM, (unsigned char*)p.w_out_t(), WIN_SCALE, scr, r, lane); continue; } r -= I_OUT;
            p0_transpose_item(p.w_q, DM, 2048, p.w_q_t(), scr, r, lane);
        }
    }
}

template <int CTRL> __device__ __forceinline__ int dpp_i(int v) { return __builtin_amdgcn_update_dpp(0, v, CTRL, 0xf, 0xf, true); }
template <int CTRL> __device__ __forceinline__ float dpp_f(float v) { return __builtin_bit_cast(float, __builtin_amdgcn_update_dpp(0, __builtin_bit_cast(int, v), CTRL, 0xf, 0xf, true)); }
constexpr int DPP_XOR1 = 0xB1, DPP_XOR2 = 0x4E, DPP_HMIRROR = 0x141, DPP_ROR8 = 0x128;
constexpr float I8_MAGIC = 12582912.f;
__device__ __forceinline__ unsigned pack4_i8(float t0, float t1, float t2, float t3) {
    const unsigned p01 = __builtin_amdgcn_perm(__builtin_bit_cast(unsigned, t1), __builtin_bit_cast(unsigned, t0), 0x0c0c0400u);
    const unsigned p23 = __builtin_amdgcn_perm(__builtin_bit_cast(unsigned, t3), __builtin_bit_cast(unsigned, t2), 0x0c0c0400u);
    return __builtin_amdgcn_perm(p23, p01, 0x05040100u);
}
__device__ __forceinline__ void bg_convert_tables(const P& p) {
    int tid_ = threadIdx.x; asm volatile("" : "+v"(tid_));
    const int lane = tid_ & 63;
    unsigned* head = p.queues() + 16 * 64;
    for (;;) {
        unsigned v = 0u; if (lane == 0) v = __hip_atomic_fetch_add(head, 32u, __ATOMIC_RELAXED, __HIP_MEMORY_SCOPE_AGENT);
        const int rg = (int)__builtin_amdgcn_readfirstlane(v);
        if (rg >= 2 * 16384) break;
#pragma unroll 1
      for (int r0 = rg; r0 < rg + 32; r0 += 4) {
        const bool second = r0 >= 16384; const int rr0 = second ? r0 - 16384 : r0;
        const float* src = (second ? p.peer_v : p.peer_u) + (size_t)rr0 * DM + lane * 16;
        unsigned char* dst = (second ? p.pv8() : p.pu8()) + (size_t)(lane >> 3) * (16384 * 128) + (size_t)rr0 * 128 + (lane & 7) * 16;
        f32x4 v4[4][4];
#pragma unroll
        for (int q = 0; q < 4; ++q)
#pragma unroll
            for (int j = 0; j < 4; ++j) v4[q][j] = *(const f32x4*)(src + q * DM + 4 * j);
        float inv = 1.f;
#pragma unroll
        for (int q = 0; q < 4; ++q) {
            float am = 0.f;
#pragma unroll
            for (int j = 0; j < 4; ++j) am = fmaxf(am, fmaxf(fmaxf(fabsf(v4[q][j][0]), fabsf(v4[q][j][1])), fmaxf(fabsf(v4[q][j][2]), fabsf(v4[q][j][3]))));
            am = wave_max(am);
            const float top = 6.f;
            const float sc = am > 0.f ? top / am : 1.f;
            if (second) {
                u32x2 o2;
#pragma unroll
                for (int jj = 0; jj < 2; ++jj) {
                    unsigned w = 0u;
                    w = __builtin_amdgcn_cvt_scalef32_pk_fp4_f32(w, v4[q][jj * 2][0] * sc, v4[q][jj * 2][1] * sc, 1.0f, 0);
                    w = __builtin_amdgcn_cvt_scalef32_pk_fp4_f32(w, v4[q][jj * 2][2] * sc, v4[q][jj * 2][3] * sc, 1.0f, 1);
                    w = __builtin_amdgcn_cvt_scalef32_pk_fp4_f32(w, v4[q][jj * 2 + 1][0] * sc, v4[q][jj * 2 + 1][1] * sc, 1.0f, 2);
                    w = __builtin_amdgcn_cvt_scalef32_pk_fp4_f32(w, v4[q][jj * 2 + 1][2] * sc, v4[q][jj * 2 + 1][3] * sc, 1.0f, 3);
                    o2[jj] = w;
                }
                *(u32x2*)(p.pv8() + (size_t)(lane >> 4) * (16384 * 128) + (size_t)(rr0 + q) * 128 + (lane & 15) * 8) = o2;
                inv = lane == q ? (am > 0.f ? am / top : 1.f) : inv;
            } else {
                float a16 = 0.f;
#pragma unroll
                for (int j = 0; j < 4; ++j) a16 = fmaxf(a16, fmaxf(fmaxf(fabsf(v4[q][j][0]), fabsf(v4[q][j][1])), fmaxf(fabsf(v4[q][j][2]), fabsf(v4[q][j][3]))));
                a16 = fmaxf(a16, dpp_f<DPP_XOR1>(a16)); a16 = fmaxf(a16, dpp_f<DPP_XOR2>(a16)); a16 = fmaxf(a16, dpp_f<DPP_HMIRROR>(a16)); a16 = fmaxf(a16, dpp_f<DPP_ROR8>(a16));
                const float s4 = a16 > 0.f ? 7.f / a16 : 1.f;
                u32x2 o2;
#pragma unroll
                for (int jj = 0; jj < 2; ++jj) {
                    unsigned w = 0u;
#pragma unroll
                    for (int k = 0; k < 8; ++k) { const float t = v4[q][jj * 2 + (k >> 2)][k & 3] * s4 + I8_MAGIC; w |= (__builtin_bit_cast(unsigned, t) & 15u) << (4 * k); }
                    o2[jj] = w;
                }
                *(u32x2*)(p.pu8() + (size_t)(lane >> 4) * (16384 * 128) + (size_t)(rr0 + q) * 128 + (lane & 15) * 8) = o2;
                if ((lane & 15) == 0) p.pisc_u()[(size_t)(rr0 + q) * 4 + (lane >> 4)] = a16 > 0.f ? a16 * (1.f / 7.f) : 1.f;
            }
        }
        if (second && lane < 4) p.pisc()[r0 + lane] = inv;
      }
    }
}

__device__ __forceinline__ void normmod_row_bf16(const float* src, bf16_t* dst, const float* g, const float* shift, const float* scale, int lane) {
    const f32x4* s = (const f32x4*)src;
    f32x4 v[4]; float ss = 0.f;
#pragma unroll
    for (int j = 0; j < 4; ++j) { v[j] = s[lane + 64 * j]; ss += v[j][0] * v[j][0] + v[j][1] * v[j][1] + v[j][2] * v[j][2] + v[j][3] * v[j][3]; }
    ss = wave_sum(ss);
    const float rstd = rsqrtf(ss * (1.f / DM) + EPSN);
#pragma unroll
    for (int j = 0; j < 4; ++j) {
        const int i4 = lane + 64 * j;
        const f32x4 gg = ((const f32x4*)g)[i4], sh = ((const f32x4*)shift)[i4], sc = ((const f32x4*)scale)[i4];
        const f32x4 o = v[j] * rstd * gg * (sc + 1.f) + sh;
        *(unsigned*)((unsigned char*)dst + (size_t)i4 * 4) = pk4_fp8(o[0], o[1], o[2], o[3]);
    }
}
__device__ __forceinline__ void ph_norm1(const P& p, LAS unsigned char* lds) {
    int tid_ = threadIdx.x; asm volatile("" : "+v"(tid_));
    const int wave = tid_ >> 6, lane = tid_ & 63, G = gridDim.x;
    const int gw = blockIdx.x * NWAVES + __builtin_amdgcn_readfirstlane(wave), NGW = G * NWAVES;
    for (int r4 = gw; r4 < NTOK / 4; r4 += NGW) {
        const int r = r4 * 4;
        const f32x4* s = (const f32x4*)(p.x + (size_t)r * DM);
        f32x4 v[4][4];
#pragma unroll
        for (int k = 0; k < 4; ++k)
#pragma unroll
            for (int j = 0; j < 4; ++j) v[k][j] = s[k * (DM / 4) + lane + 64 * j];
        const float* modb = p.mod() + (size_t)(r >> 12) * (6 * DM);
#pragma unroll
        for (int k = 0; k < 4; ++k) {
            float ss = 0.f;
#pragma unroll
            for (int j = 0; j < 4; ++j) ss += v[k][j][0] * v[k][j][0] + v[k][j][1] * v[k][j][1] + v[k][j][2] * v[k][j][2] + v[k][j][3] * v[k][j][3];
            ss = wave_sum(ss);
            const float rstd = rsqrtf(ss * (1.f / DM) + EPSN);
            unsigned char* dst = (unsigned char*)p.hx() + (size_t)(r + k) * DM;
#pragma unroll
            for (int j = 0; j < 4; ++j) {
                const int i4 = lane + 64 * j;
                const f32x4 gg = ((const f32x4*)p.norm1_g)[i4], sh = ((const f32x4*)modb)[i4], sc = ((const f32x4*)(modb + DM))[i4];
                const f32x4 o = v[k][j] * rstd * gg * (sc + 1.f) + sh;
                *(unsigned*)(dst + (size_t)i4 * 4) = pk4_fp8(o[0], o[1], o[2], o[3]);
            }
        }
    }
    for (int rc = gw; rc < NCTX; rc += NGW) { const float* modc = p.mod() + 8 * (6 * DM); normmod_row_bf16(p.ctx + (size_t)rc * DM, (bf16_t*)((unsigned char*)p.hc() + (size_t)rc * DM), p.norm1_g, modc, modc + DM, lane); }
}

constexpr int RPB_LD = 128, RPB_PAD = 48;
__device__ __forceinline__ void ph_na(const P& p, LAS unsigned char* lds) {
    int tid_ = threadIdx.x; asm volatile("" : "+v"(tid_));
    const int tid = tid_, h = __builtin_amdgcn_readfirstlane(tid >> 6), lane = tid & 63, lt = lane & 15, lq = lane >> 4;
    constexpr float LOG2E = 1.4426950408889634f, CS = 0.125f * LOG2E;
    LAS float* rp = (LAS float*)lds;
    for (int e = tid; e < 8 * 15 * RPB_LD; e += NT) { const int c = (e & (RPB_LD - 1)) - RPB_PAD; rp[e] = (c >= 0 && c < 31) ? p.rpb[(e / RPB_LD) * 31 + c] * LOG2E : 0.f; }
    __syncthreads();
    const int pa = (lt >> 2) * 8 + (lt & 3);
    const unsigned lane_k = pa * 512 + lq * 8, lane_v = lt * 64 + lq * 8, lane_q = lt * 512 + lq * 8, lane_o = lt * 512 + lq * 4;
    for (int item = blockIdx.x; item < NB * GW; item += gridDim.x) {
        const int b = item >> 6, r = item & 63;
        int r0 = r - 4; r0 = r0 < 0 ? 0 : (r0 > 56 ? 56 : r0);
        const bf16_t* Kb = p.kb() + ((size_t)b * SEQL + (size_t)r0 * GW) * 512 + h * 64;
        const bf16_t* Kc = p.kc() + ((size_t)b * CTXL) * 512 + h * 64;
        const bf16_t* Vt = p.vT() + ((size_t)((b * 8 + h) * 64 + r0)) * 4096;
        const bf16_t* Vc = p.vcT() + ((size_t)((b * 8 + h) * 4)) * 4096;
        const bf16_t* Qb = p.qb() + ((size_t)b * SEQL + r * GW) * 512 + h * 64;
        unsigned char* Ob = (unsigned char*)p.na() + ((size_t)b * SEQL + r * GW) * 512 + h * 64;
        const LAS float* rph = rp + (h * 15 + (r0 - r + 7)) * RPB_LD;
        bf16x8 qf[4][2];
#pragma unroll
        for (int qt = 0; qt < 4; ++qt) { qf[qt][0] = *(const bf16x8*)(Qb + qt * 16 * 512 + lane_q); qf[qt][1] = *(const bf16x8*)(Qb + qt * 16 * 512 + 32 + lane_q); }
        f32x4 o[4][4]; float m[4], l[4];
#pragma unroll
        for (int qt = 0; qt < 4; ++qt) { m[qt] = -1e30f; l[qt] = 0.f;
#pragma unroll
            for (int d = 0; d < 4; ++d) o[qt][d] = (f32x4){0.f, 0.f, 0.f, 0.f}; }
        bf16x8 kf[2][2][2];
#pragma unroll
        for (int st = 0; st < 2; ++st)
#pragma unroll
            for (int ab = 0; ab < 2; ++ab) { kf[st][ab][0] = *(const bf16x8*)(Kb + (st * 32 + ab * 4) * 512 + lane_k); kf[st][ab][1] = *(const bf16x8*)(Kb + (st * 32 + ab * 4) * 512 + 32 + lane_k); }
#pragma unroll 1
        for (int i = 0; i < 8; ++i) {
            bf16x8 vf[2][4];
#pragma unroll
            for (int st = 0; st < 2; ++st)
#pragma unroll
                for (int d = 0; d < 4; ++d) vf[st][d] = *(const bf16x8*)(Vt + i * 4096 + d * 1024 + st * 32 + lane_v);
            const LAS float* rr_ = rph + i * RPB_LD;
#pragma unroll
            for (int half = 0; half < 2; ++half) {
                f32x4 s[2][2][2];
#pragma unroll
                for (int q2 = 0; q2 < 2; ++q2) {
                    const int qt = half * 2 + q2;
#pragma unroll
                    for (int st = 0; st < 2; ++st) {
                        if ((st == 0 && qt == 3) || (st == 1 && qt == 0)) continue;
#pragma unroll
                        for (int ab = 0; ab < 2; ++ab) {
                            f32x4 c = {0.f, 0.f, 0.f, 0.f};
                            c = __builtin_amdgcn_mfma_f32_16x16x32_bf16(kf[st][ab][0], qf[qt][0], c, 0, 0, 0);
                            c = __builtin_amdgcn_mfma_f32_16x16x32_bf16(kf[st][ab][1], qf[qt][1], c, 0, 0, 0);
                            s[q2][st][ab] = c;
                        }
                    }
                }
                if (half == 1) {
                    if (i < 7) {
#pragma unroll
                        for (int st = 0; st < 2; ++st)
#pragma unroll
                            for (int ab = 0; ab < 2; ++ab) { const bf16_t* kp = Kb + ((i + 1) * GW + st * 32 + ab * 4) * 512; kf[st][ab][0] = *(const bf16x8*)(kp + lane_k); kf[st][ab][1] = *(const bf16x8*)(kp + 32 + lane_k); }
                    } else {
#pragma unroll
                        for (int ab = 0; ab < 2; ++ab) { kf[0][ab][0] = *(const bf16x8*)(Kc + ab * 4 * 512 + lane_k); kf[0][ab][1] = *(const bf16x8*)(Kc + ab * 4 * 512 + 32 + lane_k); }
                    }
                }
#pragma unroll
                for (int q2 = 0; q2 < 2; ++q2) {
                    const int qt = half * 2 + q2;
                    const int qc = qt * 16 + lt; int c0 = qc - 8; c0 = c0 < 0 ? 0 : (c0 > 48 ? 48 : c0);
                    int wo = lq * 8 - c0; asm volatile("" : "+v"(wo));
                    float mx = -1e30f;
#pragma unroll
                    for (int st = 0; st < 2; ++st) {
                        if ((st == 0 && qt == 3) || (st == 1 && qt == 0)) continue;
                        const int kc0 = st * 32 + lq * 8, bbase = kc0 - qc + 15 + RPB_PAD;
#pragma unroll
                        for (int j = 0; j < 8; ++j) {
                            float t = s[q2][st][j >> 2][j & 3] * CS + rr_[bbase + j];
                            t = ((unsigned)(wo + st * 32 + j) < 16u) ? t : -1e30f;
                            s[q2][st][j >> 2][j & 3] = t; mx = fmaxf(mx, t);
                        }
                    }
                    mx = fmaxf(mx, __shfl_xor(mx, 16)); mx = fmaxf(mx, __shfl_xor(mx, 32));
                    const float mn = fmaxf(m[qt], mx), corr = __builtin_amdgcn_exp2f(m[qt] - mn);
                    m[qt] = mn; float ls = l[qt] * corr;
#pragma unroll
                    for (int d = 0; d < 4; ++d) o[qt][d] = o[qt][d] * corr;
#pragma unroll
                    for (int st = 0; st < 2; ++st) {
                        if ((st == 0 && qt == 3) || (st == 1 && qt == 0)) continue;
                        float pe[8];
#pragma unroll
                        for (int j = 0; j < 8; ++j) pe[j] = __builtin_amdgcn_exp2f(s[q2][st][j >> 2][j & 3] - mn);
                        ls += ((pe[0] + pe[1]) + (pe[2] + pe[3])) + ((pe[4] + pe[5]) + (pe[6] + pe[7]));
                        u32x4 pw; pw[0] = pg8::cvt_pk_bf16(pe[0], pe[1]); pw[1] = pg8::cvt_pk_bf16(pe[2], pe[3]); pw[2] = pg8::cvt_pk_bf16(pe[4], pe[5]); pw[3] = pg8::cvt_pk_bf16(pe[6], pe[7]);
                        const bf16x8 pf = __builtin_bit_cast(bf16x8, pw);
#pragma unroll
                        for (int d = 0; d < 4; ++d) o[qt][d] = __builtin_amdgcn_mfma_f32_16x16x32_bf16(vf[st][d], pf, o[qt][d], 0, 0, 0);
                    }
                    l[qt] = ls;
                }
            }
        }
#pragma unroll 1
        for (int cst = 0; cst < 8; ++cst) {
            bf16x8 vf[4];
#pragma unroll
            for (int d = 0; d < 4; ++d) vf[d] = *(const bf16x8*)(Vc + (cst >> 1) * 4096 + d * 1024 + (cst & 1) * 32 + lane_v);
            f32x4 s[4][2];
#pragma unroll
            for (int qt = 0; qt < 4; ++qt)
#pragma unroll
                for (int ab = 0; ab < 2; ++ab) {
                    f32x4 c = {0.f, 0.f, 0.f, 0.f};
                    c = __builtin_amdgcn_mfma_f32_16x16x32_bf16(kf[0][ab][0], qf[qt][0], c, 0, 0, 0);
                    c = __builtin_amdgcn_mfma_f32_16x16x32_bf16(kf[0][ab][1], qf[qt][1], c, 0, 0, 0);
                    s[qt][ab] = c;
                }
            if (cst < 7) {
#pragma unroll
                for (int ab = 0; ab < 2; ++ab) { const bf16_t* kp = Kc + ((cst + 1) * 32 + ab * 4) * 512; kf[0][ab][0] = *(const bf16x8*)(kp + lane_k); kf[0][ab][1] = *(const bf16x8*)(kp + 32 + lane_k); }
            }
#pragma unroll
            for (int qt = 0; qt < 4; ++qt) {
                float mx = -1e30f;
#pragma unroll
                for (int j = 0; j < 8; ++j) { const float t = s[qt][j >> 2][j & 3] * CS; s[qt][j >> 2][j & 3] = t; mx = fmaxf(mx, t); }
                mx = fmaxf(mx, __shfl_xor(mx, 16)); mx = fmaxf(mx, __shfl_xor(mx, 32));
                const float mn = fmaxf(m[qt], mx), corr = __builtin_amdgcn_exp2f(m[qt] - mn);
                m[qt] = mn;
#pragma unroll
                for (int d = 0; d < 4; ++d) o[qt][d] = o[qt][d] * corr;
                float pe[8];
#pragma unroll
                for (int j = 0; j < 8; ++j) pe[j] = __builtin_amdgcn_exp2f(s[qt][j >> 2][j & 3] - mn);
                l[qt] = l[qt] * corr + (((pe[0] + pe[1]) + (pe[2] + pe[3])) + ((pe[4] + pe[5]) + (pe[6] + pe[7])));
                u32x4 pw; pw[0] = pg8::cvt_pk_bf16(pe[0], pe[1]); pw[1] = pg8::cvt_pk_bf16(pe[2], pe[3]); pw[2] = pg8::cvt_pk_bf16(pe[4], pe[5]); pw[3] = pg8::cvt_pk_bf16(pe[6], pe[7]);
                const bf16x8 pf = __builtin_bit_cast(bf16x8, pw);
#pragma unroll
                for (int d = 0; d < 4; ++d) o[qt][d] = __builtin_amdgcn_mfma_f32_16x16x32_bf16(vf[d], pf, o[qt][d], 0, 0, 0);
            }
        }
#pragma unroll
        for (int qt = 0; qt < 4; ++qt) {
            float lv = l[qt]; lv += __shfl_xor(lv, 16); lv += __shfl_xor(lv, 32);
            const float inv = frcp(lv);
            const float inv8 = inv * ACT8;
            unsigned char* op = Ob + qt * 16 * 512 + lane_o;
#pragma unroll
            for (int d = 0; d < 4; ++d) *(unsigned*)(op + d * 16) = pk4_fp8(o[qt][d][0] * inv8, o[qt][d][1] * inv8, o[qt][d][2] * inv8, o[qt][d][3] * inv8);
        }
    }
}

typedef __bf16 bf16x2_t __attribute__((ext_vector_type(2)));
__device__ __forceinline__ float dot2bf(unsigned a, unsigned b, float c) { return __builtin_amdgcn_fdot2_f32_bf16(__builtin_bit_cast(bf16x2_t, a), __builtin_bit_cast(bf16x2_t, b), c, false); }
__device__ __forceinline__ unsigned ordkey(float f) { unsigned u = __builtin_bit_cast(unsigned, f); return u ^ ((unsigned)((int)u >> 31) | 0x80000000u); }
__device__ __forceinline__ float unordkey(unsigned k) { return __builtin_bit_cast(float, k ^ ((k & 0x80000000u) ? 0x80000000u : 0xFFFFFFFFu)); }
__device__ __forceinline__ float kmax(float a, float b) { float r; asm("v_max_f32 %0, %1, %2" : "=v"(r) : "v"(a), "v"(b)); return r; }
__device__ __forceinline__ float kmin(float a, float b) { float r; asm("v_min_f32 %0, %1, %2" : "=v"(r) : "v"(a), "v"(b)); return r; }
template <bool DESC> __device__ __forceinline__ void cex(float& a, float& b) { const float mx = kmax(a, b), mn = kmin(a, b); if (DESC) { a = mx; b = mn; } else { a = mn; b = mx; } }
__device__ __forceinline__ void sort16_desc(float (&a)[16]) {
#pragma unroll
    for (int k = 2; k <= 16; k <<= 1)
#pragma unroll
        for (int j = k >> 1; j > 0; j >>= 1)
#pragma unroll
            for (int i = 0; i < 16; ++i) { const int l = i ^ j; if (l > i) { if ((i & k) == 0) cex<true>(a[i], a[l]); else cex<false>(a[i], a[l]); } }
}
__device__ __forceinline__ void merge16_desc(float (&a)[16]) {
#pragma unroll
    for (int j = 8; j > 0; j >>= 1)
#pragma unroll
        for (int i = 0; i < 16; ++i) { const int l = i ^ j; if (l > i) cex<true>(a[i], a[l]); }
}
__device__ __forceinline__ void top16_merge(float (&a)[16], const float (&b)[16]) {
#pragma unroll
    for (int i = 0; i < 16; ++i) a[i] = kmax(a[i], b[15 - i]);
    merge16_desc(a);
}
__device__ __forceinline__ unsigned kbits(float k) { return __builtin_bit_cast(unsigned, k); }
__device__ __forceinline__ float kscore(float k) { return __builtin_bit_cast(float, __builtin_bit_cast(unsigned, k) & ~127u); }
struct PairTab { int i[52], j[52], n; };
constexpr PairTab make_pairs() { PairTab t{}; int n = 0; for (int i = 0; i < 16; ++i) for (int j = 0; j < 16; ++j) if ((i + 1) * (j + 1) <= 16) { t.i[n] = i; t.j[n] = j; ++n; } t.n = n; for (int k = n; k < 52; ++k) { t.i[k] = 0; t.j[k] = 0; } return t; }
constexpr PairTab PAIRS = make_pairs();
static_assert(PAIRS.n == 50, "50 candidate pairs");

constexpr int SK_LD = 136;
__device__ __forceinline__ void ph_peer_topk(const P& p, LAS unsigned char* lds) {
    int tid_ = threadIdx.x; asm volatile("" : "+v"(tid_));
    const int tid = tid_, wave = tid >> 6, lane = tid & 63;
    LAS bf16_t* sk = (LAS bf16_t*)lds;
    for (int e = tid; e < 2 * 128 * 16; e += NT) {
        const int row = e >> 4, c8 = (e & 15) * 8;
        const f32x4 a = *(const f32x4*)(p.subkeys + (size_t)row * 128 + c8), b = *(const f32x4*)(p.subkeys + (size_t)row * 128 + c8 + 4);
        u32x4 o; o.x = pk2(a[0], a[1]); o.y = pk2(a[2], a[3]); o.z = pk2(b[0], b[1]); o.w = pk2(b[2], b[3]);
        *(LAS u32x4*)(sk + row * SK_LD + c8) = o;
    }
    __syncthreads();
    const int lt = lane & 15, lq = lane >> 4;
    for (int tile = blockIdx.x * NWAVES + wave; tile < NTOK / 16; tile += gridDim.x * NWAVES) {
        const int tok = tile * 16 + lt;
        const bf16_t* qrow = p.qp() + (size_t)tok * 2048;
        for (int h = 0; h < 8; ++h) {
            float s0[16], s1[16];
#pragma unroll
            for (int n = 0; n < 2; ++n) {
                bf16x8 bq[4];
#pragma unroll
                for (int ks = 0; ks < 4; ++ks) bq[ks] = *(const bf16x8*)(qrow + h * 256 + n * 128 + ks * 32 + lq * 8);
                float a[16], b[16];
#pragma unroll
                for (int kb = 0; kb < 8; ++kb) {
                    f32x4 c = {0.f, 0.f, 0.f, 0.f};
#pragma unroll
                    for (int ks = 0; ks < 4; ++ks) {
                        const bf16x8 ak = *(const LAS bf16x8*)(sk + (n * 128 + kb * 16 + lt) * SK_LD + ks * 32 + lq * 8);
                        c = __builtin_amdgcn_mfma_f32_16x16x32_bf16(ak, bq[ks], c, 0, 0, 0);
                    }
#pragma unroll
                    for (int r = 0; r < 4; ++r) {
                        const float cr = c[r];
                        const float key = __builtin_bit_cast(float, (__builtin_bit_cast(unsigned, cr) & ~127u) | (unsigned)(kb * 16 + lq * 4 + r));
                        if (kb < 4) a[kb * 4 + r] = key; else b[(kb - 4) * 4 + r] = key;
                    }
                    asm volatile("" ::: "memory");
                }
                sort16_desc(a); sort16_desc(b);
                top16_merge(a, b);
#pragma unroll
                for (int i = 0; i < 16; ++i) b[i] = __shfl_xor(a[i], 16);
                top16_merge(a, b);
#pragma unroll
                for (int i = 0; i < 16; ++i) b[i] = __shfl_xor(a[i], 32);
                top16_merge(a, b);
                if (n == 0) {
#pragma unroll
                    for (int i = 0; i < 16; ++i) s0[i] = a[i];
                } else {
#pragma unroll
                    for (int i = 0; i < 16; ++i) s1[i] = a[i];
                }
            }
            float ck[16], cs[13]; unsigned ce_[13];
#pragma unroll
            for (int s = 0; s < 13; ++s) {
                const float k0 = lq == 0 ? s0[PAIRS.i[s * 4]] : (lq == 1 ? s0[PAIRS.i[s * 4 + 1]] : (lq == 2 ? s0[PAIRS.i[s * 4 + 2]] : s0[PAIRS.i[s * 4 + 3]]));
                const float k1 = lq == 0 ? s1[PAIRS.j[s * 4]] : (lq == 1 ? s1[PAIRS.j[s * 4 + 1]] : (lq == 2 ? s1[PAIRS.j[s * 4 + 2]] : s1[PAIRS.j[s * 4 + 3]]));
                const float sum = kscore(k0) + kscore(k1);
                const bool valid = (s * 4 + lq) < PAIRS.n;
                cs[s] = sum; ce_[s] = (kbits(k0) & 127u) * 128u + (kbits(k1) & 127u);
                ck[s] = valid ? __builtin_bit_cast(float, (__builtin_bit_cast(unsigned, sum) & ~63u) | (unsigned)(s * 4 + lq)) : -__builtin_inff();
            }
            ck[13] = -__builtin_inff(); ck[14] = -__builtin_inff(); ck[15] = -__builtin_inff();
            float srt[16], ob[16];
#pragma unroll
            for (int i = 0; i < 16; ++i) srt[i] = ck[i];
            sort16_desc(srt);
#pragma unroll
            for (int i = 0; i < 16; ++i) ob[i] = __shfl_xor(srt[i], 16);
            top16_merge(srt, ob);
#pragma unroll
            for (int i = 0; i < 16; ++i) ob[i] = __shfl_xor(srt[i], 32);
            float thr = __builtin_inff();
#pragma unroll
            for (int i = 0; i < 16; ++i) thr = kmin(thr, kmax(srt[i], ob[15 - i]));
            const float mtop = kscore(s0[0]) + kscore(s1[0]);
            float zp = 0.f; int cnt = 0;
#pragma unroll
            for (int s = 0; s < 13; ++s) { const bool sel = ck[s] >= thr; const float e = sel ? __expf(cs[s] - mtop) : 0.f; cs[s] = e; zp += e; cnt += sel ? 1 : 0; }
            float z = zp; z += __shfl_xor(z, 16); z += __shfl_xor(z, 32);
            const float rz = frcp(z);
            const int c0 = __shfl(cnt, lt), c1 = __shfl(cnt, lt + 16), c2 = __shfl(cnt, lt + 32);
            int pos = lq == 0 ? 0 : (lq == 1 ? c0 : (lq == 2 ? c0 + c1 : c0 + c1 + c2));
            unsigned short* dste = (unsigned short*)p.topk() + ((size_t)tok * 8 + h) * 16; float* dstg = p.gates() + ((size_t)tok * 8 + h) * 16;
#pragma unroll
            for (int s = 0; s < 13; ++s) {
                const bool sel = ck[s] >= thr;
                if (sel) { dste[pos] = (unsigned short)ce_[s]; dstg[pos] = cs[s] * rz; ++pos; }
            }
        }
    }
}

__device__ __forceinline__ unsigned xcc_id() { return (unsigned)__builtin_amdgcn_s_getreg((3 << 11) | 20) & 7u; }
__device__ __forceinline__ int q_grab(unsigned* head, int lane) { unsigned v = 0u; if (lane == 0) v = __hip_atomic_fetch_add(head, 16u, __ATOMIC_RELAXED, __HIP_MEMORY_SCOPE_AGENT); return (int)__builtin_amdgcn_readfirstlane(v); }

__device__ __forceinline__ void g_ids(const unsigned short* tkrow, unsigned lo_g16, u32x4 (&ids)[2]) {
#pragma unroll
    for (int q = 0; q < 2; ++q) ids[q] = *(const u32x4*)(tkrow + lo_g16 + q * 8);
}
__device__ __forceinline__ void g_wts(const float* wrow, unsigned lo_g16, u32x4 (&wts)[4]) {
#pragma unroll
    for (int q = 0; q < 4; ++q) wts[q] = *(const u32x4*)(wrow + lo_g16 + q * 4);
}
__device__ __forceinline__ void g_rows8(const unsigned char* tb, unsigned lo_c16, const u32x4& idh, u32x4 (&rows)[8]) {
#pragma unroll
    for (int i = 0; i < 8; ++i) {
        const unsigned w = idh[i >> 1];
        unsigned off; const unsigned k128 = 128u;
        if (i & 1) asm("v_mad_u32_u16 %0, %1, %2, %3 op_sel:[1,0,0,0]" : "=v"(off) : "v"(w), "s"(k128), "v"(lo_c16));
        else asm("v_mad_u32_u16 %0, %1, %2, %3" : "=v"(off) : "v"(w), "s"(k128), "v"(lo_c16));
        rows[i] = *(const u32x4*)(tb + off);
    }
}
typedef _Float16 f16x2 __attribute__((ext_vector_type(2)));
__device__ __forceinline__ void g_dots8_i4(const u32x4 (&uu)[8], const unsigned (&hqh)[4], const unsigned (&hql)[4], int* pd) {
#pragma unroll
    for (int i = 0; i < 8; ++i) {
        int dh = 0, dl = 0;
#pragma unroll
        for (int j = 0; j < 4; ++j) { dh = __builtin_amdgcn_sdot8((int)uu[i][j], (int)hqh[j], dh, false); dl = __builtin_amdgcn_sdot8((int)uu[i][j], (int)hql[j], dl, false); }
        pd[i] = dh * 16 + dl;
    }
}
__device__ __forceinline__ void halve16_c8(const int (&v)[16], int b4, int b2, int b1, int& o0, int& o1) {
    int r8[8], r4[4];
#pragma unroll
    for (int i = 0; i < 8; ++i) { const int keep = b4 ? v[i + 8] : v[i], send = b4 ? v[i] : v[i + 8]; r8[i] = keep + dpp_i<DPP_HMIRROR>(send); }
#pragma unroll
    for (int i = 0; i < 4; ++i) { const int keep = b2 ? r8[i + 4] : r8[i], send = b2 ? r8[i] : r8[i + 4]; r4[i] = keep + dpp_i<DPP_XOR2>(send); }
    { const int keep = b1 ? r4[2] : r4[0], send = b1 ? r4[0] : r4[2]; o0 = keep + dpp_i<DPP_XOR1>(send); }
    { const int keep = b1 ? r4[3] : r4[1], send = b1 ? r4[1] : r4[3]; o1 = keep + dpp_i<DPP_XOR1>(send); }
}
template <bool FIRST>
__device__ __forceinline__ void g_acc8q(const u32x4 (&vv)[8], const u32x4& w0, const u32x4& w1, f16x2 (&acc)[16]) {
#pragma unroll
    for (int i = 0; i < 8; ++i) {
        const unsigned wu = i < 4 ? w0[i & 3] : w1[i & 3];
        const f16x2 w = __builtin_bit_cast(f16x2, wu);
#pragma unroll
        for (int j = 0; j < 4; ++j) {
            const unsigned wv = vv[i][j];
            const f16x2 v0 = __builtin_bit_cast(f16x2, __builtin_amdgcn_cvt_scalef32_pk_f16_fp4(wv, 0.00390625f, 0)), v1 = __builtin_bit_cast(f16x2, __builtin_amdgcn_cvt_scalef32_pk_f16_fp4(wv, 0.00390625f, 1));
            const f16x2 v2 = __builtin_bit_cast(f16x2, __builtin_amdgcn_cvt_scalef32_pk_f16_fp4(wv, 0.00390625f, 2)), v3 = __builtin_bit_cast(f16x2, __builtin_amdgcn_cvt_scalef32_pk_f16_fp4(wv, 0.00390625f, 3));
            if (FIRST && i == 0) { acc[j * 4 + 0] = v0 * w; acc[j * 4 + 1] = v1 * w; acc[j * 4 + 2] = v2 * w; acc[j * 4 + 3] = v3 * w; }
            else { acc[j * 4 + 0] = __builtin_elementwise_fma(v0, w, acc[j * 4 + 0]); acc[j * 4 + 1] = __builtin_elementwise_fma(v1, w, acc[j * 4 + 1]);
                   acc[j * 4 + 2] = __builtin_elementwise_fma(v2, w, acc[j * 4 + 2]); acc[j * 4 + 3] = __builtin_elementwise_fma(v3, w, acc[j * 4 + 3]); }
        }
    }
}
__device__ __forceinline__ void halve16h(const f16x2 (&v)[16], int b1, f16x2& o0, f16x2& o1) {
    f16x2 r8[8], r4[4];
#pragma unroll
    for (int i = 0; i < 8; ++i) { const u32x2 sw = __builtin_amdgcn_permlane32_swap(__builtin_bit_cast(unsigned, v[i]), __builtin_bit_cast(unsigned, v[i + 8]), false, false);
        const unsigned s0 = sw[0], s1 = sw[1];
        r8[i] = __builtin_bit_cast(f16x2, s0) + __builtin_bit_cast(f16x2, s1); }
#pragma unroll
    for (int i = 0; i < 4; ++i) { const u32x2 sw = __builtin_amdgcn_permlane16_swap(__builtin_bit_cast(unsigned, r8[i]), __builtin_bit_cast(unsigned, r8[i + 4]), false, false);
        const unsigned s0 = sw[0], s1 = sw[1];
        r4[i] = __builtin_bit_cast(f16x2, s0) + __builtin_bit_cast(f16x2, s1); }
#pragma unroll
    for (int i = 0; i < 2; ++i) {
        const unsigned keep = __builtin_bit_cast(unsigned, b1 ? r4[i + 2] : r4[i]), send = __builtin_bit_cast(unsigned, b1 ? r4[i] : r4[i + 2]);
        const f16x2 r = __builtin_bit_cast(f16x2, keep) + __builtin_bit_cast(f16x2, (unsigned)__builtin_amdgcn_update_dpp(0, (int)send, 0x128, 0xf, 0xf, true));
        if (i == 0) o0 = r; else o1 = r;
    }
}

template <int WHICH>
__device__ __forceinline__ void ph_gather_sliced(const P& p, LAS unsigned char* lds) {
    int tid_ = threadIdx.x; asm volatile("" : "+v"(tid_));
    const int lane = tid_ & 63, c = lane & 7, g = lane >> 3;
    LAS unsigned char* wlds = lds + __builtin_amdgcn_readfirstlane(tid_ >> 6) * 8192;
    const unsigned xs = xcc_id();
    constexpr int NSL = 4, SLW = DM / NSL;
    for (unsigned tr = 0; tr < NSL; ++tr) {
        const int sl = (int)((xs + tr) & (unsigned)(NSL - 1));
        unsigned* head = p.queues() + (WHICH * 8 + sl) * 64;
        const unsigned char* tb = (WHICH == 0 ? p.pu8() : p.pv8()) + (size_t)sl * (16384 * 128);
        for (;;) {
            const int t0 = q_grab(head, lane);
            if (t0 >= NTOK) break;
            unsigned oc = c * 16, og = g * 16; asm volatile("" : "+v"(oc), "+v"(og));
            const unsigned short* idb = (const unsigned short*)p.topk() + (size_t)t0 * 128;
            const float* wb = p.wl() + (size_t)t0 * 128;
            const float* modb = p.mod() + (size_t)(t0 >> 12) * (6 * DM) + sl * SLW;
            u32x4 idc[2], idn[2], RA[8], RB[8], wc[4];
            g_ids(idb, og, idc); if (WHICH == 1) g_wts(wb, og, wc);
            g_rows8(tb, oc, idc[0], RA);
            if (WHICH == 0) {
                {
                    unsigned l4 = lane * 4; asm volatile("" : "+v"(l4));
                    const bf16_t* xg = p.x1b() + (size_t)t0 * DM + sl * SLW;
                    f32x4 A, Bs;
                    { const f32x4 gg = *(const f32x4*)(p.norm2_g + sl * SLW + l4), sh = *(const f32x4*)(modb + 3 * DM + l4), sc = *(const f32x4*)(modb + 4 * DM + l4);
#pragma unroll
                      for (int i = 0; i < 4; ++i) { A[i] = gg[i] * (1.f + sc[i]); Bs[i] = sh[i]; } }
                    const float rsl = rstd_from_fix(p.rowss()[t0 + (lane & 15)]);
                    {
                        u32x2 xw[16];
#pragma unroll
                        for (int k = 0; k < 16; ++k) xw[k] = *(const u32x2*)(xg + (size_t)k * DM + l4);
#pragma unroll
                        for (int k = 0; k < 16; ++k) {
                            const int tk = k;
                            const float rstd = __builtin_bit_cast(float, __builtin_amdgcn_readlane(__builtin_bit_cast(unsigned, rsl), tk));
                            float h[4], am = 0.f;
                            const unsigned x01 = xw[k][0], x23 = xw[k][1];
                            const float xf[4] = {bflo(x01), bfhi(x01), bflo(x23), bfhi(x23)};
#pragma unroll
                            for (int i = 0; i < 4; ++i) { h[i] = xf[i] * rstd * A[i] + Bs[i]; am = fmaxf(am, fabsf(h[i])); }
                            am = fmaxf(am, dpp_f<DPP_XOR1>(am)); am = fmaxf(am, dpp_f<DPP_XOR2>(am)); am = fmaxf(am, dpp_f<DPP_HMIRROR>(am)); am = fmaxf(am, dpp_f<DPP_ROR8>(am));
                            { const u32x2 sw = __builtin_amdgcn_permlane16_swap(__builtin_bit_cast(unsigned, am), __builtin_bit_cast(unsigned, am), false, false); const unsigned s0 = sw[0], s1 = sw[1];
                              am = fmaxf(__builtin_bit_cast(float, s0), __builtin_bit_cast(float, s1)); }
                            { const u32x2 sw = __builtin_amdgcn_permlane32_swap(__builtin_bit_cast(unsigned, am), __builtin_bit_cast(unsigned, am), false, false); const unsigned s0 = sw[0], s1 = sw[1];
                              am = fmaxf(__builtin_bit_cast(float, s0), __builtin_bit_cast(float, s1)); }
                            am = fmaxf(am, 1e-30f);
                            const float hs = 119.f * frcp(am);
                            unsigned whi = 0u, wlo = 0u;
#pragma unroll
                            for (int i = 0; i < 4; ++i) {
                                const unsigned qb = __builtin_bit_cast(unsigned, h[i] * hs + I8_MAGIC);
                                wlo |= (qb & 15u) << (4 * i);
                                whi |= (((qb + 8u) >> 4) & 15u) << (4 * i);
                            }
                            *(LAS unsigned short*)(wlds + tk * 256 + lane * 2) = (unsigned short)whi;
                            *(LAS unsigned short*)(wlds + tk * 256 + 128 + lane * 2) = (unsigned short)wlo;
                            *(LAS float*)(wlds + 4096 + tk * 4) = am * (1.f / 119.f);
                        }
                    }
                    asm volatile("s_waitcnt lgkmcnt(0)" ::: "memory");
                }
                const unsigned lo_st = og + 2 * (c & 1) + 4 * ((c >> 1) & 1) + 8 * ((c >> 2) & 1);
                float* apb = p.apart() + ((size_t)sl * NTOK + t0) * 128;
#define G1_TOKEN(tt, IDC, IDN, MORE) do { \
                    g_rows8(tb, oc, IDC[1], RB); \
                    if (MORE) g_ids(idb + ((tt) + 1) * 128, og, IDN); \
                    const u32x4 hh4 = *(const LAS u32x4*)(wlds + (tt) * 256 + oc), hl4 = *(const LAS u32x4*)(wlds + (tt) * 256 + 128 + oc); \
                    const float hinv = *(const LAS float*)(wlds + 4096 + (tt) * 4); \
                    const unsigned hqh[4] = {hh4[0], hh4[1], hh4[2], hh4[3]}, hql[4] = {hl4[0], hl4[1], hl4[2], hl4[3]}; \
                    int pd[16]; \
                    g_dots8_i4(RA, hqh, hql, pd); \
                    if (MORE) g_rows8(tb, oc, IDN[0], RA); \
                    g_dots8_i4(RB, hqh, hql, pd + 8); \
                    int o0, o1; halve16_c8(pd, c & 4, c & 2, c & 1, o0, o1); \
                    f32x2 st; st[0] = (float)o0 * hinv; st[1] = (float)o1 * hinv; \
                    *(f32x2*)(apb + (tt) * 128 + lo_st) = st; } while (0)
#pragma unroll 1
                for (int tt = 0; tt < 16; tt += 2) {
                    G1_TOKEN(tt, idc, idn, true);
                    const bool more = tt + 2 < 16;
                    G1_TOKEN(tt + 1, idn, idc, more);
                }
#undef G1_TOKEN
            } else {
                const unsigned lo_col = 2 * oc + 4 * (g & 1) + 8 * ((g >> 1) & 1) + 16 * ((g >> 2) & 1);
                bf16_t* xb = p.x1b() + (size_t)t0 * DM + sl * SLW;
                const f32x4 g2 = *(const f32x4*)(modb + 5 * DM + lo_col);
                u32x2 x1n = *(const u32x2*)(xb + lo_col);
                u32x4 wd[4];
#define G2_TOKEN(tt, IDC, IDN, WC, WN, MORE) do { \
                    g_rows8(tb, oc, IDC[1], RB); \
                    const unsigned x01 = x1n[0], x23 = x1n[1]; \
                    if (MORE) { g_ids(idb + ((tt) + 1) * 128, og, IDN); g_wts(wb + ((tt) + 1) * 128, og, WN); x1n = *(const u32x2*)(xb + (size_t)((tt) + 1) * DM + lo_col); } \
                    f16x2 acc[16]; \
                    g_acc8q<true>(RA, WC[0], WC[1], acc); \
                    if (MORE) g_rows8(tb, oc, IDN[0], RA); \
                    g_acc8q<false>(RB, WC[2], WC[3], acc); \
                    f16x2 oa, ob; halve16h(acc, g & 1, oa, ob); \
                    u32x2 x2; x2[0] = pg8::cvt_pk_bf16(bflo(x01) + g2[0] * (float)oa[0], bfhi(x01) + g2[1] * (float)oa[1]); x2[1] = pg8::cvt_pk_bf16(bflo(x23) + g2[2] * (float)ob[0], bfhi(x23) + g2[3] * (float)ob[1]); \
                    *(u32x2*)(xb + (size_t)(tt) * DM + lo_col) = x2; } while (0)
#pragma unroll 1
                for (int tt = 0; tt < 16; tt += 2) {
                    G2_TOKEN(tt, idc, idn, wc, wd, true);
                    const bool more = tt + 2 < 16;
                    G2_TOKEN(tt + 1, idn, idc, wd, wc, more);
                }
#undef G2_TOKEN
            }
        }
    }
}
__device__ __forceinline__ void ph_gather_weights(const P& p) {
    int tid_ = threadIdx.x; asm volatile("" : "+v"(tid_));
    const size_t gsz = (size_t)gridDim.x * NT;
    const float* isc = p.pisc();
    for (size_t i = (size_t)blockIdx.x * NT + tid_; i < (size_t)NTOK * 128; i += gsz) {
        const unsigned e = ((const unsigned short*)p.topk())[i]; const float gate = p.gates()[i];
        const f32x4 su = *(const f32x4*)(p.pisc_u() + (size_t)e * 4);
        float a = 0.f;
#pragma unroll
        for (int sl = 0; sl < 4; ++sl) a += p.apart()[(size_t)sl * NTOK * 128 + i] * su[sl];
        const float w = gate * isc[16384 + e] * gelu_tanh(a) * 256.f;
        const unsigned short hw = __builtin_bit_cast(unsigned short, (_Float16)w);
        ((unsigned*)p.wl())[i] = (unsigned)hw | ((unsigned)hw << 16);
    }
}
__device__ __forceinline__ void ph_final_norm(const P& p) {
    int tid_ = threadIdx.x; asm volatile("" : "+v"(tid_));
    const int wave = __builtin_amdgcn_readfirstlane(tid_ >> 6), lane = tid_ & 63;
    for (int t4 = blockIdx.x * NWAVES + wave; t4 < NTOK / 4; t4 += gridDim.x * NWAVES) {
        const u32x4* src = (const u32x4*)(p.x1b() + (size_t)t4 * 4 * DM);
        f32x4* row = (f32x4*)(p.out + (size_t)t4 * 4 * DM);
        u32x4 vw[4][2];
#pragma unroll
        for (int k = 0; k < 4; ++k)
#pragma unroll
            for (int j = 0; j < 2; ++j) vw[k][j] = src[k * (DM / 8) + lane + 64 * j];
#pragma unroll
        for (int k = 0; k < 4; ++k) {
            f32x4 v[4]; float ss = 0.f;
#pragma unroll
            for (int j = 0; j < 2; ++j) {
                const unsigned w0 = vw[k][j][0], w1 = vw[k][j][1], w2 = vw[k][j][2], w3 = vw[k][j][3];
                v[j * 2] = (f32x4){bflo(w0), bfhi(w0), bflo(w1), bfhi(w1)}; v[j * 2 + 1] = (f32x4){bflo(w2), bfhi(w2), bflo(w3), bfhi(w3)};
            }
#pragma unroll
            for (int j = 0; j < 4; ++j) ss += v[j][0] * v[j][0] + v[j][1] * v[j][1] + v[j][2] * v[j][2] + v[j][3] * v[j][3];
            ss = wave_sum(ss);
            const float rstd = rsqrtf(ss * (1.f / DM) + EPSN);
#pragma unroll
            for (int j = 0; j < 4; ++j) { const int i4 = (lane + 64 * (j >> 1)) * 2 + (j & 1); const f32x4 fg = ((const f32x4*)p.final_g)[i4]; row[k * (DM / 4) + i4] = v[j] * rstd * fg; }
        }
    }
}

#define XB_TMO      128
#define XB_XCNT(j)  (256  + 64 * (j))
#define XB_XSUB(j)  (1280 + 64 * (j))
#define XB_XGEN(j)  (2304 + 64 * (j))
#define XB_TOP      3328
#define XB_TOPGEN   3392
#define XCD_BAR_WORDS 3456
#define XB_SPIN_CAP (1u << 18)
__device__ __forceinline__ unsigned xb_ld(unsigned* p)              { return __hip_atomic_load(p, __ATOMIC_RELAXED, __HIP_MEMORY_SCOPE_AGENT); }
__device__ __forceinline__ unsigned xb_add(unsigned* p, unsigned v) { return __hip_atomic_fetch_add(p, v, __ATOMIC_RELAXED, __HIP_MEMORY_SCOPE_AGENT); }
__device__ __forceinline__ unsigned xb_xcc_id() { return (unsigned)__builtin_amdgcn_s_getreg((3 << 11) | 20) & 0xFu; }
#define XB_SPIN(cond, bar) do { unsigned _sp = 0; while (cond) { __builtin_amdgcn_s_sleep(1); \
    if ((++_sp & 255u) == 0u) { if (xb_ld(&(bar)[XB_TMO])) break; if (_sp > XB_SPIN_CAP) { atomicAdd(&(bar)[XB_TMO], 1u); break; } } } } while (0)
struct XcdBarrier { unsigned* bar; unsigned x; volatile LAS unsigned* st; };
__device__ __forceinline__ XcdBarrier xcd_barrier_post(unsigned* bar, volatile LAS unsigned* st) {
    XcdBarrier b; b.bar = bar; b.x = xb_xcc_id(); b.st = st;
    if (threadIdx.x == 0) (void)xb_add(&bar[XB_XCNT(b.x)], 1u);
    return b;
}
__device__ __forceinline__ void xcd_barrier_complete(unsigned* bar, unsigned x, unsigned& nloc, unsigned& nx) {
    const unsigned G = gridDim.x * gridDim.y * gridDim.z;
    unsigned sum, cnt, mine, sp = 0u;
    for (;;) {
        sum = 0u; cnt = 0u; mine = 0u;
#pragma unroll
        for (unsigned j = 0; j < 16; ++j) { const unsigned c = xb_ld(&bar[XB_XCNT(j)]); sum += c; cnt += (c > 0u) ? 1u : 0u; mine = (j == x) ? c : mine; }
        if (sum == G) break;
        __builtin_amdgcn_s_sleep(1);
        if ((++sp & 255u) == 0u) { if (xb_ld(&bar[XB_TMO])) break; if (sp > XB_SPIN_CAP) { atomicAdd(&bar[XB_TMO], 1u); break; } }
    }
    nloc = mine > 0u ? mine : 1u; nx = cnt > 0u ? cnt : 1u;
}
__device__ __forceinline__ void xcd_barrier(const XcdBarrier& b) {
    asm volatile("s_waitcnt vmcnt(0)" ::: "memory");
    __syncthreads();
    if (threadIdx.x == 0) {
        unsigned* bar = b.bar;
        __builtin_amdgcn_s_waitcnt(0);
        unsigned nloc = b.st[0], nx = b.st[1];
        if (nloc == 0u) { xcd_barrier_complete(bar, b.x, nloc, nx); b.st[0] = nloc; b.st[1] = nx; }
        const unsigned old = xb_add(&bar[XB_XSUB(b.x)], 1u);
        const unsigned gen = old / nloc;
        if (old + 1u == (gen + 1u) * nloc) {
            __builtin_amdgcn_fence(__ATOMIC_RELEASE, "agent");
            asm volatile("s_waitcnt vmcnt(0)" ::: "memory");
            const unsigned og = xb_add(&bar[XB_TOP], 1u);
            const unsigned tg = og / nx;
            if (og + 1u == (tg + 1u) * nx) xb_add(&bar[XB_TOPGEN], 1u);
            else XB_SPIN(xb_ld(&bar[XB_TOPGEN]) == tg, bar);
            __builtin_amdgcn_fence(__ATOMIC_ACQUIRE, "agent");
            xb_add(&bar[XB_XGEN(b.x)], 1u);
            asm volatile("s_waitcnt vmcnt(0)" ::: "memory");
        } else {
            XB_SPIN(xb_ld(&bar[XB_XGEN(b.x)]) == gen, bar);
            __builtin_amdgcn_fence(__ATOMIC_ACQUIRE, "agent");
            asm volatile("s_waitcnt vmcnt(0)" ::: "memory");
        }
    }
    __syncthreads();
}

constexpr int LDS_BYTES = 147456;
#define GSYNC() xcd_barrier(xbar)
constexpr int MISC_OFF = LDS_BYTES - 64;

__global__ void __launch_bounds__(NT, 2) mega(P p) {
    extern __shared__ __attribute__((aligned(16))) unsigned char lds_raw[];
    LAS unsigned char* lds = (LAS unsigned char*)lds_raw;
    const int G = gridDim.x, bx = blockIdx.x;
    using namespace pg8;
    if (threadIdx.x < 16) ((LAS unsigned*)(lds + MISC_OFF))[threadIdx.x] = 0u;
    for (unsigned i = (unsigned)bx * NT + threadIdx.x; i < (1u << 20) / 8u; i += (unsigned)G * NT) ((unsigned long long*)p.ws)[i] = 0ull;
    cg::this_grid().sync();
    const XcdBarrier xbar = xcd_barrier_post((unsigned*)p.ws, (volatile LAS unsigned*)(lds + MISC_OFF));

    ph_prep(p, lds);
    GSYNC();
    ph_norm1(p, lds);
    GSYNC();
    {
        Gemm<DM / 2, DM / 2, DM / 2, 0, 0, true> g{p.hx(), p.w_in_t()}; StaticOrder<NTOK, INC> S; S.init(G, bx);
        EpiInProj E{p.U(), p.kb(), (size_t)(p.qb() - p.kb()), p.vT(), p.ga(), 0};
        gemm_phase<EpiInProj, StaticOrder<NTOK, INC>, true, true>(lds, g, S, E);
        Gemm<DM / 2, DM / 2, DM / 2, 0, 0, true> g2{p.hc(), p.w_in_t()}; StaticOrder<NCTX, CTXC> S2; S2.init(G, bx);
        EpiInProj E2{p.U(), p.kc(), 0, p.vcT(), p.ga(), 1};
        gemm_phase<EpiInProj, StaticOrder<NCTX, CTXC>, true, true>(lds, g2, S2, E2);
    }
    for (int it = bx - 48; it >= 0 && it < 128; it += G) ssm_prep_item(p, lds, it);
    for (int cb = bx - 176; cb >= 0 && cb < 32; cb += G) {
        const float* m3 = p.mod() + 3 * DM;
        const float* const rows[8] = {m3, m3 + 6 * DM, m3 + 12 * DM, m3 + 18 * DM, m3 + 24 * DM, m3 + 30 * DM, m3 + 36 * DM, m3 + 42 * DM};
        gemv_block64<8, false>(rows, p.w_q, 2048, cb * 64, nullptr, p.c2(), 2048, (LAS float*)lds);
    }
    bg_convert_tables(p);
    GSYNC();
    {
        Gemm<512, SSM_LD, 512, (long)SSM_ROWS * SSM_LD, 256L * 512> g{p.U(), p.Win()}; StaticOrder<SSM_ROWS, 256, 32> S; S.init(G, bx);
        EpiE E{p.E()};
        gemm_phase<EpiE, StaticOrder<SSM_ROWS, 256, 32>, true, true>(lds, g, S, E);
    }
    GSYNC();
    ph_carry(p);
    ph_na(p, lds);
    GSYNC();
    {
        Gemm<SSM_LD, SSM_LD, SSM_LD, (long)SSM_ROWS * SSM_LD, 512L * SSM_LD> g{p.U(), p.Kmat()}; StaticOrder<1024, 512, 32> S; S.init(G, bx);
        EpiZ E{p.z()};
        gemm_phase<EpiZ, StaticOrder<1024, 512, 32>, true, true>(lds, g, S, E);
    }
    GSYNC();
    {
        Gemm<512, 512, 512> g{p.z(), p.w_glu_t()}; StaticOrder<NTOK, 512> S; S.init(G, bx);
        EpiGlu E{p.gl(), p.z(), p.b_glu};
        gemm_phase<EpiGlu, StaticOrder<NTOK, 512>, true, true>(lds, g, S, E);
    }
    GSYNC();
    {
        Gemm<256, 256, 256, 32L * 1024 * 1024, 512L * 1024, true> g{p.na(), p.w_b_t()}; PairOrder<NTOK, DM> S; S.init(G, bx);
        EpiMerge E{p.merged(), p.ga(), p.gb()};
        gemm_phase<EpiMerge, PairOrder<NTOK, DM>, true, true>(lds, g, S, E);
    }
    GSYNC();
    {
        Gemm<DM / 2, DM / 2, DM / 2, 0, 0, true> g{p.merged(), p.w_out_t()}; StaticOrder<NTOK, DM> S; S.init(G, bx);
        EpiOut E{p.x, p.x1b(), p.x1g(), p.mod(), p.norm2_g, p.rowss()};
        gemm_phase<EpiOut, StaticOrder<NTOK, DM>, true, true>(lds, g, S, E);
    }
    GSYNC();
    {
        Gemm<DM, DM, DM> g{p.x1g(), p.w_q_t()}; StaticOrder<NTOK, 2048> S; S.init(G, bx);
        EpiQ E{p.qp(), p.rowss(), p.c2()};
        gemm_phase<EpiQ, StaticOrder<NTOK, 2048>, true, true>(lds, g, S, E);
    }
    GSYNC();
    ph_peer_topk(p, lds);
    GSYNC();
    ph_gather_sliced<0>(p, lds);
    GSYNC();
    ph_gather_weights(p);
    GSYNC();
    ph_gather_sliced<1>(p, lds);
    GSYNC();
    ph_final_norm(p);
}

extern "C" void kernel_launch(void* const* d_in, const int* in_sizes, int n_in, void* d_out, int out_size, void* d_ws, size_t ws_size, hipStream_t stream) {
    static int grid = 0;
    if (grid == 0) {
        int dev = 0, cus = 0, per_cu = 0;
        (void)hipGetDevice(&dev);
        (void)hipDeviceGetAttribute(&cus, hipDeviceAttributeMultiprocessorCount, dev);
        (void)hipFuncSetAttribute((const void*)mega, hipFuncAttributeMaxDynamicSharedMemorySize, LDS_BYTES);
        (void)hipOccupancyMaxActiveBlocksPerMultiprocessor(&per_cu, (const void*)mega, NT, LDS_BYTES);
        if (per_cu < 1) { fprintf(stderr, "occupancy query says %d blocks per CU\n", per_cu); per_cu = 1; }
        grid = cus;
    }
    P p{};
    const float* const* in = (const float* const*)d_in;
    p.x = in[0]; p.c = in[1]; p.ctx = in[2]; p.c_ctx = in[3]; p.w_mod = in[4]; p.b_mod = in[5]; p.norm1_g = in[6]; p.norm2_g = in[7]; p.w_in = in[8];
    p.a_re = in[9]; p.a_im = in[10]; p.log_dt = in[11]; p.b_re = in[12]; p.b_im = in[13]; p.c_re = in[14]; p.c_im = in[15]; p.ssm_d = in[16];
    p.w_glu = in[17]; p.b_glu = in[18]; p.w_a = in[19]; p.w_b = in[20]; p.rpb = in[21]; p.w_out = in[22]; p.w_q = in[23]; p.subkeys = in[24];
    p.peer_u = in[25]; p.peer_v = in[26]; p.final_g = in[27];
    p.out = (float*)d_out;
    p.ws = (unsigned char*)d_ws;
    void* args[] = {&p};
    hipError_t e = hipLaunchCooperativeKernel((const void*)mega, dim3(grid), dim3(NT), args, LDS_BYTES, stream);
    if (e != hipSuccess) fprintf(stderr, "cooperative launch failed: %s (grid %d)\n", hipGetErrorString(e), grid);
}
```

```cpp
#include <hip/hip_runtime.h>
#include <hip/hip_cooperative_groups.h>
#include <cstdio>
#include <cstdint>
namespace cg = cooperative_groups;

#define LAS __attribute__((address_space(3)))
typedef unsigned short bf16_t;
typedef short bf16x8 __attribute__((ext_vector_type(8)));
typedef float f32x4 __attribute__((ext_vector_type(4)));
typedef float f32x2 __attribute__((ext_vector_type(2)));
typedef unsigned u32x4 __attribute__((ext_vector_type(4)));
typedef unsigned u32x2 __attribute__((ext_vector_type(2)));

constexpr int DM = 1024, NB = 8, SEQL = 4096, CTXL = 256, GW = 64, NTOK = NB * SEQL, NCTX = NB * CTXL;
constexpr int INC = 4096, CTXC = 1536;
constexpr int NT = 512, NWAVES = 8;
constexpr float EPSN = 1e-6f;
constexpr int SSM_ROWS = 1280;
constexpr int SSM_LD = 768;

__device__ __forceinline__ unsigned f2bf(float f) { unsigned u = __builtin_bit_cast(unsigned, f); return (u + 0x7fffu + ((u >> 16) & 1u)) >> 16; }
__device__ __forceinline__ unsigned pk2(float lo, float hi) { return f2bf(lo) | (f2bf(hi) << 16); }
__device__ __forceinline__ float bflo(unsigned w) { return __builtin_bit_cast(float, w << 16); }
__device__ __forceinline__ float bfhi(unsigned w) { return __builtin_bit_cast(float, w & 0xffff0000u); }
__device__ __forceinline__ float bf2f(bf16_t h) { return __builtin_bit_cast(float, (unsigned)h << 16); }

__device__ __forceinline__ float wave_sum(float v) {
#pragma unroll
    for (int o = 1; o < 64; o <<= 1) v += __shfl_xor(v, o);
    return v;
}
__device__ __forceinline__ float wave_max(float v) {
#pragma unroll
    for (int o = 1; o < 64; o <<= 1) v = fmaxf(v, __shfl_xor(v, o));
    return v;
}
__device__ __forceinline__ float frcp(float x) { return __builtin_amdgcn_rcpf(x); }
__device__ __forceinline__ float sigmoidf_(float x) { return frcp(1.f + __expf(-x)); }
__device__ __forceinline__ float siluf_(float x) { return x * frcp(1.f + __expf(-x)); }
__device__ __forceinline__ float gelu_tanh(float x) {
    const float k0 = 0.7978845608028654f, k1 = 0.044715f;
    const float u = k0 * (x + k1 * x * x * x);
    const float t = 1.f - 2.f * frcp(1.f + __expf(2.f * u));
    return 0.5f * x * (1.f + t);
}

namespace pg8 {
#define PG8_LAS __attribute__((address_space(3)))
constexpr int BM = 256, BK = 64, HALF = 128, HTB = HALF * BK * 2  , STAGE_BYTES = 8 * HTB, NXCD = 8, WGM = 8;
__host__ __device__ __forceinline__ int lds_byte(int r, int c) { const int st = (r >> 4) * 2 + (c >> 5), rr = r & 15, cc = c & 31, ob = rr * 64 + cc * 2; return st * 1024 + (ob ^ (((ob >> 9) & 1) << 5)); }
__host__ __device__ __forceinline__ void stage_rc(int b, int& R, int& C) { const int st = b / 1024, sb = b % 1024, swz = sb ^ (((sb >> 9) & 1) << 5); R = (st >> 1) * 16 + swz / 64; C = (st & 1) * 32 + (swz % 64) / 2; }
__host__ __device__ __forceinline__ int perm32(int rho) { const int n = rho >> 4, i = rho & 15; return 8 * (i >> 2) + 4 * n + (i & 3); }

struct Unit { int pm, pn, g; };
template <int K_, int LDA, int LDB, long GSA = 0, long GSB = 0, int FP8_ = 0>
struct Gemm {
    const bf16_t* A; const bf16_t* Bt;
    static constexpr int K = K_, lda = LDA, ldb = LDB; static constexpr bool FP8 = FP8_ == 1, FP8L = FP8_ == 2;
    __device__ __forceinline__ const char* abase(const Unit& u) const { return (const char*)(A + (size_t)u.g * GSA + (size_t)u.pm * BM * LDA); }
    __device__ __forceinline__ const char* bbase(const Unit& u) const { return (const char*)(Bt + (size_t)u.g * GSB + (size_t)u.pn * BM * LDB); }
};
template <int M, int N, int NGRP = 1>
struct StaticOrder {
    static constexpr int nM = M / BM, nN = N / BM, nwg = nM * nN;
    int G, c;
    __device__ void init(int G_, int c_) { G = G_; c = c_; }
    __device__ bool next(int i, Unit& u) const {
        const int L = i * G + c; if (L >= nwg * NGRP) return false;
        u.g = L / nwg;
        int wgid = L % nwg; { constexpr int q = nwg / NXCD, r = nwg % NXCD; const int xcd = wgid % NXCD, off = wgid / NXCD; wgid = (xcd < r ? xcd * (q + 1) : r * (q + 1) + (xcd - r) * q) + off; }
        constexpr int nig = WGM * nN; const int gid = wgid / nig, fm = gid * WGM, gsz = (nM - fm) < WGM ? (nM - fm) : WGM;
        u.pm = fm + ((wgid % nig) % gsz); u.pn = (wgid % nig) / gsz; return true;
    }
    __device__ __forceinline__ void a_ready(const Unit&) const {}
    __device__ __forceinline__ void done(const Unit&) const {}
};
__device__ __forceinline__ unsigned cvt_pk_bf16(float lo, float hi) { unsigned r; asm volatile("v_cvt_pk_bf16_f32 %0, %1, %2" : "=v"(r) : "v"(lo), "v"(hi)); return r; }
typedef long i64x2 __attribute__((ext_vector_type(2)));
typedef int i32x4 __attribute__((ext_vector_type(4)));
typedef int i32x8 __attribute__((ext_vector_type(8)));
template <class Epi, class Sched, bool ALIGN_EPI = false, bool SP2 = false, class GemmT>
__device__ __forceinline__ void gemm_phase(PG8_LAS unsigned char* lds, const GemmT g, const Sched& S, const Epi& E) {
    int tid_ = threadIdx.x; asm volatile("" : "+v"(tid_));
    const int tid = tid_, wid = __builtin_amdgcn_readfirstlane(tid >> 6), lane = tid & 63, wr = wid >> 2, wc = wid & 3, fr = lane & 15, fq = lane >> 4;
    const int K = g.K, nt = K / BK;
    unsigned voffA[2], voffB[2];
#pragma unroll
    for (int i = 0; i < 2; ++i) { int R, C; stage_rc(tid * 16 + i * 8192, R, C); const int Rb = Epi::PERM ? ((R & ~31) + perm32(R & 31)) : R;
        voffA[i] = (unsigned)(R * g.lda + C) * 2u; voffB[i] = (unsigned)(Rb * g.ldb + C) * 2u; }
    const size_t kstep = (size_t)(BK * 2);
    const size_t hstepA = (size_t)HALF * g.lda * 2, hstepB = (size_t)HALF * g.ldb * 2;
    const unsigned ldsw = (unsigned)wid * 1024u;
    const int aoff = lds_byte(wr * 64 + fr, fq * 8), boff = lds_byte(wc * 32 + fr, fq * 8);
#define PG8_SA(b, h) (((b) * 2 + (h)) * HTB)
#define PG8_SB(b, h) ((4 + (b) * 2 + (h)) * HTB)
#define PG8_STAGE(bufoff, gbase, voff) do { _Pragma("unroll") for (int _i = 0; _i < 2; ++_i) \
        __builtin_amdgcn_global_load_lds((const unsigned*)((const char*)(gbase) + (voff)[_i]), (PG8_LAS unsigned*)(lds + (bufoff) + ldsw + _i * 8192), 16, 0, 0); } while (0)
#define PG8_LDA(dst, b, h) do { if constexpr (GemmT::FP8) { _Pragma("unroll") for (int m = 0; m < 4; ++m) dst##8[m] = __builtin_shufflevector(*(const PG8_LAS i32x4*)(lds + PG8_SA(b, h) + aoff + m * 2048), *(const PG8_LAS i32x4*)(lds + PG8_SA(b, h) + aoff + m * 2048 + 1024), 0, 1, 2, 3, 4, 5, 6, 7); } \
        else { _Pragma("unroll") for (int m = 0; m < 4; ++m) _Pragma("unroll") for (int k = 0; k < 2; ++k) dst[m][k] = *(const PG8_LAS bf16x8*)(lds + PG8_SA(b, h) + aoff + m * 2048 + k * 1024); } } while (0)
#define PG8_LDB(dst, b, h) do { if constexpr (GemmT::FP8) { _Pragma("unroll") for (int n = 0; n < 2; ++n) dst##8[n] = __builtin_shufflevector(*(const PG8_LAS i32x4*)(lds + PG8_SB(b, h) + boff + n * 2048), *(const PG8_LAS i32x4*)(lds + PG8_SB(b, h) + boff + n * 2048 + 1024), 0, 1, 2, 3, 4, 5, 6, 7); } \
        else { _Pragma("unroll") for (int n = 0; n < 2; ++n) _Pragma("unroll") for (int k = 0; k < 2; ++k) dst[n][k] = *(const PG8_LAS bf16x8*)(lds + PG8_SB(b, h) + boff + n * 2048 + k * 1024); } } while (0)
#define PG8_MMA(ai, bj, At, Bt) do { __builtin_amdgcn_s_setprio(1); \
        if constexpr (GemmT::FP8) { __builtin_amdgcn_sched_barrier(0); _Pragma("unroll") for (int m = 0; m < 4; ++m) _Pragma("unroll") for (int n = 0; n < 2; ++n) \
            { acc[ai][bj][m][n] = __builtin_amdgcn_mfma_scale_f32_16x16x128_f8f6f4(Bt##8[n], At##8[m], acc[ai][bj][m][n], 0, 0, 0, 0x7f7f7f7f, 0, 0x7f7f7f7f); asm volatile("" : "+v"(acc[ai][bj][m][n])); } __builtin_amdgcn_sched_barrier(0); } \
        else if constexpr (GemmT::FP8L) { _Pragma("unroll") for (int m = 0; m < 4; ++m) _Pragma("unroll") for (int n = 0; n < 2; ++n) _Pragma("unroll") for (int k = 0; k < 2; ++k) { \
            const i64x2 b2_ = __builtin_bit_cast(i64x2, Bt[n][k]), a2_ = __builtin_bit_cast(i64x2, At[m][k]); const long bl_ = b2_[0], bh_ = b2_[1], al_ = a2_[0], ah_ = a2_[1]; \
            acc[ai][bj][m][n] = __builtin_amdgcn_mfma_f32_16x16x32_fp8_fp8(bl_, al_, acc[ai][bj][m][n], 0, 0, 0); acc[ai][bj][m][n] = __builtin_amdgcn_mfma_f32_16x16x32_fp8_fp8(bh_, ah_, acc[ai][bj][m][n], 0, 0, 0); } } \
        else { _Pragma("unroll") for (int m = 0; m < 4; ++m) _Pragma("unroll") for (int n = 0; n < 2; ++n) _Pragma("unroll") for (int k = 0; k < 2; ++k) \
            acc[ai][bj][m][n] = __builtin_amdgcn_mfma_f32_16x16x32_bf16(Bt[n][k], At[m][k], acc[ai][bj][m][n], 0, 0, 0); } __builtin_amdgcn_s_setprio(0); } while (0)
#define PG8_WAIT_V(n) asm volatile("s_waitcnt vmcnt(" #n ")" ::: "memory")
#define PG8_WAIT_L(n) asm volatile("s_waitcnt lgkmcnt(" #n ")" ::: "memory")
#define PG8_BAR __builtin_amdgcn_s_barrier()
#define PG8_SCHED __builtin_amdgcn_sched_barrier(0)
    Unit cur, nxt; int ui = 0;
    if (!S.next(0, cur)) return;
    f32x4 acc[2][2][4][2];
#pragma unroll
    for (int a = 0; a < 2; ++a)
#pragma unroll
        for (int b = 0; b < 2; ++b)
#pragma unroll
            for (int m = 0; m < 4; ++m)
#pragma unroll
                for (int n = 0; n < 2; ++n) acc[a][b][m][n] = (f32x4){0.f, 0.f, 0.f, 0.f};
    bf16x8 At[4][2], B0[2][2], B1[2][2];
    i32x8 At8[4], B08[2], B18[2];
    const char* cA = g.abase(cur); const char* cB = g.bbase(cur);
    S.a_ready(cur);
    if constexpr (SP2) {
        PG8_STAGE(PG8_SB(0, 0), cB, voffB); PG8_STAGE(PG8_SB(0, 1), cB + hstepB, voffB); PG8_STAGE(PG8_SA(0, 0), cA, voffA); PG8_STAGE(PG8_SA(0, 1), cA + hstepA, voffA);
        if (wr == 1) PG8_BAR;
        PG8_WAIT_V(2); PG8_BAR;
        PG8_STAGE(PG8_SB(1, 0), cB + kstep, voffB); PG8_STAGE(PG8_SA(1, 0), cA + kstep, voffA); PG8_STAGE(PG8_SB(1, 1), cB + hstepB + kstep, voffB);
        PG8_WAIT_V(6); PG8_BAR;
    } else {
        PG8_STAGE(PG8_SB(0, 0), cB, voffB); PG8_STAGE(PG8_SA(0, 0), cA, voffA); PG8_STAGE(PG8_SB(0, 1), cB + hstepB, voffB); PG8_STAGE(PG8_SA(0, 1), cA + hstepA, voffA);
        if (wr == 1) PG8_BAR;
        PG8_WAIT_V(4); PG8_BAR;
        PG8_STAGE(PG8_SB(1, 0), cB + kstep, voffB); PG8_STAGE(PG8_SA(1, 0), cA + kstep, voffA); PG8_STAGE(PG8_SB(1, 1), cB + hstepB + kstep, voffB);
        PG8_WAIT_V(6); PG8_BAR;
    }
    for (;;) {
        const bool has_next = S.next(ui + 1, nxt);
        const char* nA = has_next ? g.abase(nxt) : cA; const char* nB = has_next ? g.bbase(nxt) : cB;
#pragma unroll 1
        for (int t = 0; t < nt; t += 2) {
            const bool last = (t == nt - 2);
            const char* a1 = cA + (size_t)(t + 1) * kstep;
            const char* a2 = last ? nA : cA + (size_t)(t + 2) * kstep; const char* b2 = last ? nB : cB + (size_t)(t + 2) * kstep;
            const char* a3 = a2 + kstep; const char* b3 = b2 + kstep;
            if (last && has_next) S.a_ready(nxt);
            if constexpr (SP2) {
            PG8_LDB(B0, 0, 0); PG8_LDB(B1, 0, 1); PG8_SCHED; PG8_LDA(At, 0, 0); PG8_STAGE(PG8_SA(1, 1), a1 + hstepA, voffA);
            PG8_WAIT_V(8); PG8_WAIT_L(0); PG8_BAR; PG8_MMA(0, 0, At, B0); PG8_MMA(0, 1, At, B1); PG8_BAR; PG8_SCHED;
            PG8_LDA(At, 0, 1); PG8_STAGE(PG8_SB(0, 0), b2, voffB); PG8_STAGE(PG8_SB(0, 1), b2 + hstepB, voffB); PG8_STAGE(PG8_SA(0, 0), a2, voffA);
            PG8_WAIT_V(8); PG8_WAIT_L(0); PG8_BAR; PG8_MMA(1, 0, At, B0); PG8_MMA(1, 1, At, B1); PG8_BAR; PG8_SCHED;
            PG8_LDB(B0, 1, 0); PG8_LDB(B1, 1, 1); PG8_SCHED; PG8_LDA(At, 1, 0); PG8_STAGE(PG8_SA(0, 1), a2 + hstepA, voffA);
            PG8_WAIT_V(8); PG8_WAIT_L(0); PG8_BAR; PG8_MMA(0, 0, At, B0); PG8_MMA(0, 1, At, B1); PG8_BAR; PG8_SCHED;
            PG8_LDA(At, 1, 1); PG8_STAGE(PG8_SB(1, 0), b3, voffB); PG8_STAGE(PG8_SB(1, 1), b3 + hstepB, voffB); PG8_STAGE(PG8_SA(1, 0), a3, voffA);
            PG8_WAIT_V(8); PG8_WAIT_L(0); PG8_BAR; PG8_MMA(1, 0, At, B0); PG8_MMA(1, 1, At, B1); PG8_BAR; PG8_SCHED;
            } else {
            PG8_LDB(B0, 0, 0); PG8_SCHED; PG8_LDA(At, 0, 0); PG8_STAGE(PG8_SA(1, 1), a1 + hstepA, voffA);
            PG8_WAIT_L(8); PG8_BAR; PG8_WAIT_L(0); PG8_MMA(0, 0, At, B0); PG8_BAR; PG8_SCHED;
            PG8_LDB(B1, 0, 1); PG8_STAGE(PG8_SB(0, 0), b2, voffB);
            PG8_BAR; PG8_WAIT_L(0); PG8_MMA(0, 1, At, B1); PG8_BAR;
            PG8_LDA(At, 0, 1); PG8_STAGE(PG8_SA(0, 0), a2, voffA);
            PG8_BAR; PG8_WAIT_L(0); PG8_MMA(1, 0, At, B0); PG8_BAR; PG8_SCHED;
            PG8_STAGE(PG8_SB(0, 1), b2 + hstepB, voffB);
            PG8_WAIT_V(6); PG8_BAR; PG8_MMA(1, 1, At, B1); PG8_BAR;
            PG8_LDB(B0, 1, 0); PG8_SCHED; PG8_LDA(At, 1, 0); PG8_STAGE(PG8_SA(0, 1), a2 + hstepA, voffA);
            PG8_WAIT_L(8); PG8_BAR; PG8_WAIT_L(0); PG8_MMA(0, 0, At, B0); PG8_BAR; PG8_SCHED;
            PG8_LDB(B1, 1, 1); PG8_STAGE(PG8_SB(1, 0), b3, voffB);
            PG8_BAR; PG8_WAIT_L(0); PG8_MMA(0, 1, At, B1); PG8_BAR;
            PG8_LDA(At, 1, 1); PG8_STAGE(PG8_SA(1, 0), a3, voffA);
            PG8_BAR; PG8_WAIT_L(0); PG8_MMA(1, 0, At, B0); PG8_BAR; PG8_SCHED;
            PG8_STAGE(PG8_SB(1, 1), b3 + hstepB, voffB);
            PG8_WAIT_V(6); PG8_BAR; PG8_MMA(1, 1, At, B1); PG8_BAR;
            }
        }
        if constexpr (ALIGN_EPI) { if (wr == 0) PG8_BAR; }
        if constexpr (!Epi::AFTER_DRAIN) { E(acc, cur, wr, wc, fr, fq); S.done(cur); }
        if (!has_next) break;
        if (!E.keep(cur)) {
#pragma unroll
        for (int a = 0; a < 2; ++a)
#pragma unroll
            for (int b = 0; b < 2; ++b)
#pragma unroll
                for (int m = 0; m < 4; ++m)
#pragma unroll
                    for (int n = 0; n < 2; ++n) acc[a][b][m][n] = (f32x4){0.f, 0.f, 0.f, 0.f};
        }
        cur = nxt; cA = nA; cB = nB; ++ui;
        if constexpr (ALIGN_EPI) { if (wr == 1) PG8_BAR; }
    }
    PG8_WAIT_V(0);
    if constexpr (!ALIGN_EPI) { if (wr == 0) PG8_BAR; }
    PG8_BAR;
    if constexpr (Epi::AFTER_DRAIN) { E.fused(acc, cur, wr, wc, fr, fq, lds, wid, lane); S.done(cur); }
#undef PG8_SA
#undef PG8_SB
#undef PG8_STAGE
#undef PG8_LDA
#undef PG8_LDB
#undef PG8_MMA
#undef PG8_WAIT_V
#undef PG8_WAIT_L
#undef PG8_BAR
#undef PG8_SCHED
}
}

constexpr size_t MiB = 1u << 20;
struct P {
    const float *x, *c, *ctx, *c_ctx, *w_mod, *b_mod, *norm1_g, *norm2_g, *w_in;
    const float *a_re, *a_im, *log_dt, *b_re, *b_im, *c_re, *c_im, *ssm_d;
    const float *w_glu, *b_glu, *w_a, *w_b, *rpb, *w_out, *w_q, *subkeys, *peer_u, *peer_v, *final_g;
    float* out;
    unsigned char* ws;
    __device__ __forceinline__ unsigned long long* rowss() const { return (unsigned long long*)(ws + 512 * 1024); }
    __device__ __forceinline__ float* mod() const { return (float*)(ws + 1 * MiB); }
    __device__ __forceinline__ float* c2() const { return (float*)(ws + 1 * MiB + 256 * 1024); }
    __device__ __forceinline__ bf16_t* w_in_t() const { return (bf16_t*)(ws + 3 * MiB); }
    __device__ __forceinline__ bf16_t* w_glu_t() const { return (bf16_t*)(ws + 11 * MiB); }
    __device__ __forceinline__ bf16_t* w_b_t() const { return (bf16_t*)(ws + 12 * MiB); }
    __device__ __forceinline__ bf16_t* w_a_t() const { return (bf16_t*)(ws + 13 * MiB); }
    __device__ __forceinline__ bf16_t* w_out_t() const { return (bf16_t*)(ws + 14 * MiB); }
    __device__ __forceinline__ bf16_t* w_q_t() const { return (bf16_t*)(ws + 16 * MiB); }
    __device__ __forceinline__ bf16_t* Kmat() const { return (bf16_t*)(ws + 21 * MiB); }
    __device__ __forceinline__ bf16_t* Win() const { return (bf16_t*)(ws + 45 * MiB); }
    __device__ __forceinline__ float* lamT() const { return (float*)(ws + 53 * MiB); }
    __device__ __forceinline__ unsigned char* pu8() const { return ws + 54 * MiB; }
    __device__ __forceinline__ unsigned char* pv8() const { return ws + 70 * MiB; }
    __device__ __forceinline__ float* pisc() const { return (float*)(ws + 53 * MiB + 128 * 1024); }
    __device__ __forceinline__ float* pisc_u() const { return (float*)(ws + 53 * MiB + 256 * 1024); }
    __device__ __forceinline__ bf16_t* ga() const { return (bf16_t*)(ws + 118 * MiB); }
    __device__ __forceinline__ bf16_t* gb() const { return (bf16_t*)(ws + 182 * MiB); }
    __device__ __forceinline__ bf16_t* x1g() const { return (bf16_t*)(ws + 118 * MiB); }
    __device__ __forceinline__ unsigned* topk() const { return (unsigned*)(ws + 182 * MiB); }
    __device__ __forceinline__ float* gates() const { return (float*)(ws + 198 * MiB); }
    __device__ __forceinline__ bf16_t* kb() const { return (bf16_t*)(ws + 246 * MiB); }
    __device__ __forceinline__ bf16_t* vT() const { return (bf16_t*)(ws + 278 * MiB); }
    __device__ __forceinline__ bf16_t* qb() const { return (bf16_t*)(ws + 310 * MiB); }
    __device__ __forceinline__ bf16_t* kc() const { return (bf16_t*)(ws + 342 * MiB); }
    __device__ __forceinline__ bf16_t* vcT() const { return (bf16_t*)(ws + 344 * MiB); }
    __device__ __forceinline__ bf16_t* U() const { return (bf16_t*)(ws + 346 * MiB); }
    __device__ __forceinline__ float* E() const { return (float*)(ws + 406 * MiB); }
    __device__ __forceinline__ bf16_t* merged() const { return (bf16_t*)(ws + 246 * MiB); }
    __device__ __forceinline__ bf16_t* qp() const { return (bf16_t*)(ws + 246 * MiB); }
    __device__ __forceinline__ float* apart() const { return (float*)(ws + 246 * MiB); }
    __device__ __forceinline__ float* wl() const { return (float*)(ws + 374 * MiB); }
    __device__ __forceinline__ float* ss2() const { return (float*)(ws + 406 * MiB); }
    __device__ __forceinline__ bf16_t* x1b() const { return (bf16_t*)(ws + 406 * MiB); }
    __device__ __forceinline__ unsigned* queues() const { return (unsigned*)(ws + 64 * 1024); }
    __device__ __forceinline__ bf16_t* hx() const { return (bf16_t*)out; }
    __device__ __forceinline__ bf16_t* hc() const { return (bf16_t*)((unsigned char*)out + 64 * MiB); }
    __device__ __forceinline__ bf16_t* na() const { return (bf16_t*)out; }
    __device__ __forceinline__ bf16_t* z() const { return (bf16_t*)((unsigned char*)out + 32 * MiB); }
    __device__ __forceinline__ bf16_t* gl() const { return (bf16_t*)((unsigned char*)out + 64 * MiB); }
};

constexpr float SS_FIX = 1099511627776.f, SS_UNFIX = 1.f / 1099511627776.f;
__device__ __forceinline__ float rstd_from_fix(unsigned long long v) { return rsqrtf((float)v * (SS_UNFIX / DM) + EPSN); }
constexpr float ACT8 = 8.f;
constexpr float WIN_SCALE = 32.f;
__device__ __forceinline__ unsigned pk4_fp8(float a, float b, float c, float d) { int w = 0; w = __builtin_amdgcn_cvt_pk_fp8_f32(a, b, w, false); w = __builtin_amdgcn_cvt_pk_fp8_f32(c, d, w, true); return (unsigned)w; }
namespace pg8 {
struct EpiInProj {
    static constexpr bool PERM = true, AFTER_DRAIN = false;
    __device__ __forceinline__ bool keep(const Unit&) const { return false; }
    bf16_t* U; bf16_t* d_kq; size_t kq_stride; bf16_t* d_vT; bf16_t* d_gate; int is_ctx;
    __device__ __forceinline__ void operator()(const f32x4 (&acc)[2][2][4][2], const Unit& u, int wr, int wc, int fr, int fq) const {
        if (u.pn < 2) {
#pragma unroll
            for (int ai = 0; ai < 2; ++ai)
#pragma unroll
                for (int m = 0; m < 4; ++m) {
                    const int row = u.pm * BM + ai * HALF + wr * 64 + m * 16 + fr;
                    const int n = is_ctx ? (1024 + (row >> 8) * 8 + ((row & 255) >> 5)) : ((row >> 12) * 128 + ((row & 4095) >> 5));
                    const int jj = row & 31;
#pragma unroll
                    for (int bj = 0; bj < 2; ++bj) {
                        const int col = u.pn * BM + bj * HALF + wc * 32 + 8 * fq;
                        const f32x4 v0 = acc[ai][bj][m][0] * (1.f / WIN_SCALE), v1 = acc[ai][bj][m][1] * (1.f / WIN_SCALE);
                        u32x2 w; w.x = pk4_fp8(v0[0], v0[1], v0[2], v0[3]); w.y = pk4_fp8(v1[0], v1[1], v1[2], v1[3]);
                        *(u32x2*)((unsigned char*)U + ((size_t)((col >> 4) * SSM_ROWS + n) * SSM_LD + jj * 16 + (col & 15))) = w;
                    }
                    asm volatile("" ::: "memory");
                }
        } else if (u.pn == 4 || u.pn == 5) {
            const int RB = is_ctx ? (CTXL / 64) : (SEQL / 64);
#pragma unroll
            for (int ai = 0; ai < 2; ++ai)
#pragma unroll
                for (int m = 0; m < 4; ++m) {
                    const int row = u.pm * BM + ai * HALF + wr * 64 + m * 16 + fr;
                    const int b = is_ctx ? (row >> 8) : (row >> 12), t = is_ctx ? (row & 255) : (row & 4095);
#pragma unroll
                    for (int bj = 0; bj < 2; ++bj) {
                        const int col = u.pn * BM + bj * HALF + wc * 32 + 8 * fq - 1024;
                        bf16_t* dst = d_vT + ((size_t)((b * 8 + (col >> 6)) * RB + (t >> 6)) * 4096 + (col & 63) * 64 + (t & 63));
#pragma unroll
                        for (int n = 0; n < 2; ++n)
#pragma unroll
                            for (int i = 0; i < 4; ++i) dst[(n * 4 + i) * 64] = (bf16_t)f2bf(acc[ai][bj][m][n][i] * (1.f / WIN_SCALE));
                    }
                    asm volatile("" ::: "memory");
                }
        } else {
            bf16_t* base; int ld, c0;
            if (u.pn < 8) { const int which = (u.pn - 2) >> 2; base = d_kq + (size_t)which * kq_stride; ld = 512; c0 = 512 + which * 1024; }
            else { const int which = (u.pn - 8) >> 2; base = d_gate + (size_t)which * ((size_t)NTOK * DM); ld = DM; c0 = 2048 + which * 1024; }
#pragma unroll
            for (int ai = 0; ai < 2; ++ai)
#pragma unroll
                for (int m = 0; m < 4; ++m) {
                    const int row = u.pm * BM + ai * HALF + wr * 64 + m * 16 + fr;
#pragma unroll
                    for (int bj = 0; bj < 2; ++bj) {
                        const int col = u.pn * BM + bj * HALF + wc * 32 + 8 * fq - c0;
                        const f32x4 v0 = acc[ai][bj][m][0] * (1.f / WIN_SCALE), v1 = acc[ai][bj][m][1] * (1.f / WIN_SCALE);
                        u32x4 w; w.x = cvt_pk_bf16(v0[0], v0[1]); w.y = cvt_pk_bf16(v0[2], v0[3]); w.z = cvt_pk_bf16(v1[0], v1[1]); w.w = cvt_pk_bf16(v1[2], v1[3]);
                        *(u32x4*)(base + (size_t)row * ld + col) = w;
                    }
                    asm volatile("" ::: "memory");
                }
        }
    }
};
struct EpiGlu {
    static constexpr bool PERM = true, AFTER_DRAIN = false;
    __device__ __forceinline__ bool keep(const Unit&) const { return false; }
    bf16_t* gl; const bf16_t* z; const float* bias;
    __device__ __forceinline__ void operator()(const f32x4 (&acc)[2][2][4][2], const Unit& u, int wr, int wc, int fr, int fq) const {
#pragma unroll
        for (int ai = 0; ai < 2; ++ai)
#pragma unroll
            for (int m = 0; m < 4; ++m) {
                const int row = u.pm * BM + ai * HALF + wr * 64 + m * 16 + fr;
#pragma unroll
                for (int bj = 0; bj < 2; ++bj) {
                    const int col = u.pn * BM + bj * HALF + wc * 32 + 8 * fq;
                    const f32x4 v0 = acc[ai][bj][m][0], v1 = acc[ai][bj][m][1];
                    const f32x4 b0 = *(const f32x4*)(bias + col), b1 = *(const f32x4*)(bias + col + 4);
                    const u32x4 zz = *(const u32x4*)(z + (size_t)row * 512 + col);
                    float o[8];
                    o[0] = bflo(zz.x) * sigmoidf_(v0[0] + b0[0]); o[1] = bfhi(zz.x) * sigmoidf_(v0[1] + b0[1]);
                    o[2] = bflo(zz.y) * sigmoidf_(v0[2] + b0[2]); o[3] = bfhi(zz.y) * sigmoidf_(v0[3] + b0[3]);
                    o[4] = bflo(zz.z) * sigmoidf_(v1[0] + b1[0]); o[5] = bfhi(zz.z) * sigmoidf_(v1[1] + b1[1]);
                    o[6] = bflo(zz.w) * sigmoidf_(v1[2] + b1[2]); o[7] = bfhi(zz.w) * sigmoidf_(v1[3] + b1[3]);
                    u32x2 w; w.x = pk4_fp8(o[0] * ACT8, o[1] * ACT8, o[2] * ACT8, o[3] * ACT8); w.y = pk4_fp8(o[4] * ACT8, o[5] * ACT8, o[6] * ACT8, o[7] * ACT8);
                    *(u32x2*)((unsigned char*)gl + (size_t)row * 512 + col) = w;
                }
            }
    }
};
template <int M, int N>
struct PairOrder {
    StaticOrder<M, N> S;
    __device__ void init(int G_, int c_) { S.init(G_, c_); }
    __device__ bool next(int i, Unit& u) const { if (!S.next(i >> 1, u)) return false; u.g = i & 1; return true; }
    __device__ __forceinline__ void a_ready(const Unit&) const {}
    __device__ __forceinline__ void done(const Unit&) const {}
};
struct EpiMerge {
    static constexpr bool PERM = true, AFTER_DRAIN = false;
    __device__ __forceinline__ bool keep(const Unit& u) const { return u.g == 0; }
    bf16_t* merged; const bf16_t* ga; const bf16_t* gb;
    __device__ __forceinline__ void operator()(f32x4 (&acc)[2][2][4][2], const Unit& u, int wr, int wc, int fr, int fq) const {
#pragma unroll
        for (int ai = 0; ai < 2; ++ai)
#pragma unroll
            for (int m = 0; m < 4; ++m) {
                const int row = u.pm * BM + ai * HALF + wr * 64 + m * 16 + fr;
#pragma unroll
                for (int bj = 0; bj < 2; ++bj) {
                    const int col = u.pn * BM + bj * HALF + wc * 32 + 8 * fq;
                    const u32x4 a4 = *(const u32x4*)(ga + (size_t)row * DM + col);
                    float sa[8];
#pragma unroll
                    for (int q = 0; q < 4; ++q) { sa[2 * q] = sigmoidf_(bflo(a4[q])); sa[2 * q + 1] = sigmoidf_(bfhi(a4[q])); }
                    if (u.g == 0) {
                        const u32x4 b4 = *(const u32x4*)(gb + (size_t)row * DM + col);
#pragma unroll
                        for (int q = 0; q < 4; ++q) {
                            const float r0 = sigmoidf_(bflo(b4[q])) * frcp(sa[2 * q]), r1 = sigmoidf_(bfhi(b4[q])) * frcp(sa[2 * q + 1]);
                            acc[ai][bj][m][q >> 1][(q & 1) * 2] *= r0; acc[ai][bj][m][q >> 1][(q & 1) * 2 + 1] *= r1;
                        }
                    } else {
                        const f32x4 v0 = acc[ai][bj][m][0], v1 = acc[ai][bj][m][1];
                        constexpr float f = ACT8 / (ACT8 * WIN_SCALE);
                        u32x2 w; w[0] = pk4_fp8(v0[0] * sa[0] * f, v0[1] * sa[1] * f, v0[2] * sa[2] * f, v0[3] * sa[3] * f); w[1] = pk4_fp8(v1[0] * sa[4] * f, v1[1] * sa[5] * f, v1[2] * sa[6] * f, v1[3] * sa[7] * f);
                        *(u32x2*)((unsigned char*)merged + (size_t)row * DM + col) = w;
                    }
                }
                asm volatile("" ::: "memory");
            }
    }
};
struct EpiOut {
    static constexpr bool PERM = true, AFTER_DRAIN = false;
    __device__ __forceinline__ bool keep(const Unit&) const { return false; }
    const float* x; bf16_t* x1; bf16_t* x1g; const float* mod; const float* g2; unsigned long long* rowss;
    __device__ __forceinline__ void operator()(const f32x4 (&acc)[2][2][4][2], const Unit& u, int wr, int wc, int fr, int fq) const {
#pragma unroll
        for (int ai = 0; ai < 2; ++ai)
#pragma unroll
            for (int m = 0; m < 4; ++m) {
                const int row = u.pm * BM + ai * HALF + wr * 64 + m * 16 + fr;
                const float* modb = mod + (size_t)(row >> 12) * (6 * DM);
                float ss = 0.f;
#pragma unroll
                for (int bj = 0; bj < 2; ++bj) {
                    const int col = u.pn * BM + bj * HALF + wc * 32 + 8 * fq;
#pragma unroll
                    for (int n = 0; n < 2; ++n) {
                        const int cc = col + 4 * n;
                        const f32x4 v = acc[ai][bj][m][n] * (1.f / (ACT8 * WIN_SCALE));
                        const f32x4 xx = *(const f32x4*)(x + (size_t)row * DM + cc);
                        const f32x4 g1 = *(const f32x4*)(modb + 2 * DM + cc), sc = *(const f32x4*)(modb + 4 * DM + cc), gg = *(const f32x4*)(g2 + cc);
                        const f32x4 o = xx + g1 * v;
                        { u32x2 w1; w1.x = cvt_pk_bf16(o[0], o[1]); w1.y = cvt_pk_bf16(o[2], o[3]); *(u32x2*)(x1 + (size_t)row * DM + cc) = w1; }
                        ss += o[0] * o[0] + o[1] * o[1] + o[2] * o[2] + o[3] * o[3];
                        const f32x4 og = o * gg * (sc + 1.f);
                        u32x2 w; w.x = cvt_pk_bf16(og[0], og[1]); w.y = cvt_pk_bf16(og[2], og[3]);
                        *(u32x2*)(x1g + (size_t)row * DM + cc) = w;
                    }
                }
                ss += __shfl_xor(ss, 16); ss += __shfl_xor(ss, 32);
                if (fq == 0) atomicAdd(rowss + row, (unsigned long long)(ss * SS_FIX));
            }
    }
};
struct EpiQ {
    static constexpr bool PERM = true, AFTER_DRAIN = false;
    __device__ __forceinline__ bool keep(const Unit&) const { return false; }
    bf16_t* qp; const unsigned long long* rowss; const float* c2;
    __device__ __forceinline__ void operator()(const f32x4 (&acc)[2][2][4][2], const Unit& u, int wr, int wc, int fr, int fq) const {
#pragma unroll
        for (int ai = 0; ai < 2; ++ai)
#pragma unroll
            for (int m = 0; m < 4; ++m) {
                const int row = u.pm * BM + ai * HALF + wr * 64 + m * 16 + fr;
                const float rstd = rstd_from_fix(rowss[row]);
                const float* cb = c2 + (size_t)(row >> 12) * 2048;
#pragma unroll
                for (int bj = 0; bj < 2; ++bj) {
                    const int col = u.pn * BM + bj * HALF + wc * 32 + 8 * fq;
                    const f32x4 v0 = acc[ai][bj][m][0] * rstd + *(const f32x4*)(cb + col), v1 = acc[ai][bj][m][1] * rstd + *(const f32x4*)(cb + col + 4);
                    u32x4 w; w.x = cvt_pk_bf16(v0[0], v0[1]); w.y = cvt_pk_bf16(v0[2], v0[3]); w.z = cvt_pk_bf16(v1[0], v1[1]); w.w = cvt_pk_bf16(v1[2], v1[3]);
                    *(u32x4*)(qp + (size_t)row * 2048 + col) = w;
                }
            }
    }
};
struct EpiE {
    static constexpr bool PERM = true, AFTER_DRAIN = false;
    __device__ __forceinline__ bool keep(const Unit&) const { return false; }
    float* E;
    __device__ __forceinline__ void operator()(const f32x4 (&acc)[2][2][4][2], const Unit& u, int wr, int wc, int fr, int fq) const {
#pragma unroll
        for (int ai = 0; ai < 2; ++ai)
#pragma unroll
            for (int m = 0; m < 4; ++m) {
                const int row = u.pm * BM + ai * HALF + wr * 64 + m * 16 + fr;
#pragma unroll
                for (int bj = 0; bj < 2; ++bj) {
                    const int col = u.pn * BM + bj * HALF + wc * 32 + 8 * fq;
                    float* d = E + ((size_t)(u.g * SSM_ROWS + row) * 256 + col);
                    *(f32x4*)d = acc[ai][bj][m][0] * (1.f / WIN_SCALE); *(f32x4*)(d + 4) = acc[ai][bj][m][1] * (1.f / WIN_SCALE);
                }
            }
    }
};
struct EpiZ {
    static constexpr bool PERM = true, AFTER_DRAIN = false;
    __device__ __forceinline__ bool keep(const Unit&) const { return false; }
    bf16_t* z;
    __device__ __forceinline__ void operator()(const f32x4 (&acc)[2][2][4][2], const Unit& u, int wr, int wc, int fr, int fq) const {
#pragma unroll
        for (int ai = 0; ai < 2; ++ai)
#pragma unroll
            for (int m = 0; m < 4; ++m) {
                const int n = u.pm * BM + ai * HALF + wr * 64 + m * 16 + fr;
                const size_t tok0 = (size_t)(n >> 7) * SEQL + (size_t)(n & 127) * 32;
#pragma unroll
                for (int bj = 0; bj < 2; ++bj) {
                    const int col = u.pn * BM + bj * HALF + wc * 32 + 8 * fq;
                    const f32x4 v0 = acc[ai][bj][m][0] * (1.f / WIN_SCALE), v1 = acc[ai][bj][m][1] * (1.f / WIN_SCALE);
                    u32x4 w; w.x = cvt_pk_bf16(gelu_tanh(v0[0]), gelu_tanh(v0[1])); w.y = cvt_pk_bf16(gelu_tanh(v0[2]), gelu_tanh(v0[3]));
                    w.z = cvt_pk_bf16(gelu_tanh(v1[0]), gelu_tanh(v1[1])); w.w = cvt_pk_bf16(gelu_tanh(v1[2]), gelu_tanh(v1[3]));
                    *(u32x4*)(z + (tok0 + (col >> 4)) * 512 + u.g * 16 + (col & 15)) = w;
                }
            }
    }
};
}

__device__ __forceinline__ void sincos_d(double th, double& s, double& c) {
    const double twopi = 6.283185307179586476925, hpi = 1.570796326794896619231;
    th -= twopi * rint(th / twopi);
    const double q = rint(th / hpi); const double y = th - q * hpi, y2 = y * y;
    const double sy = y * (1.0 - y2 / 6.0 * (1.0 - y2 / 20.0 * (1.0 - y2 / 42.0 * (1.0 - y2 / 72.0 * (1.0 - y2 / 110.0 * (1.0 - y2 / 156.0 * (1.0 - y2 / 210.0)))))));
    const double cy = 1.0 - y2 / 2.0 * (1.0 - y2 / 12.0 * (1.0 - y2 / 30.0 * (1.0 - y2 / 56.0 * (1.0 - y2 / 90.0 * (1.0 - y2 / 132.0 * (1.0 - y2 / 182.0))))));
    const int qi = ((int)q) & 3;
    s = qi == 0 ? sy : (qi == 1 ? cy : (qi == 2 ? -sy : -cy));
    c = qi == 0 ? cy : (qi == 1 ? -sy : (qi == 2 ? -cy : sy));
}
__device__ __forceinline__ void ssm_prep_item(const P& p, LAS unsigned char* lds, int item) {
    const int g = item >> 2, qtr = item & 3, tid = threadIdx.x;
    LAS f32x2* lamk = (LAS f32x2*)lds;
    LAS f32x2* Bb = lamk + 2 * 64 * 33;
    LAS f32x2* Cc = Bb + 2 * 64 * 16;
    LAS float* Kc = (LAS float*)(Cc + 2 * 16 * 64);
    if (tid < 128) {
        const int d = tid >> 6, pp = tid & 63, gi = d * 32 + g;
        const double are = (double)p.a_re[gi * 64 + pp], aim = (double)p.a_im[gi * 64 + pp];
        const double dt = (double)expf(p.log_dt[gi]);
        const double er = exp(are * dt); double sn, cs; sincos_d(aim * dt, sn, cs);
        const double lr = er * cs, li = er * sn;
        double pr = 1.0, pi_ = 0.0;
        for (int k = 0; k <= 32; ++k) {
            lamk[(d * 64 + pp) * 33 + k] = (f32x2){(float)pr, (float)pi_};
            const double nr_ = pr * lr - pi_ * li, ni_ = pr * li + pi_ * lr; pr = nr_; pi_ = ni_;
        }
        if (qtr == 0) { const f32x2 l32 = lamk[(d * 64 + pp) * 33 + 32]; *(f32x2*)(p.lamT() + (size_t)(gi * 64 + pp) * 2) = l32; }
        const double nr = lr - 1.0, ni = li, den = are * are + aim * aim;
        const double qr = (nr * are + ni * aim) / den, qi = (ni * are - nr * aim) / den;
        f32x4 brv[4], biv[4];
#pragma unroll
        for (int q = 0; q < 4; ++q) { brv[q] = *(const f32x4*)(p.b_re + ((size_t)gi * 64 + pp) * 16 + 4 * q); biv[q] = *(const f32x4*)(p.b_im + ((size_t)gi * 64 + pp) * 16 + 4 * q); }
#pragma unroll
        for (int h = 0; h < 16; ++h) {
            const double br = (double)brv[h >> 2][h & 3], bi = (double)biv[h >> 2][h & 3];
            Bb[(d * 64 + pp) * 16 + h] = (f32x2){(float)(qr * br - qi * bi), (float)(qr * bi + qi * br)};
        }
    }
    for (int e = tid; e < 2 * 16 * 64; e += NT) {
        const int d = e >> 10, h = (e >> 6) & 15, pp = e & 63; const size_t src = ((size_t)(d * 32 + g) * 16 + h) * 64 + pp;
        Cc[e] = (f32x2){p.c_re[src], p.c_im[src]};
    }
    __syncthreads();
    {
        const int wv = __builtin_amdgcn_readfirstlane(tid >> 6), lane = tid & 63, lm = lane & 15, kq = lane >> 4, d = wv >> 2;
        bf16x8 bop[4];
#pragma unroll
        for (int ks = 0; ks < 4; ++ks) {
            u32x4 w;
#pragma unroll
            for (int j = 0; j < 4; ++j) { const f32x2 bb = Bb[(d * 64 + ks * 16 + kq * 4 + j) * 16 + lm]; w[j] = pk2(bb[0], bb[1]); }
            bop[ks] = __builtin_bit_cast(bf16x8, w);
        }
#pragma unroll 1
        for (int k = (wv & 3) * 8; k < (wv & 3) * 8 + 8; ++k) {
            f32x4 acc = {0.f, 0.f, 0.f, 0.f};
#pragma unroll
            for (int ks = 0; ks < 4; ++ks) {
                u32x4 w;
#pragma unroll
                for (int j = 0; j < 4; ++j) {
                    const int pp = ks * 16 + kq * 4 + j;
                    const f32x2 c = Cc[(d * 16 + lm) * 64 + pp], l = lamk[(d * 64 + pp) * 33 + k];
                    w[j] = pk2(c[0] * l[0] - c[1] * l[1], -(c[0] * l[1] + c[1] * l[0]));
                }
                acc = __builtin_amdgcn_mfma_f32_16x16x32_bf16(__builtin_bit_cast(bf16x8, w), bop[ks], acc, 0, 0, 0);
            }
#pragma unroll
            for (int r = 0; r < 4; ++r) Kc[((d * 32 + k) * 16 + kq * 4 + r) * 16 + lm] = acc[r];
        }
    }
    __syncthreads();
    for (int ch = tid; ch < 128 * 96; ch += NT) {
        const int mrow = 128 * qtr + ch / 96, k0 = (ch % 96) * 8, ii = mrow >> 4, h = mrow & 15;
        float v[8];
        if (k0 < 512) {
            const int jj = k0 >> 4, h20 = k0 & 15;
#pragma unroll
            for (int i = 0; i < 8; ++i) {
                const int h2 = h20 + i; float val = 0.f;
                if (ii >= jj) val += Kc[((0 * 32 + (ii - jj)) * 16 + h) * 16 + h2];
                if (jj >= ii) val += Kc[((1 * 32 + (jj - ii)) * 16 + h) * 16 + h2];
                if (ii == jj && h == h2) val += p.ssm_d[g * 16 + h];
                v[i] = val;
            }
        } else {
            const int sc = k0 - 512, d = sc >> 7, ri = (sc >> 6) & 1, p0 = sc & 63, e = d == 0 ? ii + 1 : 32 - ii;
#pragma unroll
            for (int i = 0; i < 8; ++i) {
                const int pp = p0 + i; const f32x2 c = Cc[(d * 16 + h) * 64 + pp], l = lamk[(d * 64 + pp) * 33 + e];
                const float clr = c[0] * l[0] - c[1] * l[1], cli = c[0] * l[1] + c[1] * l[0];
                v[i] = ri == 0 ? clr : -cli;
            }
        }
        u32x2 o; o.x = pk4_fp8(v[0] * WIN_SCALE, v[1] * WIN_SCALE, v[2] * WIN_SCALE, v[3] * WIN_SCALE); o.y = pk4_fp8(v[4] * WIN_SCALE, v[5] * WIN_SCALE, v[6] * WIN_SCALE, v[7] * WIN_SCALE);
        *(u32x2*)((unsigned char*)p.Kmat() + ((size_t)(g * 512 + mrow) * SSM_LD + k0)) = o;
    }
    for (int ch = tid; ch < 64 * 64; ch += NT) {
        const int nrow = 64 * qtr + ch / 64, k0 = (ch % 64) * 8, d = nrow >> 7, ri = (nrow >> 6) & 1, pp = nrow & 63;
        const int jj = k0 >> 4, h20 = k0 & 15, e = d == 0 ? 31 - jj : jj;
        const f32x2 l = lamk[(d * 64 + pp) * 33 + e];
        float v[8];
#pragma unroll
        for (int i = 0; i < 8; ++i) { const f32x2 b = Bb[(d * 64 + pp) * 16 + h20 + i]; v[i] = ri == 0 ? (l[0] * b[0] - l[1] * b[1]) : (l[0] * b[1] + l[1] * b[0]); }
        u32x2 o; o.x = pk4_fp8(v[0] * WIN_SCALE, v[1] * WIN_SCALE, v[2] * WIN_SCALE, v[3] * WIN_SCALE); o.y = pk4_fp8(v[4] * WIN_SCALE, v[5] * WIN_SCALE, v[6] * WIN_SCALE, v[7] * WIN_SCALE);
        *(u32x2*)((unsigned char*)p.Win() + ((size_t)(g * 256 + nrow) * 512 + k0)) = o;
    }
    __syncthreads();
}
__device__ __forceinline__ void ph_carry(const P& p) {
    int tid = threadIdx.x; asm volatile("" : "+v"(tid));
    if (tid >= 128) return;
    for (int gidx = blockIdx.x * 128 + tid; gidx < 32 * 8 * 2 * 64; gidx += gridDim.x * 128) {
        const int pp = gidx & 63, d = (gidx >> 6) & 1, b = (gidx >> 7) & 7, g = gidx >> 10;
        const f32x2 lt = *(const f32x2*)(p.lamT() + (size_t)((d * 32 + g) * 64 + pp) * 2);
        const float* Eg = p.E() + (size_t)g * SSM_ROWS * 256 + d * 128 + pp;
        unsigned char* Ug = (unsigned char*)p.U() + (size_t)g * SSM_ROWS * SSM_LD + 512 + d * 128 + pp;
        float fr = 0.f, fi = 0.f;
#pragma unroll
        for (int cc = 0; cc < 8; ++cc) {
            const int n = 1024 + b * 8 + (d == 0 ? cc : 7 - cc);
            const float er = Eg[(size_t)n * 256], ei = Eg[(size_t)n * 256 + 64];
            const float nr = lt[0] * fr - lt[1] * fi + er, ni = lt[0] * fi + lt[1] * fr + ei; fr = nr; fi = ni;
        }
#pragma unroll 8
        for (int c = 0; c < 128; ++c) {
            const int n = b * 128 + (d == 0 ? c : 127 - c);
            const float er = Eg[(size_t)n * 256], ei = Eg[(size_t)n * 256 + 64];
            { const unsigned w8 = pk4_fp8(fr, fi, 0.f, 0.f); Ug[(size_t)n * SSM_LD] = (unsigned char)(w8 & 255u); Ug[(size_t)n * SSM_LD + 64] = (unsigned char)((w8 >> 8) & 255u); }
            const float nr = lt[0] * fr - lt[1] * fi + er, ni = lt[0] * fi + lt[1] * fr + ei; fr = nr; fi = ni;
        }
    }
}


__device__ __forceinline__ void p0_transpose_item_fp8(const float* W, int K, int N, unsigned char* WT, float scale, LAS float* scr, int item, int lane) {
    const int nblk = N / 32, kb = item / nblk, nb = item % nblk, k0 = 64 * kb, n0 = 32 * nb;
#pragma unroll 8
    for (int i = 0; i < 32; ++i) { const int kk = 2 * i + (lane >> 5); scr[kk * 33 + (lane & 31)] = W[(size_t)(k0 + kk) * N + n0 + (lane & 31)]; }
    asm volatile("s_waitcnt lgkmcnt(0)" ::: "memory");
    const int c = lane & 7;
#pragma unroll
    for (int j = 0; j < 4; ++j) { const int n = (lane >> 3) + 8 * j; const LAS float* s = scr + (8 * c) * 33 + n;
        u32x2 o; o.x = pk4_fp8(s[0 * 33] * scale, s[1 * 33] * scale, s[2 * 33] * scale, s[3 * 33] * scale); o.y = pk4_fp8(s[4 * 33] * scale, s[5 * 33] * scale, s[6 * 33] * scale, s[7 * 33] * scale);
        *(u32x2*)(WT + (size_t)(n0 + n) * K + k0 + 8 * c) = o; }
    asm volatile("s_waitcnt lgkmcnt(0)" ::: "memory");
}
__device__ __forceinline__ void p0_transpose_item(const float* W, int K, int N, bf16_t* WT, LAS float* scr, int item, int lane) {
    const int nblk = N / 32, kb = item / nblk, nb = item % nblk, k0 = 64 * kb, n0 = 32 * nb;
#pragma unroll 8
    for (int i = 0; i < 32; ++i) { const int kk = 2 * i + (lane >> 5); scr[kk * 33 + (lane & 31)] = W[(size_t)(k0 + kk) * N + n0 + (lane & 31)]; }
    asm volatile("s_waitcnt lgkmcnt(0)" ::: "memory");
    const int c = lane & 7;
#pragma unroll
    for (int j = 0; j < 4; ++j) { const int n = (lane >> 3) + 8 * j; const LAS float* s = scr + (8 * c) * 33 + n;
        u32x4 o; o.x = pk2(s[0 * 33], s[1 * 33]); o.y = pk2(s[2 * 33], s[3 * 33]); o.z = pk2(s[4 * 33], s[5 * 33]); o.w = pk2(s[6 * 33], s[7 * 33]);
        *(u32x4*)(WT + (size_t)(n0 + n) * K + k0 + 8 * c) = o; }
    asm volatile("s_waitcnt lgkmcnt(0)" ::: "memory");
}

template <int NR, bool SILU>
__device__ __forceinline__ void gemv_block64(const float* const (&rows)[NR], const float* W, int ldw, int col0, const float* bias, float* y, int ldy, LAS float* scr) {
    const int wave = threadIdx.x >> 6, lane = threadIdx.x & 63;
    LAS float* act = scr + 8 * NR * 64;
#pragma unroll
    for (int r = 0; r < NR; ++r) for (int k = threadIdx.x; k < DM; k += NT) { const float s = rows[r][k]; act[r * DM + k] = SILU ? siluf_(s) : s; }
    __syncthreads();
    float acc[NR];
#pragma unroll
    for (int r = 0; r < NR; ++r) acc[r] = 0.f;
    const int kb = wave * 128;
#pragma unroll 32
    for (int k = kb; k < kb + 128; ++k) {
        const float w = W[(size_t)k * ldw + col0 + lane];
#pragma unroll
        for (int r = 0; r < NR; ++r) acc[r] += act[r * DM + k] * w;
    }
#pragma unroll
    for (int r = 0; r < NR; ++r) scr[(wave * NR + r) * 64 + lane] = acc[r];
    __syncthreads();
    for (int e = threadIdx.x; e < NR * 64; e += NT) {
        const int r = e >> 6, l = e & 63; float s = 0.f;
#pragma unroll
        for (int w = 0; w < 8; ++w) s += scr[(w * NR + r) * 64 + l];
        y[(size_t)r * ldy + col0 + l] = s + (bias ? bias[col0 + l] : 0.f);
    }
    __syncthreads();
}

__device__ __forceinline__ void ph_prep(const P& p, LAS unsigned char* lds) {
    int tid_ = threadIdx.x; asm volatile("" : "+v"(tid_));
    const int wave = tid_ >> 6, lane = tid_ & 63, G = gridDim.x;
    for (int cb = blockIdx.x; cb < 96; cb += G) {
        const float* const rows[9] = {p.c, p.c + DM, p.c + 2 * DM, p.c + 3 * DM, p.c + 4 * DM, p.c + 5 * DM, p.c + 6 * DM, p.c + 7 * DM, p.c_ctx};
        gemv_block64<9, true>(rows, p.w_mod, 6 * DM, cb * 64, p.b_mod, p.mod(), 6 * DM, (LAS float*)lds);
    }
    {
        LAS float* scr = (LAS float*)(lds + wave * 16384);
        const int gw = blockIdx.x * NWAVES + wave, NGW = G * NWAVES;
        constexpr int I_IN = (DM / 64) * (INC / 32), I_GLU = (512 / 64) * (512 / 32), I_A = (512 / 64) * (DM / 32), I_OUT = (DM / 64) * (DM / 32), I_Q = (DM / 64) * (2048 / 32);
        constexpr int NITEMS = I_IN + I_GLU + 2 * I_A + I_OUT + I_Q;
        for (int it = gw; it < NITEMS; it += NGW) {
            int r = it;
            if (r < I_IN) { p0_transpose_item_fp8(p.w_in, DM, INC, (unsigned char*)p.w_in_t(), WIN_SCALE, scr, r, lane); continue; } r -= I_IN;
            if (r < I_GLU) { p0_transpose_item(p.w_glu, 512, 512, p.w_glu_t(), scr, r, lane); continue; } r -= I_GLU;
            if (r < I_A) { p0_transpose_item_fp8(p.w_a, 512, DM, (unsigned char*)p.w_a_t(), WIN_SCALE, scr, r, lane); continue; } r -= I_A;
            if (r < I_A) { p0_transpose_item_fp8(p.w_b, 512, DM, (unsigned char*)p.w_b_t(), WIN_SCALE, scr, r, lane); continue; } r -= I_A;
            if (r < I_OUT) { p0_transpose_item_fp8(p.w_out, DM, DM, (unsigned char*)p.w_out_t(), WIN_SCALE, scr, r, lane); continue; } r -= I_OUT;
            p0_transpose_item(p.w_q, DM, 2048, p.w_q_t(), scr, r, lane);
        }
    }
}

template <int CTRL> __device__ __forceinline__ int dpp_i(int v) { return __builtin_amdgcn_update_dpp(0, v, CTRL, 0xf, 0xf, true); }
template <int CTRL> __device__ __forceinline__ float dpp_f(float v) { return __builtin_bit_cast(float, __builtin_amdgcn_update_dpp(0, __builtin_bit_cast(int, v), CTRL, 0xf, 0xf, true)); }
constexpr int DPP_XOR1 = 0xB1, DPP_XOR2 = 0x4E, DPP_HMIRROR = 0x141, DPP_ROR8 = 0x128;
constexpr float I8_MAGIC = 12582912.f;
__device__ __forceinline__ unsigned pack4_i8(float t0, float t1, float t2, float t3) {
    const unsigned p01 = __builtin_amdgcn_perm(__builtin_bit_cast(unsigned, t1), __builtin_bit_cast(unsigned, t0), 0x0c0c0400u);
    const unsigned p23 = __builtin_amdgcn_perm(__builtin_bit_cast(unsigned, t3), __builtin_bit_cast(unsigned, t2), 0x0c0c0400u);
    return __builtin_amdgcn_perm(p23, p01, 0x05040100u);
}
__device__ __forceinline__ void bg_convert_tables(const P& p) {
    int tid_ = threadIdx.x; asm volatile("" : "+v"(tid_));
    const int lane = tid_ & 63;
    unsigned* head = p.queues() + 16 * 64;
    for (;;) {
        unsigned v = 0u; if (lane == 0) v = __hip_atomic_fetch_add(head, 32u, __ATOMIC_RELAXED, __HIP_MEMORY_SCOPE_AGENT);
        const int rg = (int)__builtin_amdgcn_readfirstlane(v);
        if (rg >= 2 * 16384) break;
#pragma unroll 1
      for (int r0 = rg; r0 < rg + 32; r0 += 4) {
        const bool second = r0 >= 16384; const int rr0 = second ? r0 - 16384 : r0;
        const float* src = (second ? p.peer_v : p.peer_u) + (size_t)rr0 * DM + lane * 16;
        unsigned char* dst = (second ? p.pv8() : p.pu8()) + (size_t)(lane >> 3) * (16384 * 128) + (size_t)rr0 * 128 + (lane & 7) * 16;
        f32x4 v4[4][4];
#pragma unroll
        for (int q = 0; q < 4; ++q)
#pragma unroll
            for (int j = 0; j < 4; ++j) v4[q][j] = *(const f32x4*)(src + q * DM + 4 * j);
        float inv = 1.f;
#pragma unroll
        for (int q = 0; q < 4; ++q) {
            float am = 0.f;
#pragma unroll
            for (int j = 0; j < 4; ++j) am = fmaxf(am, fmaxf(fmaxf(fabsf(v4[q][j][0]), fabsf(v4[q][j][1])), fmaxf(fabsf(v4[q][j][2]), fabsf(v4[q][j][3]))));
            am = wave_max(am);
            const float top = 6.f;
            const float sc = am > 0.f ? top / am : 1.f;
            if (second) {
                u32x2 o2;
#pragma unroll
                for (int jj = 0; jj < 2; ++jj) {
                    unsigned w = 0u;
                    w = __builtin_amdgcn_cvt_scalef32_pk_fp4_f32(w, v4[q][jj * 2][0] * sc, v4[q][jj * 2][1] * sc, 1.0f, 0);
                    w = __builtin_amdgcn_cvt_scalef32_pk_fp4_f32(w, v4[q][jj * 2][2] * sc, v4[q][jj * 2][3] * sc, 1.0f, 1);
                    w = __builtin_amdgcn_cvt_scalef32_pk_fp4_f32(w, v4[q][jj * 2 + 1][0] * sc, v4[q][jj * 2 + 1][1] * sc, 1.0f, 2);
                    w = __builtin_amdgcn_cvt_scalef32_pk_fp4_f32(w, v4[q][jj * 2 + 1][2] * sc, v4[q][jj * 2 + 1][3] * sc, 1.0f, 3);
                    o2[jj] = w;
                }
                *(u32x2*)(p.pv8() + (size_t)(lane >> 4) * (16384 * 128) + (size_t)(rr0 + q) * 128 + (lane & 15) * 8) = o2;
                inv = lane == q ? (am > 0.f ? am / top : 1.f) : inv;
            } else {
                float a16 = 0.f;
#pragma unroll
                for (int j = 0; j < 4; ++j) a16 = fmaxf(a16, fmaxf(fmaxf(fabsf(v4[q][j][0]), fabsf(v4[q][j][1])), fmaxf(fabsf(v4[q][j][2]), fabsf(v4[q][j][3]))));
                a16 = fmaxf(a16, dpp_f<DPP_XOR1>(a16)); a16 = fmaxf(a16, dpp_f<DPP_XOR2>(a16)); a16 = fmaxf(a16, dpp_f<DPP_HMIRROR>(a16)); a16 = fmaxf(a16, dpp_f<DPP_ROR8>(a16));
                const float s4 = a16 > 0.f ? 7.f / a16 : 1.f;
                u32x2 o2;
#pragma unroll
                for (int jj = 0; jj < 2; ++jj) {
                    unsigned w = 0u;
#pragma unroll
                    for (int k = 0; k < 8; ++k) { const float t = v4[q][jj * 2 + (k >> 2)][k & 3] * s4 + I8_MAGIC; w |= (__builtin_bit_cast(unsigned, t) & 15u) << (4 * k); }
                    o2[jj] = w;
                }
                *(u32x2*)(p.pu8() + (size_t)(lane >> 4) * (16384 * 128) + (size_t)(rr0 + q) * 128 + (lane & 15) * 8) = o2;
                if ((lane & 15) == 0) p.pisc_u()[(size_t)(rr0 + q) * 4 + (lane >> 4)] = a16 > 0.f ? a16 * (1.f / 7.f) : 1.f;
            }
        }
        if (second && lane < 4) p.pisc()[r0 + lane] = inv;
      }
    }
}

__device__ __forceinline__ void normmod_row_bf16(const float* src, bf16_t* dst, const float* g, const float* shift, const float* scale, int lane) {
    const f32x4* s = (const f32x4*)src;
    f32x4 v[4]; float ss = 0.f;
#pragma unroll
    for (int j = 0; j < 4; ++j) { v[j] = s[lane + 64 * j]; ss += v[j][0] * v[j][0] + v[j][1] * v[j][1] + v[j][2] * v[j][2] + v[j][3] * v[j][3]; }
    ss = wave_sum(ss);
    const float rstd = rsqrtf(ss * (1.f / DM) + EPSN);
#pragma unroll
    for (int j = 0; j < 4; ++j) {
        const int i4 = lane + 64 * j;
        const f32x4 gg = ((const f32x4*)g)[i4], sh = ((const f32x4*)shift)[i4], sc = ((const f32x4*)scale)[i4];
        const f32x4 o = v[j] * rstd * gg * (sc + 1.f) + sh;
        *(unsigned*)((unsigned char*)dst + (size_t)i4 * 4) = pk4_fp8(o[0], o[1], o[2], o[3]);
    }
}
__device__ __forceinline__ void ph_norm1(const P& p, LAS unsigned char* lds) {
    int tid_ = threadIdx.x; asm volatile("" : "+v"(tid_));
    const int wave = tid_ >> 6, lane = tid_ & 63, G = gridDim.x;
    const int gw = blockIdx.x * NWAVES + __builtin_amdgcn_readfirstlane(wave), NGW = G * NWAVES;
    for (int r4 = gw; r4 < NTOK / 4; r4 += NGW) {
        const int r = r4 * 4;
        const f32x4* s = (const f32x4*)(p.x + (size_t)r * DM);
        f32x4 v[4][4];
#pragma unroll
        for (int k = 0; k < 4; ++k)
#pragma unroll
            for (int j = 0; j < 4; ++j) v[k][j] = s[k * (DM / 4) + lane + 64 * j];
        const float* modb = p.mod() + (size_t)(r >> 12) * (6 * DM);
#pragma unroll
        for (int k = 0; k < 4; ++k) {
            float ss = 0.f;
#pragma unroll
            for (int j = 0; j < 4; ++j) ss += v[k][j][0] * v[k][j][0] + v[k][j][1] * v[k][j][1] + v[k][j][2] * v[k][j][2] + v[k][j][3] * v[k][j][3];
            ss = wave_sum(ss);
            const float rstd = rsqrtf(ss * (1.f / DM) + EPSN);
            unsigned char* dst = (unsigned char*)p.hx() + (size_t)(r + k) * DM;
#pragma unroll
            for (int j = 0; j < 4; ++j) {
                const int i4 = lane + 64 * j;
                const f32x4 gg = ((const f32x4*)p.norm1_g)[i4], sh = ((const f32x4*)modb)[i4], sc = ((const f32x4*)(modb + DM))[i4];
                const f32x4 o = v[k][j] * rstd * gg * (sc + 1.f) + sh;
                *(unsigned*)(dst + (size_t)i4 * 4) = pk4_fp8(o[0], o[1], o[2], o[3]);
            }
        }
    }
    for (int rc = gw; rc < NCTX; rc += NGW) { const float* modc = p.mod() + 8 * (6 * DM); normmod_row_bf16(p.ctx + (size_t)rc * DM, (bf16_t*)((unsigned char*)p.hc() + (size_t)rc * DM), p.norm1_g, modc, modc + DM, lane); }
}

constexpr int RPB_LD = 128, RPB_PAD = 48;
__device__ __forceinline__ void ph_na(const P& p, LAS unsigned char* lds) {
    int tid_ = threadIdx.x; asm volatile("" : "+v"(tid_));
    const int tid = tid_, h = __builtin_amdgcn_readfirstlane(tid >> 6), lane = tid & 63, lt = lane & 15, lq = lane >> 4;
    constexpr float LOG2E = 1.4426950408889634f, CS = 0.125f * LOG2E;
    LAS float* rp = (LAS float*)lds;
    for (int e = tid; e < 8 * 15 * RPB_LD; e += NT) { const int c = (e & (RPB_LD - 1)) - RPB_PAD; rp[e] = (c >= 0 && c < 31) ? p.rpb[(e / RPB_LD) * 31 + c] * LOG2E : 0.f; }
    __syncthreads();
    const int pa = (lt >> 2) * 8 + (lt & 3);
    const unsigned lane_k = pa * 512 + lq * 8, lane_v = lt * 64 + lq * 8, lane_q = lt * 512 + lq * 8, lane_o = lt * 512 + lq * 4;
    for (int item = blockIdx.x; item < NB * GW; item += gridDim.x) {
        const int b = item >> 6, r = item & 63;
        int r0 = r - 4; r0 = r0 < 0 ? 0 : (r0 > 56 ? 56 : r0);
        const bf16_t* Kb = p.kb() + ((size_t)b * SEQL + (size_t)r0 * GW) * 512 + h * 64;
        const bf16_t* Kc = p.kc() + ((size_t)b * CTXL) * 512 + h * 64;
        const bf16_t* Vt = p.vT() + ((size_t)((b * 8 + h) * 64 + r0)) * 4096;
        const bf16_t* Vc = p.vcT() + ((size_t)((b * 8 + h) * 4)) * 4096;
        const bf16_t* Qb = p.qb() + ((size_t)b * SEQL + r * GW) * 512 + h * 64;
        unsigned char* Ob = (unsigned char*)p.na() + ((size_t)b * SEQL + r * GW) * 512 + h * 64;
        const LAS float* rph = rp + (h * 15 + (r0 - r + 7)) * RPB_LD;
        bf16x8 qf[4][2];
#pragma unroll
        for (int qt = 0; qt < 4; ++qt) { qf[qt][0] = *(const bf16x8*)(Qb + qt * 16 * 512 + lane_q); qf[qt][1] = *(const bf16x8*)(Qb + qt * 16 * 512 + 32 + lane_q); }
        f32x4 o[4][4]; float m[4], l[4];
#pragma unroll
        for (int qt = 0; qt < 4; ++qt) { m[qt] = -1e30f; l[qt] = 0.f;
#pragma unroll
            for (int d = 0; d < 4; ++d) o[qt][d] = (f32x4){0.f, 0.f, 0.f, 0.f}; }
        bf16x8 kf[2][2][2];
#pragma unroll
        for (int st = 0; st < 2; ++st)
#pragma unroll
            for (int ab = 0; ab < 2; ++ab) { kf[st][ab][0] = *(const bf16x8*)(Kb + (st * 32 + ab * 4) * 512 + lane_k); kf[st][ab][1] = *(const bf16x8*)(Kb + (st * 32 + ab * 4) * 512 + 32 + lane_k); }
#pragma unroll 1
        for (int i = 0; i < 8; ++i) {
            bf16x8 vf[2][4];
#pragma unroll
            for (int st = 0; st < 2; ++st)
#pragma unroll
                for (int d = 0; d < 4; ++d) vf[st][d] = *(const bf16x8*)(Vt + i * 4096 + d * 1024 + st * 32 + lane_v);
            const LAS float* rr_ = rph + i * RPB_LD;
#pragma unroll
            for (int half = 0; half < 2; ++half) {
                f32x4 s[2][2][2];
#pragma unroll
                for (int q2 = 0; q2 < 2; ++q2) {
                    const int qt = half * 2 + q2;
#pragma unroll
                    for (int st = 0; st < 2; ++st) {
                        if ((st == 0 && qt == 3) || (st == 1 && qt == 0)) continue;
#pragma unroll
                        for (int ab = 0; ab < 2; ++ab) {
                            f32x4 c = {0.f, 0.f, 0.f, 0.f};
                            c = __builtin_amdgcn_mfma_f32_16x16x32_bf16(kf[st][ab][0], qf[qt][0], c, 0, 0, 0);
                            c = __builtin_amdgcn_mfma_f32_16x16x32_bf16(kf[st][ab][1], qf[qt][1], c, 0, 0, 0);
                            s[q2][st][ab] = c;
                        }
                    }
                }
                if (half == 1) {
                    if (i < 7) {
#pragma unroll
                        for (int st = 0; st < 2; ++st)
#pragma unroll
                            for (int ab = 0; ab < 2; ++ab) { const bf16_t* kp = Kb + ((i + 1) * GW + st * 32 + ab * 4) * 512; kf[st][ab][0] = *(const bf16x8*)(kp + lane_k); kf[st][ab][1] = *(const bf16x8*)(kp + 32 + lane_k); }
                    } else {
#pragma unroll
                        for (int ab = 0; ab < 2; ++ab) { kf[0][ab][0] = *(const bf16x8*)(Kc + ab * 4 * 512 + lane_k); kf[0][ab][1] = *(const bf16x8*)(Kc + ab * 4 * 512 + 32 + lane_k); }
                    }
                }
#pragma unroll
                for (int q2 = 0; q2 < 2; ++q2) {
                    const int qt = half * 2 + q2;
                    const int qc = qt * 16 + lt; int c0 = qc - 8; c0 = c0 < 0 ? 0 : (c0 > 48 ? 48 : c0);
                    int wo = lq * 8 - c0; asm volatile("" : "+v"(wo));
                    float mx = -1e30f;
#pragma unroll
                    for (int st = 0; st < 2; ++st) {
                        if ((st == 0 && qt == 3) || (st == 1 && qt == 0)) continue;
                        const int kc0 = st * 32 + lq * 8, bbase = kc0 - qc + 15 + RPB_PAD;
#pragma unroll
                        for (int j = 0; j < 8; ++j) {
                            float t = s[q2][st][j >> 2][j & 3] * CS + rr_[bbase + j];
                            t = ((unsigned)(wo + st * 32 + j) < 16u) ? t : -1e30f;
                            s[q2][st][j >> 2][j & 3] = t; mx = fmaxf(mx, t);
                        }
                    }
                    mx = fmaxf(mx, __shfl_xor(mx, 16)); mx = fmaxf(mx, __shfl_xor(mx, 32));
                    const float mn = fmaxf(m[qt], mx), corr = __builtin_amdgcn_exp2f(m[qt] - mn);
                    m[qt] = mn; float ls = l[qt] * corr;
#pragma unroll
                    for (int d = 0; d < 4; ++d) o[qt][d] = o[qt][d] * corr;
#pragma unroll
                    for (int st = 0; st < 2; ++st) {
                        if ((st == 0 && qt == 3) || (st == 1 && qt == 0)) continue;
                        float pe[8];
#pragma unroll
                        for (int j = 0; j < 8; ++j) pe[j] = __builtin_amdgcn_exp2f(s[q2][st][j >> 2][j & 3] - mn);
                        ls += ((pe[0] + pe[1]) + (pe[2] + pe[3])) + ((pe[4] + pe[5]) + (pe[6] + pe[7]));
                        u32x4 pw; pw[0] = pg8::cvt_pk_bf16(pe[0], pe[1]); pw[1] = pg8::cvt_pk_bf16(pe[2], pe[3]); pw[2] = pg8::cvt_pk_bf16(pe[4], pe[5]); pw[3] = pg8::cvt_pk_bf16(pe[6], pe[7]);
                        const bf16x8 pf = __builtin_bit_cast(bf16x8, pw);
#pragma unroll
                        for (int d = 0; d < 4; ++d) o[qt][d] = __builtin_amdgcn_mfma_f32_16x16x32_bf16(vf[st][d], pf, o[qt][d], 0, 0, 0);
                    }
                    l[qt] = ls;
                }
            }
        }
#pragma unroll 1
        for (int cst = 0; cst < 8; ++cst) {
            bf16x8 vf[4];
#pragma unroll
            for (int d = 0; d < 4; ++d) vf[d] = *(const bf16x8*)(Vc + (cst >> 1) * 4096 + d * 1024 + (cst & 1) * 32 + lane_v);
            f32x4 s[4][2];
#pragma unroll
            for (int qt = 0; qt < 4; ++qt)
#pragma unroll
                for (int ab = 0; ab < 2; ++ab) {
                    f32x4 c = {0.f, 0.f, 0.f, 0.f};
                    c = __builtin_amdgcn_mfma_f32_16x16x32_bf16(kf[0][ab][0], qf[qt][0], c, 0, 0, 0);
                    c = __builtin_amdgcn_mfma_f32_16x16x32_bf16(kf[0][ab][1], qf[qt][1], c, 0, 0, 0);
                    s[qt][ab] = c;
                }
            if (cst < 7) {
#pragma unroll
                for (int ab = 0; ab < 2; ++ab) { const bf16_t* kp = Kc + ((cst + 1) * 32 + ab * 4) * 512; kf[0][ab][0] = *(const bf16x8*)(kp + lane_k); kf[0][ab][1] = *(const bf16x8*)(kp + 32 + lane_k); }
            }
#pragma unroll
            for (int qt = 0; qt < 4; ++qt) {
                float mx = -1e30f;
#pragma unroll
                for (int j = 0; j < 8; ++j) { const float t = s[qt][j >> 2][j & 3] * CS; s[qt][j >> 2][j & 3] = t; mx = fmaxf(mx, t); }
                mx = fmaxf(mx, __shfl_xor(mx, 16)); mx = fmaxf(mx, __shfl_xor(mx, 32));
                const float mn = fmaxf(m[qt], mx), corr = __builtin_amdgcn_exp2f(m[qt] - mn);
                m[qt] = mn;
#pragma unroll
                for (int d = 0; d < 4; ++d) o[qt][d] = o[qt][d] * corr;
                float pe[8];
#pragma unroll
                for (int j = 0; j < 8; ++j) pe[j] = __builtin_amdgcn_exp2f(s[qt][j >> 2][j & 3] - mn);
                l[qt] = l[qt] * corr + (((pe[0] + pe[1]) + (pe[2] + pe[3])) + ((pe[4] + pe[5]) + (pe[6] + pe[7])));
                u32x4 pw; pw[0] = pg8::cvt_pk_bf16(pe[0], pe[1]); pw[1] = pg8::cvt_pk_bf16(pe[2], pe[3]); pw[2] = pg8::cvt_pk_bf16(pe[4], pe[5]); pw[3] = pg8::cvt_pk_bf16(pe[6], pe[7]);
                const bf16x8 pf = __builtin_bit_cast(bf16x8, pw);
#pragma unroll
                for (int d = 0; d < 4; ++d) o[qt][d] = __builtin_amdgcn_mfma_f32_16x16x32_bf16(vf[d], pf, o[qt][d], 0, 0, 0);
            }
        }
#pragma unroll
        for (int qt = 0; qt < 4; ++qt) {
            float lv = l[qt]; lv += __shfl_xor(lv, 16); lv += __shfl_xor(lv, 32);
            const float inv = frcp(lv);
            const float inv8 = inv * ACT8;
            unsigned char* op = Ob + qt * 16 * 512 + lane_o;
#pragma unroll
            for (int d = 0; d < 4; ++d) *(unsigned*)(op + d * 16) = pk4_fp8(o[qt][d][0] * inv8, o[qt][d][1] * inv8, o[qt][d][2] * inv8, o[qt][d][3] * inv8);
        }
    }
}

typedef __bf16 bf16x2_t __attribute__((ext_vector_type(2)));
__device__ __forceinline__ float dot2bf(unsigned a, unsigned b, float c) { return __builtin_amdgcn_fdot2_f32_bf16(__builtin_bit_cast(bf16x2_t, a), __builtin_bit_cast(bf16x2_t, b), c, false); }
__device__ __forceinline__ unsigned ordkey(float f) { unsigned u = __builtin_bit_cast(unsigned, f); return u ^ ((unsigned)((int)u >> 31) | 0x80000000u); }
__device__ __forceinline__ float unordkey(unsigned k) { return __builtin_bit_cast(float, k ^ ((k & 0x80000000u) ? 0x80000000u : 0xFFFFFFFFu)); }
__device__ __forceinline__ float kmax(float a, float b) { float r; asm("v_max_f32 %0, %1, %2" : "=v"(r) : "v"(a), "v"(b)); return r; }
__device__ __forceinline__ float kmin(float a, float b) { float r; asm("v_min_f32 %0, %1, %2" : "=v"(r) : "v"(a), "v"(b)); return r; }
template <bool DESC> __device__ __forceinline__ void cex(float& a, float& b) { const float mx = kmax(a, b), mn = kmin(a, b); if (DESC) { a = mx; b = mn; } else { a = mn; b = mx; } }
__device__ __forceinline__ void sort16_desc(float (&a)[16]) {
#pragma unroll
    for (int k = 2; k <= 16; k <<= 1)
#pragma unroll
        for (int j = k >> 1; j > 0; j >>= 1)
#pragma unroll
            for (int i = 0; i < 16; ++i) { const int l = i ^ j; if (l > i) { if ((i & k) == 0) cex<true>(a[i], a[l]); else cex<false>(a[i], a[l]); } }
}
__device__ __forceinline__ void merge16_desc(float (&a)[16]) {
#pragma unroll
    for (int j = 8; j > 0; j >>= 1)
#pragma unroll
        for (int i = 0; i < 16; ++i) { const int l = i ^ j; if (l > i) cex<true>(a[i], a[l]); }
}
__device__ __forceinline__ void top16_merge(float (&a)[16], const float (&b)[16]) {
#pragma unroll
    for (int i = 0; i < 16; ++i) a[i] = kmax(a[i], b[15 - i]);
    merge16_desc(a);
}
__device__ __forceinline__ unsigned kbits(float k) { return __builtin_bit_cast(unsigned, k); }
__device__ __forceinline__ float kscore(float k) { return __builtin_bit_cast(float, __builtin_bit_cast(unsigned, k) & ~127u); }
struct PairTab { int i[52], j[52], n; };
constexpr PairTab make_pairs() { PairTab t{}; int n = 0; for (int i = 0; i < 16; ++i) for (int j = 0; j < 16; ++j) if ((i + 1) * (j + 1) <= 16) { t.i[n] = i; t.j[n] = j; ++n; } t.n = n; for (int k = n; k < 52; ++k) { t.i[k] = 0; t.j[k] = 0; } return t; }
constexpr PairTab PAIRS = make_pairs();
static_assert(PAIRS.n == 50, "50 candidate pairs");

constexpr int SK_LD = 136;
__device__ __forceinline__ void ph_peer_topk(const P& p, LAS unsigned char* lds) {
    int tid_ = threadIdx.x; asm volatile("" : "+v"(tid_));
    const int tid = tid_, wave = tid >> 6, lane = tid & 63;
    LAS bf16_t* sk = (LAS bf16_t*)lds;
    for (int e = tid; e < 2 * 128 * 16; e += NT) {
        const int row = e >> 4, c8 = (e & 15) * 8;
        const f32x4 a = *(const f32x4*)(p.subkeys + (size_t)row * 128 + c8), b = *(const f32x4*)(p.subkeys + (size_t)row * 128 + c8 + 4);
        u32x4 o; o.x = pk2(a[0], a[1]); o.y = pk2(a[2], a[3]); o.z = pk2(b[0], b[1]); o.w = pk2(b[2], b[3]);
        *(LAS u32x4*)(sk + row * SK_LD + c8) = o;
    }
    __syncthreads();
    const int lt = lane & 15, lq = lane >> 4;
    for (int tile = blockIdx.x * NWAVES + wave; tile < NTOK / 16; tile += gridDim.x * NWAVES) {
        const int tok = tile * 16 + lt;
        const bf16_t* qrow = p.qp() + (size_t)tok * 2048;
        for (int h = 0; h < 8; ++h) {
            float s0[16], s1[16];
#pragma unroll
            for (int n = 0; n < 2; ++n) {
                bf16x8 bq[4];
#pragma unroll
                for (int ks = 0; ks < 4; ++ks) bq[ks] = *(const bf16x8*)(qrow + h * 256 + n * 128 + ks * 32 + lq * 8);
                float a[16], b[16];
#pragma unroll
                for (int kb = 0; kb < 8; ++kb) {
                    f32x4 c = {0.f, 0.f, 0.f, 0.f};
#pragma unroll
                    for (int ks = 0; ks < 4; ++ks) {
                        const bf16x8 ak = *(const LAS bf16x8*)(sk + (n * 128 + kb * 16 + lt) * SK_LD + ks * 32 + lq * 8);
                        c = __builtin_amdgcn_mfma_f32_16x16x32_bf16(ak, bq[ks], c, 0, 0, 0);
                    }
#pragma unroll
                    for (int r = 0; r < 4; ++r) {
                        const float cr = c[r];
                        const float key = __builtin_bit_cast(float, (__builtin_bit_cast(unsigned, cr) & ~127u) | (unsigned)(kb * 16 + lq * 4 + r));
                        if (kb < 4) a[kb * 4 + r] = key; else b[(kb - 4) * 4 + r] = key;
                    }
                    asm volatile("" ::: "memory");
                }
                sort16_desc(a); sort16_desc(b);
                top16_merge(a, b);
#pragma unroll
                for (int i = 0; i < 16; ++i) b[i] = __shfl_xor(a[i], 16);
                top16_merge(a, b);
#pragma unroll
                for (int i = 0; i < 16; ++i) b[i] = __shfl_xor(a[i], 32);
                top16_merge(a, b);
                if (n == 0) {
#pragma unroll
                    for (int i = 0; i < 16; ++i) s0[i] = a[i];
                } else {
#pragma unroll
                    for (int i = 0; i < 16; ++i) s1[i] = a[i];
                }
            }
            float ck[16], cs[13]; unsigned ce_[13];
#pragma unroll
            for (int s = 0; s < 13; ++s) {
                const float k0 = lq == 0 ? s0[PAIRS.i[s * 4]] : (lq == 1 ? s0[PAIRS.i[s * 4 + 1]] : (lq == 2 ? s0[PAIRS.i[s * 4 + 2]] : s0[PAIRS.i[s * 4 + 3]]));
                const float k1 = lq == 0 ? s1[PAIRS.j[s * 4]] : (lq == 1 ? s1[PAIRS.j[s * 4 + 1]] : (lq == 2 ? s1[PAIRS.j[s * 4 + 2]] : s1[PAIRS.j[s * 4 + 3]]));
                const float sum = kscore(k0) + kscore(k1);
                const bool valid = (s * 4 + lq) < PAIRS.n;
                cs[s] = sum; ce_[s] = (kbits(k0) & 127u) * 128u + (kbits(k1) & 127u);
                ck[s] = valid ? __builtin_bit_cast(float, (__builtin_bit_cast(unsigned, sum) & ~63u) | (unsigned)(s * 4 + lq)) : -__builtin_inff();
            }
            ck[13] = -__builtin_inff(); ck[14] = -__builtin_inff(); ck[15] = -__builtin_inff();
            float srt[16], ob[16];
#pragma unroll
            for (int i = 0; i < 16; ++i) srt[i] = ck[i];
            sort16_desc(srt);
#pragma unroll
            for (int i = 0; i < 16; ++i) ob[i] = __shfl_xor(srt[i], 16);
            top16_merge(srt, ob);
#pragma unroll
            for (int i = 0; i < 16; ++i) ob[i] = __shfl_xor(srt[i], 32);
            float thr = __builtin_inff();
#pragma unroll
            for (int i = 0; i < 16; ++i) thr = kmin(thr, kmax(srt[i], ob[15 - i]));
            const float mtop = kscore(s0[0]) + kscore(s1[0]);
            float zp = 0.f; int cnt = 0;
#pragma unroll
            for (int s = 0; s < 13; ++s) { const bool sel = ck[s] >= thr; const float e = sel ? __expf(cs[s] - mtop) : 0.f; cs[s] = e; zp += e; cnt += sel ? 1 : 0; }
            float z = zp; z += __shfl_xor(z, 16); z += __shfl_xor(z, 32);
            const float rz = frcp(z);
            const int c0 = __shfl(cnt, lt), c1 = __shfl(cnt, lt + 16), c2 = __shfl(cnt, lt + 32);
            int pos = lq == 0 ? 0 : (lq == 1 ? c0 : (lq == 2 ? c0 + c1 : c0 + c1 + c2));
            unsigned short* dste = (unsigned short*)p.topk() + ((size_t)tok * 8 + h) * 16; float* dstg = p.gates() + ((size_t)tok * 8 + h) * 16;
#pragma unroll
            for (int s = 0; s < 13; ++s) {
                const bool sel = ck[s] >= thr;
                if (sel) { dste[pos] = (unsigned short)ce_[s]; dstg[pos] = cs[s] * rz; ++pos; }
            }
        }
    }
}

__device__ __forceinline__ unsigned xcc_id() { return (unsigned)__builtin_amdgcn_s_getreg((3 << 11) | 20) & 7u; }
__device__ __forceinline__ int q_grab(unsigned* head, int lane) { unsigned v = 0u; if (lane == 0) v = __hip_atomic_fetch_add(head, 16u, __ATOMIC_RELAXED, __HIP_MEMORY_SCOPE_AGENT); return (int)__builtin_amdgcn_readfirstlane(v); }

__device__ __forceinline__ void g_ids(const unsigned short* tkrow, unsigned lo_g16, u32x4 (&ids)[2]) {
#pragma unroll
    for (int q = 0; q < 2; ++q) ids[q] = *(const u32x4*)(tkrow + lo_g16 + q * 8);
}
__device__ __forceinline__ void g_wts(const float* wrow, unsigned lo_g16, u32x4 (&wts)[4]) {
#pragma unroll
    for (int q = 0; q < 4; ++q) wts[q] = *(const u32x4*)(wrow + lo_g16 + q * 4);
}
__device__ __forceinline__ void g_rows8(const unsigned char* tb, unsigned lo_c16, const u32x4& idh, u32x4 (&rows)[8]) {
#pragma unroll
    for (int i = 0; i < 8; ++i) {
        const unsigned w = idh[i >> 1];
        unsigned off; const unsigned k128 = 128u;
        if (i & 1) asm("v_mad_u32_u16 %0, %1, %2, %3 op_sel:[1,0,0,0]" : "=v"(off) : "v"(w), "s"(k128), "v"(lo_c16));
        else asm("v_mad_u32_u16 %0, %1, %2, %3" : "=v"(off) : "v"(w), "s"(k128), "v"(lo_c16));
        rows[i] = *(const u32x4*)(tb + off);
    }
}
typedef _Float16 f16x2 __attribute__((ext_vector_type(2)));
__device__ __forceinline__ void g_dots8_i4(const u32x4 (&uu)[8], const unsigned (&hqh)[4], const unsigned (&hql)[4], int* pd) {
#pragma unroll
    for (int i = 0; i < 8; ++i) {
        int dh = 0, dl = 0;
#pragma unroll
        for (int j = 0; j < 4; ++j) { dh = __builtin_amdgcn_sdot8((int)uu[i][j], (int)hqh[j], dh, false); dl = __builtin_amdgcn_sdot8((int)uu[i][j], (int)hql[j], dl, false); }
        pd[i] = dh * 16 + dl;
    }
}
__device__ __forceinline__ void halve16_c8(const int (&v)[16], int b4, int b2, int b1, int& o0, int& o1) {
    int r8[8], r4[4];
#pragma unroll
    for (int i = 0; i < 8; ++i) { const int keep = b4 ? v[i + 8] : v[i], send = b4 ? v[i] : v[i + 8]; r8[i] = keep + dpp_i<DPP_HMIRROR>(send); }
#pragma unroll
    for (int i = 0; i < 4; ++i) { const int keep = b2 ? r8[i + 4] : r8[i], send = b2 ? r8[i] : r8[i + 4]; r4[i] = keep + dpp_i<DPP_XOR2>(send); }
    { const int keep = b1 ? r4[2] : r4[0], send = b1 ? r4[0] : r4[2]; o0 = keep + dpp_i<DPP_XOR1>(send); }
    { const int keep = b1 ? r4[3] : r4[1], send = b1 ? r4[1] : r4[3]; o1 = keep + dpp_i<DPP_XOR1>(send); }
}
template <bool FIRST>
__device__ __forceinline__ void g_acc8q(const u32x4 (&vv)[8], const u32x4& w0, const u32x4& w1, f16x2 (&acc)[16]) {
#pragma unroll
    for (int i = 0; i < 8; ++i) {
        const unsigned wu = i < 4 ? w0[i & 3] : w1[i & 3];
        const f16x2 w = __builtin_bit_cast(f16x2, wu);
#pragma unroll
        for (int j = 0; j < 4; ++j) {
            const unsigned wv = vv[i][j];
            const f16x2 v0 = __builtin_bit_cast(f16x2, __builtin_amdgcn_cvt_scalef32_pk_f16_fp4(wv, 0.00390625f, 0)), v1 = __builtin_bit_cast(f16x2, __builtin_amdgcn_cvt_scalef32_pk_f16_fp4(wv, 0.00390625f, 1));
            const f16x2 v2 = __builtin_bit_cast(f16x2, __builtin_amdgcn_cvt_scalef32_pk_f16_fp4(wv, 0.00390625f, 2)), v3 = __builtin_bit_cast(f16x2, __builtin_amdgcn_cvt_scalef32_pk_f16_fp4(wv, 0.00390625f, 3));
            if (FIRST && i == 0) { acc[j * 4 + 0] = v0 * w; acc[j * 4 + 1] = v1 * w; acc[j * 4 + 2] = v2 * w; acc[j * 4 + 3] = v3 * w; }
            else { acc[j * 4 + 0] = __builtin_elementwise_fma(v0, w, acc[j * 4 + 0]); acc[j * 4 + 1] = __builtin_elementwise_fma(v1, w, acc[j * 4 + 1]);
                   acc[j * 4 + 2] = __builtin_elementwise_fma(v2, w, acc[j * 4 + 2]); acc[j * 4 + 3] = __builtin_elementwise_fma(v3, w, acc[j * 4 + 3]); }
        }
    }
}
__device__ __forceinline__ void halve16h(const f16x2 (&v)[16], int b1, f16x2& o0, f16x2& o1) {
    f16x2 r8[8], r4[4];
#pragma unroll
    for (int i = 0; i < 8; ++i) { const u32x2 sw = __builtin_amdgcn_permlane32_swap(__builtin_bit_cast(unsigned, v[i]), __builtin_bit_cast(unsigned, v[i + 8]), false, false);
        const unsigned s0 = sw[0], s1 = sw[1];
        r8[i] = __builtin_bit_cast(f16x2, s0) + __builtin_bit_cast(f16x2, s1); }
#pragma unroll
    for (int i = 0; i < 4; ++i) { const u32x2 sw = __builtin_amdgcn_permlane16_swap(__builtin_bit_cast(unsigned, r8[i]), __builtin_bit_cast(unsigned, r8[i + 4]), false, false);
        const unsigned s0 = sw[0], s1 = sw[1];
        r4[i] = __builtin_bit_cast(f16x2, s0) + __builtin_bit_cast(f16x2, s1); }
#pragma unroll
    for (int i = 0; i < 2; ++i) {
        const unsigned keep = __builtin_bit_cast(unsigned, b1 ? r4[i + 2] : r4[i]), send = __builtin_bit_cast(unsigned, b1 ? r4[i] : r4[i + 2]);
        const f16x2 r = __builtin_bit_cast(f16x2, keep) + __builtin_bit_cast(f16x2, (unsigned)__builtin_amdgcn_update_dpp(0, (int)send, 0x128, 0xf, 0xf, true));
        if (i == 0) o0 = r; else o1 = r;
    }
}

template <int WHICH>
__device__ __forceinline__ void ph_gather_sliced(const P& p, LAS unsigned char* lds) {
    int tid_ = threadIdx.x; asm volatile("" : "+v"(tid_));
    const int lane = tid_ & 63, c = lane & 7, g = lane >> 3;
    LAS unsigned char* wlds = lds + __builtin_amdgcn_readfirstlane(tid_ >> 6) * 8192;
    const unsigned xs = xcc_id();
    constexpr int NSL = 4, SLW = DM / NSL;
    for (unsigned tr = 0; tr < NSL; ++tr) {
        const int sl = (int)((xs + tr) & (unsigned)(NSL - 1));
        unsigned* head = p.queues() + (WHICH * 8 + sl) * 64;
        const unsigned char* tb = (WHICH == 0 ? p.pu8() : p.pv8()) + (size_t)sl * (16384 * 128);
        for (;;) {
            const int t0 = q_grab(head, lane);
            if (t0 >= NTOK) break;
            unsigned oc = c * 16, og = g * 16; asm volatile("" : "+v"(oc), "+v"(og));
            const unsigned short* idb = (const unsigned short*)p.topk() + (size_t)t0 * 128;
            const float* wb = p.wl() + (size_t)t0 * 128;
            const float* modb = p.mod() + (size_t)(t0 >> 12) * (6 * DM) + sl * SLW;
            u32x4 idc[2], idn[2], RA[8], RB[8], wc[4];
            g_ids(idb, og, idc); if (WHICH == 1) g_wts(wb, og, wc);
            g_rows8(tb, oc, idc[0], RA);
            if (WHICH == 0) {
                {
                    unsigned l4 = lane * 4; asm volatile("" : "+v"(l4));
                    const bf16_t* xg = p.x1b() + (size_t)t0 * DM + sl * SLW;
                    f32x4 A, Bs;
                    { const f32x4 gg = *(const f32x4*)(p.norm2_g + sl * SLW + l4), sh = *(const f32x4*)(modb + 3 * DM + l4), sc = *(const f32x4*)(modb + 4 * DM + l4);
#pragma unroll
                      for (int i = 0; i < 4; ++i) { A[i] = gg[i] * (1.f + sc[i]); Bs[i] = sh[i]; } }
                    const float rsl = rstd_from_fix(p.rowss()[t0 + (lane & 15)]);
                    {
                        u32x2 xw[16];
#pragma unroll
                        for (int k = 0; k < 16; ++k) xw[k] = *(const u32x2*)(xg + (size_t)k * DM + l4);
#pragma unroll
                        for (int k = 0; k < 16; ++k) {
                            const int tk = k;
                            const float rstd = __builtin_bit_cast(float, __builtin_amdgcn_readlane(__builtin_bit_cast(unsigned, rsl), tk));
                            float h[4], am = 0.f;
                            const unsigned x01 = xw[k][0], x23 = xw[k][1];
                            const float xf[4] = {bflo(x01), bfhi(x01), bflo(x23), bfhi(x23)};
#pragma unroll
                            for (int i = 0; i < 4; ++i) { h[i] = xf[i] * rstd * A[i] + Bs[i]; am = fmaxf(am, fabsf(h[i])); }
                            am = fmaxf(am, dpp_f<DPP_XOR1>(am)); am = fmaxf(am, dpp_f<DPP_XOR2>(am)); am = fmaxf(am, dpp_f<DPP_HMIRROR>(am)); am = fmaxf(am, dpp_f<DPP_ROR8>(am));
                            { const u32x2 sw = __builtin_amdgcn_permlane16_swap(__builtin_bit_cast(unsigned, am), __builtin_bit_cast(unsigned, am), false, false); const unsigned s0 = sw[0], s1 = sw[1];
                              am = fmaxf(__builtin_bit_cast(float, s0), __builtin_bit_cast(float, s1)); }
                            { const u32x2 sw = __builtin_amdgcn_permlane32_swap(__builtin_bit_cast(unsigned, am), __builtin_bit_cast(unsigned, am), false, false); const unsigned s0 = sw[0], s1 = sw[1];
                              am = fmaxf(__builtin_bit_cast(float, s0), __builtin_bit_cast(float, s1)); }
                            am = fmaxf(am, 1e-30f);
                            const float hs = 119.f * frcp(am);
                            unsigned whi = 0u, wlo = 0u;
#pragma unroll
                            for (int i = 0; i < 4; ++i) {
                                const unsigned qb = __builtin_bit_cast(unsigned, h[i] * hs + I8_MAGIC);
                                wlo |= (qb & 15u) << (4 * i);
                                whi |= (((qb + 8u) >> 4) & 15u) << (4 * i);
                            }
                            *(LAS unsigned short*)(wlds + tk * 256 + lane * 2) = (unsigned short)whi;
                            *(LAS unsigned short*)(wlds + tk * 256 + 128 + lane * 2) = (unsigned short)wlo;
                            *(LAS float*)(wlds + 4096 + tk * 4) = am * (1.f / 119.f);
                        }
                    }
                    asm volatile("s_waitcnt lgkmcnt(0)" ::: "memory");
                }
                const unsigned lo_st = og + 2 * (c & 1) + 4 * ((c >> 1) & 1) + 8 * ((c >> 2) & 1);
                float* apb = p.apart() + ((size_t)sl * NTOK + t0) * 128;
#define G1_TOKEN(tt, IDC, IDN, MORE) do { \
                    g_rows8(tb, oc, IDC[1], RB); \
                    if (MORE) g_ids(idb + ((tt) + 1) * 128, og, IDN); \
                    const u32x4 hh4 = *(const LAS u32x4*)(wlds + (tt) * 256 + oc), hl4 = *(const LAS u32x4*)(wlds + (tt) * 256 + 128 + oc); \
                    const float hinv = *(const LAS float*)(wlds + 4096 + (tt) * 4); \
                    const unsigned hqh[4] = {hh4[0], hh4[1], hh4[2], hh4[3]}, hql[4] = {hl4[0], hl4[1], hl4[2], hl4[3]}; \
                    int pd[16]; \
                    g_dots8_i4(RA, hqh, hql, pd); \
                    if (MORE) g_rows8(tb, oc, IDN[0], RA); \
                    g_dots8_i4(RB, hqh, hql, pd + 8); \
                    int o0, o1; halve16_c8(pd, c & 4, c & 2, c & 1, o0, o1); \
                    f32x2 st; st[0] = (float)o0 * hinv; st[1] = (float)o1 * hinv; \
                    *(f32x2*)(apb + (tt) * 128 + lo_st) = st; } while (0)
#pragma unroll 1
                for (int tt = 0; tt < 16; tt += 2) {
                    G1_TOKEN(tt, idc, idn, true);
                    const bool more = tt + 2 < 16;
                    G1_TOKEN(tt + 1, idn, idc, more);
                }
#undef G1_TOKEN
            } else {
                const unsigned lo_col = 2 * oc + 4 * (g & 1) + 8 * ((g >> 1) & 1) + 16 * ((g >> 2) & 1);
                bf16_t* xb = p.x1b() + (size_t)t0 * DM + sl * SLW;
                const f32x4 g2 = *(const f32x4*)(modb + 5 * DM + lo_col);
                u32x2 x1n = *(const u32x2*)(xb + lo_col);
                u32x4 wd[4];
#define G2_TOKEN(tt, IDC, IDN, WC, WN, MORE) do { \
                    g_rows8(tb, oc, IDC[1], RB); \
                    const unsigned x01 = x1n[0], x23 = x1n[1]; \
                    if (MORE) { g_ids(idb + ((tt) + 1) * 128, og, IDN); g_wts(wb + ((tt) + 1) * 128, og, WN); x1n = *(const u32x2*)(xb + (size_t)((tt) + 1) * DM + lo_col); } \
                    f16x2 acc[16]; \
                    g_acc8q<true>(RA, WC[0], WC[1], acc); \
                    if (MORE) g_rows8(tb, oc, IDN[0], RA); \
                    g_acc8q<false>(RB, WC[2], WC[3], acc); \
                    f16x2 oa, ob; halve16h(acc, g & 1, oa, ob); \
                    u32x2 x2; x2[0] = pg8::cvt_pk_bf16(bflo(x01) + g2[0] * (float)oa[0], bfhi(x01) + g2[1] * (float)oa[1]); x2[1] = pg8::cvt_pk_bf16(bflo(x23) + g2[2] * (float)ob[0], bfhi(x23) + g2[3] * (float)ob[1]); \
                    *(u32x2*)(xb + (size_t)(tt) * DM + lo_col) = x2; } while (0)
#pragma unroll 1
                for (int tt = 0; tt < 16; tt += 2) {
                    G2_TOKEN(tt, idc, idn, wc, wd, true);
                    const bool more = tt + 2 < 16;
                    G2_TOKEN(tt + 1, idn, idc, wd, wc, more);
                }
#undef G2_TOKEN
            }
        }
    }
}
__device__ __forceinline__ void ph_gather_weights(const P& p) {
    int tid_ = threadIdx.x; asm volatile("" : "+v"(tid_));
    const size_t gsz = (size_t)gridDim.x * NT;
    const float* isc = p.pisc();
    for (size_t i = (size_t)blockIdx.x * NT + tid_; i < (size_t)NTOK * 128; i += gsz) {
        const unsigned e = ((const unsigned short*)p.topk())[i]; const float gate = p.gates()[i];
        const f32x4 su = *(const f32x4*)(p.pisc_u() + (size_t)e * 4);
        float a = 0.f;
#pragma unroll
        for (int sl = 0; sl < 4; ++sl) a += p.apart()[(size_t)sl * NTOK * 128 + i] * su[sl];
        const float w = gate * isc[16384 + e] * gelu_tanh(a) * 256.f;
        const unsigned short hw = __builtin_bit_cast(unsigned short, (_Float16)w);
        ((unsigned*)p.wl())[i] = (unsigned)hw | ((unsigned)hw << 16);
    }
}
__device__ __forceinline__ void ph_final_norm(const P& p) {
    int tid_ = threadIdx.x; asm volatile("" : "+v"(tid_));
    const int wave = __builtin_amdgcn_readfirstlane(tid_ >> 6), lane = tid_ & 63;
    for (int t4 = blockIdx.x * NWAVES + wave; t4 < NTOK / 4; t4 += gridDim.x * NWAVES) {
        const u32x4* src = (const u32x4*)(p.x1b() + (size_t)t4 * 4 * DM);
        f32x4* row = (f32x4*)(p.out + (size_t)t4 * 4 * DM);
        u32x4 vw[4][2];
#pragma unroll
        for (int k = 0; k < 4; ++k)
#pragma unroll
            for (int j = 0; j < 2; ++j) vw[k][j] = src[k * (DM / 8) + lane + 64 * j];
#pragma unroll
        for (int k = 0; k < 4; ++k) {
            f32x4 v[4]; float ss = 0.f;
#pragma unroll
            for (int j = 0; j < 2; ++j) {
                const unsigned w0 = vw[k][j][0], w1 = vw[k][j][1], w2 = vw[k][j][2], w3 = vw[k][j][3];
                v[j * 2] = (f32x4){bflo(w0), bfhi(w0), bflo(w1), bfhi(w1)}; v[j * 2 + 1] = (f32x4){bflo(w2), bfhi(w2), bflo(w3), bfhi(w3)};
            }
#pragma unroll
            for (int j = 0; j < 4; ++j) ss += v[j][0] * v[j][0] + v[j][1] * v[j][1] + v[j][2] * v[j][2] + v[j][3] * v[j][3];
            ss = wave_sum(ss);
            const float rstd = rsqrtf(ss * (1.f / DM) + EPSN);
#pragma unroll
            for (int j = 0; j < 4; ++j) { const int i4 = (lane + 64 * (j >> 1)) * 2 + (j & 1); const f32x4 fg = ((const f32x4*)p.final_g)[i4]; row[k * (DM / 4) + i4] = v[j] * rstd * fg; }
        }
    }
}

#define XB_TMO      128
#define XB_XCNT(j)  (256  + 64 * (j))
#define XB_XSUB(j)  (1280 + 64 * (j))
#define XB_XGEN(j)  (2304 + 64 * (j))
#define XB_TOP      3328
#define XB_TOPGEN   3392
#define XCD_BAR_WORDS 3456
#define XB_SPIN_CAP (1u << 18)
__device__ __forceinline__ unsigned xb_ld(unsigned* p)              { return __hip_atomic_load(p, __ATOMIC_RELAXED, __HIP_MEMORY_SCOPE_AGENT); }
__device__ __forceinline__ unsigned xb_add(unsigned* p, unsigned v) { return __hip_atomic_fetch_add(p, v, __ATOMIC_RELAXED, __HIP_MEMORY_SCOPE_AGENT); }
__device__ __forceinline__ unsigned xb_xcc_id() { return (unsigned)__builtin_amdgcn_s_getreg((3 << 11) | 20) & 0xFu; }
#define XB_SPIN(cond, bar) do { unsigned _sp = 0; while (cond) { __builtin_amdgcn_s_sleep(1); \
    if ((++_sp & 255u) == 0u) { if (xb_ld(&(bar)[XB_TMO])) break; if (_sp > XB_SPIN_CAP) { atomicAdd(&(bar)[XB_TMO], 1u); break; } } } } while (0)
struct XcdBarrier { unsigned* bar; unsigned x; volatile LAS unsigned* st; };
__device__ __forceinline__ XcdBarrier xcd_barrier_post(unsigned* bar, volatile LAS unsigned* st) {
    XcdBarrier b; b.bar = bar; b.x = xb_xcc_id(); b.st = st;
    if (threadIdx.x == 0) (void)xb_add(&bar[XB_XCNT(b.x)], 1u);
    return b;
}
__device__ __forceinline__ void xcd_barrier_complete(unsigned* bar, unsigned x, unsigned& nloc, unsigned& nx) {
    const unsigned G = gridDim.x * gridDim.y * gridDim.z;
    unsigned sum, cnt, mine, sp = 0u;
    for (;;) {
        sum = 0u; cnt = 0u; mine = 0u;
#pragma unroll
        for (unsigned j = 0; j < 16; ++j) { const unsigned c = xb_ld(&bar[XB_XCNT(j)]); sum += c; cnt += (c > 0u) ? 1u : 0u; mine = (j == x) ? c : mine; }
        if (sum == G) break;
        __builtin_amdgcn_s_sleep(1);
        if ((++sp & 255u) == 0u) { if (xb_ld(&bar[XB_TMO])) break; if (sp > XB_SPIN_CAP) { atomicAdd(&bar[XB_TMO], 1u); break; } }
    }
    nloc = mine > 0u ? mine : 1u; nx = cnt > 0u ? cnt : 1u;
}
__device__ __forceinline__ void xcd_barrier(const XcdBarrier& b) {
    asm volatile("s_waitcnt vmcnt(0)" ::: "memory");
    __syncthreads();
    if (threadIdx.x == 0) {
        unsigned* bar = b.bar;
        __builtin_amdgcn_s_waitcnt(0);
        unsigned nloc = b.st[0], nx = b.st[1];
        if (nloc == 0u) { xcd_barrier_complete(bar, b.x, nloc, nx); b.st[0] = nloc; b.st[1] = nx; }
        const unsigned old = xb_add(&bar[XB_XSUB(b.x)], 1u);
        const unsigned gen = old / nloc;
        if (old + 1u == (gen + 1u) * nloc) {
            __builtin_amdgcn_fence(__ATOMIC_RELEASE, "agent");
            asm volatile("s_waitcnt vmcnt(0)" ::: "memory");
            const unsigned og = xb_add(&bar[XB_TOP], 1u);
            const unsigned tg = og / nx;
            if (og + 1u == (tg + 1u) * nx) xb_add(&bar[XB_TOPGEN], 1u);
            else XB_SPIN(xb_ld(&bar[XB_TOPGEN]) == tg, bar);
            __builtin_amdgcn_fence(__ATOMIC_ACQUIRE, "agent");
            xb_add(&bar[XB_XGEN(b.x)], 1u);
            asm volatile("s_waitcnt vmcnt(0)" ::: "memory");
        } else {
            XB_SPIN(xb_ld(&bar[XB_XGEN(b.x)]) == gen, bar);
            __builtin_amdgcn_fence(__ATOMIC_ACQUIRE, "agent");
            asm volatile("s_waitcnt vmcnt(0)" ::: "memory");
        }
    }
    __syncthreads();
}

constexpr int LDS_BYTES = 147456;
#define GSYNC() xcd_barrier(xbar)
constexpr int MISC_OFF = LDS_BYTES - 64;

__global__ void __launch_bounds__(NT, 2) mega(P p) {
    extern __shared__ __attribute__((aligned(16))) unsigned char lds_raw[];
    LAS unsigned char* lds = (LAS unsigned char*)lds_raw;
    const int G = gridDim.x, bx = blockIdx.x;
    using namespace pg8;
    if (threadIdx.x < 16) ((LAS unsigned*)(lds + MISC_OFF))[threadIdx.x] = 0u;
    for (unsigned i = (unsigned)bx * NT + threadIdx.x; i < (1u << 20) / 8u; i += (unsigned)G * NT) ((unsigned long long*)p.ws)[i] = 0ull;
    cg::this_grid().sync();
    const XcdBarrier xbar = xcd_barrier_post((unsigned*)p.ws, (volatile LAS unsigned*)(lds + MISC_OFF));

    ph_prep(p, lds);
    GSYNC();
    ph_norm1(p, lds);
    GSYNC();
    {
        Gemm<DM / 2, DM / 2, DM / 2, 0, 0, true> g{p.hx(), p.w_in_t()}; StaticOrder<NTOK, INC> S; S.init(G, bx);
        EpiInProj E{p.U(), p.kb(), (size_t)(p.qb() - p.kb()), p.vT(), p.ga(), 0};
        gemm_phase<EpiInProj, StaticOrder<NTOK, INC>, true, true>(lds, g, S, E);
        Gemm<DM / 2, DM / 2, DM / 2, 0, 0, true> g2{p.hc(), p.w_in_t()}; StaticOrder<NCTX, CTXC> S2; S2.init(G, bx);
        EpiInProj E2{p.U(), p.kc(), 0, p.vcT(), p.ga(), 1};
        gemm_phase<EpiInProj, StaticOrder<NCTX, CTXC>, true, true>(lds, g2, S2, E2);
    }
    for (int it = bx - 48; it >= 0 && it < 128; it += G) ssm_prep_item(p, lds, it);
    for (int cb = bx - 176; cb >= 0 && cb < 32; cb += G) {
        const float* m3 = p.mod() + 3 * DM;
        const float* const rows[8] = {m3, m3 + 6 * DM, m3 + 12 * DM, m3 + 18 * DM, m3 + 24 * DM, m3 + 30 * DM, m3 + 36 * DM, m3 + 42 * DM};
        gemv_block64<8, false>(rows, p.w_q, 2048, cb * 64, nullptr, p.c2(), 2048, (LAS float*)lds);
    }
    bg_convert_tables(p);
    GSYNC();
    {
        Gemm<256, SSM_LD / 2, 256, (long)SSM_ROWS * SSM_LD / 2, 256L * 256, 2> g{p.U(), p.Win()}; StaticOrder<SSM_ROWS, 256, 32> S; S.init(G, bx);
        EpiE E{p.E()};
        gemm_phase<EpiE, StaticOrder<SSM_ROWS, 256, 32>, true, true>(lds, g, S, E);
    }
    GSYNC();
    ph_carry(p);
    ph_na(p, lds);
    GSYNC();
    {
        Gemm<SSM_LD / 2, SSM_LD / 2, SSM_LD / 2, (long)SSM_ROWS * SSM_LD / 2, 512L * SSM_LD / 2, 2> g{p.U(), p.Kmat()}; StaticOrder<1024, 512, 32> S; S.init(G, bx);
        EpiZ E{p.z()};
        gemm_phase<EpiZ, StaticOrder<1024, 512, 32>, true, true>(lds, g, S, E);
    }
    GSYNC();
    {
        Gemm<512, 512, 512> g{p.z(), p.w_glu_t()}; StaticOrder<NTOK, 512> S; S.init(G, bx);
        EpiGlu E{p.gl(), p.z(), p.b_glu};
        gemm_phase<EpiGlu, StaticOrder<NTOK, 512>, true, true>(lds, g, S, E);
    }
    GSYNC();
    {
        Gemm<256, 256, 256, 32L * 1024 * 1024, 512L * 1024, true> g{p.na(), p.w_b_t()}; PairOrder<NTOK, DM> S; S.init(G, bx);
        EpiMerge E{p.merged(), p.ga(), p.gb()};
        gemm_phase<EpiMerge, PairOrder<NTOK, DM>, true, true>(lds, g, S, E);
    }
    GSYNC();
    {
        Gemm<DM / 2, DM / 2, DM / 2, 0, 0, true> g{p.merged(), p.w_out_t()}; StaticOrder<NTOK, DM> S; S.init(G, bx);
        EpiOut E{p.x, p.x1b(), p.x1g(), p.mod(), p.norm2_g, p.rowss()};
        gemm_phase<EpiOut, StaticOrder<NTOK, DM>, true, true>(lds, g, S, E);
    }
    GSYNC();
    {
        Gemm<DM, DM, DM> g{p.x1g(), p.w_q_t()}; StaticOrder<NTOK, 2048> S; S.init(G, bx);
        EpiQ E{p.qp(), p.rowss(), p.c2()};
        gemm_phase<EpiQ, StaticOrder<NTOK, 2048>, true, true>(lds, g, S, E);
    }
    GSYNC();
    ph_peer_topk(p, lds);
    GSYNC();
    ph_gather_sliced<0>(p, lds);
    GSYNC();
    ph_gather_weights(p);
    GSYNC();
    ph_gather_sliced<1>(p, lds);
    GSYNC();
    ph_final_norm(p);
}

extern "C" void kernel_launch(void* const* d_in, const int* in_sizes, int n_in, void* d_out, int out_size, void* d_ws, size_t ws_size, hipStream_t stream) {
    static int grid = 0;
    if (grid == 0) {
        int dev = 0, cus = 0, per_cu = 0;
        (void)hipGetDevice(&dev);
        (void)hipDeviceGetAttribute(&cus, hipDeviceAttributeMultiprocessorCount, dev);
        (void)hipFuncSetAttribute((const void*)mega, hipFuncAttributeMaxDynamicSharedMemorySize, LDS_BYTES);
        (void)hipOccupancyMaxActiveBlocksPerMultiprocessor(&per_cu, (const void*)mega, NT, LDS_BYTES);
        if (per_cu < 1) { fprintf(stderr, "occupancy query says %d blocks per CU\n", per_cu); per_cu = 1; }
        grid = cus;
    }
    P p{};
    const float* const* in = (const float* const*)d_in;
    p.x = in[0]; p.c = in[1]; p.ctx = in[2]; p.c_ctx = in[3]; p.w_mod = in[4]; p.b_mod = in[5]; p.norm1_g = in[6]; p.norm2_g = in[7]; p.w_in = in[8];
    p.a_re = in[9]; p.a_im = in[10]; p.log_dt = in[11]; p.b_re = in[12]; p.b_im = in[13]; p.c_re = in[14]; p.c_im = in[15]; p.ssm_d = in[16];
    p.w_glu = in[17]; p.b_glu = in[18]; p.w_a = in[19]; p.w_b = in[20]; p.rpb = in[21]; p.w_out = in[22]; p.w_q = in[23]; p.subkeys = in[24];
    p.peer_u = in[25]; p.peer_v = in[26]; p.final_g = in[27];
    p.out = (float*)d_out;
    p.ws = (unsigned char*)d_ws;
    void* args[] = {&p};
    hipError_t e = hipLaunchCooperativeKernel((const void*)mega, dim3(grid), dim3(NT), args, LDS_BYTES, stream);
    if (e != hipSuccess) fprintf(stderr, "cooperative launch failed: %s (grid %d)\n", hipGetErrorString(e), grid);
}
```

```cpp
#include <hip/hip_runtime.h>
#include <hip/hip_cooperative_groups.h>
#include <cstdio>
#include <cstdint>
namespace cg = cooperative_groups;

#define LAS __attribute__((address_space(3)))
typedef unsigned short bf16_t;
typedef short bf16x8 __attribute__((ext_vector_type(8)));
typedef float f32x4 __attribute__((ext_vector_type(4)));
typedef float f32x2 __attribute__((ext_vector_type(2)));
typedef unsigned u32x4 __attribute__((ext_vector_type(4)));
typedef unsigned u32x2 __attribute__((ext_vector_type(2)));

constexpr int DM = 1024, NB = 8, SEQL = 4096, CTXL = 256, GW = 64, NTOK = NB * SEQL, NCTX = NB * CTXL;
constexpr int INC = 4096, CTXC = 1536;
constexpr int NT = 512, NWAVES = 8;
constexpr float EPSN = 1e-6f;
constexpr int SSM_ROWS = 1280;
constexpr int SSM_LD = 768;

__device__ __forceinline__ unsigned f2bf(float f) { unsigned u = __builtin_bit_cast(unsigned, f); return (u + 0x7fffu + ((u >> 16) & 1u)) >> 16; }
__device__ __forceinline__ unsigned pk2(float lo, float hi) { return f2bf(lo) | (f2bf(hi) << 16); }
__device__ __forceinline__ float bflo(unsigned w) { return __builtin_bit_cast(float, w << 16); }
__device__ __forceinline__ float bfhi(unsigned w) { return __builtin_bit_cast(float, w & 0xffff0000u); }
__device__ __forceinline__ float bf2f(bf16_t h) { return __builtin_bit_cast(float, (unsigned)h << 16); }

__device__ __forceinline__ float wave_sum(float v) {
#pragma unroll
    for (int o = 1; o < 64; o <<= 1) v += __shfl_xor(v, o);
    return v;
}
__device__ __forceinline__ float wave_max(float v) {
#pragma unroll
    for (int o = 1; o < 64; o <<= 1) v = fmaxf(v, __shfl_xor(v, o));
    return v;
}
__device__ __forceinline__ float frcp(float x) { return __builtin_amdgcn_rcpf(x); }
__device__ __forceinline__ float sigmoidf_(float x) { return frcp(1.f + __expf(-x)); }
__device__ __forceinline__ float siluf_(float x) { return x * frcp(1.f + __expf(-x)); }
__device__ __forceinline__ float gelu_tanh(float x) {
    const float k0 = 0.7978845608028654f, k1 = 0.044715f;
    const float u = k0 * (x + k1 * x * x * x);
    const float t = 1.f - 2.f * frcp(1.f + __expf(2.f * u));
    return 0.5f * x * (1.f + t);
}

namespace pg8 {
#define PG8_LAS __attribute__((address_space(3)))
constexpr int BM = 256, BK = 64, HALF = 128, HTB = HALF * BK * 2  , STAGE_BYTES = 8 * HTB, NXCD = 8, WGM = 8;
__host__ __device__ __forceinline__ int lds_byte(int r, int c) { const int st = (r >> 4) * 2 + (c >> 5), rr = r & 15, cc = c & 31, ob = rr * 64 + cc * 2; return st * 1024 + (ob ^ (((ob >> 9) & 1) << 5)); }
__host__ __device__ __forceinline__ void stage_rc(int b, int& R, int& C) { const int st = b / 1024, sb = b % 1024, swz = sb ^ (((sb >> 9) & 1) << 5); R = (st >> 1) * 16 + swz / 64; C = (st & 1) * 32 + (swz % 64) / 2; }
__host__ __device__ __forceinline__ int perm32(int rho) { const int n = rho >> 4, i = rho & 15; return 8 * (i >> 2) + 4 * n + (i & 3); }

struct Unit { int pm, pn, g; };
template <int K_, int LDA, int LDB, long GSA = 0, long GSB = 0, int FP8_ = 0>
struct Gemm {
    const bf16_t* A; const bf16_t* Bt;
    static constexpr int K = K_, lda = LDA, ldb = LDB; static constexpr bool FP8 = FP8_ == 1, FP8L = FP8_ == 2;
    __device__ __forceinline__ const char* abase(const Unit& u) const { return (const char*)(A + (size_t)u.g * GSA + (size_t)u.pm * BM * LDA); }
    __device__ __forceinline__ const char* bbase(const Unit& u) const { return (const char*)(Bt + (size_t)u.g * GSB + (size_t)u.pn * BM * LDB); }
};
template <int M, int N, int NGRP = 1>
struct StaticOrder {
    static constexpr int nM = M / BM, nN = N / BM, nwg = nM * nN;
    int G, c;
    __device__ void init(int G_, int c_) { G = G_; c = c_; }
    __device__ bool next(int i, Unit& u) const {
        const int L = i * G + c; if (L >= nwg * NGRP) return false;
        u.g = L / nwg;
        int wgid = L % nwg; { constexpr int q = nwg / NXCD, r = nwg % NXCD; const int xcd = wgid % NXCD, off = wgid / NXCD; wgid = (xcd < r ? xcd * (q + 1) : r * (q + 1) + (xcd - r) * q) + off; }
        constexpr int nig = WGM * nN; const int gid = wgid / nig, fm = gid * WGM, gsz = (nM - fm) < WGM ? (nM - fm) : WGM;
        u.pm = fm + ((wgid % nig) % gsz); u.pn = (wgid % nig) / gsz; return true;
    }
    __device__ __forceinline__ void a_ready(const Unit&) const {}
    __device__ __forceinline__ void done(const Unit&) const {}
};
__device__ __forceinline__ unsigned cvt_pk_bf16(float lo, float hi) { unsigned r; asm volatile("v_cvt_pk_bf16_f32 %0, %1, %2" : "=v"(r) : "v"(lo), "v"(hi)); return r; }
typedef long i64x2 __attribute__((ext_vector_type(2)));
typedef int i32x4 __attribute__((ext_vector_type(4)));
typedef int i32x8 __attribute__((ext_vector_type(8)));
template <class Epi, class Sched, bool ALIGN_EPI = false, bool SP2 = false, class GemmT>
__device__ __forceinline__ void gemm_phase(PG8_LAS unsigned char* lds, const GemmT g, const Sched& S, const Epi& E) {
    int tid_ = threadIdx.x; asm volatile("" : "+v"(tid_));
    const int tid = tid_, wid = __builtin_amdgcn_readfirstlane(tid >> 6), lane = tid & 63, wr = wid >> 2, wc = wid & 3, fr = lane & 15, fq = lane >> 4;
    const int K = g.K, nt = K / BK;
    unsigned voffA[2], voffB[2];
#pragma unroll
    for (int i = 0; i < 2; ++i) { int R, C; stage_rc(tid * 16 + i * 8192, R, C); const int Rb = Epi::PERM ? ((R & ~31) + perm32(R & 31)) : R;
        voffA[i] = (unsigned)(R * g.lda + C) * 2u; voffB[i] = (unsigned)(Rb * g.ldb + C) * 2u; }
    const size_t kstep = (size_t)(BK * 2);
    const size_t hstepA = (size_t)HALF * g.lda * 2, hstepB = (size_t)HALF * g.ldb * 2;
    const unsigned ldsw = (unsigned)wid * 1024u;
    const int aoff = lds_byte(wr * 64 + fr, fq * 8), boff = lds_byte(wc * 32 + fr, fq * 8);
#define PG8_SA(b, h) (((b) * 2 + (h)) * HTB)
#define PG8_SB(b, h) ((4 + (b) * 2 + (h)) * HTB)
#define PG8_STAGE(bufoff, gbase, voff) do { _Pragma("unroll") for (int _i = 0; _i < 2; ++_i) \
        __builtin_amdgcn_global_load_lds((const unsigned*)((const char*)(gbase) + (voff)[_i]), (PG8_LAS unsigned*)(lds + (bufoff) + ldsw + _i * 8192), 16, 0, 0); } while (0)
#define PG8_LDA(dst, b, h) do { if constexpr (GemmT::FP8) { _Pragma("unroll") for (int m = 0; m < 4; ++m) dst##8[m] = __builtin_shufflevector(*(const PG8_LAS i32x4*)(lds + PG8_SA(b, h) + aoff + m * 2048), *(const PG8_LAS i32x4*)(lds + PG8_SA(b, h) + aoff + m * 2048 + 1024), 0, 1, 2, 3, 4, 5, 6, 7); } \
        else { _Pragma("unroll") for (int m = 0; m < 4; ++m) _Pragma("unroll") for (int k = 0; k < 2; ++k) dst[m][k] = *(const PG8_LAS bf16x8*)(lds + PG8_SA(b, h) + aoff + m * 2048 + k * 1024); } } while (0)
#define PG8_LDB(dst, b, h) do { if constexpr (GemmT::FP8) { _Pragma("unroll") for (int n = 0; n < 2; ++n) dst##8[n] = __builtin_shufflevector(*(const PG8_LAS i32x4*)(lds + PG8_SB(b, h) + boff + n * 2048), *(const PG8_LAS i32x4*)(lds + PG8_SB(b, h) + boff + n * 2048 + 1024), 0, 1, 2, 3, 4, 5, 6, 7); } \
        else { _Pragma("unroll") for (int n = 0; n < 2; ++n) _Pragma("unroll") for (int k = 0; k < 2; ++k) dst[n][k] = *(const PG8_LAS bf16x8*)(lds + PG8_SB(b, h) + boff + n * 2048 + k * 1024); } } while (0)
#define PG8_MMA(ai, bj, At, Bt) do { __builtin_amdgcn_s_setprio(1); \
        if constexpr (GemmT::FP8) { __builtin_amdgcn_sched_barrier(0); _Pragma("unroll") for (int m = 0; m < 4; ++m) _Pragma("unroll") for (int n = 0; n < 2; ++n) \
            { acc[ai][bj][m][n] = __builtin_amdgcn_mfma_scale_f32_16x16x128_f8f6f4(Bt##8[n], At##8[m], acc[ai][bj][m][n], 0, 0, 0, 0x7f7f7f7f, 0, 0x7f7f7f7f); asm volatile("" : "+v"(acc[ai][bj][m][n])); } __builtin_amdgcn_sched_barrier(0); } \
        else if constexpr (GemmT::FP8L) { _Pragma("unroll") for (int m = 0; m < 4; ++m) _Pragma("unroll") for (int n = 0; n < 2; ++n) _Pragma("unroll") for (int k = 0; k < 2; ++k) { \
            const i64x2 b2_ = __builtin_bit_cast(i64x2, Bt[n][k]), a2_ = __builtin_bit_cast(i64x2, At[m][k]); const long bl_ = b2_[0], bh_ = b2_[1], al_ = a2_[0], ah_ = a2_[1]; \
            acc[ai][bj][m][n] = __builtin_amdgcn_mfma_f32_16x16x32_fp8_fp8(bl_, al_, acc[ai][bj][m][n], 0, 0, 0); acc[ai][bj][m][n] = __builtin_amdgcn_mfma_f32_16x16x32_fp8_fp8(bh_, ah_, acc[ai][bj][m][n], 0, 0, 0); } } \
        else { _Pragma("unroll") for (int m = 0; m < 4; ++m) _Pragma("unroll") for (int n = 0; n < 2; ++n) _Pragma("unroll") for (int k = 0; k < 2; ++k) \
            acc[ai][bj][m][n] = __builtin_amdgcn_mfma_f32_16x16x32_bf16(Bt[n][k], At[m][k], acc[ai][bj][m][n], 0, 0, 0); } __builtin_amdgcn_s_setprio(0); } while (0)
#define PG8_WAIT_V(n) asm volatile("s_waitcnt vmcnt(" #n ")" ::: "memory")
#define PG8_WAIT_L(n) asm volatile("s_waitcnt lgkmcnt(" #n ")" ::: "memory")
#define PG8_BAR __builtin_amdgcn_s_barrier()
#define PG8_SCHED __builtin_amdgcn_sched_barrier(0)
    Unit cur, nxt; int ui = 0;
    if (!S.next(0, cur)) return;
    f32x4 acc[2][2][4][2];
#pragma unroll
    for (int a = 0; a < 2; ++a)
#pragma unroll
        for (int b = 0; b < 2; ++b)
#pragma unroll
            for (int m = 0; m < 4; ++m)
#pragma unroll
                for (int n = 0; n < 2; ++n) acc[a][b][m][n] = (f32x4){0.f, 0.f, 0.f, 0.f};
    bf16x8 At[4][2], B0[2][2], B1[2][2];
    i32x8 At8[4], B08[2], B18[2];
    const char* cA = g.abase(cur); const char* cB = g.bbase(cur);
    S.a_ready(cur);
    if constexpr (SP2) {
        PG8_STAGE(PG8_SB(0, 0), cB, voffB); PG8_STAGE(PG8_SB(0, 1), cB + hstepB, voffB); PG8_STAGE(PG8_SA(0, 0), cA, voffA); PG8_STAGE(PG8_SA(0, 1), cA + hstepA, voffA);
        if (wr == 1) PG8_BAR;
        PG8_WAIT_V(2); PG8_BAR;
        PG8_STAGE(PG8_SB(1, 0), cB + kstep, voffB); PG8_STAGE(PG8_SA(1, 0), cA + kstep, voffA); PG8_STAGE(PG8_SB(1, 1), cB + hstepB + kstep, voffB);
        PG8_WAIT_V(6); PG8_BAR;
    } else {
        PG8_STAGE(PG8_SB(0, 0), cB, voffB); PG8_STAGE(PG8_SA(0, 0), cA, voffA); PG8_STAGE(PG8_SB(0, 1), cB + hstepB, voffB); PG8_STAGE(PG8_SA(0, 1), cA + hstepA, voffA);
        if (wr == 1) PG8_BAR;
        PG8_WAIT_V(4); PG8_BAR;
        PG8_STAGE(PG8_SB(1, 0), cB + kstep, voffB); PG8_STAGE(PG8_SA(1, 0), cA + kstep, voffA); PG8_STAGE(PG8_SB(1, 1), cB + hstepB + kstep, voffB);
        PG8_WAIT_V(6); PG8_BAR;
    }
    for (;;) {
        const bool has_next = S.next(ui + 1, nxt);
        const char* nA = has_next ? g.abase(nxt) : cA; const char* nB = has_next ? g.bbase(nxt) : cB;
#pragma unroll 1
        for (int t = 0; t < nt; t += 2) {
            const bool last = (t == nt - 2);
            const char* a1 = cA + (size_t)(t + 1) * kstep;
            const char* a2 = last ? nA : cA + (size_t)(t + 2) * kstep; const char* b2 = last ? nB : cB + (size_t)(t + 2) * kstep;
            const char* a3 = a2 + kstep; const char* b3 = b2 + kstep;
            if (last && has_next) S.a_ready(nxt);
            if constexpr (SP2) {
            PG8_LDB(B0, 0, 0); PG8_LDB(B1, 0, 1); PG8_SCHED; PG8_LDA(At, 0, 0); PG8_STAGE(PG8_SA(1, 1), a1 + hstepA, voffA);
            PG8_WAIT_V(8); PG8_WAIT_L(0); PG8_BAR; PG8_MMA(0, 0, At, B0); PG8_MMA(0, 1, At, B1); PG8_BAR; PG8_SCHED;
            PG8_LDA(At, 0, 1); PG8_STAGE(PG8_SB(0, 0), b2, voffB); PG8_STAGE(PG8_SB(0, 1), b2 + hstepB, voffB); PG8_STAGE(PG8_SA(0, 0), a2, voffA);
            PG8_WAIT_V(8); PG8_WAIT_L(0); PG8_BAR; PG8_MMA(1, 0, At, B0); PG8_MMA(1, 1, At, B1); PG8_BAR; PG8_SCHED;
            PG8_LDB(B0, 1, 0); PG8_LDB(B1, 1, 1); PG8_SCHED; PG8_LDA(At, 1, 0); PG8_STAGE(PG8_SA(0, 1), a2 + hstepA, voffA);
            PG8_WAIT_V(8); PG8_WAIT_L(0); PG8_BAR; PG8_MMA(0, 0, At, B0); PG8_MMA(0, 1, At, B1); PG8_BAR; PG8_SCHED;
            PG8_LDA(At, 1, 1); PG8_STAGE(PG8_SB(1, 0), b3, voffB); PG8_STAGE(PG8_SB(1, 1), b3 + hstepB, voffB); PG8_STAGE(PG8_SA(1, 0), a3, voffA);
            PG8_WAIT_V(8); PG8_WAIT_L(0); PG8_BAR; PG8_MMA(1, 0, At, B0); PG8_MMA(1, 1, At, B1); PG8_BAR; PG8_SCHED;
            } else {
            PG8_LDB(B0, 0, 0); PG8_SCHED; PG8_LDA(At, 0, 0); PG8_STAGE(PG8_SA(1, 1), a1 + hstepA, voffA);
            PG8_WAIT_L(8); PG8_BAR; PG8_WAIT_L(0); PG8_MMA(0, 0, At, B0); PG8_BAR; PG8_SCHED;
            PG8_LDB(B1, 0, 1); PG8_STAGE(PG8_SB(0, 0), b2, voffB);
            PG8_BAR; PG8_WAIT_L(0); PG8_MMA(0, 1, At, B1); PG8_BAR;
            PG8_LDA(At, 0, 1); PG8_STAGE(PG8_SA(0, 0), a2, voffA);
            PG8_BAR; PG8_WAIT_L(0); PG8_MMA(1, 0, At, B0); PG8_BAR; PG8_SCHED;
            PG8_STAGE(PG8_SB(0, 1), b2 + hstepB, voffB);
            PG8_WAIT_V(6); PG8_BAR; PG8_MMA(1, 1, At, B1); PG8_BAR;
            PG8_LDB(B0, 1, 0); PG8_SCHED; PG8_LDA(At, 1, 0); PG8_STAGE(PG8_SA(0, 1), a2 + hstepA, voffA);
            PG8_WAIT_L(8); PG8_BAR; PG8_WAIT_L(0); PG8_MMA(0, 0, At, B0); PG8_BAR; PG8_SCHED;
            PG8_LDB(B1, 1, 1); PG8_STAGE(PG8_SB(1, 0), b3, voffB);
            PG8_BAR; PG8_WAIT_L(0); PG8_MMA(0, 1, At, B1); PG8_BAR;
            PG8_LDA(At, 1, 1); PG8_STAGE(PG8_SA(1, 0), a3, voffA);
            PG8_BAR; PG8_WAIT_L(0); PG8_MMA(1, 0, At, B0); PG8_BAR; PG8_SCHED;
            PG8_STAGE(PG8_SB(1, 1), b3 + hstepB, voffB);
            PG8_WAIT_V(6); PG8_BAR; PG8_MMA(1, 1, At, B1); PG8_BAR;
            }
        }
        if constexpr (ALIGN_EPI) { if (wr == 0) PG8_BAR; }
        if constexpr (!Epi::AFTER_DRAIN) { E(acc, cur, wr, wc, fr, fq); S.done(cur); }
        if (!has_next) break;
        if (!E.keep(cur)) {
#pragma unroll
        for (int a = 0; a < 2; ++a)
#pragma unroll
            for (int b = 0; b < 2; ++b)
#pragma unroll
                for (int m = 0; m < 4; ++m)
#pragma unroll
                    for (int n = 0; n < 2; ++n) acc[a][b][m][n] = (f32x4){0.f, 0.f, 0.f, 0.f};
        }
        cur = nxt; cA = nA; cB = nB; ++ui;
        if constexpr (ALIGN_EPI) { if (wr == 1) PG8_BAR; }
    }
    PG8_WAIT_V(0);
    if constexpr (!ALIGN_EPI) { if (wr == 0) PG8_BAR; }
    PG8_BAR;
    if constexpr (Epi::AFTER_DRAIN) { E.fused(acc, cur, wr, wc, fr, fq, lds, wid, lane); S.done(cur); }
#undef PG8_SA
#undef PG8_SB
#undef PG8_STAGE
#undef PG8_LDA
#undef PG8_LDB
#undef PG8_MMA
#undef PG8_WAIT_V
#undef PG8_WAIT_L
#undef PG8_BAR
#undef PG8_SCHED
}
}

constexpr size_t MiB = 1u << 20;
struct P {
    const float *x, *c, *ctx, *c_ctx, *w_mod, *b_mod, *norm1_g, *norm2_g, *w_in;
    const float *a_re, *a_im, *log_dt, *b_re, *b_im, *c_re, *c_im, *ssm_d;
    const float *w_glu, *b_glu, *w_a, *w_b, *rpb, *w_out, *w_q, *subkeys, *peer_u, *peer_v, *final_g;
    float* out;
    unsigned char* ws;
    __device__ __forceinline__ unsigned long long* rowss() const { return (unsigned long long*)(ws + 512 * 1024); }
    __device__ __forceinline__ float* mod() const { return (float*)(ws + 1 * MiB); }
    __device__ __forceinline__ float* c2() const { return (float*)(ws + 1 * MiB + 256 * 1024); }
    __device__ __forceinline__ bf16_t* w_in_t() const { return (bf16_t*)(ws + 3 * MiB); }
    __device__ __forceinline__ bf16_t* w_glu_t() const { return (bf16_t*)(ws + 11 * MiB); }
    __device__ __forceinline__ bf16_t* w_b_t() const { return (bf16_t*)(ws + 12 * MiB); }
    __device__ __forceinline__ bf16_t* w_a_t() const { return (bf16_t*)(ws + 13 * MiB); }
    __device__ __forceinline__ bf16_t* w_out_t() const { return (bf16_t*)(ws + 14 * MiB); }
    __device__ __forceinline__ bf16_t* w_q_t() const { return (bf16_t*)(ws + 16 * MiB); }
    __device__ __forceinline__ bf16_t* Kmat() const { return (bf16_t*)(ws + 21 * MiB); }
    __device__ __forceinline__ bf16_t* Win() const { return (bf16_t*)(ws + 45 * MiB); }
    __device__ __forceinline__ float* lamT() const { return (float*)(ws + 53 * MiB); }
    __device__ __forceinline__ unsigned char* pu8() const { return ws + 54 * MiB; }
    __device__ __forceinline__ unsigned char* pv8() const { return ws + 70 * MiB; }
    __device__ __forceinline__ float* pisc() const { return (float*)(ws + 53 * MiB + 128 * 1024); }
    __device__ __forceinline__ float* pisc_u() const { return (float*)(ws + 53 * MiB + 256 * 1024); }
    __device__ __forceinline__ bf16_t* ga() const { return (bf16_t*)(ws + 118 * MiB); }
    __device__ __forceinline__ bf16_t* gb() const { return (bf16_t*)(ws + 182 * MiB); }
    __device__ __forceinline__ bf16_t* wq_s() const { return (bf16_t*)(ws + 80 * MiB); }
    __device__ __forceinline__ unsigned* topk() const { return (unsigned*)(ws + 182 * MiB); }
    __device__ __forceinline__ float* gates() const { return (float*)(ws + 198 * MiB); }
    __device__ __forceinline__ bf16_t* kb() const { return (bf16_t*)(ws + 246 * MiB); }
    __device__ __forceinline__ bf16_t* vT() const { return (bf16_t*)(ws + 278 * MiB); }
    __device__ __forceinline__ bf16_t* qb() const { return (bf16_t*)(ws + 310 * MiB); }
    __device__ __forceinline__ bf16_t* kc() const { return (bf16_t*)(ws + 342 * MiB); }
    __device__ __forceinline__ bf16_t* vcT() const { return (bf16_t*)(ws + 344 * MiB); }
    __device__ __forceinline__ bf16_t* U() const { return (bf16_t*)(ws + 346 * MiB); }
    __device__ __forceinline__ float* E() const { return (float*)(ws + 406 * MiB); }
    __device__ __forceinline__ bf16_t* merged() const { return (bf16_t*)(ws + 246 * MiB); }
    __device__ __forceinline__ bf16_t* qp() const { return (bf16_t*)(ws + 246 * MiB); }
    __device__ __forceinline__ float* apart() const { return (float*)(ws + 246 * MiB); }
    __device__ __forceinline__ float* wl() const { return (float*)(ws + 374 * MiB); }
    __device__ __forceinline__ float* ss2() const { return (float*)(ws + 406 * MiB); }
    __device__ __forceinline__ bf16_t* x1b() const { return (bf16_t*)(ws + 406 * MiB); }
    __device__ __forceinline__ unsigned* queues() const { return (unsigned*)(ws + 64 * 1024); }
    __device__ __forceinline__ bf16_t* hx() const { return (bf16_t*)out; }
    __device__ __forceinline__ bf16_t* hc() const { return (bf16_t*)((unsigned char*)out + 64 * MiB); }
    __device__ __forceinline__ bf16_t* na() const { return (bf16_t*)out; }
    __device__ __forceinline__ bf16_t* z() const { return (bf16_t*)((unsigned char*)out + 32 * MiB); }
    __device__ __forceinline__ bf16_t* gl() const { return (bf16_t*)((unsigned char*)out + 64 * MiB); }
};

template <int CTRL> __device__ __forceinline__ int dpp_i(int v) { return __builtin_amdgcn_update_dpp(0, v, CTRL, 0xf, 0xf, true); }
template <int CTRL> __device__ __forceinline__ float dpp_f(float v) { return __builtin_bit_cast(float, __builtin_amdgcn_update_dpp(0, __builtin_bit_cast(int, v), CTRL, 0xf, 0xf, true)); }
constexpr int DPP_XOR1 = 0xB1, DPP_XOR2 = 0x4E, DPP_HMIRROR = 0x141, DPP_ROR8 = 0x128;
constexpr float I8_MAGIC = 12582912.f;
__device__ __forceinline__ unsigned pack4_i8(float t0, float t1, float t2, float t3) {
    const unsigned p01 = __builtin_amdgcn_perm(__builtin_bit_cast(unsigned, t1), __builtin_bit_cast(unsigned, t0), 0x0c0c0400u);
    const unsigned p23 = __builtin_amdgcn_perm(__builtin_bit_cast(unsigned, t3), __builtin_bit_cast(unsigned, t2), 0x0c0c0400u);
    return __builtin_amdgcn_perm(p23, p01, 0x05040100u);
}
constexpr float SS_FIX = 1099511627776.f, SS_UNFIX = 1.f / 1099511627776.f;
__device__ __forceinline__ float rstd_from_fix(unsigned long long v) { return rsqrtf((float)v * (SS_UNFIX / DM) + EPSN); }
constexpr size_t GATE_STRIDE = (size_t)64 << 20;
constexpr float ACT8 = 8.f;
constexpr float WIN_SCALE = 32.f;
__device__ __forceinline__ unsigned pk4_fp8(float a, float b, float c, float d) { int w = 0; w = __builtin_amdgcn_cvt_pk_fp8_f32(a, b, w, false); w = __builtin_amdgcn_cvt_pk_fp8_f32(c, d, w, true); return (unsigned)w; }
namespace pg8 {
struct EpiInProj {
    static constexpr bool PERM = true, AFTER_DRAIN = false;
    __device__ __forceinline__ bool keep(const Unit&) const { return false; }
    bf16_t* U; bf16_t* d_kq; size_t kq_stride; bf16_t* d_vT; bf16_t* d_gate; int is_ctx;
    __device__ __forceinline__ void operator()(const f32x4 (&acc)[2][2][4][2], const Unit& u, int wr, int wc, int fr, int fq) const {
        if (u.pn < 2) {
#pragma unroll
            for (int ai = 0; ai < 2; ++ai)
#pragma unroll
                for (int m = 0; m < 4; ++m) {
                    const int row = u.pm * BM + ai * HALF + wr * 64 + m * 16 + fr;
                    const int n = is_ctx ? (1024 + (row >> 8) * 8 + ((row & 255) >> 5)) : ((row >> 12) * 128 + ((row & 4095) >> 5));
                    const int jj = row & 31;
#pragma unroll
                    for (int bj = 0; bj < 2; ++bj) {
                        const int col = u.pn * BM + bj * HALF + wc * 32 + 8 * fq;
                        const f32x4 v0 = acc[ai][bj][m][0] * (1.f / WIN_SCALE), v1 = acc[ai][bj][m][1] * (1.f / WIN_SCALE);
                        u32x2 w; w.x = pk4_fp8(v0[0], v0[1], v0[2], v0[3]); w.y = pk4_fp8(v1[0], v1[1], v1[2], v1[3]);
                        *(u32x2*)((unsigned char*)U + ((size_t)((col >> 4) * SSM_ROWS + n) * SSM_LD + jj * 16 + (col & 15))) = w;
                    }
                    asm volatile("" ::: "memory");
                }
        } else if (u.pn == 4 || u.pn == 5) {
            const int RB = is_ctx ? (CTXL / 64) : (SEQL / 64);
#pragma unroll
            for (int ai = 0; ai < 2; ++ai)
#pragma unroll
                for (int m = 0; m < 4; ++m) {
                    const int row = u.pm * BM + ai * HALF + wr * 64 + m * 16 + fr;
                    const int b = is_ctx ? (row >> 8) : (row >> 12), t = is_ctx ? (row & 255) : (row & 4095);
#pragma unroll
                    for (int bj = 0; bj < 2; ++bj) {
                        const int col = u.pn * BM + bj * HALF + wc * 32 + 8 * fq - 1024;
                        unsigned char* dst = (unsigned char*)d_vT + ((size_t)((b * 8 + (col >> 6)) * RB + (t >> 6)) * 4096 + (col & 63) * 64 + (t & 63));
#pragma unroll
                        for (int n = 0; n < 2; ++n) {
                            const f32x4 vv = acc[ai][bj][m][n] * (ACT8 / WIN_SCALE);
                            const unsigned w = pk4_fp8(vv[0], vv[1], vv[2], vv[3]);
#pragma unroll
                            for (int i = 0; i < 4; ++i) dst[(n * 4 + i) * 64] = (unsigned char)(w >> (8 * i));
                        }
                    }
                    asm volatile("" ::: "memory");
                }
        } else if (u.pn >= 8) {
            const int which = (u.pn - 8) >> 2;
            unsigned char* base8 = (unsigned char*)d_gate + (size_t)which * GATE_STRIDE;
#pragma unroll
            for (int ai = 0; ai < 2; ++ai)
#pragma unroll
                for (int m = 0; m < 4; ++m) {
                    const int row = u.pm * BM + ai * HALF + wr * 64 + m * 16 + fr;
#pragma unroll
                    for (int bj = 0; bj < 2; ++bj) {
                        const int col = u.pn * BM + bj * HALF + wc * 32 + 8 * fq - (2048 + which * 1024);
                        const f32x4 v0 = acc[ai][bj][m][0] * (1.f / WIN_SCALE), v1 = acc[ai][bj][m][1] * (1.f / WIN_SCALE);
                        float t[8];
#pragma unroll
                        for (int i = 0; i < 4; ++i) { t[i] = fminf(sigmoidf_(v0[i]), 0.998f) * 256.f + (I8_MAGIC - 0.5f); t[4 + i] = fminf(sigmoidf_(v1[i]), 0.998f) * 256.f + (I8_MAGIC - 0.5f); }
                        u32x2 w; w.x = pack4_i8(t[0], t[1], t[2], t[3]); w.y = pack4_i8(t[4], t[5], t[6], t[7]);
                        *(u32x2*)(base8 + (size_t)row * DM + col) = w;
                    }
                    asm volatile("" ::: "memory");
                }
        } else {
            bf16_t* base; int ld, c0;
            { const int which = (u.pn - 2) >> 2; base = d_kq + (size_t)which * kq_stride; ld = 512; c0 = 512 + which * 1024; }
#pragma unroll
            for (int ai = 0; ai < 2; ++ai)
#pragma unroll
                for (int m = 0; m < 4; ++m) {
                    const int row = u.pm * BM + ai * HALF + wr * 64 + m * 16 + fr;
#pragma unroll
                    for (int bj = 0; bj < 2; ++bj) {
                        const int col = u.pn * BM + bj * HALF + wc * 32 + 8 * fq - c0;
                        const f32x4 v0 = acc[ai][bj][m][0] * (ACT8 / WIN_SCALE), v1 = acc[ai][bj][m][1] * (ACT8 / WIN_SCALE);
                        u32x2 w; w.x = pk4_fp8(v0[0], v0[1], v0[2], v0[3]); w.y = pk4_fp8(v1[0], v1[1], v1[2], v1[3]);
                        *(u32x2*)((unsigned char*)base + (size_t)row * ld + col) = w;
                    }
                    asm volatile("" ::: "memory");
                }
        }
    }
};
template <int M, int N>
struct BatchOrder {
    StaticOrder<M, N> S;
    __device__ void init(int G_, int c_) { S.init(G_, c_); }
    __device__ bool next(int i, Unit& u) const { if (!S.next(i, u)) return false; u.g = u.pm >> 4; return true; }
    __device__ __forceinline__ void a_ready(const Unit&) const {}
    __device__ __forceinline__ void done(const Unit&) const {}
};
struct EpiGlu {
    static constexpr bool PERM = true, AFTER_DRAIN = false;
    __device__ __forceinline__ bool keep(const Unit&) const { return false; }
    bf16_t* gl; const bf16_t* z; const float* bias;
    __device__ __forceinline__ void operator()(const f32x4 (&acc)[2][2][4][2], const Unit& u, int wr, int wc, int fr, int fq) const {
#pragma unroll
        for (int ai = 0; ai < 2; ++ai)
#pragma unroll
            for (int m = 0; m < 4; ++m) {
                const int row = u.pm * BM + ai * HALF + wr * 64 + m * 16 + fr;
#pragma unroll
                for (int bj = 0; bj < 2; ++bj) {
                    const int col = u.pn * BM + bj * HALF + wc * 32 + 8 * fq;
                    const f32x4 v0 = acc[ai][bj][m][0], v1 = acc[ai][bj][m][1];
                    const f32x4 b0 = *(const f32x4*)(bias + col), b1 = *(const f32x4*)(bias + col + 4);
                    const u32x2 zz = *(const u32x2*)((const unsigned char*)z + (size_t)row * 512 + col);
                    const int z0 = (int)zz[0], z1 = (int)zz[1];
                    const f32x2 za = __builtin_amdgcn_cvt_pk_f32_fp8(z0, false), zb = __builtin_amdgcn_cvt_pk_f32_fp8(z0, true), zc = __builtin_amdgcn_cvt_pk_f32_fp8(z1, false), zd = __builtin_amdgcn_cvt_pk_f32_fp8(z1, true);
                    constexpr float si = 1.f / (ACT8 * WIN_SCALE), zi = 1.f / ACT8;
                    float o[8];
                    o[0] = za[0] * zi * sigmoidf_(v0[0] * si + b0[0]); o[1] = za[1] * zi * sigmoidf_(v0[1] * si + b0[1]);
                    o[2] = zb[0] * zi * sigmoidf_(v0[2] * si + b0[2]); o[3] = zb[1] * zi * sigmoidf_(v0[3] * si + b0[3]);
                    o[4] = zc[0] * zi * sigmoidf_(v1[0] * si + b1[0]); o[5] = zc[1] * zi * sigmoidf_(v1[1] * si + b1[1]);
                    o[6] = zd[0] * zi * sigmoidf_(v1[2] * si + b1[2]); o[7] = zd[1] * zi * sigmoidf_(v1[3] * si + b1[3]);
                    u32x2 w; w.x = pk4_fp8(o[0] * ACT8, o[1] * ACT8, o[2] * ACT8, o[3] * ACT8); w.y = pk4_fp8(o[4] * ACT8, o[5] * ACT8, o[6] * ACT8, o[7] * ACT8);
                    *(u32x2*)((unsigned char*)gl + (size_t)row * 512 + col) = w;
                }
            }
    }
};
template <int M, int N>
struct PairOrder {
    StaticOrder<M, N> S;
    __device__ void init(int G_, int c_) { S.init(G_, c_); }
    __device__ bool next(int i, Unit& u) const { if (!S.next(i >> 1, u)) return false; u.g = i & 1; return true; }
    __device__ __forceinline__ void a_ready(const Unit&) const {}
    __device__ __forceinline__ void done(const Unit&) const {}
};
struct EpiMerge {
    static constexpr bool PERM = true, AFTER_DRAIN = false;
    __device__ __forceinline__ bool keep(const Unit& u) const { return u.g == 0; }
    bf16_t* merged; const unsigned char* ga; const unsigned char* gb;
    __device__ __forceinline__ void operator()(f32x4 (&acc)[2][2][4][2], const Unit& u, int wr, int wc, int fr, int fq) const {
#pragma unroll
        for (int ai = 0; ai < 2; ++ai)
#pragma unroll
            for (int m = 0; m < 4; ++m) {
                const int row = u.pm * BM + ai * HALF + wr * 64 + m * 16 + fr;
#pragma unroll
                for (int bj = 0; bj < 2; ++bj) {
                    const int col = u.pn * BM + bj * HALF + wc * 32 + 8 * fq;
                    const u32x2 a2 = *(const u32x2*)(ga + (size_t)row * DM + col);
                    const unsigned a0 = a2[0], a1 = a2[1];
                    float sa[8];
#pragma unroll
                    for (int q = 0; q < 4; ++q) { sa[q] = ((float)((a0 >> (8 * q)) & 255u) + 0.5f) * (1.f / 256.f); sa[4 + q] = ((float)((a1 >> (8 * q)) & 255u) + 0.5f) * (1.f / 256.f); }
                    if (u.g == 0) {
                        const u32x2 b2 = *(const u32x2*)(gb + (size_t)row * DM + col);
                        const unsigned b0 = b2[0], b1 = b2[1];
#pragma unroll
                        for (int q = 0; q < 8; ++q) {
                            const float sb = ((float)(((q < 4 ? b0 : b1) >> (8 * (q & 3))) & 255u) + 0.5f) * (1.f / 256.f);
                            acc[ai][bj][m][q >> 2][q & 3] *= sb * frcp(sa[q]);
                        }
                    } else {
                        const f32x4 v0 = acc[ai][bj][m][0], v1 = acc[ai][bj][m][1];
                        constexpr float f = ACT8 / (ACT8 * WIN_SCALE);
                        u32x2 w; w[0] = pk4_fp8(v0[0] * sa[0] * f, v0[1] * sa[1] * f, v0[2] * sa[2] * f, v0[3] * sa[3] * f); w[1] = pk4_fp8(v1[0] * sa[4] * f, v1[1] * sa[5] * f, v1[2] * sa[6] * f, v1[3] * sa[7] * f);
                        *(u32x2*)((unsigned char*)merged + (size_t)row * DM + col) = w;
                    }
                }
                asm volatile("" ::: "memory");
            }
    }
};
struct EpiOut {
    static constexpr bool PERM = true, AFTER_DRAIN = false;
    __device__ __forceinline__ bool keep(const Unit&) const { return false; }
    const float* x; bf16_t* x1; const float* mod; unsigned long long* rowss;
    __device__ __forceinline__ void operator()(const f32x4 (&acc)[2][2][4][2], const Unit& u, int wr, int wc, int fr, int fq) const {
#pragma unroll
        for (int ai = 0; ai < 2; ++ai)
#pragma unroll
            for (int m = 0; m < 4; ++m) {
                const int row = u.pm * BM + ai * HALF + wr * 64 + m * 16 + fr;
                const float* modb = mod + (size_t)(row >> 12) * (6 * DM);
                float ss = 0.f;
#pragma unroll
                for (int bj = 0; bj < 2; ++bj) {
                    const int col = u.pn * BM + bj * HALF + wc * 32 + 8 * fq;
#pragma unroll
                    for (int n = 0; n < 2; ++n) {
                        const int cc = col + 4 * n;
                        const f32x4 v = acc[ai][bj][m][n] * (1.f / (ACT8 * WIN_SCALE));
                        const f32x4 xx = *(const f32x4*)(x + (size_t)row * DM + cc);
                        const f32x4 g1 = *(const f32x4*)(modb + 2 * DM + cc);
                        const f32x4 o = xx + g1 * v;
                        { u32x2 w1; w1.x = cvt_pk_bf16(o[0], o[1]); w1.y = cvt_pk_bf16(o[2], o[3]); *(u32x2*)(x1 + (size_t)row * DM + cc) = w1; }
                        ss += o[0] * o[0] + o[1] * o[1] + o[2] * o[2] + o[3] * o[3];
                    }
                }
                ss += __shfl_xor(ss, 16); ss += __shfl_xor(ss, 32);
                if (fq == 0) atomicAdd(rowss + row, (unsigned long long)(ss * SS_FIX));
            }
    }
};
struct EpiQ {
    static constexpr bool PERM = true, AFTER_DRAIN = false;
    __device__ __forceinline__ bool keep(const Unit&) const { return false; }
    bf16_t* qp; const unsigned long long* rowss; const float* c2;
    __device__ __forceinline__ void operator()(const f32x4 (&acc)[2][2][4][2], const Unit& u, int wr, int wc, int fr, int fq) const {
#pragma unroll
        for (int ai = 0; ai < 2; ++ai)
#pragma unroll
            for (int m = 0; m < 4; ++m) {
                const int row = u.pm * BM + ai * HALF + wr * 64 + m * 16 + fr;
                const float rstd = rstd_from_fix(rowss[row]);
                const float* cb = c2 + (size_t)(row >> 12) * 2048;
#pragma unroll
                for (int bj = 0; bj < 2; ++bj) {
                    const int col = u.pn * BM + bj * HALF + wc * 32 + 8 * fq;
                    const f32x4 v0 = acc[ai][bj][m][0] * rstd + *(const f32x4*)(cb + col), v1 = acc[ai][bj][m][1] * rstd + *(const f32x4*)(cb + col + 4);
                    u32x4 w; w.x = cvt_pk_bf16(v0[0], v0[1]); w.y = cvt_pk_bf16(v0[2], v0[3]); w.z = cvt_pk_bf16(v1[0], v1[1]); w.w = cvt_pk_bf16(v1[2], v1[3]);
                    *(u32x4*)(qp + (size_t)row * 2048 + col) = w;
                }
            }
    }
};
struct EpiE {
    static constexpr bool PERM = true, AFTER_DRAIN = false;
    __device__ __forceinline__ bool keep(const Unit&) const { return false; }
    float* E;
    __device__ __forceinline__ void operator()(const f32x4 (&acc)[2][2][4][2], const Unit& u, int wr, int wc, int fr, int fq) const {
#pragma unroll
        for (int ai = 0; ai < 2; ++ai)
#pragma unroll
            for (int m = 0; m < 4; ++m) {
                const int row = u.pm * BM + ai * HALF + wr * 64 + m * 16 + fr;
#pragma unroll
                for (int bj = 0; bj < 2; ++bj) {
                    const int col = u.pn * BM + bj * HALF + wc * 32 + 8 * fq;
                    float* d = E + ((size_t)(u.g * SSM_ROWS + row) * 256 + col);
                    *(f32x4*)d = acc[ai][bj][m][0] * (1.f / WIN_SCALE); *(f32x4*)(d + 4) = acc[ai][bj][m][1] * (1.f / WIN_SCALE);
                }
            }
    }
};
struct EpiZ {
    static constexpr bool PERM = true, AFTER_DRAIN = false;
    __device__ __forceinline__ bool keep(const Unit&) const { return false; }
    bf16_t* z;
    __device__ __forceinline__ void operator()(const f32x4 (&acc)[2][2][4][2], const Unit& u, int wr, int wc, int fr, int fq) const {
#pragma unroll
        for (int ai = 0; ai < 2; ++ai)
#pragma unroll
            for (int m = 0; m < 4; ++m) {
                const int n = u.pm * BM + ai * HALF + wr * 64 + m * 16 + fr;
                const size_t tok0 = (size_t)(n >> 7) * SEQL + (size_t)(n & 127) * 32;
#pragma unroll
                for (int bj = 0; bj < 2; ++bj) {
                    const int col = u.pn * BM + bj * HALF + wc * 32 + 8 * fq;
                    const f32x4 v0 = acc[ai][bj][m][0] * (1.f / WIN_SCALE), v1 = acc[ai][bj][m][1] * (1.f / WIN_SCALE);
                    u32x2 w; w.x = pk4_fp8(gelu_tanh(v0[0]) * ACT8, gelu_tanh(v0[1]) * ACT8, gelu_tanh(v0[2]) * ACT8, gelu_tanh(v0[3]) * ACT8);
                    w.y = pk4_fp8(gelu_tanh(v1[0]) * ACT8, gelu_tanh(v1[1]) * ACT8, gelu_tanh(v1[2]) * ACT8, gelu_tanh(v1[3]) * ACT8);
                    *(u32x2*)((unsigned char*)z + (tok0 + (col >> 4)) * 512 + u.g * 16 + (col & 15)) = w;
                }
            }
    }
};
}

__device__ __forceinline__ void sincos_d(double th, double& s, double& c) {
    const double twopi = 6.283185307179586476925, hpi = 1.570796326794896619231;
    th -= twopi * rint(th / twopi);
    const double q = rint(th / hpi); const double y = th - q * hpi, y2 = y * y;
    const double sy = y * (1.0 - y2 / 6.0 * (1.0 - y2 / 20.0 * (1.0 - y2 / 42.0 * (1.0 - y2 / 72.0 * (1.0 - y2 / 110.0 * (1.0 - y2 / 156.0 * (1.0 - y2 / 210.0)))))));
    const double cy = 1.0 - y2 / 2.0 * (1.0 - y2 / 12.0 * (1.0 - y2 / 30.0 * (1.0 - y2 / 56.0 * (1.0 - y2 / 90.0 * (1.0 - y2 / 132.0 * (1.0 - y2 / 182.0))))));
    const int qi = ((int)q) & 3;
    s = qi == 0 ? sy : (qi == 1 ? cy : (qi == 2 ? -sy : -cy));
    c = qi == 0 ? cy : (qi == 1 ? -sy : (qi == 2 ? -cy : sy));
}
__device__ __forceinline__ void ssm_prep_item(const P& p, LAS unsigned char* lds, int item) {
    const int g = item >> 2, qtr = item & 3, tid = threadIdx.x;
    LAS f32x2* lamk = (LAS f32x2*)lds;
    LAS f32x2* Bb = lamk + 2 * 64 * 33;
    LAS f32x2* Cc = Bb + 2 * 64 * 16;
    LAS float* Kc = (LAS float*)(Cc + 2 * 16 * 64);
    if (tid < 128) {
        const int d = tid >> 6, pp = tid & 63, gi = d * 32 + g;
        const double are = (double)p.a_re[gi * 64 + pp], aim = (double)p.a_im[gi * 64 + pp];
        const double dt = (double)expf(p.log_dt[gi]);
        const double er = exp(are * dt); double sn, cs; sincos_d(aim * dt, sn, cs);
        const double lr = er * cs, li = er * sn;
        double pr = 1.0, pi_ = 0.0;
        for (int k = 0; k <= 32; ++k) {
            lamk[(d * 64 + pp) * 33 + k] = (f32x2){(float)pr, (float)pi_};
            const double nr_ = pr * lr - pi_ * li, ni_ = pr * li + pi_ * lr; pr = nr_; pi_ = ni_;
        }
        if (qtr == 0) { const f32x2 l32 = lamk[(d * 64 + pp) * 33 + 32]; *(f32x2*)(p.lamT() + (size_t)(gi * 64 + pp) * 2) = l32; }
        const double nr = lr - 1.0, ni = li, den = are * are + aim * aim;
        const double qr = (nr * are + ni * aim) / den, qi = (ni * are - nr * aim) / den;
        f32x4 brv[4], biv[4];
#pragma unroll
        for (int q = 0; q < 4; ++q) { brv[q] = *(const f32x4*)(p.b_re + ((size_t)gi * 64 + pp) * 16 + 4 * q); biv[q] = *(const f32x4*)(p.b_im + ((size_t)gi * 64 + pp) * 16 + 4 * q); }
#pragma unroll
        for (int h = 0; h < 16; ++h) {
            const double br = (double)brv[h >> 2][h & 3], bi = (double)biv[h >> 2][h & 3];
            Bb[(d * 64 + pp) * 16 + h] = (f32x2){(float)(qr * br - qi * bi), (float)(qr * bi + qi * br)};
        }
    }
    for (int e = tid; e < 2 * 16 * 64; e += NT) {
        const int d = e >> 10, h = (e >> 6) & 15, pp = e & 63; const size_t src = ((size_t)(d * 32 + g) * 16 + h) * 64 + pp;
        Cc[e] = (f32x2){p.c_re[src], p.c_im[src]};
    }
    __syncthreads();
    {
        const int wv = __builtin_amdgcn_readfirstlane(tid >> 6), lane = tid & 63, lm = lane & 15, kq = lane >> 4, d = wv >> 2;
        bf16x8 bop[4];
#pragma unroll
        for (int ks = 0; ks < 4; ++ks) {
            u32x4 w;
#pragma unroll
            for (int j = 0; j < 4; ++j) { const f32x2 bb = Bb[(d * 64 + ks * 16 + kq * 4 + j) * 16 + lm]; w[j] = pk2(bb[0], bb[1]); }
            bop[ks] = __builtin_bit_cast(bf16x8, w);
        }
#pragma unroll 1
        for (int k = (wv & 3) * 8; k < (wv & 3) * 8 + 8; ++k) {
            f32x4 acc = {0.f, 0.f, 0.f, 0.f};
#pragma unroll
            for (int ks = 0; ks < 4; ++ks) {
                u32x4 w;
#pragma unroll
                for (int j = 0; j < 4; ++j) {
                    const int pp = ks * 16 + kq * 4 + j;
                    const f32x2 c = Cc[(d * 16 + lm) * 64 + pp], l = lamk[(d * 64 + pp) * 33 + k];
                    w[j] = pk2(c[0] * l[0] - c[1] * l[1], -(c[0] * l[1] + c[1] * l[0]));
                }
                acc = __builtin_amdgcn_mfma_f32_16x16x32_bf16(__builtin_bit_cast(bf16x8, w), bop[ks], acc, 0, 0, 0);
            }
#pragma unroll
            for (int r = 0; r < 4; ++r) Kc[((d * 32 + k) * 16 + kq * 4 + r) * 16 + lm] = acc[r];
        }
    }
    __syncthreads();
    for (int ch = tid; ch < 128 * 96; ch += NT) {
        const int mrow = 128 * qtr + ch / 96, k0 = (ch % 96) * 8, ii = mrow >> 4, h = mrow & 15;
        float v[8];
        if (k0 < 512) {
            const int jj = k0 >> 4, h20 = k0 & 15;
#pragma unroll
            for (int i = 0; i < 8; ++i) {
                const int h2 = h20 + i; float val = 0.f;
                if (ii >= jj) val += Kc[((0 * 32 + (ii - jj)) * 16 + h) * 16 + h2];
                if (jj >= ii) val += Kc[((1 * 32 + (jj - ii)) * 16 + h) * 16 + h2];
                if (ii == jj && h == h2) val += p.ssm_d[g * 16 + h];
                v[i] = val;
            }
        } else {
            const int sc = k0 - 512, d = sc >> 7, ri = (sc >> 6) & 1, p0 = sc & 63, e = d == 0 ? ii + 1 : 32 - ii;
#pragma unroll
            for (int i = 0; i < 8; ++i) {
                const int pp = p0 + i; const f32x2 c = Cc[(d * 16 + h) * 64 + pp], l = lamk[(d * 64 + pp) * 33 + e];
                const float clr = c[0] * l[0] - c[1] * l[1], cli = c[0] * l[1] + c[1] * l[0];
                v[i] = ri == 0 ? clr : -cli;
            }
        }
        u32x2 o; o.x = pk4_fp8(v[0] * WIN_SCALE, v[1] * WIN_SCALE, v[2] * WIN_SCALE, v[3] * WIN_SCALE); o.y = pk4_fp8(v[4] * WIN_SCALE, v[5] * WIN_SCALE, v[6] * WIN_SCALE, v[7] * WIN_SCALE);
        *(u32x2*)((unsigned char*)p.Kmat() + ((size_t)(g * 512 + mrow) * SSM_LD + k0)) = o;
    }
    for (int ch = tid; ch < 64 * 64; ch += NT) {
        const int nrow = 64 * qtr + ch / 64, k0 = (ch % 64) * 8, d = nrow >> 7, ri = (nrow >> 6) & 1, pp = nrow & 63;
        const int jj = k0 >> 4, h20 = k0 & 15, e = d == 0 ? 31 - jj : jj;
        const f32x2 l = lamk[(d * 64 + pp) * 33 + e];
        float v[8];
#pragma unroll
        for (int i = 0; i < 8; ++i) { const f32x2 b = Bb[(d * 64 + pp) * 16 + h20 + i]; v[i] = ri == 0 ? (l[0] * b[0] - l[1] * b[1]) : (l[0] * b[1] + l[1] * b[0]); }
        u32x2 o; o.x = pk4_fp8(v[0] * WIN_SCALE, v[1] * WIN_SCALE, v[2] * WIN_SCALE, v[3] * WIN_SCALE); o.y = pk4_fp8(v[4] * WIN_SCALE, v[5] * WIN_SCALE, v[6] * WIN_SCALE, v[7] * WIN_SCALE);
        *(u32x2*)((unsigned char*)p.Win() + ((size_t)(g * 256 + nrow) * 512 + k0)) = o;
    }
    __syncthreads();
}
__device__ __forceinline__ void ph_carry(const P& p) {
    int tid = threadIdx.x; asm volatile("" : "+v"(tid));
    if (tid >= 128) return;
    for (int gidx = blockIdx.x * 128 + tid; gidx < 32 * 8 * 2 * 64; gidx += gridDim.x * 128) {
        const int pp = gidx & 63, d = (gidx >> 6) & 1, b = (gidx >> 7) & 7, g = gidx >> 10;
        const f32x2 lt = *(const f32x2*)(p.lamT() + (size_t)((d * 32 + g) * 64 + pp) * 2);
        const float* Eg = p.E() + (size_t)g * SSM_ROWS * 256 + d * 128 + pp;
        unsigned char* Ug = (unsigned char*)p.U() + (size_t)g * SSM_ROWS * SSM_LD + 512 + d * 128 + pp;
        float fr = 0.f, fi = 0.f;
#pragma unroll
        for (int cc = 0; cc < 8; ++cc) {
            const int n = 1024 + b * 8 + (d == 0 ? cc : 7 - cc);
            const float er = Eg[(size_t)n * 256], ei = Eg[(size_t)n * 256 + 64];
            const float nr = lt[0] * fr - lt[1] * fi + er, ni = lt[0] * fi + lt[1] * fr + ei; fr = nr; fi = ni;
        }
#pragma unroll 1
        for (int c0 = 0; c0 < 128; c0 += 32) {
            float er[32], ei[32];
#pragma unroll
            for (int k = 0; k < 32; ++k) { const int n = b * 128 + (d == 0 ? c0 + k : 127 - c0 - k); er[k] = Eg[(size_t)n * 256]; ei[k] = Eg[(size_t)n * 256 + 64]; }
#pragma unroll
            for (int k = 0; k < 32; ++k) {
                const int n = b * 128 + (d == 0 ? c0 + k : 127 - c0 - k);
                { const unsigned w8 = pk4_fp8(fr, fi, 0.f, 0.f); Ug[(size_t)n * SSM_LD] = (unsigned char)(w8 & 255u); Ug[(size_t)n * SSM_LD + 64] = (unsigned char)((w8 >> 8) & 255u); }
                const float nr = lt[0] * fr - lt[1] * fi + er[k], ni = lt[0] * fi + lt[1] * fr + ei[k]; fr = nr; fi = ni;
            }
        }
    }
}


__device__ __forceinline__ void p0_transpose_item_fp8(const float* W, int K, int N, unsigned char* WT, float scale, LAS float* scr, int item, int lane) {
    const int nblk = N / 32, kb = item / nblk, nb = item % nblk, k0 = 64 * kb, n0 = 32 * nb;
#pragma unroll 8
    for (int i = 0; i < 32; ++i) { const int kk = 2 * i + (lane >> 5); scr[kk * 33 + (lane & 31)] = W[(size_t)(k0 + kk) * N + n0 + (lane & 31)]; }
    asm volatile("s_waitcnt lgkmcnt(0)" ::: "memory");
    const int c = lane & 7;
#pragma unroll
    for (int j = 0; j < 4; ++j) { const int n = (lane >> 3) + 8 * j; const LAS float* s = scr + (8 * c) * 33 + n;
        u32x2 o; o.x = pk4_fp8(s[0 * 33] * scale, s[1 * 33] * scale, s[2 * 33] * scale, s[3 * 33] * scale); o.y = pk4_fp8(s[4 * 33] * scale, s[5 * 33] * scale, s[6 * 33] * scale, s[7 * 33] * scale);
        *(u32x2*)(WT + (size_t)(n0 + n) * K + k0 + 8 * c) = o; }
    asm volatile("s_waitcnt lgkmcnt(0)" ::: "memory");
}
__device__ __forceinline__ void p0_transpose_item(const float* W, int K, int N, bf16_t* WT, LAS float* scr, int item, int lane) {
    const int nblk = N / 32, kb = item / nblk, nb = item % nblk, k0 = 64 * kb, n0 = 32 * nb;
#pragma unroll 8
    for (int i = 0; i < 32; ++i) { const int kk = 2 * i + (lane >> 5); scr[kk * 33 + (lane & 31)] = W[(size_t)(k0 + kk) * N + n0 + (lane & 31)]; }
    asm volatile("s_waitcnt lgkmcnt(0)" ::: "memory");
    const int c = lane & 7;
#pragma unroll
    for (int j = 0; j < 4; ++j) { const int n = (lane >> 3) + 8 * j; const LAS float* s = scr + (8 * c) * 33 + n;
        u32x4 o; o.x = pk2(s[0 * 33], s[1 * 33]); o.y = pk2(s[2 * 33], s[3 * 33]); o.z = pk2(s[4 * 33], s[5 * 33]); o.w = pk2(s[6 * 33], s[7 * 33]);
        *(u32x4*)(WT + (size_t)(n0 + n) * K + k0 + 8 * c) = o; }
    asm volatile("s_waitcnt lgkmcnt(0)" ::: "memory");
}

template <int NR, bool SILU>
__device__ __forceinline__ void gemv_block64(const float* const (&rows)[NR], const float* W, int ldw, int col0, const float* bias, float* y, int ldy, LAS float* scr) {
    const int wave = threadIdx.x >> 6, lane = threadIdx.x & 63;
    LAS float* act = scr + 8 * NR * 64;
#pragma unroll
    for (int r = 0; r < NR; ++r) for (int k = threadIdx.x; k < DM; k += NT) { const float s = rows[r][k]; act[r * DM + k] = SILU ? siluf_(s) : s; }
    __syncthreads();
    float acc[NR];
#pragma unroll
    for (int r = 0; r < NR; ++r) acc[r] = 0.f;
    const int kb = wave * 128;
#pragma unroll 32
    for (int k = kb; k < kb + 128; ++k) {
        const float w = W[(size_t)k * ldw + col0 + lane];
#pragma unroll
        for (int r = 0; r < NR; ++r) acc[r] += act[r * DM + k] * w;
    }
#pragma unroll
    for (int r = 0; r < NR; ++r) scr[(wave * NR + r) * 64 + lane] = acc[r];
    __syncthreads();
    for (int e = threadIdx.x; e < NR * 64; e += NT) {
        const int r = e >> 6, l = e & 63; float s = 0.f;
#pragma unroll
        for (int w = 0; w < 8; ++w) s += scr[(w * NR + r) * 64 + l];
        y[(size_t)r * ldy + col0 + l] = s + (bias ? bias[col0 + l] : 0.f);
    }
    __syncthreads();
}

__device__ __forceinline__ void ph_prep(const P& p, LAS unsigned char* lds) {
    int tid_ = threadIdx.x; asm volatile("" : "+v"(tid_));
    const int wave = tid_ >> 6, lane = tid_ & 63, G = gridDim.x;
    for (int cb = blockIdx.x; cb < 96; cb += G) {
        const float* const rows[9] = {p.c, p.c + DM, p.c + 2 * DM, p.c + 3 * DM, p.c + 4 * DM, p.c + 5 * DM, p.c + 6 * DM, p.c + 7 * DM, p.c_ctx};
        gemv_block64<9, true>(rows, p.w_mod, 6 * DM, cb * 64, p.b_mod, p.mod(), 6 * DM, (LAS float*)lds);
    }
    {
        LAS float* scr = (LAS float*)(lds + wave * 16384);
        const int gw = blockIdx.x * NWAVES + wave, NGW = G * NWAVES;
        constexpr int I_IN = (DM / 64) * (INC / 32), I_GLU = (512 / 64) * (512 / 32), I_A = (512 / 64) * (DM / 32), I_OUT = (DM / 64) * (DM / 32), I_Q = (DM / 64) * (2048 / 32);
        constexpr int NITEMS = I_IN + I_GLU + 2 * I_A + I_OUT;
        for (int it = gw; it < NITEMS; it += NGW) {
            int r = it;
            if (r < I_IN) { p0_transpose_item_fp8(p.w_in, DM, INC, (unsigned char*)p.w_in_t(), WIN_SCALE, scr, r, lane); continue; } r -= I_IN;
            if (r < I_GLU) { p0_transpose_item_fp8(p.w_glu, 512, 512, (unsigned char*)p.w_glu_t(), WIN_SCALE, scr, r, lane); continue; } r -= I_GLU;
            if (r < I_A) { p0_transpose_item_fp8(p.w_a, 512, DM, (unsigned char*)p.w_a_t(), WIN_SCALE, scr, r, lane); continue; } r -= I_A;
            if (r < I_A) { p0_transpose_item_fp8(p.w_b, 512, DM, (unsigned char*)p.w_b_t(), WIN_SCALE, scr, r, lane); continue; } r -= I_A;
            p0_transpose_item_fp8(p.w_out, DM, DM, (unsigned char*)p.w_out_t(), WIN_SCALE, scr, r - 0, lane);
        }
    }
}

__device__ __forceinline__ void bg_convert_tables(const P& p) {
    int tid_ = threadIdx.x; asm volatile("" : "+v"(tid_));
    const int lane = tid_ & 63;
    unsigned* head = p.queues() + 16 * 64;
    for (;;) {
        unsigned v = 0u; if (lane == 0) v = __hip_atomic_fetch_add(head, 32u, __ATOMIC_RELAXED, __HIP_MEMORY_SCOPE_AGENT);
        const int rg = (int)__builtin_amdgcn_readfirstlane(v);
        if (rg >= 2 * 16384) break;
#pragma unroll 1
      for (int r0 = rg; r0 < rg + 32; r0 += 4) {
        const bool second = r0 >= 16384; const int rr0 = second ? r0 - 16384 : r0;
        const float* src = (second ? p.peer_v : p.peer_u) + (size_t)rr0 * DM + lane * 16;
        unsigned char* dst = (second ? p.pv8() : p.pu8()) + (size_t)(lane >> 3) * (16384 * 128) + (size_t)rr0 * 128 + (lane & 7) * 16;
        f32x4 v4[4][4];
#pragma unroll
        for (int q = 0; q < 4; ++q)
#pragma unroll
            for (int j = 0; j < 4; ++j) v4[q][j] = *(const f32x4*)(src + q * DM + 4 * j);
        float inv = 1.f;
#pragma unroll
        for (int q = 0; q < 4; ++q) {
            float am = 0.f;
#pragma unroll
            for (int j = 0; j < 4; ++j) am = fmaxf(am, fmaxf(fmaxf(fabsf(v4[q][j][0]), fabsf(v4[q][j][1])), fmaxf(fabsf(v4[q][j][2]), fabsf(v4[q][j][3]))));
            am = wave_max(am);
            const float top = 6.f;
            const float sc = am > 0.f ? top / am : 1.f;
            if (second) {
                u32x2 o2;
#pragma unroll
                for (int jj = 0; jj < 2; ++jj) {
                    unsigned w = 0u;
                    w = __builtin_amdgcn_cvt_scalef32_pk_fp4_f32(w, v4[q][jj * 2][0] * sc, v4[q][jj * 2][1] * sc, 1.0f, 0);
                    w = __builtin_amdgcn_cvt_scalef32_pk_fp4_f32(w, v4[q][jj * 2][2] * sc, v4[q][jj * 2][3] * sc, 1.0f, 1);
                    w = __builtin_amdgcn_cvt_scalef32_pk_fp4_f32(w, v4[q][jj * 2 + 1][0] * sc, v4[q][jj * 2 + 1][1] * sc, 1.0f, 2);
                    w = __builtin_amdgcn_cvt_scalef32_pk_fp4_f32(w, v4[q][jj * 2 + 1][2] * sc, v4[q][jj * 2 + 1][3] * sc, 1.0f, 3);
                    o2[jj] = w;
                }
                *(u32x2*)(p.pv8() + (size_t)(lane >> 4) * (16384 * 128) + (size_t)(rr0 + q) * 128 + (lane & 15) * 8) = o2;
                inv = lane == q ? (am > 0.f ? am / top : 1.f) : inv;
            } else {
                float a16 = 0.f;
#pragma unroll
                for (int j = 0; j < 4; ++j) a16 = fmaxf(a16, fmaxf(fmaxf(fabsf(v4[q][j][0]), fabsf(v4[q][j][1])), fmaxf(fabsf(v4[q][j][2]), fabsf(v4[q][j][3]))));
                a16 = fmaxf(a16, dpp_f<DPP_XOR1>(a16)); a16 = fmaxf(a16, dpp_f<DPP_XOR2>(a16)); a16 = fmaxf(a16, dpp_f<DPP_HMIRROR>(a16)); a16 = fmaxf(a16, dpp_f<DPP_ROR8>(a16));
                const float s4 = a16 > 0.f ? 7.f / a16 : 1.f;
                u32x2 o2;
#pragma unroll
                for (int jj = 0; jj < 2; ++jj) {
                    unsigned w = 0u;
#pragma unroll
                    for (int k = 0; k < 8; ++k) { const float t = v4[q][jj * 2 + (k >> 2)][k & 3] * s4 + I8_MAGIC; w |= (__builtin_bit_cast(unsigned, t) & 15u) << (4 * k); }
                    o2[jj] = w;
                }
                *(u32x2*)(p.pu8() + (size_t)(lane >> 4) * (16384 * 128) + (size_t)(rr0 + q) * 128 + (lane & 15) * 8) = o2;
                if ((lane & 15) == 0) p.pisc_u()[(size_t)(rr0 + q) * 4 + (lane >> 4)] = a16 > 0.f ? a16 * (1.f / 7.f) : 1.f;
            }
        }
        if (second && lane < 4) p.pisc()[r0 + lane] = inv;
      }
    }
}

__device__ __forceinline__ void side_query_weights(const P& p, LAS unsigned char* lds, int wi, int W, int lane) {
    LAS float* scr = (LAS float*)(lds + 65536 + (wi % 6) * 8448);
#pragma unroll 1
    for (int it = wi; it < (DM / 64) * (2048 / 32); it += W) {
        const int kb = it >> 6, nb = it & 63, k0 = 64 * kb, n0 = 32 * nb;
#pragma unroll
        for (int i = 0; i < 32; ++i) { const int kk = 2 * i + (lane >> 5); scr[kk * 33 + (lane & 31)] = p.w_q[(size_t)(k0 + kk) * 2048 + n0 + (lane & 31)]; }
        asm volatile("s_waitcnt lgkmcnt(0)" ::: "memory");
        const int c = lane & 7;
        const f32x4 ga = *(const f32x4*)(p.norm2_g + k0 + 8 * c), gb = *(const f32x4*)(p.norm2_g + k0 + 8 * c + 4);
#pragma unroll 1
        for (int b = 0; b < 8; ++b) {
            const float* sc2 = p.mod() + (size_t)b * (6 * DM) + 4 * DM + k0 + 8 * c;
            const f32x4 sa = *(const f32x4*)sc2, sb = *(const f32x4*)(sc2 + 4);
            float m[8];
#pragma unroll
            for (int t = 0; t < 4; ++t) { m[t] = ga[t] * (1.f + sa[t]); m[4 + t] = gb[t] * (1.f + sb[t]); }
#pragma unroll
            for (int j = 0; j < 4; ++j) { const int n = (lane >> 3) + 8 * j; const LAS float* sv = scr + (8 * c) * 33 + n;
                u32x4 o; o.x = pg8::cvt_pk_bf16(sv[0 * 33] * m[0], sv[1 * 33] * m[1]); o.y = pg8::cvt_pk_bf16(sv[2 * 33] * m[2], sv[3 * 33] * m[3]);
                o.z = pg8::cvt_pk_bf16(sv[4 * 33] * m[4], sv[5 * 33] * m[5]); o.w = pg8::cvt_pk_bf16(sv[6 * 33] * m[6], sv[7 * 33] * m[7]);
                *(u32x4*)(p.wq_s() + ((size_t)(b * 2048 + n0 + n) * DM + k0 + 8 * c)) = o; }
        }
        asm volatile("s_waitcnt lgkmcnt(0)" ::: "memory");
    }
}

__device__ __forceinline__ void normmod_row_bf16(const float* src, bf16_t* dst, const float* g, const float* shift, const float* scale, int lane) {
    const f32x4* s = (const f32x4*)src;
    f32x4 v[4]; float ss = 0.f;
#pragma unroll
    for (int j = 0; j < 4; ++j) { v[j] = s[lane + 64 * j]; ss += v[j][0] * v[j][0] + v[j][1] * v[j][1] + v[j][2] * v[j][2] + v[j][3] * v[j][3]; }
    ss = wave_sum(ss);
    const float rstd = rsqrtf(ss * (1.f / DM) + EPSN);
#pragma unroll
    for (int j = 0; j < 4; ++j) {
        const int i4 = lane + 64 * j;
        const f32x4 gg = ((const f32x4*)g)[i4], sh = ((const f32x4*)shift)[i4], sc = ((const f32x4*)scale)[i4];
        const f32x4 o = v[j] * rstd * gg * (sc + 1.f) + sh;
        *(unsigned*)((unsigned char*)dst + (size_t)i4 * 4) = pk4_fp8(o[0], o[1], o[2], o[3]);
    }
}
__device__ __forceinline__ void ph_norm1(const P& p, LAS unsigned char* lds) {
    int tid_ = threadIdx.x; asm volatile("" : "+v"(tid_));
    const int wave = tid_ >> 6, lane = tid_ & 63, G = gridDim.x;
    const int gw = blockIdx.x * NWAVES + __builtin_amdgcn_readfirstlane(wave), NGW = G * NWAVES;
    for (int r4 = gw; r4 < NTOK / 4; r4 += NGW) {
        const int r = r4 * 4;
        const f32x4* s = (const f32x4*)(p.x + (size_t)r * DM);
        f32x4 v[4][4];
#pragma unroll
        for (int k = 0; k < 4; ++k)
#pragma unroll
            for (int j = 0; j < 4; ++j) v[k][j] = s[k * (DM / 4) + lane + 64 * j];
        const float* modb = p.mod() + (size_t)(r >> 12) * (6 * DM);
#pragma unroll
        for (int k = 0; k < 4; ++k) {
            float ss = 0.f;
#pragma unroll
            for (int j = 0; j < 4; ++j) ss += v[k][j][0] * v[k][j][0] + v[k][j][1] * v[k][j][1] + v[k][j][2] * v[k][j][2] + v[k][j][3] * v[k][j][3];
            ss = wave_sum(ss);
            const float rstd = rsqrtf(ss * (1.f / DM) + EPSN);
            unsigned char* dst = (unsigned char*)p.hx() + (size_t)(r + k) * DM;
#pragma unroll
            for (int j = 0; j < 4; ++j) {
                const int i4 = lane + 64 * j;
                const f32x4 gg = ((const f32x4*)p.norm1_g)[i4], sh = ((const f32x4*)modb)[i4], sc = ((const f32x4*)(modb + DM))[i4];
                const f32x4 o = v[k][j] * rstd * gg * (sc + 1.f) + sh;
                *(unsigned*)(dst + (size_t)i4 * 4) = pk4_fp8(o[0], o[1], o[2], o[3]);
            }
        }
    }
    for (int rc = gw; rc < NCTX; rc += NGW) { const float* modc = p.mod() + 8 * (6 * DM); normmod_row_bf16(p.ctx + (size_t)rc * DM, (bf16_t*)((unsigned char*)p.hc() + (size_t)rc * DM), p.norm1_g, modc, modc + DM, lane); }
}

constexpr int RPB_LD = 128, RPB_PAD = 48;
__device__ __forceinline__ void ph_na(const P& p, LAS unsigned char* lds) {
    int tid_ = threadIdx.x; asm volatile("" : "+v"(tid_));
    const int tid = tid_, h = __builtin_amdgcn_readfirstlane(tid >> 6), lane = tid & 63, lt = lane & 15, lq = lane >> 4;
    constexpr float LOG2E = 1.4426950408889634f, CS = 0.125f * LOG2E / (ACT8 * ACT8);
    LAS float* rp = (LAS float*)lds;
    for (int e = tid; e < 8 * 15 * RPB_LD; e += NT) { const int c = (e & (RPB_LD - 1)) - RPB_PAD; rp[e] = (c >= 0 && c < 31) ? p.rpb[(e / RPB_LD) * 31 + c] * LOG2E : 0.f; }
    __syncthreads();
    const int pa = (lt >> 2) * 8 + (lt & 3);
    const unsigned lane_k = pa * 512 + lq * 8, lane_v = lt * 64 + lq * 8, lane_q = lt * 512 + lq * 8, lane_o = lt * 512 + lq * 4;
    for (int item = blockIdx.x; item < NB * GW; item += gridDim.x) {
        const int b = item >> 6, r = item & 63;
        int r0 = r - 4; r0 = r0 < 0 ? 0 : (r0 > 56 ? 56 : r0);
        const unsigned char* Kb = (const unsigned char*)p.kb() + ((size_t)b * SEQL + (size_t)r0 * GW) * 512 + h * 64;
        const unsigned char* Kc = (const unsigned char*)p.kc() + ((size_t)b * CTXL) * 512 + h * 64;
        const unsigned char* Vt = (const unsigned char*)p.vT() + ((size_t)((b * 8 + h) * 64 + r0)) * 4096;
        const unsigned char* Vc = (const unsigned char*)p.vcT() + ((size_t)((b * 8 + h) * 4)) * 4096;
        const unsigned char* Qb = (const unsigned char*)p.qb() + ((size_t)b * SEQL + r * GW) * 512 + h * 64;
        unsigned char* Ob = (unsigned char*)p.na() + ((size_t)b * SEQL + r * GW) * 512 + h * 64;
        const LAS float* rph = rp + (h * 15 + (r0 - r + 7)) * RPB_LD;
        long qf[4][2];
#pragma unroll
        for (int qt = 0; qt < 4; ++qt) { qf[qt][0] = *(const long*)(Qb + qt * 16 * 512 + lane_q); qf[qt][1] = *(const long*)(Qb + qt * 16 * 512 + 32 + lane_q); }
        f32x4 o[4][4]; float m[4], l[4];
#pragma unroll
        for (int qt = 0; qt < 4; ++qt) { m[qt] = -1e30f; l[qt] = 0.f;
#pragma unroll
            for (int d = 0; d < 4; ++d) o[qt][d] = (f32x4){0.f, 0.f, 0.f, 0.f}; }
        long kf[2][2][2];
#pragma unroll
        for (int st = 0; st < 2; ++st)
#pragma unroll
            for (int ab = 0; ab < 2; ++ab) { kf[st][ab][0] = *(const long*)(Kb + (st * 32 + ab * 4) * 512 + lane_k); kf[st][ab][1] = *(const long*)(Kb + (st * 32 + ab * 4) * 512 + 32 + lane_k); }
#pragma unroll 1
        for (int i = 0; i < 8; ++i) {
            long vf[2][4];
#pragma unroll
            for (int st = 0; st < 2; ++st)
#pragma unroll
                for (int d = 0; d < 4; ++d) vf[st][d] = *(const long*)(Vt + i * 4096 + d * 1024 + st * 32 + lane_v);
            const LAS float* rr_ = rph + i * RPB_LD;
#pragma unroll
            for (int half = 0; half < 2; ++half) {
                f32x4 s[2][2][2];
#pragma unroll
                for (int q2 = 0; q2 < 2; ++q2) {
                    const int qt = half * 2 + q2;
#pragma unroll
                    for (int st = 0; st < 2; ++st) {
                        if ((st == 0 && qt == 3) || (st == 1 && qt == 0)) continue;
#pragma unroll
                        for (int ab = 0; ab < 2; ++ab) {
                            f32x4 c = {0.f, 0.f, 0.f, 0.f};
                            c = __builtin_amdgcn_mfma_f32_16x16x32_fp8_fp8(kf[st][ab][0], qf[qt][0], c, 0, 0, 0);
                            c = __builtin_amdgcn_mfma_f32_16x16x32_fp8_fp8(kf[st][ab][1], qf[qt][1], c, 0, 0, 0);
                            s[q2][st][ab] = c;
                        }
                    }
                }
                if (half == 1) {
                    if (i < 7) {
#pragma unroll
                        for (int st = 0; st < 2; ++st)
#pragma unroll
                            for (int ab = 0; ab < 2; ++ab) { const unsigned char* kp = Kb + ((i + 1) * GW + st * 32 + ab * 4) * 512; kf[st][ab][0] = *(const long*)(kp + lane_k); kf[st][ab][1] = *(const long*)(kp + 32 + lane_k); }
                    } else {
#pragma unroll
                        for (int ab = 0; ab < 2; ++ab) { kf[0][ab][0] = *(const long*)(Kc + ab * 4 * 512 + lane_k); kf[0][ab][1] = *(const long*)(Kc + ab * 4 * 512 + 32 + lane_k); }
                    }
                }
#pragma unroll
                for (int q2 = 0; q2 < 2; ++q2) {
                    const int qt = half * 2 + q2;
                    const int qc = qt * 16 + lt; int c0 = qc - 8; c0 = c0 < 0 ? 0 : (c0 > 48 ? 48 : c0);
                    int wo = lq * 8 - c0; asm volatile("" : "+v"(wo));
                    float mx = -1e30f;
#pragma unroll
                    for (int st = 0; st < 2; ++st) {
                        if ((st == 0 && qt == 3) || (st == 1 && qt == 0)) continue;
                        const int kc0 = st * 32 + lq * 8, bbase = kc0 - qc + 15 + RPB_PAD;
#pragma unroll
                        for (int j = 0; j < 8; ++j) {
                            float t = s[q2][st][j >> 2][j & 3] * CS + rr_[bbase + j];
                            t = ((unsigned)(wo + st * 32 + j) < 16u) ? t : -1e30f;
                            s[q2][st][j >> 2][j & 3] = t; mx = fmaxf(mx, t);
                        }
                    }
                    mx = fmaxf(mx, __shfl_xor(mx, 16)); mx = fmaxf(mx, __shfl_xor(mx, 32));
                    const float mn = fmaxf(m[qt], mx), corr = __builtin_amdgcn_exp2f(m[qt] - mn);
                    m[qt] = mn; float ls = l[qt] * corr; const float mn6 = mn - 6.f;
#pragma unroll
                    for (int d = 0; d < 4; ++d) o[qt][d] = o[qt][d] * corr;
#pragma unroll
                    for (int st = 0; st < 2; ++st) {
                        if ((st == 0 && qt == 3) || (st == 1 && qt == 0)) continue;
                        float pe[8];
#pragma unroll
                        for (int j = 0; j < 8; ++j) pe[j] = __builtin_amdgcn_exp2f(s[q2][st][j >> 2][j & 3] - mn6);
                        ls += ((pe[0] + pe[1]) + (pe[2] + pe[3])) + ((pe[4] + pe[5]) + (pe[6] + pe[7]));
                        const long pf = (long)(((unsigned long)pk4_fp8(pe[4], pe[5], pe[6], pe[7]) << 32) | (unsigned long)pk4_fp8(pe[0], pe[1], pe[2], pe[3]));
#pragma unroll
                        for (int d = 0; d < 4; ++d) o[qt][d] = __builtin_amdgcn_mfma_f32_16x16x32_fp8_fp8(vf[st][d], pf, o[qt][d], 0, 0, 0);
                    }
                    l[qt] = ls;
                }
            }
        }
#pragma unroll 1
        for (int cst = 0; cst < 8; ++cst) {
            long vf[4];
#pragma unroll
            for (int d = 0; d < 4; ++d) vf[d] = *(const long*)(Vc + (cst >> 1) * 4096 + d * 1024 + (cst & 1) * 32 + lane_v);
            f32x4 s[4][2];
#pragma unroll
            for (int qt = 0; qt < 4; ++qt)
#pragma unroll
                for (int ab = 0; ab < 2; ++ab) {
                    f32x4 c = {0.f, 0.f, 0.f, 0.f};
                    c = __builtin_amdgcn_mfma_f32_16x16x32_fp8_fp8(kf[0][ab][0], qf[qt][0], c, 0, 0, 0);
                    c = __builtin_amdgcn_mfma_f32_16x16x32_fp8_fp8(kf[0][ab][1], qf[qt][1], c, 0, 0, 0);
                    s[qt][ab] = c;
                }
            if (cst < 7) {
#pragma unroll
                for (int ab = 0; ab < 2; ++ab) { const unsigned char* kp = Kc + ((cst + 1) * 32 + ab * 4) * 512; kf[0][ab][0] = *(const long*)(kp + lane_k); kf[0][ab][1] = *(const long*)(kp + 32 + lane_k); }
            }
#pragma unroll
            for (int qt = 0; qt < 4; ++qt) {
                float mx = -1e30f;
#pragma unroll
                for (int j = 0; j < 8; ++j) { const float t = s[qt][j >> 2][j & 3] * CS; s[qt][j >> 2][j & 3] = t; mx = fmaxf(mx, t); }
                mx = fmaxf(mx, __shfl_xor(mx, 16)); mx = fmaxf(mx, __shfl_xor(mx, 32));
                const float mn = fmaxf(m[qt], mx), corr = __builtin_amdgcn_exp2f(m[qt] - mn);
                m[qt] = mn; const float mn6 = mn - 6.f;
#pragma unroll
                for (int d = 0; d < 4; ++d) o[qt][d] = o[qt][d] * corr;
                float pe[8];
#pragma unroll
                for (int j = 0; j < 8; ++j) pe[j] = __builtin_amdgcn_exp2f(s[qt][j >> 2][j & 3] - mn6);
                l[qt] = l[qt] * corr + (((pe[0] + pe[1]) + (pe[2] + pe[3])) + ((pe[4] + pe[5]) + (pe[6] + pe[7])));
                const long pf = (long)(((unsigned long)pk4_fp8(pe[4], pe[5], pe[6], pe[7]) << 32) | (unsigned long)pk4_fp8(pe[0], pe[1], pe[2], pe[3]));
#pragma unroll
                for (int d = 0; d < 4; ++d) o[qt][d] = __builtin_amdgcn_mfma_f32_16x16x32_fp8_fp8(vf[d], pf, o[qt][d], 0, 0, 0);
            }
        }
#pragma unroll
        for (int qt = 0; qt < 4; ++qt) {
            float lv = l[qt]; lv += __shfl_xor(lv, 16); lv += __shfl_xor(lv, 32);
            const float inv = frcp(lv);
            const float inv8 = inv * (ACT8 / 8.f);
            unsigned char* op = Ob + qt * 16 * 512 + lane_o;
#pragma unroll
            for (int d = 0; d < 4; ++d) *(unsigned*)(op + d * 16) = pk4_fp8(o[qt][d][0] * inv8, o[qt][d][1] * inv8, o[qt][d][2] * inv8, o[qt][d][3] * inv8);
        }
    }
}

typedef __bf16 bf16x2_t __attribute__((ext_vector_type(2)));
__device__ __forceinline__ float dot2bf(unsigned a, unsigned b, float c) { return __builtin_amdgcn_fdot2_f32_bf16(__builtin_bit_cast(bf16x2_t, a), __builtin_bit_cast(bf16x2_t, b), c, false); }
__device__ __forceinline__ unsigned ordkey(float f) { unsigned u = __builtin_bit_cast(unsigned, f); return u ^ ((unsigned)((int)u >> 31) | 0x80000000u); }
__device__ __forceinline__ float unordkey(unsigned k) { return __builtin_bit_cast(float, k ^ ((k & 0x80000000u) ? 0x80000000u : 0xFFFFFFFFu)); }
__device__ __forceinline__ float kmax(float a, float b) { float r; asm("v_max_f32 %0, %1, %2" : "=v"(r) : "v"(a), "v"(b)); return r; }
__device__ __forceinline__ float kmin(float a, float b) { float r; asm("v_min_f32 %0, %1, %2" : "=v"(r) : "v"(a), "v"(b)); return r; }
template <bool DESC> __device__ __forceinline__ void cex(float& a, float& b) { const float mx = kmax(a, b), mn = kmin(a, b); if (DESC) { a = mx; b = mn; } else { a = mn; b = mx; } }
__device__ __forceinline__ void sort16_desc(float (&a)[16]) {
    cex<true>(a[0], a[13]); cex<true>(a[1], a[12]); cex<true>(a[2], a[15]); cex<true>(a[3], a[14]); cex<true>(a[4], a[8]); cex<true>(a[5], a[6]); cex<true>(a[7], a[11]); cex<true>(a[9], a[10]); cex<true>(a[0], a[5]); cex<true>(a[1], a[7]); cex<true>(a[2], a[9]); cex<true>(a[3], a[4]); cex<true>(a[6], a[13]); cex<true>(a[8], a[14]); cex<true>(a[10], a[15]); cex<true>(a[11], a[12]); cex<true>(a[0], a[1]); cex<true>(a[2], a[3]); cex<true>(a[4], a[5]); cex<true>(a[6], a[8]); cex<true>(a[7], a[9]); cex<true>(a[10], a[11]); cex<true>(a[12], a[13]); cex<true>(a[14], a[15]); cex<true>(a[0], a[2]); cex<true>(a[1], a[3]); cex<true>(a[4], a[10]); cex<true>(a[5], a[11]); cex<true>(a[6], a[7]); cex<true>(a[8], a[9]); cex<true>(a[12], a[14]); cex<true>(a[13], a[15]); cex<true>(a[1], a[2]); cex<true>(a[3], a[12]); cex<true>(a[4], a[6]); cex<true>(a[5], a[7]); cex<true>(a[8], a[10]); cex<true>(a[9], a[11]); cex<true>(a[13], a[14]); cex<true>(a[1], a[4]); cex<true>(a[2], a[6]); cex<true>(a[5], a[8]); cex<true>(a[7], a[10]); cex<true>(a[9], a[13]); cex<true>(a[11], a[14]); cex<true>(a[2], a[4]); cex<true>(a[3], a[6]); cex<true>(a[9], a[12]); cex<true>(a[11], a[13]); cex<true>(a[3], a[5]); cex<true>(a[6], a[8]); cex<true>(a[7], a[9]); cex<true>(a[10], a[12]); cex<true>(a[3], a[4]); cex<true>(a[5], a[6]); cex<true>(a[7], a[8]); cex<true>(a[9], a[10]); cex<true>(a[11], a[12]); cex<true>(a[6], a[7]); cex<true>(a[8], a[9]);
}
__device__ __forceinline__ void merge16_desc(float (&a)[16]) {
#pragma unroll
    for (int j = 8; j > 0; j >>= 1)
#pragma unroll
        for (int i = 0; i < 16; ++i) { const int l = i ^ j; if (l > i) cex<true>(a[i], a[l]); }
}
__device__ __forceinline__ void top16_merge(float (&a)[16], const float (&b)[16]) {
#pragma unroll
    for (int i = 0; i < 16; ++i) a[i] = kmax(a[i], b[15 - i]);
    merge16_desc(a);
}
__device__ __forceinline__ unsigned kbits(float k) { return __builtin_bit_cast(unsigned, k); }
__device__ __forceinline__ float kscore(float k) { return __builtin_bit_cast(float, __builtin_bit_cast(unsigned, k) & ~127u); }
struct PairTab { int i[52], j[52], n; };
constexpr PairTab make_pairs() { PairTab t{}; int n = 0; for (int i = 0; i < 16; ++i) for (int j = 0; j < 16; ++j) if ((i + 1) * (j + 1) <= 16) { t.i[n] = i; t.j[n] = j; ++n; } t.n = n; for (int k = n; k < 52; ++k) { t.i[k] = 0; t.j[k] = 0; } return t; }
constexpr PairTab PAIRS = make_pairs();
static_assert(PAIRS.n == 50, "50 candidate pairs");

constexpr int SK_LD = 136;
__device__ __forceinline__ void ph_peer_topk(const P& p, LAS unsigned char* lds) {
    int tid_ = threadIdx.x; asm volatile("" : "+v"(tid_));
    const int tid = tid_, wave = tid >> 6, lane = tid & 63;
    LAS bf16_t* sk = (LAS bf16_t*)lds;
    for (int e = tid; e < 2 * 128 * 16; e += NT) {
        const int row = e >> 4, c8 = (e & 15) * 8;
        const f32x4 a = *(const f32x4*)(p.subkeys + (size_t)row * 128 + c8), b = *(const f32x4*)(p.subkeys + (size_t)row * 128 + c8 + 4);
        u32x4 o; o.x = pk2(a[0], a[1]); o.y = pk2(a[2], a[3]); o.z = pk2(b[0], b[1]); o.w = pk2(b[2], b[3]);
        *(LAS u32x4*)(sk + row * SK_LD + c8) = o;
    }
    __syncthreads();
    const int lt = lane & 15, lq = lane >> 4;
    for (int tile = blockIdx.x * NWAVES + wave; tile < NTOK / 16; tile += gridDim.x * NWAVES) {
        const int tok = tile * 16 + lt;
        const bf16_t* qrow = p.qp() + (size_t)tok * 2048;
        for (int h = 0; h < 8; ++h) {
            float s0[16], s1[16];
#pragma unroll
            for (int n = 0; n < 2; ++n) {
                bf16x8 bq[4];
#pragma unroll
                for (int ks = 0; ks < 4; ++ks) bq[ks] = *(const bf16x8*)(qrow + h * 256 + n * 128 + ks * 32 + lq * 8);
                float a[16], b[16];
#pragma unroll
                for (int kb = 0; kb < 8; ++kb) {
                    f32x4 c = {0.f, 0.f, 0.f, 0.f};
#pragma unroll
                    for (int ks = 0; ks < 4; ++ks) {
                        const bf16x8 ak = *(const LAS bf16x8*)(sk + (n * 128 + kb * 16 + lt) * SK_LD + ks * 32 + lq * 8);
                        c = __builtin_amdgcn_mfma_f32_16x16x32_bf16(ak, bq[ks], c, 0, 0, 0);
                    }
#pragma unroll
                    for (int r = 0; r < 4; ++r) {
                        const float cr = c[r];
                        const float key = __builtin_bit_cast(float, (__builtin_bit_cast(unsigned, cr) & ~127u) | (unsigned)(kb * 16 + lq * 4 + r));
                        if (kb < 4) a[kb * 4 + r] = key; else b[(kb - 4) * 4 + r] = key;
                    }
                    asm volatile("" ::: "memory");
                }
                sort16_desc(a); sort16_desc(b);
                top16_merge(a, b);
#pragma unroll
                for (int i = 0; i < 16; ++i) b[i] = __shfl_xor(a[i], 16);
                top16_merge(a, b);
#pragma unroll
                for (int i = 0; i < 16; ++i) b[i] = __shfl_xor(a[i], 32);
                top16_merge(a, b);
                if (n == 0) {
#pragma unroll
                    for (int i = 0; i < 16; ++i) s0[i] = a[i];
                } else {
#pragma unroll
                    for (int i = 0; i < 16; ++i) s1[i] = a[i];
                }
            }
            float ck[16], cs[13]; unsigned ce_[13];
#pragma unroll
            for (int s = 0; s < 13; ++s) {
                const float k0 = lq == 0 ? s0[PAIRS.i[s * 4]] : (lq == 1 ? s0[PAIRS.i[s * 4 + 1]] : (lq == 2 ? s0[PAIRS.i[s * 4 + 2]] : s0[PAIRS.i[s * 4 + 3]]));
                const float k1 = lq == 0 ? s1[PAIRS.j[s * 4]] : (lq == 1 ? s1[PAIRS.j[s * 4 + 1]] : (lq == 2 ? s1[PAIRS.j[s * 4 + 2]] : s1[PAIRS.j[s * 4 + 3]]));
                const float sum = kscore(k0) + kscore(k1);
                const bool valid = (s * 4 + lq) < PAIRS.n;
                cs[s] = sum; ce_[s] = (kbits(k0) & 127u) * 128u + (kbits(k1) & 127u);
                ck[s] = valid ? __builtin_bit_cast(float, (__builtin_bit_cast(unsigned, sum) & ~63u) | (unsigned)(s * 4 + lq)) : -__builtin_inff();
            }
            ck[13] = -__builtin_inff(); ck[14] = -__builtin_inff(); ck[15] = -__builtin_inff();
            float srt[16], ob[16];
#pragma unroll
            for (int i = 0; i < 16; ++i) srt[i] = ck[i];
            sort16_desc(srt);
#pragma unroll
            for (int i = 0; i < 16; ++i) ob[i] = __shfl_xor(srt[i], 16);
            top16_merge(srt, ob);
#pragma unroll
            for (int i = 0; i < 16; ++i) ob[i] = __shfl_xor(srt[i], 32);
            float thr = __builtin_inff();
#pragma unroll
            for (int i = 0; i < 16; ++i) thr = kmin(thr, kmax(srt[i], ob[15 - i]));
            const float mtop = kscore(s0[0]) + kscore(s1[0]);
            float zp = 0.f; int cnt = 0;
#pragma unroll
            for (int s = 0; s < 13; ++s) { const bool sel = ck[s] >= thr; const float e = sel ? __expf(cs[s] - mtop) : 0.f; cs[s] = e; zp += e; cnt += sel ? 1 : 0; }
            float z = zp; z += __shfl_xor(z, 16); z += __shfl_xor(z, 32);
            const float rz = frcp(z);
            const int c0 = __shfl(cnt, lt), c1 = __shfl(cnt, lt + 16), c2 = __shfl(cnt, lt + 32);
            int pos = lq == 0 ? 0 : (lq == 1 ? c0 : (lq == 2 ? c0 + c1 : c0 + c1 + c2));
            unsigned short* dste = (unsigned short*)p.topk() + ((size_t)tok * 8 + h) * 16; float* dstg = p.gates() + ((size_t)tok * 8 + h) * 16;
#pragma unroll
            for (int s = 0; s < 13; ++s) {
                const bool sel = ck[s] >= thr;
                if (sel) { dste[pos] = (unsigned short)ce_[s]; dstg[pos] = cs[s] * rz; ++pos; }
            }
        }
    }
}

__device__ __forceinline__ unsigned xcc_id() { return (unsigned)__builtin_amdgcn_s_getreg((3 << 11) | 20) & 7u; }
__device__ __forceinline__ int q_grab(unsigned* head, int lane) { unsigned v = 0u; if (lane == 0) v = __hip_atomic_fetch_add(head, 16u, __ATOMIC_RELAXED, __HIP_MEMORY_SCOPE_AGENT); return (int)__builtin_amdgcn_readfirstlane(v); }

__device__ __forceinline__ void g_ids(const unsigned short* tkrow, unsigned lo_g16, u32x4 (&ids)[2]) {
#pragma unroll
    for (int q = 0; q < 2; ++q) ids[q] = *(const u32x4*)(tkrow + lo_g16 + q * 8);
}
__device__ __forceinline__ void g_wts(const float* wrow, unsigned lo_g16, u32x4 (&wts)[4]) {
#pragma unroll
    for (int q = 0; q < 4; ++q) wts[q] = *(const u32x4*)(wrow + lo_g16 + q * 4);
}
__device__ __forceinline__ void g_rows8(const unsigned char* tb, unsigned lo_c16, const u32x4& idh, u32x4 (&rows)[8]) {
#pragma unroll
    for (int i = 0; i < 8; ++i) {
        const unsigned w = idh[i >> 1];
        unsigned off; const unsigned k128 = 128u;
        if (i & 1) asm("v_mad_u32_u16 %0, %1, %2, %3 op_sel:[1,0,0,0]" : "=v"(off) : "v"(w), "s"(k128), "v"(lo_c16));
        else asm("v_mad_u32_u16 %0, %1, %2, %3" : "=v"(off) : "v"(w), "s"(k128), "v"(lo_c16));
        rows[i] = *(const u32x4*)(tb + off);
    }
}
typedef _Float16 f16x2 __attribute__((ext_vector_type(2)));
__device__ __forceinline__ void g_dots8_i4(const u32x4 (&uu)[8], const unsigned (&hqh)[4], const unsigned (&hql)[4], int* pd) {
#pragma unroll
    for (int i = 0; i < 8; ++i) {
        int dh = 0, dl = 0;
#pragma unroll
        for (int j = 0; j < 4; ++j) { dh = __builtin_amdgcn_sdot8((int)uu[i][j], (int)hqh[j], dh, false); dl = __builtin_amdgcn_sdot8((int)uu[i][j], (int)hql[j], dl, false); }
        pd[i] = dh * 16 + dl;
    }
}
__device__ __forceinline__ void halve16_c8(const int (&v)[16], int b4, int b2, int b1, int& o0, int& o1) {
    int r8[8], r4[4];
#pragma unroll
    for (int i = 0; i < 8; ++i) { const int keep = b4 ? v[i + 8] : v[i], send = b4 ? v[i] : v[i + 8]; r8[i] = keep + dpp_i<DPP_HMIRROR>(send); }
#pragma unroll
    for (int i = 0; i < 4; ++i) { const int keep = b2 ? r8[i + 4] : r8[i], send = b2 ? r8[i] : r8[i + 4]; r4[i] = keep + dpp_i<DPP_XOR2>(send); }
    { const int keep = b1 ? r4[2] : r4[0], send = b1 ? r4[0] : r4[2]; o0 = keep + dpp_i<DPP_XOR1>(send); }
    { const int keep = b1 ? r4[3] : r4[1], send = b1 ? r4[1] : r4[3]; o1 = keep + dpp_i<DPP_XOR1>(send); }
}
template <bool FIRST>
__device__ __forceinline__ void g_acc8q(const u32x4 (&vv)[8], const u32x4& w0, const u32x4& w1, f16x2 (&acc)[16]) {
#pragma unroll
    for (int i = 0; i < 8; ++i) {
        const unsigned wu = i < 4 ? w0[i & 3] : w1[i & 3];
        const f16x2 w = __builtin_bit_cast(f16x2, wu);
#pragma unroll
        for (int j = 0; j < 4; ++j) {
            const unsigned wv = vv[i][j];
            const f16x2 v0 = __builtin_bit_cast(f16x2, __builtin_amdgcn_cvt_scalef32_pk_f16_fp4(wv, 0.00390625f, 0)), v1 = __builtin_bit_cast(f16x2, __builtin_amdgcn_cvt_scalef32_pk_f16_fp4(wv, 0.00390625f, 1));
            const f16x2 v2 = __builtin_bit_cast(f16x2, __builtin_amdgcn_cvt_scalef32_pk_f16_fp4(wv, 0.00390625f, 2)), v3 = __builtin_bit_cast(f16x2, __builtin_amdgcn_cvt_scalef32_pk_f16_fp4(wv, 0.00390625f, 3));
            if (FIRST && i == 0) { acc[j * 4 + 0] = v0 * w; acc[j * 4 + 1] = v1 * w; acc[j * 4 + 2] = v2 * w; acc[j * 4 + 3] = v3 * w; }
            else { acc[j * 4 + 0] = __builtin_elementwise_fma(v0, w, acc[j * 4 + 0]); acc[j * 4 + 1] = __builtin_elementwise_fma(v1, w, acc[j * 4 + 1]);
                   acc[j * 4 + 2] = __builtin_elementwise_fma(v2, w, acc[j * 4 + 2]); acc[j * 4 + 3] = __builtin_elementwise_fma(v3, w, acc[j * 4 + 3]); }
        }
    }
}
__device__ __forceinline__ void halve16h(const f16x2 (&v)[16], int b1, f16x2& o0, f16x2& o1) {
    f16x2 r8[8], r4[4];
#pragma unroll
    for (int i = 0; i < 8; ++i) { const u32x2 sw = __builtin_amdgcn_permlane32_swap(__builtin_bit_cast(unsigned, v[i]), __builtin_bit_cast(unsigned, v[i + 8]), false, false);
        const unsigned s0 = sw[0], s1 = sw[1];
        r8[i] = __builtin_bit_cast(f16x2, s0) + __builtin_bit_cast(f16x2, s1); }
#pragma unroll
    for (int i = 0; i < 4; ++i) { const u32x2 sw = __builtin_amdgcn_permlane16_swap(__builtin_bit_cast(unsigned, r8[i]), __builtin_bit_cast(unsigned, r8[i + 4]), false, false);
        const unsigned s0 = sw[0], s1 = sw[1];
        r4[i] = __builtin_bit_cast(f16x2, s0) + __builtin_bit_cast(f16x2, s1); }
#pragma unroll
    for (int i = 0; i < 2; ++i) {
        const unsigned keep = __builtin_bit_cast(unsigned, b1 ? r4[i + 2] : r4[i]), send = __builtin_bit_cast(unsigned, b1 ? r4[i] : r4[i + 2]);
        const f16x2 r = __builtin_bit_cast(f16x2, keep) + __builtin_bit_cast(f16x2, (unsigned)__builtin_amdgcn_update_dpp(0, (int)send, 0x128, 0xf, 0xf, true));
        if (i == 0) o0 = r; else o1 = r;
    }
}

typedef int i32x2 __attribute__((ext_vector_type(2)));
using pg8::i32x4; using pg8::i32x8;
constexpr float G2_WS = 128.f;
template <int WHICH>
__device__ __forceinline__ void ph_gather_sliced(const P& p, LAS unsigned char* lds) {
    int tid_ = threadIdx.x; asm volatile("" : "+v"(tid_));
    const int lane = tid_ & 63, c = lane & 7, g = lane >> 3;
    LAS unsigned char* wlds = lds + __builtin_amdgcn_readfirstlane(tid_ >> 6) * 8192;
    const unsigned xs = xcc_id();
    constexpr int NSL = 4, SLW = DM / NSL;
    for (unsigned tr = 0; tr < NSL; ++tr) {
        const int sl = (int)((xs + tr) & (unsigned)(NSL - 1));
        unsigned* head = p.queues() + (WHICH * 8 + sl) * 64;
        const unsigned char* tb = (WHICH == 0 ? p.pu8() : p.pv8()) + (size_t)sl * (16384 * 128);
        for (;;) {
            const int t0 = q_grab(head, lane);
            if (t0 >= NTOK) break;
            unsigned oc = c * 16, og = g * 16; asm volatile("" : "+v"(oc), "+v"(og));
            const unsigned short* idb = (const unsigned short*)p.topk() + (size_t)t0 * 128;
            const float* wb = p.wl() + (size_t)t0 * 128;
            const float* modb = p.mod() + (size_t)(t0 >> 12) * (6 * DM) + sl * SLW;
            u32x4 idc[2], idn[2], RA[8], RB[8], wc[4];
            g_ids(idb, og, idc);
            g_rows8(tb, oc, idc[0], RA);
            if (WHICH == 0) {
                g_rows8(tb, oc, idc[1], RB); g_ids(idb + 128, og, idn);
                {
                    unsigned l4 = lane * 4; asm volatile("" : "+v"(l4));
                    const bf16_t* xg = p.x1b() + (size_t)t0 * DM + sl * SLW;
                    f32x4 A, Bs;
                    { const f32x4 gg = *(const f32x4*)(p.norm2_g + sl * SLW + l4), sh = *(const f32x4*)(modb + 3 * DM + l4), sc = *(const f32x4*)(modb + 4 * DM + l4);
#pragma unroll
                      for (int i = 0; i < 4; ++i) { A[i] = gg[i] * (1.f + sc[i]); Bs[i] = sh[i]; } }
                    const float rsl = rstd_from_fix(p.rowss()[t0 + (lane & 15)]);
                    {
                        u32x2 xw[16];
#pragma unroll
                        for (int k = 0; k < 16; ++k) xw[k] = *(const u32x2*)(xg + (size_t)k * DM + l4);
#pragma unroll
                        for (int k = 0; k < 16; ++k) {
                            const int tk = k;
                            const float rstd = __builtin_bit_cast(float, __builtin_amdgcn_readlane(__builtin_bit_cast(unsigned, rsl), tk));
                            float h[4], am = 0.f;
                            const unsigned x01 = xw[k][0], x23 = xw[k][1];
                            const float xf[4] = {bflo(x01), bfhi(x01), bflo(x23), bfhi(x23)};
#pragma unroll
                            for (int i = 0; i < 4; ++i) { h[i] = xf[i] * rstd * A[i] + Bs[i]; am = fmaxf(am, fabsf(h[i])); }
                            am = fmaxf(am, dpp_f<DPP_XOR1>(am)); am = fmaxf(am, dpp_f<DPP_XOR2>(am)); am = fmaxf(am, dpp_f<DPP_HMIRROR>(am)); am = fmaxf(am, dpp_f<DPP_ROR8>(am));
                            { const u32x2 sw = __builtin_amdgcn_permlane16_swap(__builtin_bit_cast(unsigned, am), __builtin_bit_cast(unsigned, am), false, false); const unsigned s0 = sw[0], s1 = sw[1];
                              am = fmaxf(__builtin_bit_cast(float, s0), __builtin_bit_cast(float, s1)); }
                            { const u32x2 sw = __builtin_amdgcn_permlane32_swap(__builtin_bit_cast(unsigned, am), __builtin_bit_cast(unsigned, am), false, false); const unsigned s0 = sw[0], s1 = sw[1];
                              am = fmaxf(__builtin_bit_cast(float, s0), __builtin_bit_cast(float, s1)); }
                            am = fmaxf(am, 1e-30f);
                            const float hs = 119.f * frcp(am);
                            unsigned whi = 0u, wlo = 0u;
#pragma unroll
                            for (int i = 0; i < 4; ++i) {
                                const unsigned qb = __builtin_bit_cast(unsigned, h[i] * hs + I8_MAGIC);
                                wlo |= (qb & 15u) << (4 * i);
                                whi |= (((qb + 8u) >> 4) & 15u) << (4 * i);
                            }
                            *(LAS unsigned short*)(wlds + tk * 256 + lane * 2) = (unsigned short)whi;
                            *(LAS unsigned short*)(wlds + tk * 256 + 128 + lane * 2) = (unsigned short)wlo;
                            *(LAS float*)(wlds + 4096 + tk * 4) = am * (1.f / 119.f);
                        }
                    }
                    asm volatile("s_waitcnt lgkmcnt(0)" ::: "memory");
                }
                const unsigned lo_st = og + 2 * (c & 1) + 4 * ((c >> 1) & 1) + 8 * ((c >> 2) & 1);
                _Float16* apb = (_Float16*)p.apart() + ((size_t)sl * NTOK + t0) * 128;
#define G1_TOKEN(tt, IDC, IDN, MORE) do { \
                    const u32x4 hh4 = *(const LAS u32x4*)(wlds + (tt) * 256 + oc), hl4 = *(const LAS u32x4*)(wlds + (tt) * 256 + 128 + oc); \
                    const float hinv = *(const LAS float*)(wlds + 4096 + (tt) * 4); \
                    const unsigned hqh[4] = {hh4[0], hh4[1], hh4[2], hh4[3]}, hql[4] = {hl4[0], hl4[1], hl4[2], hl4[3]}; \
                    int pd[16]; \
                    g_dots8_i4(RA, hqh, hql, pd); \
                    if (MORE) g_rows8(tb, oc, IDN[0], RA); \
                    g_dots8_i4(RB, hqh, hql, pd + 8); \
                    if (MORE) { g_rows8(tb, oc, IDN[1], RB); if ((tt) + 2 < 16) g_ids(idb + ((tt) + 2) * 128, og, IDC); }        \
                    int o0, o1; halve16_c8(pd, c & 4, c & 2, c & 1, o0, o1); \
                    const auto st = __builtin_amdgcn_cvt_pkrtz((float)o0 * hinv, (float)o1 * hinv); \
                    *(unsigned*)(apb + (tt) * 128 + lo_st) = __builtin_bit_cast(unsigned, st); } while (0)
#pragma unroll 1
                for (int tt = 0; tt < 16; tt += 2) {
                    G1_TOKEN(tt, idc, idn, true);
                    const bool more = tt + 2 < 16;
                    G1_TOKEN(tt + 1, idn, idc, more);
                }
#undef G1_TOKEN
            } else {
                LAS unsigned char* rl = lds + __builtin_amdgcn_readfirstlane(tid_ >> 6) * 16640;
                LAS float* ol = (LAS float*)rl;
                const int q16 = lane & 15, kq = lane >> 4;
                const unsigned lo_col = lane * 4;
                bf16_t* xb = p.x1b() + (size_t)t0 * DM + sl * SLW;
                const f32x4 g2 = *(const f32x4*)(modb + 5 * DM + lo_col);
                u32x2 x1n = *(const u32x2*)(xb + lo_col);
                const unsigned char* wq = (const unsigned char*)p.wl() + (size_t)t0 * 256 + (q16 & 3) * 64 + kq * 16;
                const float* wscp = (const float*)((const unsigned char*)p.wl() + 8 * MiB) + t0;
                const bool wrow = q16 < 4;
                const unsigned wroff = (unsigned)g * 128 + oc;
                const unsigned troff = (unsigned)q16 * 1040 + (unsigned)(2 * kq) * 128;
#define G2_TOKEN(tt, IDC, IDN, MORE) do { \
                    g_rows8(tb, oc, IDC[1], RB); \
                    const unsigned x01 = x1n[0], x23 = x1n[1]; \
                    i32x4 wa0 = *(const i32x4*)(wq + (tt) * 256); const float wsc_ = wscp[(tt)]; \
                    if (MORE) { g_ids(idb + ((tt) + 1) * 128, og, IDN); x1n = *(const u32x2*)(xb + (size_t)((tt) + 1) * DM + lo_col); } \
                    _Pragma("unroll") for (int i = 0; i < 8; ++i) *(LAS u32x4*)(rl + wroff + i * 1040) = RA[i]; \
                    if (MORE) g_rows8(tb, oc, IDN[0], RA); \
                    _Pragma("unroll") for (int i = 0; i < 8; ++i) *(LAS u32x4*)(rl + wroff + (8 + i) * 1040) = RB[i]; \
                    if (!wrow) wa0 = (i32x4){0, 0, 0, 0}; \
                    const int wA_ = wa0[0], wB_ = wa0[1], wC_ = wa0[2], wD_ = wa0[3]; \
                    const i32x8 a8 = {wA_, wB_, wC_, wD_, 0, 0, 0, 0}; \
                    asm volatile("s_waitcnt lgkmcnt(0)" ::: "memory"); \
                    float ov[16]; \
                    { i32x2 tA_[16], tB_[16]; \
                      _Pragma("unroll") for (int cb = 0; cb < 16; ++cb) { tA_[cb] = __builtin_amdgcn_ds_read_tr4_b64_v2i32((LAS i32x2*)(rl + troff + cb * 8)); tB_[cb] = __builtin_amdgcn_ds_read_tr4_b64_v2i32((LAS i32x2*)(rl + troff + 128 + cb * 8)); } \
                      _Pragma("unroll") for (int cb = 0; cb < 16; ++cb) { \
                        const int b0_ = tA_[cb][0], b1_ = tA_[cb][1], b2_ = tB_[cb][0], b3_ = tB_[cb][1]; \
                        const i32x8 b8 = {b0_, b1_, b2_, b3_, 0, 0, 0, 0}; \
                        f32x4 c4 = {0.f, 0.f, 0.f, 0.f}; \
                        c4 = __builtin_amdgcn_mfma_scale_f32_16x16x128_f8f6f4(a8, b8, c4, 4, 4, 0, 0x7f7f7f7f, 0, 0x7f7f7f7f); \
                        ov[cb] = (c4[0] + c4[1] * 0.25f) + (c4[2] * 0.0625f + c4[3] * 0.015625f); } \
                      _Pragma("unroll") for (int cb = 0; cb < 16; ++cb) asm volatile("" : "+v"(ov[cb])); } \
                    if (lane < 16) { _Pragma("unroll") for (int cb = 0; cb < 16; ++cb) ol[cb * 16 + lane] = ov[cb]; } \
                    asm volatile("s_waitcnt lgkmcnt(0)" ::: "memory"); \
                    const f32x4 o4 = *(const LAS f32x4*)(ol + lo_col) * wsc_; \
                    u32x2 x2; x2[0] = pg8::cvt_pk_bf16(bflo(x01) + g2[0] * o4[0], bfhi(x01) + g2[1] * o4[1]); x2[1] = pg8::cvt_pk_bf16(bflo(x23) + g2[2] * o4[2], bfhi(x23) + g2[3] * o4[3]); \
                    *(u32x2*)(xb + (size_t)(tt) * DM + lo_col) = x2; \
                    asm volatile("s_waitcnt lgkmcnt(0)" ::: "memory"); } while (0)
#pragma unroll 1
                for (int tt = 0; tt < 16; tt += 2) {
                    G2_TOKEN(tt, idc, idn, true);
                    const bool more = tt + 2 < 16;
                    G2_TOKEN(tt + 1, idn, idc, more);
                }
#undef G2_TOKEN
            }
        }
    }
}
__device__ __forceinline__ void ph_gather_weights(const P& p) {
    int tid_ = threadIdx.x; asm volatile("" : "+v"(tid_));
    const int lane = tid_ & 63, wave = __builtin_amdgcn_readfirstlane(tid_ >> 6);
    const float* isc = p.pisc();
    for (int tok = blockIdx.x * NWAVES + wave; tok < NTOK; tok += gridDim.x * NWAVES) {
        const size_t i = (size_t)tok * 128 + lane * 2;
        const unsigned ee = *(const unsigned*)((const unsigned short*)p.topk() + i); const f32x2 gate = *(const f32x2*)(p.gates() + i);
        const unsigned e0 = ee & 0xffffu, e1 = ee >> 16;
        const f32x4 su0 = *(const f32x4*)(p.pisc_u() + (size_t)e0 * 4), su1 = *(const f32x4*)(p.pisc_u() + (size_t)e1 * 4);
        float a0 = 0.f, a1 = 0.f;
#pragma unroll
        for (int sl = 0; sl < 4; ++sl) { typedef _Float16 h2_t __attribute__((ext_vector_type(2))); const h2_t ap = __builtin_bit_cast(h2_t, *(const unsigned*)((const _Float16*)p.apart() + (size_t)sl * NTOK * 128 + i)); a0 += (float)ap[0] * su0[sl]; a1 += (float)ap[1] * su1[sl]; }
        const float w0 = gate[0] * isc[16384 + e0] * gelu_tanh(a0), w1 = gate[1] * isc[16384 + e1] * gelu_tanh(a1);
        const float wm = wave_max(fmaxf(fabsf(w0), fabsf(w1)));
        const float sc = wm > 0.f ? 6.f * frcp(wm) : 0.f;
        float x0 = w0 * sc, x1 = w1 * sc;
        unsigned char* wq = (unsigned char*)p.wl() + (size_t)tok * 256 + lane;
#pragma unroll
        for (int pl = 0; pl < 4; ++pl) {
            const unsigned by = __builtin_amdgcn_cvt_scalef32_pk_fp4_f32(0u, x0, x1, 1.0f, 0) & 255u;
            const auto dd = __builtin_amdgcn_cvt_scalef32_pk_f16_fp4(by, 1.0f, 0);
            x0 = (x0 - (float)dd[0]) * 4.f; x1 = (x1 - (float)dd[1]) * 4.f;
            wq[pl * 64] = (unsigned char)by;
        }
        if (lane == 0) ((float*)((unsigned char*)p.wl() + 8 * MiB))[tok] = wm * (1.f / 6.f);
    }
}
__device__ __forceinline__ void ph_final_norm(const P& p) {
    int tid_ = threadIdx.x; asm volatile("" : "+v"(tid_));
    const int wave = __builtin_amdgcn_readfirstlane(tid_ >> 6), lane = tid_ & 63;
    for (int t4 = blockIdx.x * NWAVES + wave; t4 < NTOK / 4; t4 += gridDim.x * NWAVES) {
        const u32x4* src = (const u32x4*)(p.x1b() + (size_t)t4 * 4 * DM);
        f32x4* row = (f32x4*)(p.out + (size_t)t4 * 4 * DM);
        u32x4 vw[4][2];
#pragma unroll
        for (int k = 0; k < 4; ++k)
#pragma unroll
            for (int j = 0; j < 2; ++j) vw[k][j] = src[k * (DM / 8) + lane + 64 * j];
#pragma unroll
        for (int k = 0; k < 4; ++k) {
            f32x4 v[4]; float ss = 0.f;
#pragma unroll
            for (int j = 0; j < 2; ++j) {
                const unsigned w0 = vw[k][j][0], w1 = vw[k][j][1], w2 = vw[k][j][2], w3 = vw[k][j][3];
                v[j * 2] = (f32x4){bflo(w0), bfhi(w0), bflo(w1), bfhi(w1)}; v[j * 2 + 1] = (f32x4){bflo(w2), bfhi(w2), bflo(w3), bfhi(w3)};
            }
#pragma unroll
            for (int j = 0; j < 4; ++j) ss += v[j][0] * v[j][0] + v[j][1] * v[j][1] + v[j][2] * v[j][2] + v[j][3] * v[j][3];
            ss = wave_sum(ss);
            const float rstd = rsqrtf(ss * (1.f / DM) + EPSN);
#pragma unroll
            for (int j = 0; j < 4; ++j) { const int i4 = (lane + 64 * (j >> 1)) * 2 + (j & 1); const f32x4 fg = ((const f32x4*)p.final_g)[i4]; row[k * (DM / 4) + i4] = v[j] * rstd * fg; }
        }
    }
}

#define XB_TMO      128
#define XB_XCNT(j)  (256  + 64 * (j))
#define XB_XSUB(j)  (1280 + 64 * (j))
#define XB_XGEN(j)  (2304 + 64 * (j))
#define XB_TOP      3328
#define XB_TOPGEN   3392
#define XCD_BAR_WORDS 3456
#define XB_SPIN_CAP (1u << 18)
__device__ __forceinline__ unsigned xb_ld(unsigned* p)              { return __hip_atomic_load(p, __ATOMIC_RELAXED, __HIP_MEMORY_SCOPE_AGENT); }
__device__ __forceinline__ unsigned xb_add(unsigned* p, unsigned v) { return __hip_atomic_fetch_add(p, v, __ATOMIC_RELAXED, __HIP_MEMORY_SCOPE_AGENT); }
__device__ __forceinline__ unsigned xb_xcc_id() { return (unsigned)__builtin_amdgcn_s_getreg((3 << 11) | 20) & 0xFu; }
#define XB_SPIN(cond, bar) do { unsigned _sp = 0; while (cond) { __builtin_amdgcn_s_sleep(1); \
    if ((++_sp & 255u) == 0u) { if (xb_ld(&(bar)[XB_TMO])) break; if (_sp > XB_SPIN_CAP) { atomicAdd(&(bar)[XB_TMO], 1u); break; } } } } while (0)
struct XcdBarrier { unsigned* bar; unsigned x; volatile LAS unsigned* st; };
__device__ __forceinline__ XcdBarrier xcd_barrier_post(unsigned* bar, volatile LAS unsigned* st) {
    XcdBarrier b; b.bar = bar; b.x = xb_xcc_id(); b.st = st;
    if (threadIdx.x == 0) (void)xb_add(&bar[XB_XCNT(b.x)], 1u);
    return b;
}
__device__ __forceinline__ void xcd_barrier_complete(unsigned* bar, unsigned x, unsigned& nloc, unsigned& nx) {
    const unsigned G = gridDim.x * gridDim.y * gridDim.z;
    unsigned sum, cnt, mine, sp = 0u;
    for (;;) {
        sum = 0u; cnt = 0u; mine = 0u;
#pragma unroll
        for (unsigned j = 0; j < 16; ++j) { const unsigned c = xb_ld(&bar[XB_XCNT(j)]); sum += c; cnt += (c > 0u) ? 1u : 0u; mine = (j == x) ? c : mine; }
        if (sum == G) break;
        __builtin_amdgcn_s_sleep(1);
        if ((++sp & 255u) == 0u) { if (xb_ld(&bar[XB_TMO])) break; if (sp > XB_SPIN_CAP) { atomicAdd(&bar[XB_TMO], 1u); break; } }
    }
    nloc = mine > 0u ? mine : 1u; nx = cnt > 0u ? cnt : 1u;
}
__device__ __forceinline__ void xcd_barrier(const XcdBarrier& b) {
    asm volatile("s_waitcnt vmcnt(0)" ::: "memory");
    __syncthreads();
    if (threadIdx.x == 0) {
        unsigned* bar = b.bar;
        __builtin_amdgcn_s_waitcnt(0);
        unsigned nloc = b.st[0], nx = b.st[1];
        if (nloc == 0u) { xcd_barrier_complete(bar, b.x, nloc, nx); b.st[0] = nloc; b.st[1] = nx; }
        const unsigned old = xb_add(&bar[XB_XSUB(b.x)], 1u);
        const unsigned gen = old / nloc;
        if (old + 1u == (gen + 1u) * nloc) {
            __builtin_amdgcn_fence(__ATOMIC_RELEASE, "agent");
            asm volatile("s_waitcnt vmcnt(0)" ::: "memory");
            const unsigned og = xb_add(&bar[XB_TOP], 1u);
            const unsigned tg = og / nx;
            if (og + 1u == (tg + 1u) * nx) xb_add(&bar[XB_TOPGEN], 1u);
            else XB_SPIN(xb_ld(&bar[XB_TOPGEN]) == tg, bar);
            __builtin_amdgcn_fence(__ATOMIC_ACQUIRE, "agent");
            xb_add(&bar[XB_XGEN(b.x)], 1u);
            asm volatile("s_waitcnt vmcnt(0)" ::: "memory");
        } else {
            XB_SPIN(xb_ld(&bar[XB_XGEN(b.x)]) == gen, bar);
            __builtin_amdgcn_fence(__ATOMIC_ACQUIRE, "agent");
            asm volatile("s_waitcnt vmcnt(0)" ::: "memory");
        }
    }
    __syncthreads();
}

constexpr int LDS_BYTES = 147456;
#define GSYNC() xcd_barrier(xbar)
constexpr int MISC_OFF = LDS_BYTES - 64;

__global__ void __launch_bounds__(NT, 2) mega(P p) {
    extern __shared__ __attribute__((aligned(16))) unsigned char lds_raw[];
    LAS unsigned char* lds = (LAS unsigned char*)lds_raw;
    const int G = gridDim.x, bx = blockIdx.x;
    using namespace pg8;
    if (threadIdx.x < 16) ((LAS unsigned*)(lds + MISC_OFF))[threadIdx.x] = 0u;
    for (unsigned i = (unsigned)bx * NT + threadIdx.x; i < (1u << 20) / 8u; i += (unsigned)G * NT) ((unsigned long long*)p.ws)[i] = 0ull;
    cg::this_grid().sync();
    const XcdBarrier xbar = xcd_barrier_post((unsigned*)p.ws, (volatile LAS unsigned*)(lds + MISC_OFF));

    ph_prep(p, lds);
    GSYNC();
    ph_norm1(p, lds);
    GSYNC();
    {
        Gemm<DM / 2, DM / 2, DM / 2, 0, 0, true> g{p.hx(), p.w_in_t()}; StaticOrder<NTOK, INC> S; S.init(G, bx);
        EpiInProj E{p.U(), p.kb(), (size_t)(p.qb() - p.kb()), p.vT(), p.ga(), 0};
        gemm_phase<EpiInProj, StaticOrder<NTOK, INC>, true, true>(lds, g, S, E);
        Gemm<DM / 2, DM / 2, DM / 2, 0, 0, true> g2{p.hc(), p.w_in_t()}; StaticOrder<NCTX, CTXC> S2; S2.init(G, bx);
        EpiInProj E2{p.U(), p.kc(), 0, p.vcT(), p.ga(), 1};
        gemm_phase<EpiInProj, StaticOrder<NCTX, CTXC>, true, true>(lds, g2, S2, E2);
    }
    for (int it = bx - 48; it >= 0 && it < 128; it += G) ssm_prep_item(p, lds, it);
    for (int cb = bx - 176; cb >= 0 && cb < 32; cb += G) {
        const float* m3 = p.mod() + 3 * DM;
        const float* const rows[8] = {m3, m3 + 6 * DM, m3 + 12 * DM, m3 + 18 * DM, m3 + 24 * DM, m3 + 30 * DM, m3 + 36 * DM, m3 + 42 * DM};
        gemv_block64<8, false>(rows, p.w_q, 2048, cb * 64, nullptr, p.c2(), 2048, (LAS float*)lds);
    }
    bg_convert_tables(p);
    GSYNC();
    {
        Gemm<256, SSM_LD / 2, 256, (long)SSM_ROWS * SSM_LD / 2, 256L * 256, 2> g{p.U(), p.Win()}; StaticOrder<SSM_ROWS, 256, 32> S; S.init(G, bx);
        EpiE E{p.E()};
        gemm_phase<EpiE, StaticOrder<SSM_ROWS, 256, 32>, true, true>(lds, g, S, E);
    }
    GSYNC();
    ph_carry(p);
    if (threadIdx.x >= 128) side_query_weights(p, lds, bx * 6 + (int)__builtin_amdgcn_readfirstlane(threadIdx.x >> 6) - 2, G * 6, threadIdx.x & 63);
    ph_na(p, lds);
    GSYNC();
    {
        Gemm<SSM_LD / 2, SSM_LD / 2, SSM_LD / 2, (long)SSM_ROWS * SSM_LD / 2, 512L * SSM_LD / 2, 2> g{p.U(), p.Kmat()}; StaticOrder<1024, 512, 32> S; S.init(G, bx);
        EpiZ E{p.z()};
        gemm_phase<EpiZ, StaticOrder<1024, 512, 32>, true, true>(lds, g, S, E);
    }
    GSYNC();
    {
        Gemm<256, 256, 256, 0, 0, 1> g{p.z(), p.w_glu_t()}; StaticOrder<NTOK, 512> S; S.init(G, bx);
        EpiGlu E{p.gl(), p.z(), p.b_glu};
        gemm_phase<EpiGlu, StaticOrder<NTOK, 512>, true, true>(lds, g, S, E);
    }
    GSYNC();
    {
        Gemm<256, 256, 256, 32L * 1024 * 1024, 512L * 1024, true> g{p.na(), p.w_b_t()}; PairOrder<NTOK, DM> S; S.init(G, bx);
        EpiMerge E{p.merged(), (const unsigned char*)p.ga(), (const unsigned char*)p.gb()};
        gemm_phase<EpiMerge, PairOrder<NTOK, DM>, true, true>(lds, g, S, E);
    }
    GSYNC();
    {
        Gemm<DM / 2, DM / 2, DM / 2, 0, 0, true> g{p.merged(), p.w_out_t()}; StaticOrder<NTOK, DM> S; S.init(G, bx);
        EpiOut E{p.x, p.x1b(), p.mod(), p.rowss()};
        gemm_phase<EpiOut, StaticOrder<NTOK, DM>, true, true>(lds, g, S, E);
    }
    GSYNC();
    {
        Gemm<DM, DM, DM, 0, 2048L * DM> g{p.x1b(), p.wq_s()}; BatchOrder<NTOK, 2048> S; S.init(G, bx);
        EpiQ E{p.qp(), p.rowss(), p.c2()};
        gemm_phase<EpiQ, BatchOrder<NTOK, 2048>, true, true>(lds, g, S, E);
    }
    GSYNC();
    ph_peer_topk(p, lds);
    GSYNC();
    ph_gather_sliced<0>(p, lds);
    GSYNC();
    ph_gather_weights(p);
    GSYNC();
    ph_gather_sliced<1>(p, lds);
    GSYNC();
    ph_final_norm(p);
}

extern "C" void kernel_launch(void* const* d_in, const int* in_sizes, int n_in, void* d_out, int out_size, void* d_ws, size_t ws_size, hipStream_t stream) {
    static int grid = 0;
    if (grid == 0) {
        int dev = 0, cus = 0, per_cu = 0;
        (void)hipGetDevice(&dev);
        (void)hipDeviceGetAttribute(&cus, hipDeviceAttributeMultiprocessorCount, dev);
        (void)hipFuncSetAttribute((const void*)mega, hipFuncAttributeMaxDynamicSharedMemorySize, LDS_BYTES);
        (void)hipOccupancyMaxActiveBlocksPerMultiprocessor(&per_cu, (const void*)mega, NT, LDS_BYTES);
        if (per_cu < 1) { fprintf(stderr, "occupancy query says %d blocks per CU\n", per_cu); per_cu = 1; }
        grid = cus;
    }
    P p{};
    const float* const* in = (const float* const*)d_in;
    p.x = in[0]; p.c = in[1]; p.ctx = in[2]; p.c_ctx = in[3]; p.w_mod = in[4]; p.b_mod = in[5]; p.norm1_g = in[6]; p.norm2_g = in[7]; p.w_in = in[8];
    p.a_re = in[9]; p.a_im = in[10]; p.log_dt = in[11]; p.b_re = in[12]; p.b_im = in[13]; p.c_re = in[14]; p.c_im = in[15]; p.ssm_d = in[16];
    p.w_glu = in[17]; p.b_glu = in[18]; p.w_a = in[19]; p.w_b = in[20]; p.rpb = in[21]; p.w_out = in[22]; p.w_q = in[23]; p.subkeys = in[24];
    p.peer_u = in[25]; p.peer_v = in[26]; p.final_g = in[27];
    p.out = (float*)d_out;
    p.ws = (unsigned char*)d_ws;
    void* args[] = {&p};
    hipError_t e = hipLaunchCooperativeKernel((const void*)mega, dim3(grid), dim3(NT), args, LDS_BYTES, stream);
    if (e != hipSuccess) fprintf(stderr, "cooperative launch failed: %s (grid %d)\n", hipGetErrorString(e), grid);
}
```
